# Optimizing an MI355X kernel written in HIP

```python
import jax, jax.numpy as jnp
from jax import lax
import numpy as np

D_MODEL = 2048
BATCH = 8
SEQ = 2048
DEPTH = 1

N_META = 16
D_MIX = D_MODEL
HEAD_DIM = 64
D_ATTN = D_MIX // 2
N_Q_HEADS = D_ATTN // HEAD_DIM
N_KV_HEADS = 4
D_KV = N_KV_HEADS * HEAD_DIM
WINDOW = 128
BLOCK = 128
ROPE_THETA = 10000.0
D_LRU = D_MIX - D_ATTN
N_LRU_BLOCKS = 16
LRU_BLOCK = D_LRU // N_LRU_BLOCKS
CONV_WIDTH = 4
LRU_C = 8.0
D_IN_PROJ = D_ATTN + 2 * D_KV + 2 * D_LRU
N_EXPERTS = 32
TOP_K = 4
D_FF = D_MODEL
SWIGLU_LIMIT = 7.0
SWIGLU_ALPHA = 1.702
NORM_EPS = 1e-5
NEG_INF = -1e30

kernel_name = "hymba_swa_sink_rglru_moe"


def rms_norm(x, g):
    xf = x.astype(jnp.float32)
    y = xf * lax.rsqrt(jnp.mean(xf * xf, axis=-1, keepdims=True) + NORM_EPS)
    return (y * g.astype(jnp.float32)).astype(x.dtype)


def rotary(x, pos):
    half = HEAD_DIM // 2
    inv = 1.0 / (ROPE_THETA ** (jnp.arange(half, dtype=jnp.float32) / half))
    ang = pos.astype(jnp.float32)[:, None] * inv[None, :]
    cos = jnp.cos(ang)[None, :, None, :]
    sin = jnp.sin(ang)[None, :, None, :]
    xf = x.astype(jnp.float32)
    x1, x2 = xf[..., :half], xf[..., half:]
    out = jnp.concatenate([x1 * cos - x2 * sin, x2 * cos + x1 * sin], axis=-1)
    return out.astype(x.dtype)


def sliding_window_attention(q, k, v, sinks):
    B, T = q.shape[0], q.shape[1]
    pad_l = (-N_META) % BLOCK
    pad_r = (-(T + pad_l)) % BLOCK
    Tp = T + pad_l + pad_r
    nb = Tp // BLOCK
    G = N_Q_HEADS // N_KV_HEADS
    padw = ((0, 0), (pad_l, pad_r), (0, 0), (0, 0))
    pos = jnp.arange(Tp) - pad_l
    q = rotary(jnp.pad(q, padw), pos)
    k = rotary(jnp.pad(k, padw), pos)
    v = jnp.pad(v, padw)

    qb = q.reshape(B, nb, BLOCK, N_KV_HEADS, G, HEAD_DIM)
    kb = k.reshape(B, nb, BLOCK, N_KV_HEADS, HEAD_DIM)
    vb = v.reshape(B, nb, BLOCK, N_KV_HEADS, HEAD_DIM)
    shift = lambda t: jnp.concatenate([jnp.zeros_like(t[:, :1]), t[:, :-1]], axis=1)
    k_band = jnp.concatenate([shift(kb), kb], axis=2)
    v_band = jnp.concatenate([shift(vb), vb], axis=2)
    k_meta = k[:, pad_l:pad_l + N_META]
    v_meta = v[:, pad_l:pad_l + N_META]

    scale = HEAD_DIM ** -0.5
    s_band = jnp.einsum('bnqhgd,bnkhd->bnhgqk', qb, k_band,
                        preferred_element_type=jnp.float32) * scale
    s_meta = jnp.einsum('bnqhgd,bmhd->bnhgqm', qb, k_meta,
                        preferred_element_type=jnp.float32) * scale

    qi = jnp.arange(nb)[:, None] * BLOCK + jnp.arange(BLOCK)[None, :]
    ki = (jnp.arange(nb)[:, None] - 1) * BLOCK + jnp.arange(2 * BLOCK)[None, :]
    diff = qi[:, :, None] - ki[:, None, :]
    band_ok = (diff >= 0) & (diff < WINDOW) & (ki[:, None, :] >= pad_l + N_META)
    meta_ok = (pad_l + jnp.arange(N_META))[None, None, :] <= qi[:, :, None]
    s_band = jnp.where(band_ok[None, :, None, None], s_band, NEG_INF)
    s_meta = jnp.where(meta_ok[None, :, None, None], s_meta, NEG_INF)

    sink = jnp.broadcast_to(
        sinks.astype(jnp.float32).reshape(N_KV_HEADS, G)[None, None, :, :, None, None],
        s_band.shape[:-1] + (1,))
    p = jax.nn.softmax(jnp.concatenate([sink, s_meta, s_band], axis=-1), axis=-1)
    p_meta = p[..., 1:1 + N_META].astype(v.dtype)
    p_band = p[..., 1 + N_META:].astype(v.dtype)
    o = (jnp.einsum('bnhgqm,bmhd->bnqhgd', p_meta, v_meta)
         + jnp.einsum('bnhgqk,bnkhd->bnqhgd', p_band, v_band))
    o = o.reshape(B, Tp, D_ATTN)
    return o[:, pad_l:pad_l + T]


def rg_lru_branch(xr, gate, conv_w, conv_b, w_a, b_a, w_i, b_i, lam):
    B, T, C = xr.shape
    xc = lax.conv_general_dilated(
        xr, conv_w[:, None, :].astype(xr.dtype), window_strides=(1,),
        padding=((CONV_WIDTH - 1, 0),), dimension_numbers=('NWC', 'WIO', 'NWC'),
        feature_group_count=C) + conv_b
    xh = xc.reshape(B, T, N_LRU_BLOCKS, LRU_BLOCK)
    r = jax.nn.sigmoid((jnp.einsum('btnc,ncd->btnd', xh, w_a).reshape(B, T, C) + b_a).astype(jnp.float32))
    i = jax.nn.sigmoid((jnp.einsum('btnc,ncd->btnd', xh, w_i).reshape(B, T, C) + b_i).astype(jnp.float32))
    log_a = -LRU_C * r * jax.nn.softplus(-lam.astype(jnp.float32))
    a = jnp.exp(log_a)
    mult = jnp.sqrt(-jnp.expm1(2.0 * log_a))
    b = mult * i * xc.astype(jnp.float32)

    def combine(e1, e2):
        a1, b1 = e1
        a2, b2 = e2
        return a1 * a2, a2 * b1 + b2

    _, h = lax.associative_scan(combine, (a, b), axis=1)
    y = h * jax.nn.gelu(gate.astype(jnp.float32))
    return y.astype(xr.dtype)


def hybrid_mixer(h, w_in, b_in, sinks, conv_w, conv_b, w_a, b_a, w_i, b_i, lam,
                 g_attn_out, g_lru_out, w_out, b_out):
    B, T, _ = h.shape
    z = h @ w_in + b_in
    q, k, v, xr, gt = jnp.split(
        z, [D_ATTN, D_ATTN + D_KV, D_ATTN + 2 * D_KV, D_ATTN + 2 * D_KV + D_LRU], axis=-1)
    q = q.reshape(B, T, N_Q_HEADS, HEAD_DIM)
    k = k.reshape(B, T, N_KV_HEADS, HEAD_DIM)
    v = v.reshape(B, T, N_KV_HEADS, HEAD_DIM)
    attn = sliding_window_attention(q, k, v, sinks)
    lru = rg_lru_branch(xr, gt, conv_w, conv_b, w_a, b_a, w_i, b_i, lam)
    o = jnp.concatenate([rms_norm(attn, g_attn_out), rms_norm(lru, g_lru_out)], axis=-1)
    return o @ w_out + b_out


def moe_ffn(h, w_router, b_router, w_gate, b_gate, w_up, b_up, w_down, b_down):
    B, T, D = h.shape
    xf = h.reshape(-1, D)
    N = xf.shape[0]
    logits = (xf @ w_router + b_router).astype(jnp.float32)
    top_v, top_e = lax.top_k(logits, TOP_K)
    wts = jax.nn.softmax(top_v, axis=-1)
    e_flat = top_e.reshape(-1)
    order = jnp.argsort(e_flat)
    e_sorted = e_flat[order]
    tok = order // TOP_K
    xs = xf[tok]
    sizes = jnp.bincount(e_flat, length=N_EXPERTS).astype(jnp.int32)
    g = lax.ragged_dot(xs, w_gate, sizes) + b_gate[e_sorted]
    u = lax.ragged_dot(xs, w_up, sizes) + b_up[e_sorted]
    g = jnp.minimum(g, SWIGLU_LIMIT)
    u = jnp.clip(u, -SWIGLU_LIMIT, SWIGLU_LIMIT)
    act = g * jax.nn.sigmoid(SWIGLU_ALPHA * g) * (u + 1.0)
    y = lax.ragged_dot(act, w_down, sizes) + b_down[e_sorted]
    y = y * wts.reshape(-1)[order][:, None].astype(y.dtype)
    out = jax.ops.segment_sum(y, tok, num_segments=N)
    return out.reshape(B, T, D)


def setup_inputs(seed: int = 0) -> dict:
    key = jax.random.key(seed)
    ks = jax.random.split(key, 32)
    f32 = jnp.float32
    nrm = lambda k, shape, s: jax.random.normal(k, shape, f32) * s
    L = DEPTH
    u = jax.random.uniform(ks[12], (L, D_LRU), f32, 0.81, 0.998)
    s = u ** (1.0 / LRU_C)
    lru_lambda = jnp.log(s) - jnp.log1p(-s)
    return {
        "x": nrm(ks[0], (BATCH, SEQ, D_MODEL), 1.0),
        "meta_tokens": nrm(ks[1], (N_META, D_MODEL), 1.0),
        "norm_mix": 1.0 + nrm(ks[2], (L, D_MODEL), 0.02),
        "w_in": nrm(ks[3], (L, D_MODEL, D_IN_PROJ), D_MODEL ** -0.5),
        "b_in": nrm(ks[4], (L, D_IN_PROJ), 0.01),
        "sinks": nrm(ks[5], (L, N_Q_HEADS), 0.5),
        "conv_w": nrm(ks[6], (L, CONV_WIDTH, D_LRU), CONV_WIDTH ** -0.5),
        "conv_b": nrm(ks[7], (L, D_LRU), 0.01),
        "w_a": nrm(ks[8], (L, N_LRU_BLOCKS, LRU_BLOCK, LRU_BLOCK), LRU_BLOCK ** -0.5),
        "b_a": nrm(ks[9], (L, D_LRU), 0.01),
        "w_i": nrm(ks[10], (L, N_LRU_BLOCKS, LRU_BLOCK, LRU_BLOCK), LRU_BLOCK ** -0.5),
        "b_i": nrm(ks[11], (L, D_LRU), 0.01),
        "lru_lambda": lru_lambda,
        "g_attn_out": 1.0 + nrm(ks[13], (L, D_ATTN), 0.02),
        "g_lru_out": 1.0 + nrm(ks[14], (L, D_LRU), 0.02),
        "w_out": nrm(ks[15], (L, D_MIX, D_MODEL), D_MIX ** -0.5),
        "b_out": nrm(ks[16], (L, D_MODEL), 0.01),
        "norm_ffn": 1.0 + nrm(ks[17], (L, D_MODEL), 0.02),
        "w_router": nrm(ks[18], (L, D_MODEL, N_EXPERTS), D_MODEL ** -0.5),
        "b_router": nrm(ks[19], (L, N_EXPERTS), 0.01),
        "w_gate": nrm(ks[20], (L, N_EXPERTS, D_MODEL, D_FF), D_MODEL ** -0.5),
        "b_gate": nrm(ks[21], (L, N_EXPERTS, D_FF), 0.01),
        "w_up": nrm(ks[22], (L, N_EXPERTS, D_MODEL, D_FF), D_MODEL ** -0.5),
        "b_up": nrm(ks[23], (L, N_EXPERTS, D_FF), 0.01),
        "w_down": nrm(ks[24], (L, N_EXPERTS, D_FF, D_MODEL), D_FF ** -0.5),
        "b_down": nrm(ks[25], (L, N_EXPERTS, D_MODEL), 0.01),
        "final_norm": 1.0 + nrm(ks[26], (D_MODEL,), 0.02),
    }


def reference(x, meta_tokens, norm_mix, w_in, b_in, sinks, conv_w, conv_b, w_a, b_a,
              w_i, b_i, lru_lambda, g_attn_out, g_lru_out, w_out, b_out, norm_ffn,
              w_router, b_router, w_gate, b_gate, w_up, b_up, w_down, b_down, final_norm):
    B = x.shape[0]
    meta = jnp.broadcast_to(meta_tokens[None].astype(x.dtype), (B, N_META, x.shape[-1]))
    h = jnp.concatenate([meta, x], axis=1)
    for l in range(DEPTH):
        h = h + hybrid_mixer(rms_norm(h, norm_mix[l]), w_in[l], b_in[l], sinks[l],
                             conv_w[l], conv_b[l], w_a[l], b_a[l], w_i[l], b_i[l],
                             lru_lambda[l], g_attn_out[l], g_lru_out[l], w_out[l], b_out[l])
        h = h + moe_ffn(rms_norm(h, norm_ffn[l]), w_router[l], b_router[l], w_gate[l],
                        b_gate[l], w_up[l], b_up[l], w_down[l], b_down[l])
    h = rms_norm(h, final_norm)
    return h[:, N_META:]
```

```cpp
#include <hip/hip_runtime.h>
#include <cstdio>
#include <cstdint>

#define LAS __attribute__((address_space(3)))
typedef unsigned short bf16;
typedef float f32x4 __attribute__((ext_vector_type(4)));
typedef short bf16x8 __attribute__((ext_vector_type(8)));
typedef unsigned u32x4 __attribute__((ext_vector_type(4)));
typedef unsigned u32x2 __attribute__((ext_vector_type(2)));

constexpr int D = 2048, SEQ = 2048, NMETA = 16, TT = 2064, NBATCH = 8;
constexpr int MREAL = 16384, METAROW0 = 16384, MVALID = 16400, MROWS = 16640;
constexpr int DIN = 3584, DLRU = 1024, HD = 64;
constexpr int ZQ = 0, ZK = 1024, ZV = 1280, ZX = 1536, ZG = 2560;
constexpr int NEXP = 32, DFF = 2048, PROWS = 73728;
constexpr float EPS = 1e-5f;

constexpr size_t MiB = 1u << 20;
constexpr size_t WS_CTL = 0, CTL_BYTES = 1 * MiB;
constexpr size_t WS_COS = 1 * MiB, WS_SIN = 1 * MiB + 320 * 1024;
constexpr size_t WS_TOPE = 2 * MiB, WS_TOPW = WS_TOPE + 256 * 1024, WS_RSTD2 = WS_TOPW + 256 * 1024, WS_ROWPAIR = WS_RSTD2 + 64 * 1024, WS_ROWW = WS_ROWPAIR + 320 * 1024;
constexpr size_t WS_LRUSUM = 4 * MiB;
constexpr size_t WS_WINT = 10 * MiB, WS_WOUTT = 24 * MiB, WS_WGT = 32 * MiB, WS_WUT = 288 * MiB, WS_WDT = 544 * MiB;
constexpr size_t WS_N1 = 800 * MiB, WS_Z = 866 * MiB, WS_O = 980 * MiB, WS_H1 = 1044 * MiB, WS_XS = 1172 * MiB, WS_YB = WS_XS, WS_ACT = 1460 * MiB, WS_END = 1748 * MiB;
constexpr size_t WS_XC = WS_XS, WS_AA = WS_XS + 66 * MiB, WS_BB = WS_XS + 132 * MiB, WS_YL = WS_XS + 198 * MiB;
static_assert(WS_ROWW + PROWS * 4 <= WS_LRUSUM, "small map");
constexpr int CW_COUNTS = 1024, CW_CURSOR = 1088, CW_BAR = 4096;

constexpr int LDS_TAB = 131072;
constexpr int LDS_MISC = LDS_TAB + 8192;
constexpr int LDS_BYTES = 147456;

__device__ const float c_inv_freq[32] = {1.000000000e+00f, 7.498942018e-01f, 5.623413324e-01f, 4.216965139e-01f, 3.162277639e-01f, 2.371373922e-01f, 1.778279394e-01f, 1.333521456e-01f, 1.000000015e-01f, 7.498941571e-02f, 5.623412877e-02f, 4.216964915e-02f, 3.162277862e-02f, 2.371373586e-02f, 1.778279431e-02f, 1.333521493e-02f, 9.999999776e-03f, 7.498942316e-03f, 5.623413250e-03f, 4.216964822e-03f, 3.162277862e-03f, 2.371373819e-03f, 1.778279431e-03f, 1.333521446e-03f, 1.000000047e-03f, 7.498941850e-04f, 5.623413017e-04f, 4.216965463e-04f, 3.162277862e-04f, 2.371373848e-04f, 1.778279402e-04f, 1.333521504e-04f};

struct Args { const float* in[27]; float* out; unsigned char* ws; int ph_lo, ph_hi; };
enum { I_X = 0, I_META, I_NORM_MIX, I_W_IN, I_B_IN, I_SINKS, I_CONV_W, I_CONV_B, I_W_A, I_B_A, I_W_I, I_B_I, I_LAMBDA, I_G_ATTN, I_G_LRU, I_W_OUT, I_B_OUT, I_NORM_FFN,
       I_W_ROUTER, I_B_ROUTER, I_W_GATE, I_B_GATE, I_W_UP, I_B_UP, I_W_DOWN, I_B_DOWN, I_FINAL_NORM };

__device__ __forceinline__ float bf2f(unsigned b) { return __uint_as_float((b & 0xffffu) << 16); }
__device__ __forceinline__ unsigned f2bf(float f) { unsigned u = __float_as_uint(f); return (u + 0x7fffu + ((u >> 16) & 1u)) >> 16; }
__device__ __forceinline__ unsigned pk2(float lo, float hi) { return f2bf(lo) | (f2bf(hi) << 16); }
__device__ __forceinline__ float wave_sum(float v) {
#pragma unroll
    for (int o = 1; o < 64; o <<= 1) v += __shfl_xor(v, o);
    return v;
}
__device__ __forceinline__ float wave_max(float v) {
#pragma unroll
    for (int o = 1; o < 64; o <<= 1) v = fmaxf(v, __shfl_xor(v, o));
    return v;
}
__device__ __forceinline__ float sigmoidf_(float x) { return 1.0f / (1.0f + __expf(-x)); }
__device__ __forceinline__ float gelu_tanh(float x) { const float u = 0.7978845608028654f * (x + 0.044715f * x * x * x); return 0.5f * x * (1.0f + tanhf(u)); }
__device__ __forceinline__ int tok_row(int b, int t) { return t < NMETA ? METAROW0 + t : b * SEQ + (t - NMETA); }

__device__ __forceinline__ void transpose_item(const float* W, int K, int N, bf16* WT, LAS float* scr, int item, int lane) {
    const int nblk = N / 32, kb = item / nblk, nb = item % nblk, k0 = 64 * kb, n0 = 32 * nb;
#pragma unroll 8
    for (int i = 0; i < 32; ++i) { const int kk = 2 * i + (lane >> 5); scr[kk * 33 + (lane & 31)] = W[(size_t)(k0 + kk) * N + n0 + (lane & 31)]; }
    asm volatile("s_waitcnt lgkmcnt(0)" ::: "memory");
    const int c = lane & 7;
#pragma unroll
    for (int j = 0; j < 4; ++j) { const int n = (lane >> 3) + 8 * j; const LAS float* s = scr + (8 * c) * 33 + n;
        u32x4 o; o.x = pk2(s[0 * 33], s[1 * 33]); o.y = pk2(s[2 * 33], s[3 * 33]); o.z = pk2(s[4 * 33], s[5 * 33]); o.w = pk2(s[6 * 33], s[7 * 33]);
        *(u32x4*)(WT + (size_t)(n0 + n) * K + k0 + 8 * c) = o; }
    asm volatile("s_waitcnt lgkmcnt(0)" ::: "memory");
}

__device__ __forceinline__ void phase_prologue(const Args& a, LAS unsigned char* lds, int tid, int lane, int wave) {
    const int gw = blockIdx.x * 8 + wave, NGW = gridDim.x * 8;
    const int gt = blockIdx.x * 512 + tid, NGT = gridDim.x * 512;
    unsigned char* ws = a.ws;
    LAS float* scr = (LAS float*)(lds + wave * 8704);
    constexpr int IT_IN = 32 * (DIN / 32), IT_OUT = 32 * (D / 32), IT_E = 32 * (D / 32);
    constexpr int NITEMS = IT_IN + IT_OUT + 96 * IT_E;
    for (int it = gw; it < NITEMS; it += NGW) {
        int r = it;
        if (r < IT_IN) { transpose_item(a.in[I_W_IN], D, DIN, (bf16*)(ws + WS_WINT), scr, r, lane); continue; } r -= IT_IN;
        if (r < IT_OUT) { transpose_item(a.in[I_W_OUT], D, D, (bf16*)(ws + WS_WOUTT), scr, r, lane); continue; } r -= IT_OUT;
        const int mat = r / IT_E, item = r % IT_E, which = mat / NEXP, e = mat % NEXP;
        const float* src = a.in[which == 0 ? I_W_GATE : (which == 1 ? I_W_UP : I_W_DOWN)] + (size_t)e * D * D;
        bf16* dst = (bf16*)(ws + (which == 0 ? WS_WGT : (which == 1 ? WS_WUT : WS_WDT))) + (size_t)e * D * D;
        transpose_item(src, D, D, dst, scr, item, lane);
    }
    bf16* N1 = (bf16*)(ws + WS_N1);
    for (int r = gw; r < MROWS; r += NGW) {
        u32x2* orow = (u32x2*)(N1 + (size_t)r * D);
        if (r >= MVALID) {
#pragma unroll
            for (int j = 0; j < 8; ++j) orow[lane + 64 * j] = (u32x2){0u, 0u};
            continue; }
        const f32x4* xr = (const f32x4*)(r < MREAL ? a.in[I_X] + (size_t)r * D : a.in[I_META] + (size_t)(r - MREAL) * D);
        f32x4 v[8]; float ss = 0.f;
#pragma unroll
        for (int j = 0; j < 8; ++j) { v[j] = xr[lane + 64 * j]; ss += (v[j].x * v[j].x + v[j].y * v[j].y) + (v[j].z * v[j].z + v[j].w * v[j].w); }
        ss = wave_sum(ss);
        const float rstd = 1.0f / sqrtf(ss * (1.0f / D) + EPS);
#pragma unroll
        for (int j = 0; j < 8; ++j) { const f32x4 g = ((const f32x4*)a.in[I_NORM_MIX])[lane + 64 * j];
            orow[lane + 64 * j] = (u32x2){pk2(v[j].x * rstd * g.x, v[j].y * rstd * g.y), pk2(v[j].z * rstd * g.z, v[j].w * rstd * g.w)}; }
    }
    float* cosT = (float*)(ws + WS_COS); float* sinT = (float*)(ws + WS_SIN);
    for (int i = gt; i < TT * 32; i += NGT) {
        const int pos = i >> 5, j = i & 31;
        const float ang = (float)pos * c_inv_freq[j];
        const double t = (double)ang * 0.15915494309189535; const float fr = (float)(t - floor(t));
        cosT[i] = __builtin_amdgcn_cosf(fr); sinT[i] = __builtin_amdgcn_sinf(fr);
    }
    int* rowpair = (int*)(ws + WS_ROWPAIR);
    for (int i = gt; i < PROWS; i += NGT) rowpair[i] = -1;
}

template <bool DUAL, class BSel, class Epi>
__device__ __forceinline__ void naive_gemm(const bf16* A, int mt_count, int nt_count, int K, const BSel& bsel, const Epi& epi, int gw, int NGW, int lane) {
    const int fr = lane & 15, fq = lane >> 4;
    for (int tile = gw; tile < mt_count * nt_count; tile += NGW) {
        const int tm = tile / nt_count, tn = tile % nt_count;
        const bf16 *B0, *B1; bsel(tm, B0, B1);
        f32x4 acc[4][4], acc2[4][4];
#pragma unroll
        for (int i = 0; i < 4; ++i)
#pragma unroll
            for (int j = 0; j < 4; ++j) { acc[i][j] = (f32x4){0.f, 0.f, 0.f, 0.f}; acc2[i][j] = (f32x4){0.f, 0.f, 0.f, 0.f}; }
        const bf16* ap = A + (size_t)(tm * 64 + fr) * K + fq * 8;
        const bf16* bp0 = B0 + (size_t)(tn * 64 + fr) * K + fq * 8;
        const bf16* bp1 = B1 + (size_t)(tn * 64 + fr) * K + fq * 8;
        for (int k0 = 0; k0 < K; k0 += 32) {
            bf16x8 af[4], bfr[4];
#pragma unroll
            for (int i = 0; i < 4; ++i) af[i] = *(const bf16x8*)(ap + (size_t)i * 16 * K + k0);
#pragma unroll
            for (int j = 0; j < 4; ++j) bfr[j] = *(const bf16x8*)(bp0 + (size_t)j * 16 * K + k0);
#pragma unroll
            for (int i = 0; i < 4; ++i)
#pragma unroll
                for (int j = 0; j < 4; ++j) acc[i][j] = __builtin_amdgcn_mfma_f32_16x16x32_bf16(af[i], bfr[j], acc[i][j], 0, 0, 0);
            if (DUAL) {
#pragma unroll
                for (int j = 0; j < 4; ++j) bfr[j] = *(const bf16x8*)(bp1 + (size_t)j * 16 * K + k0);
#pragma unroll
                for (int i = 0; i < 4; ++i)
#pragma unroll
                    for (int j = 0; j < 4; ++j) acc2[i][j] = __builtin_amdgcn_mfma_f32_16x16x32_bf16(af[i], bfr[j], acc2[i][j], 0, 0, 0);
            }
        }
#pragma unroll
        for (int i = 0; i < 4; ++i)
#pragma unroll
            for (int j = 0; j < 4; ++j)
#pragma unroll
                for (int r = 0; r < 4; ++r) epi(tm, tm * 64 + i * 16 + fq * 4 + r, tn * 64 + j * 16 + fr, acc[i][j][r], acc2[i][j][r]);
    }
}

__device__ __forceinline__ void phase_attn_naive(const Args& a, int lane, int wave) {
    const int gw = blockIdx.x * 8 + wave, NGW = gridDim.x * 8;
    const bf16* Z = (const bf16*)(a.ws + WS_Z); bf16* O = (bf16*)(a.ws + WS_O);
    const float* cosT = (const float*)(a.ws + WS_COS); const float* sinT = (const float*)(a.ws + WS_SIN);
    const int j = lane & 31;
    for (int it = gw; it < MREAL * 16; it += NGW) {
        const int head = it & 15, row = it >> 4, b = row >> 11, s = row & 2047, t = NMETA + s, kvh = head >> 2;
        const float qv = bf2f(Z[(size_t)row * DIN + ZQ + head * 64 + lane]);
        const float qo = __shfl_xor(qv, 32);
        float c = cosT[t * 32 + j], sn = sinT[t * 32 + j];
        const float q = 0.125f * (lane < 32 ? qv * c - qo * sn : qv * c + qo * sn);
        float m = a.in[I_SINKS][head], l = 1.f, o = 0.f;
        const int nk = NMETA + (s + 1 < 128 ? s + 1 : 128);
        for (int kk = 0; kk < nk; ++kk) {
            int krow, kpos;
            if (kk < NMETA) { krow = METAROW0 + kk; kpos = kk; } else { const int sp = s - (kk - NMETA); krow = b * SEQ + sp; kpos = NMETA + sp; }
            const float kv = bf2f(Z[(size_t)krow * DIN + ZK + kvh * 64 + lane]);
            const float ko = __shfl_xor(kv, 32);
            c = cosT[kpos * 32 + j]; sn = sinT[kpos * 32 + j];
            const float kr = lane < 32 ? kv * c - ko * sn : kv * c + ko * sn;
            const float sc = wave_sum(q * kr);
            const float mn = fmaxf(m, sc), al = __expf(m - mn), p = __expf(sc - mn);
            const float vv = bf2f(Z[(size_t)krow * DIN + ZV + kvh * 64 + lane]);
            l = l * al + p; o = o * al + p * vv; m = mn;
        }
        O[(size_t)row * D + head * 64 + lane] = (bf16)f2bf(o / l);
    }
}

__device__ __forceinline__ void phase_lru_xc(const Args& a, int tid) {
    const int gt = blockIdx.x * 512 + tid, NGT = gridDim.x * 512;
    const bf16* Z = (const bf16*)(a.ws + WS_Z); float* XC = (float*)(a.ws + WS_XC);
    for (int idx = gt; idx < MVALID * DLRU; idx += NGT) {
        const int row = idx >> 10, c = idx & 1023;
        const int b = row < MREAL ? (row >> 11) : 0, t = row < MREAL ? NMETA + (row & 2047) : row - MREAL;
        float acc = a.in[I_CONV_B][c];
#pragma unroll
        for (int jj = 0; jj < 4; ++jj) { const int tt = t - 3 + jj;
            if (tt >= 0) acc += a.in[I_CONV_W][jj * DLRU + c] * bf2f(Z[(size_t)tok_row(b, tt) * DIN + ZX + c]); }
        XC[idx] = acc;
    }
}
__device__ __forceinline__ void phase_lru_gates(const Args& a, int tid) {
    const int gt = blockIdx.x * 512 + tid, NGT = gridDim.x * 512;
    const float* XC = (const float*)(a.ws + WS_XC); float* AA = (float*)(a.ws + WS_AA); float* BB = (float*)(a.ws + WS_BB);
    for (int idx = gt; idx < MVALID * DLRU; idx += NGT) {
        const int row = idx >> 10, c = idx & 1023, n = c >> 6, d = c & 63;
        float ra = a.in[I_B_A][c], ri = a.in[I_B_I][c];
        const float* xr = XC + (size_t)row * DLRU + n * 64;
        const float* wa = a.in[I_W_A] + (size_t)n * 4096 + d; const float* wi = a.in[I_W_I] + (size_t)n * 4096 + d;
        for (int cc = 0; cc < 64; ++cc) { const float xv = xr[cc]; ra += xv * wa[cc * 64]; ri += xv * wi[cc * 64]; }
        const float r = sigmoidf_(ra), ig = sigmoidf_(ri);
        const float sp = log1pf(expf(-a.in[I_LAMBDA][c]));
        const float log_a = -8.0f * r * sp;
        AA[idx] = expf(log_a);
        BB[idx] = sqrtf(-expm1f(2.0f * log_a)) * ig * XC[idx];
    }
}
__device__ __forceinline__ void phase_lru_scan(const Args& a, int tid) {
    const int gt = blockIdx.x * 512 + tid;
    if (gt >= NBATCH * DLRU) return;
    const int b = gt >> 10, c = gt & 1023;
    const float* AA = (const float*)(a.ws + WS_AA); const float* BB = (const float*)(a.ws + WS_BB); float* YL = (float*)(a.ws + WS_YL);
    const bf16* Z = (const bf16*)(a.ws + WS_Z);
    float h = 0.f;
    for (int t = 0; t < NMETA; ++t) { const int row = METAROW0 + t; h = AA[(size_t)row * DLRU + c] * h + BB[(size_t)row * DLRU + c]; }
#pragma unroll 8
    for (int s = 0; s < SEQ; ++s) { const size_t row = (size_t)b * SEQ + s;
        h = AA[row * DLRU + c] * h + BB[row * DLRU + c];
        YL[row * DLRU + c] = h * gelu_tanh(bf2f(Z[row * DIN + ZG + c])); }
}
__device__ __forceinline__ void phase_norm_o(const Args& a, int lane, int wave) {
    const int gw = blockIdx.x * 8 + wave, NGW = gridDim.x * 8;
    bf16* O = (bf16*)(a.ws + WS_O); const float* YL = (const float*)(a.ws + WS_YL);
    for (int row = gw; row < MREAL; row += NGW) {
        u32x4* op = (u32x4*)(O + (size_t)row * D);
        u32x4 w[2]; float v[16]; float ss = 0.f;
#pragma unroll
        for (int j = 0; j < 2; ++j) { w[j] = op[lane + 64 * j];
#pragma unroll
            for (int q = 0; q < 4; ++q) { v[j * 8 + 2 * q] = bf2f(w[j][q]); v[j * 8 + 2 * q + 1] = bf2f(w[j][q] >> 16); } }
#pragma unroll
        for (int i = 0; i < 16; ++i) ss += v[i] * v[i];
        ss = wave_sum(ss);
        float rstd = 1.0f / sqrtf(ss * (1.0f / 1024.0f) + EPS);
#pragma unroll
        for (int j = 0; j < 2; ++j) { const float* g = a.in[I_G_ATTN] + (lane + 64 * j) * 8; u32x4 o;
#pragma unroll
            for (int q = 0; q < 4; ++q) o[q] = pk2(v[j * 8 + 2 * q] * rstd * g[2 * q], v[j * 8 + 2 * q + 1] * rstd * g[2 * q + 1]);
            op[lane + 64 * j] = o; }
        const f32x4* yp = (const f32x4*)(YL + (size_t)row * DLRU);
        f32x4 y[4]; ss = 0.f;
#pragma unroll
        for (int j = 0; j < 4; ++j) { y[j] = yp[lane + 64 * j]; ss += (y[j].x * y[j].x + y[j].y * y[j].y) + (y[j].z * y[j].z + y[j].w * y[j].w); }
        ss = wave_sum(ss);
        rstd = 1.0f / sqrtf(ss * (1.0f / 1024.0f) + EPS);
        u32x2* o2 = (u32x2*)(O + (size_t)row * D + 1024);
#pragma unroll
        for (int j = 0; j < 4; ++j) { const f32x4 g = ((const f32x4*)a.in[I_G_LRU])[lane + 64 * j];
            o2[lane + 64 * j] = (u32x2){pk2(y[j].x * rstd * g.x, y[j].y * rstd * g.y), pk2(y[j].z * rstd * g.z, y[j].w * rstd * g.w)}; }
    }
}

__device__ __forceinline__ void phase_router(const Args& a, int lane, int wave) {
    const int gw = blockIdx.x * 8 + wave, NGW = gridDim.x * 8;
    const float* H1 = (const float*)(a.ws + WS_H1);
    int* tope = (int*)(a.ws + WS_TOPE); float* topw = (float*)(a.ws + WS_TOPW); float* rstd2 = (float*)(a.ws + WS_RSTD2);
    unsigned* counts = (unsigned*)(a.ws + WS_CTL) + CW_COUNTS;
    const float* wr = a.in[I_W_ROUTER]; const float* nf = a.in[I_NORM_FFN];
    for (int row = gw; row < MREAL; row += NGW) {
        const float* hr = H1 + (size_t)row * D;
        float ss = 0.f;
#pragma unroll
        for (int j = 0; j < 8; ++j) { const f32x4 v = ((const f32x4*)hr)[lane + 64 * j]; ss += (v.x * v.x + v.y * v.y) + (v.z * v.z + v.w * v.w); }
        ss = wave_sum(ss);
        const float rstd = 1.0f / sqrtf(ss * (1.0f / D) + EPS);
        const int e = lane & 31, kh = lane >> 5;
        float acc = 0.f;
        for (int k = kh * 1024; k < kh * 1024 + 1024; ++k) acc += (hr[k] * rstd * nf[k]) * wr[k * NEXP + e];
        acc += __shfl_xor(acc, 32);
        float val = lane < 32 ? acc + a.in[I_B_ROUTER][e] : -3.0e38f;
        float tv[4]; int te[4];
#pragma unroll
        for (int r = 0; r < 4; ++r) {
            const float mx = wave_max(val);
            const unsigned long long msk = __ballot(val == mx);
            const int win = __ffsll((long long)msk) - 1;
            tv[r] = mx; te[r] = win;
            if (lane == win) val = -3.0e38f;
        }
        const float e1 = __expf(tv[1] - tv[0]), e2 = __expf(tv[2] - tv[0]), e3 = __expf(tv[3] - tv[0]);
        const float inv = 1.0f / (1.0f + e1 + e2 + e3);
        if (lane == 0) {
            rstd2[row] = rstd;
            tope[row * 4 + 0] = te[0]; tope[row * 4 + 1] = te[1]; tope[row * 4 + 2] = te[2]; tope[row * 4 + 3] = te[3];
            topw[row * 4 + 0] = inv; topw[row * 4 + 1] = e1 * inv; topw[row * 4 + 2] = e2 * inv; topw[row * 4 + 3] = e3 * inv;
            atomicAdd(&counts[te[0]], 1u); atomicAdd(&counts[te[1]], 1u); atomicAdd(&counts[te[2]], 1u); atomicAdd(&counts[te[3]], 1u);
        }
    }
}

__device__ __forceinline__ void build_tile_table(const Args& a, LAS int* tstart, int tid) {
    if (tid == 0) {
        const unsigned* counts = (const unsigned*)(a.ws + WS_CTL) + CW_COUNTS;
        int acc = 0;
        for (int e = 0; e < NEXP; ++e) { tstart[e] = acc; acc += (int)((__hip_atomic_load(counts + e, __ATOMIC_RELAXED, __HIP_MEMORY_SCOPE_AGENT) + 255u) >> 8); }
        tstart[NEXP] = acc;
    }
    __syncthreads();
}
__device__ __forceinline__ int tile_expert(const LAS int* tstart, int tile) {
    int e = 0;
#pragma unroll 1
    for (int i = 1; i < NEXP; ++i) e += (tstart[i] <= tile) ? 1 : 0;
    return e;
}

__device__ __forceinline__ void phase_assign(const Args& a, LAS unsigned char* lds, int tid, int lane, int wave) {
    LAS int* tstart = (LAS int*)(lds + LDS_TAB);
    LAS int* hist = tstart + 64; LAS int* base = hist + 32; LAS int* spos = base + 32;
    build_tile_table(a, tstart, tid);
    const int* tope = (const int*)(a.ws + WS_TOPE); const float* topw = (const float*)(a.ws + WS_TOPW); const float* rstd2 = (const float*)(a.ws + WS_RSTD2);
    int* rowpair = (int*)(a.ws + WS_ROWPAIR); float* roww = (float*)(a.ws + WS_ROWW);
    unsigned* cursor = (unsigned*)(a.ws + WS_CTL) + CW_CURSOR;
    const float* H1 = (const float*)(a.ws + WS_H1); bf16* XS = (bf16*)(a.ws + WS_XS);
    for (int blk = blockIdx.x; blk < MREAL / 64; blk += gridDim.x) {
        if (tid < 32) hist[tid] = 0;
        __syncthreads();
        int e = 0, rank = 0, pair = 0;
        if (tid < 256) { pair = blk * 256 + tid; e = tope[pair]; rank = atomicAdd((int*)&hist[e], 1); }
        __syncthreads();
        if (tid < 32) base[tid] = (int)atomicAdd(&cursor[tid], (unsigned)hist[tid]);
        __syncthreads();
        if (tid < 256) { const int pos = tstart[e] * 256 + base[e] + rank; spos[tid] = pos; rowpair[pos] = pair; roww[pos] = topw[pair]; }
        __syncthreads();
        for (int tt = wave * 8; tt < wave * 8 + 8; ++tt) {
            const int token = blk * 64 + tt; const float rstd = rstd2[token];
            const f32x4* hr = (const f32x4*)(H1 + (size_t)token * D);
            u32x2 o[8];
#pragma unroll
            for (int j = 0; j < 8; ++j) { const f32x4 v = hr[lane + 64 * j]; const f32x4 g = ((const f32x4*)a.in[I_NORM_FFN])[lane + 64 * j];
                o[j] = (u32x2){pk2(v.x * rstd * g.x, v.y * rstd * g.y), pk2(v.z * rstd * g.z, v.w * rstd * g.w)}; }
#pragma unroll
            for (int k = 0; k < 4; ++k) { u32x2* dst = (u32x2*)(XS + (size_t)spos[tt * 4 + k] * D);
#pragma unroll
                for (int j = 0; j < 8; ++j) dst[lane + 64 * j] = o[j]; }
        }
        __syncthreads();
    }
}

__device__ __forceinline__ void phase_final(const Args& a, int lane, int wave) {
    const int gw = blockIdx.x * 8 + wave, NGW = gridDim.x * 8;
    const float* H1 = (const float*)(a.ws + WS_H1); const bf16* YB = (const bf16*)(a.ws + WS_YB);
    for (int row = gw; row < MREAL; row += NGW) {
        f32x4 v[8]; float ss = 0.f;
#pragma unroll
        for (int j = 0; j < 8; ++j) { v[j] = ((const f32x4*)(H1 + (size_t)row * D))[lane + 64 * j];
#pragma unroll
            for (int k = 0; k < 4; ++k) { const u32x2 y = ((const u32x2*)(YB + ((size_t)row * 4 + k) * D))[lane + 64 * j];
                v[j].x += bf2f(y.x); v[j].y += bf2f(y.x >> 16); v[j].z += bf2f(y.y); v[j].w += bf2f(y.y >> 16); }
            ss += (v[j].x * v[j].x + v[j].y * v[j].y) + (v[j].z * v[j].z + v[j].w * v[j].w); }
        ss = wave_sum(ss);
        const float rstd = 1.0f / sqrtf(ss * (1.0f / D) + EPS);
        f32x4* op = (f32x4*)(a.out + (size_t)row * D);
#pragma unroll
        for (int j = 0; j < 8; ++j) { const f32x4 g = ((const f32x4*)a.in[I_FINAL_NORM])[lane + 64 * j]; op[lane + 64 * j] = v[j] * rstd * g; }
    }
}

enum { PH_PROLOGUE = 0, PH_G1, PH_ATTN, PH_LRU_GATES, PH_LRU_SCAN, PH_NORM_O, PH_G2, PH_ROUTER, PH_ASSIGN, PH_G3, PH_G4, PH_FINAL, PH_COUNT };

__global__ void __launch_bounds__(512, 2) fwd(Args a) {
    extern __shared__ __attribute__((aligned(16))) unsigned char lds_raw[];
    LAS unsigned char* lds = (LAS unsigned char*)lds_raw;
    const int tid = threadIdx.x, lane = tid & 63, wave = __builtin_amdgcn_readfirstlane(tid >> 6);
    const int gw = blockIdx.x * 8 + wave, NGW = gridDim.x * 8;
    unsigned char* ws = a.ws;
#define IN(k) (a.ph_lo <= (k) && (k) < a.ph_hi)

    if (IN(PH_PROLOGUE)) phase_prologue(a, lds, tid, lane, wave);

    if (IN(PH_G1)) {
        const bf16* WINT = (const bf16*)(ws + WS_WINT); bf16* Z = (bf16*)(ws + WS_Z); const float* bin = a.in[I_B_IN];
        naive_gemm<false>((const bf16*)(ws + WS_N1), MROWS / 64, DIN / 64, D,
            [&](int, const bf16*& b0, const bf16*& b1) { b0 = WINT; b1 = WINT; },
            [&](int, int row, int col, float v, float) { Z[(size_t)row * DIN + col] = (bf16)f2bf(v + bin[col]); }, gw, NGW, lane);
    }
    if (IN(PH_ATTN)) { phase_attn_naive(a, lane, wave); phase_lru_xc(a, tid); }
    if (IN(PH_LRU_GATES)) phase_lru_gates(a, tid);
    if (IN(PH_LRU_SCAN)) phase_lru_scan(a, tid);
    if (IN(PH_NORM_O)) phase_norm_o(a, lane, wave);
    if (IN(PH_G2)) {
        const bf16* WOUTT = (const bf16*)(ws + WS_WOUTT); float* H1 = (float*)(ws + WS_H1); const float* bo = a.in[I_B_OUT]; const float* x = a.in[I_X];
        naive_gemm<false>((const bf16*)(ws + WS_O), MREAL / 64, D / 64, D,
            [&](int, const bf16*& b0, const bf16*& b1) { b0 = WOUTT; b1 = WOUTT; },
            [&](int, int row, int col, float v, float) { H1[(size_t)row * D + col] = x[(size_t)row * D + col] + v + bo[col]; }, gw, NGW, lane);
    }
    if (IN(PH_ROUTER)) phase_router(a, lane, wave);
    if (IN(PH_ASSIGN)) phase_assign(a, lds, tid, lane, wave);
    if (IN(PH_G3)) {
        LAS int* tstart = (LAS int*)(lds + LDS_TAB);
        build_tile_table(a, tstart, tid);
        const int ntile = tstart[NEXP];
        const bf16* WGT = (const bf16*)(ws + WS_WGT); const bf16* WUT = (const bf16*)(ws + WS_WUT); bf16* ACT = (bf16*)(ws + WS_ACT);
        const float* bg = a.in[I_B_GATE]; const float* bu = a.in[I_B_UP];
        naive_gemm<true>((const bf16*)(ws + WS_XS), ntile * 4, DFF / 64, D,
            [&](int tm, const bf16*& b0, const bf16*& b1) { const int e = tile_expert(tstart, tm >> 2); b0 = WGT + (size_t)e * D * D; b1 = WUT + (size_t)e * D * D; },
            [&](int tm, int row, int col, float g, float u) { const int e = tile_expert(tstart, tm >> 2);
                g += bg[e * DFF + col]; u += bu[e * DFF + col];
                g = fminf(g, 7.0f); u = fminf(fmaxf(u, -7.0f), 7.0f);
                ACT[(size_t)row * DFF + col] = (bf16)f2bf(g * sigmoidf_(1.702f * g) * (u + 1.0f)); }, gw, NGW, lane);
    }
    if (IN(PH_G4)) {
        LAS int* tstart = (LAS int*)(lds + LDS_TAB);
        build_tile_table(a, tstart, tid);
        const int ntile = tstart[NEXP];
        const bf16* WDT = (const bf16*)(ws + WS_WDT); bf16* YB = (bf16*)(ws + WS_YB);
        const float* bd = a.in[I_B_DOWN]; const int* rowpair = (const int*)(ws + WS_ROWPAIR); const float* roww = (const float*)(ws + WS_ROWW);
        naive_gemm<false>((const bf16*)(ws + WS_ACT), ntile * 4, D / 64, DFF,
            [&](int tm, const bf16*& b0, const bf16*& b1) { const int e = tile_expert(tstart, tm >> 2); b0 = WDT + (size_t)e * D * D; b1 = b0; },
            [&](int tm, int row, int col, float v, float) { const int e = tile_expert(tstart, tm >> 2); const int pair = rowpair[row];
                if (pair >= 0) YB[(size_t)pair * D + col] = (bf16)f2bf((v + bd[e * D + col]) * roww[row]); }, gw, NGW, lane);
    }
    if (IN(PH_FINAL)) phase_final(a, lane, wave);
#undef IN
}

extern "C" void kernel_launch(void* const* d_in, const int* in_sizes, int n_in, void* d_out, int out_size, void* d_ws, size_t ws_size, hipStream_t stream) {
    static int grid = 0;
    if (grid == 0) {
        if (n_in != 27 || out_size != MREAL * D || ws_size < WS_END) { fprintf(stderr, "kernel_launch: unexpected problem (n_in %d, out %d, ws %zu)\n", n_in, out_size, ws_size); grid = -1; return; }
        int dev = 0, cus = 0;
        if (hipGetDevice(&dev) != hipSuccess || hipDeviceGetAttribute(&cus, hipDeviceAttributeMultiprocessorCount, dev) != hipSuccess) { grid = -1; return; }
        if (hipFuncSetAttribute((const void*)fwd, hipFuncAttributeMaxDynamicSharedMemorySize, LDS_BYTES) != hipSuccess) { fprintf(stderr, "kernel_launch: hipFuncSetAttribute failed\n"); grid = -1; return; }
        grid = cus;
    }
    if (grid < 0) return;
    (void)hipMemsetAsync((char*)d_ws + WS_CTL, 0, CTL_BYTES, stream);
    Args a{};
    for (int i = 0; i < 27; ++i) a.in[i] = (const float*)d_in[i];
    a.out = (float*)d_out; a.ws = (unsigned char*)d_ws;
    for (int ph = 0; ph < PH_COUNT; ++ph) {
        a.ph_lo = ph; a.ph_hi = ph + 1;
        hipLaunchKernelGGL(fwd, dim3(grid), dim3(512), LDS_BYTES, stream, a);
    }
}
```

```cpp
#include <hip/hip_runtime.h>
#include <cstdio>
#include <cstdint>

#define LAS __attribute__((address_space(3)))
#ifndef MK_ONE_LAUNCH
#define MK_ONE_LAUNCH 1
#endif
typedef unsigned short bf16;
typedef float f32x4 __attribute__((ext_vector_type(4)));
typedef short bf16x8 __attribute__((ext_vector_type(8)));
typedef unsigned u32x4 __attribute__((ext_vector_type(4)));
typedef unsigned u32x2 __attribute__((ext_vector_type(2)));

constexpr int D = 2048, SEQ = 2048, NMETA = 16, TT = 2064, NBATCH = 8;
constexpr int MREAL = 16384, METAROW0 = 16384, MVALID = 16400, MROWS = 16640;
constexpr int DIN = 3584, DLRU = 1024, HD = 64;
constexpr int ZQ = 0, ZK = 1024, ZV = 1280, ZX = 1536, ZG = 2560;
constexpr int NEXP = 32, DFF = 2048, PROWS = 73728;
constexpr float EPS = 1e-5f;

constexpr size_t MiB = 1u << 20;
constexpr size_t WS_CTL = 0, CTL_BYTES = 1 * MiB;
constexpr size_t WS_COS = 1 * MiB, WS_SIN = 1 * MiB + 320 * 1024;
constexpr size_t WS_TOPE = 2 * MiB, WS_TOPW = WS_TOPE + 256 * 1024, WS_RSTD2 = WS_TOPW + 256 * 1024, WS_ROWPAIR = WS_RSTD2 + 64 * 1024, WS_ROWW = WS_ROWPAIR + 320 * 1024;
constexpr size_t WS_LRUSUM = 4 * MiB;
constexpr size_t WS_WINT = 10 * MiB, WS_WOUTT = 24 * MiB, WS_WGT = 32 * MiB, WS_WUT = 288 * MiB, WS_WDT = 544 * MiB;
constexpr size_t WS_N1 = 800 * MiB, WS_Z = 866 * MiB, WS_O = 980 * MiB, WS_H1 = 1044 * MiB, WS_XS = 1172 * MiB, WS_YB = WS_XS, WS_ACT = 1460 * MiB, WS_END = 1748 * MiB;
constexpr size_t WS_XC = WS_XS, WS_AA = WS_XS + 66 * MiB, WS_BB = WS_XS + 132 * MiB, WS_YL = WS_XS + 198 * MiB;
static_assert(WS_ROWW + PROWS * 4 <= WS_LRUSUM, "small map");
constexpr int CW_COUNTS = 1024, CW_CURSOR = 1088, CW_BAR = 4096;

constexpr int LDS_TAB = 131072;
constexpr int LDS_MISC = LDS_TAB + 8192;
constexpr int LDS_BYTES = 147456;

__device__ const float c_inv_freq[32] = {1.000000000e+00f, 7.498942018e-01f, 5.623413324e-01f, 4.216965139e-01f, 3.162277639e-01f, 2.371373922e-01f, 1.778279394e-01f, 1.333521456e-01f, 1.000000015e-01f, 7.498941571e-02f, 5.623412877e-02f, 4.216964915e-02f, 3.162277862e-02f, 2.371373586e-02f, 1.778279431e-02f, 1.333521493e-02f, 9.999999776e-03f, 7.498942316e-03f, 5.623413250e-03f, 4.216964822e-03f, 3.162277862e-03f, 2.371373819e-03f, 1.778279431e-03f, 1.333521446e-03f, 1.000000047e-03f, 7.498941850e-04f, 5.623413017e-04f, 4.216965463e-04f, 3.162277862e-04f, 2.371373848e-04f, 1.778279402e-04f, 1.333521504e-04f};

struct Args { const float* in[27]; float* out; unsigned char* ws; int ph_lo, ph_hi; };
enum { I_X = 0, I_META, I_NORM_MIX, I_W_IN, I_B_IN, I_SINKS, I_CONV_W, I_CONV_B, I_W_A, I_B_A, I_W_I, I_B_I, I_LAMBDA, I_G_ATTN, I_G_LRU, I_W_OUT, I_B_OUT, I_NORM_FFN,
       I_W_ROUTER, I_B_ROUTER, I_W_GATE, I_B_GATE, I_W_UP, I_B_UP, I_W_DOWN, I_B_DOWN, I_FINAL_NORM };


#define XB_TMO      128
#define XB_XCNT(j)  (256  + 64 * (j))
#define XB_XSUB(j)  (1280 + 64 * (j))
#define XB_XGEN(j)  (2304 + 64 * (j))
#define XB_TOP      3328
#define XB_TOPGEN   3392
#define XCD_BAR_WORDS 3456
#define XB_SPIN_CAP (1u << 18)

__device__ __forceinline__ unsigned xb_ld(unsigned* p)              { return __hip_atomic_load(p, __ATOMIC_RELAXED, __HIP_MEMORY_SCOPE_AGENT); }
__device__ __forceinline__ unsigned xb_add(unsigned* p, unsigned v) { return __hip_atomic_fetch_add(p, v, __ATOMIC_RELAXED, __HIP_MEMORY_SCOPE_AGENT); }
__device__ __forceinline__ unsigned xb_xcc_id() { return (unsigned)__builtin_amdgcn_s_getreg((3 << 11) | 20) & 0xFu; }
#define XB_SPIN(cond, bar) do { unsigned _sp = 0; while (cond) { __builtin_amdgcn_s_sleep(1); \
    if ((++_sp & 255u) == 0u) { if (xb_ld(&(bar)[XB_TMO])) break; if (_sp > XB_SPIN_CAP) { atomicAdd(&(bar)[XB_TMO], 1u); break; } } } } while (0)

struct XcdBarrier {
    unsigned* bar; unsigned x;
    volatile LAS unsigned* st;
};

__device__ __forceinline__ XcdBarrier xcd_barrier_post(unsigned* bar, volatile LAS unsigned* st) {
    XcdBarrier b; b.bar = bar; b.x = xb_xcc_id(); b.st = st;
    if (threadIdx.x == 0) (void)xb_add(&bar[XB_XCNT(b.x)], 1u);
    return b;
}
__device__ __forceinline__ void xcd_barrier_complete(unsigned* bar, unsigned x, unsigned& nloc, unsigned& nx) {
    const unsigned G = gridDim.x * gridDim.y * gridDim.z;
    unsigned sum, cnt, mine, sp = 0u;
    for (;;) {
        sum = 0u; cnt = 0u; mine = 0u;
#pragma unroll
        for (unsigned j = 0; j < 16; ++j) { const unsigned c = xb_ld(&bar[XB_XCNT(j)]); sum += c; cnt += (c > 0u) ? 1u : 0u; mine = (j == x) ? c : mine; }
        if (sum == G) break;
        __builtin_amdgcn_s_sleep(1);
        if ((++sp & 255u) == 0u) { if (xb_ld(&bar[XB_TMO])) break; if (sp > XB_SPIN_CAP) { atomicAdd(&bar[XB_TMO], 1u); break; } }
    }
    nloc = mine > 0u ? mine : 1u; nx = cnt > 0u ? cnt : 1u;
}

__device__ __forceinline__ void xcd_barrier(const XcdBarrier& b) {
    asm volatile("s_waitcnt vmcnt(0)" ::: "memory");
    __syncthreads();
    if (threadIdx.x == 0) {
        unsigned* bar = b.bar;
        __builtin_amdgcn_s_waitcnt(0);
        unsigned nloc = b.st[0], nx = b.st[1];
        if (nloc == 0u) { xcd_barrier_complete(bar, b.x, nloc, nx); b.st[0] = nloc; b.st[1] = nx; }
        const unsigned old = xb_add(&bar[XB_XSUB(b.x)], 1u);
        const unsigned gen = old / nloc;
        if (old + 1u == (gen + 1u) * nloc) {
            __builtin_amdgcn_fence(__ATOMIC_RELEASE, "agent");
            asm volatile("s_waitcnt vmcnt(0)" ::: "memory");
            const unsigned og = xb_add(&bar[XB_TOP], 1u);
            const unsigned tg = og / nx;
            if (og + 1u == (tg + 1u) * nx) xb_add(&bar[XB_TOPGEN], 1u);
            else XB_SPIN(xb_ld(&bar[XB_TOPGEN]) == tg, bar);
            __builtin_amdgcn_fence(__ATOMIC_ACQUIRE, "agent");
            xb_add(&bar[XB_XGEN(b.x)], 1u);
            asm volatile("s_waitcnt vmcnt(0)" ::: "memory");
        } else {
            XB_SPIN(xb_ld(&bar[XB_XGEN(b.x)]) == gen, bar);
            __builtin_amdgcn_fence(__ATOMIC_ACQUIRE, "agent");
            asm volatile("s_waitcnt vmcnt(0)" ::: "memory");
        }
    }
    __syncthreads();
}

__device__ __forceinline__ float bf2f(unsigned b) { return __uint_as_float((b & 0xffffu) << 16); }
__device__ __forceinline__ unsigned f2bf(float f) { unsigned u = __float_as_uint(f); return (u + 0x7fffu + ((u >> 16) & 1u)) >> 16; }
__device__ __forceinline__ unsigned pk2(float lo, float hi) { return f2bf(lo) | (f2bf(hi) << 16); }
__device__ __forceinline__ float wave_sum(float v) {
#pragma unroll
    for (int o = 1; o < 64; o <<= 1) v += __shfl_xor(v, o);
    return v;
}
__device__ __forceinline__ float wave_max(float v) {
#pragma unroll
    for (int o = 1; o < 64; o <<= 1) v = fmaxf(v, __shfl_xor(v, o));
    return v;
}
__device__ __forceinline__ float sigmoidf_(float x) { return 1.0f / (1.0f + __expf(-x)); }
__device__ __forceinline__ float gelu_tanh(float x) { const float u = 0.7978845608028654f * (x + 0.044715f * x * x * x); return 0.5f * x * (1.0f + tanhf(u)); }
__device__ __forceinline__ int tok_row(int b, int t) { return t < NMETA ? METAROW0 + t : b * SEQ + (t - NMETA); }

__device__ __forceinline__ void transpose_item(const float* W, int K, int N, bf16* WT, LAS float* scr, int item, int lane) {
    const int nblk = N / 32, kb = item / nblk, nb = item % nblk, k0 = 64 * kb, n0 = 32 * nb;
#pragma unroll 8
    for (int i = 0; i < 32; ++i) { const int kk = 2 * i + (lane >> 5); scr[kk * 33 + (lane & 31)] = W[(size_t)(k0 + kk) * N + n0 + (lane & 31)]; }
    asm volatile("s_waitcnt lgkmcnt(0)" ::: "memory");
    const int c = lane & 7;
#pragma unroll
    for (int j = 0; j < 4; ++j) { const int n = (lane >> 3) + 8 * j; const LAS float* s = scr + (8 * c) * 33 + n;
        u32x4 o; o.x = pk2(s[0 * 33], s[1 * 33]); o.y = pk2(s[2 * 33], s[3 * 33]); o.z = pk2(s[4 * 33], s[5 * 33]); o.w = pk2(s[6 * 33], s[7 * 33]);
        *(u32x4*)(WT + (size_t)(n0 + n) * K + k0 + 8 * c) = o; }
    asm volatile("s_waitcnt lgkmcnt(0)" ::: "memory");
}

__device__ __forceinline__ void phase_prologue(const Args& a, LAS unsigned char* lds, int tid, int lane, int wave) {
    const int gw = blockIdx.x * 8 + wave, NGW = gridDim.x * 8;
    const int gt = blockIdx.x * 512 + tid, NGT = gridDim.x * 512;
    unsigned char* ws = a.ws;
    LAS float* scr = (LAS float*)(lds + wave * 8704);
    constexpr int IT_IN = 32 * (DIN / 32), IT_OUT = 32 * (D / 32), IT_E = 32 * (D / 32);
    constexpr int NITEMS = IT_IN + IT_OUT + 96 * IT_E;
    for (int it = gw; it < NITEMS; it += NGW) {
        int r = it;
        if (r < IT_IN) { transpose_item(a.in[I_W_IN], D, DIN, (bf16*)(ws + WS_WINT), scr, r, lane); continue; } r -= IT_IN;
        if (r < IT_OUT) { transpose_item(a.in[I_W_OUT], D, D, (bf16*)(ws + WS_WOUTT), scr, r, lane); continue; } r -= IT_OUT;
        const int mat = r / IT_E, item = r % IT_E, which = mat / NEXP, e = mat % NEXP;
        const float* src = a.in[which == 0 ? I_W_GATE : (which == 1 ? I_W_UP : I_W_DOWN)] + (size_t)e * D * D;
        bf16* dst = (bf16*)(ws + (which == 0 ? WS_WGT : (which == 1 ? WS_WUT : WS_WDT))) + (size_t)e * D * D;
        transpose_item(src, D, D, dst, scr, item, lane);
    }
    bf16* N1 = (bf16*)(ws + WS_N1);
    for (int r = gw; r < MROWS; r += NGW) {
        u32x2* orow = (u32x2*)(N1 + (size_t)r * D);
        if (r >= MVALID) {
#pragma unroll
            for (int j = 0; j < 8; ++j) orow[lane + 64 * j] = (u32x2){0u, 0u};
            continue; }
        const f32x4* xr = (const f32x4*)(r < MREAL ? a.in[I_X] + (size_t)r * D : a.in[I_META] + (size_t)(r - MREAL) * D);
        f32x4 v[8]; float ss = 0.f;
#pragma unroll
        for (int j = 0; j < 8; ++j) { v[j] = xr[lane + 64 * j]; ss += (v[j].x * v[j].x + v[j].y * v[j].y) + (v[j].z * v[j].z + v[j].w * v[j].w); }
        ss = wave_sum(ss);
        const float rstd = 1.0f / sqrtf(ss * (1.0f / D) + EPS);
#pragma unroll
        for (int j = 0; j < 8; ++j) { const f32x4 g = ((const f32x4*)a.in[I_NORM_MIX])[lane + 64 * j];
            orow[lane + 64 * j] = (u32x2){pk2(v[j].x * rstd * g.x, v[j].y * rstd * g.y), pk2(v[j].z * rstd * g.z, v[j].w * rstd * g.w)}; }
    }
    float* cosT = (float*)(ws + WS_COS); float* sinT = (float*)(ws + WS_SIN);
    for (int i = gt; i < TT * 32; i += NGT) {
        const int pos = i >> 5, j = i & 31;
        const float ang = (float)pos * c_inv_freq[j];
        const double t = (double)ang * 0.15915494309189535; const float fr = (float)(t - floor(t));
        cosT[i] = __builtin_amdgcn_cosf(fr); sinT[i] = __builtin_amdgcn_sinf(fr);
    }
    int* rowpair = (int*)(ws + WS_ROWPAIR);
    for (int i = gt; i < PROWS; i += NGT) rowpair[i] = -1;
}

template <bool DUAL, class BSel, class Epi>
__device__ __forceinline__ void naive_gemm(const bf16* A, int mt_count, int nt_count, int K, const BSel& bsel, const Epi& epi, int gw, int NGW, int lane) {
    const int fr = lane & 15, fq = lane >> 4;
    for (int tile = gw; tile < mt_count * nt_count; tile += NGW) {
        const int tm = tile / nt_count, tn = tile % nt_count;
        const bf16 *B0, *B1; bsel(tm, B0, B1);
        f32x4 acc[4][4], acc2[4][4];
#pragma unroll
        for (int i = 0; i < 4; ++i)
#pragma unroll
            for (int j = 0; j < 4; ++j) { acc[i][j] = (f32x4){0.f, 0.f, 0.f, 0.f}; acc2[i][j] = (f32x4){0.f, 0.f, 0.f, 0.f}; }
        const bf16* ap = A + (size_t)(tm * 64 + fr) * K + fq * 8;
        const bf16* bp0 = B0 + (size_t)(tn * 64 + fr) * K + fq * 8;
        const bf16* bp1 = B1 + (size_t)(tn * 64 + fr) * K + fq * 8;
        for (int k0 = 0; k0 < K; k0 += 32) {
            bf16x8 af[4], bfr[4];
#pragma unroll
            for (int i = 0; i < 4; ++i) af[i] = *(const bf16x8*)(ap + (size_t)i * 16 * K + k0);
#pragma unroll
            for (int j = 0; j < 4; ++j) bfr[j] = *(const bf16x8*)(bp0 + (size_t)j * 16 * K + k0);
#pragma unroll
            for (int i = 0; i < 4; ++i)
#pragma unroll
                for (int j = 0; j < 4; ++j) acc[i][j] = __builtin_amdgcn_mfma_f32_16x16x32_bf16(af[i], bfr[j], acc[i][j], 0, 0, 0);
            if (DUAL) {
#pragma unroll
                for (int j = 0; j < 4; ++j) bfr[j] = *(const bf16x8*)(bp1 + (size_t)j * 16 * K + k0);
#pragma unroll
                for (int i = 0; i < 4; ++i)
#pragma unroll
                    for (int j = 0; j < 4; ++j) acc2[i][j] = __builtin_amdgcn_mfma_f32_16x16x32_bf16(af[i], bfr[j], acc2[i][j], 0, 0, 0);
            }
        }
#pragma unroll
        for (int i = 0; i < 4; ++i)
#pragma unroll
            for (int j = 0; j < 4; ++j)
#pragma unroll
                for (int r = 0; r < 4; ++r) epi(tm, tm * 64 + i * 16 + fq * 4 + r, tn * 64 + j * 16 + fr, acc[i][j][r], acc2[i][j][r]);
    }
}

__device__ __forceinline__ void phase_attn_naive(const Args& a, int lane, int wave) {
    const int gw = blockIdx.x * 8 + wave, NGW = gridDim.x * 8;
    const bf16* Z = (const bf16*)(a.ws + WS_Z); bf16* O = (bf16*)(a.ws + WS_O);
    const float* cosT = (const float*)(a.ws + WS_COS); const float* sinT = (const float*)(a.ws + WS_SIN);
    const int j = lane & 31;
    for (int it = gw; it < MREAL * 16; it += NGW) {
        const int head = it & 15, row = it >> 4, b = row >> 11, s = row & 2047, t = NMETA + s, kvh = head >> 2;
        const float qv = bf2f(Z[(size_t)row * DIN + ZQ + head * 64 + lane]);
        const float qo = __shfl_xor(qv, 32);
        float c = cosT[t * 32 + j], sn = sinT[t * 32 + j];
        const float q = 0.125f * (lane < 32 ? qv * c - qo * sn : qv * c + qo * sn);
        float m = a.in[I_SINKS][head], l = 1.f, o = 0.f;
        const int nk = NMETA + (s + 1 < 128 ? s + 1 : 128);
        for (int kk = 0; kk < nk; ++kk) {
            int krow, kpos;
            if (kk < NMETA) { krow = METAROW0 + kk; kpos = kk; } else { const int sp = s - (kk - NMETA); krow = b * SEQ + sp; kpos = NMETA + sp; }
            const float kv = bf2f(Z[(size_t)krow * DIN + ZK + kvh * 64 + lane]);
            const float ko = __shfl_xor(kv, 32);
            c = cosT[kpos * 32 + j]; sn = sinT[kpos * 32 + j];
            const float kr = lane < 32 ? kv * c - ko * sn : kv * c + ko * sn;
            const float sc = wave_sum(q * kr);
            const float mn = fmaxf(m, sc), al = __expf(m - mn), p = __expf(sc - mn);
            const float vv = bf2f(Z[(size_t)krow * DIN + ZV + kvh * 64 + lane]);
            l = l * al + p; o = o * al + p * vv; m = mn;
        }
        O[(size_t)row * D + head * 64 + lane] = (bf16)f2bf(o / l);
    }
}

__device__ __forceinline__ void phase_lru_xc(const Args& a, int tid) {
    const int gt = blockIdx.x * 512 + tid, NGT = gridDim.x * 512;
    const bf16* Z = (const bf16*)(a.ws + WS_Z); float* XC = (float*)(a.ws + WS_XC);
    for (int idx = gt; idx < MVALID * DLRU; idx += NGT) {
        const int row = idx >> 10, c = idx & 1023;
        const int b = row < MREAL ? (row >> 11) : 0, t = row < MREAL ? NMETA + (row & 2047) : row - MREAL;
        float acc = a.in[I_CONV_B][c];
#pragma unroll
        for (int jj = 0; jj < 4; ++jj) { const int tt = t - 3 + jj;
            if (tt >= 0) acc += a.in[I_CONV_W][jj * DLRU + c] * bf2f(Z[(size_t)tok_row(b, tt) * DIN + ZX + c]); }
        XC[idx] = acc;
    }
}
__device__ __forceinline__ void phase_lru_gates(const Args& a, int tid) {
    const int gt = blockIdx.x * 512 + tid, NGT = gridDim.x * 512;
    const float* XC = (const float*)(a.ws + WS_XC); float* AA = (float*)(a.ws + WS_AA); float* BB = (float*)(a.ws + WS_BB);
    for (int idx = gt; idx < MVALID * DLRU; idx += NGT) {
        const int row = idx >> 10, c = idx & 1023, n = c >> 6, d = c & 63;
        float ra = a.in[I_B_A][c], ri = a.in[I_B_I][c];
        const float* xr = XC + (size_t)row * DLRU + n * 64;
        const float* wa = a.in[I_W_A] + (size_t)n * 4096 + d; const float* wi = a.in[I_W_I] + (size_t)n * 4096 + d;
        for (int cc = 0; cc < 64; ++cc) { const float xv = xr[cc]; ra += xv * wa[cc * 64]; ri += xv * wi[cc * 64]; }
        const float r = sigmoidf_(ra), ig = sigmoidf_(ri);
        const float sp = log1pf(expf(-a.in[I_LAMBDA][c]));
        const float log_a = -8.0f * r * sp;
        AA[idx] = expf(log_a);
        BB[idx] = sqrtf(-expm1f(2.0f * log_a)) * ig * XC[idx];
    }
}
__device__ __forceinline__ void phase_lru_scan(const Args& a, int tid) {
    const int gt = blockIdx.x * 512 + tid;
    if (gt >= NBATCH * DLRU) return;
    const int b = gt >> 10, c = gt & 1023;
    const float* AA = (const float*)(a.ws + WS_AA); const float* BB = (const float*)(a.ws + WS_BB); float* YL = (float*)(a.ws + WS_YL);
    const bf16* Z = (const bf16*)(a.ws + WS_Z);
    float h = 0.f;
    for (int t = 0; t < NMETA; ++t) { const int row = METAROW0 + t; h = AA[(size_t)row * DLRU + c] * h + BB[(size_t)row * DLRU + c]; }
#pragma unroll 8
    for (int s = 0; s < SEQ; ++s) { const size_t row = (size_t)b * SEQ + s;
        h = AA[row * DLRU + c] * h + BB[row * DLRU + c];
        YL[row * DLRU + c] = h * gelu_tanh(bf2f(Z[row * DIN + ZG + c])); }
}
__device__ __forceinline__ void phase_norm_o(const Args& a, int lane, int wave) {
    const int gw = blockIdx.x * 8 + wave, NGW = gridDim.x * 8;
    bf16* O = (bf16*)(a.ws + WS_O); const float* YL = (const float*)(a.ws + WS_YL);
    for (int row = gw; row < MREAL; row += NGW) {
        u32x4* op = (u32x4*)(O + (size_t)row * D);
        u32x4 w[2]; float v[16]; float ss = 0.f;
#pragma unroll
        for (int j = 0; j < 2; ++j) { w[j] = op[lane + 64 * j];
#pragma unroll
            for (int q = 0; q < 4; ++q) { v[j * 8 + 2 * q] = bf2f(w[j][q]); v[j * 8 + 2 * q + 1] = bf2f(w[j][q] >> 16); } }
#pragma unroll
        for (int i = 0; i < 16; ++i) ss += v[i] * v[i];
        ss = wave_sum(ss);
        float rstd = 1.0f / sqrtf(ss * (1.0f / 1024.0f) + EPS);
#pragma unroll
        for (int j = 0; j < 2; ++j) { const float* g = a.in[I_G_ATTN] + (lane + 64 * j) * 8; u32x4 o;
#pragma unroll
            for (int q = 0; q < 4; ++q) o[q] = pk2(v[j * 8 + 2 * q] * rstd * g[2 * q], v[j * 8 + 2 * q + 1] * rstd * g[2 * q + 1]);
            op[lane + 64 * j] = o; }
        const f32x4* yp = (const f32x4*)(YL + (size_t)row * DLRU);
        f32x4 y[4]; ss = 0.f;
#pragma unroll
        for (int j = 0; j < 4; ++j) { y[j] = yp[lane + 64 * j]; ss += (y[j].x * y[j].x + y[j].y * y[j].y) + (y[j].z * y[j].z + y[j].w * y[j].w); }
        ss = wave_sum(ss);
        rstd = 1.0f / sqrtf(ss * (1.0f / 1024.0f) + EPS);
        u32x2* o2 = (u32x2*)(O + (size_t)row * D + 1024);
#pragma unroll
        for (int j = 0; j < 4; ++j) { const f32x4 g = ((const f32x4*)a.in[I_G_LRU])[lane + 64 * j];
            o2[lane + 64 * j] = (u32x2){pk2(y[j].x * rstd * g.x, y[j].y * rstd * g.y), pk2(y[j].z * rstd * g.z, y[j].w * rstd * g.w)}; }
    }
}

__device__ __forceinline__ void phase_router(const Args& a, int lane, int wave) {
    const int gw = blockIdx.x * 8 + wave, NGW = gridDim.x * 8;
    const float* H1 = (const float*)(a.ws + WS_H1);
    int* tope = (int*)(a.ws + WS_TOPE); float* topw = (float*)(a.ws + WS_TOPW); float* rstd2 = (float*)(a.ws + WS_RSTD2);
    unsigned* counts = (unsigned*)(a.ws + WS_CTL) + CW_COUNTS;
    const float* wr = a.in[I_W_ROUTER]; const float* nf = a.in[I_NORM_FFN];
    for (int row = gw; row < MREAL; row += NGW) {
        const float* hr = H1 + (size_t)row * D;
        float ss = 0.f;
#pragma unroll
        for (int j = 0; j < 8; ++j) { const f32x4 v = ((const f32x4*)hr)[lane + 64 * j]; ss += (v.x * v.x + v.y * v.y) + (v.z * v.z + v.w * v.w); }
        ss = wave_sum(ss);
        const float rstd = 1.0f / sqrtf(ss * (1.0f / D) + EPS);
        const int e = lane & 31, kh = lane >> 5;
        float acc = 0.f;
        for (int k = kh * 1024; k < kh * 1024 + 1024; ++k) acc += (hr[k] * rstd * nf[k]) * wr[k * NEXP + e];
        acc += __shfl_xor(acc, 32);
        float val = lane < 32 ? acc + a.in[I_B_ROUTER][e] : -3.0e38f;
        float tv[4]; int te[4];
#pragma unroll
        for (int r = 0; r < 4; ++r) {
            const float mx = wave_max(val);
            const unsigned long long msk = __ballot(val == mx);
            const int win = __ffsll((long long)msk) - 1;
            tv[r] = mx; te[r] = win;
            if (lane == win) val = -3.0e38f;
        }
        const float e1 = __expf(tv[1] - tv[0]), e2 = __expf(tv[2] - tv[0]), e3 = __expf(tv[3] - tv[0]);
        const float inv = 1.0f / (1.0f + e1 + e2 + e3);
        if (lane == 0) {
            rstd2[row] = rstd;
            tope[row * 4 + 0] = te[0]; tope[row * 4 + 1] = te[1]; tope[row * 4 + 2] = te[2]; tope[row * 4 + 3] = te[3];
            topw[row * 4 + 0] = inv; topw[row * 4 + 1] = e1 * inv; topw[row * 4 + 2] = e2 * inv; topw[row * 4 + 3] = e3 * inv;
            atomicAdd(&counts[te[0]], 1u); atomicAdd(&counts[te[1]], 1u); atomicAdd(&counts[te[2]], 1u); atomicAdd(&counts[te[3]], 1u);
        }
    }
}

__device__ __forceinline__ void build_tile_table(const Args& a, LAS int* tstart, int tid) {
    if (tid == 0) {
        const unsigned* counts = (const unsigned*)(a.ws + WS_CTL) + CW_COUNTS;
        int acc = 0;
        for (int e = 0; e < NEXP; ++e) { tstart[e] = acc; acc += (int)((__hip_atomic_load(counts + e, __ATOMIC_RELAXED, __HIP_MEMORY_SCOPE_AGENT) + 255u) >> 8); }
        tstart[NEXP] = acc;
    }
    __syncthreads();
}
__device__ __forceinline__ int tile_expert(const LAS int* tstart, int tile) {
    int e = 0;
#pragma unroll 1
    for (int i = 1; i < NEXP; ++i) e += (tstart[i] <= tile) ? 1 : 0;
    return e;
}

__device__ __forceinline__ void phase_assign(const Args& a, LAS unsigned char* lds, int tid, int lane, int wave) {
    LAS int* tstart = (LAS int*)(lds + LDS_TAB);
    LAS int* hist = tstart + 64; LAS int* base = hist + 32; LAS int* spos = base + 32;
    build_tile_table(a, tstart, tid);
    const int* tope = (const int*)(a.ws + WS_TOPE); const float* topw = (const float*)(a.ws + WS_TOPW); const float* rstd2 = (const float*)(a.ws + WS_RSTD2);
    int* rowpair = (int*)(a.ws + WS_ROWPAIR); float* roww = (float*)(a.ws + WS_ROWW);
    unsigned* cursor = (unsigned*)(a.ws + WS_CTL) + CW_CURSOR;
    const float* H1 = (const float*)(a.ws + WS_H1); bf16* XS = (bf16*)(a.ws + WS_XS);
    for (int blk = blockIdx.x; blk < MREAL / 64; blk += gridDim.x) {
        if (tid < 32) hist[tid] = 0;
        __syncthreads();
        int e = 0, rank = 0, pair = 0;
        if (tid < 256) { pair = blk * 256 + tid; e = tope[pair]; rank = atomicAdd((int*)&hist[e], 1); }
        __syncthreads();
        if (tid < 32) base[tid] = (int)atomicAdd(&cursor[tid], (unsigned)hist[tid]);
        __syncthreads();
        if (tid < 256) { const int pos = tstart[e] * 256 + base[e] + rank; spos[tid] = pos; rowpair[pos] = pair; roww[pos] = topw[pair]; }
        __syncthreads();
        for (int tt = wave * 8; tt < wave * 8 + 8; ++tt) {
            const int token = blk * 64 + tt; const float rstd = rstd2[token];
            const f32x4* hr = (const f32x4*)(H1 + (size_t)token * D);
            u32x2 o[8];
#pragma unroll
            for (int j = 0; j < 8; ++j) { const f32x4 v = hr[lane + 64 * j]; const f32x4 g = ((const f32x4*)a.in[I_NORM_FFN])[lane + 64 * j];
                o[j] = (u32x2){pk2(v.x * rstd * g.x, v.y * rstd * g.y), pk2(v.z * rstd * g.z, v.w * rstd * g.w)}; }
#pragma unroll
            for (int k = 0; k < 4; ++k) { u32x2* dst = (u32x2*)(XS + (size_t)spos[tt * 4 + k] * D);
#pragma unroll
                for (int j = 0; j < 8; ++j) dst[lane + 64 * j] = o[j]; }
        }
        __syncthreads();
    }
}

__device__ __forceinline__ void phase_final(const Args& a, int lane, int wave) {
    const int gw = blockIdx.x * 8 + wave, NGW = gridDim.x * 8;
    const float* H1 = (const float*)(a.ws + WS_H1); const bf16* YB = (const bf16*)(a.ws + WS_YB);
    for (int row = gw; row < MREAL; row += NGW) {
        f32x4 v[8]; float ss = 0.f;
#pragma unroll
        for (int j = 0; j < 8; ++j) { v[j] = ((const f32x4*)(H1 + (size_t)row * D))[lane + 64 * j];
#pragma unroll
            for (int k = 0; k < 4; ++k) { const u32x2 y = ((const u32x2*)(YB + ((size_t)row * 4 + k) * D))[lane + 64 * j];
                v[j].x += bf2f(y.x); v[j].y += bf2f(y.x >> 16); v[j].z += bf2f(y.y); v[j].w += bf2f(y.y >> 16); }
            ss += (v[j].x * v[j].x + v[j].y * v[j].y) + (v[j].z * v[j].z + v[j].w * v[j].w); }
        ss = wave_sum(ss);
        const float rstd = 1.0f / sqrtf(ss * (1.0f / D) + EPS);
        f32x4* op = (f32x4*)(a.out + (size_t)row * D);
#pragma unroll
        for (int j = 0; j < 8; ++j) { const f32x4 g = ((const f32x4*)a.in[I_FINAL_NORM])[lane + 64 * j]; op[lane + 64 * j] = v[j] * rstd * g; }
    }
}

enum { PH_PROLOGUE = 0, PH_G1, PH_ATTN, PH_LRU_GATES, PH_LRU_SCAN, PH_NORM_O, PH_G2, PH_ROUTER, PH_ASSIGN, PH_G3, PH_G4, PH_FINAL, PH_COUNT };

__global__ void __launch_bounds__(512, 2) fwd(Args a) {
    extern __shared__ __attribute__((aligned(16))) unsigned char lds_raw[];
    LAS unsigned char* lds = (LAS unsigned char*)lds_raw;
    const int tid = threadIdx.x, lane = tid & 63, wave = __builtin_amdgcn_readfirstlane(tid >> 6);
    const int gw = blockIdx.x * 8 + wave, NGW = gridDim.x * 8;
    unsigned char* ws = a.ws;
#define IN(k) (a.ph_lo <= (k) && (k) < a.ph_hi)
#define SEAM(k) do { if (IN(k) && IN((k) + 1)) xcd_barrier(bar); } while (0)
    if (tid < 4) ((LAS unsigned*)(lds + LDS_MISC))[tid] = 0u;
    __syncthreads();
    XcdBarrier bar; bar.bar = (unsigned*)(ws + WS_CTL) + CW_BAR; bar.x = 0; bar.st = nullptr;
    if (a.ph_hi - a.ph_lo > 1) bar = xcd_barrier_post((unsigned*)(ws + WS_CTL) + CW_BAR, (volatile LAS unsigned*)(lds + LDS_MISC));

    if (IN(PH_PROLOGUE)) phase_prologue(a, lds, tid, lane, wave);
    SEAM(PH_PROLOGUE);

    if (IN(PH_G1)) {
        const bf16* WINT = (const bf16*)(ws + WS_WINT); bf16* Z = (bf16*)(ws + WS_Z); const float* bin = a.in[I_B_IN];
        naive_gemm<false>((const bf16*)(ws + WS_N1), MROWS / 64, DIN / 64, D,
            [&](int, const bf16*& b0, const bf16*& b1) { b0 = WINT; b1 = WINT; },
            [&](int, int row, int col, float v, float) { Z[(size_t)row * DIN + col] = (bf16)f2bf(v + bin[col]); }, gw, NGW, lane);
    }
    SEAM(PH_G1);
    if (IN(PH_ATTN)) { phase_attn_naive(a, lane, wave); phase_lru_xc(a, tid); }
    SEAM(PH_ATTN);
    if (IN(PH_LRU_GATES)) phase_lru_gates(a, tid);
    SEAM(PH_LRU_GATES);
    if (IN(PH_LRU_SCAN)) phase_lru_scan(a, tid);
    SEAM(PH_LRU_SCAN);
    if (IN(PH_NORM_O)) phase_norm_o(a, lane, wave);
    SEAM(PH_NORM_O);
    if (IN(PH_G2)) {
        const bf16* WOUTT = (const bf16*)(ws + WS_WOUTT); float* H1 = (float*)(ws + WS_H1); const float* bo = a.in[I_B_OUT]; const float* x = a.in[I_X];
        naive_gemm<false>((const bf16*)(ws + WS_O), MREAL / 64, D / 64, D,
            [&](int, const bf16*& b0, const bf16*& b1) { b0 = WOUTT; b1 = WOUTT; },
            [&](int, int row, int col, float v, float) { H1[(size_t)row * D + col] = x[(size_t)row * D + col] + v + bo[col]; }, gw, NGW, lane);
    }
    SEAM(PH_G2);
    if (IN(PH_ROUTER)) phase_router(a, lane, wave);
    SEAM(PH_ROUTER);
    if (IN(PH_ASSIGN)) phase_assign(a, lds, tid, lane, wave);
    SEAM(PH_ASSIGN);
    if (IN(PH_G3)) {
        LAS int* tstart = (LAS int*)(lds + LDS_TAB);
        build_tile_table(a, tstart, tid);
        const int ntile = tstart[NEXP];
        const bf16* WGT = (const bf16*)(ws + WS_WGT); const bf16* WUT = (const bf16*)(ws + WS_WUT); bf16* ACT = (bf16*)(ws + WS_ACT);
        const float* bg = a.in[I_B_GATE]; const float* bu = a.in[I_B_UP];
        naive_gemm<true>((const bf16*)(ws + WS_XS), ntile * 4, DFF / 64, D,
            [&](int tm, const bf16*& b0, const bf16*& b1) { const int e = tile_expert(tstart, tm >> 2); b0 = WGT + (size_t)e * D * D; b1 = WUT + (size_t)e * D * D; },
            [&](int tm, int row, int col, float g, float u) { const int e = tile_expert(tstart, tm >> 2);
                g += bg[e * DFF + col]; u += bu[e * DFF + col];
                g = fminf(g, 7.0f); u = fminf(fmaxf(u, -7.0f), 7.0f);
                ACT[(size_t)row * DFF + col] = (bf16)f2bf(g * sigmoidf_(1.702f * g) * (u + 1.0f)); }, gw, NGW, lane);
    }
    SEAM(PH_G3);
    if (IN(PH_G4)) {
        LAS int* tstart = (LAS int*)(lds + LDS_TAB);
        build_tile_table(a, tstart, tid);
        const int ntile = tstart[NEXP];
        const bf16* WDT = (const bf16*)(ws + WS_WDT); bf16* YB = (bf16*)(ws + WS_YB);
        const float* bd = a.in[I_B_DOWN]; const int* rowpair = (const int*)(ws + WS_ROWPAIR); const float* roww = (const float*)(ws + WS_ROWW);
        naive_gemm<false>((const bf16*)(ws + WS_ACT), ntile * 4, D / 64, DFF,
            [&](int tm, const bf16*& b0, const bf16*& b1) { const int e = tile_expert(tstart, tm >> 2); b0 = WDT + (size_t)e * D * D; b1 = b0; },
            [&](int tm, int row, int col, float v, float) { const int e = tile_expert(tstart, tm >> 2); const int pair = rowpair[row];
                if (pair >= 0) YB[(size_t)pair * D + col] = (bf16)f2bf((v + bd[e * D + col]) * roww[row]); }, gw, NGW, lane);
    }
    SEAM(PH_G4);
    if (IN(PH_FINAL)) phase_final(a, lane, wave);
#undef IN
#undef SEAM
}

extern "C" void kernel_launch(void* const* d_in, const int* in_sizes, int n_in, void* d_out, int out_size, void* d_ws, size_t ws_size, hipStream_t stream) {
    static int grid = 0;
    if (grid == 0) {
        if (n_in != 27 || out_size != MREAL * D || ws_size < WS_END) { fprintf(stderr, "kernel_launch: unexpected problem (n_in %d, out %d, ws %zu)\n", n_in, out_size, ws_size); grid = -1; return; }
        int dev = 0, cus = 0;
        if (hipGetDevice(&dev) != hipSuccess || hipDeviceGetAttribute(&cus, hipDeviceAttributeMultiprocessorCount, dev) != hipSuccess) { grid = -1; return; }
        if (hipFuncSetAttribute((const void*)fwd, hipFuncAttributeMaxDynamicSharedMemorySize, LDS_BYTES) != hipSuccess) { fprintf(stderr, "kernel_launch: hipFuncSetAttribute failed\n"); grid = -1; return; }
        grid = cus;
    }
    if (grid < 0) return;
    (void)hipMemsetAsync((char*)d_ws + WS_CTL, 0, CTL_BYTES, stream);
    Args a{};
    for (int i = 0; i < 27; ++i) a.in[i] = (const float*)d_in[i];
    a.out = (float*)d_out; a.ws = (unsigned char*)d_ws;
#if MK_ONE_LAUNCH
    a.ph_lo = 0; a.ph_hi = PH_COUNT;
    hipLaunchKernelGGL(fwd, dim3(grid), dim3(512), LDS_BYTES, stream, a);
#else
    for (int ph = 0; ph < PH_COUNT; ++ph) {
        a.ph_lo = ph; a.ph_hi = ph + 1;
        hipLaunchKernelGGL(fwd, dim3(grid), dim3(512), LDS_BYTES, stream, a);
    }
#endif
}
```

```cpp
#include <hip/hip_runtime.h>
#include <cstdio>
#include <cstdint>

#define LAS __attribute__((address_space(3)))
#ifndef MK_ONE_LAUNCH
#define MK_ONE_LAUNCH 1
#endif
typedef unsigned short bf16;
typedef float f32x4 __attribute__((ext_vector_type(4)));
typedef short bf16x8 __attribute__((ext_vector_type(8)));
typedef unsigned u32x4 __attribute__((ext_vector_type(4)));
typedef unsigned u32x2 __attribute__((ext_vector_type(2)));

constexpr int D = 2048, SEQ = 2048, NMETA = 16, TT = 2064, NBATCH = 8;
constexpr int MREAL = 16384, METAROW0 = 16384, MVALID = 16400, MROWS = 16640;
constexpr int DIN = 3584, DLRU = 1024, HD = 64;
constexpr int ZQ = 0, ZK = 1024, ZV = 1280, ZX = 1536, ZG = 2560;
constexpr int NEXP = 32, DFF = 2048, PROWS = 73728;
constexpr float EPS = 1e-5f;

constexpr size_t MiB = 1u << 20;
constexpr size_t WS_CTL = 0, CTL_BYTES = 1 * MiB;
constexpr size_t WS_COS = 1 * MiB, WS_SIN = 1 * MiB + 320 * 1024;
constexpr size_t WS_TOPE = 2 * MiB, WS_TOPW = WS_TOPE + 256 * 1024, WS_RSTD2 = WS_TOPW + 256 * 1024, WS_ROWPAIR = WS_RSTD2 + 64 * 1024, WS_ROWW = WS_ROWPAIR + 320 * 1024;
constexpr size_t WS_LRUSUM = 4 * MiB;
constexpr size_t WS_WINT = 10 * MiB, WS_WOUTT = 24 * MiB, WS_WGT = 32 * MiB, WS_WUT = 288 * MiB, WS_WDT = 544 * MiB;
constexpr size_t WS_N1 = 800 * MiB, WS_Z = 866 * MiB, WS_O = 980 * MiB, WS_H1 = 1044 * MiB, WS_XS = 1172 * MiB, WS_YB = WS_XS, WS_ACT = 1460 * MiB, WS_END = 1748 * MiB;
constexpr size_t WS_XC = WS_XS, WS_AA = WS_XS + 66 * MiB, WS_BB = WS_XS + 132 * MiB, WS_YL = WS_XS + 198 * MiB;
static_assert(WS_ROWW + PROWS * 4 <= WS_LRUSUM, "small map");
constexpr int CW_COUNTS = 1024, CW_CURSOR = 1088, CW_BAR = 4096;

constexpr int LDS_TAB = 131072;
constexpr int LDS_MISC = LDS_TAB + 8192;
constexpr int LDS_BYTES = 147456;

__device__ const float c_inv_freq[32] = {1.000000000e+00f, 7.498942018e-01f, 5.623413324e-01f, 4.216965139e-01f, 3.162277639e-01f, 2.371373922e-01f, 1.778279394e-01f, 1.333521456e-01f, 1.000000015e-01f, 7.498941571e-02f, 5.623412877e-02f, 4.216964915e-02f, 3.162277862e-02f, 2.371373586e-02f, 1.778279431e-02f, 1.333521493e-02f, 9.999999776e-03f, 7.498942316e-03f, 5.623413250e-03f, 4.216964822e-03f, 3.162277862e-03f, 2.371373819e-03f, 1.778279431e-03f, 1.333521446e-03f, 1.000000047e-03f, 7.498941850e-04f, 5.623413017e-04f, 4.216965463e-04f, 3.162277862e-04f, 2.371373848e-04f, 1.778279402e-04f, 1.333521504e-04f};

struct Args { const float* in[27]; float* out; unsigned char* ws; int ph_lo, ph_hi; };
enum { I_X = 0, I_META, I_NORM_MIX, I_W_IN, I_B_IN, I_SINKS, I_CONV_W, I_CONV_B, I_W_A, I_B_A, I_W_I, I_B_I, I_LAMBDA, I_G_ATTN, I_G_LRU, I_W_OUT, I_B_OUT, I_NORM_FFN,
       I_W_ROUTER, I_B_ROUTER, I_W_GATE, I_B_GATE, I_W_UP, I_B_UP, I_W_DOWN, I_B_DOWN, I_FINAL_NORM };


#define XB_TMO      128
#define XB_XCNT(j)  (256  + 64 * (j))
#define XB_XSUB(j)  (1280 + 64 * (j))
#define XB_XGEN(j)  (2304 + 64 * (j))
#define XB_TOP      3328
#define XB_TOPGEN   3392
#define XCD_BAR_WORDS 3456
#define XB_SPIN_CAP (1u << 18)

__device__ __forceinline__ unsigned xb_ld(unsigned* p)              { return __hip_atomic_load(p, __ATOMIC_RELAXED, __HIP_MEMORY_SCOPE_AGENT); }
__device__ __forceinline__ unsigned xb_add(unsigned* p, unsigned v) { return __hip_atomic_fetch_add(p, v, __ATOMIC_RELAXED, __HIP_MEMORY_SCOPE_AGENT); }
__device__ __forceinline__ unsigned xb_xcc_id() { return (unsigned)__builtin_amdgcn_s_getreg((3 << 11) | 20) & 0xFu; }
#define XB_SPIN(cond, bar) do { unsigned _sp = 0; while (cond) { __builtin_amdgcn_s_sleep(1); \
    if ((++_sp & 255u) == 0u) { if (xb_ld(&(bar)[XB_TMO])) break; if (_sp > XB_SPIN_CAP) { atomicAdd(&(bar)[XB_TMO], 1u); break; } } } } while (0)

struct XcdBarrier {
    unsigned* bar; unsigned x;
    volatile LAS unsigned* st;
};

__device__ __forceinline__ XcdBarrier xcd_barrier_post(unsigned* bar, volatile LAS unsigned* st) {
    XcdBarrier b; b.bar = bar; b.x = xb_xcc_id(); b.st = st;
    if (threadIdx.x == 0) (void)xb_add(&bar[XB_XCNT(b.x)], 1u);
    return b;
}
__device__ __forceinline__ void xcd_barrier_complete(unsigned* bar, unsigned x, unsigned& nloc, unsigned& nx) {
    const unsigned G = gridDim.x * gridDim.y * gridDim.z;
    unsigned sum, cnt, mine, sp = 0u;
    for (;;) {
        sum = 0u; cnt = 0u; mine = 0u;
#pragma unroll
        for (unsigned j = 0; j < 16; ++j) { const unsigned c = xb_ld(&bar[XB_XCNT(j)]); sum += c; cnt += (c > 0u) ? 1u : 0u; mine = (j == x) ? c : mine; }
        if (sum == G) break;
        __builtin_amdgcn_s_sleep(1);
        if ((++sp & 255u) == 0u) { if (xb_ld(&bar[XB_TMO])) break; if (sp > XB_SPIN_CAP) { atomicAdd(&bar[XB_TMO], 1u); break; } }
    }
    nloc = mine > 0u ? mine : 1u; nx = cnt > 0u ? cnt : 1u;
}

__device__ __forceinline__ void xcd_barrier(const XcdBarrier& b) {
    asm volatile("s_waitcnt vmcnt(0)" ::: "memory");
    __syncthreads();
    if (threadIdx.x == 0) {
        unsigned* bar = b.bar;
        __builtin_amdgcn_s_waitcnt(0);
        unsigned nloc = b.st[0], nx = b.st[1];
        if (nloc == 0u) { xcd_barrier_complete(bar, b.x, nloc, nx); b.st[0] = nloc; b.st[1] = nx; }
        const unsigned old = xb_add(&bar[XB_XSUB(b.x)], 1u);
        const unsigned gen = old / nloc;
        if (old + 1u == (gen + 1u) * nloc) {
            __builtin_amdgcn_fence(__ATOMIC_RELEASE, "agent");
            asm volatile("s_waitcnt vmcnt(0)" ::: "memory");
            const unsigned og = xb_add(&bar[XB_TOP], 1u);
            const unsigned tg = og / nx;
            if (og + 1u == (tg + 1u) * nx) xb_add(&bar[XB_TOPGEN], 1u);
            else XB_SPIN(xb_ld(&bar[XB_TOPGEN]) == tg, bar);
            __builtin_amdgcn_fence(__ATOMIC_ACQUIRE, "agent");
            xb_add(&bar[XB_XGEN(b.x)], 1u);
            asm volatile("s_waitcnt vmcnt(0)" ::: "memory");
        } else {
            XB_SPIN(xb_ld(&bar[XB_XGEN(b.x)]) == gen, bar);
            __builtin_amdgcn_fence(__ATOMIC_ACQUIRE, "agent");
            asm volatile("s_waitcnt vmcnt(0)" ::: "memory");
        }
    }
    __syncthreads();
}

__device__ __forceinline__ float bf2f(unsigned b) { return __uint_as_float((b & 0xffffu) << 16); }
__device__ __forceinline__ unsigned f2bf(float f) { unsigned u = __float_as_uint(f); return (u + 0x7fffu + ((u >> 16) & 1u)) >> 16; }
__device__ __forceinline__ unsigned pk2(float lo, float hi) { return f2bf(lo) | (f2bf(hi) << 16); }
__device__ __forceinline__ float wave_sum(float v) {
#pragma unroll
    for (int o = 1; o < 64; o <<= 1) v += __shfl_xor(v, o);
    return v;
}
__device__ __forceinline__ float wave_max(float v) {
#pragma unroll
    for (int o = 1; o < 64; o <<= 1) v = fmaxf(v, __shfl_xor(v, o));
    return v;
}
__device__ __forceinline__ float sigmoidf_(float x) { return 1.0f / (1.0f + __expf(-x)); }
__device__ __forceinline__ float gelu_tanh(float x) { const float u = 0.7978845608028654f * (x + 0.044715f * x * x * x); return 0.5f * x * (1.0f + tanhf(u)); }
__device__ __forceinline__ int tok_row(int b, int t) { return t < NMETA ? METAROW0 + t : b * SEQ + (t - NMETA); }

__device__ __forceinline__ void transpose_item(const float* W, int K, int N, bf16* WT, LAS float* scr, int item, int lane) {
    const int nblk = N / 32, kb = item / nblk, nb = item % nblk, k0 = 64 * kb, n0 = 32 * nb;
#pragma unroll 8
    for (int i = 0; i < 32; ++i) { const int kk = 2 * i + (lane >> 5); scr[kk * 33 + (lane & 31)] = W[(size_t)(k0 + kk) * N + n0 + (lane & 31)]; }
    asm volatile("s_waitcnt lgkmcnt(0)" ::: "memory");
    const int c = lane & 7;
#pragma unroll
    for (int j = 0; j < 4; ++j) { const int n = (lane >> 3) + 8 * j; const LAS float* s = scr + (8 * c) * 33 + n;
        u32x4 o; o.x = pk2(s[0 * 33], s[1 * 33]); o.y = pk2(s[2 * 33], s[3 * 33]); o.z = pk2(s[4 * 33], s[5 * 33]); o.w = pk2(s[6 * 33], s[7 * 33]);
        *(u32x4*)(WT + (size_t)(n0 + n) * K + k0 + 8 * c) = o; }
    asm volatile("s_waitcnt lgkmcnt(0)" ::: "memory");
}

__device__ __forceinline__ void phase_prologue(const Args& a, LAS unsigned char* lds, int tid, int lane, int wave) {
    const int gw = blockIdx.x * 8 + wave, NGW = gridDim.x * 8;
    const int gt = blockIdx.x * 512 + tid, NGT = gridDim.x * 512;
    unsigned char* ws = a.ws;
    LAS float* scr = (LAS float*)(lds + wave * 8704);
    constexpr int IT_IN = 32 * (DIN / 32), IT_OUT = 32 * (D / 32), IT_E = 32 * (D / 32);
    constexpr int NITEMS = IT_IN + IT_OUT + 96 * IT_E;
    for (int it = gw; it < NITEMS; it += NGW) {
        int r = it;
        if (r < IT_IN) { transpose_item(a.in[I_W_IN], D, DIN, (bf16*)(ws + WS_WINT), scr, r, lane); continue; } r -= IT_IN;
        if (r < IT_OUT) { transpose_item(a.in[I_W_OUT], D, D, (bf16*)(ws + WS_WOUTT), scr, r, lane); continue; } r -= IT_OUT;
        const int mat = r / IT_E, item = r % IT_E, which = mat / NEXP, e = mat % NEXP;
        const float* src = a.in[which == 0 ? I_W_GATE : (which == 1 ? I_W_UP : I_W_DOWN)] + (size_t)e * D * D;
        bf16* dst = (bf16*)(ws + (which == 0 ? WS_WGT : (which == 1 ? WS_WUT : WS_WDT))) + (size_t)e * D * D;
        transpose_item(src, D, D, dst, scr, item, lane);
    }
    bf16* N1 = (bf16*)(ws + WS_N1);
    for (int r = gw; r < MROWS; r += NGW) {
        u32x2* orow = (u32x2*)(N1 + (size_t)r * D);
        if (r >= MVALID) {
#pragma unroll
            for (int j = 0; j < 8; ++j) orow[lane + 64 * j] = (u32x2){0u, 0u};
            continue; }
        const f32x4* xr = (const f32x4*)(r < MREAL ? a.in[I_X] + (size_t)r * D : a.in[I_META] + (size_t)(r - MREAL) * D);
        f32x4 v[8]; float ss = 0.f;
#pragma unroll
        for (int j = 0; j < 8; ++j) { v[j] = xr[lane + 64 * j]; ss += (v[j].x * v[j].x + v[j].y * v[j].y) + (v[j].z * v[j].z + v[j].w * v[j].w); }
        ss = wave_sum(ss);
        const float rstd = 1.0f / sqrtf(ss * (1.0f / D) + EPS);
#pragma unroll
        for (int j = 0; j < 8; ++j) { const f32x4 g = ((const f32x4*)a.in[I_NORM_MIX])[lane + 64 * j];
            orow[lane + 64 * j] = (u32x2){pk2(v[j].x * rstd * g.x, v[j].y * rstd * g.y), pk2(v[j].z * rstd * g.z, v[j].w * rstd * g.w)}; }
    }
    float* cosT = (float*)(ws + WS_COS); float* sinT = (float*)(ws + WS_SIN);
    for (int i = gt; i < TT * 32; i += NGT) {
        const int pos = i >> 5, j = i & 31;
        const float ang = (float)pos * c_inv_freq[j];
        const double t = (double)ang * 0.15915494309189535; const float fr = (float)(t - floor(t));
        cosT[i] = __builtin_amdgcn_cosf(fr); sinT[i] = __builtin_amdgcn_sinf(fr);
    }
    int* rowpair = (int*)(ws + WS_ROWPAIR);
    for (int i = gt; i < PROWS; i += NGT) rowpair[i] = -1;
}

template <bool DUAL, class BSel, class Epi>
__device__ __forceinline__ void naive_gemm(const bf16* A, int mt_count, int nt_count, int K, const BSel& bsel, const Epi& epi, int gw, int NGW, int lane) {
    const int fr = lane & 15, fq = lane >> 4;
    for (int tile = gw; tile < mt_count * nt_count; tile += NGW) {
        const int tm = tile / nt_count, tn = tile % nt_count;
        const bf16 *B0, *B1; bsel(tm, B0, B1);
        f32x4 acc[4][4], acc2[4][4];
#pragma unroll
        for (int i = 0; i < 4; ++i)
#pragma unroll
            for (int j = 0; j < 4; ++j) { acc[i][j] = (f32x4){0.f, 0.f, 0.f, 0.f}; acc2[i][j] = (f32x4){0.f, 0.f, 0.f, 0.f}; }
        const bf16* ap = A + (size_t)(tm * 64 + fr) * K + fq * 8;
        const bf16* bp0 = B0 + (size_t)(tn * 64 + fr) * K + fq * 8;
        const bf16* bp1 = B1 + (size_t)(tn * 64 + fr) * K + fq * 8;
        for (int k0 = 0; k0 < K; k0 += 32) {
            bf16x8 af[4], bfr[4];
#pragma unroll
            for (int i = 0; i < 4; ++i) af[i] = *(const bf16x8*)(ap + (size_t)i * 16 * K + k0);
#pragma unroll
            for (int j = 0; j < 4; ++j) bfr[j] = *(const bf16x8*)(bp0 + (size_t)j * 16 * K + k0);
#pragma unroll
            for (int i = 0; i < 4; ++i)
#pragma unroll
                for (int j = 0; j < 4; ++j) acc[i][j] = __builtin_amdgcn_mfma_f32_16x16x32_bf16(af[i], bfr[j], acc[i][j], 0, 0, 0);
            if (DUAL) {
#pragma unroll
                for (int j = 0; j < 4; ++j) bfr[j] = *(const bf16x8*)(bp1 + (size_t)j * 16 * K + k0);
#pragma unroll
                for (int i = 0; i < 4; ++i)
#pragma unroll
                    for (int j = 0; j < 4; ++j) acc2[i][j] = __builtin_amdgcn_mfma_f32_16x16x32_bf16(af[i], bfr[j], acc2[i][j], 0, 0, 0);
            }
        }
#pragma unroll
        for (int i = 0; i < 4; ++i)
#pragma unroll
            for (int j = 0; j < 4; ++j)
#pragma unroll
                for (int r = 0; r < 4; ++r) epi(tm, tm * 64 + i * 16 + fq * 4 + r, tn * 64 + j * 16 + fr, acc[i][j][r], acc2[i][j][r]);
    }
}


namespace pg8 {
constexpr int BM = 256, BK = 64, HALF = 128, HTB = HALF * BK * 2, STAGE_BYTES = 8 * HTB, NXCD = 8, WGM = 8, KD = 2048, NKT = KD / BK;
__host__ __device__ __forceinline__ int lds_byte(int r, int c) { const int st = (r >> 4) * 2 + (c >> 5), rr = r & 15, cc = c & 31, ob = rr * 64 + cc * 2; return st * 1024 + (ob ^ (((ob >> 9) & 1) << 5)); }
__host__ __device__ __forceinline__ void stage_rc(int b, int& R, int& C) { const int st = b / 1024, sb = b % 1024, swz = sb ^ (((sb >> 9) & 1) << 5); R = (st >> 1) * 16 + swz / 64; C = (st & 1) * 32 + (swz % 64) / 2; }
__host__ __device__ __forceinline__ int perm32(int rho) { const int n = rho >> 4, i = rho & 15; return 8 * (i >> 2) + 4 * n + (i & 3); }
struct Unit { const char* a; const char* b0; const char* b1; int pm, pn, e; };
__device__ __forceinline__ bool static_tile(int i, int G, int c, int nM, int nN, int& pm, int& pn) {
    const int nwg = nM * nN; const long L = (long)i * G + c; if (L >= nwg) return false;
    int wgid = (int)L; { const int q = nwg / NXCD, r = nwg % NXCD, xcd = wgid % NXCD, off = wgid / NXCD; wgid = (xcd < r ? xcd * (q + 1) : r * (q + 1) + (xcd - r) * q) + off; }
    const int nig = WGM * nN, gid = wgid / nig, fm = gid * WGM, gsz = (nM - fm) < WGM ? (nM - fm) : WGM;
    pm = fm + ((wgid % nig) % gsz); pn = (wgid % nig) / gsz; return true;
}
__device__ __forceinline__ unsigned cvt_pk_bf16(float lo, float hi) { unsigned r; asm volatile("v_cvt_pk_bf16_f32 %0, %1, %2" : "=v"(r) : "v"(lo), "v"(hi)); return r; }

template <class Epi, class Sched>
__device__ __forceinline__ void gemm_phase(LAS unsigned char* lds, const Sched& S, const Epi& E) {
    const int tid = threadIdx.x, wid = __builtin_amdgcn_readfirstlane(tid >> 6), lane = tid & 63, wr = wid >> 2, wc = wid & 3, fr = lane & 15, fq = lane >> 4;
    unsigned voffA[2], voffB[2];
#pragma unroll
    for (int i = 0; i < 2; ++i) { int R, C; stage_rc(tid * 16 + i * 8192, R, C); const int Rb = Epi::PERM ? ((R & ~31) + perm32(R & 31)) : R;
        voffA[i] = (unsigned)(R * KD + C) * 2u; voffB[i] = (unsigned)(Rb * KD + C) * 2u; }
    constexpr size_t kstep = (size_t)(BK * 2);
    constexpr size_t hstep = (size_t)HALF * KD * 2;
    const unsigned ldsw = (unsigned)wid * 1024u;
    const int aoff = lds_byte(wr * 64 + fr, fq * 8), boff = lds_byte(wc * 32 + fr, fq * 8);
#define PG8_SA(b, h) (((b) * 2 + (h)) * HTB)
#define PG8_SB(b, h) ((4 + (b) * 2 + (h)) * HTB)
#define PG8_STAGE(bufoff, gbase, voff) do { _Pragma("unroll") for (int _i = 0; _i < 2; ++_i) \
        __builtin_amdgcn_global_load_lds((const unsigned*)((const char*)(gbase) + (voff)[_i]), (LAS unsigned*)(lds + (bufoff) + ldsw + _i * 8192), 16, 0, 0); } while (0)
#define PG8_LDA(dst, b, h) do { _Pragma("unroll") for (int m = 0; m < 4; ++m) _Pragma("unroll") for (int k = 0; k < 2; ++k) dst[m][k] = *(const LAS bf16x8*)(lds + PG8_SA(b, h) + aoff + m * 2048 + k * 1024); } while (0)
#define PG8_LDB(dst, b, h) do { _Pragma("unroll") for (int n = 0; n < 2; ++n) _Pragma("unroll") for (int k = 0; k < 2; ++k) dst[n][k] = *(const LAS bf16x8*)(lds + PG8_SB(b, h) + boff + n * 2048 + k * 1024); } while (0)
#define PG8_MMA(ai, bj, At, Bt) do { __builtin_amdgcn_s_setprio(1); _Pragma("unroll") for (int m = 0; m < 4; ++m) _Pragma("unroll") for (int n = 0; n < 2; ++n) _Pragma("unroll") for (int k = 0; k < 2; ++k) \
        acc[ai][bj][m][n] = __builtin_amdgcn_mfma_f32_16x16x32_bf16(Bt[n][k], At[m][k], acc[ai][bj][m][n], 0, 0, 0); __builtin_amdgcn_s_setprio(0); } while (0)
#define PG8_WAIT_V(n) asm volatile("s_waitcnt vmcnt(" #n ")" ::: "memory")
#define PG8_WAIT_L(n) asm volatile("s_waitcnt lgkmcnt(" #n ")" ::: "memory")
#define PG8_BAR __builtin_amdgcn_s_barrier()
#define PG8_SCHED __builtin_amdgcn_sched_barrier(0)
    Unit cur, nxt; int ui = 0;
    if (!S.next(0, cur)) return;
    f32x4 acc[2][2][4][2];
#pragma unroll
    for (int a = 0; a < 2; ++a)
#pragma unroll
        for (int b = 0; b < 2; ++b)
#pragma unroll
            for (int m = 0; m < 4; ++m)
#pragma unroll
                for (int n = 0; n < 2; ++n) acc[a][b][m][n] = (f32x4){0.f, 0.f, 0.f, 0.f};
    bf16x8 At[4][2], B0[2][2], B1[2][2];
    PG8_STAGE(PG8_SB(0, 0), cur.b0, voffB); PG8_STAGE(PG8_SB(0, 1), cur.b1, voffB); PG8_STAGE(PG8_SA(0, 0), cur.a, voffA); PG8_STAGE(PG8_SA(0, 1), cur.a + hstep, voffA);
    if (wr == 1) PG8_BAR;
    PG8_WAIT_V(2); PG8_BAR;
    PG8_STAGE(PG8_SB(1, 0), cur.b0 + kstep, voffB); PG8_STAGE(PG8_SA(1, 0), cur.a + kstep, voffA); PG8_STAGE(PG8_SB(1, 1), cur.b1 + kstep, voffB);
    PG8_WAIT_V(6); PG8_BAR;
    for (;;) {
        const bool has_next = S.next(ui + 1, nxt);
        const char* nA = has_next ? nxt.a : cur.a; const char* nB0 = has_next ? nxt.b0 : cur.b0; const char* nB1 = has_next ? nxt.b1 : cur.b1;
        for (int t = 0; t < NKT; t += 2) {
            const bool last = (t == NKT - 2);
            const char* a1 = cur.a + (size_t)(t + 1) * kstep;
            const char* a2 = last ? nA : cur.a + (size_t)(t + 2) * kstep;
            const char* b20 = last ? nB0 : cur.b0 + (size_t)(t + 2) * kstep; const char* b21 = last ? nB1 : cur.b1 + (size_t)(t + 2) * kstep;
            const char* a3 = a2 + kstep; const char* b30 = b20 + kstep; const char* b31 = b21 + kstep;
            PG8_LDB(B0, 0, 0); PG8_LDB(B1, 0, 1); PG8_SCHED; PG8_LDA(At, 0, 0); PG8_STAGE(PG8_SA(1, 1), a1 + hstep, voffA);
            PG8_WAIT_V(8); PG8_WAIT_L(0); PG8_BAR; PG8_MMA(0, 0, At, B0); PG8_MMA(0, 1, At, B1); PG8_BAR; PG8_SCHED;
            PG8_LDA(At, 0, 1); PG8_STAGE(PG8_SB(0, 0), b20, voffB); PG8_STAGE(PG8_SB(0, 1), b21, voffB); PG8_STAGE(PG8_SA(0, 0), a2, voffA);
            PG8_WAIT_V(8); PG8_WAIT_L(0); PG8_BAR; PG8_MMA(1, 0, At, B0); PG8_MMA(1, 1, At, B1); PG8_BAR; PG8_SCHED;
            PG8_LDB(B0, 1, 0); PG8_LDB(B1, 1, 1); PG8_SCHED; PG8_LDA(At, 1, 0); PG8_STAGE(PG8_SA(0, 1), a2 + hstep, voffA);
            PG8_WAIT_V(8); PG8_WAIT_L(0); PG8_BAR; PG8_MMA(0, 0, At, B0); PG8_MMA(0, 1, At, B1); PG8_BAR; PG8_SCHED;
            PG8_LDA(At, 1, 1); PG8_STAGE(PG8_SB(1, 0), b30, voffB); PG8_STAGE(PG8_SB(1, 1), b31, voffB); PG8_STAGE(PG8_SA(1, 0), a3, voffA);
            PG8_WAIT_V(8); PG8_WAIT_L(0); PG8_BAR; PG8_MMA(1, 0, At, B0); PG8_MMA(1, 1, At, B1); PG8_BAR; PG8_SCHED;
        }
        if (wr == 0) PG8_BAR;
        E(acc, cur, wr, wc, fr, fq);
        if (!has_next) break;
#pragma unroll
        for (int a = 0; a < 2; ++a)
#pragma unroll
            for (int b = 0; b < 2; ++b)
#pragma unroll
                for (int m = 0; m < 4; ++m)
#pragma unroll
                    for (int n = 0; n < 2; ++n) acc[a][b][m][n] = (f32x4){0.f, 0.f, 0.f, 0.f};
        cur = nxt; ++ui;
        if (wr == 1) PG8_BAR;
    }
    PG8_WAIT_V(0);
    PG8_BAR;
#undef PG8_SA
#undef PG8_SB
#undef PG8_STAGE
#undef PG8_LDA
#undef PG8_LDB
#undef PG8_MMA
#undef PG8_WAIT_V
#undef PG8_WAIT_L
#undef PG8_BAR
#undef PG8_SCHED
}

struct SchedDense {
    const char* A; const char* Bt; int nM, nN, G, c;
    __device__ __forceinline__ bool next(int i, Unit& u) const {
        int pm, pn; if (!static_tile(i, G, c, nM, nN, pm, pn)) return false;
        u.pm = pm; u.pn = pn; u.e = 0; u.a = A + (size_t)pm * (BM * KD * 2); u.b0 = Bt + (size_t)pn * (BM * KD * 2); u.b1 = u.b0 + (size_t)HALF * KD * 2; return true;
    }
};
struct SchedMoE {
    const char* A; const char* B0; const char* B1; const LAS int* tstart; int nM, nN, G, c; bool split;
    __device__ __forceinline__ bool next(int i, Unit& u) const {
        int pm, pn; if (!static_tile(i, G, c, nM, nN, pm, pn)) return false;
        int e = 0;
#pragma unroll 1
        for (int q = 1; q < 32; ++q) e += (tstart[q] <= pm) ? 1 : 0;
        u.pm = pm; u.pn = pn; u.e = e; u.a = A + (size_t)pm * (BM * KD * 2);
        const size_t eoff = (size_t)e * ((size_t)KD * 2048 * 2);
        if (split) { u.b0 = B0 + eoff + (size_t)pn * (HALF * KD * 2); u.b1 = B1 + eoff + (size_t)pn * (HALF * KD * 2); }
        else { u.b0 = B0 + eoff + (size_t)pn * (BM * KD * 2); u.b1 = u.b0 + (size_t)HALF * KD * 2; }
        return true;
    }
};

struct EpiZ {
    static constexpr bool PERM = true;
    bf16* Z; const float* bias;
    __device__ __forceinline__ void operator()(const f32x4 (&acc)[2][2][4][2], const Unit& u, int wr, int wc, int fr, int fq) const {
        const int row0 = u.pm * BM + wr * 64 + fr, col0 = u.pn * BM + wc * 32 + 8 * fq;
        f32x4 bv[2][2];
#pragma unroll
        for (int bj = 0; bj < 2; ++bj)
#pragma unroll
            for (int n = 0; n < 2; ++n) bv[bj][n] = *(const f32x4*)(bias + col0 + bj * HALF + 4 * n);
#pragma unroll
        for (int ai = 0; ai < 2; ++ai)
#pragma unroll
            for (int m = 0; m < 4; ++m) { bf16* rowp = Z + (size_t)(row0 + ai * HALF + m * 16) * DIN + col0;
#pragma unroll
                for (int bj = 0; bj < 2; ++bj) { const f32x4 v0 = acc[ai][bj][m][0] + bv[bj][0], v1 = acc[ai][bj][m][1] + bv[bj][1];
                    u32x4 w; w.x = cvt_pk_bf16(v0[0], v0[1]); w.y = cvt_pk_bf16(v0[2], v0[3]); w.z = cvt_pk_bf16(v1[0], v1[1]); w.w = cvt_pk_bf16(v1[2], v1[3]);
                    *(u32x4*)(rowp + bj * HALF) = w; } }
    }
};
struct EpiH1 {
    static constexpr bool PERM = false;
    float* H1; const float* x; const float* bias;
    __device__ __forceinline__ void operator()(const f32x4 (&acc)[2][2][4][2], const Unit& u, int wr, int wc, int fr, int fq) const {
        const int row0 = u.pm * BM + wr * 64 + fr, col0 = u.pn * BM + wc * 32 + 4 * fq;
        f32x4 bv[2][2];
#pragma unroll
        for (int bj = 0; bj < 2; ++bj)
#pragma unroll
            for (int n = 0; n < 2; ++n) bv[bj][n] = *(const f32x4*)(bias + col0 + bj * HALF + n * 16);
#pragma unroll
        for (int ai = 0; ai < 2; ++ai)
#pragma unroll
            for (int m = 0; m < 4; ++m) { const size_t ro = (size_t)(row0 + ai * HALF + m * 16) * D + col0;
#pragma unroll
                for (int bj = 0; bj < 2; ++bj)
#pragma unroll
                    for (int n = 0; n < 2; ++n) *(f32x4*)(H1 + ro + bj * HALF + n * 16) = *(const f32x4*)(x + ro + bj * HALF + n * 16) + acc[ai][bj][m][n] + bv[bj][n]; }
    }
};
struct EpiAct {
    static constexpr bool PERM = true;
    bf16* ACT; const float* bg; const float* bu;
    __device__ __forceinline__ void operator()(const f32x4 (&acc)[2][2][4][2], const Unit& u, int wr, int wc, int fr, int fq) const {
        const int row0 = u.pm * BM + wr * 64 + fr, col0 = u.pn * HALF + wc * 32 + 8 * fq;
        f32x4 gv[2], uv[2];
#pragma unroll
        for (int n = 0; n < 2; ++n) { gv[n] = *(const f32x4*)(bg + (size_t)u.e * DFF + col0 + 4 * n); uv[n] = *(const f32x4*)(bu + (size_t)u.e * DFF + col0 + 4 * n); }
#pragma unroll
        for (int ai = 0; ai < 2; ++ai)
#pragma unroll
            for (int m = 0; m < 4; ++m) { float r[8];
#pragma unroll
                for (int n = 0; n < 2; ++n)
#pragma unroll
                    for (int j = 0; j < 4; ++j) { float g = acc[ai][0][m][n][j] + gv[n][j], up = acc[ai][1][m][n][j] + uv[n][j];
                        g = fminf(g, 7.0f); up = fminf(fmaxf(up, -7.0f), 7.0f);
                        r[n * 4 + j] = g * (1.0f / (1.0f + __expf(-1.702f * g))) * (up + 1.0f); }
                u32x4 w; w.x = cvt_pk_bf16(r[0], r[1]); w.y = cvt_pk_bf16(r[2], r[3]); w.z = cvt_pk_bf16(r[4], r[5]); w.w = cvt_pk_bf16(r[6], r[7]);
                *(u32x4*)(ACT + (size_t)(row0 + ai * HALF + m * 16) * DFF + col0) = w; }
    }
};
struct EpiDown {
    static constexpr bool PERM = true;
    bf16* YB; const float* bd; const int* rowpair; const float* roww;
    __device__ __forceinline__ void operator()(const f32x4 (&acc)[2][2][4][2], const Unit& u, int wr, int wc, int fr, int fq) const {
        const int row0 = u.pm * BM + wr * 64 + fr, col0 = u.pn * BM + wc * 32 + 8 * fq;
        f32x4 bv[2][2];
#pragma unroll
        for (int bj = 0; bj < 2; ++bj)
#pragma unroll
            for (int n = 0; n < 2; ++n) bv[bj][n] = *(const f32x4*)(bd + (size_t)u.e * D + col0 + bj * HALF + 4 * n);
#pragma unroll
        for (int ai = 0; ai < 2; ++ai)
#pragma unroll
            for (int m = 0; m < 4; ++m) { const int row = row0 + ai * HALF + m * 16; const int pair = rowpair[row]; const float wt = roww[row];
                if (pair >= 0) { bf16* rowp = YB + (size_t)pair * D + col0;
#pragma unroll
                    for (int bj = 0; bj < 2; ++bj) { const f32x4 v0 = (acc[ai][bj][m][0] + bv[bj][0]) * wt, v1 = (acc[ai][bj][m][1] + bv[bj][1]) * wt;
                        u32x4 w; w.x = cvt_pk_bf16(v0[0], v0[1]); w.y = cvt_pk_bf16(v0[2], v0[3]); w.z = cvt_pk_bf16(v1[0], v1[1]); w.w = cvt_pk_bf16(v1[2], v1[3]);
                        *(u32x4*)(rowp + bj * HALF) = w; } } }
    }
};
}

__device__ __forceinline__ void phase_attn_naive(const Args& a, int lane, int wave) {
    const int gw = blockIdx.x * 8 + wave, NGW = gridDim.x * 8;
    const bf16* Z = (const bf16*)(a.ws + WS_Z); bf16* O = (bf16*)(a.ws + WS_O);
    const float* cosT = (const float*)(a.ws + WS_COS); const float* sinT = (const float*)(a.ws + WS_SIN);
    const int j = lane & 31;
    for (int it = gw; it < MREAL * 16; it += NGW) {
        const int head = it & 15, row = it >> 4, b = row >> 11, s = row & 2047, t = NMETA + s, kvh = head >> 2;
        const float qv = bf2f(Z[(size_t)row * DIN + ZQ + head * 64 + lane]);
        const float qo = __shfl_xor(qv, 32);
        float c = cosT[t * 32 + j], sn = sinT[t * 32 + j];
        const float q = 0.125f * (lane < 32 ? qv * c - qo * sn : qv * c + qo * sn);
        float m = a.in[I_SINKS][head], l = 1.f, o = 0.f;
        const int nk = NMETA + (s + 1 < 128 ? s + 1 : 128);
        for (int kk = 0; kk < nk; ++kk) {
            int krow, kpos;
            if (kk < NMETA) { krow = METAROW0 + kk; kpos = kk; } else { const int sp = s - (kk - NMETA); krow = b * SEQ + sp; kpos = NMETA + sp; }
            const float kv = bf2f(Z[(size_t)krow * DIN + ZK + kvh * 64 + lane]);
            const float ko = __shfl_xor(kv, 32);
            c = cosT[kpos * 32 + j]; sn = sinT[kpos * 32 + j];
            const float kr = lane < 32 ? kv * c - ko * sn : kv * c + ko * sn;
            const float sc = wave_sum(q * kr);
            const float mn = fmaxf(m, sc), al = __expf(m - mn), p = __expf(sc - mn);
            const float vv = bf2f(Z[(size_t)krow * DIN + ZV + kvh * 64 + lane]);
            l = l * al + p; o = o * al + p * vv; m = mn;
        }
        O[(size_t)row * D + head * 64 + lane] = (bf16)f2bf(o / l);
    }
}

__device__ __forceinline__ void phase_lru_xc(const Args& a, int tid) {
    const int gt = blockIdx.x * 512 + tid, NGT = gridDim.x * 512;
    const bf16* Z = (const bf16*)(a.ws + WS_Z); float* XC = (float*)(a.ws + WS_XC);
    for (int idx = gt; idx < MVALID * DLRU; idx += NGT) {
        const int row = idx >> 10, c = idx & 1023;
        const int b = row < MREAL ? (row >> 11) : 0, t = row < MREAL ? NMETA + (row & 2047) : row - MREAL;
        float acc = a.in[I_CONV_B][c];
#pragma unroll
        for (int jj = 0; jj < 4; ++jj) { const int tt = t - 3 + jj;
            if (tt >= 0) acc += a.in[I_CONV_W][jj * DLRU + c] * bf2f(Z[(size_t)tok_row(b, tt) * DIN + ZX + c]); }
        XC[idx] = acc;
    }
}
__device__ __forceinline__ void phase_lru_gates(const Args& a, int tid) {
    const int gt = blockIdx.x * 512 + tid, NGT = gridDim.x * 512;
    const float* XC = (const float*)(a.ws + WS_XC); float* AA = (float*)(a.ws + WS_AA); float* BB = (float*)(a.ws + WS_BB);
    for (int idx = gt; idx < MVALID * DLRU; idx += NGT) {
        const int row = idx >> 10, c = idx & 1023, n = c >> 6, d = c & 63;
        float ra = a.in[I_B_A][c], ri = a.in[I_B_I][c];
        const float* xr = XC + (size_t)row * DLRU + n * 64;
        const float* wa = a.in[I_W_A] + (size_t)n * 4096 + d; const float* wi = a.in[I_W_I] + (size_t)n * 4096 + d;
        for (int cc = 0; cc < 64; ++cc) { const float xv = xr[cc]; ra += xv * wa[cc * 64]; ri += xv * wi[cc * 64]; }
        const float r = sigmoidf_(ra), ig = sigmoidf_(ri);
        const float sp = log1pf(expf(-a.in[I_LAMBDA][c]));
        const float log_a = -8.0f * r * sp;
        AA[idx] = expf(log_a);
        BB[idx] = sqrtf(-expm1f(2.0f * log_a)) * ig * XC[idx];
    }
}
__device__ __forceinline__ void phase_lru_scan(const Args& a, int tid) {
    const int gt = blockIdx.x * 512 + tid;
    if (gt >= NBATCH * DLRU) return;
    const int b = gt >> 10, c = gt & 1023;
    const float* AA = (const float*)(a.ws + WS_AA); const float* BB = (const float*)(a.ws + WS_BB); float* YL = (float*)(a.ws + WS_YL);
    const bf16* Z = (const bf16*)(a.ws + WS_Z);
    float h = 0.f;
    for (int t = 0; t < NMETA; ++t) { const int row = METAROW0 + t; h = AA[(size_t)row * DLRU + c] * h + BB[(size_t)row * DLRU + c]; }
#pragma unroll 8
    for (int s = 0; s < SEQ; ++s) { const size_t row = (size_t)b * SEQ + s;
        h = AA[row * DLRU + c] * h + BB[row * DLRU + c];
        YL[row * DLRU + c] = h * gelu_tanh(bf2f(Z[row * DIN + ZG + c])); }
}
__device__ __forceinline__ void phase_norm_o(const Args& a, int lane, int wave) {
    const int gw = blockIdx.x * 8 + wave, NGW = gridDim.x * 8;
    bf16* O = (bf16*)(a.ws + WS_O); const float* YL = (const float*)(a.ws + WS_YL);
    for (int row = gw; row < MREAL; row += NGW) {
        u32x4* op = (u32x4*)(O + (size_t)row * D);
        u32x4 w[2]; float v[16]; float ss = 0.f;
#pragma unroll
        for (int j = 0; j < 2; ++j) { w[j] = op[lane + 64 * j];
#pragma unroll
            for (int q = 0; q < 4; ++q) { v[j * 8 + 2 * q] = bf2f(w[j][q]); v[j * 8 + 2 * q + 1] = bf2f(w[j][q] >> 16); } }
#pragma unroll
        for (int i = 0; i < 16; ++i) ss += v[i] * v[i];
        ss = wave_sum(ss);
        float rstd = 1.0f / sqrtf(ss * (1.0f / 1024.0f) + EPS);
#pragma unroll
        for (int j = 0; j < 2; ++j) { const float* g = a.in[I_G_ATTN] + (lane + 64 * j) * 8; u32x4 o;
#pragma unroll
            for (int q = 0; q < 4; ++q) o[q] = pk2(v[j * 8 + 2 * q] * rstd * g[2 * q], v[j * 8 + 2 * q + 1] * rstd * g[2 * q + 1]);
            op[lane + 64 * j] = o; }
        const f32x4* yp = (const f32x4*)(YL + (size_t)row * DLRU);
        f32x4 y[4]; ss = 0.f;
#pragma unroll
        for (int j = 0; j < 4; ++j) { y[j] = yp[lane + 64 * j]; ss += (y[j].x * y[j].x + y[j].y * y[j].y) + (y[j].z * y[j].z + y[j].w * y[j].w); }
        ss = wave_sum(ss);
        rstd = 1.0f / sqrtf(ss * (1.0f / 1024.0f) + EPS);
        u32x2* o2 = (u32x2*)(O + (size_t)row * D + 1024);
#pragma unroll
        for (int j = 0; j < 4; ++j) { const f32x4 g = ((const f32x4*)a.in[I_G_LRU])[lane + 64 * j];
            o2[lane + 64 * j] = (u32x2){pk2(y[j].x * rstd * g.x, y[j].y * rstd * g.y), pk2(y[j].z * rstd * g.z, y[j].w * rstd * g.w)}; }
    }
}

__device__ __forceinline__ void phase_router(const Args& a, int lane, int wave) {
    const int gw = blockIdx.x * 8 + wave, NGW = gridDim.x * 8;
    const float* H1 = (const float*)(a.ws + WS_H1);
    int* tope = (int*)(a.ws + WS_TOPE); float* topw = (float*)(a.ws + WS_TOPW); float* rstd2 = (float*)(a.ws + WS_RSTD2);
    unsigned* counts = (unsigned*)(a.ws + WS_CTL) + CW_COUNTS;
    const float* wr = a.in[I_W_ROUTER]; const float* nf = a.in[I_NORM_FFN];
    for (int row = gw; row < MREAL; row += NGW) {
        const float* hr = H1 + (size_t)row * D;
        float ss = 0.f;
#pragma unroll
        for (int j = 0; j < 8; ++j) { const f32x4 v = ((const f32x4*)hr)[lane + 64 * j]; ss += (v.x * v.x + v.y * v.y) + (v.z * v.z + v.w * v.w); }
        ss = wave_sum(ss);
        const float rstd = 1.0f / sqrtf(ss * (1.0f / D) + EPS);
        const int e = lane & 31, kh = lane >> 5;
        float acc = 0.f;
        for (int k = kh * 1024; k < kh * 1024 + 1024; ++k) acc += (hr[k] * rstd * nf[k]) * wr[k * NEXP + e];
        acc += __shfl_xor(acc, 32);
        float val = lane < 32 ? acc + a.in[I_B_ROUTER][e] : -3.0e38f;
        float tv[4]; int te[4];
#pragma unroll
        for (int r = 0; r < 4; ++r) {
            const float mx = wave_max(val);
            const unsigned long long msk = __ballot(val == mx);
            const int win = __ffsll((long long)msk) - 1;
            tv[r] = mx; te[r] = win;
            if (lane == win) val = -3.0e38f;
        }
        const float e1 = __expf(tv[1] - tv[0]), e2 = __expf(tv[2] - tv[0]), e3 = __expf(tv[3] - tv[0]);
        const float inv = 1.0f / (1.0f + e1 + e2 + e3);
        if (lane == 0) {
            rstd2[row] = rstd;
            tope[row * 4 + 0] = te[0]; tope[row * 4 + 1] = te[1]; tope[row * 4 + 2] = te[2]; tope[row * 4 + 3] = te[3];
            topw[row * 4 + 0] = inv; topw[row * 4 + 1] = e1 * inv; topw[row * 4 + 2] = e2 * inv; topw[row * 4 + 3] = e3 * inv;
            atomicAdd(&counts[te[0]], 1u); atomicAdd(&counts[te[1]], 1u); atomicAdd(&counts[te[2]], 1u); atomicAdd(&counts[te[3]], 1u);
        }
    }
}

__device__ __forceinline__ void build_tile_table(const Args& a, LAS int* tstart, int tid) {
    if (tid == 0) {
        const unsigned* counts = (const unsigned*)(a.ws + WS_CTL) + CW_COUNTS;
        int acc = 0;
        for (int e = 0; e < NEXP; ++e) { tstart[e] = acc; acc += (int)((__hip_atomic_load(counts + e, __ATOMIC_RELAXED, __HIP_MEMORY_SCOPE_AGENT) + 255u) >> 8); }
        tstart[NEXP] = acc;
    }
    __syncthreads();
}
__device__ __forceinline__ int tile_expert(const LAS int* tstart, int tile) {
    int e = 0;
#pragma unroll 1
    for (int i = 1; i < NEXP; ++i) e += (tstart[i] <= tile) ? 1 : 0;
    return e;
}

__device__ __forceinline__ void phase_assign(const Args& a, LAS unsigned char* lds, int tid, int lane, int wave) {
    LAS int* tstart = (LAS int*)(lds + LDS_TAB);
    LAS int* hist = tstart + 64; LAS int* base = hist + 32; LAS int* spos = base + 32;
    build_tile_table(a, tstart, tid);
    const int* tope = (const int*)(a.ws + WS_TOPE); const float* topw = (const float*)(a.ws + WS_TOPW); const float* rstd2 = (const float*)(a.ws + WS_RSTD2);
    int* rowpair = (int*)(a.ws + WS_ROWPAIR); float* roww = (float*)(a.ws + WS_ROWW);
    unsigned* cursor = (unsigned*)(a.ws + WS_CTL) + CW_CURSOR;
    const float* H1 = (const float*)(a.ws + WS_H1); bf16* XS = (bf16*)(a.ws + WS_XS);
    for (int blk = blockIdx.x; blk < MREAL / 64; blk += gridDim.x) {
        if (tid < 32) hist[tid] = 0;
        __syncthreads();
        int e = 0, rank = 0, pair = 0;
        if (tid < 256) { pair = blk * 256 + tid; e = tope[pair]; rank = atomicAdd((int*)&hist[e], 1); }
        __syncthreads();
        if (tid < 32) base[tid] = (int)atomicAdd(&cursor[tid], (unsigned)hist[tid]);
        __syncthreads();
        if (tid < 256) { const int pos = tstart[e] * 256 + base[e] + rank; spos[tid] = pos; rowpair[pos] = pair; roww[pos] = topw[pair]; }
        __syncthreads();
        for (int tt = wave * 8; tt < wave * 8 + 8; ++tt) {
            const int token = blk * 64 + tt; const float rstd = rstd2[token];
            const f32x4* hr = (const f32x4*)(H1 + (size_t)token * D);
            u32x2 o[8];
#pragma unroll
            for (int j = 0; j < 8; ++j) { const f32x4 v = hr[lane + 64 * j]; const f32x4 g = ((const f32x4*)a.in[I_NORM_FFN])[lane + 64 * j];
                o[j] = (u32x2){pk2(v.x * rstd * g.x, v.y * rstd * g.y), pk2(v.z * rstd * g.z, v.w * rstd * g.w)}; }
#pragma unroll
            for (int k = 0; k < 4; ++k) { u32x2* dst = (u32x2*)(XS + (size_t)spos[tt * 4 + k] * D);
#pragma unroll
                for (int j = 0; j < 8; ++j) dst[lane + 64 * j] = o[j]; }
        }
        __syncthreads();
    }
}

__device__ __forceinline__ void phase_final(const Args& a, int lane, int wave) {
    const int gw = blockIdx.x * 8 + wave, NGW = gridDim.x * 8;
    const float* H1 = (const float*)(a.ws + WS_H1); const bf16* YB = (const bf16*)(a.ws + WS_YB);
    for (int row = gw; row < MREAL; row += NGW) {
        f32x4 v[8]; float ss = 0.f;
#pragma unroll
        for (int j = 0; j < 8; ++j) { v[j] = ((const f32x4*)(H1 + (size_t)row * D))[lane + 64 * j];
#pragma unroll
            for (int k = 0; k < 4; ++k) { const u32x2 y = ((const u32x2*)(YB + ((size_t)row * 4 + k) * D))[lane + 64 * j];
                v[j].x += bf2f(y.x); v[j].y += bf2f(y.x >> 16); v[j].z += bf2f(y.y); v[j].w += bf2f(y.y >> 16); }
            ss += (v[j].x * v[j].x + v[j].y * v[j].y) + (v[j].z * v[j].z + v[j].w * v[j].w); }
        ss = wave_sum(ss);
        const float rstd = 1.0f / sqrtf(ss * (1.0f / D) + EPS);
        f32x4* op = (f32x4*)(a.out + (size_t)row * D);
#pragma unroll
        for (int j = 0; j < 8; ++j) { const f32x4 g = ((const f32x4*)a.in[I_FINAL_NORM])[lane + 64 * j]; op[lane + 64 * j] = v[j] * rstd * g; }
    }
}

enum { PH_PROLOGUE = 0, PH_G1, PH_ATTN, PH_LRU_GATES, PH_LRU_SCAN, PH_NORM_O, PH_G2, PH_ROUTER, PH_ASSIGN, PH_G3, PH_G4, PH_FINAL, PH_COUNT };

__global__ void __launch_bounds__(512, 2) fwd(Args a) {
    extern __shared__ __attribute__((aligned(16))) unsigned char lds_raw[];
    LAS unsigned char* lds = (LAS unsigned char*)lds_raw;
    const int tid = threadIdx.x, lane = tid & 63, wave = __builtin_amdgcn_readfirstlane(tid >> 6);
    const int gw = blockIdx.x * 8 + wave, NGW = gridDim.x * 8;
    unsigned char* ws = a.ws;
#define IN(k) (a.ph_lo <= (k) && (k) < a.ph_hi)
#define SEAM(k) do { if (IN(k) && IN((k) + 1)) xcd_barrier(bar); } while (0)
    if (tid < 4) ((LAS unsigned*)(lds + LDS_MISC))[tid] = 0u;
    __syncthreads();
    XcdBarrier bar; bar.bar = (unsigned*)(ws + WS_CTL) + CW_BAR; bar.x = 0; bar.st = nullptr;
    if (a.ph_hi - a.ph_lo > 1) bar = xcd_barrier_post((unsigned*)(ws + WS_CTL) + CW_BAR, (volatile LAS unsigned*)(lds + LDS_MISC));

    if (IN(PH_PROLOGUE)) phase_prologue(a, lds, tid, lane, wave);
    SEAM(PH_PROLOGUE);

    if (IN(PH_G1)) {
        pg8::SchedDense S{(const char*)(ws + WS_N1), (const char*)(ws + WS_WINT), MROWS / 256, DIN / 256, (int)gridDim.x, (int)blockIdx.x};
        pg8::EpiZ E{(bf16*)(ws + WS_Z), a.in[I_B_IN]};
        pg8::gemm_phase(lds, S, E);
    }
    SEAM(PH_G1);
    if (IN(PH_ATTN)) { phase_attn_naive(a, lane, wave); phase_lru_xc(a, tid); }
    SEAM(PH_ATTN);
    if (IN(PH_LRU_GATES)) phase_lru_gates(a, tid);
    SEAM(PH_LRU_GATES);
    if (IN(PH_LRU_SCAN)) phase_lru_scan(a, tid);
    SEAM(PH_LRU_SCAN);
    if (IN(PH_NORM_O)) phase_norm_o(a, lane, wave);
    SEAM(PH_NORM_O);
    if (IN(PH_G2)) {
        pg8::SchedDense S{(const char*)(ws + WS_O), (const char*)(ws + WS_WOUTT), MREAL / 256, D / 256, (int)gridDim.x, (int)blockIdx.x};
        pg8::EpiH1 E{(float*)(ws + WS_H1), a.in[I_X], a.in[I_B_OUT]};
        pg8::gemm_phase(lds, S, E);
    }
    SEAM(PH_G2);
    if (IN(PH_ROUTER)) phase_router(a, lane, wave);
    SEAM(PH_ROUTER);
    if (IN(PH_ASSIGN)) phase_assign(a, lds, tid, lane, wave);
    SEAM(PH_ASSIGN);
    if (IN(PH_G3)) {
        LAS int* tstart = (LAS int*)(lds + LDS_TAB);
        build_tile_table(a, tstart, tid);
        pg8::SchedMoE S{(const char*)(ws + WS_XS), (const char*)(ws + WS_WGT), (const char*)(ws + WS_WUT), tstart, tstart[NEXP], DFF / 128, (int)gridDim.x, (int)blockIdx.x, true};
        pg8::EpiAct E{(bf16*)(ws + WS_ACT), a.in[I_B_GATE], a.in[I_B_UP]};
        pg8::gemm_phase(lds, S, E);
    }
    SEAM(PH_G3);
    if (IN(PH_G4)) {
        LAS int* tstart = (LAS int*)(lds + LDS_TAB);
        build_tile_table(a, tstart, tid);
        pg8::SchedMoE S{(const char*)(ws + WS_ACT), (const char*)(ws + WS_WDT), (const char*)(ws + WS_WDT), tstart, tstart[NEXP], D / 256, (int)gridDim.x, (int)blockIdx.x, false};
        pg8::EpiDown E{(bf16*)(ws + WS_YB), a.in[I_B_DOWN], (const int*)(ws + WS_ROWPAIR), (const float*)(ws + WS_ROWW)};
        pg8::gemm_phase(lds, S, E);
    }
    SEAM(PH_G4);
    if (IN(PH_FINAL)) phase_final(a, lane, wave);
#undef IN
#undef SEAM
}

extern "C" void kernel_launch(void* const* d_in, const int* in_sizes, int n_in, void* d_out, int out_size, void* d_ws, size_t ws_size, hipStream_t stream) {
    static int grid = 0;
    if (grid == 0) {
        if (n_in != 27 || out_size != MREAL * D || ws_size < WS_END) { fprintf(stderr, "kernel_launch: unexpected problem (n_in %d, out %d, ws %zu)\n", n_in, out_size, ws_size); grid = -1; return; }
        int dev = 0, cus = 0;
        if (hipGetDevice(&dev) != hipSuccess || hipDeviceGetAttribute(&cus, hipDeviceAttributeMultiprocessorCount, dev) != hipSuccess) { grid = -1; return; }
        if (hipFuncSetAttribute((const void*)fwd, hipFuncAttributeMaxDynamicSharedMemorySize, LDS_BYTES) != hipSuccess) { fprintf(stderr, "kernel_launch: hipFuncSetAttribute failed\n"); grid = -1; return; }
        grid = cus;
    }
    if (grid < 0) return;
    (void)hipMemsetAsync((char*)d_ws + WS_CTL, 0, CTL_BYTES, stream);
    Args a{};
    for (int i = 0; i < 27; ++i) a.in[i] = (const float*)d_in[i];
    a.out = (float*)d_out; a.ws = (unsigned char*)d_ws;
#if MK_ONE_LAUNCH
    a.ph_lo = 0; a.ph_hi = PH_COUNT;
    hipLaunchKernelGGL(fwd, dim3(grid), dim3(512), LDS_BYTES, stream, a);
#else
    for (int ph = 0; ph < PH_COUNT; ++ph) {
        a.ph_lo = ph; a.ph_hi = ph + 1;
        hipLaunchKernelGGL(fwd, dim3(grid), dim3(512), LDS_BYTES, stream, a);
    }
#endif
}
```

```cpp
#include <hip/hip_runtime.h>
#include <cstdio>
#include <cstdint>

#define LAS __attribute__((address_space(3)))
#ifndef MK_ONE_LAUNCH
#define MK_ONE_LAUNCH 1
#endif
typedef unsigned short bf16;
typedef float f32x4 __attribute__((ext_vector_type(4)));
typedef short bf16x8 __attribute__((ext_vector_type(8)));
typedef unsigned u32x4 __attribute__((ext_vector_type(4)));
typedef unsigned u32x2 __attribute__((ext_vector_type(2)));

constexpr int D = 2048, SEQ = 2048, NMETA = 16, TT = 2064, NBATCH = 8;
constexpr int MREAL = 16384, METAROW0 = 16384, MVALID = 16400, MROWS = 16640;
constexpr int DIN = 3584, DLRU = 1024, HD = 64;
constexpr int ZQ = 0, ZK = 1024, ZV = 1280, ZX = 1536, ZG = 2560;
constexpr int NEXP = 32, DFF = 2048, PROWS = 73728;
constexpr float EPS = 1e-5f;

constexpr size_t MiB = 1u << 20;
constexpr size_t WS_CTL = 0, CTL_BYTES = 1 * MiB;
constexpr size_t WS_COS = 1 * MiB, WS_SIN = 1 * MiB + 320 * 1024;
constexpr size_t WS_TOPE = 2 * MiB, WS_TOPW = WS_TOPE + 256 * 1024, WS_RSTD2 = WS_TOPW + 256 * 1024, WS_ROWPAIR = WS_RSTD2 + 64 * 1024, WS_ROWW = WS_ROWPAIR + 320 * 1024;
constexpr size_t WS_LRUSUM = 4 * MiB;
constexpr size_t WS_WAT = 9 * MiB, WS_WIT = WS_WAT + 128 * 1024, WS_WRT = WS_WIT + 128 * 1024;
constexpr size_t WS_WINT = 10 * MiB, WS_WOUTT = 24 * MiB, WS_WGT = 32 * MiB, WS_WUT = 288 * MiB, WS_WDT = 544 * MiB;
constexpr size_t WS_N1 = 800 * MiB, WS_Z = 866 * MiB, WS_O = 980 * MiB, WS_H1 = 1044 * MiB, WS_XS = 1172 * MiB, WS_YB = WS_XS, WS_ACT = 1460 * MiB, WS_END = 1748 * MiB;
constexpr size_t WS_XC = WS_XS, WS_AA = WS_XS + 66 * MiB, WS_BB = WS_XS + 132 * MiB, WS_YL = WS_XS + 198 * MiB;
static_assert(WS_ROWW + PROWS * 4 <= WS_LRUSUM, "small map");
constexpr int CW_COUNTS = 1024, CW_CURSOR = 1088, CW_BAR = 4096;

constexpr int LDS_TAB = 131072;
constexpr int LDS_MISC = LDS_TAB + 8192;
constexpr int LDS_BYTES = 147456;

__device__ const float c_inv_freq[32] = {1.000000000e+00f, 7.498942018e-01f, 5.623413324e-01f, 4.216965139e-01f, 3.162277639e-01f, 2.371373922e-01f, 1.778279394e-01f, 1.333521456e-01f, 1.000000015e-01f, 7.498941571e-02f, 5.623412877e-02f, 4.216964915e-02f, 3.162277862e-02f, 2.371373586e-02f, 1.778279431e-02f, 1.333521493e-02f, 9.999999776e-03f, 7.498942316e-03f, 5.623413250e-03f, 4.216964822e-03f, 3.162277862e-03f, 2.371373819e-03f, 1.778279431e-03f, 1.333521446e-03f, 1.000000047e-03f, 7.498941850e-04f, 5.623413017e-04f, 4.216965463e-04f, 3.162277862e-04f, 2.371373848e-04f, 1.778279402e-04f, 1.333521504e-04f};

struct Args { const float* in[27]; float* out; unsigned char* ws; int ph_lo, ph_hi; };
enum { I_X = 0, I_META, I_NORM_MIX, I_W_IN, I_B_IN, I_SINKS, I_CONV_W, I_CONV_B, I_W_A, I_B_A, I_W_I, I_B_I, I_LAMBDA, I_G_ATTN, I_G_LRU, I_W_OUT, I_B_OUT, I_NORM_FFN,
       I_W_ROUTER, I_B_ROUTER, I_W_GATE, I_B_GATE, I_W_UP, I_B_UP, I_W_DOWN, I_B_DOWN, I_FINAL_NORM };


#define XB_TMO      128
#define XB_XCNT(j)  (256  + 64 * (j))
#define XB_XSUB(j)  (1280 + 64 * (j))
#define XB_XGEN(j)  (2304 + 64 * (j))
#define XB_TOP      3328
#define XB_TOPGEN   3392
#define XCD_BAR_WORDS 3456
#define XB_SPIN_CAP (1u << 18)

__device__ __forceinline__ unsigned xb_ld(unsigned* p)              { return __hip_atomic_load(p, __ATOMIC_RELAXED, __HIP_MEMORY_SCOPE_AGENT); }
__device__ __forceinline__ unsigned xb_add(unsigned* p, unsigned v) { return __hip_atomic_fetch_add(p, v, __ATOMIC_RELAXED, __HIP_MEMORY_SCOPE_AGENT); }
__device__ __forceinline__ unsigned xb_xcc_id() { return (unsigned)__builtin_amdgcn_s_getreg((3 << 11) | 20) & 0xFu; }
#define XB_SPIN(cond, bar) do { unsigned _sp = 0; while (cond) { __builtin_amdgcn_s_sleep(1); \
    if ((++_sp & 255u) == 0u) { if (xb_ld(&(bar)[XB_TMO])) break; if (_sp > XB_SPIN_CAP) { atomicAdd(&(bar)[XB_TMO], 1u); break; } } } } while (0)

struct XcdBarrier {
    unsigned* bar; unsigned x;
    volatile LAS unsigned* st;
};

__device__ __forceinline__ XcdBarrier xcd_barrier_post(unsigned* bar, volatile LAS unsigned* st) {
    XcdBarrier b; b.bar = bar; b.x = xb_xcc_id(); b.st = st;
    if (threadIdx.x == 0) (void)xb_add(&bar[XB_XCNT(b.x)], 1u);
    return b;
}
__device__ __forceinline__ void xcd_barrier_complete(unsigned* bar, unsigned x, unsigned& nloc, unsigned& nx) {
    const unsigned G = gridDim.x * gridDim.y * gridDim.z;
    unsigned sum, cnt, mine, sp = 0u;
    for (;;) {
        sum = 0u; cnt = 0u; mine = 0u;
#pragma unroll
        for (unsigned j = 0; j < 16; ++j) { const unsigned c = xb_ld(&bar[XB_XCNT(j)]); sum += c; cnt += (c > 0u) ? 1u : 0u; mine = (j == x) ? c : mine; }
        if (sum == G) break;
        __builtin_amdgcn_s_sleep(1);
        if ((++sp & 255u) == 0u) { if (xb_ld(&bar[XB_TMO])) break; if (sp > XB_SPIN_CAP) { atomicAdd(&bar[XB_TMO], 1u); break; } }
    }
    nloc = mine > 0u ? mine : 1u; nx = cnt > 0u ? cnt : 1u;
}

__device__ __forceinline__ void xcd_barrier(const XcdBarrier& b) {
    asm volatile("s_waitcnt vmcnt(0)" ::: "memory");
    __syncthreads();
    if (threadIdx.x == 0) {
        unsigned* bar = b.bar;
        __builtin_amdgcn_s_waitcnt(0);
        unsigned nloc = b.st[0], nx = b.st[1];
        if (nloc == 0u) { xcd_barrier_complete(bar, b.x, nloc, nx); b.st[0] = nloc; b.st[1] = nx; }
        const unsigned old = xb_add(&bar[XB_XSUB(b.x)], 1u);
        const unsigned gen = old / nloc;
        if (old + 1u == (gen + 1u) * nloc) {
            __builtin_amdgcn_fence(__ATOMIC_RELEASE, "agent");
            asm volatile("s_waitcnt vmcnt(0)" ::: "memory");
            const unsigned og = xb_add(&bar[XB_TOP], 1u);
            const unsigned tg = og / nx;
            if (og + 1u == (tg + 1u) * nx) xb_add(&bar[XB_TOPGEN], 1u);
            else XB_SPIN(xb_ld(&bar[XB_TOPGEN]) == tg, bar);
            __builtin_amdgcn_fence(__ATOMIC_ACQUIRE, "agent");
            xb_add(&bar[XB_XGEN(b.x)], 1u);
            asm volatile("s_waitcnt vmcnt(0)" ::: "memory");
        } else {
            XB_SPIN(xb_ld(&bar[XB_XGEN(b.x)]) == gen, bar);
            __builtin_amdgcn_fence(__ATOMIC_ACQUIRE, "agent");
            asm volatile("s_waitcnt vmcnt(0)" ::: "memory");
        }
    }
    __syncthreads();
}

__device__ __forceinline__ float bf2f(unsigned b) { return __uint_as_float((b & 0xffffu) << 16); }
__device__ __forceinline__ unsigned f2bf(float f) { unsigned u = __float_as_uint(f); return (u + 0x7fffu + ((u >> 16) & 1u)) >> 16; }
__device__ __forceinline__ unsigned pk2(float lo, float hi) { return f2bf(lo) | (f2bf(hi) << 16); }
__device__ __forceinline__ float wave_sum(float v) {
#pragma unroll
    for (int o = 1; o < 64; o <<= 1) v += __shfl_xor(v, o);
    return v;
}
__device__ __forceinline__ float wave_max(float v) {
#pragma unroll
    for (int o = 1; o < 64; o <<= 1) v = fmaxf(v, __shfl_xor(v, o));
    return v;
}
__device__ __forceinline__ float sigmoidf_(float x) { return 1.0f / (1.0f + __expf(-x)); }
__device__ __forceinline__ float gelu_tanh(float x) { const float u = 0.7978845608028654f * (x + 0.044715f * x * x * x); return 0.5f * x * (1.0f + tanhf(u)); }
__device__ __forceinline__ int tok_row(int b, int t) { return t < NMETA ? METAROW0 + t : b * SEQ + (t - NMETA); }

__device__ __forceinline__ void transpose_item(const float* W, int K, int N, bf16* WT, LAS float* scr, int item, int lane) {
    const int nblk = N / 32, kb = item / nblk, nb = item % nblk, k0 = 64 * kb, n0 = 32 * nb;
#pragma unroll 8
    for (int i = 0; i < 32; ++i) { const int kk = 2 * i + (lane >> 5); scr[kk * 33 + (lane & 31)] = W[(size_t)(k0 + kk) * N + n0 + (lane & 31)]; }
    asm volatile("s_waitcnt lgkmcnt(0)" ::: "memory");
    const int c = lane & 7;
#pragma unroll
    for (int j = 0; j < 4; ++j) { const int n = (lane >> 3) + 8 * j; const LAS float* s = scr + (8 * c) * 33 + n;
        u32x4 o; o.x = pk2(s[0 * 33], s[1 * 33]); o.y = pk2(s[2 * 33], s[3 * 33]); o.z = pk2(s[4 * 33], s[5 * 33]); o.w = pk2(s[6 * 33], s[7 * 33]);
        *(u32x4*)(WT + (size_t)(n0 + n) * K + k0 + 8 * c) = o; }
    asm volatile("s_waitcnt lgkmcnt(0)" ::: "memory");
}

__device__ __forceinline__ void phase_prologue(const Args& a, LAS unsigned char* lds, int tid, int lane, int wave) {
    const int gw = blockIdx.x * 8 + wave, NGW = gridDim.x * 8;
    const int gt = blockIdx.x * 512 + tid, NGT = gridDim.x * 512;
    unsigned char* ws = a.ws;
    LAS float* scr = (LAS float*)(lds + wave * 8704);
    constexpr int IT_IN = 32 * (DIN / 32), IT_OUT = 32 * (D / 32), IT_E = 32 * (D / 32);
    constexpr int NITEMS = IT_IN + IT_OUT + 96 * IT_E;
    for (int it = gw; it < NITEMS; it += NGW) {
        int r = it;
        if (r < IT_IN) { transpose_item(a.in[I_W_IN], D, DIN, (bf16*)(ws + WS_WINT), scr, r, lane); continue; } r -= IT_IN;
        if (r < IT_OUT) { transpose_item(a.in[I_W_OUT], D, D, (bf16*)(ws + WS_WOUTT), scr, r, lane); continue; } r -= IT_OUT;
        const int mat = r / IT_E, item = r % IT_E, which = mat / NEXP, e = mat % NEXP;
        const float* src = a.in[which == 0 ? I_W_GATE : (which == 1 ? I_W_UP : I_W_DOWN)] + (size_t)e * D * D;
        bf16* dst = (bf16*)(ws + (which == 0 ? WS_WGT : (which == 1 ? WS_WUT : WS_WDT))) + (size_t)e * D * D;
        transpose_item(src, D, D, dst, scr, item, lane);
    }
    bf16* N1 = (bf16*)(ws + WS_N1);
    for (int r = gw; r < MROWS; r += NGW) {
        u32x2* orow = (u32x2*)(N1 + (size_t)r * D);
        if (r >= MVALID) {
#pragma unroll
            for (int j = 0; j < 8; ++j) orow[lane + 64 * j] = (u32x2){0u, 0u};
            continue; }
        const f32x4* xr = (const f32x4*)(r < MREAL ? a.in[I_X] + (size_t)r * D : a.in[I_META] + (size_t)(r - MREAL) * D);
        f32x4 v[8]; float ss = 0.f;
#pragma unroll
        for (int j = 0; j < 8; ++j) { v[j] = xr[lane + 64 * j]; ss += (v[j].x * v[j].x + v[j].y * v[j].y) + (v[j].z * v[j].z + v[j].w * v[j].w); }
        ss = wave_sum(ss);
        const float rstd = 1.0f / sqrtf(ss * (1.0f / D) + EPS);
#pragma unroll
        for (int j = 0; j < 8; ++j) { const f32x4 g = ((const f32x4*)a.in[I_NORM_MIX])[lane + 64 * j];
            orow[lane + 64 * j] = (u32x2){pk2(v[j].x * rstd * g.x, v[j].y * rstd * g.y), pk2(v[j].z * rstd * g.z, v[j].w * rstd * g.w)}; }
    }
    float* cosT = (float*)(ws + WS_COS); float* sinT = (float*)(ws + WS_SIN);
    for (int i = gt; i < TT * 32; i += NGT) {
        const int pos = i >> 5, j = i & 31;
        const float ang = (float)pos * c_inv_freq[j];
        const double t = (double)ang * 0.15915494309189535; const float fr = (float)(t - floor(t));
        cosT[i] = __builtin_amdgcn_cosf(fr); sinT[i] = __builtin_amdgcn_sinf(fr);
    }
    { bf16* WaT = (bf16*)(ws + WS_WAT); bf16* WiT = (bf16*)(ws + WS_WIT);
      for (int i = gt; i < 16 * 64 * 64; i += NGT) { const int n = i >> 12, d = (i >> 6) & 63, cc = i & 63;
          WaT[i] = (bf16)f2bf(a.in[I_W_A][(n * 64 + cc) * 64 + d]); WiT[i] = (bf16)f2bf(a.in[I_W_I][(n * 64 + cc) * 64 + d]); } }
    { bf16* WRT = (bf16*)(ws + WS_WRT);
      for (int i = gt; i < NEXP * D; i += NGT) { const int e = i >> 11, k = i & 2047; WRT[i] = (bf16)f2bf(a.in[I_NORM_FFN][k] * a.in[I_W_ROUTER][k * NEXP + e]); } }
    int* rowpair = (int*)(ws + WS_ROWPAIR);
    for (int i = gt; i < PROWS; i += NGT) rowpair[i] = -1;
}

template <bool DUAL, class BSel, class Epi>
__device__ __forceinline__ void naive_gemm(const bf16* A, int mt_count, int nt_count, int K, const BSel& bsel, const Epi& epi, int gw, int NGW, int lane) {
    const int fr = lane & 15, fq = lane >> 4;
    for (int tile = gw; tile < mt_count * nt_count; tile += NGW) {
        const int tm = tile / nt_count, tn = tile % nt_count;
        const bf16 *B0, *B1; bsel(tm, B0, B1);
        f32x4 acc[4][4], acc2[4][4];
#pragma unroll
        for (int i = 0; i < 4; ++i)
#pragma unroll
            for (int j = 0; j < 4; ++j) { acc[i][j] = (f32x4){0.f, 0.f, 0.f, 0.f}; acc2[i][j] = (f32x4){0.f, 0.f, 0.f, 0.f}; }
        const bf16* ap = A + (size_t)(tm * 64 + fr) * K + fq * 8;
        const bf16* bp0 = B0 + (size_t)(tn * 64 + fr) * K + fq * 8;
        const bf16* bp1 = B1 + (size_t)(tn * 64 + fr) * K + fq * 8;
        for (int k0 = 0; k0 < K; k0 += 32) {
            bf16x8 af[4], bfr[4];
#pragma unroll
            for (int i = 0; i < 4; ++i) af[i] = *(const bf16x8*)(ap + (size_t)i * 16 * K + k0);
#pragma unroll
            for (int j = 0; j < 4; ++j) bfr[j] = *(const bf16x8*)(bp0 + (size_t)j * 16 * K + k0);
#pragma unroll
            for (int i = 0; i < 4; ++i)
#pragma unroll
                for (int j = 0; j < 4; ++j) acc[i][j] = __builtin_amdgcn_mfma_f32_16x16x32_bf16(af[i], bfr[j], acc[i][j], 0, 0, 0);
            if (DUAL) {
#pragma unroll
                for (int j = 0; j < 4; ++j) bfr[j] = *(const bf16x8*)(bp1 + (size_t)j * 16 * K + k0);
#pragma unroll
                for (int i = 0; i < 4; ++i)
#pragma unroll
                    for (int j = 0; j < 4; ++j) acc2[i][j] = __builtin_amdgcn_mfma_f32_16x16x32_bf16(af[i], bfr[j], acc2[i][j], 0, 0, 0);
            }
        }
#pragma unroll
        for (int i = 0; i < 4; ++i)
#pragma unroll
            for (int j = 0; j < 4; ++j)
#pragma unroll
                for (int r = 0; r < 4; ++r) epi(tm, tm * 64 + i * 16 + fq * 4 + r, tn * 64 + j * 16 + fr, acc[i][j][r], acc2[i][j][r]);
    }
}


namespace pg8 {
constexpr int BM = 256, BK = 64, HALF = 128, HTB = HALF * BK * 2, STAGE_BYTES = 8 * HTB, NXCD = 8, WGM = 8, KD = 2048, NKT = KD / BK;
__host__ __device__ __forceinline__ int lds_byte(int r, int c) { const int st = (r >> 4) * 2 + (c >> 5), rr = r & 15, cc = c & 31, ob = rr * 64 + cc * 2; return st * 1024 + (ob ^ (((ob >> 9) & 1) << 5)); }
__host__ __device__ __forceinline__ void stage_rc(int b, int& R, int& C) { const int st = b / 1024, sb = b % 1024, swz = sb ^ (((sb >> 9) & 1) << 5); R = (st >> 1) * 16 + swz / 64; C = (st & 1) * 32 + (swz % 64) / 2; }
__host__ __device__ __forceinline__ int perm32(int rho) { const int n = rho >> 4, i = rho & 15; return 8 * (i >> 2) + 4 * n + (i & 3); }
struct Unit { const char* a; const char* b0; const char* b1; int pm, pn, e; };
__device__ __forceinline__ bool static_tile(int i, int G, int c, int nM, int nN, int& pm, int& pn) {
    const int nwg = nM * nN; const long L = (long)i * G + c; if (L >= nwg) return false;
    int wgid = (int)L; { const int q = nwg / NXCD, r = nwg % NXCD, xcd = wgid % NXCD, off = wgid / NXCD; wgid = (xcd < r ? xcd * (q + 1) : r * (q + 1) + (xcd - r) * q) + off; }
    const int nig = WGM * nN, gid = wgid / nig, fm = gid * WGM, gsz = (nM - fm) < WGM ? (nM - fm) : WGM;
    pm = fm + ((wgid % nig) % gsz); pn = (wgid % nig) / gsz; return true;
}
__device__ __forceinline__ unsigned cvt_pk_bf16(float lo, float hi) { unsigned r; asm volatile("v_cvt_pk_bf16_f32 %0, %1, %2" : "=v"(r) : "v"(lo), "v"(hi)); return r; }

template <class Epi, class Sched>
__device__ __forceinline__ void gemm_phase(LAS unsigned char* lds, const Sched& S, const Epi& E) {
    const int tid = threadIdx.x, wid = __builtin_amdgcn_readfirstlane(tid >> 6), lane = tid & 63, wr = wid >> 2, wc = wid & 3, fr = lane & 15, fq = lane >> 4;
    unsigned voffA[2], voffB[2];
#pragma unroll
    for (int i = 0; i < 2; ++i) { int R, C; stage_rc(tid * 16 + i * 8192, R, C); const int Rb = Epi::PERM ? ((R & ~31) + perm32(R & 31)) : R;
        voffA[i] = (unsigned)(R * KD + C) * 2u; voffB[i] = (unsigned)(Rb * KD + C) * 2u; }
    constexpr size_t kstep = (size_t)(BK * 2);
    constexpr size_t hstep = (size_t)HALF * KD * 2;
    const unsigned ldsw = (unsigned)wid * 1024u;
    const int aoff = lds_byte(wr * 64 + fr, fq * 8), boff = lds_byte(wc * 32 + fr, fq * 8);
#define PG8_SA(b, h) (((b) * 2 + (h)) * HTB)
#define PG8_SB(b, h) ((4 + (b) * 2 + (h)) * HTB)
#define PG8_STAGE(bufoff, gbase, voff) do { _Pragma("unroll") for (int _i = 0; _i < 2; ++_i) \
        __builtin_amdgcn_global_load_lds((const unsigned*)((const char*)(gbase) + (voff)[_i]), (LAS unsigned*)(lds + (bufoff) + ldsw + _i * 8192), 16, 0, 0); } while (0)
#define PG8_LDA(dst, b, h) do { _Pragma("unroll") for (int m = 0; m < 4; ++m) _Pragma("unroll") for (int k = 0; k < 2; ++k) dst[m][k] = *(const LAS bf16x8*)(lds + PG8_SA(b, h) + aoff + m * 2048 + k * 1024); } while (0)
#define PG8_LDB(dst, b, h) do { _Pragma("unroll") for (int n = 0; n < 2; ++n) _Pragma("unroll") for (int k = 0; k < 2; ++k) dst[n][k] = *(const LAS bf16x8*)(lds + PG8_SB(b, h) + boff + n * 2048 + k * 1024); } while (0)
#define PG8_MMA(ai, bj, At, Bt) do { __builtin_amdgcn_s_setprio(1); _Pragma("unroll") for (int m = 0; m < 4; ++m) _Pragma("unroll") for (int n = 0; n < 2; ++n) _Pragma("unroll") for (int k = 0; k < 2; ++k) \
        acc[ai][bj][m][n] = __builtin_amdgcn_mfma_f32_16x16x32_bf16(Bt[n][k], At[m][k], acc[ai][bj][m][n], 0, 0, 0); __builtin_amdgcn_s_setprio(0); } while (0)
#define PG8_WAIT_V(n) asm volatile("s_waitcnt vmcnt(" #n ")" ::: "memory")
#define PG8_WAIT_L(n) asm volatile("s_waitcnt lgkmcnt(" #n ")" ::: "memory")
#define PG8_BAR __builtin_amdgcn_s_barrier()
#define PG8_SCHED __builtin_amdgcn_sched_barrier(0)
    Unit cur, nxt; int ui = 0;
    if (!S.next(0, cur)) return;
    f32x4 acc[2][2][4][2];
#pragma unroll
    for (int a = 0; a < 2; ++a)
#pragma unroll
        for (int b = 0; b < 2; ++b)
#pragma unroll
            for (int m = 0; m < 4; ++m)
#pragma unroll
                for (int n = 0; n < 2; ++n) acc[a][b][m][n] = (f32x4){0.f, 0.f, 0.f, 0.f};
    bf16x8 At[4][2], B0[2][2], B1[2][2];
    PG8_STAGE(PG8_SB(0, 0), cur.b0, voffB); PG8_STAGE(PG8_SB(0, 1), cur.b1, voffB); PG8_STAGE(PG8_SA(0, 0), cur.a, voffA); PG8_STAGE(PG8_SA(0, 1), cur.a + hstep, voffA);
    if (wr == 1) PG8_BAR;
    PG8_WAIT_V(2); PG8_BAR;
    PG8_STAGE(PG8_SB(1, 0), cur.b0 + kstep, voffB); PG8_STAGE(PG8_SA(1, 0), cur.a + kstep, voffA); PG8_STAGE(PG8_SB(1, 1), cur.b1 + kstep, voffB);
    PG8_WAIT_V(6); PG8_BAR;
    for (;;) {
        const bool has_next = S.next(ui + 1, nxt);
        const char* nA = has_next ? nxt.a : cur.a; const char* nB0 = has_next ? nxt.b0 : cur.b0; const char* nB1 = has_next ? nxt.b1 : cur.b1;
        for (int t = 0; t < NKT; t += 2) {
            const bool last = (t == NKT - 2);
            const char* a1 = cur.a + (size_t)(t + 1) * kstep;
            const char* a2 = last ? nA : cur.a + (size_t)(t + 2) * kstep;
            const char* b20 = last ? nB0 : cur.b0 + (size_t)(t + 2) * kstep; const char* b21 = last ? nB1 : cur.b1 + (size_t)(t + 2) * kstep;
            const char* a3 = a2 + kstep; const char* b30 = b20 + kstep; const char* b31 = b21 + kstep;
            PG8_LDB(B0, 0, 0); PG8_LDB(B1, 0, 1); PG8_SCHED; PG8_LDA(At, 0, 0); PG8_STAGE(PG8_SA(1, 1), a1 + hstep, voffA);
            PG8_WAIT_V(8); PG8_WAIT_L(0); PG8_BAR; PG8_MMA(0, 0, At, B0); PG8_MMA(0, 1, At, B1); PG8_BAR; PG8_SCHED;
            PG8_LDA(At, 0, 1); PG8_STAGE(PG8_SB(0, 0), b20, voffB); PG8_STAGE(PG8_SB(0, 1), b21, voffB); PG8_STAGE(PG8_SA(0, 0), a2, voffA);
            PG8_WAIT_V(8); PG8_WAIT_L(0); PG8_BAR; PG8_MMA(1, 0, At, B0); PG8_MMA(1, 1, At, B1); PG8_BAR; PG8_SCHED;
            PG8_LDB(B0, 1, 0); PG8_LDB(B1, 1, 1); PG8_SCHED; PG8_LDA(At, 1, 0); PG8_STAGE(PG8_SA(0, 1), a2 + hstep, voffA);
            PG8_WAIT_V(8); PG8_WAIT_L(0); PG8_BAR; PG8_MMA(0, 0, At, B0); PG8_MMA(0, 1, At, B1); PG8_BAR; PG8_SCHED;
            PG8_LDA(At, 1, 1); PG8_STAGE(PG8_SB(1, 0), b30, voffB); PG8_STAGE(PG8_SB(1, 1), b31, voffB); PG8_STAGE(PG8_SA(1, 0), a3, voffA);
            PG8_WAIT_V(8); PG8_WAIT_L(0); PG8_BAR; PG8_MMA(1, 0, At, B0); PG8_MMA(1, 1, At, B1); PG8_BAR; PG8_SCHED;
        }
        if (wr == 0) PG8_BAR;
        E(acc, cur, wr, wc, fr, fq);
        if (!has_next) break;
#pragma unroll
        for (int a = 0; a < 2; ++a)
#pragma unroll
            for (int b = 0; b < 2; ++b)
#pragma unroll
                for (int m = 0; m < 4; ++m)
#pragma unroll
                    for (int n = 0; n < 2; ++n) acc[a][b][m][n] = (f32x4){0.f, 0.f, 0.f, 0.f};
        cur = nxt; ++ui;
        if (wr == 1) PG8_BAR;
    }
    PG8_WAIT_V(0);
    PG8_BAR;
#undef PG8_SA
#undef PG8_SB
#undef PG8_STAGE
#undef PG8_LDA
#undef PG8_LDB
#undef PG8_MMA
#undef PG8_WAIT_V
#undef PG8_WAIT_L
#undef PG8_BAR
#undef PG8_SCHED
}

struct SchedDense {
    const char* A; const char* Bt; int nM, nN, G, c;
    __device__ __forceinline__ bool next(int i, Unit& u) const {
        int pm, pn; if (!static_tile(i, G, c, nM, nN, pm, pn)) return false;
        u.pm = pm; u.pn = pn; u.e = 0; u.a = A + (size_t)pm * (BM * KD * 2); u.b0 = Bt + (size_t)pn * (BM * KD * 2); u.b1 = u.b0 + (size_t)HALF * KD * 2; return true;
    }
};
struct SchedMoE {
    const char* A; const char* B0; const char* B1; const LAS int* tstart; int nM, nN, G, c; bool split;
    __device__ __forceinline__ bool next(int i, Unit& u) const {
        int pm, pn; if (!static_tile(i, G, c, nM, nN, pm, pn)) return false;
        int e = 0;
#pragma unroll 1
        for (int q = 1; q < 32; ++q) e += (tstart[q] <= pm) ? 1 : 0;
        u.pm = pm; u.pn = pn; u.e = e; u.a = A + (size_t)pm * (BM * KD * 2);
        const size_t eoff = (size_t)e * ((size_t)KD * 2048 * 2);
        if (split) { u.b0 = B0 + eoff + (size_t)pn * (HALF * KD * 2); u.b1 = B1 + eoff + (size_t)pn * (HALF * KD * 2); }
        else { u.b0 = B0 + eoff + (size_t)pn * (BM * KD * 2); u.b1 = u.b0 + (size_t)HALF * KD * 2; }
        return true;
    }
};

struct EpiZ {
    static constexpr bool PERM = true;
    bf16* Z; const float* bias;
    __device__ __forceinline__ void operator()(const f32x4 (&acc)[2][2][4][2], const Unit& u, int wr, int wc, int fr, int fq) const {
        const int row0 = u.pm * BM + wr * 64 + fr, col0 = u.pn * BM + wc * 32 + 8 * fq;
        f32x4 bv[2][2];
#pragma unroll
        for (int bj = 0; bj < 2; ++bj)
#pragma unroll
            for (int n = 0; n < 2; ++n) bv[bj][n] = *(const f32x4*)(bias + col0 + bj * HALF + 4 * n);
#pragma unroll
        for (int ai = 0; ai < 2; ++ai)
#pragma unroll
            for (int m = 0; m < 4; ++m) { bf16* rowp = Z + (size_t)(row0 + ai * HALF + m * 16) * DIN + col0;
#pragma unroll
                for (int bj = 0; bj < 2; ++bj) { const f32x4 v0 = acc[ai][bj][m][0] + bv[bj][0], v1 = acc[ai][bj][m][1] + bv[bj][1];
                    u32x4 w; w.x = cvt_pk_bf16(v0[0], v0[1]); w.y = cvt_pk_bf16(v0[2], v0[3]); w.z = cvt_pk_bf16(v1[0], v1[1]); w.w = cvt_pk_bf16(v1[2], v1[3]);
                    *(u32x4*)(rowp + bj * HALF) = w; } }
    }
};
struct EpiH1 {
    static constexpr bool PERM = false;
    float* H1; const float* x; const float* bias;
    __device__ __forceinline__ void operator()(const f32x4 (&acc)[2][2][4][2], const Unit& u, int wr, int wc, int fr, int fq) const {
        const int row0 = u.pm * BM + wr * 64 + fr, col0 = u.pn * BM + wc * 32 + 4 * fq;
        f32x4 bv[2][2];
#pragma unroll
        for (int bj = 0; bj < 2; ++bj)
#pragma unroll
            for (int n = 0; n < 2; ++n) bv[bj][n] = *(const f32x4*)(bias + col0 + bj * HALF + n * 16);
#pragma unroll
        for (int ai = 0; ai < 2; ++ai)
#pragma unroll
            for (int m = 0; m < 4; ++m) { const size_t ro = (size_t)(row0 + ai * HALF + m * 16) * D + col0;
#pragma unroll
                for (int bj = 0; bj < 2; ++bj)
#pragma unroll
                    for (int n = 0; n < 2; ++n) *(f32x4*)(H1 + ro + bj * HALF + n * 16) = *(const f32x4*)(x + ro + bj * HALF + n * 16) + acc[ai][bj][m][n] + bv[bj][n]; }
    }
};
struct EpiAct {
    static constexpr bool PERM = true;
    bf16* ACT; const float* bg; const float* bu;
    __device__ __forceinline__ void operator()(const f32x4 (&acc)[2][2][4][2], const Unit& u, int wr, int wc, int fr, int fq) const {
        const int row0 = u.pm * BM + wr * 64 + fr, col0 = u.pn * HALF + wc * 32 + 8 * fq;
        f32x4 gv[2], uv[2];
#pragma unroll
        for (int n = 0; n < 2; ++n) { gv[n] = *(const f32x4*)(bg + (size_t)u.e * DFF + col0 + 4 * n); uv[n] = *(const f32x4*)(bu + (size_t)u.e * DFF + col0 + 4 * n); }
#pragma unroll
        for (int ai = 0; ai < 2; ++ai)
#pragma unroll
            for (int m = 0; m < 4; ++m) { float r[8];
#pragma unroll
                for (int n = 0; n < 2; ++n)
#pragma unroll
                    for (int j = 0; j < 4; ++j) { float g = acc[ai][0][m][n][j] + gv[n][j], up = acc[ai][1][m][n][j] + uv[n][j];
                        g = fminf(g, 7.0f); up = fminf(fmaxf(up, -7.0f), 7.0f);
                        r[n * 4 + j] = g * (1.0f / (1.0f + __expf(-1.702f * g))) * (up + 1.0f); }
                u32x4 w; w.x = cvt_pk_bf16(r[0], r[1]); w.y = cvt_pk_bf16(r[2], r[3]); w.z = cvt_pk_bf16(r[4], r[5]); w.w = cvt_pk_bf16(r[6], r[7]);
                *(u32x4*)(ACT + (size_t)(row0 + ai * HALF + m * 16) * DFF + col0) = w; }
    }
};
struct EpiDown {
    static constexpr bool PERM = true;
    bf16* YB; const float* bd; const int* rowpair; const float* roww;
    __device__ __forceinline__ void operator()(const f32x4 (&acc)[2][2][4][2], const Unit& u, int wr, int wc, int fr, int fq) const {
        const int row0 = u.pm * BM + wr * 64 + fr, col0 = u.pn * BM + wc * 32 + 8 * fq;
        f32x4 bv[2][2];
#pragma unroll
        for (int bj = 0; bj < 2; ++bj)
#pragma unroll
            for (int n = 0; n < 2; ++n) bv[bj][n] = *(const f32x4*)(bd + (size_t)u.e * D + col0 + bj * HALF + 4 * n);
#pragma unroll
        for (int ai = 0; ai < 2; ++ai)
#pragma unroll
            for (int m = 0; m < 4; ++m) { const int row = row0 + ai * HALF + m * 16; const int pair = rowpair[row]; const float wt = roww[row];
                if (pair >= 0) { bf16* rowp = YB + (size_t)pair * D + col0;
#pragma unroll
                    for (int bj = 0; bj < 2; ++bj) { const f32x4 v0 = (acc[ai][bj][m][0] + bv[bj][0]) * wt, v1 = (acc[ai][bj][m][1] + bv[bj][1]) * wt;
                        u32x4 w; w.x = cvt_pk_bf16(v0[0], v0[1]); w.y = cvt_pk_bf16(v0[2], v0[3]); w.z = cvt_pk_bf16(v1[0], v1[1]); w.w = cvt_pk_bf16(v1[2], v1[3]);
                        *(u32x4*)(rowp + bj * HALF) = w; } } }
    }
};
}


typedef float f32x16 __attribute__((ext_vector_type(16)));
constexpr int AT_KS = 144, AT_VS = 584, AT_KOFF = 0, AT_VOFF = 288 * AT_KS;
__device__ __forceinline__ float bflo(unsigned w) { return __uint_as_float(w << 16); }
__device__ __forceinline__ float bfhi(unsigned w) { return __uint_as_float(w & 0xffff0000u); }

__device__ __forceinline__ void attn_tile(LAS unsigned char* lds, int slot_base, int kind, int j, int lane, int hq,
                                          const bf16x8 (&qf)[2][4], f32x16 (&oacc)[2][2], float (&mrow)[2], float (&lrow)[2]) {
    const int r31 = lane & 31, h = lane >> 5;
    bf16x8 kf[4], vf[2][2];
#pragma unroll
    for (int ks = 0; ks < 4; ++ks) kf[ks] = *(const LAS bf16x8*)(lds + AT_KOFF + (slot_base + r31) * AT_KS + (16 * ks + 8 * h) * 2);
#pragma unroll
    for (int dt = 0; dt < 2; ++dt)
#pragma unroll
        for (int sp = 0; sp < 2; ++sp) { const LAS unsigned char* p = lds + AT_VOFF + (32 * dt + r31) * AT_VS + (slot_base + 16 * sp + 4 * h) * 2;
            const u32x2 lo = *(const LAS u32x2*)p, hi = *(const LAS u32x2*)(p + 16);
            const u32x4 w = (u32x4){lo.x, lo.y, hi.x, hi.y}; vf[dt][sp] = __builtin_bit_cast(bf16x8, w); }
#pragma unroll
    for (int qt = 0; qt < 2; ++qt) {
        f32x16 s;
#pragma unroll
        for (int r = 0; r < 16; ++r) s[r] = 0.f;
#pragma unroll
        for (int ks = 0; ks < 4; ++ks) s = __builtin_amdgcn_mfma_f32_32x32x16_bf16(kf[ks], qf[qt][ks], s, 0, 0, 0);
        const int i = 64 * hq + 32 * qt + r31;
        float mx = -1.0e30f;
#pragma unroll
        for (int r = 0; r < 16; ++r) { const int key = (r & 3) + 8 * (r >> 2) + 4 * h;
            const bool ok = kind == 0 ? (key < 16) : (kind == 1 ? (32 * j + key >= i + 1) : (32 * j + key <= i));
            s[r] = ok ? s[r] : -1.0e30f; mx = fmaxf(mx, s[r]); }
        mx = fmaxf(mx, __shfl_xor(mx, 32));
        const float mn = fmaxf(mrow[qt], mx), al = __expf(mrow[qt] - mn); mrow[qt] = mn;
        float ps = 0.f;
#pragma unroll
        for (int r = 0; r < 16; ++r) { s[r] = __expf(s[r] - mn); ps += s[r]; }
        lrow[qt] = lrow[qt] * al + ps;
#pragma unroll
        for (int dt = 0; dt < 2; ++dt)
#pragma unroll
            for (int r = 0; r < 16; ++r) oacc[qt][dt][r] *= al;
        bf16x8 pf[2];
#pragma unroll
        for (int sp = 0; sp < 2; ++sp) { const u32x4 w = (u32x4){pk2(s[8 * sp + 0], s[8 * sp + 1]), pk2(s[8 * sp + 2], s[8 * sp + 3]), pk2(s[8 * sp + 4], s[8 * sp + 5]), pk2(s[8 * sp + 6], s[8 * sp + 7])};
            pf[sp] = __builtin_bit_cast(bf16x8, w); }
#pragma unroll
        for (int dt = 0; dt < 2; ++dt)
#pragma unroll
            for (int sp = 0; sp < 2; ++sp) oacc[qt][dt] = __builtin_amdgcn_mfma_f32_32x32x16_bf16(vf[dt][sp], pf[sp], oacc[qt][dt], 0, 0, 0);
    }
}

__device__ __forceinline__ void attn_item(const Args& a, LAS unsigned char* lds, int item, int tid, int lane, int wave) {
    const int kvh = item & 3, qblk = (item >> 2) & 15, b = item >> 6;
    const bf16* Z = (const bf16*)(a.ws + WS_Z); bf16* O = (bf16*)(a.ws + WS_O);
    const float* cosT = (const float*)(a.ws + WS_COS); const float* sinT = (const float*)(a.ws + WS_SIN);
    __syncthreads();
    for (int task = tid; task < 288 * 4; task += 512) {
        const int slot = task >> 2, c = task & 3;
        int krow, kpos; bool valid;
        if (slot < 32) { valid = slot < NMETA; krow = METAROW0 + slot; kpos = slot; }
        else { const int sp = 128 * (qblk - 1) + (slot - 32); valid = sp >= 0; krow = b * SEQ + sp; kpos = NMETA + sp; }
        u32x4 lo = (u32x4){0u, 0u, 0u, 0u}, hi = lo;
        if (valid) {
            const bf16* kp = Z + (size_t)krow * DIN + ZK + kvh * 64 + c * 8;
            const u32x4 x1 = *(const u32x4*)kp, x2 = *(const u32x4*)(kp + 32);
            const f32x4 c0 = *(const f32x4*)(cosT + kpos * 32 + c * 8), c1 = *(const f32x4*)(cosT + kpos * 32 + c * 8 + 4);
            const f32x4 s0 = *(const f32x4*)(sinT + kpos * 32 + c * 8), s1 = *(const f32x4*)(sinT + kpos * 32 + c * 8 + 4);
#pragma unroll
            for (int q = 0; q < 4; ++q) { const float ca = q < 2 ? c0[2 * q] : c1[2 * q - 4], cb = q < 2 ? c0[2 * q + 1] : c1[2 * q - 3], sa = q < 2 ? s0[2 * q] : s1[2 * q - 4], sb = q < 2 ? s0[2 * q + 1] : s1[2 * q - 3];
                const float a0 = bflo(x1[q]), a1 = bfhi(x1[q]), b0 = bflo(x2[q]), b1 = bfhi(x2[q]);
                lo[q] = pk2(a0 * ca - b0 * sa, a1 * cb - b1 * sb); hi[q] = pk2(b0 * ca + a0 * sa, b1 * cb + a1 * sb); }
        }
        *(LAS u32x4*)(lds + AT_KOFF + slot * AT_KS + c * 16) = lo; *(LAS u32x4*)(lds + AT_KOFF + slot * AT_KS + 64 + c * 16) = hi;
    }
    for (int task = tid; task < 144 * 8; task += 512) {
        const int slot0 = (task >> 3) * 2, c = task & 7;
        int vrow; bool valid;
        if (slot0 < 32) { valid = slot0 < NMETA; vrow = METAROW0 + slot0; }
        else { const int sp = 128 * (qblk - 1) + (slot0 - 32); valid = sp >= 0; vrow = b * SEQ + sp; }
        u32x4 v0 = (u32x4){0u, 0u, 0u, 0u}, v1 = v0;
        if (valid) { const bf16* vp = Z + (size_t)vrow * DIN + ZV + kvh * 64 + c * 8; v0 = *(const u32x4*)vp; v1 = *(const u32x4*)(vp + DIN); }
#pragma unroll
        for (int q = 0; q < 4; ++q) {
            *(LAS unsigned*)(lds + AT_VOFF + (c * 8 + 2 * q) * AT_VS + slot0 * 2) = (v0[q] & 0xffffu) | (v1[q] << 16);
            *(LAS unsigned*)(lds + AT_VOFF + (c * 8 + 2 * q + 1) * AT_VS + slot0 * 2) = (v0[q] >> 16) | (v1[q] & 0xffff0000u); }
    }
    const int g = wave >> 1, hq = wave & 1, head = kvh * 4 + g, r31 = lane & 31, h = lane >> 5;
    bf16x8 qf[2][4];
#pragma unroll
    for (int qt = 0; qt < 2; ++qt) {
        const int s = 128 * qblk + 64 * hq + 32 * qt + r31, pos = NMETA + s;
        const bf16* qp = Z + (size_t)(b * SEQ + s) * DIN + ZQ + head * 64 + 8 * h;
        u32x4 x[4];
#pragma unroll
        for (int ks = 0; ks < 4; ++ks) x[ks] = *(const u32x4*)(qp + 16 * ks);
#pragma unroll
        for (int ks = 0; ks < 2; ++ks) {
            const float* cp = cosT + pos * 32 + 16 * ks + 8 * h; const float* sp = sinT + pos * 32 + 16 * ks + 8 * h;
            const f32x4 c0 = *(const f32x4*)cp, c1 = *(const f32x4*)(cp + 4), s0 = *(const f32x4*)sp, s1 = *(const f32x4*)(sp + 4);
            u32x4 lo, hi;
#pragma unroll
            for (int q = 0; q < 4; ++q) { const float ca = q < 2 ? c0[2 * q] : c1[2 * q - 4], cb = q < 2 ? c0[2 * q + 1] : c1[2 * q - 3], sa = q < 2 ? s0[2 * q] : s1[2 * q - 4], sb = q < 2 ? s0[2 * q + 1] : s1[2 * q - 3];
                const float a0 = bflo(x[ks][q]), a1 = bfhi(x[ks][q]), b0 = bflo(x[ks + 2][q]), b1 = bfhi(x[ks + 2][q]);
                lo[q] = pk2(0.125f * (a0 * ca - b0 * sa), 0.125f * (a1 * cb - b1 * sb)); hi[q] = pk2(0.125f * (b0 * ca + a0 * sa), 0.125f * (b1 * cb + a1 * sb)); }
            qf[qt][ks] = __builtin_bit_cast(bf16x8, lo); qf[qt][ks + 2] = __builtin_bit_cast(bf16x8, hi);
        }
    }
    f32x16 oacc[2][2]; float mrow[2], lrow[2];
#pragma unroll
    for (int qt = 0; qt < 2; ++qt) { mrow[qt] = a.in[I_SINKS][head]; lrow[qt] = h == 0 ? 1.0f : 0.0f;
#pragma unroll
        for (int dt = 0; dt < 2; ++dt)
#pragma unroll
            for (int r = 0; r < 16; ++r) oacc[qt][dt][r] = 0.f; }
    __syncthreads();
    attn_tile(lds, 0, 0, 0, lane, hq, qf, oacc, mrow, lrow);
    if (qblk > 0) {
#pragma unroll 1
        for (int j = hq ? 2 : 0; j < 4; ++j) attn_tile(lds, 32 + 32 * j, 1, j, lane, hq, qf, oacc, mrow, lrow);
    }
#pragma unroll 1
    for (int j = 0; j < (hq ? 4 : 2); ++j) attn_tile(lds, 160 + 32 * j, 2, j, lane, hq, qf, oacc, mrow, lrow);
#pragma unroll
    for (int qt = 0; qt < 2; ++qt) {
        const float lt = lrow[qt] + __shfl_xor(lrow[qt], 32), inv = 1.0f / lt;
        bf16* op = O + (size_t)(b * SEQ + 128 * qblk + 64 * hq + 32 * qt + r31) * D + head * 64 + 4 * h;
#pragma unroll
        for (int dt = 0; dt < 2; ++dt)
#pragma unroll
            for (int rr = 0; rr < 4; ++rr)
                *(u32x2*)(op + 32 * dt + 8 * rr) = (u32x2){pk2(oacc[qt][dt][4 * rr] * inv, oacc[qt][dt][4 * rr + 1] * inv), pk2(oacc[qt][dt][4 * rr + 2] * inv, oacc[qt][dt][4 * rr + 3] * inv)};
    }
}

constexpr int LR_XS = 2064;
template <int PASS>
__device__ __forceinline__ void lru_item(const Args& a, LAS unsigned char* lds, int item, int tid, int lane, int wave) {
    const int b = item / 65, c = item % 65; const bool meta = (c == 64);
    const bf16* Z = (const bf16*)(a.ws + WS_Z);
    float* sumA = (float*)(a.ws + WS_LRUSUM); float* sumB = sumA + NBATCH * 64 * DLRU; float* metaB = sumB + NBATCH * 64 * DLRU;
    __syncthreads();
    for (int task = tid; task < 32 * 128; task += 512) {
        const int tl = task >> 7, ch0 = (task & 127) * 8;
        const int t = meta ? tl : NMETA + 32 * c + tl;
        float acc[8];
        { const f32x4 b0 = *(const f32x4*)(a.in[I_CONV_B] + ch0), b1 = *(const f32x4*)(a.in[I_CONV_B] + ch0 + 4);
          acc[0] = b0.x; acc[1] = b0.y; acc[2] = b0.z; acc[3] = b0.w; acc[4] = b1.x; acc[5] = b1.y; acc[6] = b1.z; acc[7] = b1.w; }
        const bool live = !(meta && tl >= NMETA);
#pragma unroll
        for (int jj = 0; jj < 4; ++jj) { const int tt = t - 3 + jj;
            if (live && tt >= 0) { const u32x4 x = *(const u32x4*)(Z + (size_t)tok_row(b, tt) * DIN + ZX + ch0);
                const f32x4 w0 = *(const f32x4*)(a.in[I_CONV_W] + jj * DLRU + ch0), w1 = *(const f32x4*)(a.in[I_CONV_W] + jj * DLRU + ch0 + 4);
                acc[0] += w0.x * bflo(x[0]); acc[1] += w0.y * bfhi(x[0]); acc[2] += w0.z * bflo(x[1]); acc[3] += w0.w * bfhi(x[1]);
                acc[4] += w1.x * bflo(x[2]); acc[5] += w1.y * bfhi(x[2]); acc[6] += w1.z * bflo(x[3]); acc[7] += w1.w * bfhi(x[3]); } }
        u32x4 o = (u32x4){0u, 0u, 0u, 0u};
        if (live) o = (u32x4){pk2(acc[0], acc[1]), pk2(acc[2], acc[3]), pk2(acc[4], acc[5]), pk2(acc[6], acc[7])};
        *(LAS u32x4*)(lds + tl * LR_XS + ch0 * 2) = o;
    }
    __syncthreads();
    const bf16* WaT = (const bf16*)(a.ws + WS_WAT); const bf16* WiT = (const bf16*)(a.ws + WS_WIT);
    const int r31 = lane & 31, h = lane >> 5;
    const int tau = 16 * ((r31 >> 2) & 1) + 4 * (r31 >> 3) + (r31 & 3);
#pragma unroll 1
    for (int nb = 0; nb < 2; ++nb) {
        const int n = 2 * wave + nb;
        bf16x8 af[4];
#pragma unroll
        for (int ks = 0; ks < 4; ++ks) af[ks] = *(const LAS bf16x8*)(lds + tau * LR_XS + (64 * n + 16 * ks + 8 * h) * 2);
#pragma unroll 1
        for (int nt = 0; nt < 2; ++nt) {
            const int ch = 64 * n + 32 * nt + r31;
            f32x16 accR, accI;
#pragma unroll
            for (int r = 0; r < 16; ++r) { accR[r] = 0.f; accI[r] = 0.f; }
#pragma unroll
            for (int ks = 0; ks < 4; ++ks) {
                const bf16x8 wa = *(const bf16x8*)(WaT + ((size_t)(n * 64 + 32 * nt + r31) * 64 + 16 * ks + 8 * h));
                const bf16x8 wi = *(const bf16x8*)(WiT + ((size_t)(n * 64 + 32 * nt + r31) * 64 + 16 * ks + 8 * h));
                accR = __builtin_amdgcn_mfma_f32_32x32x16_bf16(af[ks], wa, accR, 0, 0, 0);
                accI = __builtin_amdgcn_mfma_f32_32x32x16_bf16(af[ks], wi, accI, 0, 0, 0);
            }
            const float ba = a.in[I_B_A][ch], bi = a.in[I_B_I][ch], sp = log1pf(__expf(-a.in[I_LAMBDA][ch]));
            float av[16], bv[16];
            float Ap = 1.0f, Bp = 0.0f;
#pragma unroll
            for (int r = 0; r < 16; ++r) {
                const float xcv = bf2f(*(const LAS unsigned short*)(lds + (16 * h + r) * LR_XS + ch * 2));
                const float rg = sigmoidf_(accR[r] + ba), ig = sigmoidf_(accI[r] + bi);
                const float log_a = -8.0f * rg * sp;
                av[r] = __expf(log_a); bv[r] = sqrtf(-expm1f(2.0f * log_a)) * ig * xcv;
                Ap *= av[r]; Bp = av[r] * Bp + bv[r];
            }
            const float Ao = __shfl_xor(Ap, 32), Bo = __shfl_xor(Bp, 32);
            if (PASS == 0) {
                if (h == 0) {
                    if (meta) metaB[ch] = Bp;
                    else { sumA[((size_t)b * 64 + c) * DLRU + ch] = Ap * Ao; sumB[((size_t)b * 64 + c) * DLRU + ch] = Ao * Bp + Bo; }
                }
            } else {
                float hin = metaB[ch];
                for (int jc = 0; jc < c; ++jc) hin = sumA[((size_t)b * 64 + jc) * DLRU + ch] * hin + sumB[((size_t)b * 64 + jc) * DLRU + ch];
                float hs = h == 0 ? hin : (Ao * hin + Bo);
#pragma unroll
                for (int r = 0; r < 16; ++r) {
                    hs = av[r] * hs + bv[r];
                    const int tl = 16 * h + r;
                    const float gt = bf2f(Z[(size_t)(b * SEQ + 32 * c + tl) * DIN + ZG + ch]);
                    *(LAS unsigned short*)(lds + tl * LR_XS + ch * 2) = (unsigned short)f2bf(hs * gelu_tanh(gt));
                }
            }
        }
    }
    if (PASS == 1) {
        __syncthreads();
        bf16* O = (bf16*)(a.ws + WS_O);
#pragma unroll 1
        for (int q = 0; q < 4; ++q) {
            const int tl = 4 * wave + q; const size_t row = (size_t)b * SEQ + 32 * c + tl;
            u32x4 w[2]; float v[16]; float ss = 0.f;
#pragma unroll
            for (int jj = 0; jj < 2; ++jj) { w[jj] = *(const LAS u32x4*)(lds + tl * LR_XS + (lane + 64 * jj) * 16);
#pragma unroll
                for (int k = 0; k < 4; ++k) { v[jj * 8 + 2 * k] = bflo(w[jj][k]); v[jj * 8 + 2 * k + 1] = bfhi(w[jj][k]); } }
#pragma unroll
            for (int k = 0; k < 16; ++k) ss += v[k] * v[k];
            ss = wave_sum(ss);
            float rstd = 1.0f / sqrtf(ss * (1.0f / 1024.0f) + EPS);
#pragma unroll
            for (int jj = 0; jj < 2; ++jj) { const float* gp = a.in[I_G_LRU] + (lane + 64 * jj) * 8; const f32x4 g0 = *(const f32x4*)gp, g1 = *(const f32x4*)(gp + 4);
                const u32x4 o = (u32x4){pk2(v[jj * 8 + 0] * rstd * g0.x, v[jj * 8 + 1] * rstd * g0.y), pk2(v[jj * 8 + 2] * rstd * g0.z, v[jj * 8 + 3] * rstd * g0.w),
                                        pk2(v[jj * 8 + 4] * rstd * g1.x, v[jj * 8 + 5] * rstd * g1.y), pk2(v[jj * 8 + 6] * rstd * g1.z, v[jj * 8 + 7] * rstd * g1.w)};
                *(u32x4*)(O + row * D + 1024 + (lane + 64 * jj) * 8) = o; }
            ss = 0.f;
#pragma unroll
            for (int jj = 0; jj < 2; ++jj) { w[jj] = *(const u32x4*)(O + row * D + (lane + 64 * jj) * 8);
#pragma unroll
                for (int k = 0; k < 4; ++k) { v[jj * 8 + 2 * k] = bflo(w[jj][k]); v[jj * 8 + 2 * k + 1] = bfhi(w[jj][k]); } }
#pragma unroll
            for (int k = 0; k < 16; ++k) ss += v[k] * v[k];
            ss = wave_sum(ss);
            rstd = 1.0f / sqrtf(ss * (1.0f / 1024.0f) + EPS);
#pragma unroll
            for (int jj = 0; jj < 2; ++jj) { const float* gp = a.in[I_G_ATTN] + (lane + 64 * jj) * 8; const f32x4 g0 = *(const f32x4*)gp, g1 = *(const f32x4*)(gp + 4);
                const u32x4 o = (u32x4){pk2(v[jj * 8 + 0] * rstd * g0.x, v[jj * 8 + 1] * rstd * g0.y), pk2(v[jj * 8 + 2] * rstd * g0.z, v[jj * 8 + 3] * rstd * g0.w),
                                        pk2(v[jj * 8 + 4] * rstd * g1.x, v[jj * 8 + 5] * rstd * g1.y), pk2(v[jj * 8 + 6] * rstd * g1.z, v[jj * 8 + 7] * rstd * g1.w)};
                *(u32x4*)(O + row * D + (lane + 64 * jj) * 8) = o; }
        }
    }
}

__device__ __forceinline__ void phase_attn_naive(const Args& a, int lane, int wave) {
    const int gw = blockIdx.x * 8 + wave, NGW = gridDim.x * 8;
    const bf16* Z = (const bf16*)(a.ws + WS_Z); bf16* O = (bf16*)(a.ws + WS_O);
    const float* cosT = (const float*)(a.ws + WS_COS); const float* sinT = (const float*)(a.ws + WS_SIN);
    const int j = lane & 31;
    for (int it = gw; it < MREAL * 16; it += NGW) {
        const int head = it & 15, row = it >> 4, b = row >> 11, s = row & 2047, t = NMETA + s, kvh = head >> 2;
        const float qv = bf2f(Z[(size_t)row * DIN + ZQ + head * 64 + lane]);
        const float qo = __shfl_xor(qv, 32);
        float c = cosT[t * 32 + j], sn = sinT[t * 32 + j];
        const float q = 0.125f * (lane < 32 ? qv * c - qo * sn : qv * c + qo * sn);
        float m = a.in[I_SINKS][head], l = 1.f, o = 0.f;
        const int nk = NMETA + (s + 1 < 128 ? s + 1 : 128);
        for (int kk = 0; kk < nk; ++kk) {
            int krow, kpos;
            if (kk < NMETA) { krow = METAROW0 + kk; kpos = kk; } else { const int sp = s - (kk - NMETA); krow = b * SEQ + sp; kpos = NMETA + sp; }
            const float kv = bf2f(Z[(size_t)krow * DIN + ZK + kvh * 64 + lane]);
            const float ko = __shfl_xor(kv, 32);
            c = cosT[kpos * 32 + j]; sn = sinT[kpos * 32 + j];
            const float kr = lane < 32 ? kv * c - ko * sn : kv * c + ko * sn;
            const float sc = wave_sum(q * kr);
            const float mn = fmaxf(m, sc), al = __expf(m - mn), p = __expf(sc - mn);
            const float vv = bf2f(Z[(size_t)krow * DIN + ZV + kvh * 64 + lane]);
            l = l * al + p; o = o * al + p * vv; m = mn;
        }
        O[(size_t)row * D + head * 64 + lane] = (bf16)f2bf(o / l);
    }
}

__device__ __forceinline__ void phase_lru_xc(const Args& a, int tid) {
    const int gt = blockIdx.x * 512 + tid, NGT = gridDim.x * 512;
    const bf16* Z = (const bf16*)(a.ws + WS_Z); float* XC = (float*)(a.ws + WS_XC);
    for (int idx = gt; idx < MVALID * DLRU; idx += NGT) {
        const int row = idx >> 10, c = idx & 1023;
        const int b = row < MREAL ? (row >> 11) : 0, t = row < MREAL ? NMETA + (row & 2047) : row - MREAL;
        float acc = a.in[I_CONV_B][c];
#pragma unroll
        for (int jj = 0; jj < 4; ++jj) { const int tt = t - 3 + jj;
            if (tt >= 0) acc += a.in[I_CONV_W][jj * DLRU + c] * bf2f(Z[(size_t)tok_row(b, tt) * DIN + ZX + c]); }
        XC[idx] = acc;
    }
}
__device__ __forceinline__ void phase_lru_gates(const Args& a, int tid) {
    const int gt = blockIdx.x * 512 + tid, NGT = gridDim.x * 512;
    const float* XC = (const float*)(a.ws + WS_XC); float* AA = (float*)(a.ws + WS_AA); float* BB = (float*)(a.ws + WS_BB);
    for (int idx = gt; idx < MVALID * DLRU; idx += NGT) {
        const int row = idx >> 10, c = idx & 1023, n = c >> 6, d = c & 63;
        float ra = a.in[I_B_A][c], ri = a.in[I_B_I][c];
        const float* xr = XC + (size_t)row * DLRU + n * 64;
        const float* wa = a.in[I_W_A] + (size_t)n * 4096 + d; const float* wi = a.in[I_W_I] + (size_t)n * 4096 + d;
        for (int cc = 0; cc < 64; ++cc) { const float xv = xr[cc]; ra += xv * wa[cc * 64]; ri += xv * wi[cc * 64]; }
        const float r = sigmoidf_(ra), ig = sigmoidf_(ri);
        const float sp = log1pf(expf(-a.in[I_LAMBDA][c]));
        const float log_a = -8.0f * r * sp;
        AA[idx] = expf(log_a);
        BB[idx] = sqrtf(-expm1f(2.0f * log_a)) * ig * XC[idx];
    }
}
__device__ __forceinline__ void phase_lru_scan(const Args& a, int tid) {
    const int gt = blockIdx.x * 512 + tid;
    if (gt >= NBATCH * DLRU) return;
    const int b = gt >> 10, c = gt & 1023;
    const float* AA = (const float*)(a.ws + WS_AA); const float* BB = (const float*)(a.ws + WS_BB); float* YL = (float*)(a.ws + WS_YL);
    const bf16* Z = (const bf16*)(a.ws + WS_Z);
    float h = 0.f;
    for (int t = 0; t < NMETA; ++t) { const int row = METAROW0 + t; h = AA[(size_t)row * DLRU + c] * h + BB[(size_t)row * DLRU + c]; }
#pragma unroll 8
    for (int s = 0; s < SEQ; ++s) { const size_t row = (size_t)b * SEQ + s;
        h = AA[row * DLRU + c] * h + BB[row * DLRU + c];
        YL[row * DLRU + c] = h * gelu_tanh(bf2f(Z[row * DIN + ZG + c])); }
}
__device__ __forceinline__ void phase_norm_o(const Args& a, int lane, int wave) {
    const int gw = blockIdx.x * 8 + wave, NGW = gridDim.x * 8;
    bf16* O = (bf16*)(a.ws + WS_O); const float* YL = (const float*)(a.ws + WS_YL);
    for (int row = gw; row < MREAL; row += NGW) {
        u32x4* op = (u32x4*)(O + (size_t)row * D);
        u32x4 w[2]; float v[16]; float ss = 0.f;
#pragma unroll
        for (int j = 0; j < 2; ++j) { w[j] = op[lane + 64 * j];
#pragma unroll
            for (int q = 0; q < 4; ++q) { v[j * 8 + 2 * q] = bf2f(w[j][q]); v[j * 8 + 2 * q + 1] = bf2f(w[j][q] >> 16); } }
#pragma unroll
        for (int i = 0; i < 16; ++i) ss += v[i] * v[i];
        ss = wave_sum(ss);
        float rstd = 1.0f / sqrtf(ss * (1.0f / 1024.0f) + EPS);
#pragma unroll
        for (int j = 0; j < 2; ++j) { const float* g = a.in[I_G_ATTN] + (lane + 64 * j) * 8; u32x4 o;
#pragma unroll
            for (int q = 0; q < 4; ++q) o[q] = pk2(v[j * 8 + 2 * q] * rstd * g[2 * q], v[j * 8 + 2 * q + 1] * rstd * g[2 * q + 1]);
            op[lane + 64 * j] = o; }
        const f32x4* yp = (const f32x4*)(YL + (size_t)row * DLRU);
        f32x4 y[4]; ss = 0.f;
#pragma unroll
        for (int j = 0; j < 4; ++j) { y[j] = yp[lane + 64 * j]; ss += (y[j].x * y[j].x + y[j].y * y[j].y) + (y[j].z * y[j].z + y[j].w * y[j].w); }
        ss = wave_sum(ss);
        rstd = 1.0f / sqrtf(ss * (1.0f / 1024.0f) + EPS);
        u32x2* o2 = (u32x2*)(O + (size_t)row * D + 1024);
#pragma unroll
        for (int j = 0; j < 4; ++j) { const f32x4 g = ((const f32x4*)a.in[I_G_LRU])[lane + 64 * j];
            o2[lane + 64 * j] = (u32x2){pk2(y[j].x * rstd * g.x, y[j].y * rstd * g.y), pk2(y[j].z * rstd * g.z, y[j].w * rstd * g.w)}; }
    }
}

__device__ __forceinline__ void phase_router(const Args& a, int lane, int wave) {
    const int gw = blockIdx.x * 8 + wave, NGW = gridDim.x * 8;
    const float* H1 = (const float*)(a.ws + WS_H1);
    int* tope = (int*)(a.ws + WS_TOPE); float* topw = (float*)(a.ws + WS_TOPW); float* rstd2 = (float*)(a.ws + WS_RSTD2);
    unsigned* counts = (unsigned*)(a.ws + WS_CTL) + CW_COUNTS;
    const float* wr = a.in[I_W_ROUTER]; const float* nf = a.in[I_NORM_FFN];
    for (int row = gw; row < MREAL; row += NGW) {
        const float* hr = H1 + (size_t)row * D;
        float ss = 0.f;
#pragma unroll
        for (int j = 0; j < 8; ++j) { const f32x4 v = ((const f32x4*)hr)[lane + 64 * j]; ss += (v.x * v.x + v.y * v.y) + (v.z * v.z + v.w * v.w); }
        ss = wave_sum(ss);
        const float rstd = 1.0f / sqrtf(ss * (1.0f / D) + EPS);
        const int e = lane & 31, kh = lane >> 5;
        float acc = 0.f;
        for (int k = kh * 1024; k < kh * 1024 + 1024; ++k) acc += (hr[k] * rstd * nf[k]) * wr[k * NEXP + e];
        acc += __shfl_xor(acc, 32);
        float val = lane < 32 ? acc + a.in[I_B_ROUTER][e] : -3.0e38f;
        float tv[4]; int te[4];
#pragma unroll
        for (int r = 0; r < 4; ++r) {
            const float mx = wave_max(val);
            const unsigned long long msk = __ballot(val == mx);
            const int win = __ffsll((long long)msk) - 1;
            tv[r] = mx; te[r] = win;
            if (lane == win) val = -3.0e38f;
        }
        const float e1 = __expf(tv[1] - tv[0]), e2 = __expf(tv[2] - tv[0]), e3 = __expf(tv[3] - tv[0]);
        const float inv = 1.0f / (1.0f + e1 + e2 + e3);
        if (lane == 0) {
            rstd2[row] = rstd;
            tope[row * 4 + 0] = te[0]; tope[row * 4 + 1] = te[1]; tope[row * 4 + 2] = te[2]; tope[row * 4 + 3] = te[3];
            topw[row * 4 + 0] = inv; topw[row * 4 + 1] = e1 * inv; topw[row * 4 + 2] = e2 * inv; topw[row * 4 + 3] = e3 * inv;
            atomicAdd(&counts[te[0]], 1u); atomicAdd(&counts[te[1]], 1u); atomicAdd(&counts[te[2]], 1u); atomicAdd(&counts[te[3]], 1u);
        }
    }
}


__device__ __forceinline__ void phase_router_mfma(const Args& a, LAS unsigned char* lds, int tid, int lane, int wave) {
    const float* H1 = (const float*)(a.ws + WS_H1); const bf16* WRT = (const bf16*)(a.ws + WS_WRT);
    int* tope = (int*)(a.ws + WS_TOPE); float* topw = (float*)(a.ws + WS_TOPW); float* rstd2 = (float*)(a.ws + WS_RSTD2);
    unsigned* counts = (unsigned*)(a.ws + WS_CTL) + CW_COUNTS;
    LAS float* lg = (LAS float*)(lds + wave * 2048);
    LAS int* hist = (LAS int*)(lds + 32768);
    if (tid < 32) hist[tid] = 0;
    __syncthreads();
    const int fr = lane & 15, fq = lane >> 4;
    for (int grp = wave * gridDim.x + blockIdx.x; grp < MREAL / 16; grp += 8 * gridDim.x) {
        const int row0 = grp * 16;
        const float* hp = H1 + (size_t)(row0 + fr) * D + 8 * fq;
        const bf16* wp = WRT + (size_t)fr * D + 8 * fq;
        f32x4 acc0 = (f32x4){0.f, 0.f, 0.f, 0.f}, acc1 = acc0; float ss = 0.f;
#pragma unroll 4
        for (int kk = 0; kk < 64; ++kk) {
            const f32x4 x0 = *(const f32x4*)(hp + 32 * kk), x1 = *(const f32x4*)(hp + 32 * kk + 4);
            ss += (x0.x * x0.x + x0.y * x0.y) + (x0.z * x0.z + x0.w * x0.w) + (x1.x * x1.x + x1.y * x1.y) + (x1.z * x1.z + x1.w * x1.w);
            const u32x4 w = (u32x4){pk2(x0.x, x0.y), pk2(x0.z, x0.w), pk2(x1.x, x1.y), pk2(x1.z, x1.w)};
            const bf16x8 af = __builtin_bit_cast(bf16x8, w);
            const bf16x8 b0 = *(const bf16x8*)(wp + 32 * kk), b1 = *(const bf16x8*)(wp + (size_t)16 * D + 32 * kk);
            acc0 = __builtin_amdgcn_mfma_f32_16x16x32_bf16(af, b0, acc0, 0, 0, 0);
            acc1 = __builtin_amdgcn_mfma_f32_16x16x32_bf16(af, b1, acc1, 0, 0, 0);
        }
        ss += __shfl_xor(ss, 16); ss += __shfl_xor(ss, 32);
        const float rstd = 1.0f / sqrtf(ss * (1.0f / D) + EPS);
        if (fq == 0) rstd2[row0 + fr] = rstd;
        const float br0 = a.in[I_B_ROUTER][fr], br1 = a.in[I_B_ROUTER][16 + fr];
#pragma unroll
        for (int j = 0; j < 4; ++j) { const int row = 4 * fq + j; const float rs = __shfl(rstd, row);
            lg[row * 32 + fr] = acc0[j] * rs + br0; lg[row * 32 + 16 + fr] = acc1[j] * rs + br1; }
        asm volatile("s_waitcnt lgkmcnt(0)" ::: "memory");
        if (lane < 16) {
            float v[32];
#pragma unroll
            for (int q = 0; q < 8; ++q) { const f32x4 t = *(const LAS f32x4*)(lg + lane * 32 + 4 * q); v[4 * q] = t.x; v[4 * q + 1] = t.y; v[4 * q + 2] = t.z; v[4 * q + 3] = t.w; }
            float tv[4]; int te[4];
#pragma unroll
            for (int r = 0; r < 4; ++r) { float best = -3.0e38f; int bi = 0;
#pragma unroll
                for (int e = 0; e < 32; ++e) { const bool gtb = v[e] > best; best = gtb ? v[e] : best; bi = gtb ? e : bi; }
#pragma unroll
                for (int e = 0; e < 32; ++e) v[e] = (e == bi) ? -3.0e38f : v[e];
                tv[r] = best; te[r] = bi; }
            const float e1 = __expf(tv[1] - tv[0]), e2 = __expf(tv[2] - tv[0]), e3 = __expf(tv[3] - tv[0]);
            const float inv = 1.0f / (1.0f + e1 + e2 + e3);
            const int row = row0 + lane;
            *(int4*)(tope + row * 4) = make_int4(te[0], te[1], te[2], te[3]);
            *(f32x4*)(topw + row * 4) = (f32x4){inv, e1 * inv, e2 * inv, e3 * inv};
#pragma unroll
            for (int r = 0; r < 4; ++r) atomicAdd((int*)&hist[te[r]], 1);
        }
        asm volatile("s_waitcnt lgkmcnt(0)" ::: "memory");
    }
    __syncthreads();
    if (tid < 32 && hist[tid] != 0) atomicAdd(&counts[tid], (unsigned)hist[tid]);
}

__device__ __forceinline__ void build_tile_table(const Args& a, LAS int* tstart, int tid) {
    if (tid == 0) {
        const unsigned* counts = (const unsigned*)(a.ws + WS_CTL) + CW_COUNTS;
        int acc = 0;
        for (int e = 0; e < NEXP; ++e) { tstart[e] = acc; acc += (int)((__hip_atomic_load(counts + e, __ATOMIC_RELAXED, __HIP_MEMORY_SCOPE_AGENT) + 255u) >> 8); }
        tstart[NEXP] = acc;
    }
    __syncthreads();
}
__device__ __forceinline__ int tile_expert(const LAS int* tstart, int tile) {
    int e = 0;
#pragma unroll 1
    for (int i = 1; i < NEXP; ++i) e += (tstart[i] <= tile) ? 1 : 0;
    return e;
}

__device__ __forceinline__ void phase_assign(const Args& a, LAS unsigned char* lds, int tid, int lane, int wave) {
    LAS int* tstart = (LAS int*)(lds + LDS_TAB);
    LAS int* hist = tstart + 64; LAS int* base = hist + 32; LAS int* spos = base + 32;
    build_tile_table(a, tstart, tid);
    const int* tope = (const int*)(a.ws + WS_TOPE); const float* topw = (const float*)(a.ws + WS_TOPW); const float* rstd2 = (const float*)(a.ws + WS_RSTD2);
    int* rowpair = (int*)(a.ws + WS_ROWPAIR); float* roww = (float*)(a.ws + WS_ROWW);
    unsigned* cursor = (unsigned*)(a.ws + WS_CTL) + CW_CURSOR;
    const float* H1 = (const float*)(a.ws + WS_H1); bf16* XS = (bf16*)(a.ws + WS_XS);
    for (int blk = blockIdx.x; blk < MREAL / 64; blk += gridDim.x) {
        if (tid < 32) hist[tid] = 0;
        __syncthreads();
        int e = 0, rank = 0, pair = 0;
        if (tid < 256) { pair = blk * 256 + tid; e = tope[pair]; rank = atomicAdd((int*)&hist[e], 1); }
        __syncthreads();
        if (tid < 32) base[tid] = (int)atomicAdd(&cursor[tid], (unsigned)hist[tid]);
        __syncthreads();
        if (tid < 256) { const int pos = tstart[e] * 256 + base[e] + rank; spos[tid] = pos; rowpair[pos] = pair; roww[pos] = topw[pair]; }
        __syncthreads();
        for (int tt = wave * 8; tt < wave * 8 + 8; ++tt) {
            const int token = blk * 64 + tt; const float rstd = rstd2[token];
            const f32x4* hr = (const f32x4*)(H1 + (size_t)token * D);
            u32x2 o[8];
#pragma unroll
            for (int j = 0; j < 8; ++j) { const f32x4 v = hr[lane + 64 * j]; const f32x4 g = ((const f32x4*)a.in[I_NORM_FFN])[lane + 64 * j];
                o[j] = (u32x2){pk2(v.x * rstd * g.x, v.y * rstd * g.y), pk2(v.z * rstd * g.z, v.w * rstd * g.w)}; }
#pragma unroll
            for (int k = 0; k < 4; ++k) { u32x2* dst = (u32x2*)(XS + (size_t)spos[tt * 4 + k] * D);
#pragma unroll
                for (int j = 0; j < 8; ++j) dst[lane + 64 * j] = o[j]; }
        }
        __syncthreads();
    }
}

__device__ __forceinline__ void phase_final(const Args& a, int lane, int wave) {
    const int gw = blockIdx.x * 8 + wave, NGW = gridDim.x * 8;
    const float* H1 = (const float*)(a.ws + WS_H1); const bf16* YB = (const bf16*)(a.ws + WS_YB);
    for (int row = gw; row < MREAL; row += NGW) {
        f32x4 v[8]; float ss = 0.f;
#pragma unroll
        for (int j = 0; j < 8; ++j) { v[j] = ((const f32x4*)(H1 + (size_t)row * D))[lane + 64 * j];
#pragma unroll
            for (int k = 0; k < 4; ++k) { const u32x2 y = ((const u32x2*)(YB + ((size_t)row * 4 + k) * D))[lane + 64 * j];
                v[j].x += bf2f(y.x); v[j].y += bf2f(y.x >> 16); v[j].z += bf2f(y.y); v[j].w += bf2f(y.y >> 16); }
            ss += (v[j].x * v[j].x + v[j].y * v[j].y) + (v[j].z * v[j].z + v[j].w * v[j].w); }
        ss = wave_sum(ss);
        const float rstd = 1.0f / sqrtf(ss * (1.0f / D) + EPS);
        f32x4* op = (f32x4*)(a.out + (size_t)row * D);
#pragma unroll
        for (int j = 0; j < 8; ++j) { const f32x4 g = ((const f32x4*)a.in[I_FINAL_NORM])[lane + 64 * j]; op[lane + 64 * j] = v[j] * rstd * g; }
    }
}

enum { PH_PROLOGUE = 0, PH_G1, PH_ATTN, PH_LRU_B, PH_G2, PH_ROUTER, PH_ASSIGN, PH_G3, PH_G4, PH_FINAL, PH_COUNT };

__global__ void __launch_bounds__(512, 2) fwd(Args a) {
    extern __shared__ __attribute__((aligned(16))) unsigned char lds_raw[];
    LAS unsigned char* lds = (LAS unsigned char*)lds_raw;
    const int tid = threadIdx.x, lane = tid & 63, wave = __builtin_amdgcn_readfirstlane(tid >> 6);
    const int gw = blockIdx.x * 8 + wave, NGW = gridDim.x * 8;
    unsigned char* ws = a.ws;
#define IN(k) (a.ph_lo <= (k) && (k) < a.ph_hi)
#define SEAM(k) do { if (IN(k) && IN((k) + 1)) xcd_barrier(bar); } while (0)
    if (tid < 4) ((LAS unsigned*)(lds + LDS_MISC))[tid] = 0u;
    __syncthreads();
    XcdBarrier bar; bar.bar = (unsigned*)(ws + WS_CTL) + CW_BAR; bar.x = 0; bar.st = nullptr;
    if (a.ph_hi - a.ph_lo > 1) bar = xcd_barrier_post((unsigned*)(ws + WS_CTL) + CW_BAR, (volatile LAS unsigned*)(lds + LDS_MISC));

    if (IN(PH_PROLOGUE)) phase_prologue(a, lds, tid, lane, wave);
    SEAM(PH_PROLOGUE);

    if (IN(PH_G1)) {
        pg8::SchedDense S{(const char*)(ws + WS_N1), (const char*)(ws + WS_WINT), MROWS / 256, DIN / 256, (int)gridDim.x, (int)blockIdx.x};
        pg8::EpiZ E{(bf16*)(ws + WS_Z), a.in[I_B_IN]};
        pg8::gemm_phase(lds, S, E);
    }
    SEAM(PH_G1);
    if (IN(PH_ATTN)) {
        for (int it = blockIdx.x; it < NBATCH * 16 * 4; it += gridDim.x) attn_item(a, lds, it, tid, lane, wave);
        for (int it = blockIdx.x; it < NBATCH * 65; it += gridDim.x) { if (it % 65 == 64 && it != 64) continue; lru_item<0>(a, lds, it, tid, lane, wave); }
    }
    SEAM(PH_ATTN);
    if (IN(PH_LRU_B)) {
        for (int it = blockIdx.x; it < NBATCH * 65; it += gridDim.x) { if (it % 65 == 64) continue; lru_item<1>(a, lds, it, tid, lane, wave); }
    }
    SEAM(PH_LRU_B);
    if (IN(PH_G2)) {
        pg8::SchedDense S{(const char*)(ws + WS_O), (const char*)(ws + WS_WOUTT), MREAL / 256, D / 256, (int)gridDim.x, (int)blockIdx.x};
        pg8::EpiH1 E{(float*)(ws + WS_H1), a.in[I_X], a.in[I_B_OUT]};
        pg8::gemm_phase(lds, S, E);
    }
    SEAM(PH_G2);
    if (IN(PH_ROUTER)) phase_router_mfma(a, lds, tid, lane, wave);
    SEAM(PH_ROUTER);
    if (IN(PH_ASSIGN)) phase_assign(a, lds, tid, lane, wave);
    SEAM(PH_ASSIGN);
    if (IN(PH_G3)) {
        LAS int* tstart = (LAS int*)(lds + LDS_TAB);
        build_tile_table(a, tstart, tid);
        pg8::SchedMoE S{(const char*)(ws + WS_XS), (const char*)(ws + WS_WGT), (const char*)(ws + WS_WUT), tstart, tstart[NEXP], DFF / 128, (int)gridDim.x, (int)blockIdx.x, true};
        pg8::EpiAct E{(bf16*)(ws + WS_ACT), a.in[I_B_GATE], a.in[I_B_UP]};
        pg8::gemm_phase(lds, S, E);
    }
    SEAM(PH_G3);
    if (IN(PH_G4)) {
        LAS int* tstart = (LAS int*)(lds + LDS_TAB);
        build_tile_table(a, tstart, tid);
        pg8::SchedMoE S{(const char*)(ws + WS_ACT), (const char*)(ws + WS_WDT), (const char*)(ws + WS_WDT), tstart, tstart[NEXP], D / 256, (int)gridDim.x, (int)blockIdx.x, false};
        pg8::EpiDown E{(bf16*)(ws + WS_YB), a.in[I_B_DOWN], (const int*)(ws + WS_ROWPAIR), (const float*)(ws + WS_ROWW)};
        pg8::gemm_phase(lds, S, E);
    }
    SEAM(PH_G4);
    if (IN(PH_FINAL)) phase_final(a, lane, wave);
#undef IN
#undef SEAM
}

extern "C" void kernel_launch(void* const* d_in, const int* in_sizes, int n_in, void* d_out, int out_size, void* d_ws, size_t ws_size, hipStream_t stream) {
    static int grid = 0;
    if (grid == 0) {
        if (n_in != 27 || out_size != MREAL * D || ws_size < WS_END) { fprintf(stderr, "kernel_launch: unexpected problem (n_in %d, out %d, ws %zu)\n", n_in, out_size, ws_size); grid = -1; return; }
        int dev = 0, cus = 0;
        if (hipGetDevice(&dev) != hipSuccess || hipDeviceGetAttribute(&cus, hipDeviceAttributeMultiprocessorCount, dev) != hipSuccess) { grid = -1; return; }
        if (hipFuncSetAttribute((const void*)fwd, hipFuncAttributeMaxDynamicSharedMemorySize, LDS_BYTES) != hipSuccess) { fprintf(stderr, "kernel_launch: hipFuncSetAttribute failed\n"); grid = -1; return; }
        grid = cus;
    }
    if (grid < 0) return;
    (void)hipMemsetAsync((char*)d_ws + WS_CTL, 0, CTL_BYTES, stream);
    Args a{};
    for (int i = 0; i < 27; ++i) a.in[i] = (const float*)d_in[i];
    a.out = (float*)d_out; a.ws = (unsigned char*)d_ws;
#if MK_ONE_LAUNCH
    a.ph_lo = 0; a.ph_hi = PH_COUNT;
    hipLaunchKernelGGL(fwd, dim3(grid), dim3(512), LDS_BYTES, stream, a);
#else
    for (int ph = 0; ph < PH_COUNT; ++ph) {
        a.ph_lo = ph; a.ph_hi = ph + 1;
        hipLaunchKernelGGL(fwd, dim3(grid), dim3(512), LDS_BYTES, stream, a);
    }
#endif
}
```

```cpp
#include <hip/hip_runtime.h>
#include <cstdio>
#include <cstdint>

#define LAS __attribute__((address_space(3)))
#ifndef MK_ONE_LAUNCH
#define MK_ONE_LAUNCH 1
#endif
typedef unsigned short bf16;
typedef float f32x4 __attribute__((ext_vector_type(4)));
typedef short bf16x8 __attribute__((ext_vector_type(8)));
typedef unsigned u32x4 __attribute__((ext_vector_type(4)));
typedef unsigned u32x2 __attribute__((ext_vector_type(2)));

constexpr int D = 2048, SEQ = 2048, NMETA = 16, TT = 2064, NBATCH = 8;
constexpr int MREAL = 16384, METAROW0 = 16384, MVALID = 16400, MROWS = 16640;
constexpr int DIN = 3584, DLRU = 1024, HD = 64;
constexpr int ZQ = 0, ZK = 1024, ZV = 1280, ZX = 1536, ZG = 2560;
constexpr int NEXP = 32, DFF = 2048, PROWS = 73728;
constexpr float EPS = 1e-5f;

constexpr size_t MiB = 1u << 20;
constexpr size_t WS_CTL = 0, CTL_BYTES = 1 * MiB;
constexpr size_t WS_COS = 1 * MiB, WS_SIN = 1 * MiB + 320 * 1024;
constexpr size_t WS_TOPE = 2 * MiB, WS_TOPW = WS_TOPE + 256 * 1024, WS_RSTD2 = WS_TOPW + 256 * 1024, WS_ROWPAIR = WS_RSTD2 + 64 * 1024, WS_ROWW = WS_ROWPAIR + 320 * 1024;
constexpr size_t WS_LRUSUM = 4 * MiB;
constexpr size_t WS_WAT = 9 * MiB, WS_WIT = WS_WAT + 128 * 1024, WS_WRT = WS_WIT + 128 * 1024;
constexpr size_t WS_WINT = 10 * MiB, WS_WOUTT = 24 * MiB, WS_WGT = 32 * MiB, WS_WUT = 288 * MiB, WS_WDT = 544 * MiB;
constexpr size_t WS_N1 = 800 * MiB, WS_Z = 866 * MiB, WS_O = 980 * MiB, WS_H1 = 1044 * MiB, WS_XS = 1172 * MiB, WS_YB = WS_XS, WS_ACT = 1460 * MiB, WS_END = 1748 * MiB;
constexpr size_t WS_XC = WS_XS, WS_AA = WS_XS + 66 * MiB, WS_BB = WS_XS + 132 * MiB, WS_YL = WS_XS + 198 * MiB;
static_assert(WS_ROWW + PROWS * 4 <= WS_LRUSUM, "small map");
constexpr int CW_COUNTS = 1024, CW_CURSOR = 1088, CW_BAR = 4096;

constexpr int LDS_TAB = 131072;
constexpr int LDS_MISC = LDS_TAB + 8192;
constexpr int LDS_BYTES = 147456;

__device__ const float c_inv_freq[32] = {1.000000000e+00f, 7.498942018e-01f, 5.623413324e-01f, 4.216965139e-01f, 3.162277639e-01f, 2.371373922e-01f, 1.778279394e-01f, 1.333521456e-01f, 1.000000015e-01f, 7.498941571e-02f, 5.623412877e-02f, 4.216964915e-02f, 3.162277862e-02f, 2.371373586e-02f, 1.778279431e-02f, 1.333521493e-02f, 9.999999776e-03f, 7.498942316e-03f, 5.623413250e-03f, 4.216964822e-03f, 3.162277862e-03f, 2.371373819e-03f, 1.778279431e-03f, 1.333521446e-03f, 1.000000047e-03f, 7.498941850e-04f, 5.623413017e-04f, 4.216965463e-04f, 3.162277862e-04f, 2.371373848e-04f, 1.778279402e-04f, 1.333521504e-04f};

struct Args { const float* in[27]; float* out; unsigned char* ws; int ph_lo, ph_hi; };
enum { I_X = 0, I_META, I_NORM_MIX, I_W_IN, I_B_IN, I_SINKS, I_CONV_W, I_CONV_B, I_W_A, I_B_A, I_W_I, I_B_I, I_LAMBDA, I_G_ATTN, I_G_LRU, I_W_OUT, I_B_OUT, I_NORM_FFN,
       I_W_ROUTER, I_B_ROUTER, I_W_GATE, I_B_GATE, I_W_UP, I_B_UP, I_W_DOWN, I_B_DOWN, I_FINAL_NORM };


#define XB_TMO      128
#define XB_XCNT(j)  (256  + 64 * (j))
#define XB_XSUB(j)  (1280 + 64 * (j))
#define XB_XGEN(j)  (2304 + 64 * (j))
#define XB_TOP      3328
#define XB_TOPGEN   3392
#define XCD_BAR_WORDS 3456
#define XB_SPIN_CAP (1u << 18)

__device__ __forceinline__ unsigned xb_ld(unsigned* p)              { return __hip_atomic_load(p, __ATOMIC_RELAXED, __HIP_MEMORY_SCOPE_AGENT); }
__device__ __forceinline__ unsigned xb_add(unsigned* p, unsigned v) { return __hip_atomic_fetch_add(p, v, __ATOMIC_RELAXED, __HIP_MEMORY_SCOPE_AGENT); }
__device__ __forceinline__ unsigned xb_xcc_id() { return (unsigned)__builtin_amdgcn_s_getreg((3 << 11) | 20) & 0xFu; }
#define XB_SPIN(cond, bar) do { unsigned _sp = 0; while (cond) { __builtin_amdgcn_s_sleep(1); \
    if ((++_sp & 255u) == 0u) { if (xb_ld(&(bar)[XB_TMO])) break; if (_sp > XB_SPIN_CAP) { atomicAdd(&(bar)[XB_TMO], 1u); break; } } } } while (0)

struct XcdBarrier {
    unsigned* bar; unsigned x;
    volatile LAS unsigned* st;
};

__device__ __forceinline__ XcdBarrier xcd_barrier_post(unsigned* bar, volatile LAS unsigned* st) {
    XcdBarrier b; b.bar = bar; b.x = xb_xcc_id(); b.st = st;
    if (threadIdx.x == 0) (void)xb_add(&bar[XB_XCNT(b.x)], 1u);
    return b;
}
__device__ __forceinline__ void xcd_barrier_complete(unsigned* bar, unsigned x, unsigned& nloc, unsigned& nx) {
    const unsigned G = gridDim.x * gridDim.y * gridDim.z;
    unsigned sum, cnt, mine, sp = 0u;
    for (;;) {
        sum = 0u; cnt = 0u; mine = 0u;
#pragma unroll
        for (unsigned j = 0; j < 16; ++j) { const unsigned c = xb_ld(&bar[XB_XCNT(j)]); sum += c; cnt += (c > 0u) ? 1u : 0u; mine = (j == x) ? c : mine; }
        if (sum == G) break;
        __builtin_amdgcn_s_sleep(1);
        if ((++sp & 255u) == 0u) { if (xb_ld(&bar[XB_TMO])) break; if (sp > XB_SPIN_CAP) { atomicAdd(&bar[XB_TMO], 1u); break; } }
    }
    nloc = mine > 0u ? mine : 1u; nx = cnt > 0u ? cnt : 1u;
}

__device__ __forceinline__ void xcd_barrier(const XcdBarrier& b) {
    asm volatile("s_waitcnt vmcnt(0)" ::: "memory");
    __syncthreads();
    if (threadIdx.x == 0) {
        unsigned* bar = b.bar;
        __builtin_amdgcn_s_waitcnt(0);
        unsigned nloc = b.st[0], nx = b.st[1];
        if (nloc == 0u) { xcd_barrier_complete(bar, b.x, nloc, nx); b.st[0] = nloc; b.st[1] = nx; }
        const unsigned old = xb_add(&bar[XB_XSUB(b.x)], 1u);
        const unsigned gen = old / nloc;
        if (old + 1u == (gen + 1u) * nloc) {
            __builtin_amdgcn_fence(__ATOMIC_RELEASE, "agent");
            asm volatile("s_waitcnt vmcnt(0)" ::: "memory");
            const unsigned og = xb_add(&bar[XB_TOP], 1u);
            const unsigned tg = og / nx;
            if (og + 1u == (tg + 1u) * nx) xb_add(&bar[XB_TOPGEN], 1u);
            else XB_SPIN(xb_ld(&bar[XB_TOPGEN]) == tg, bar);
            __builtin_amdgcn_fence(__ATOMIC_ACQUIRE, "agent");
            xb_add(&bar[XB_XGEN(b.x)], 1u);
            asm volatile("s_waitcnt vmcnt(0)" ::: "memory");
        } else {
            XB_SPIN(xb_ld(&bar[XB_XGEN(b.x)]) == gen, bar);
            __builtin_amdgcn_fence(__ATOMIC_ACQUIRE, "agent");
            asm volatile("s_waitcnt vmcnt(0)" ::: "memory");
        }
    }
    __syncthreads();
}

__device__ __forceinline__ float bf2f(unsigned b) { return __uint_as_float((b & 0xffffu) << 16); }
__device__ __forceinline__ unsigned f2bf(float f) { unsigned u = __float_as_uint(f); return (u + 0x7fffu + ((u >> 16) & 1u)) >> 16; }
__device__ __forceinline__ unsigned pk2(float lo, float hi) { return f2bf(lo) | (f2bf(hi) << 16); }
constexpr float W_SCALE = 256.0f, XS_SCALE = 8.0f, ACT_SCALE = 4.0f;
__device__ __forceinline__ float clamp_fp8(float x) { return fminf(fmaxf(x, -448.0f), 448.0f); }
__device__ __forceinline__ unsigned pk4_fp8(float a, float b, float c, float d) {
    int w = 0; w = __builtin_amdgcn_cvt_pk_fp8_f32(clamp_fp8(a), clamp_fp8(b), w, false); w = __builtin_amdgcn_cvt_pk_fp8_f32(clamp_fp8(c), clamp_fp8(d), w, true); return (unsigned)w; }
__device__ __forceinline__ float wave_sum(float v) {
#pragma unroll
    for (int o = 1; o < 64; o <<= 1) v += __shfl_xor(v, o);
    return v;
}
__device__ __forceinline__ float wave_max(float v) {
#pragma unroll
    for (int o = 1; o < 64; o <<= 1) v = fmaxf(v, __shfl_xor(v, o));
    return v;
}
__device__ __forceinline__ float sigmoidf_(float x) { return 1.0f / (1.0f + __expf(-x)); }
__device__ __forceinline__ float gelu_tanh(float x) { const float u = 0.7978845608028654f * (x + 0.044715f * x * x * x); return 0.5f * x * (1.0f + tanhf(u)); }
__device__ __forceinline__ int tok_row(int b, int t) { return t < NMETA ? METAROW0 + t : b * SEQ + (t - NMETA); }

__device__ __forceinline__ void transpose_item(const float* W, int K, int N, bf16* WT, LAS float* scr, int item, int lane) {
    const int nblk = N / 32, kb = item / nblk, nb = item % nblk, k0 = 64 * kb, n0 = 32 * nb;
#pragma unroll 8
    for (int i = 0; i < 32; ++i) { const int kk = 2 * i + (lane >> 5); scr[kk * 33 + (lane & 31)] = W[(size_t)(k0 + kk) * N + n0 + (lane & 31)]; }
    asm volatile("s_waitcnt lgkmcnt(0)" ::: "memory");
    const int c = lane & 7;
#pragma unroll
    for (int j = 0; j < 4; ++j) { const int n = (lane >> 3) + 8 * j; const LAS float* s = scr + (8 * c) * 33 + n;
        u32x4 o; o.x = pk2(s[0 * 33], s[1 * 33]); o.y = pk2(s[2 * 33], s[3 * 33]); o.z = pk2(s[4 * 33], s[5 * 33]); o.w = pk2(s[6 * 33], s[7 * 33]);
        *(u32x4*)(WT + (size_t)(n0 + n) * K + k0 + 8 * c) = o; }
    asm volatile("s_waitcnt lgkmcnt(0)" ::: "memory");
}

__device__ __forceinline__ void phase_prologue(const Args& a, LAS unsigned char* lds, int tid, int lane, int wave) {
    const int gw = blockIdx.x * 8 + wave, NGW = gridDim.x * 8;
    const int gt = blockIdx.x * 512 + tid, NGT = gridDim.x * 512;
    unsigned char* ws = a.ws;
    LAS float* scr = (LAS float*)(lds + wave * 8704);
    constexpr int IT_IN = 32 * (DIN / 32), IT_OUT = 32 * (D / 32);
    constexpr int NITEMS = IT_IN + IT_OUT;
    for (int it = gw; it < NITEMS; it += NGW) {
        int r = it;
        if (r < IT_IN) { transpose_item(a.in[I_W_IN], D, DIN, (bf16*)(ws + WS_WINT), scr, r, lane); continue; } r -= IT_IN;
        transpose_item(a.in[I_W_OUT], D, D, (bf16*)(ws + WS_WOUTT), scr, r, lane);
    }
    __syncthreads();
    {
        LAS unsigned* T = (LAS unsigned*)lds;
        const int n4 = tid & 63, kq = tid >> 6;
        constexpr int TILES_PER_MAT = (D / 128) * (D / 256);
        for (int tile = blockIdx.x; tile < 96 * TILES_PER_MAT; tile += gridDim.x) {
            const int mat = tile / TILES_PER_MAT, tl = tile % TILES_PER_MAT, which = mat / NEXP, e = mat % NEXP;
            const int k0 = (tl / (D / 256)) * 128, n0 = (tl % (D / 256)) * 256;
            const float* src = a.in[which == 0 ? I_W_GATE : (which == 1 ? I_W_UP : I_W_DOWN)] + (size_t)e * D * D;
            unsigned char* dst = ws + (which == 0 ? WS_WGT : (which == 1 ? WS_WUT : WS_WDT)) + (size_t)e * D * D;
#pragma unroll
            for (int i = 0; i < 4; ++i) {
                const int kk = 4 * (kq + 8 * i);
                const float* p = src + (size_t)(k0 + kk) * D + n0 + 4 * n4;
                const f32x4 r0 = *(const f32x4*)p * W_SCALE, r1 = *(const f32x4*)(p + D) * W_SCALE, r2 = *(const f32x4*)(p + 2 * D) * W_SCALE, r3 = *(const f32x4*)(p + 3 * D) * W_SCALE;
                T[(4 * n4 + 0) * 33 + (kk >> 2)] = pk4_fp8(r0.x, r1.x, r2.x, r3.x);
                T[(4 * n4 + 1) * 33 + (kk >> 2)] = pk4_fp8(r0.y, r1.y, r2.y, r3.y);
                T[(4 * n4 + 2) * 33 + (kk >> 2)] = pk4_fp8(r0.z, r1.z, r2.z, r3.z);
                T[(4 * n4 + 3) * 33 + (kk >> 2)] = pk4_fp8(r0.w, r1.w, r2.w, r3.w);
            }
            __syncthreads();
#pragma unroll
            for (int i = 0; i < 4; ++i) {
                const int n = (tid >> 3) + 64 * i, c = tid & 7;
                const u32x4 o = (u32x4){T[n * 33 + 4 * c], T[n * 33 + 4 * c + 1], T[n * 33 + 4 * c + 2], T[n * 33 + 4 * c + 3]};
                *(u32x4*)(dst + (size_t)(n0 + n) * D + k0 + 16 * c) = o;
            }
            __syncthreads();
        }
    }
    bf16* N1 = (bf16*)(ws + WS_N1);
    for (int r = gw; r < MROWS; r += NGW) {
        u32x2* orow = (u32x2*)(N1 + (size_t)r * D);
        if (r >= MVALID) {
#pragma unroll
            for (int j = 0; j < 8; ++j) orow[lane + 64 * j] = (u32x2){0u, 0u};
            continue; }
        const f32x4* xr = (const f32x4*)(r < MREAL ? a.in[I_X] + (size_t)r * D : a.in[I_META] + (size_t)(r - MREAL) * D);
        f32x4 v[8]; float ss = 0.f;
#pragma unroll
        for (int j = 0; j < 8; ++j) { v[j] = xr[lane + 64 * j]; ss += (v[j].x * v[j].x + v[j].y * v[j].y) + (v[j].z * v[j].z + v[j].w * v[j].w); }
        ss = wave_sum(ss);
        const float rstd = 1.0f / sqrtf(ss * (1.0f / D) + EPS);
#pragma unroll
        for (int j = 0; j < 8; ++j) { const f32x4 g = ((const f32x4*)a.in[I_NORM_MIX])[lane + 64 * j];
            orow[lane + 64 * j] = (u32x2){pk2(v[j].x * rstd * g.x, v[j].y * rstd * g.y), pk2(v[j].z * rstd * g.z, v[j].w * rstd * g.w)}; }
    }
    float* cosT = (float*)(ws + WS_COS); float* sinT = (float*)(ws + WS_SIN);
    for (int i = gt; i < TT * 32; i += NGT) {
        const int pos = i >> 5, j = i & 31;
        const float ang = (float)pos * c_inv_freq[j];
        const double t = (double)ang * 0.15915494309189535; const float fr = (float)(t - floor(t));
        cosT[i] = __builtin_amdgcn_cosf(fr); sinT[i] = __builtin_amdgcn_sinf(fr);
    }
    { bf16* WaT = (bf16*)(ws + WS_WAT); bf16* WiT = (bf16*)(ws + WS_WIT);
      for (int i = gt; i < 16 * 64 * 64; i += NGT) { const int n = i >> 12, d = (i >> 6) & 63, cc = i & 63;
          WaT[i] = (bf16)f2bf(a.in[I_W_A][(n * 64 + cc) * 64 + d]); WiT[i] = (bf16)f2bf(a.in[I_W_I][(n * 64 + cc) * 64 + d]); } }
    { bf16* WRT = (bf16*)(ws + WS_WRT);
      for (int i = gt; i < NEXP * D; i += NGT) { const int e = i >> 11, k = i & 2047; WRT[i] = (bf16)f2bf(a.in[I_NORM_FFN][k] * a.in[I_W_ROUTER][k * NEXP + e]); } }
    int* rowpair = (int*)(ws + WS_ROWPAIR);
    for (int i = gt; i < PROWS; i += NGT) rowpair[i] = -1;
}

template <bool DUAL, class BSel, class Epi>
__device__ __forceinline__ void naive_gemm(const bf16* A, int mt_count, int nt_count, int K, const BSel& bsel, const Epi& epi, int gw, int NGW, int lane) {
    const int fr = lane & 15, fq = lane >> 4;
    for (int tile = gw; tile < mt_count * nt_count; tile += NGW) {
        const int tm = tile / nt_count, tn = tile % nt_count;
        const bf16 *B0, *B1; bsel(tm, B0, B1);
        f32x4 acc[4][4], acc2[4][4];
#pragma unroll
        for (int i = 0; i < 4; ++i)
#pragma unroll
            for (int j = 0; j < 4; ++j) { acc[i][j] = (f32x4){0.f, 0.f, 0.f, 0.f}; acc2[i][j] = (f32x4){0.f, 0.f, 0.f, 0.f}; }
        const bf16* ap = A + (size_t)(tm * 64 + fr) * K + fq * 8;
        const bf16* bp0 = B0 + (size_t)(tn * 64 + fr) * K + fq * 8;
        const bf16* bp1 = B1 + (size_t)(tn * 64 + fr) * K + fq * 8;
        for (int k0 = 0; k0 < K; k0 += 32) {
            bf16x8 af[4], bfr[4];
#pragma unroll
            for (int i = 0; i < 4; ++i) af[i] = *(const bf16x8*)(ap + (size_t)i * 16 * K + k0);
#pragma unroll
            for (int j = 0; j < 4; ++j) bfr[j] = *(const bf16x8*)(bp0 + (size_t)j * 16 * K + k0);
#pragma unroll
            for (int i = 0; i < 4; ++i)
#pragma unroll
                for (int j = 0; j < 4; ++j) acc[i][j] = __builtin_amdgcn_mfma_f32_16x16x32_bf16(af[i], bfr[j], acc[i][j], 0, 0, 0);
            if (DUAL) {
#pragma unroll
                for (int j = 0; j < 4; ++j) bfr[j] = *(const bf16x8*)(bp1 + (size_t)j * 16 * K + k0);
#pragma unroll
                for (int i = 0; i < 4; ++i)
#pragma unroll
                    for (int j = 0; j < 4; ++j) acc2[i][j] = __builtin_amdgcn_mfma_f32_16x16x32_bf16(af[i], bfr[j], acc2[i][j], 0, 0, 0);
            }
        }
#pragma unroll
        for (int i = 0; i < 4; ++i)
#pragma unroll
            for (int j = 0; j < 4; ++j)
#pragma unroll
                for (int r = 0; r < 4; ++r) epi(tm, tm * 64 + i * 16 + fq * 4 + r, tn * 64 + j * 16 + fr, acc[i][j][r], acc2[i][j][r]);
    }
}


namespace pg8 {
constexpr int BM = 256, BK = 64, HALF = 128, HTB = HALF * BK * 2, STAGE_BYTES = 8 * HTB, NXCD = 8, WGM = 8, KD = 2048, NKT = KD / BK;
__host__ __device__ __forceinline__ int lds_byte(int r, int c) { const int st = (r >> 4) * 2 + (c >> 5), rr = r & 15, cc = c & 31, ob = rr * 64 + cc * 2; return st * 1024 + (ob ^ (((ob >> 9) & 1) << 5)); }
__host__ __device__ __forceinline__ void stage_rc(int b, int& R, int& C) { const int st = b / 1024, sb = b % 1024, swz = sb ^ (((sb >> 9) & 1) << 5); R = (st >> 1) * 16 + swz / 64; C = (st & 1) * 32 + (swz % 64) / 2; }
__host__ __device__ __forceinline__ int perm32(int rho) { const int n = rho >> 4, i = rho & 15; return 8 * (i >> 2) + 4 * n + (i & 3); }
struct Unit { const char* a; const char* b0; const char* b1; int pm, pn, e; };
__device__ __forceinline__ bool static_tile(int i, int G, int c, int nM, int nN, int& pm, int& pn) {
    const int nwg = nM * nN; const long L = (long)i * G + c; if (L >= nwg) return false;
    int wgid = (int)L; { const int q = nwg / NXCD, r = nwg % NXCD, xcd = wgid % NXCD, off = wgid / NXCD; wgid = (xcd < r ? xcd * (q + 1) : r * (q + 1) + (xcd - r) * q) + off; }
    const int nig = WGM * nN, gid = wgid / nig, fm = gid * WGM, gsz = (nM - fm) < WGM ? (nM - fm) : WGM;
    pm = fm + ((wgid % nig) % gsz); pn = (wgid % nig) / gsz; return true;
}
__device__ __forceinline__ unsigned cvt_pk_bf16(float lo, float hi) { unsigned r; asm volatile("v_cvt_pk_bf16_f32 %0, %1, %2" : "=v"(r) : "v"(lo), "v"(hi)); return r; }

typedef int i32x8 __attribute__((ext_vector_type(8)));
typedef int i32x4 __attribute__((ext_vector_type(4)));
__device__ __forceinline__ i32x8 cat8(bf16x8 lo, bf16x8 hi) { const i32x4 a = __builtin_bit_cast(i32x4, lo), b = __builtin_bit_cast(i32x4, hi); return __builtin_shufflevector(a, b, 0, 1, 2, 3, 4, 5, 6, 7); }
template <bool FP8, class Epi, class Sched>
__device__ __forceinline__ void gemm_phase(LAS unsigned char* lds, const Sched& S, const Epi& E) {
    constexpr int ROWB = FP8 ? 2048 : 4096, NKTL = ROWB / 128;
    const int tid = threadIdx.x, wid = __builtin_amdgcn_readfirstlane(tid >> 6), lane = tid & 63, wr = wid >> 2, wc = wid & 3, fr = lane & 15, fq = lane >> 4;
    unsigned voffA[2], voffB[2];
#pragma unroll
    for (int i = 0; i < 2; ++i) { int R, C; stage_rc(tid * 16 + i * 8192, R, C); const int Rb = Epi::PERM ? ((R & ~31) + perm32(R & 31)) : R;
        voffA[i] = (unsigned)(R * ROWB + C * 2); voffB[i] = (unsigned)(Rb * ROWB + C * 2); }
    constexpr size_t kstep = (size_t)(BK * 2);
    constexpr size_t hstep = (size_t)HALF * ROWB;
    const unsigned ldsw = (unsigned)wid * 1024u;
    const int aoff = lds_byte(wr * 64 + fr, fq * 8), boff = lds_byte(wc * 32 + fr, fq * 8);
#define PG8_SA(b, h) (((b) * 2 + (h)) * HTB)
#define PG8_SB(b, h) ((4 + (b) * 2 + (h)) * HTB)
#define PG8_STAGE(bufoff, gbase, voff) do { _Pragma("unroll") for (int _i = 0; _i < 2; ++_i) \
        __builtin_amdgcn_global_load_lds((const unsigned*)((const char*)(gbase) + (voff)[_i]), (LAS unsigned*)(lds + (bufoff) + ldsw + _i * 8192), 16, 0, 0); } while (0)
#define PG8_LDA(dst, b, h) do { _Pragma("unroll") for (int m = 0; m < 4; ++m) { \
        if constexpr (FP8) dst##8[m] = __builtin_shufflevector(*(const LAS i32x4*)(lds + PG8_SA(b, h) + aoff + m * 2048), *(const LAS i32x4*)(lds + PG8_SA(b, h) + aoff + m * 2048 + 1024), 0, 1, 2, 3, 4, 5, 6, 7); \
        else { _Pragma("unroll") for (int k = 0; k < 2; ++k) dst[m][k] = *(const LAS bf16x8*)(lds + PG8_SA(b, h) + aoff + m * 2048 + k * 1024); } } } while (0)
#define PG8_LDB(dst, b, h) do { _Pragma("unroll") for (int n = 0; n < 2; ++n) { \
        if constexpr (FP8) dst##8[n] = __builtin_shufflevector(*(const LAS i32x4*)(lds + PG8_SB(b, h) + boff + n * 2048), *(const LAS i32x4*)(lds + PG8_SB(b, h) + boff + n * 2048 + 1024), 0, 1, 2, 3, 4, 5, 6, 7); \
        else { _Pragma("unroll") for (int k = 0; k < 2; ++k) dst[n][k] = *(const LAS bf16x8*)(lds + PG8_SB(b, h) + boff + n * 2048 + k * 1024); } } } while (0)
#define PG8_MMA(ai, bj, At, Bt) do { __builtin_amdgcn_s_setprio(1); _Pragma("unroll") for (int m = 0; m < 4; ++m) _Pragma("unroll") for (int n = 0; n < 2; ++n) { \
        if constexpr (FP8) asm volatile("v_mfma_f32_16x16x128_f8f6f4 %0, %1, %2, %0" : "+v"(acc[ai][bj][m][n]) : "v"(Bt##8[n]), "v"(At##8[m])); \
        else { _Pragma("unroll") for (int k = 0; k < 2; ++k) acc[ai][bj][m][n] = __builtin_amdgcn_mfma_f32_16x16x32_bf16(Bt[n][k], At[m][k], acc[ai][bj][m][n], 0, 0, 0); } } \
        __builtin_amdgcn_s_setprio(0); } while (0)
#define PG8_WAIT_V(n) asm volatile("s_waitcnt vmcnt(" #n ")" ::: "memory")
#define PG8_WAIT_L(n) asm volatile("s_waitcnt lgkmcnt(" #n ")" ::: "memory")
#define PG8_BAR __builtin_amdgcn_s_barrier()
#define PG8_SCHED __builtin_amdgcn_sched_barrier(0)
    Unit cur, nxt; int ui = 0;
    if (!S.next(0, cur)) return;
    f32x4 acc[2][2][4][2];
#pragma unroll
    for (int a = 0; a < 2; ++a)
#pragma unroll
        for (int b = 0; b < 2; ++b)
#pragma unroll
            for (int m = 0; m < 4; ++m)
#pragma unroll
                for (int n = 0; n < 2; ++n) acc[a][b][m][n] = (f32x4){0.f, 0.f, 0.f, 0.f};
    bf16x8 At[4][2], B0[2][2], B1[2][2];
    i32x8 At8[4], B08[2], B18[2];
    PG8_STAGE(PG8_SB(0, 0), cur.b0, voffB); PG8_STAGE(PG8_SB(0, 1), cur.b1, voffB); PG8_STAGE(PG8_SA(0, 0), cur.a, voffA); PG8_STAGE(PG8_SA(0, 1), cur.a + hstep, voffA);
    if (wr == 1) PG8_BAR;
    PG8_WAIT_V(2); PG8_BAR;
    PG8_STAGE(PG8_SB(1, 0), cur.b0 + kstep, voffB); PG8_STAGE(PG8_SA(1, 0), cur.a + kstep, voffA); PG8_STAGE(PG8_SB(1, 1), cur.b1 + kstep, voffB);
    PG8_WAIT_V(6); PG8_BAR;
    for (;;) {
        const bool has_next = S.next(ui + 1, nxt);
        const char* nA = has_next ? nxt.a : cur.a; const char* nB0 = has_next ? nxt.b0 : cur.b0; const char* nB1 = has_next ? nxt.b1 : cur.b1;
        for (int t = 0; t < NKTL; t += 2) {
            const bool last = (t == NKTL - 2);
            const char* a1 = cur.a + (size_t)(t + 1) * kstep;
            const char* a2 = last ? nA : cur.a + (size_t)(t + 2) * kstep;
            const char* b20 = last ? nB0 : cur.b0 + (size_t)(t + 2) * kstep; const char* b21 = last ? nB1 : cur.b1 + (size_t)(t + 2) * kstep;
            const char* a3 = a2 + kstep; const char* b30 = b20 + kstep; const char* b31 = b21 + kstep;
            PG8_LDB(B0, 0, 0); PG8_LDB(B1, 0, 1); PG8_SCHED; PG8_LDA(At, 0, 0); PG8_STAGE(PG8_SA(1, 1), a1 + hstep, voffA);
            PG8_WAIT_V(8); PG8_WAIT_L(0); PG8_BAR; PG8_MMA(0, 0, At, B0); PG8_MMA(0, 1, At, B1); PG8_BAR; PG8_SCHED;
            PG8_LDA(At, 0, 1); PG8_STAGE(PG8_SB(0, 0), b20, voffB); PG8_STAGE(PG8_SB(0, 1), b21, voffB); PG8_STAGE(PG8_SA(0, 0), a2, voffA);
            PG8_WAIT_V(8); PG8_WAIT_L(0); PG8_BAR; PG8_MMA(1, 0, At, B0); PG8_MMA(1, 1, At, B1); PG8_BAR; PG8_SCHED;
            PG8_LDB(B0, 1, 0); PG8_LDB(B1, 1, 1); PG8_SCHED; PG8_LDA(At, 1, 0); PG8_STAGE(PG8_SA(0, 1), a2 + hstep, voffA);
            PG8_WAIT_V(8); PG8_WAIT_L(0); PG8_BAR; PG8_MMA(0, 0, At, B0); PG8_MMA(0, 1, At, B1); PG8_BAR; PG8_SCHED;
            PG8_LDA(At, 1, 1); PG8_STAGE(PG8_SB(1, 0), b30, voffB); PG8_STAGE(PG8_SB(1, 1), b31, voffB); PG8_STAGE(PG8_SA(1, 0), a3, voffA);
            PG8_WAIT_V(8); PG8_WAIT_L(0); PG8_BAR; PG8_MMA(1, 0, At, B0); PG8_MMA(1, 1, At, B1); PG8_BAR; PG8_SCHED;
        }
        if (wr == 0) PG8_BAR;
        if constexpr (FP8) asm volatile("s_nop 15\n\ts_nop 15" ::: "memory");
        E(acc, cur, wr, wc, fr, fq);
        if (!has_next) break;
#pragma unroll
        for (int a = 0; a < 2; ++a)
#pragma unroll
            for (int b = 0; b < 2; ++b)
#pragma unroll
                for (int m = 0; m < 4; ++m)
#pragma unroll
                    for (int n = 0; n < 2; ++n) acc[a][b][m][n] = (f32x4){0.f, 0.f, 0.f, 0.f};
        cur = nxt; ++ui;
        if (wr == 1) PG8_BAR;
    }
    PG8_WAIT_V(0);
    PG8_BAR;
#undef PG8_SA
#undef PG8_SB
#undef PG8_STAGE
#undef PG8_LDA
#undef PG8_LDB
#undef PG8_MMA
#undef PG8_WAIT_V
#undef PG8_WAIT_L
#undef PG8_BAR
#undef PG8_SCHED
}

struct SchedDense {
    const char* A; const char* Bt; int nM, nN, G, c;
    __device__ __forceinline__ bool next(int i, Unit& u) const {
        int pm, pn; if (!static_tile(i, G, c, nM, nN, pm, pn)) return false;
        u.pm = pm; u.pn = pn; u.e = 0; u.a = A + (size_t)pm * (BM * 4096); u.b0 = Bt + (size_t)pn * (BM * 4096); u.b1 = u.b0 + (size_t)HALF * 4096; return true;
    }
};
struct SchedMoE {
    const char* A; const char* B0; const char* B1; const LAS int* tstart; int nM, nN, G, c; bool split;
    __device__ __forceinline__ bool next(int i, Unit& u) const {
        int pm, pn; if (!static_tile(i, G, c, nM, nN, pm, pn)) return false;
        int e = 0;
#pragma unroll 1
        for (int q = 1; q < 32; ++q) e += (tstart[q] <= pm) ? 1 : 0;
        u.pm = pm; u.pn = pn; u.e = e; u.a = A + (size_t)pm * (BM * 2048);
        const size_t eoff = (size_t)e * ((size_t)2048 * 2048);
        if (split) { u.b0 = B0 + eoff + (size_t)pn * (HALF * 2048); u.b1 = B1 + eoff + (size_t)pn * (HALF * 2048); }
        else { u.b0 = B0 + eoff + (size_t)pn * (BM * 2048); u.b1 = u.b0 + (size_t)HALF * 2048; }
        return true;
    }
};

struct EpiZ {
    static constexpr bool PERM = true;
    bf16* Z; const float* bias;
    __device__ __forceinline__ void operator()(const f32x4 (&acc)[2][2][4][2], const Unit& u, int wr, int wc, int fr, int fq) const {
        const int row0 = u.pm * BM + wr * 64 + fr, col0 = u.pn * BM + wc * 32 + 8 * fq;
        f32x4 bv[2][2];
#pragma unroll
        for (int bj = 0; bj < 2; ++bj)
#pragma unroll
            for (int n = 0; n < 2; ++n) bv[bj][n] = *(const f32x4*)(bias + col0 + bj * HALF + 4 * n);
#pragma unroll
        for (int ai = 0; ai < 2; ++ai)
#pragma unroll
            for (int m = 0; m < 4; ++m) { bf16* rowp = Z + (size_t)(row0 + ai * HALF + m * 16) * DIN + col0;
#pragma unroll
                for (int bj = 0; bj < 2; ++bj) { const f32x4 v0 = acc[ai][bj][m][0] + bv[bj][0], v1 = acc[ai][bj][m][1] + bv[bj][1];
                    u32x4 w; w.x = cvt_pk_bf16(v0[0], v0[1]); w.y = cvt_pk_bf16(v0[2], v0[3]); w.z = cvt_pk_bf16(v1[0], v1[1]); w.w = cvt_pk_bf16(v1[2], v1[3]);
                    *(u32x4*)(rowp + bj * HALF) = w; } }
    }
};
struct EpiH1 {
    static constexpr bool PERM = false;
    float* H1; const float* x; const float* bias;
    __device__ __forceinline__ void operator()(const f32x4 (&acc)[2][2][4][2], const Unit& u, int wr, int wc, int fr, int fq) const {
        const int row0 = u.pm * BM + wr * 64 + fr, col0 = u.pn * BM + wc * 32 + 4 * fq;
        f32x4 bv[2][2];
#pragma unroll
        for (int bj = 0; bj < 2; ++bj)
#pragma unroll
            for (int n = 0; n < 2; ++n) bv[bj][n] = *(const f32x4*)(bias + col0 + bj * HALF + n * 16);
#pragma unroll
        for (int ai = 0; ai < 2; ++ai)
#pragma unroll
            for (int m = 0; m < 4; ++m) { const size_t ro = (size_t)(row0 + ai * HALF + m * 16) * D + col0;
#pragma unroll
                for (int bj = 0; bj < 2; ++bj)
#pragma unroll
                    for (int n = 0; n < 2; ++n) *(f32x4*)(H1 + ro + bj * HALF + n * 16) = *(const f32x4*)(x + ro + bj * HALF + n * 16) + acc[ai][bj][m][n] + bv[bj][n]; }
    }
};
struct EpiAct {
    static constexpr bool PERM = true;
    unsigned char* ACT; const float* bg; const float* bu;
    __device__ __forceinline__ void operator()(const f32x4 (&acc)[2][2][4][2], const Unit& u, int wr, int wc, int fr, int fq) const {
        const int row0 = u.pm * BM + wr * 64 + fr, col0 = u.pn * HALF + wc * 32 + 8 * fq;
        f32x4 gv[2], uv[2];
#pragma unroll
        for (int n = 0; n < 2; ++n) { gv[n] = *(const f32x4*)(bg + (size_t)u.e * DFF + col0 + 4 * n); uv[n] = *(const f32x4*)(bu + (size_t)u.e * DFF + col0 + 4 * n); }
#pragma unroll
        for (int ai = 0; ai < 2; ++ai)
#pragma unroll
            for (int m = 0; m < 4; ++m) { float r[8];
#pragma unroll
                for (int n = 0; n < 2; ++n)
#pragma unroll
                    for (int j = 0; j < 4; ++j) { float g = acc[ai][0][m][n][j] * (1.0f / (W_SCALE * XS_SCALE)) + gv[n][j], up = acc[ai][1][m][n][j] * (1.0f / (W_SCALE * XS_SCALE)) + uv[n][j];
                        g = fminf(g, 7.0f); up = fminf(fmaxf(up, -7.0f), 7.0f);
                        r[n * 4 + j] = ACT_SCALE * g * (1.0f / (1.0f + __expf(-1.702f * g))) * (up + 1.0f); }
                *(u32x2*)(ACT + (size_t)(row0 + ai * HALF + m * 16) * DFF + col0) = (u32x2){pk4_fp8(r[0], r[1], r[2], r[3]), pk4_fp8(r[4], r[5], r[6], r[7])}; }
    }
};
struct EpiDown {
    static constexpr bool PERM = true;
    bf16* YB; const float* bd; const int* rowpair; const float* roww;
    __device__ __forceinline__ void operator()(const f32x4 (&acc)[2][2][4][2], const Unit& u, int wr, int wc, int fr, int fq) const {
        const int row0 = u.pm * BM + wr * 64 + fr, col0 = u.pn * BM + wc * 32 + 8 * fq;
        f32x4 bv[2][2];
#pragma unroll
        for (int bj = 0; bj < 2; ++bj)
#pragma unroll
            for (int n = 0; n < 2; ++n) bv[bj][n] = *(const f32x4*)(bd + (size_t)u.e * D + col0 + bj * HALF + 4 * n);
#pragma unroll
        for (int ai = 0; ai < 2; ++ai)
#pragma unroll
            for (int m = 0; m < 4; ++m) { const int row = row0 + ai * HALF + m * 16; const int pair = rowpair[row]; const float wt = roww[row];
                if (pair >= 0) { bf16* rowp = YB + (size_t)pair * D + col0;
#pragma unroll
                    for (int bj = 0; bj < 2; ++bj) { const f32x4 v0 = (acc[ai][bj][m][0] * (1.0f / (W_SCALE * ACT_SCALE)) + bv[bj][0]) * wt, v1 = (acc[ai][bj][m][1] * (1.0f / (W_SCALE * ACT_SCALE)) + bv[bj][1]) * wt;
                        u32x4 w; w.x = cvt_pk_bf16(v0[0], v0[1]); w.y = cvt_pk_bf16(v0[2], v0[3]); w.z = cvt_pk_bf16(v1[0], v1[1]); w.w = cvt_pk_bf16(v1[2], v1[3]);
                        *(u32x4*)(rowp + bj * HALF) = w; } } }
    }
};
}


typedef float f32x16 __attribute__((ext_vector_type(16)));
constexpr int AT_KS = 144, AT_VS = 584, AT_KOFF = 0, AT_VOFF = 288 * AT_KS;
__device__ __forceinline__ float bflo(unsigned w) { return __uint_as_float(w << 16); }
__device__ __forceinline__ float bfhi(unsigned w) { return __uint_as_float(w & 0xffff0000u); }

__device__ __forceinline__ void attn_tile(LAS unsigned char* lds, int slot_base, int kind, int j, int lane, int hq,
                                          const bf16x8 (&qf)[2][4], f32x16 (&oacc)[2][2], float (&mrow)[2], float (&lrow)[2]) {
    const int r31 = lane & 31, h = lane >> 5;
    bf16x8 kf[4], vf[2][2];
#pragma unroll
    for (int ks = 0; ks < 4; ++ks) kf[ks] = *(const LAS bf16x8*)(lds + AT_KOFF + (slot_base + r31) * AT_KS + (16 * ks + 8 * h) * 2);
#pragma unroll
    for (int dt = 0; dt < 2; ++dt)
#pragma unroll
        for (int sp = 0; sp < 2; ++sp) { const LAS unsigned char* p = lds + AT_VOFF + (32 * dt + r31) * AT_VS + (slot_base + 16 * sp + 4 * h) * 2;
            const u32x2 lo = *(const LAS u32x2*)p, hi = *(const LAS u32x2*)(p + 16);
            const u32x4 w = (u32x4){lo.x, lo.y, hi.x, hi.y}; vf[dt][sp] = __builtin_bit_cast(bf16x8, w); }
#pragma unroll
    for (int qt = 0; qt < 2; ++qt) {
        f32x16 s;
#pragma unroll
        for (int r = 0; r < 16; ++r) s[r] = 0.f;
#pragma unroll
        for (int ks = 0; ks < 4; ++ks) s = __builtin_amdgcn_mfma_f32_32x32x16_bf16(kf[ks], qf[qt][ks], s, 0, 0, 0);
        const int i = 64 * hq + 32 * qt + r31;
        float mx = -1.0e30f;
#pragma unroll
        for (int r = 0; r < 16; ++r) { const int key = (r & 3) + 8 * (r >> 2) + 4 * h;
            const bool ok = kind == 0 ? (key < 16) : (kind == 1 ? (32 * j + key >= i + 1) : (32 * j + key <= i));
            s[r] = ok ? s[r] : -1.0e30f; mx = fmaxf(mx, s[r]); }
        mx = fmaxf(mx, __shfl_xor(mx, 32));
        const float mn = fmaxf(mrow[qt], mx), al = __expf(mrow[qt] - mn); mrow[qt] = mn;
        float ps = 0.f;
#pragma unroll
        for (int r = 0; r < 16; ++r) { s[r] = __expf(s[r] - mn); ps += s[r]; }
        lrow[qt] = lrow[qt] * al + ps;
#pragma unroll
        for (int dt = 0; dt < 2; ++dt)
#pragma unroll
            for (int r = 0; r < 16; ++r) oacc[qt][dt][r] *= al;
        bf16x8 pf[2];
#pragma unroll
        for (int sp = 0; sp < 2; ++sp) { const u32x4 w = (u32x4){pk2(s[8 * sp + 0], s[8 * sp + 1]), pk2(s[8 * sp + 2], s[8 * sp + 3]), pk2(s[8 * sp + 4], s[8 * sp + 5]), pk2(s[8 * sp + 6], s[8 * sp + 7])};
            pf[sp] = __builtin_bit_cast(bf16x8, w); }
#pragma unroll
        for (int dt = 0; dt < 2; ++dt)
#pragma unroll
            for (int sp = 0; sp < 2; ++sp) oacc[qt][dt] = __builtin_amdgcn_mfma_f32_32x32x16_bf16(vf[dt][sp], pf[sp], oacc[qt][dt], 0, 0, 0);
    }
}

__device__ __forceinline__ void attn_item(const Args& a, LAS unsigned char* lds, int item, int tid, int lane, int wave) {
    const int kvh = item & 3, qblk = (item >> 2) & 15, b = item >> 6;
    const bf16* Z = (const bf16*)(a.ws + WS_Z); bf16* O = (bf16*)(a.ws + WS_O);
    const float* cosT = (const float*)(a.ws + WS_COS); const float* sinT = (const float*)(a.ws + WS_SIN);
    __syncthreads();
    for (int task = tid; task < 288 * 4; task += 512) {
        const int slot = task >> 2, c = task & 3;
        int krow, kpos; bool valid;
        if (slot < 32) { valid = slot < NMETA; krow = METAROW0 + slot; kpos = slot; }
        else { const int sp = 128 * (qblk - 1) + (slot - 32); valid = sp >= 0; krow = b * SEQ + sp; kpos = NMETA + sp; }
        u32x4 lo = (u32x4){0u, 0u, 0u, 0u}, hi = lo;
        if (valid) {
            const bf16* kp = Z + (size_t)krow * DIN + ZK + kvh * 64 + c * 8;
            const u32x4 x1 = *(const u32x4*)kp, x2 = *(const u32x4*)(kp + 32);
            const f32x4 c0 = *(const f32x4*)(cosT + kpos * 32 + c * 8), c1 = *(const f32x4*)(cosT + kpos * 32 + c * 8 + 4);
            const f32x4 s0 = *(const f32x4*)(sinT + kpos * 32 + c * 8), s1 = *(const f32x4*)(sinT + kpos * 32 + c * 8 + 4);
#pragma unroll
            for (int q = 0; q < 4; ++q) { const float ca = q < 2 ? c0[2 * q] : c1[2 * q - 4], cb = q < 2 ? c0[2 * q + 1] : c1[2 * q - 3], sa = q < 2 ? s0[2 * q] : s1[2 * q - 4], sb = q < 2 ? s0[2 * q + 1] : s1[2 * q - 3];
                const float a0 = bflo(x1[q]), a1 = bfhi(x1[q]), b0 = bflo(x2[q]), b1 = bfhi(x2[q]);
                lo[q] = pk2(a0 * ca - b0 * sa, a1 * cb - b1 * sb); hi[q] = pk2(b0 * ca + a0 * sa, b1 * cb + a1 * sb); }
        }
        *(LAS u32x4*)(lds + AT_KOFF + slot * AT_KS + c * 16) = lo; *(LAS u32x4*)(lds + AT_KOFF + slot * AT_KS + 64 + c * 16) = hi;
    }
    for (int task = tid; task < 144 * 8; task += 512) {
        const int slot0 = (task >> 3) * 2, c = task & 7;
        int vrow; bool valid;
        if (slot0 < 32) { valid = slot0 < NMETA; vrow = METAROW0 + slot0; }
        else { const int sp = 128 * (qblk - 1) + (slot0 - 32); valid = sp >= 0; vrow = b * SEQ + sp; }
        u32x4 v0 = (u32x4){0u, 0u, 0u, 0u}, v1 = v0;
        if (valid) { const bf16* vp = Z + (size_t)vrow * DIN + ZV + kvh * 64 + c * 8; v0 = *(const u32x4*)vp; v1 = *(const u32x4*)(vp + DIN); }
#pragma unroll
        for (int q = 0; q < 4; ++q) {
            *(LAS unsigned*)(lds + AT_VOFF + (c * 8 + 2 * q) * AT_VS + slot0 * 2) = (v0[q] & 0xffffu) | (v1[q] << 16);
            *(LAS unsigned*)(lds + AT_VOFF + (c * 8 + 2 * q + 1) * AT_VS + slot0 * 2) = (v0[q] >> 16) | (v1[q] & 0xffff0000u); }
    }
    const int g = wave >> 1, hq = wave & 1, head = kvh * 4 + g, r31 = lane & 31, h = lane >> 5;
    bf16x8 qf[2][4];
#pragma unroll
    for (int qt = 0; qt < 2; ++qt) {
        const int s = 128 * qblk + 64 * hq + 32 * qt + r31, pos = NMETA + s;
        const bf16* qp = Z + (size_t)(b * SEQ + s) * DIN + ZQ + head * 64 + 8 * h;
        u32x4 x[4];
#pragma unroll
        for (int ks = 0; ks < 4; ++ks) x[ks] = *(const u32x4*)(qp + 16 * ks);
#pragma unroll
        for (int ks = 0; ks < 2; ++ks) {
            const float* cp = cosT + pos * 32 + 16 * ks + 8 * h; const float* sp = sinT + pos * 32 + 16 * ks + 8 * h;
            const f32x4 c0 = *(const f32x4*)cp, c1 = *(const f32x4*)(cp + 4), s0 = *(const f32x4*)sp, s1 = *(const f32x4*)(sp + 4);
            u32x4 lo, hi;
#pragma unroll
            for (int q = 0; q < 4; ++q) { const float ca = q < 2 ? c0[2 * q] : c1[2 * q - 4], cb = q < 2 ? c0[2 * q + 1] : c1[2 * q - 3], sa = q < 2 ? s0[2 * q] : s1[2 * q - 4], sb = q < 2 ? s0[2 * q + 1] : s1[2 * q - 3];
                const float a0 = bflo(x[ks][q]), a1 = bfhi(x[ks][q]), b0 = bflo(x[ks + 2][q]), b1 = bfhi(x[ks + 2][q]);
                lo[q] = pk2(0.125f * (a0 * ca - b0 * sa), 0.125f * (a1 * cb - b1 * sb)); hi[q] = pk2(0.125f * (b0 * ca + a0 * sa), 0.125f * (b1 * cb + a1 * sb)); }
            qf[qt][ks] = __builtin_bit_cast(bf16x8, lo); qf[qt][ks + 2] = __builtin_bit_cast(bf16x8, hi);
        }
    }
    f32x16 oacc[2][2]; float mrow[2], lrow[2];
#pragma unroll
    for (int qt = 0; qt < 2; ++qt) { mrow[qt] = a.in[I_SINKS][head]; lrow[qt] = h == 0 ? 1.0f : 0.0f;
#pragma unroll
        for (int dt = 0; dt < 2; ++dt)
#pragma unroll
            for (int r = 0; r < 16; ++r) oacc[qt][dt][r] = 0.f; }
    __syncthreads();
    attn_tile(lds, 0, 0, 0, lane, hq, qf, oacc, mrow, lrow);
    if (qblk > 0) {
#pragma unroll 1
        for (int j = hq ? 2 : 0; j < 4; ++j) attn_tile(lds, 32 + 32 * j, 1, j, lane, hq, qf, oacc, mrow, lrow);
    }
#pragma unroll 1
    for (int j = 0; j < (hq ? 4 : 2); ++j) attn_tile(lds, 160 + 32 * j, 2, j, lane, hq, qf, oacc, mrow, lrow);
#pragma unroll
    for (int qt = 0; qt < 2; ++qt) {
        const float lt = lrow[qt] + __shfl_xor(lrow[qt], 32), inv = 1.0f / lt;
        bf16* op = O + (size_t)(b * SEQ + 128 * qblk + 64 * hq + 32 * qt + r31) * D + head * 64 + 4 * h;
#pragma unroll
        for (int dt = 0; dt < 2; ++dt)
#pragma unroll
            for (int rr = 0; rr < 4; ++rr)
                *(u32x2*)(op + 32 * dt + 8 * rr) = (u32x2){pk2(oacc[qt][dt][4 * rr] * inv, oacc[qt][dt][4 * rr + 1] * inv), pk2(oacc[qt][dt][4 * rr + 2] * inv, oacc[qt][dt][4 * rr + 3] * inv)};
    }
}

constexpr int LR_XS = 2064;
template <int PASS>
__device__ __forceinline__ void lru_item(const Args& a, LAS unsigned char* lds, int item, int tid, int lane, int wave) {
    const int b = item / 65, c = item % 65; const bool meta = (c == 64);
    const bf16* Z = (const bf16*)(a.ws + WS_Z);
    float* sumA = (float*)(a.ws + WS_LRUSUM); float* sumB = sumA + NBATCH * 64 * DLRU; float* metaB = sumB + NBATCH * 64 * DLRU;
    __syncthreads();
    for (int task = tid; task < 32 * 128; task += 512) {
        const int tl = task >> 7, ch0 = (task & 127) * 8;
        const int t = meta ? tl : NMETA + 32 * c + tl;
        float acc[8];
        { const f32x4 b0 = *(const f32x4*)(a.in[I_CONV_B] + ch0), b1 = *(const f32x4*)(a.in[I_CONV_B] + ch0 + 4);
          acc[0] = b0.x; acc[1] = b0.y; acc[2] = b0.z; acc[3] = b0.w; acc[4] = b1.x; acc[5] = b1.y; acc[6] = b1.z; acc[7] = b1.w; }
        const bool live = !(meta && tl >= NMETA);
#pragma unroll
        for (int jj = 0; jj < 4; ++jj) { const int tt = t - 3 + jj;
            if (live && tt >= 0) { const u32x4 x = *(const u32x4*)(Z + (size_t)tok_row(b, tt) * DIN + ZX + ch0);
                const f32x4 w0 = *(const f32x4*)(a.in[I_CONV_W] + jj * DLRU + ch0), w1 = *(const f32x4*)(a.in[I_CONV_W] + jj * DLRU + ch0 + 4);
                acc[0] += w0.x * bflo(x[0]); acc[1] += w0.y * bfhi(x[0]); acc[2] += w0.z * bflo(x[1]); acc[3] += w0.w * bfhi(x[1]);
                acc[4] += w1.x * bflo(x[2]); acc[5] += w1.y * bfhi(x[2]); acc[6] += w1.z * bflo(x[3]); acc[7] += w1.w * bfhi(x[3]); } }
        u32x4 o = (u32x4){0u, 0u, 0u, 0u};
        if (live) o = (u32x4){pk2(acc[0], acc[1]), pk2(acc[2], acc[3]), pk2(acc[4], acc[5]), pk2(acc[6], acc[7])};
        *(LAS u32x4*)(lds + tl * LR_XS + ch0 * 2) = o;
    }
    __syncthreads();
    const bf16* WaT = (const bf16*)(a.ws + WS_WAT); const bf16* WiT = (const bf16*)(a.ws + WS_WIT);
    const int r31 = lane & 31, h = lane >> 5;
    const int tau = 16 * ((r31 >> 2) & 1) + 4 * (r31 >> 3) + (r31 & 3);
#pragma unroll 1
    for (int nb = 0; nb < 2; ++nb) {
        const int n = 2 * wave + nb;
        bf16x8 af[4];
#pragma unroll
        for (int ks = 0; ks < 4; ++ks) af[ks] = *(const LAS bf16x8*)(lds + tau * LR_XS + (64 * n + 16 * ks + 8 * h) * 2);
#pragma unroll 1
        for (int nt = 0; nt < 2; ++nt) {
            const int ch = 64 * n + 32 * nt + r31;
            f32x16 accR, accI;
#pragma unroll
            for (int r = 0; r < 16; ++r) { accR[r] = 0.f; accI[r] = 0.f; }
#pragma unroll
            for (int ks = 0; ks < 4; ++ks) {
                const bf16x8 wa = *(const bf16x8*)(WaT + ((size_t)(n * 64 + 32 * nt + r31) * 64 + 16 * ks + 8 * h));
                const bf16x8 wi = *(const bf16x8*)(WiT + ((size_t)(n * 64 + 32 * nt + r31) * 64 + 16 * ks + 8 * h));
                accR = __builtin_amdgcn_mfma_f32_32x32x16_bf16(af[ks], wa, accR, 0, 0, 0);
                accI = __builtin_amdgcn_mfma_f32_32x32x16_bf16(af[ks], wi, accI, 0, 0, 0);
            }
            const float ba = a.in[I_B_A][ch], bi = a.in[I_B_I][ch], sp = log1pf(__expf(-a.in[I_LAMBDA][ch]));
            float av[16], bv[16];
            float Ap = 1.0f, Bp = 0.0f;
#pragma unroll
            for (int r = 0; r < 16; ++r) {
                const float xcv = bf2f(*(const LAS unsigned short*)(lds + (16 * h + r) * LR_XS + ch * 2));
                const float rg = sigmoidf_(accR[r] + ba), ig = sigmoidf_(accI[r] + bi);
                const float log_a = -8.0f * rg * sp;
                av[r] = __expf(log_a); bv[r] = sqrtf(-expm1f(2.0f * log_a)) * ig * xcv;
                Ap *= av[r]; Bp = av[r] * Bp + bv[r];
            }
            const float Ao = __shfl_xor(Ap, 32), Bo = __shfl_xor(Bp, 32);
            if (PASS == 0) {
                if (h == 0) {
                    if (meta) metaB[ch] = Bp;
                    else { sumA[((size_t)b * 64 + c) * DLRU + ch] = Ap * Ao; sumB[((size_t)b * 64 + c) * DLRU + ch] = Ao * Bp + Bo; }
                }
            } else {
                float hin = metaB[ch];
                for (int jc = 0; jc < c; ++jc) hin = sumA[((size_t)b * 64 + jc) * DLRU + ch] * hin + sumB[((size_t)b * 64 + jc) * DLRU + ch];
                float hs = h == 0 ? hin : (Ao * hin + Bo);
#pragma unroll
                for (int r = 0; r < 16; ++r) {
                    hs = av[r] * hs + bv[r];
                    const int tl = 16 * h + r;
                    const float gt = bf2f(Z[(size_t)(b * SEQ + 32 * c + tl) * DIN + ZG + ch]);
                    *(LAS unsigned short*)(lds + tl * LR_XS + ch * 2) = (unsigned short)f2bf(hs * gelu_tanh(gt));
                }
            }
        }
    }
    if (PASS == 1) {
        __syncthreads();
        bf16* O = (bf16*)(a.ws + WS_O);
#pragma unroll 1
        for (int q = 0; q < 4; ++q) {
            const int tl = 4 * wave + q; const size_t row = (size_t)b * SEQ + 32 * c + tl;
            u32x4 w[2]; float v[16]; float ss = 0.f;
#pragma unroll
            for (int jj = 0; jj < 2; ++jj) { w[jj] = *(const LAS u32x4*)(lds + tl * LR_XS + (lane + 64 * jj) * 16);
#pragma unroll
                for (int k = 0; k < 4; ++k) { v[jj * 8 + 2 * k] = bflo(w[jj][k]); v[jj * 8 + 2 * k + 1] = bfhi(w[jj][k]); } }
#pragma unroll
            for (int k = 0; k < 16; ++k) ss += v[k] * v[k];
            ss = wave_sum(ss);
            float rstd = 1.0f / sqrtf(ss * (1.0f / 1024.0f) + EPS);
#pragma unroll
            for (int jj = 0; jj < 2; ++jj) { const float* gp = a.in[I_G_LRU] + (lane + 64 * jj) * 8; const f32x4 g0 = *(const f32x4*)gp, g1 = *(const f32x4*)(gp + 4);
                const u32x4 o = (u32x4){pk2(v[jj * 8 + 0] * rstd * g0.x, v[jj * 8 + 1] * rstd * g0.y), pk2(v[jj * 8 + 2] * rstd * g0.z, v[jj * 8 + 3] * rstd * g0.w),
                                        pk2(v[jj * 8 + 4] * rstd * g1.x, v[jj * 8 + 5] * rstd * g1.y), pk2(v[jj * 8 + 6] * rstd * g1.z, v[jj * 8 + 7] * rstd * g1.w)};
                *(u32x4*)(O + row * D + 1024 + (lane + 64 * jj) * 8) = o; }
            ss = 0.f;
#pragma unroll
            for (int jj = 0; jj < 2; ++jj) { w[jj] = *(const u32x4*)(O + row * D + (lane + 64 * jj) * 8);
#pragma unroll
                for (int k = 0; k < 4; ++k) { v[jj * 8 + 2 * k] = bflo(w[jj][k]); v[jj * 8 + 2 * k + 1] = bfhi(w[jj][k]); } }
#pragma unroll
            for (int k = 0; k < 16; ++k) ss += v[k] * v[k];
            ss = wave_sum(ss);
            rstd = 1.0f / sqrtf(ss * (1.0f / 1024.0f) + EPS);
#pragma unroll
            for (int jj = 0; jj < 2; ++jj) { const float* gp = a.in[I_G_ATTN] + (lane + 64 * jj) * 8; const f32x4 g0 = *(const f32x4*)gp, g1 = *(const f32x4*)(gp + 4);
                const u32x4 o = (u32x4){pk2(v[jj * 8 + 0] * rstd * g0.x, v[jj * 8 + 1] * rstd * g0.y), pk2(v[jj * 8 + 2] * rstd * g0.z, v[jj * 8 + 3] * rstd * g0.w),
                                        pk2(v[jj * 8 + 4] * rstd * g1.x, v[jj * 8 + 5] * rstd * g1.y), pk2(v[jj * 8 + 6] * rstd * g1.z, v[jj * 8 + 7] * rstd * g1.w)};
                *(u32x4*)(O + row * D + (lane + 64 * jj) * 8) = o; }
        }
    }
}

__device__ __forceinline__ void phase_attn_naive(const Args& a, int lane, int wave) {
    const int gw = blockIdx.x * 8 + wave, NGW = gridDim.x * 8;
    const bf16* Z = (const bf16*)(a.ws + WS_Z); bf16* O = (bf16*)(a.ws + WS_O);
    const float* cosT = (const float*)(a.ws + WS_COS); const float* sinT = (const float*)(a.ws + WS_SIN);
    const int j = lane & 31;
    for (int it = gw; it < MREAL * 16; it += NGW) {
        const int head = it & 15, row = it >> 4, b = row >> 11, s = row & 2047, t = NMETA + s, kvh = head >> 2;
        const float qv = bf2f(Z[(size_t)row * DIN + ZQ + head * 64 + lane]);
        const float qo = __shfl_xor(qv, 32);
        float c = cosT[t * 32 + j], sn = sinT[t * 32 + j];
        const float q = 0.125f * (lane < 32 ? qv * c - qo * sn : qv * c + qo * sn);
        float m = a.in[I_SINKS][head], l = 1.f, o = 0.f;
        const int nk = NMETA + (s + 1 < 128 ? s + 1 : 128);
        for (int kk = 0; kk < nk; ++kk) {
            int krow, kpos;
            if (kk < NMETA) { krow = METAROW0 + kk; kpos = kk; } else { const int sp = s - (kk - NMETA); krow = b * SEQ + sp; kpos = NMETA + sp; }
            const float kv = bf2f(Z[(size_t)krow * DIN + ZK + kvh * 64 + lane]);
            const float ko = __shfl_xor(kv, 32);
            c = cosT[kpos * 32 + j]; sn = sinT[kpos * 32 + j];
            const float kr = lane < 32 ? kv * c - ko * sn : kv * c + ko * sn;
            const float sc = wave_sum(q * kr);
            const float mn = fmaxf(m, sc), al = __expf(m - mn), p = __expf(sc - mn);
            const float vv = bf2f(Z[(size_t)krow * DIN + ZV + kvh * 64 + lane]);
            l = l * al + p; o = o * al + p * vv; m = mn;
        }
        O[(size_t)row * D + head * 64 + lane] = (bf16)f2bf(o / l);
    }
}

__device__ __forceinline__ void phase_lru_xc(const Args& a, int tid) {
    const int gt = blockIdx.x * 512 + tid, NGT = gridDim.x * 512;
    const bf16* Z = (const bf16*)(a.ws + WS_Z); float* XC = (float*)(a.ws + WS_XC);
    for (int idx = gt; idx < MVALID * DLRU; idx += NGT) {
        const int row = idx >> 10, c = idx & 1023;
        const int b = row < MREAL ? (row >> 11) : 0, t = row < MREAL ? NMETA + (row & 2047) : row - MREAL;
        float acc = a.in[I_CONV_B][c];
#pragma unroll
        for (int jj = 0; jj < 4; ++jj) { const int tt = t - 3 + jj;
            if (tt >= 0) acc += a.in[I_CONV_W][jj * DLRU + c] * bf2f(Z[(size_t)tok_row(b, tt) * DIN + ZX + c]); }
        XC[idx] = acc;
    }
}
__device__ __forceinline__ void phase_lru_gates(const Args& a, int tid) {
    const int gt = blockIdx.x * 512 + tid, NGT = gridDim.x * 512;
    const float* XC = (const float*)(a.ws + WS_XC); float* AA = (float*)(a.ws + WS_AA); float* BB = (float*)(a.ws + WS_BB);
    for (int idx = gt; idx < MVALID * DLRU; idx += NGT) {
        const int row = idx >> 10, c = idx & 1023, n = c >> 6, d = c & 63;
        float ra = a.in[I_B_A][c], ri = a.in[I_B_I][c];
        const float* xr = XC + (size_t)row * DLRU + n * 64;
        const float* wa = a.in[I_W_A] + (size_t)n * 4096 + d; const float* wi = a.in[I_W_I] + (size_t)n * 4096 + d;
        for (int cc = 0; cc < 64; ++cc) { const float xv = xr[cc]; ra += xv * wa[cc * 64]; ri += xv * wi[cc * 64]; }
        const float r = sigmoidf_(ra), ig = sigmoidf_(ri);
        const float sp = log1pf(expf(-a.in[I_LAMBDA][c]));
        const float log_a = -8.0f * r * sp;
        AA[idx] = expf(log_a);
        BB[idx] = sqrtf(-expm1f(2.0f * log_a)) * ig * XC[idx];
    }
}
__device__ __forceinline__ void phase_lru_scan(const Args& a, int tid) {
    const int gt = blockIdx.x * 512 + tid;
    if (gt >= NBATCH * DLRU) return;
    const int b = gt >> 10, c = gt & 1023;
    const float* AA = (const float*)(a.ws + WS_AA); const float* BB = (const float*)(a.ws + WS_BB); float* YL = (float*)(a.ws + WS_YL);
    const bf16* Z = (const bf16*)(a.ws + WS_Z);
    float h = 0.f;
    for (int t = 0; t < NMETA; ++t) { const int row = METAROW0 + t; h = AA[(size_t)row * DLRU + c] * h + BB[(size_t)row * DLRU + c]; }
#pragma unroll 8
    for (int s = 0; s < SEQ; ++s) { const size_t row = (size_t)b * SEQ + s;
        h = AA[row * DLRU + c] * h + BB[row * DLRU + c];
        YL[row * DLRU + c] = h * gelu_tanh(bf2f(Z[row * DIN + ZG + c])); }
}
__device__ __forceinline__ void phase_norm_o(const Args& a, int lane, int wave) {
    const int gw = blockIdx.x * 8 + wave, NGW = gridDim.x * 8;
    bf16* O = (bf16*)(a.ws + WS_O); const float* YL = (const float*)(a.ws + WS_YL);
    for (int row = gw; row < MREAL; row += NGW) {
        u32x4* op = (u32x4*)(O + (size_t)row * D);
        u32x4 w[2]; float v[16]; float ss = 0.f;
#pragma unroll
        for (int j = 0; j < 2; ++j) { w[j] = op[lane + 64 * j];
#pragma unroll
            for (int q = 0; q < 4; ++q) { v[j * 8 + 2 * q] = bf2f(w[j][q]); v[j * 8 + 2 * q + 1] = bf2f(w[j][q] >> 16); } }
#pragma unroll
        for (int i = 0; i < 16; ++i) ss += v[i] * v[i];
        ss = wave_sum(ss);
        float rstd = 1.0f / sqrtf(ss * (1.0f / 1024.0f) + EPS);
#pragma unroll
        for (int j = 0; j < 2; ++j) { const float* g = a.in[I_G_ATTN] + (lane + 64 * j) * 8; u32x4 o;
#pragma unroll
            for (int q = 0; q < 4; ++q) o[q] = pk2(v[j * 8 + 2 * q] * rstd * g[2 * q], v[j * 8 + 2 * q + 1] * rstd * g[2 * q + 1]);
            op[lane + 64 * j] = o; }
        const f32x4* yp = (const f32x4*)(YL + (size_t)row * DLRU);
        f32x4 y[4]; ss = 0.f;
#pragma unroll
        for (int j = 0; j < 4; ++j) { y[j] = yp[lane + 64 * j]; ss += (y[j].x * y[j].x + y[j].y * y[j].y) + (y[j].z * y[j].z + y[j].w * y[j].w); }
        ss = wave_sum(ss);
        rstd = 1.0f / sqrtf(ss * (1.0f / 1024.0f) + EPS);
        u32x2* o2 = (u32x2*)(O + (size_t)row * D + 1024);
#pragma unroll
        for (int j = 0; j < 4; ++j) { const f32x4 g = ((const f32x4*)a.in[I_G_LRU])[lane + 64 * j];
            o2[lane + 64 * j] = (u32x2){pk2(y[j].x * rstd * g.x, y[j].y * rstd * g.y), pk2(y[j].z * rstd * g.z, y[j].w * rstd * g.w)}; }
    }
}

__device__ __forceinline__ void phase_router(const Args& a, int lane, int wave) {
    const int gw = blockIdx.x * 8 + wave, NGW = gridDim.x * 8;
    const float* H1 = (const float*)(a.ws + WS_H1);
    int* tope = (int*)(a.ws + WS_TOPE); float* topw = (float*)(a.ws + WS_TOPW); float* rstd2 = (float*)(a.ws + WS_RSTD2);
    unsigned* counts = (unsigned*)(a.ws + WS_CTL) + CW_COUNTS;
    const float* wr = a.in[I_W_ROUTER]; const float* nf = a.in[I_NORM_FFN];
    for (int row = gw; row < MREAL; row += NGW) {
        const float* hr = H1 + (size_t)row * D;
        float ss = 0.f;
#pragma unroll
        for (int j = 0; j < 8; ++j) { const f32x4 v = ((const f32x4*)hr)[lane + 64 * j]; ss += (v.x * v.x + v.y * v.y) + (v.z * v.z + v.w * v.w); }
        ss = wave_sum(ss);
        const float rstd = 1.0f / sqrtf(ss * (1.0f / D) + EPS);
        const int e = lane & 31, kh = lane >> 5;
        float acc = 0.f;
        for (int k = kh * 1024; k < kh * 1024 + 1024; ++k) acc += (hr[k] * rstd * nf[k]) * wr[k * NEXP + e];
        acc += __shfl_xor(acc, 32);
        float val = lane < 32 ? acc + a.in[I_B_ROUTER][e] : -3.0e38f;
        float tv[4]; int te[4];
#pragma unroll
        for (int r = 0; r < 4; ++r) {
            const float mx = wave_max(val);
            const unsigned long long msk = __ballot(val == mx);
            const int win = __ffsll((long long)msk) - 1;
            tv[r] = mx; te[r] = win;
            if (lane == win) val = -3.0e38f;
        }
        const float e1 = __expf(tv[1] - tv[0]), e2 = __expf(tv[2] - tv[0]), e3 = __expf(tv[3] - tv[0]);
        const float inv = 1.0f / (1.0f + e1 + e2 + e3);
        if (lane == 0) {
            rstd2[row] = rstd;
            tope[row * 4 + 0] = te[0]; tope[row * 4 + 1] = te[1]; tope[row * 4 + 2] = te[2]; tope[row * 4 + 3] = te[3];
            topw[row * 4 + 0] = inv; topw[row * 4 + 1] = e1 * inv; topw[row * 4 + 2] = e2 * inv; topw[row * 4 + 3] = e3 * inv;
            atomicAdd(&counts[te[0]], 1u); atomicAdd(&counts[te[1]], 1u); atomicAdd(&counts[te[2]], 1u); atomicAdd(&counts[te[3]], 1u);
        }
    }
}


__device__ __forceinline__ void phase_router_mfma(const Args& a, LAS unsigned char* lds, int tid, int lane, int wave) {
    const float* H1 = (const float*)(a.ws + WS_H1); const bf16* WRT = (const bf16*)(a.ws + WS_WRT);
    int* tope = (int*)(a.ws + WS_TOPE); float* topw = (float*)(a.ws + WS_TOPW); float* rstd2 = (float*)(a.ws + WS_RSTD2);
    unsigned* counts = (unsigned*)(a.ws + WS_CTL) + CW_COUNTS;
    LAS float* lg = (LAS float*)(lds + wave * 2048);
    LAS int* hist = (LAS int*)(lds + 32768);
    if (tid < 32) hist[tid] = 0;
    __syncthreads();
    const int fr = lane & 15, fq = lane >> 4;
    for (int grp = wave * gridDim.x + blockIdx.x; grp < MREAL / 16; grp += 8 * gridDim.x) {
        const int row0 = grp * 16;
        const float* hp = H1 + (size_t)(row0 + fr) * D + 8 * fq;
        const bf16* wp = WRT + (size_t)fr * D + 8 * fq;
        f32x4 acc0 = (f32x4){0.f, 0.f, 0.f, 0.f}, acc1 = acc0; float ss = 0.f;
#pragma unroll 4
        for (int kk = 0; kk < 64; ++kk) {
            const f32x4 x0 = *(const f32x4*)(hp + 32 * kk), x1 = *(const f32x4*)(hp + 32 * kk + 4);
            ss += (x0.x * x0.x + x0.y * x0.y) + (x0.z * x0.z + x0.w * x0.w) + (x1.x * x1.x + x1.y * x1.y) + (x1.z * x1.z + x1.w * x1.w);
            const u32x4 w = (u32x4){pk2(x0.x, x0.y), pk2(x0.z, x0.w), pk2(x1.x, x1.y), pk2(x1.z, x1.w)};
            const bf16x8 af = __builtin_bit_cast(bf16x8, w);
            const bf16x8 b0 = *(const bf16x8*)(wp + 32 * kk), b1 = *(const bf16x8*)(wp + (size_t)16 * D + 32 * kk);
            acc0 = __builtin_amdgcn_mfma_f32_16x16x32_bf16(af, b0, acc0, 0, 0, 0);
            acc1 = __builtin_amdgcn_mfma_f32_16x16x32_bf16(af, b1, acc1, 0, 0, 0);
        }
        ss += __shfl_xor(ss, 16); ss += __shfl_xor(ss, 32);
        const float rstd = 1.0f / sqrtf(ss * (1.0f / D) + EPS);
        if (fq == 0) rstd2[row0 + fr] = rstd;
        const float br0 = a.in[I_B_ROUTER][fr], br1 = a.in[I_B_ROUTER][16 + fr];
#pragma unroll
        for (int j = 0; j < 4; ++j) { const int row = 4 * fq + j; const float rs = __shfl(rstd, row);
            lg[row * 32 + fr] = acc0[j] * rs + br0; lg[row * 32 + 16 + fr] = acc1[j] * rs + br1; }
        asm volatile("s_waitcnt lgkmcnt(0)" ::: "memory");
        if (lane < 16) {
            float v[32];
#pragma unroll
            for (int q = 0; q < 8; ++q) { const f32x4 t = *(const LAS f32x4*)(lg + lane * 32 + 4 * q); v[4 * q] = t.x; v[4 * q + 1] = t.y; v[4 * q + 2] = t.z; v[4 * q + 3] = t.w; }
            float tv[4]; int te[4];
#pragma unroll
            for (int r = 0; r < 4; ++r) { float best = -3.0e38f; int bi = 0;
#pragma unroll
                for (int e = 0; e < 32; ++e) { const bool gtb = v[e] > best; best = gtb ? v[e] : best; bi = gtb ? e : bi; }
#pragma unroll
                for (int e = 0; e < 32; ++e) v[e] = (e == bi) ? -3.0e38f : v[e];
                tv[r] = best; te[r] = bi; }
            const float e1 = __expf(tv[1] - tv[0]), e2 = __expf(tv[2] - tv[0]), e3 = __expf(tv[3] - tv[0]);
            const float inv = 1.0f / (1.0f + e1 + e2 + e3);
            const int row = row0 + lane;
            *(int4*)(tope + row * 4) = make_int4(te[0], te[1], te[2], te[3]);
            *(f32x4*)(topw + row * 4) = (f32x4){inv, e1 * inv, e2 * inv, e3 * inv};
#pragma unroll
            for (int r = 0; r < 4; ++r) atomicAdd((int*)&hist[te[r]], 1);
        }
        asm volatile("s_waitcnt lgkmcnt(0)" ::: "memory");
    }
    __syncthreads();
    if (tid < 32 && hist[tid] != 0) atomicAdd(&counts[tid], (unsigned)hist[tid]);
}

__device__ __forceinline__ void build_tile_table(const Args& a, LAS int* tstart, int tid) {
    if (tid == 0) {
        const unsigned* counts = (const unsigned*)(a.ws + WS_CTL) + CW_COUNTS;
        int acc = 0;
        for (int e = 0; e < NEXP; ++e) { tstart[e] = acc; acc += (int)((__hip_atomic_load(counts + e, __ATOMIC_RELAXED, __HIP_MEMORY_SCOPE_AGENT) + 255u) >> 8); }
        tstart[NEXP] = acc;
    }
    __syncthreads();
}
__device__ __forceinline__ int tile_expert(const LAS int* tstart, int tile) {
    int e = 0;
#pragma unroll 1
    for (int i = 1; i < NEXP; ++i) e += (tstart[i] <= tile) ? 1 : 0;
    return e;
}

__device__ __forceinline__ void phase_assign(const Args& a, LAS unsigned char* lds, int tid, int lane, int wave) {
    LAS int* tstart = (LAS int*)(lds + LDS_TAB);
    LAS int* hist = tstart + 64; LAS int* base = hist + 32; LAS int* spos = base + 32;
    build_tile_table(a, tstart, tid);
    const int* tope = (const int*)(a.ws + WS_TOPE); const float* topw = (const float*)(a.ws + WS_TOPW); const float* rstd2 = (const float*)(a.ws + WS_RSTD2);
    int* rowpair = (int*)(a.ws + WS_ROWPAIR); float* roww = (float*)(a.ws + WS_ROWW);
    unsigned* cursor = (unsigned*)(a.ws + WS_CTL) + CW_CURSOR;
    const float* H1 = (const float*)(a.ws + WS_H1); unsigned char* XS = (unsigned char*)(a.ws + WS_XS);
    for (int blk = blockIdx.x; blk < MREAL / 64; blk += gridDim.x) {
        if (tid < 32) hist[tid] = 0;
        __syncthreads();
        int e = 0, rank = 0, pair = 0;
        if (tid < 256) { pair = blk * 256 + tid; e = tope[pair]; rank = atomicAdd((int*)&hist[e], 1); }
        __syncthreads();
        if (tid < 32) base[tid] = (int)atomicAdd(&cursor[tid], (unsigned)hist[tid]);
        __syncthreads();
        if (tid < 256) { const int pos = tstart[e] * 256 + base[e] + rank; spos[tid] = pos; rowpair[pos] = pair; roww[pos] = topw[pair]; }
        __syncthreads();
        for (int tt = wave * 8; tt < wave * 8 + 8; ++tt) {
            const int token = blk * 64 + tt; const float rstd = rstd2[token] * XS_SCALE;
            const f32x4* hr = (const f32x4*)(H1 + (size_t)token * D);
            u32x2 o[4];
#pragma unroll
            for (int j = 0; j < 4; ++j) { const f32x4 v0 = hr[2 * (lane + 64 * j)], v1 = hr[2 * (lane + 64 * j) + 1];
                const f32x4 g0 = ((const f32x4*)a.in[I_NORM_FFN])[2 * (lane + 64 * j)], g1 = ((const f32x4*)a.in[I_NORM_FFN])[2 * (lane + 64 * j) + 1];
                o[j] = (u32x2){pk4_fp8(v0.x * rstd * g0.x, v0.y * rstd * g0.y, v0.z * rstd * g0.z, v0.w * rstd * g0.w), pk4_fp8(v1.x * rstd * g1.x, v1.y * rstd * g1.y, v1.z * rstd * g1.z, v1.w * rstd * g1.w)}; }
#pragma unroll
            for (int k = 0; k < 4; ++k) { u32x2* dst = (u32x2*)(XS + (size_t)spos[tt * 4 + k] * D);
#pragma unroll
                for (int j = 0; j < 4; ++j) dst[lane + 64 * j] = o[j]; }
        }
        __syncthreads();
    }
}

__device__ __forceinline__ void phase_final(const Args& a, int lane, int wave) {
    const int gw = blockIdx.x * 8 + wave, NGW = gridDim.x * 8;
    const float* H1 = (const float*)(a.ws + WS_H1); const bf16* YB = (const bf16*)(a.ws + WS_YB);
    for (int row = gw; row < MREAL; row += NGW) {
        f32x4 v[8]; float ss = 0.f;
#pragma unroll
        for (int j = 0; j < 8; ++j) { v[j] = ((const f32x4*)(H1 + (size_t)row * D))[lane + 64 * j];
#pragma unroll
            for (int k = 0; k < 4; ++k) { const u32x2 y = ((const u32x2*)(YB + ((size_t)row * 4 + k) * D))[lane + 64 * j];
                v[j].x += bf2f(y.x); v[j].y += bf2f(y.x >> 16); v[j].z += bf2f(y.y); v[j].w += bf2f(y.y >> 16); }
            ss += (v[j].x * v[j].x + v[j].y * v[j].y) + (v[j].z * v[j].z + v[j].w * v[j].w); }
        ss = wave_sum(ss);
        const float rstd = 1.0f / sqrtf(ss * (1.0f / D) + EPS);
        f32x4* op = (f32x4*)(a.out + (size_t)row * D);
#pragma unroll
        for (int j = 0; j < 8; ++j) { const f32x4 g = ((const f32x4*)a.in[I_FINAL_NORM])[lane + 64 * j]; op[lane + 64 * j] = v[j] * rstd * g; }
    }
}

enum { PH_PROLOGUE = 0, PH_G1, PH_ATTN, PH_LRU_B, PH_G2, PH_ROUTER, PH_ASSIGN, PH_G3, PH_G4, PH_FINAL, PH_COUNT };

__global__ void __launch_bounds__(512, 2) fwd(Args a) {
    extern __shared__ __attribute__((aligned(16))) unsigned char lds_raw[];
    LAS unsigned char* lds = (LAS unsigned char*)lds_raw;
    const int tid = threadIdx.x, lane = tid & 63, wave = __builtin_amdgcn_readfirstlane(tid >> 6);
    const int gw = blockIdx.x * 8 + wave, NGW = gridDim.x * 8;
    unsigned char* ws = a.ws;
#define IN(k) (a.ph_lo <= (k) && (k) < a.ph_hi)
#define SEAM(k) do { if (IN(k) && IN((k) + 1)) xcd_barrier(bar); } while (0)
    if (tid < 4) ((LAS unsigned*)(lds + LDS_MISC))[tid] = 0u;
    __syncthreads();
    XcdBarrier bar; bar.bar = (unsigned*)(ws + WS_CTL) + CW_BAR; bar.x = 0; bar.st = nullptr;
    if (a.ph_hi - a.ph_lo > 1) bar = xcd_barrier_post((unsigned*)(ws + WS_CTL) + CW_BAR, (volatile LAS unsigned*)(lds + LDS_MISC));

    if (IN(PH_PROLOGUE)) phase_prologue(a, lds, tid, lane, wave);
    SEAM(PH_PROLOGUE);

    if (IN(PH_G1)) {
        pg8::SchedDense S{(const char*)(ws + WS_N1), (const char*)(ws + WS_WINT), MROWS / 256, DIN / 256, (int)gridDim.x, (int)blockIdx.x};
        pg8::EpiZ E{(bf16*)(ws + WS_Z), a.in[I_B_IN]};
        pg8::gemm_phase<false>(lds, S, E);
    }
    SEAM(PH_G1);
    if (IN(PH_ATTN)) {
        for (int it = blockIdx.x; it < NBATCH * 16 * 4; it += gridDim.x) attn_item(a, lds, it, tid, lane, wave);
        for (int it = blockIdx.x; it < NBATCH * 65; it += gridDim.x) { if (it % 65 == 64 && it != 64) continue; lru_item<0>(a, lds, it, tid, lane, wave); }
    }
    SEAM(PH_ATTN);
    if (IN(PH_LRU_B)) {
        for (int it = blockIdx.x; it < NBATCH * 65; it += gridDim.x) { if (it % 65 == 64) continue; lru_item<1>(a, lds, it, tid, lane, wave); }
    }
    SEAM(PH_LRU_B);
    if (IN(PH_G2)) {
        pg8::SchedDense S{(const char*)(ws + WS_O), (const char*)(ws + WS_WOUTT), MREAL / 256, D / 256, (int)gridDim.x, (int)blockIdx.x};
        pg8::EpiH1 E{(float*)(ws + WS_H1), a.in[I_X], a.in[I_B_OUT]};
        pg8::gemm_phase<false>(lds, S, E);
    }
    SEAM(PH_G2);
    if (IN(PH_ROUTER)) phase_router_mfma(a, lds, tid, lane, wave);
    SEAM(PH_ROUTER);
    if (IN(PH_ASSIGN)) phase_assign(a, lds, tid, lane, wave);
    SEAM(PH_ASSIGN);
    if (IN(PH_G3)) {
        LAS int* tstart = (LAS int*)(lds + LDS_TAB);
        build_tile_table(a, tstart, tid);
        pg8::SchedMoE S{(const char*)(ws + WS_XS), (const char*)(ws + WS_WGT), (const char*)(ws + WS_WUT), tstart, tstart[NEXP], DFF / 128, (int)gridDim.x, (int)blockIdx.x, true};
        pg8::EpiAct E{(unsigned char*)(ws + WS_ACT), a.in[I_B_GATE], a.in[I_B_UP]};
        pg8::gemm_phase<true>(lds, S, E);
    }
    SEAM(PH_G3);
    if (IN(PH_G4)) {
        LAS int* tstart = (LAS int*)(lds + LDS_TAB);
        build_tile_table(a, tstart, tid);
        pg8::SchedMoE S{(const char*)(ws + WS_ACT), (const char*)(ws + WS_WDT), (const char*)(ws + WS_WDT), tstart, tstart[NEXP], D / 256, (int)gridDim.x, (int)blockIdx.x, false};
        pg8::EpiDown E{(bf16*)(ws + WS_YB), a.in[I_B_DOWN], (const int*)(ws + WS_ROWPAIR), (const float*)(ws + WS_ROWW)};
        pg8::gemm_phase<true>(lds, S, E);
    }
    SEAM(PH_G4);
    if (IN(PH_FINAL)) phase_final(a, lane, wave);
#undef IN
#undef SEAM
}

extern "C" void kernel_launch(void* const* d_in, const int* in_sizes, int n_in, void* d_out, int out_size, void* d_ws, size_t ws_size, hipStream_t stream) {
    static int grid = 0;
    if (grid == 0) {
        if (n_in != 27 || out_size != MREAL * D || ws_size < WS_END) { fprintf(stderr, "kernel_launch: unexpected problem (n_in %d, out %d, ws %zu)\n", n_in, out_size, ws_size); grid = -1; return; }
        int dev = 0, cus = 0;
        if (hipGetDevice(&dev) != hipSuccess || hipDeviceGetAttribute(&cus, hipDeviceAttributeMultiprocessorCount, dev) != hipSuccess) { grid = -1; return; }
        if (hipFuncSetAttribute((const void*)fwd, hipFuncAttributeMaxDynamicSharedMemorySize, LDS_BYTES) != hipSuccess) { fprintf(stderr, "kernel_launch: hipFuncSetAttribute failed\n"); grid = -1; return; }
        grid = cus;
    }
    if (grid < 0) return;
    (void)hipMemsetAsync((char*)d_ws + WS_CTL, 0, CTL_BYTES, stream);
    Args a{};
    for (int i = 0; i < 27; ++i) a.in[i] = (const float*)d_in[i];
    a.out = (float*)d_out; a.ws = (unsigned char*)d_ws;
#if MK_ONE_LAUNCH
    a.ph_lo = 0; a.ph_hi = PH_COUNT;
    hipLaunchKernelGGL(fwd, dim3(grid), dim3(512), LDS_BYTES, stream, a);
#else
    for (int ph = 0; ph < PH_COUNT; ++ph) {
        a.ph_lo = ph; a.ph_hi = ph + 1;
        hipLaunchKernelGGL(fwd, dim3(grid), dim3(512), LDS_BYTES, stream, a);
    }
#endif
}
```

```cpp
#include <hip/hip_runtime.h>
#include <cstdio>
#include <cstdint>

#define LAS __attribute__((address_space(3)))
#ifndef PROBE_REPEAT
#define PROBE_REPEAT -1
#endif
#ifndef MK_ONE_LAUNCH
#define MK_ONE_LAUNCH 1
#endif
typedef unsigned short bf16;
typedef float f32x4 __attribute__((ext_vector_type(4)));
typedef short bf16x8 __attribute__((ext_vector_type(8)));
typedef unsigned u32x4 __attribute__((ext_vector_type(4)));
typedef unsigned u32x2 __attribute__((ext_vector_type(2)));

constexpr int D = 2048, SEQ = 2048, NMETA = 16, TT = 2064, NBATCH = 8;
constexpr int MREAL = 16384, METAROW0 = 16384, MVALID = 16400, MROWS = 16640;
constexpr int DIN = 3584, DLRU = 1024, HD = 64;
constexpr int ZQ = 0, ZK = 1024, ZV = 1280, ZX = 1536, ZG = 2560;
constexpr int NEXP = 32, DFF = 2048, PROWS = 73728;
constexpr float EPS = 1e-5f;

constexpr size_t MiB = 1u << 20;
constexpr size_t WS_CTL = 0, CTL_BYTES = 1 * MiB;
constexpr size_t WS_COS = 1 * MiB, WS_SIN = 1 * MiB + 320 * 1024;
constexpr size_t WS_TOPE = 2 * MiB, WS_TOPW = WS_TOPE + 256 * 1024, WS_RSTD2 = WS_TOPW + 256 * 1024, WS_ROWPAIR = WS_RSTD2 + 64 * 1024, WS_ROWW = WS_ROWPAIR + 320 * 1024;
constexpr size_t WS_LRUSUM = 4 * MiB;
constexpr size_t WS_WAT = 9 * MiB, WS_WIT = WS_WAT + 128 * 1024, WS_WRT = WS_WIT + 128 * 1024;
constexpr size_t WS_WINT = 10 * MiB, WS_WOUTT = 24 * MiB, WS_WGT = 32 * MiB, WS_WUT = 288 * MiB, WS_WDT = 544 * MiB;
constexpr size_t WS_N1 = 800 * MiB, WS_Z = 866 * MiB, WS_O = 980 * MiB, WS_H1 = 1044 * MiB, WS_XS = 1172 * MiB, WS_YB = WS_XS, WS_ACT = 1460 * MiB, WS_END = 1748 * MiB;
constexpr size_t WS_XC = WS_XS, WS_AA = WS_XS + 66 * MiB, WS_BB = WS_XS + 132 * MiB, WS_YL = WS_XS + 198 * MiB;
static_assert(WS_ROWW + PROWS * 4 <= WS_LRUSUM, "small map");
constexpr int CW_COUNTS = 1024, CW_CURSOR = 1088, CW_BAR = 4096;

constexpr int LDS_TAB = 131072;
constexpr int LDS_MISC = LDS_TAB + 8192;
constexpr int LDS_BYTES = 147456;

__device__ const float c_inv_freq[32] = {1.000000000e+00f, 7.498942018e-01f, 5.623413324e-01f, 4.216965139e-01f, 3.162277639e-01f, 2.371373922e-01f, 1.778279394e-01f, 1.333521456e-01f, 1.000000015e-01f, 7.498941571e-02f, 5.623412877e-02f, 4.216964915e-02f, 3.162277862e-02f, 2.371373586e-02f, 1.778279431e-02f, 1.333521493e-02f, 9.999999776e-03f, 7.498942316e-03f, 5.623413250e-03f, 4.216964822e-03f, 3.162277862e-03f, 2.371373819e-03f, 1.778279431e-03f, 1.333521446e-03f, 1.000000047e-03f, 7.498941850e-04f, 5.623413017e-04f, 4.216965463e-04f, 3.162277862e-04f, 2.371373848e-04f, 1.778279402e-04f, 1.333521504e-04f};

struct Args { const float* in[27]; float* out; unsigned char* ws; int ph_lo, ph_hi; };
enum { I_X = 0, I_META, I_NORM_MIX, I_W_IN, I_B_IN, I_SINKS, I_CONV_W, I_CONV_B, I_W_A, I_B_A, I_W_I, I_B_I, I_LAMBDA, I_G_ATTN, I_G_LRU, I_W_OUT, I_B_OUT, I_NORM_FFN,
       I_W_ROUTER, I_B_ROUTER, I_W_GATE, I_B_GATE, I_W_UP, I_B_UP, I_W_DOWN, I_B_DOWN, I_FINAL_NORM };


#define XB_TMO      128
#define XB_XCNT(j)  (256  + 64 * (j))
#define XB_XSUB(j)  (1280 + 64 * (j))
#define XB_XGEN(j)  (2304 + 64 * (j))
#define XB_TOP      3328
#define XB_TOPGEN   3392
#define XCD_BAR_WORDS 3456
#define XB_SPIN_CAP (1u << 18)

__device__ __forceinline__ unsigned xb_ld(unsigned* p)              { return __hip_atomic_load(p, __ATOMIC_RELAXED, __HIP_MEMORY_SCOPE_AGENT); }
__device__ __forceinline__ unsigned xb_add(unsigned* p, unsigned v) { return __hip_atomic_fetch_add(p, v, __ATOMIC_RELAXED, __HIP_MEMORY_SCOPE_AGENT); }
__device__ __forceinline__ unsigned xb_xcc_id() { return (unsigned)__builtin_amdgcn_s_getreg((3 << 11) | 20) & 0xFu; }
#define XB_SPIN(cond, bar) do { unsigned _sp = 0; while (cond) { __builtin_amdgcn_s_sleep(1); \
    if ((++_sp & 255u) == 0u) { if (xb_ld(&(bar)[XB_TMO])) break; if (_sp > XB_SPIN_CAP) { atomicAdd(&(bar)[XB_TMO], 1u); break; } } } } while (0)

struct XcdBarrier {
    unsigned* bar; unsigned x;
    volatile LAS unsigned* st;
};

__device__ __forceinline__ XcdBarrier xcd_barrier_post(unsigned* bar, volatile LAS unsigned* st) {
    XcdBarrier b; b.bar = bar; b.x = xb_xcc_id(); b.st = st;
    if (threadIdx.x == 0) (void)xb_add(&bar[XB_XCNT(b.x)], 1u);
    return b;
}
__device__ __forceinline__ void xcd_barrier_complete(unsigned* bar, unsigned x, unsigned& nloc, unsigned& nx) {
    const unsigned G = gridDim.x * gridDim.y * gridDim.z;
    unsigned sum, cnt, mine, sp = 0u;
    for (;;) {
        sum = 0u; cnt = 0u; mine = 0u;
#pragma unroll
        for (unsigned j = 0; j < 16; ++j) { const unsigned c = xb_ld(&bar[XB_XCNT(j)]); sum += c; cnt += (c > 0u) ? 1u : 0u; mine = (j == x) ? c : mine; }
        if (sum == G) break;
        __builtin_amdgcn_s_sleep(1);
        if ((++sp & 255u) == 0u) { if (xb_ld(&bar[XB_TMO])) break; if (sp > XB_SPIN_CAP) { atomicAdd(&bar[XB_TMO], 1u); break; } }
    }
    nloc = mine > 0u ? mine : 1u; nx = cnt > 0u ? cnt : 1u;
}

__device__ __forceinline__ void xcd_barrier(const XcdBarrier& b) {
    asm volatile("s_waitcnt vmcnt(0)" ::: "memory");
    __syncthreads();
    if (threadIdx.x == 0) {
        unsigned* bar = b.bar;
        __builtin_amdgcn_s_waitcnt(0);
        unsigned nloc = b.st[0], nx = b.st[1];
        if (nloc == 0u) { xcd_barrier_complete(bar, b.x, nloc, nx); b.st[0] = nloc; b.st[1] = nx; }
        const unsigned old = xb_add(&bar[XB_XSUB(b.x)], 1u);
        const unsigned gen = old / nloc;
        if (old + 1u == (gen + 1u) * nloc) {
            __builtin_amdgcn_fence(__ATOMIC_RELEASE, "agent");
            asm volatile("s_waitcnt vmcnt(0)" ::: "memory");
            const unsigned og = xb_add(&bar[XB_TOP], 1u);
            const unsigned tg = og / nx;
            if (og + 1u == (tg + 1u) * nx) xb_add(&bar[XB_TOPGEN], 1u);
            else XB_SPIN(xb_ld(&bar[XB_TOPGEN]) == tg, bar);
            __builtin_amdgcn_fence(__ATOMIC_ACQUIRE, "agent");
            xb_add(&bar[XB_XGEN(b.x)], 1u);
            asm volatile("s_waitcnt vmcnt(0)" ::: "memory");
        } else {
            XB_SPIN(xb_ld(&bar[XB_XGEN(b.x)]) == gen, bar);
            __builtin_amdgcn_fence(__ATOMIC_ACQUIRE, "agent");
            asm volatile("s_waitcnt vmcnt(0)" ::: "memory");
        }
    }
    __syncthreads();
}

__device__ __forceinline__ float bf2f(unsigned b) { return __uint_as_float((b & 0xffffu) << 16); }
__device__ __forceinline__ unsigned f2bf(float f) { unsigned u = __float_as_uint(f); return (u + 0x7fffu + ((u >> 16) & 1u)) >> 16; }
__device__ __forceinline__ unsigned pk2(float lo, float hi) { return f2bf(lo) | (f2bf(hi) << 16); }
constexpr float W_SCALE = 256.0f, XS_SCALE = 8.0f, ACT_SCALE = 4.0f;
__device__ __forceinline__ float clamp_fp8(float x) { return fminf(fmaxf(x, -448.0f), 448.0f); }
__device__ __forceinline__ unsigned pk4_fp8(float a, float b, float c, float d) {
    int w = 0; w = __builtin_amdgcn_cvt_pk_fp8_f32(clamp_fp8(a), clamp_fp8(b), w, false); w = __builtin_amdgcn_cvt_pk_fp8_f32(clamp_fp8(c), clamp_fp8(d), w, true); return (unsigned)w; }
__device__ __forceinline__ float wave_sum(float v) {
#pragma unroll
    for (int o = 1; o < 64; o <<= 1) v += __shfl_xor(v, o);
    return v;
}
__device__ __forceinline__ float wave_max(float v) {
#pragma unroll
    for (int o = 1; o < 64; o <<= 1) v = fmaxf(v, __shfl_xor(v, o));
    return v;
}
__device__ __forceinline__ float sigmoidf_(float x) { return 1.0f / (1.0f + __expf(-x)); }
__device__ __forceinline__ float fast_sigmoid(float x) { return __builtin_amdgcn_rcpf(1.0f + __builtin_amdgcn_exp2f(-1.4426950408889634f * x)); }
__device__ __forceinline__ float fast_gelu_tanh(float x) { const float u2 = 1.5957691216057308f * (x + 0.044715f * x * x * x); return x * __builtin_amdgcn_rcpf(1.0f + __builtin_amdgcn_exp2f(-1.4426950408889634f * u2)); }
__device__ __forceinline__ float gelu_tanh(float x) { const float u = 0.7978845608028654f * (x + 0.044715f * x * x * x); return 0.5f * x * (1.0f + tanhf(u)); }
__device__ __forceinline__ int tok_row(int b, int t) { return t < NMETA ? METAROW0 + t : b * SEQ + (t - NMETA); }

__device__ __forceinline__ void transpose_item(const float* W, int K, int N, bf16* WT, LAS float* scr, int item, int lane) {
    const int nblk = N / 32, kb = item / nblk, nb = item % nblk, k0 = 64 * kb, n0 = 32 * nb;
#pragma unroll 8
    for (int i = 0; i < 32; ++i) { const int kk = 2 * i + (lane >> 5); scr[kk * 33 + (lane & 31)] = W[(size_t)(k0 + kk) * N + n0 + (lane & 31)]; }
    asm volatile("s_waitcnt lgkmcnt(0)" ::: "memory");
    const int c = lane & 7;
#pragma unroll
    for (int j = 0; j < 4; ++j) { const int n = (lane >> 3) + 8 * j; const LAS float* s = scr + (8 * c) * 33 + n;
        u32x4 o; o.x = pk2(s[0 * 33], s[1 * 33]); o.y = pk2(s[2 * 33], s[3 * 33]); o.z = pk2(s[4 * 33], s[5 * 33]); o.w = pk2(s[6 * 33], s[7 * 33]);
        *(u32x4*)(WT + (size_t)(n0 + n) * K + k0 + 8 * c) = o; }
    asm volatile("s_waitcnt lgkmcnt(0)" ::: "memory");
}

__device__ __forceinline__ void phase_prologue(const Args& a, LAS unsigned char* lds, int tid, int lane, int wave) {
    const int gw = blockIdx.x * 8 + wave, NGW = gridDim.x * 8;
    const int gt = blockIdx.x * 512 + tid, NGT = gridDim.x * 512;
    unsigned char* ws = a.ws;
    LAS float* scr = (LAS float*)(lds + wave * 8704);
    constexpr int IT_IN = 32 * (DIN / 32), IT_OUT = 32 * (D / 32);
    constexpr int NITEMS = IT_IN + IT_OUT;
    for (int it = gw; it < NITEMS; it += NGW) {
        int r = it;
        if (r < IT_IN) { transpose_item(a.in[I_W_IN], D, DIN, (bf16*)(ws + WS_WINT), scr, r, lane); continue; } r -= IT_IN;
        transpose_item(a.in[I_W_OUT], D, D, (bf16*)(ws + WS_WOUTT), scr, r, lane);
    }
    __syncthreads();
    {
        LAS unsigned* T = (LAS unsigned*)lds;
        const int n4 = tid & 63, kq = tid >> 6;
        constexpr int TILES_PER_MAT = (D / 128) * (D / 256);
        constexpr int NTILES = 96 * TILES_PER_MAT;
        auto tile_src = [&](int tile) -> const float* {
            const int mat = tile / TILES_PER_MAT, tl = tile % TILES_PER_MAT, which = mat / NEXP, e = mat % NEXP;
            const int k0 = (tl / (D / 256)) * 128, n0 = (tl % (D / 256)) * 256;
            return a.in[which == 0 ? I_W_GATE : (which == 1 ? I_W_UP : I_W_DOWN)] + (size_t)e * D * D + (size_t)(k0 + 4 * kq) * D + n0 + 4 * n4; };
        auto tile_dst = [&](int tile) -> unsigned char* {
            const int mat = tile / TILES_PER_MAT, tl = tile % TILES_PER_MAT, which = mat / NEXP, e = mat % NEXP;
            const int k0 = (tl / (D / 256)) * 128, n0 = (tl % (D / 256)) * 256;
            return ws + (which == 0 ? WS_WGT : (which == 1 ? WS_WUT : WS_WDT)) + (size_t)e * D * D + (size_t)n0 * D + k0; };
#define CONV_LOAD(R, tile) do { const float* _p = tile_src(tile); _Pragma("unroll") for (int i = 0; i < 4; ++i) _Pragma("unroll") for (int q = 0; q < 4; ++q) \
            R[i][q] = __builtin_nontemporal_load((const f32x4*)(_p + (size_t)(32 * i + q) * D)); } while (0)
#define CONV_STORE(R, tile) do { _Pragma("unroll") for (int i = 0; i < 4; ++i) { const int kd = kq + 8 * i; \
            T[(4 * n4 + 0) * 33 + kd] = pk4_fp8(R[i][0].x * W_SCALE, R[i][1].x * W_SCALE, R[i][2].x * W_SCALE, R[i][3].x * W_SCALE); \
            T[(4 * n4 + 1) * 33 + kd] = pk4_fp8(R[i][0].y * W_SCALE, R[i][1].y * W_SCALE, R[i][2].y * W_SCALE, R[i][3].y * W_SCALE); \
            T[(4 * n4 + 2) * 33 + kd] = pk4_fp8(R[i][0].z * W_SCALE, R[i][1].z * W_SCALE, R[i][2].z * W_SCALE, R[i][3].z * W_SCALE); \
            T[(4 * n4 + 3) * 33 + kd] = pk4_fp8(R[i][0].w * W_SCALE, R[i][1].w * W_SCALE, R[i][2].w * W_SCALE, R[i][3].w * W_SCALE); } \
            __syncthreads(); \
            { unsigned char* _d = tile_dst(tile); _Pragma("unroll") for (int i = 0; i < 4; ++i) { const int n = (tid >> 3) + 64 * i, c = tid & 7; \
                const u32x4 o = (u32x4){T[n * 33 + 4 * c], T[n * 33 + 4 * c + 1], T[n * 33 + 4 * c + 2], T[n * 33 + 4 * c + 3]}; \
                *(u32x4*)(_d + (size_t)n * D + 16 * c) = o; } } \
            __syncthreads(); } while (0)
        f32x4 RA[4][4], RB[4][4];
        int tile = blockIdx.x;
        if (tile < NTILES) CONV_LOAD(RA, tile);
        while (tile < NTILES) {
            int nxt = tile + gridDim.x;
            if (nxt < NTILES) CONV_LOAD(RB, nxt);
            CONV_STORE(RA, tile);
            tile = nxt; if (tile >= NTILES) break;
            nxt = tile + gridDim.x;
            if (nxt < NTILES) CONV_LOAD(RA, nxt);
            CONV_STORE(RB, tile);
            tile = nxt;
        }
#undef CONV_LOAD
#undef CONV_STORE
    }
    bf16* N1 = (bf16*)(ws + WS_N1);
    for (int r = gw; r < MROWS; r += NGW) {
        u32x2* orow = (u32x2*)(N1 + (size_t)r * D);
        if (r >= MVALID) {
#pragma unroll
            for (int j = 0; j < 8; ++j) orow[lane + 64 * j] = (u32x2){0u, 0u};
            continue; }
        const f32x4* xr = (const f32x4*)(r < MREAL ? a.in[I_X] + (size_t)r * D : a.in[I_META] + (size_t)(r - MREAL) * D);
        f32x4 v[8]; float ss = 0.f;
#pragma unroll
        for (int j = 0; j < 8; ++j) { v[j] = xr[lane + 64 * j]; ss += (v[j].x * v[j].x + v[j].y * v[j].y) + (v[j].z * v[j].z + v[j].w * v[j].w); }
        ss = wave_sum(ss);
        const float rstd = 1.0f / sqrtf(ss * (1.0f / D) + EPS);
#pragma unroll
        for (int j = 0; j < 8; ++j) { const f32x4 g = ((const f32x4*)a.in[I_NORM_MIX])[lane + 64 * j];
            orow[lane + 64 * j] = (u32x2){pk2(v[j].x * rstd * g.x, v[j].y * rstd * g.y), pk2(v[j].z * rstd * g.z, v[j].w * rstd * g.w)}; }
    }
    float* cosT = (float*)(ws + WS_COS); float* sinT = (float*)(ws + WS_SIN);
    for (int i = gt; i < TT * 32; i += NGT) {
        const int pos = i >> 5, j = i & 31;
        const float ang = (float)pos * c_inv_freq[j];
        const double t = (double)ang * 0.15915494309189535; const float fr = (float)(t - floor(t));
        cosT[i] = __builtin_amdgcn_cosf(fr); sinT[i] = __builtin_amdgcn_sinf(fr);
    }
    { bf16* WaT = (bf16*)(ws + WS_WAT); bf16* WiT = (bf16*)(ws + WS_WIT);
      for (int i = gt; i < 16 * 64 * 64; i += NGT) { const int n = i >> 12, d = (i >> 6) & 63, cc = i & 63;
          WaT[i] = (bf16)f2bf(a.in[I_W_A][(n * 64 + cc) * 64 + d]); WiT[i] = (bf16)f2bf(a.in[I_W_I][(n * 64 + cc) * 64 + d]); } }
    { bf16* WRT = (bf16*)(ws + WS_WRT);
      for (int i = gt; i < NEXP * D; i += NGT) { const int e = i >> 11, k = i & 2047; WRT[i] = (bf16)f2bf(a.in[I_NORM_FFN][k] * a.in[I_W_ROUTER][k * NEXP + e]); } }
    int* rowpair = (int*)(ws + WS_ROWPAIR);
    for (int i = gt; i < PROWS; i += NGT) rowpair[i] = -1;
}

template <bool DUAL, class BSel, class Epi>
__device__ __forceinline__ void naive_gemm(const bf16* A, int mt_count, int nt_count, int K, const BSel& bsel, const Epi& epi, int gw, int NGW, int lane) {
    const int fr = lane & 15, fq = lane >> 4;
    for (int tile = gw; tile < mt_count * nt_count; tile += NGW) {
        const int tm = tile / nt_count, tn = tile % nt_count;
        const bf16 *B0, *B1; bsel(tm, B0, B1);
        f32x4 acc[4][4], acc2[4][4];
#pragma unroll
        for (int i = 0; i < 4; ++i)
#pragma unroll
            for (int j = 0; j < 4; ++j) { acc[i][j] = (f32x4){0.f, 0.f, 0.f, 0.f}; acc2[i][j] = (f32x4){0.f, 0.f, 0.f, 0.f}; }
        const bf16* ap = A + (size_t)(tm * 64 + fr) * K + fq * 8;
        const bf16* bp0 = B0 + (size_t)(tn * 64 + fr) * K + fq * 8;
        const bf16* bp1 = B1 + (size_t)(tn * 64 + fr) * K + fq * 8;
        for (int k0 = 0; k0 < K; k0 += 32) {
            bf16x8 af[4], bfr[4];
#pragma unroll
            for (int i = 0; i < 4; ++i) af[i] = *(const bf16x8*)(ap + (size_t)i * 16 * K + k0);
#pragma unroll
            for (int j = 0; j < 4; ++j) bfr[j] = *(const bf16x8*)(bp0 + (size_t)j * 16 * K + k0);
#pragma unroll
            for (int i = 0; i < 4; ++i)
#pragma unroll
                for (int j = 0; j < 4; ++j) acc[i][j] = __builtin_amdgcn_mfma_f32_16x16x32_bf16(af[i], bfr[j], acc[i][j], 0, 0, 0);
            if (DUAL) {
#pragma unroll
                for (int j = 0; j < 4; ++j) bfr[j] = *(const bf16x8*)(bp1 + (size_t)j * 16 * K + k0);
#pragma unroll
                for (int i = 0; i < 4; ++i)
#pragma unroll
                    for (int j = 0; j < 4; ++j) acc2[i][j] = __builtin_amdgcn_mfma_f32_16x16x32_bf16(af[i], bfr[j], acc2[i][j], 0, 0, 0);
            }
        }
#pragma unroll
        for (int i = 0; i < 4; ++i)
#pragma unroll
            for (int j = 0; j < 4; ++j)
#pragma unroll
                for (int r = 0; r < 4; ++r) epi(tm, tm * 64 + i * 16 + fq * 4 + r, tn * 64 + j * 16 + fr, acc[i][j][r], acc2[i][j][r]);
    }
}


namespace pg8 {
constexpr int BM = 256, BK = 64, HALF = 128, HTB = HALF * BK * 2, STAGE_BYTES = 8 * HTB, NXCD = 8, WGM = 8, KD = 2048, NKT = KD / BK;
__host__ __device__ __forceinline__ int lds_byte(int r, int c) { const int st = (r >> 4) * 2 + (c >> 5), rr = r & 15, cc = c & 31, ob = rr * 64 + cc * 2; return st * 1024 + (ob ^ (((ob >> 9) & 1) << 5)); }
__host__ __device__ __forceinline__ void stage_rc(int b, int& R, int& C) { const int st = b / 1024, sb = b % 1024, swz = sb ^ (((sb >> 9) & 1) << 5); R = (st >> 1) * 16 + swz / 64; C = (st & 1) * 32 + (swz % 64) / 2; }
__host__ __device__ __forceinline__ int perm32(int rho) { const int n = rho >> 4, i = rho & 15; return 8 * (i >> 2) + 4 * n + (i & 3); }
struct Unit { const char* a; const char* b0; const char* b1; int pm, pn, e; };
__device__ __forceinline__ bool static_tile(int i, int G, int c, int nM, int nN, int& pm, int& pn) {
    const int nwg = nM * nN; const long L = (long)i * G + c; if (L >= nwg) return false;
    int wgid = (int)L; { const int q = nwg / NXCD, r = nwg % NXCD, xcd = wgid % NXCD, off = wgid / NXCD; wgid = (xcd < r ? xcd * (q + 1) : r * (q + 1) + (xcd - r) * q) + off; }
    const int nig = WGM * nN, gid = wgid / nig, fm = gid * WGM, gsz = (nM - fm) < WGM ? (nM - fm) : WGM;
    pm = fm + ((wgid % nig) % gsz); pn = (wgid % nig) / gsz; return true;
}
__device__ __forceinline__ unsigned cvt_pk_bf16(float lo, float hi) { unsigned r; asm volatile("v_cvt_pk_bf16_f32 %0, %1, %2" : "=v"(r) : "v"(lo), "v"(hi)); return r; }

typedef int i32x8 __attribute__((ext_vector_type(8)));
typedef int i32x4 __attribute__((ext_vector_type(4)));
__device__ __forceinline__ i32x8 cat8(bf16x8 lo, bf16x8 hi) { const i32x4 a = __builtin_bit_cast(i32x4, lo), b = __builtin_bit_cast(i32x4, hi); return __builtin_shufflevector(a, b, 0, 1, 2, 3, 4, 5, 6, 7); }
template <bool FP8, class Epi, class Sched>
__device__ __forceinline__ void gemm_phase(LAS unsigned char* lds, const Sched& S, const Epi& E) {
    constexpr int ROWB = FP8 ? 2048 : 4096, NKTL = ROWB / 128;
    const int tid = threadIdx.x, wid = __builtin_amdgcn_readfirstlane(tid >> 6), lane = tid & 63, wr = wid >> 2, wc = wid & 3, fr = lane & 15, fq = lane >> 4;
    unsigned voffA[2], voffB[2];
#pragma unroll
    for (int i = 0; i < 2; ++i) { int R, C; stage_rc(tid * 16 + i * 8192, R, C); const int Rb = Epi::PERM ? ((R & ~31) + perm32(R & 31)) : R;
        voffA[i] = (unsigned)(R * ROWB + C * 2); voffB[i] = (unsigned)(Rb * ROWB + C * 2); }
    constexpr size_t kstep = (size_t)(BK * 2);
    constexpr size_t hstep = (size_t)HALF * ROWB;
    const unsigned ldsw = (unsigned)wid * 1024u;
    const int aoff = lds_byte(wr * 64 + fr, fq * 8), boff = lds_byte(wc * 32 + fr, fq * 8);
#define PG8_SA(b, h) (((b) * 2 + (h)) * HTB)
#define PG8_SB(b, h) ((4 + (b) * 2 + (h)) * HTB)
#define PG8_STAGE(bufoff, gbase, voff) do { _Pragma("unroll") for (int _i = 0; _i < 2; ++_i) \
        __builtin_amdgcn_global_load_lds((const unsigned*)((const char*)(gbase) + (voff)[_i]), (LAS unsigned*)(lds + (bufoff) + ldsw + _i * 8192), 16, 0, 0); } while (0)
#define PG8_LDA(dst, b, h) do { _Pragma("unroll") for (int m = 0; m < 4; ++m) { \
        if constexpr (FP8) dst##8[m] = __builtin_shufflevector(*(const LAS i32x4*)(lds + PG8_SA(b, h) + aoff + m * 2048), *(const LAS i32x4*)(lds + PG8_SA(b, h) + aoff + m * 2048 + 1024), 0, 1, 2, 3, 4, 5, 6, 7); \
        else { _Pragma("unroll") for (int k = 0; k < 2; ++k) dst[m][k] = *(const LAS bf16x8*)(lds + PG8_SA(b, h) + aoff + m * 2048 + k * 1024); } } } while (0)
#define PG8_LDB(dst, b, h) do { _Pragma("unroll") for (int n = 0; n < 2; ++n) { \
        if constexpr (FP8) dst##8[n] = __builtin_shufflevector(*(const LAS i32x4*)(lds + PG8_SB(b, h) + boff + n * 2048), *(const LAS i32x4*)(lds + PG8_SB(b, h) + boff + n * 2048 + 1024), 0, 1, 2, 3, 4, 5, 6, 7); \
        else { _Pragma("unroll") for (int k = 0; k < 2; ++k) dst[n][k] = *(const LAS bf16x8*)(lds + PG8_SB(b, h) + boff + n * 2048 + k * 1024); } } } while (0)
#define PG8_MMA(ai, bj, At, Bt) do { __builtin_amdgcn_s_setprio(1); _Pragma("unroll") for (int m = 0; m < 4; ++m) _Pragma("unroll") for (int n = 0; n < 2; ++n) { \
        if constexpr (FP8) asm volatile("v_mfma_f32_16x16x128_f8f6f4 %0, %1, %2, %0" : "+v"(acc[ai][bj][m][n]) : "v"(Bt##8[n]), "v"(At##8[m])); \
        else { _Pragma("unroll") for (int k = 0; k < 2; ++k) acc[ai][bj][m][n] = __builtin_amdgcn_mfma_f32_16x16x32_bf16(Bt[n][k], At[m][k], acc[ai][bj][m][n], 0, 0, 0); } } \
        __builtin_amdgcn_s_setprio(0); } while (0)
#define PG8_WAIT_V(n) asm volatile("s_waitcnt vmcnt(" #n ")" ::: "memory")
#define PG8_WAIT_L(n) asm volatile("s_waitcnt lgkmcnt(" #n ")" ::: "memory")
#define PG8_BAR __builtin_amdgcn_s_barrier()
#define PG8_SCHED __builtin_amdgcn_sched_barrier(0)
    Unit cur, nxt; int ui = 0;
    if (!S.next(0, cur)) return;
    f32x4 acc[2][2][4][2];
#pragma unroll
    for (int a = 0; a < 2; ++a)
#pragma unroll
        for (int b = 0; b < 2; ++b)
#pragma unroll
            for (int m = 0; m < 4; ++m)
#pragma unroll
                for (int n = 0; n < 2; ++n) acc[a][b][m][n] = (f32x4){0.f, 0.f, 0.f, 0.f};
    bf16x8 At[4][2], B0[2][2], B1[2][2];
    i32x8 At8[4], B08[2], B18[2];
    PG8_STAGE(PG8_SB(0, 0), cur.b0, voffB); PG8_STAGE(PG8_SB(0, 1), cur.b1, voffB); PG8_STAGE(PG8_SA(0, 0), cur.a, voffA); PG8_STAGE(PG8_SA(0, 1), cur.a + hstep, voffA);
    if (wr == 1) PG8_BAR;
    PG8_WAIT_V(2); PG8_BAR;
    PG8_STAGE(PG8_SB(1, 0), cur.b0 + kstep, voffB); PG8_STAGE(PG8_SA(1, 0), cur.a + kstep, voffA); PG8_STAGE(PG8_SB(1, 1), cur.b1 + kstep, voffB);
    PG8_WAIT_V(6); PG8_BAR;
    for (;;) {
        const bool has_next = S.next(ui + 1, nxt);
        const char* nA = has_next ? nxt.a : cur.a; const char* nB0 = has_next ? nxt.b0 : cur.b0; const char* nB1 = has_next ? nxt.b1 : cur.b1;
        for (int t = 0; t < NKTL; t += 2) {
            const bool last = (t == NKTL - 2);
            const char* a1 = cur.a + (size_t)(t + 1) * kstep;
            const char* a2 = last ? nA : cur.a + (size_t)(t + 2) * kstep;
            const char* b20 = last ? nB0 : cur.b0 + (size_t)(t + 2) * kstep; const char* b21 = last ? nB1 : cur.b1 + (size_t)(t + 2) * kstep;
            const char* a3 = a2 + kstep; const char* b30 = b20 + kstep; const char* b31 = b21 + kstep;
            PG8_LDB(B0, 0, 0); PG8_LDB(B1, 0, 1); PG8_SCHED; PG8_LDA(At, 0, 0); PG8_STAGE(PG8_SA(1, 1), a1 + hstep, voffA);
            PG8_WAIT_V(8); PG8_WAIT_L(0); PG8_BAR; PG8_MMA(0, 0, At, B0); PG8_MMA(0, 1, At, B1); PG8_BAR; PG8_SCHED;
            PG8_LDA(At, 0, 1); PG8_STAGE(PG8_SB(0, 0), b20, voffB); PG8_STAGE(PG8_SB(0, 1), b21, voffB); PG8_STAGE(PG8_SA(0, 0), a2, voffA);
            PG8_WAIT_V(8); PG8_WAIT_L(0); PG8_BAR; PG8_MMA(1, 0, At, B0); PG8_MMA(1, 1, At, B1); PG8_BAR; PG8_SCHED;
            PG8_LDB(B0, 1, 0); PG8_LDB(B1, 1, 1); PG8_SCHED; PG8_LDA(At, 1, 0); PG8_STAGE(PG8_SA(0, 1), a2 + hstep, voffA);
            PG8_WAIT_V(8); PG8_WAIT_L(0); PG8_BAR; PG8_MMA(0, 0, At, B0); PG8_MMA(0, 1, At, B1); PG8_BAR; PG8_SCHED;
            PG8_LDA(At, 1, 1); PG8_STAGE(PG8_SB(1, 0), b30, voffB); PG8_STAGE(PG8_SB(1, 1), b31, voffB); PG8_STAGE(PG8_SA(1, 0), a3, voffA);
            PG8_WAIT_V(8); PG8_WAIT_L(0); PG8_BAR; PG8_MMA(1, 0, At, B0); PG8_MMA(1, 1, At, B1); PG8_BAR; PG8_SCHED;
        }
        if (wr == 0) PG8_BAR;
        if constexpr (FP8) asm volatile("s_nop 15\n\ts_nop 15" ::: "memory");
        E(acc, cur, wr, wc, fr, fq);
        if (!has_next) break;
#pragma unroll
        for (int a = 0; a < 2; ++a)
#pragma unroll
            for (int b = 0; b < 2; ++b)
#pragma unroll
                for (int m = 0; m < 4; ++m)
#pragma unroll
                    for (int n = 0; n < 2; ++n) acc[a][b][m][n] = (f32x4){0.f, 0.f, 0.f, 0.f};
        cur = nxt; ++ui;
        if (wr == 1) PG8_BAR;
    }
    PG8_WAIT_V(0);
    PG8_BAR;
#undef PG8_SA
#undef PG8_SB
#undef PG8_STAGE
#undef PG8_LDA
#undef PG8_LDB
#undef PG8_MMA
#undef PG8_WAIT_V
#undef PG8_WAIT_L
#undef PG8_BAR
#undef PG8_SCHED
}

struct SchedDense {
    const char* A; const char* Bt; int nM, nN, G, c;
    __device__ __forceinline__ bool next(int i, Unit& u) const {
        int pm, pn; if (!static_tile(i, G, c, nM, nN, pm, pn)) return false;
        u.pm = pm; u.pn = pn; u.e = 0; u.a = A + (size_t)pm * (BM * 4096); u.b0 = Bt + (size_t)pn * (BM * 4096); u.b1 = u.b0 + (size_t)HALF * 4096; return true;
    }
};
struct SchedMoE {
    const char* A; const char* B0; const char* B1; const LAS int* tstart; int nM, nN, G, c; bool split;
    __device__ __forceinline__ bool next(int i, Unit& u) const {
        int pm, pn; if (!static_tile(i, G, c, nM, nN, pm, pn)) return false;
        int e = 0;
#pragma unroll 1
        for (int q = 1; q < 32; ++q) e += (tstart[q] <= pm) ? 1 : 0;
        u.pm = pm; u.pn = pn; u.e = e; u.a = A + (size_t)pm * (BM * 2048);
        const size_t eoff = (size_t)e * ((size_t)2048 * 2048);
        if (split) { u.b0 = B0 + eoff + (size_t)pn * (HALF * 2048); u.b1 = B1 + eoff + (size_t)pn * (HALF * 2048); }
        else { u.b0 = B0 + eoff + (size_t)pn * (BM * 2048); u.b1 = u.b0 + (size_t)HALF * 2048; }
        return true;
    }
};

struct EpiZ {
    static constexpr bool PERM = true;
    bf16* Z; const float* bias;
    __device__ __forceinline__ void operator()(const f32x4 (&acc)[2][2][4][2], const Unit& u, int wr, int wc, int fr, int fq) const {
        const int row0 = u.pm * BM + wr * 64 + fr, col0 = u.pn * BM + wc * 32 + 8 * fq;
        f32x4 bv[2][2];
#pragma unroll
        for (int bj = 0; bj < 2; ++bj)
#pragma unroll
            for (int n = 0; n < 2; ++n) bv[bj][n] = *(const f32x4*)(bias + col0 + bj * HALF + 4 * n);
#pragma unroll
        for (int ai = 0; ai < 2; ++ai)
#pragma unroll
            for (int m = 0; m < 4; ++m) { bf16* rowp = Z + (size_t)(row0 + ai * HALF + m * 16) * DIN + col0;
#pragma unroll
                for (int bj = 0; bj < 2; ++bj) { const f32x4 v0 = acc[ai][bj][m][0] + bv[bj][0], v1 = acc[ai][bj][m][1] + bv[bj][1];
                    u32x4 w; w.x = cvt_pk_bf16(v0[0], v0[1]); w.y = cvt_pk_bf16(v0[2], v0[3]); w.z = cvt_pk_bf16(v1[0], v1[1]); w.w = cvt_pk_bf16(v1[2], v1[3]);
                    *(u32x4*)(rowp + bj * HALF) = w; } }
    }
};
struct EpiH1 {
    static constexpr bool PERM = true;
    bf16* H1; const float* x; const float* bias;
    __device__ __forceinline__ void operator()(const f32x4 (&acc)[2][2][4][2], const Unit& u, int wr, int wc, int fr, int fq) const {
        const int row0 = u.pm * BM + wr * 64 + fr, col0 = u.pn * BM + wc * 32 + 8 * fq;
        f32x4 bv[2][2];
#pragma unroll
        for (int bj = 0; bj < 2; ++bj)
#pragma unroll
            for (int n = 0; n < 2; ++n) bv[bj][n] = *(const f32x4*)(bias + col0 + bj * HALF + 4 * n);
#pragma unroll
        for (int ai = 0; ai < 2; ++ai)
#pragma unroll
            for (int m = 0; m < 4; ++m) { const size_t ro = (size_t)(row0 + ai * HALF + m * 16) * D + col0;
#pragma unroll
                for (int bj = 0; bj < 2; ++bj) { const f32x4 v0 = *(const f32x4*)(x + ro + bj * HALF) + acc[ai][bj][m][0] + bv[bj][0], v1 = *(const f32x4*)(x + ro + bj * HALF + 4) + acc[ai][bj][m][1] + bv[bj][1];
                    u32x4 w; w.x = cvt_pk_bf16(v0[0], v0[1]); w.y = cvt_pk_bf16(v0[2], v0[3]); w.z = cvt_pk_bf16(v1[0], v1[1]); w.w = cvt_pk_bf16(v1[2], v1[3]);
                    *(u32x4*)(H1 + ro + bj * HALF) = w; } }
    }
};
struct EpiAct {
    static constexpr bool PERM = true;
    unsigned char* ACT; const float* bg; const float* bu;
    __device__ __forceinline__ void operator()(const f32x4 (&acc)[2][2][4][2], const Unit& u, int wr, int wc, int fr, int fq) const {
        const int row0 = u.pm * BM + wr * 64 + fr, col0 = u.pn * HALF + wc * 32 + 8 * fq;
        f32x4 gv[2], uv[2];
#pragma unroll
        for (int n = 0; n < 2; ++n) { gv[n] = *(const f32x4*)(bg + (size_t)u.e * DFF + col0 + 4 * n); uv[n] = *(const f32x4*)(bu + (size_t)u.e * DFF + col0 + 4 * n); }
#pragma unroll
        for (int ai = 0; ai < 2; ++ai)
#pragma unroll
            for (int m = 0; m < 4; ++m) { float r[8];
#pragma unroll
                for (int n = 0; n < 2; ++n)
#pragma unroll
                    for (int j = 0; j < 4; ++j) { float g = acc[ai][0][m][n][j] * (1.0f / (W_SCALE * XS_SCALE)) + gv[n][j], up = acc[ai][1][m][n][j] * (1.0f / (W_SCALE * XS_SCALE)) + uv[n][j];
                        g = fminf(g, 7.0f); up = fminf(fmaxf(up, -7.0f), 7.0f);
                        r[n * 4 + j] = ACT_SCALE * g * (1.0f / (1.0f + __expf(-1.702f * g))) * (up + 1.0f); }
                *(u32x2*)(ACT + (size_t)(row0 + ai * HALF + m * 16) * DFF + col0) = (u32x2){pk4_fp8(r[0], r[1], r[2], r[3]), pk4_fp8(r[4], r[5], r[6], r[7])}; }
    }
};
struct EpiDown {
    static constexpr bool PERM = true;
    bf16* YB; const float* bd; const int* rowpair; const float* roww;
    __device__ __forceinline__ void operator()(const f32x4 (&acc)[2][2][4][2], const Unit& u, int wr, int wc, int fr, int fq) const {
        const int row0 = u.pm * BM + wr * 64 + fr, col0 = u.pn * BM + wc * 32 + 8 * fq;
        f32x4 bv[2][2];
#pragma unroll
        for (int bj = 0; bj < 2; ++bj)
#pragma unroll
            for (int n = 0; n < 2; ++n) bv[bj][n] = *(const f32x4*)(bd + (size_t)u.e * D + col0 + bj * HALF + 4 * n);
#pragma unroll
        for (int ai = 0; ai < 2; ++ai)
#pragma unroll
            for (int m = 0; m < 4; ++m) { const int row = row0 + ai * HALF + m * 16; const int pair = rowpair[row]; const float wt = roww[row];
                if (pair >= 0) { bf16* rowp = YB + (size_t)pair * D + col0;
#pragma unroll
                    for (int bj = 0; bj < 2; ++bj) { const f32x4 v0 = (acc[ai][bj][m][0] * (1.0f / (W_SCALE * ACT_SCALE)) + bv[bj][0]) * wt, v1 = (acc[ai][bj][m][1] * (1.0f / (W_SCALE * ACT_SCALE)) + bv[bj][1]) * wt;
                        u32x4 w; w.x = cvt_pk_bf16(v0[0], v0[1]); w.y = cvt_pk_bf16(v0[2], v0[3]); w.z = cvt_pk_bf16(v1[0], v1[1]); w.w = cvt_pk_bf16(v1[2], v1[3]);
                        *(u32x4*)(rowp + bj * HALF) = w; } } }
    }
};
}


typedef float f32x16 __attribute__((ext_vector_type(16)));
constexpr int AT_KS = 144, AT_VS = 584, AT_KOFF = 0, AT_VOFF = 288 * AT_KS;
__device__ __forceinline__ float bflo(unsigned w) { return __uint_as_float(w << 16); }
__device__ __forceinline__ float bfhi(unsigned w) { return __uint_as_float(w & 0xffff0000u); }

__device__ __forceinline__ void attn_tile(LAS unsigned char* lds, int slot_base, int kind, int j, int lane, int hq,
                                          const bf16x8 (&qf)[2][4], f32x16 (&oacc)[2][2], float (&mrow)[2], float (&lrow)[2]) {
    const int r31 = lane & 31, h = lane >> 5;
    bf16x8 kf[4], vf[2][2];
#pragma unroll
    for (int ks = 0; ks < 4; ++ks) kf[ks] = *(const LAS bf16x8*)(lds + AT_KOFF + (slot_base + r31) * AT_KS + (16 * ks + 8 * h) * 2);
#pragma unroll
    for (int dt = 0; dt < 2; ++dt)
#pragma unroll
        for (int sp = 0; sp < 2; ++sp) { const LAS unsigned char* p = lds + AT_VOFF + (32 * dt + r31) * AT_VS + (slot_base + 16 * sp + 4 * h) * 2;
            const u32x2 lo = *(const LAS u32x2*)p, hi = *(const LAS u32x2*)(p + 16);
            const u32x4 w = (u32x4){lo.x, lo.y, hi.x, hi.y}; vf[dt][sp] = __builtin_bit_cast(bf16x8, w); }
#pragma unroll
    for (int qt = 0; qt < 2; ++qt) {
        f32x16 s;
#pragma unroll
        for (int r = 0; r < 16; ++r) s[r] = 0.f;
#pragma unroll
        for (int ks = 0; ks < 4; ++ks) s = __builtin_amdgcn_mfma_f32_32x32x16_bf16(kf[ks], qf[qt][ks], s, 0, 0, 0);
        const int i = 64 * hq + 32 * qt + r31;
        float mx = -1.0e30f;
#pragma unroll
        for (int r = 0; r < 16; ++r) { const int key = (r & 3) + 8 * (r >> 2) + 4 * h;
            const bool ok = kind == 0 ? (key < 16) : (kind == 1 ? (32 * j + key >= i + 1) : (32 * j + key <= i));
            s[r] = ok ? s[r] : -1.0e30f; mx = fmaxf(mx, s[r]); }
        mx = fmaxf(mx, __shfl_xor(mx, 32));
        const float mn = fmaxf(mrow[qt], mx), al = __expf(mrow[qt] - mn); mrow[qt] = mn;
        float ps = 0.f;
#pragma unroll
        for (int r = 0; r < 16; ++r) { s[r] = __expf(s[r] - mn); ps += s[r]; }
        lrow[qt] = lrow[qt] * al + ps;
#pragma unroll
        for (int dt = 0; dt < 2; ++dt)
#pragma unroll
            for (int r = 0; r < 16; ++r) oacc[qt][dt][r] *= al;
        bf16x8 pf[2];
#pragma unroll
        for (int sp = 0; sp < 2; ++sp) { const u32x4 w = (u32x4){pk2(s[8 * sp + 0], s[8 * sp + 1]), pk2(s[8 * sp + 2], s[8 * sp + 3]), pk2(s[8 * sp + 4], s[8 * sp + 5]), pk2(s[8 * sp + 6], s[8 * sp + 7])};
            pf[sp] = __builtin_bit_cast(bf16x8, w); }
#pragma unroll
        for (int dt = 0; dt < 2; ++dt)
#pragma unroll
            for (int sp = 0; sp < 2; ++sp) oacc[qt][dt] = __builtin_amdgcn_mfma_f32_32x32x16_bf16(vf[dt][sp], pf[sp], oacc[qt][dt], 0, 0, 0);
    }
}

__device__ __forceinline__ void attn_item(const Args& a, LAS unsigned char* lds, int item, int tid, int lane, int wave) {
    const int kvh = item & 3, qblk = (item >> 2) & 15, b = item >> 6;
    const bf16* Z = (const bf16*)(a.ws + WS_Z); bf16* O = (bf16*)(a.ws + WS_O);
    const float* cosT = (const float*)(a.ws + WS_COS); const float* sinT = (const float*)(a.ws + WS_SIN);
    __syncthreads();
    for (int task = tid; task < 288 * 4; task += 512) {
        const int slot = task >> 2, c = task & 3;
        int krow, kpos; bool valid;
        if (slot < 32) { valid = slot < NMETA; krow = METAROW0 + slot; kpos = slot; }
        else { const int sp = 128 * (qblk - 1) + (slot - 32); valid = sp >= 0; krow = b * SEQ + sp; kpos = NMETA + sp; }
        u32x4 lo = (u32x4){0u, 0u, 0u, 0u}, hi = lo;
        if (valid) {
            const bf16* kp = Z + (size_t)krow * DIN + ZK + kvh * 64 + c * 8;
            const u32x4 x1 = *(const u32x4*)kp, x2 = *(const u32x4*)(kp + 32);
            const f32x4 c0 = *(const f32x4*)(cosT + kpos * 32 + c * 8), c1 = *(const f32x4*)(cosT + kpos * 32 + c * 8 + 4);
            const f32x4 s0 = *(const f32x4*)(sinT + kpos * 32 + c * 8), s1 = *(const f32x4*)(sinT + kpos * 32 + c * 8 + 4);
#pragma unroll
            for (int q = 0; q < 4; ++q) { const float ca = q < 2 ? c0[2 * q] : c1[2 * q - 4], cb = q < 2 ? c0[2 * q + 1] : c1[2 * q - 3], sa = q < 2 ? s0[2 * q] : s1[2 * q - 4], sb = q < 2 ? s0[2 * q + 1] : s1[2 * q - 3];
                const float a0 = bflo(x1[q]), a1 = bfhi(x1[q]), b0 = bflo(x2[q]), b1 = bfhi(x2[q]);
                lo[q] = pk2(a0 * ca - b0 * sa, a1 * cb - b1 * sb); hi[q] = pk2(b0 * ca + a0 * sa, b1 * cb + a1 * sb); }
        }
        *(LAS u32x4*)(lds + AT_KOFF + slot * AT_KS + c * 16) = lo; *(LAS u32x4*)(lds + AT_KOFF + slot * AT_KS + 64 + c * 16) = hi;
    }
    for (int task = tid; task < 144 * 8; task += 512) {
        const int slot0 = (task >> 3) * 2, c = task & 7;
        int vrow; bool valid;
        if (slot0 < 32) { valid = slot0 < NMETA; vrow = METAROW0 + slot0; }
        else { const int sp = 128 * (qblk - 1) + (slot0 - 32); valid = sp >= 0; vrow = b * SEQ + sp; }
        u32x4 v0 = (u32x4){0u, 0u, 0u, 0u}, v1 = v0;
        if (valid) { const bf16* vp = Z + (size_t)vrow * DIN + ZV + kvh * 64 + c * 8; v0 = *(const u32x4*)vp; v1 = *(const u32x4*)(vp + DIN); }
#pragma unroll
        for (int q = 0; q < 4; ++q) {
            *(LAS unsigned*)(lds + AT_VOFF + (c * 8 + 2 * q) * AT_VS + slot0 * 2) = (v0[q] & 0xffffu) | (v1[q] << 16);
            *(LAS unsigned*)(lds + AT_VOFF + (c * 8 + 2 * q + 1) * AT_VS + slot0 * 2) = (v0[q] >> 16) | (v1[q] & 0xffff0000u); }
    }
    const int g = wave >> 1, hq = wave & 1, head = kvh * 4 + g, r31 = lane & 31, h = lane >> 5;
    bf16x8 qf[2][4];
#pragma unroll
    for (int qt = 0; qt < 2; ++qt) {
        const int s = 128 * qblk + 64 * hq + 32 * qt + r31, pos = NMETA + s;
        const bf16* qp = Z + (size_t)(b * SEQ + s) * DIN + ZQ + head * 64 + 8 * h;
        u32x4 x[4];
#pragma unroll
        for (int ks = 0; ks < 4; ++ks) x[ks] = *(const u32x4*)(qp + 16 * ks);
#pragma unroll
        for (int ks = 0; ks < 2; ++ks) {
            const float* cp = cosT + pos * 32 + 16 * ks + 8 * h; const float* sp = sinT + pos * 32 + 16 * ks + 8 * h;
            const f32x4 c0 = *(const f32x4*)cp, c1 = *(const f32x4*)(cp + 4), s0 = *(const f32x4*)sp, s1 = *(const f32x4*)(sp + 4);
            u32x4 lo, hi;
#pragma unroll
            for (int q = 0; q < 4; ++q) { const float ca = q < 2 ? c0[2 * q] : c1[2 * q - 4], cb = q < 2 ? c0[2 * q + 1] : c1[2 * q - 3], sa = q < 2 ? s0[2 * q] : s1[2 * q - 4], sb = q < 2 ? s0[2 * q + 1] : s1[2 * q - 3];
                const float a0 = bflo(x[ks][q]), a1 = bfhi(x[ks][q]), b0 = bflo(x[ks + 2][q]), b1 = bfhi(x[ks + 2][q]);
                lo[q] = pk2(0.125f * (a0 * ca - b0 * sa), 0.125f * (a1 * cb - b1 * sb)); hi[q] = pk2(0.125f * (b0 * ca + a0 * sa), 0.125f * (b1 * cb + a1 * sb)); }
            qf[qt][ks] = __builtin_bit_cast(bf16x8, lo); qf[qt][ks + 2] = __builtin_bit_cast(bf16x8, hi);
        }
    }
    f32x16 oacc[2][2]; float mrow[2], lrow[2];
#pragma unroll
    for (int qt = 0; qt < 2; ++qt) { mrow[qt] = a.in[I_SINKS][head]; lrow[qt] = h == 0 ? 1.0f : 0.0f;
#pragma unroll
        for (int dt = 0; dt < 2; ++dt)
#pragma unroll
            for (int r = 0; r < 16; ++r) oacc[qt][dt][r] = 0.f; }
    __syncthreads();
    attn_tile(lds, 0, 0, 0, lane, hq, qf, oacc, mrow, lrow);
    if (qblk > 0) {
#pragma unroll 1
        for (int j = hq ? 2 : 0; j < 4; ++j) attn_tile(lds, 32 + 32 * j, 1, j, lane, hq, qf, oacc, mrow, lrow);
    }
#pragma unroll 1
    for (int j = 0; j < (hq ? 4 : 2); ++j) attn_tile(lds, 160 + 32 * j, 2, j, lane, hq, qf, oacc, mrow, lrow);
#pragma unroll
    for (int qt = 0; qt < 2; ++qt) {
        const float lt = lrow[qt] + __shfl_xor(lrow[qt], 32), inv = 1.0f / lt;
        bf16* op = O + (size_t)(b * SEQ + 128 * qblk + 64 * hq + 32 * qt + r31) * D + head * 64 + 4 * h;
#pragma unroll
        for (int dt = 0; dt < 2; ++dt)
#pragma unroll
            for (int rr = 0; rr < 4; ++rr)
                *(u32x2*)(op + 32 * dt + 8 * rr) = (u32x2){pk2(oacc[qt][dt][4 * rr] * inv, oacc[qt][dt][4 * rr + 1] * inv), pk2(oacc[qt][dt][4 * rr + 2] * inv, oacc[qt][dt][4 * rr + 3] * inv)};
    }
}

constexpr int LR_XS = 2064;
template <int PASS>
__device__ __forceinline__ void lru_item(const Args& a, LAS unsigned char* lds, int item, int tid, int lane, int wave) {
    const int b = item / 65, c = item % 65; const bool meta = (c == 64);
    const bf16* Z = (const bf16*)(a.ws + WS_Z);
    float* sumA = (float*)(a.ws + WS_LRUSUM); float* sumB = sumA + NBATCH * 64 * DLRU; float* metaB = sumB + NBATCH * 64 * DLRU;
    __syncthreads();
    {
        const int ch0 = (tid & 127) * 8, tq = tid >> 7;
        f32x4 cw[4][2], cb[2];
#pragma unroll
        for (int jj = 0; jj < 4; ++jj) { cw[jj][0] = *(const f32x4*)(a.in[I_CONV_W] + jj * DLRU + ch0); cw[jj][1] = *(const f32x4*)(a.in[I_CONV_W] + jj * DLRU + ch0 + 4); }
        cb[0] = *(const f32x4*)(a.in[I_CONV_B] + ch0); cb[1] = *(const f32x4*)(a.in[I_CONV_B] + ch0 + 4);
#pragma unroll 1
        for (int i0 = 0; i0 < 8; i0 += 4) {
            u32x4 x[4][4];
#pragma unroll
            for (int i = 0; i < 4; ++i) { const int tl = tq + 4 * (i0 + i); const int t = meta ? tl : NMETA + 32 * c + tl;
#pragma unroll
                for (int jj = 0; jj < 4; ++jj) { const int tt = t - 3 + jj; x[i][jj] = (u32x4){0u, 0u, 0u, 0u};
                    if (tt >= 0 && !(meta && tl >= NMETA)) x[i][jj] = *(const u32x4*)(Z + (size_t)tok_row(b, tt) * DIN + ZX + ch0); } }
#pragma unroll
            for (int i = 0; i < 4; ++i) { const int tl = tq + 4 * (i0 + i); const int t = meta ? tl : NMETA + 32 * c + tl;
                f32x4 a0 = cb[0], a1 = cb[1];
#pragma unroll
                for (int jj = 0; jj < 4; ++jj) { const u32x4 xx = x[i][jj];
                    if (t - 3 + jj >= 0) {
                        a0.x += cw[jj][0].x * bflo(xx[0]); a0.y += cw[jj][0].y * bfhi(xx[0]); a0.z += cw[jj][0].z * bflo(xx[1]); a0.w += cw[jj][0].w * bfhi(xx[1]);
                        a1.x += cw[jj][1].x * bflo(xx[2]); a1.y += cw[jj][1].y * bfhi(xx[2]); a1.z += cw[jj][1].z * bflo(xx[3]); a1.w += cw[jj][1].w * bfhi(xx[3]); } }
                u32x4 o = (u32x4){pk2(a0.x, a0.y), pk2(a0.z, a0.w), pk2(a1.x, a1.y), pk2(a1.z, a1.w)};
                if (meta && tl >= NMETA) o = (u32x4){0u, 0u, 0u, 0u};
                *(LAS u32x4*)(lds + tl * LR_XS + ch0 * 2) = o; }
        }
    }
    LAS float* hinL = (LAS float*)(lds + 32 * LR_XS);
    if (PASS == 1) {
        float h0 = metaB[tid], h1 = metaB[tid + 512];
        const float* pa = sumA + (size_t)b * 64 * DLRU + tid; const float* pb = sumB + (size_t)b * 64 * DLRU + tid;
#pragma unroll 8
        for (int jc = 0; jc < c; ++jc) { h0 = pa[jc * DLRU] * h0 + pb[jc * DLRU]; h1 = pa[jc * DLRU + 512] * h1 + pb[jc * DLRU + 512]; }
        hinL[tid] = h0; hinL[tid + 512] = h1;
    }
    __syncthreads();
    const bf16* WaT = (const bf16*)(a.ws + WS_WAT); const bf16* WiT = (const bf16*)(a.ws + WS_WIT);
    const int r31 = lane & 31, h = lane >> 5;
    const int tau = 16 * ((r31 >> 2) & 1) + 4 * (r31 >> 3) + (r31 & 3);
#pragma unroll 1
    for (int nb = 0; nb < 2; ++nb) {
        const int n = 2 * wave + nb;
        bf16x8 af[4];
#pragma unroll
        for (int ks = 0; ks < 4; ++ks) af[ks] = *(const LAS bf16x8*)(lds + tau * LR_XS + (64 * n + 16 * ks + 8 * h) * 2);
#pragma unroll 1
        for (int nt = 0; nt < 2; ++nt) {
            const int ch = 64 * n + 32 * nt + r31;
            f32x16 accR, accI;
#pragma unroll
            for (int r = 0; r < 16; ++r) { accR[r] = 0.f; accI[r] = 0.f; }
#pragma unroll
            for (int ks = 0; ks < 4; ++ks) {
                const bf16x8 wa = *(const bf16x8*)(WaT + ((size_t)(n * 64 + 32 * nt + r31) * 64 + 16 * ks + 8 * h));
                const bf16x8 wi = *(const bf16x8*)(WiT + ((size_t)(n * 64 + 32 * nt + r31) * 64 + 16 * ks + 8 * h));
                accR = __builtin_amdgcn_mfma_f32_32x32x16_bf16(af[ks], wa, accR, 0, 0, 0);
                accI = __builtin_amdgcn_mfma_f32_32x32x16_bf16(af[ks], wi, accI, 0, 0, 0);
            }
            const float ba = a.in[I_B_A][ch], bi = a.in[I_B_I][ch], sp8 = -8.0f * 1.4426950408889634f * log1pf(__expf(-a.in[I_LAMBDA][ch]));
            float av[16], bv[16];
            float Ap = 1.0f, Bp = 0.0f;
#pragma unroll
            for (int r = 0; r < 16; ++r) {
                const float xcv = bf2f(*(const LAS unsigned short*)(lds + (16 * h + r) * LR_XS + ch * 2));
                const float rg = fast_sigmoid(accR[r] + ba), ig = fast_sigmoid(accI[r] + bi);
                av[r] = __builtin_amdgcn_exp2f(sp8 * rg); bv[r] = __builtin_amdgcn_sqrtf(fmaxf(fmaf(-av[r], av[r], 1.0f), 0.0f)) * ig * xcv;
                Ap *= av[r]; Bp = av[r] * Bp + bv[r];
            }
            const float Ao = __shfl_xor(Ap, 32), Bo = __shfl_xor(Bp, 32);
            if (PASS == 0) {
                if (h == 0) {
                    if (meta) metaB[ch] = Bp;
                    else { sumA[((size_t)b * 64 + c) * DLRU + ch] = Ap * Ao; sumB[((size_t)b * 64 + c) * DLRU + ch] = Ao * Bp + Bo; }
                }
            } else {
                const float hin = hinL[ch];
                float hs = h == 0 ? hin : (Ao * hin + Bo);
#pragma unroll
                for (int r = 0; r < 16; ++r) {
                    hs = av[r] * hs + bv[r];
                    const int tl = 16 * h + r;
                    const float gt = bf2f(Z[(size_t)(b * SEQ + 32 * c + tl) * DIN + ZG + ch]);
                    *(LAS unsigned short*)(lds + tl * LR_XS + ch * 2) = (unsigned short)f2bf(hs * fast_gelu_tanh(gt));
                }
            }
        }
    }
    if (PASS == 1) {
        bf16* O = (bf16*)(a.ws + WS_O);
        u32x4 aw[4][2];
#pragma unroll
        for (int q = 0; q < 4; ++q)
#pragma unroll
            for (int jj = 0; jj < 2; ++jj) aw[q][jj] = *(const u32x4*)(O + ((size_t)b * SEQ + 32 * c + 4 * wave + q) * D + (lane + 64 * jj) * 8);
        f32x4 ga[2][2], gl[2][2];
#pragma unroll
        for (int jj = 0; jj < 2; ++jj) { ga[jj][0] = *(const f32x4*)(a.in[I_G_ATTN] + (lane + 64 * jj) * 8); ga[jj][1] = *(const f32x4*)(a.in[I_G_ATTN] + (lane + 64 * jj) * 8 + 4);
            gl[jj][0] = *(const f32x4*)(a.in[I_G_LRU] + (lane + 64 * jj) * 8); gl[jj][1] = *(const f32x4*)(a.in[I_G_LRU] + (lane + 64 * jj) * 8 + 4); }
        __syncthreads();
#pragma unroll
        for (int q = 0; q < 4; ++q) {
            const int tl = 4 * wave + q; const size_t row = (size_t)b * SEQ + 32 * c + tl;
#pragma unroll
            for (int half = 0; half < 2; ++half) {
                u32x4 w[2]; float v[16]; float ss = 0.f;
#pragma unroll
                for (int jj = 0; jj < 2; ++jj) { w[jj] = half == 0 ? *(const LAS u32x4*)(lds + tl * LR_XS + (lane + 64 * jj) * 16) : aw[q][jj];
#pragma unroll
                    for (int k = 0; k < 4; ++k) { v[jj * 8 + 2 * k] = bflo(w[jj][k]); v[jj * 8 + 2 * k + 1] = bfhi(w[jj][k]); } }
#pragma unroll
                for (int k = 0; k < 16; ++k) ss += v[k] * v[k];
                ss = wave_sum(ss);
                const float rstd = __builtin_amdgcn_rsqf(ss * (1.0f / 1024.0f) + EPS);
#pragma unroll
                for (int jj = 0; jj < 2; ++jj) { const f32x4 g0 = half == 0 ? gl[jj][0] : ga[jj][0], g1 = half == 0 ? gl[jj][1] : ga[jj][1];
                    const u32x4 o = (u32x4){pk2(v[jj * 8 + 0] * rstd * g0.x, v[jj * 8 + 1] * rstd * g0.y), pk2(v[jj * 8 + 2] * rstd * g0.z, v[jj * 8 + 3] * rstd * g0.w),
                                            pk2(v[jj * 8 + 4] * rstd * g1.x, v[jj * 8 + 5] * rstd * g1.y), pk2(v[jj * 8 + 6] * rstd * g1.z, v[jj * 8 + 7] * rstd * g1.w)};
                    *(u32x4*)(O + row * D + (half == 0 ? 1024 : 0) + (lane + 64 * jj) * 8) = o; }
            }
        }
    }
}

__device__ __forceinline__ void phase_attn_naive(const Args& a, int lane, int wave) {
    const int gw = blockIdx.x * 8 + wave, NGW = gridDim.x * 8;
    const bf16* Z = (const bf16*)(a.ws + WS_Z); bf16* O = (bf16*)(a.ws + WS_O);
    const float* cosT = (const float*)(a.ws + WS_COS); const float* sinT = (const float*)(a.ws + WS_SIN);
    const int j = lane & 31;
    for (int it = gw; it < MREAL * 16; it += NGW) {
        const int head = it & 15, row = it >> 4, b = row >> 11, s = row & 2047, t = NMETA + s, kvh = head >> 2;
        const float qv = bf2f(Z[(size_t)row * DIN + ZQ + head * 64 + lane]);
        const float qo = __shfl_xor(qv, 32);
        float c = cosT[t * 32 + j], sn = sinT[t * 32 + j];
        const float q = 0.125f * (lane < 32 ? qv * c - qo * sn : qv * c + qo * sn);
        float m = a.in[I_SINKS][head], l = 1.f, o = 0.f;
        const int nk = NMETA + (s + 1 < 128 ? s + 1 : 128);
        for (int kk = 0; kk < nk; ++kk) {
            int krow, kpos;
            if (kk < NMETA) { krow = METAROW0 + kk; kpos = kk; } else { const int sp = s - (kk - NMETA); krow = b * SEQ + sp; kpos = NMETA + sp; }
            const float kv = bf2f(Z[(size_t)krow * DIN + ZK + kvh * 64 + lane]);
            const float ko = __shfl_xor(kv, 32);
            c = cosT[kpos * 32 + j]; sn = sinT[kpos * 32 + j];
            const float kr = lane < 32 ? kv * c - ko * sn : kv * c + ko * sn;
            const float sc = wave_sum(q * kr);
            const float mn = fmaxf(m, sc), al = __expf(m - mn), p = __expf(sc - mn);
            const float vv = bf2f(Z[(size_t)krow * DIN + ZV + kvh * 64 + lane]);
            l = l * al + p; o = o * al + p * vv; m = mn;
        }
        O[(size_t)row * D + head * 64 + lane] = (bf16)f2bf(o / l);
    }
}

__device__ __forceinline__ void phase_lru_xc(const Args& a, int tid) {
    const int gt = blockIdx.x * 512 + tid, NGT = gridDim.x * 512;
    const bf16* Z = (const bf16*)(a.ws + WS_Z); float* XC = (float*)(a.ws + WS_XC);
    for (int idx = gt; idx < MVALID * DLRU; idx += NGT) {
        const int row = idx >> 10, c = idx & 1023;
        const int b = row < MREAL ? (row >> 11) : 0, t = row < MREAL ? NMETA + (row & 2047) : row - MREAL;
        float acc = a.in[I_CONV_B][c];
#pragma unroll
        for (int jj = 0; jj < 4; ++jj) { const int tt = t - 3 + jj;
            if (tt >= 0) acc += a.in[I_CONV_W][jj * DLRU + c] * bf2f(Z[(size_t)tok_row(b, tt) * DIN + ZX + c]); }
        XC[idx] = acc;
    }
}
__device__ __forceinline__ void phase_lru_gates(const Args& a, int tid) {
    const int gt = blockIdx.x * 512 + tid, NGT = gridDim.x * 512;
    const float* XC = (const float*)(a.ws + WS_XC); float* AA = (float*)(a.ws + WS_AA); float* BB = (float*)(a.ws + WS_BB);
    for (int idx = gt; idx < MVALID * DLRU; idx += NGT) {
        const int row = idx >> 10, c = idx & 1023, n = c >> 6, d = c & 63;
        float ra = a.in[I_B_A][c], ri = a.in[I_B_I][c];
        const float* xr = XC + (size_t)row * DLRU + n * 64;
        const float* wa = a.in[I_W_A] + (size_t)n * 4096 + d; const float* wi = a.in[I_W_I] + (size_t)n * 4096 + d;
        for (int cc = 0; cc < 64; ++cc) { const float xv = xr[cc]; ra += xv * wa[cc * 64]; ri += xv * wi[cc * 64]; }
        const float r = sigmoidf_(ra), ig = sigmoidf_(ri);
        const float sp = log1pf(expf(-a.in[I_LAMBDA][c]));
        const float log_a = -8.0f * r * sp;
        AA[idx] = expf(log_a);
        BB[idx] = sqrtf(-expm1f(2.0f * log_a)) * ig * XC[idx];
    }
}
__device__ __forceinline__ void phase_lru_scan(const Args& a, int tid) {
    const int gt = blockIdx.x * 512 + tid;
    if (gt >= NBATCH * DLRU) return;
    const int b = gt >> 10, c = gt & 1023;
    const float* AA = (const float*)(a.ws + WS_AA); const float* BB = (const float*)(a.ws + WS_BB); float* YL = (float*)(a.ws + WS_YL);
    const bf16* Z = (const bf16*)(a.ws + WS_Z);
    float h = 0.f;
    for (int t = 0; t < NMETA; ++t) { const int row = METAROW0 + t; h = AA[(size_t)row * DLRU + c] * h + BB[(size_t)row * DLRU + c]; }
#pragma unroll 8
    for (int s = 0; s < SEQ; ++s) { const size_t row = (size_t)b * SEQ + s;
        h = AA[row * DLRU + c] * h + BB[row * DLRU + c];
        YL[row * DLRU + c] = h * gelu_tanh(bf2f(Z[row * DIN + ZG + c])); }
}
__device__ __forceinline__ void phase_norm_o(const Args& a, int lane, int wave) {
    const int gw = blockIdx.x * 8 + wave, NGW = gridDim.x * 8;
    bf16* O = (bf16*)(a.ws + WS_O); const float* YL = (const float*)(a.ws + WS_YL);
    for (int row = gw; row < MREAL; row += NGW) {
        u32x4* op = (u32x4*)(O + (size_t)row * D);
        u32x4 w[2]; float v[16]; float ss = 0.f;
#pragma unroll
        for (int j = 0; j < 2; ++j) { w[j] = op[lane + 64 * j];
#pragma unroll
            for (int q = 0; q < 4; ++q) { v[j * 8 + 2 * q] = bf2f(w[j][q]); v[j * 8 + 2 * q + 1] = bf2f(w[j][q] >> 16); } }
#pragma unroll
        for (int i = 0; i < 16; ++i) ss += v[i] * v[i];
        ss = wave_sum(ss);
        float rstd = 1.0f / sqrtf(ss * (1.0f / 1024.0f) + EPS);
#pragma unroll
        for (int j = 0; j < 2; ++j) { const float* g = a.in[I_G_ATTN] + (lane + 64 * j) * 8; u32x4 o;
#pragma unroll
            for (int q = 0; q < 4; ++q) o[q] = pk2(v[j * 8 + 2 * q] * rstd * g[2 * q], v[j * 8 + 2 * q + 1] * rstd * g[2 * q + 1]);
            op[lane + 64 * j] = o; }
        const f32x4* yp = (const f32x4*)(YL + (size_t)row * DLRU);
        f32x4 y[4]; ss = 0.f;
#pragma unroll
        for (int j = 0; j < 4; ++j) { y[j] = yp[lane + 64 * j]; ss += (y[j].x * y[j].x + y[j].y * y[j].y) + (y[j].z * y[j].z + y[j].w * y[j].w); }
        ss = wave_sum(ss);
        rstd = 1.0f / sqrtf(ss * (1.0f / 1024.0f) + EPS);
        u32x2* o2 = (u32x2*)(O + (size_t)row * D + 1024);
#pragma unroll
        for (int j = 0; j < 4; ++j) { const f32x4 g = ((const f32x4*)a.in[I_G_LRU])[lane + 64 * j];
            o2[lane + 64 * j] = (u32x2){pk2(y[j].x * rstd * g.x, y[j].y * rstd * g.y), pk2(y[j].z * rstd * g.z, y[j].w * rstd * g.w)}; }
    }
}

__device__ __forceinline__ void phase_router(const Args& a, int lane, int wave) {
    const int gw = blockIdx.x * 8 + wave, NGW = gridDim.x * 8;
    const float* H1 = (const float*)(a.ws + WS_H1);
    int* tope = (int*)(a.ws + WS_TOPE); float* topw = (float*)(a.ws + WS_TOPW); float* rstd2 = (float*)(a.ws + WS_RSTD2);
    unsigned* counts = (unsigned*)(a.ws + WS_CTL) + CW_COUNTS;
    const float* wr = a.in[I_W_ROUTER]; const float* nf = a.in[I_NORM_FFN];
    for (int row = gw; row < MREAL; row += NGW) {
        const float* hr = H1 + (size_t)row * D;
        float ss = 0.f;
#pragma unroll
        for (int j = 0; j < 8; ++j) { const f32x4 v = ((const f32x4*)hr)[lane + 64 * j]; ss += (v.x * v.x + v.y * v.y) + (v.z * v.z + v.w * v.w); }
        ss = wave_sum(ss);
        const float rstd = 1.0f / sqrtf(ss * (1.0f / D) + EPS);
        const int e = lane & 31, kh = lane >> 5;
        float acc = 0.f;
        for (int k = kh * 1024; k < kh * 1024 + 1024; ++k) acc += (hr[k] * rstd * nf[k]) * wr[k * NEXP + e];
        acc += __shfl_xor(acc, 32);
        float val = lane < 32 ? acc + a.in[I_B_ROUTER][e] : -3.0e38f;
        float tv[4]; int te[4];
#pragma unroll
        for (int r = 0; r < 4; ++r) {
            const float mx = wave_max(val);
            const unsigned long long msk = __ballot(val == mx);
            const int win = __ffsll((long long)msk) - 1;
            tv[r] = mx; te[r] = win;
            if (lane == win) val = -3.0e38f;
        }
        const float e1 = __expf(tv[1] - tv[0]), e2 = __expf(tv[2] - tv[0]), e3 = __expf(tv[3] - tv[0]);
        const float inv = 1.0f / (1.0f + e1 + e2 + e3);
        if (lane == 0) {
            rstd2[row] = rstd;
            tope[row * 4 + 0] = te[0]; tope[row * 4 + 1] = te[1]; tope[row * 4 + 2] = te[2]; tope[row * 4 + 3] = te[3];
            topw[row * 4 + 0] = inv; topw[row * 4 + 1] = e1 * inv; topw[row * 4 + 2] = e2 * inv; topw[row * 4 + 3] = e3 * inv;
            atomicAdd(&counts[te[0]], 1u); atomicAdd(&counts[te[1]], 1u); atomicAdd(&counts[te[2]], 1u); atomicAdd(&counts[te[3]], 1u);
        }
    }
}


__device__ __forceinline__ void phase_router_mfma(const Args& a, LAS unsigned char* lds, int tid, int lane, int wave) {
    const bf16* H1 = (const bf16*)(a.ws + WS_H1); const bf16* WRT = (const bf16*)(a.ws + WS_WRT);
    int* tope = (int*)(a.ws + WS_TOPE); float* topw = (float*)(a.ws + WS_TOPW); float* rstd2 = (float*)(a.ws + WS_RSTD2);
    unsigned* counts = (unsigned*)(a.ws + WS_CTL) + CW_COUNTS;
    LAS float* lg = (LAS float*)(lds + wave * 2048);
    LAS int* hist = (LAS int*)(lds + 32768);
    if (tid < 32) hist[tid] = 0;
    __syncthreads();
    const int fr = lane & 15, fq = lane >> 4;
    for (int grp = wave * gridDim.x + blockIdx.x; grp < MREAL / 16; grp += 8 * gridDim.x) {
        const int row0 = grp * 16;
        const bf16* hp = H1 + (size_t)(row0 + fr) * D + 8 * fq;
        const bf16* wp = WRT + (size_t)fr * D + 8 * fq;
        f32x4 acc0 = (f32x4){0.f, 0.f, 0.f, 0.f}, acc1 = acc0; float ss = 0.f;
#pragma unroll 4
        for (int kk = 0; kk < 64; ++kk) {
            const u32x4 w = *(const u32x4*)(hp + 32 * kk);
#pragma unroll
            for (int q = 0; q < 4; ++q) { const float lo = bflo(w[q]), hi = bfhi(w[q]); ss += lo * lo + hi * hi; }
            const bf16x8 af = __builtin_bit_cast(bf16x8, w);
            const bf16x8 b0 = *(const bf16x8*)(wp + 32 * kk), b1 = *(const bf16x8*)(wp + (size_t)16 * D + 32 * kk);
            acc0 = __builtin_amdgcn_mfma_f32_16x16x32_bf16(af, b0, acc0, 0, 0, 0);
            acc1 = __builtin_amdgcn_mfma_f32_16x16x32_bf16(af, b1, acc1, 0, 0, 0);
        }
        ss += __shfl_xor(ss, 16); ss += __shfl_xor(ss, 32);
        const float rstd = 1.0f / sqrtf(ss * (1.0f / D) + EPS);
        if (fq == 0) rstd2[row0 + fr] = rstd;
        const float br0 = a.in[I_B_ROUTER][fr], br1 = a.in[I_B_ROUTER][16 + fr];
#pragma unroll
        for (int j = 0; j < 4; ++j) { const int row = 4 * fq + j; const float rs = __shfl(rstd, row);
            lg[row * 32 + fr] = acc0[j] * rs + br0; lg[row * 32 + 16 + fr] = acc1[j] * rs + br1; }
        asm volatile("s_waitcnt lgkmcnt(0)" ::: "memory");
        if (lane < 16) {
            float v[32];
#pragma unroll
            for (int q = 0; q < 8; ++q) { const f32x4 t = *(const LAS f32x4*)(lg + lane * 32 + 4 * q); v[4 * q] = t.x; v[4 * q + 1] = t.y; v[4 * q + 2] = t.z; v[4 * q + 3] = t.w; }
            float tv[4]; int te[4];
#pragma unroll
            for (int r = 0; r < 4; ++r) { float best = -3.0e38f; int bi = 0;
#pragma unroll
                for (int e = 0; e < 32; ++e) { const bool gtb = v[e] > best; best = gtb ? v[e] : best; bi = gtb ? e : bi; }
#pragma unroll
                for (int e = 0; e < 32; ++e) v[e] = (e == bi) ? -3.0e38f : v[e];
                tv[r] = best; te[r] = bi; }
            const float e1 = __expf(tv[1] - tv[0]), e2 = __expf(tv[2] - tv[0]), e3 = __expf(tv[3] - tv[0]);
            const float inv = 1.0f / (1.0f + e1 + e2 + e3);
            const int row = row0 + lane;
            *(int4*)(tope + row * 4) = make_int4(te[0], te[1], te[2], te[3]);
            *(f32x4*)(topw + row * 4) = (f32x4){inv, e1 * inv, e2 * inv, e3 * inv};
#pragma unroll
            for (int r = 0; r < 4; ++r) atomicAdd((int*)&hist[te[r]], 1);
        }
        asm volatile("s_waitcnt lgkmcnt(0)" ::: "memory");
    }
    __syncthreads();
    if (tid < 32 && hist[tid] != 0) atomicAdd(&counts[tid], (unsigned)hist[tid]);
}

__device__ __forceinline__ void build_tile_table(const Args& a, LAS int* tstart, int tid) {
    if (tid == 0) {
        const unsigned* counts = (const unsigned*)(a.ws + WS_CTL) + CW_COUNTS;
        int acc = 0;
        for (int e = 0; e < NEXP; ++e) { tstart[e] = acc; acc += (int)((__hip_atomic_load(counts + e, __ATOMIC_RELAXED, __HIP_MEMORY_SCOPE_AGENT) + 255u) >> 8); }
        tstart[NEXP] = acc;
    }
    __syncthreads();
}
__device__ __forceinline__ int tile_expert(const LAS int* tstart, int tile) {
    int e = 0;
#pragma unroll 1
    for (int i = 1; i < NEXP; ++i) e += (tstart[i] <= tile) ? 1 : 0;
    return e;
}

__device__ __forceinline__ void phase_assign(const Args& a, LAS unsigned char* lds, int tid, int lane, int wave) {
    LAS int* tstart = (LAS int*)(lds + LDS_TAB);
    LAS int* hist = tstart + 64; LAS int* base = hist + 32; LAS int* spos = base + 32;
    build_tile_table(a, tstart, tid);
    const int* tope = (const int*)(a.ws + WS_TOPE); const float* topw = (const float*)(a.ws + WS_TOPW); const float* rstd2 = (const float*)(a.ws + WS_RSTD2);
    int* rowpair = (int*)(a.ws + WS_ROWPAIR); float* roww = (float*)(a.ws + WS_ROWW);
    unsigned* cursor = (unsigned*)(a.ws + WS_CTL) + CW_CURSOR;
    const bf16* H1 = (const bf16*)(a.ws + WS_H1); unsigned char* XS = (unsigned char*)(a.ws + WS_XS);
    for (int blk = blockIdx.x; blk < MREAL / 64; blk += gridDim.x) {
        if (tid < 32) hist[tid] = 0;
        __syncthreads();
        int e = 0, rank = 0, pair = 0;
        if (tid < 256) { pair = blk * 256 + tid; e = tope[pair]; rank = atomicAdd((int*)&hist[e], 1); }
        __syncthreads();
        if (tid < 32) base[tid] = (int)atomicAdd(&cursor[tid], (unsigned)hist[tid]);
        __syncthreads();
        if (tid < 256) { const int pos = tstart[e] * 256 + base[e] + rank; spos[tid] = pos; rowpair[pos] = pair; roww[pos] = topw[pair]; }
        __syncthreads();
        for (int tt = wave * 8; tt < wave * 8 + 8; ++tt) {
            const int token = blk * 64 + tt; const float rstd = rstd2[token] * XS_SCALE;
            const u32x4* hr = (const u32x4*)(H1 + (size_t)token * D);
            u32x2 o[4];
#pragma unroll
            for (int j = 0; j < 4; ++j) { const u32x4 hv = hr[lane + 64 * j];
                const f32x4 g0 = ((const f32x4*)a.in[I_NORM_FFN])[2 * (lane + 64 * j)], g1 = ((const f32x4*)a.in[I_NORM_FFN])[2 * (lane + 64 * j) + 1];
                o[j] = (u32x2){pk4_fp8(bflo(hv[0]) * rstd * g0.x, bfhi(hv[0]) * rstd * g0.y, bflo(hv[1]) * rstd * g0.z, bfhi(hv[1]) * rstd * g0.w),
                               pk4_fp8(bflo(hv[2]) * rstd * g1.x, bfhi(hv[2]) * rstd * g1.y, bflo(hv[3]) * rstd * g1.z, bfhi(hv[3]) * rstd * g1.w)}; }
#pragma unroll
            for (int k = 0; k < 4; ++k) { u32x2* dst = (u32x2*)(XS + (size_t)spos[tt * 4 + k] * D);
#pragma unroll
                for (int j = 0; j < 4; ++j) dst[lane + 64 * j] = o[j]; }
        }
        __syncthreads();
    }
}

__device__ __forceinline__ void phase_final(const Args& a, int lane, int wave) {
    const int gw = blockIdx.x * 8 + wave, NGW = gridDim.x * 8;
    const bf16* H1 = (const bf16*)(a.ws + WS_H1); const bf16* YB = (const bf16*)(a.ws + WS_YB);
    for (int row = gw; row < MREAL; row += NGW) {
        f32x4 v[8]; float ss = 0.f;
#pragma unroll
        for (int j = 0; j < 8; ++j) { { const u32x2 hh = ((const u32x2*)(H1 + (size_t)row * D))[lane + 64 * j]; v[j] = (f32x4){bflo(hh.x), bfhi(hh.x), bflo(hh.y), bfhi(hh.y)}; }
#pragma unroll
            for (int k = 0; k < 4; ++k) { const u32x2 y = ((const u32x2*)(YB + ((size_t)row * 4 + k) * D))[lane + 64 * j];
                v[j].x += bf2f(y.x); v[j].y += bf2f(y.x >> 16); v[j].z += bf2f(y.y); v[j].w += bf2f(y.y >> 16); }
            ss += (v[j].x * v[j].x + v[j].y * v[j].y) + (v[j].z * v[j].z + v[j].w * v[j].w); }
        ss = wave_sum(ss);
        const float rstd = 1.0f / sqrtf(ss * (1.0f / D) + EPS);
        f32x4* op = (f32x4*)(a.out + (size_t)row * D);
#pragma unroll
        for (int j = 0; j < 8; ++j) { const f32x4 g = ((const f32x4*)a.in[I_FINAL_NORM])[lane + 64 * j]; op[lane + 64 * j] = v[j] * rstd * g; }
    }
}

enum { PH_PROLOGUE = 0, PH_G1, PH_ATTN, PH_LRU_B, PH_G2, PH_ROUTER, PH_ASSIGN, PH_G3, PH_G4, PH_FINAL, PH_COUNT };

__global__ void __launch_bounds__(512, 2) fwd(Args a) {
    extern __shared__ __attribute__((aligned(16))) unsigned char lds_raw[];
    LAS unsigned char* lds = (LAS unsigned char*)lds_raw;
    const int tid = threadIdx.x, lane = tid & 63, wave = __builtin_amdgcn_readfirstlane(tid >> 6);
    const int gw = blockIdx.x * 8 + wave, NGW = gridDim.x * 8;
    unsigned char* ws = a.ws;
#define IN(k) (a.ph_lo <= (k) && (k) < a.ph_hi)
#define SEAM(k) do { if (IN(k) && IN((k) + 1)) xcd_barrier(bar); } while (0)
    if (tid < 4) ((LAS unsigned*)(lds + LDS_MISC))[tid] = 0u;
    __syncthreads();
    XcdBarrier bar; bar.bar = (unsigned*)(ws + WS_CTL) + CW_BAR; bar.x = 0; bar.st = nullptr;
    if (a.ph_hi - a.ph_lo > 1) bar = xcd_barrier_post((unsigned*)(ws + WS_CTL) + CW_BAR, (volatile LAS unsigned*)(lds + LDS_MISC));

    if (IN(PH_PROLOGUE)) { phase_prologue(a, lds, tid, lane, wave);
#if PROBE_REPEAT == 0
        __syncthreads(); phase_prologue(a, lds, tid, lane, wave);
#endif
    }
    SEAM(PH_PROLOGUE);

    if (IN(PH_G1)) {
        pg8::SchedDense S{(const char*)(ws + WS_N1), (const char*)(ws + WS_WINT), MROWS / 256, DIN / 256, (int)gridDim.x, (int)blockIdx.x};
        pg8::EpiZ E{(bf16*)(ws + WS_Z), a.in[I_B_IN]};
        pg8::gemm_phase<false>(lds, S, E);
#if PROBE_REPEAT == 1
        __syncthreads(); pg8::gemm_phase<false>(lds, S, E);
#endif
    }
    SEAM(PH_G1);
    if (IN(PH_ATTN)) {
        for (int it = blockIdx.x; it < NBATCH * 16 * 4; it += gridDim.x) attn_item(a, lds, it, tid, lane, wave);
        for (int it = blockIdx.x; it < NBATCH * 65; it += gridDim.x) { if (it % 65 == 64 && it != 64) continue; lru_item<0>(a, lds, it, tid, lane, wave); }
#if PROBE_REPEAT == 2
        for (int it = blockIdx.x; it < NBATCH * 16 * 4; it += gridDim.x) attn_item(a, lds, it, tid, lane, wave);
#endif
#if PROBE_REPEAT == 3
        for (int it = blockIdx.x; it < NBATCH * 65; it += gridDim.x) { if (it % 65 == 64 && it != 64) continue; lru_item<0>(a, lds, it, tid, lane, wave); }
#endif
    }
    SEAM(PH_ATTN);
    if (IN(PH_LRU_B)) {
        for (int it = blockIdx.x; it < NBATCH * 65; it += gridDim.x) { if (it % 65 == 64) continue; lru_item<1>(a, lds, it, tid, lane, wave); }
    }
    SEAM(PH_LRU_B);
    if (IN(PH_G2)) {
        pg8::SchedDense S{(const char*)(ws + WS_O), (const char*)(ws + WS_WOUTT), MREAL / 256, D / 256, (int)gridDim.x, (int)blockIdx.x};
        pg8::EpiH1 E{(bf16*)(ws + WS_H1), a.in[I_X], a.in[I_B_OUT]};
        pg8::gemm_phase<false>(lds, S, E);
#if PROBE_REPEAT == 4
        __syncthreads(); pg8::gemm_phase<false>(lds, S, E);
#endif
    }
    SEAM(PH_G2);
    if (IN(PH_ROUTER)) phase_router_mfma(a, lds, tid, lane, wave);
    SEAM(PH_ROUTER);
    if (IN(PH_ASSIGN)) phase_assign(a, lds, tid, lane, wave);
    SEAM(PH_ASSIGN);
    if (IN(PH_G3)) {
        LAS int* tstart = (LAS int*)(lds + LDS_TAB);
        build_tile_table(a, tstart, tid);
        pg8::SchedMoE S{(const char*)(ws + WS_XS), (const char*)(ws + WS_WGT), (const char*)(ws + WS_WUT), tstart, tstart[NEXP], DFF / 128, (int)gridDim.x, (int)blockIdx.x, true};
        pg8::EpiAct E{(unsigned char*)(ws + WS_ACT), a.in[I_B_GATE], a.in[I_B_UP]};
        pg8::gemm_phase<true>(lds, S, E);
#if PROBE_REPEAT == 7
        __syncthreads(); pg8::gemm_phase<true>(lds, S, E);
#endif
    }
    SEAM(PH_G3);
    if (IN(PH_G4)) {
        LAS int* tstart = (LAS int*)(lds + LDS_TAB);
        build_tile_table(a, tstart, tid);
        pg8::SchedMoE S{(const char*)(ws + WS_ACT), (const char*)(ws + WS_WDT), (const char*)(ws + WS_WDT), tstart, tstart[NEXP], D / 256, (int)gridDim.x, (int)blockIdx.x, false};
        pg8::EpiDown E{(bf16*)(ws + WS_YB), a.in[I_B_DOWN], (const int*)(ws + WS_ROWPAIR), (const float*)(ws + WS_ROWW)};
        pg8::gemm_phase<true>(lds, S, E);
#if PROBE_REPEAT == 8
        __syncthreads(); pg8::gemm_phase<true>(lds, S, E);
#endif
    }
    SEAM(PH_G4);
    if (IN(PH_FINAL)) { phase_final(a, lane, wave);
#if PROBE_REPEAT == 9
        phase_final(a, lane, wave);
#endif
    }
#undef IN
#undef SEAM
}

extern "C" void kernel_launch(void* const* d_in, const int* in_sizes, int n_in, void* d_out, int out_size, void* d_ws, size_t ws_size, hipStream_t stream) {
    static int grid = 0;
    if (grid == 0) {
        if (n_in != 27 || out_size != MREAL * D || ws_size < WS_END) { fprintf(stderr, "kernel_launch: unexpected problem (n_in %d, out %d, ws %zu)\n", n_in, out_size, ws_size); grid = -1; return; }
        int dev = 0, cus = 0;
        if (hipGetDevice(&dev) != hipSuccess || hipDeviceGetAttribute(&cus, hipDeviceAttributeMultiprocessorCount, dev) != hipSuccess) { grid = -1; return; }
        if (hipFuncSetAttribute((const void*)fwd, hipFuncAttributeMaxDynamicSharedMemorySize, LDS_BYTES) != hipSuccess) { fprintf(stderr, "kernel_launch: hipFuncSetAttribute failed\n"); grid = -1; return; }
        grid = cus;
    }
    if (grid < 0) return;
    (void)hipMemsetAsync((char*)d_ws + WS_CTL, 0, CTL_BYTES, stream);
    Args a{};
    for (int i = 0; i < 27; ++i) a.in[i] = (const float*)d_in[i];
    a.out = (float*)d_out; a.ws = (unsigned char*)d_ws;
#if MK_ONE_LAUNCH
    a.ph_lo = 0; a.ph_hi = PH_COUNT;
    hipLaunchKernelGGL(fwd, dim3(grid), dim3(512), LDS_BYTES, stream, a);
#else
    for (int ph = 0; ph < PH_COUNT; ++ph) {
        a.ph_lo = ph; a.ph_hi = ph + 1;
        hipLaunchKernelGGL(fwd, dim3(grid), dim3(512), LDS_BYTES, stream, a);
    }
#endif
}
```

```cpp
#include <hip/hip_runtime.h>
#include <cstdio>
#include <cstdint>

#define LAS __attribute__((address_space(3)))
#ifndef PROBE_REPEAT
#define PROBE_REPEAT -1
#endif
#ifndef G1_FP8
#define G1_FP8 0
#endif
#ifndef G2_FP8
#define G2_FP8 0
#endif
#ifndef BG_WDOWN
#define BG_WDOWN 1
#endif
#ifndef MK_ONE_LAUNCH
#define MK_ONE_LAUNCH 1
#endif
typedef unsigned short bf16;
typedef float f32x4 __attribute__((ext_vector_type(4)));
typedef short bf16x8 __attribute__((ext_vector_type(8)));
typedef unsigned u32x4 __attribute__((ext_vector_type(4)));
typedef unsigned u32x2 __attribute__((ext_vector_type(2)));

constexpr int D = 2048, SEQ = 2048, NMETA = 16, TT = 2064, NBATCH = 8;
constexpr int MREAL = 16384, METAROW0 = 16384, MVALID = 16400, MROWS = 16640;
constexpr int DIN = 3584, DLRU = 1024, HD = 64;
constexpr int ZQ = 0, ZK = 1024, ZV = 1280, ZX = 1536, ZG = 2560;
constexpr int NEXP = 32, DFF = 2048, PROWS = 73728;
constexpr float EPS = 1e-5f;

constexpr size_t MiB = 1u << 20;
constexpr size_t WS_CTL = 0, CTL_BYTES = 1 * MiB;
constexpr size_t WS_COS = 1 * MiB, WS_SIN = 1 * MiB + 320 * 1024;
constexpr size_t WS_TOPE = 2 * MiB, WS_TOPW = WS_TOPE + 256 * 1024, WS_RSTD2 = WS_TOPW + 256 * 1024, WS_ROWPAIR = WS_RSTD2 + 64 * 1024, WS_ROWW = WS_ROWPAIR + 320 * 1024;
constexpr size_t WS_DUMMY = 3 * MiB + 512 * 1024;
constexpr size_t WS_LRUSUM = 4 * MiB;
constexpr size_t WS_WAT = 9 * MiB, WS_WIT = WS_WAT + 128 * 1024, WS_WRT = WS_WIT + 128 * 1024;
constexpr size_t WS_WINT = 10 * MiB, WS_WOUTT = 24 * MiB, WS_WGT = 32 * MiB, WS_WUT = 288 * MiB, WS_WDT = 544 * MiB;
constexpr size_t WS_N1 = 800 * MiB, WS_Z = 866 * MiB, WS_O = 980 * MiB, WS_H1 = 1044 * MiB, WS_XS = 1172 * MiB, WS_YB = WS_XS, WS_ACT = 1460 * MiB, WS_END = 1748 * MiB;
constexpr size_t WS_ATT = WS_N1;
constexpr size_t WS_XC = WS_XS, WS_AA = WS_XS + 66 * MiB, WS_BB = WS_XS + 132 * MiB, WS_YL = WS_XS + 198 * MiB;
static_assert(WS_ROWW + PROWS * 4 <= WS_LRUSUM, "small map");
constexpr int CW_COUNTS = 1024, CW_CURSOR = 1088, CW_BAR = 4096;

constexpr int LDS_TAB = 131072;
constexpr int LDS_MISC = LDS_TAB + 8192;
constexpr int LDS_BG = LDS_MISC + 1024;
constexpr int LDS_T2 = LDS_BG + 16384;
constexpr int LDS_BYTES = LDS_T2 + 4352;
static_assert(LDS_BYTES <= 163840 && LDS_BG % 1024 == 0, "LDS map");

__device__ const float c_inv_freq[32] = {1.000000000e+00f, 7.498942018e-01f, 5.623413324e-01f, 4.216965139e-01f, 3.162277639e-01f, 2.371373922e-01f, 1.778279394e-01f, 1.333521456e-01f, 1.000000015e-01f, 7.498941571e-02f, 5.623412877e-02f, 4.216964915e-02f, 3.162277862e-02f, 2.371373586e-02f, 1.778279431e-02f, 1.333521493e-02f, 9.999999776e-03f, 7.498942316e-03f, 5.623413250e-03f, 4.216964822e-03f, 3.162277862e-03f, 2.371373819e-03f, 1.778279431e-03f, 1.333521446e-03f, 1.000000047e-03f, 7.498941850e-04f, 5.623413017e-04f, 4.216965463e-04f, 3.162277862e-04f, 2.371373848e-04f, 1.778279402e-04f, 1.333521504e-04f};

struct Args { const float* in[27]; float* out; unsigned char* ws; int ph_lo, ph_hi; };
enum { I_X = 0, I_META, I_NORM_MIX, I_W_IN, I_B_IN, I_SINKS, I_CONV_W, I_CONV_B, I_W_A, I_B_A, I_W_I, I_B_I, I_LAMBDA, I_G_ATTN, I_G_LRU, I_W_OUT, I_B_OUT, I_NORM_FFN,
       I_W_ROUTER, I_B_ROUTER, I_W_GATE, I_B_GATE, I_W_UP, I_B_UP, I_W_DOWN, I_B_DOWN, I_FINAL_NORM };


#define XB_TMO      128
#define XB_XCNT(j)  (256  + 64 * (j))
#define XB_XSUB(j)  (1280 + 64 * (j))
#define XB_XGEN(j)  (2304 + 64 * (j))
#define XB_TOP      3328
#define XB_TOPGEN   3392
#define XCD_BAR_WORDS 3456
#define XB_SPIN_CAP (1u << 18)

__device__ __forceinline__ unsigned xb_ld(unsigned* p)              { return __hip_atomic_load(p, __ATOMIC_RELAXED, __HIP_MEMORY_SCOPE_AGENT); }
__device__ __forceinline__ unsigned xb_add(unsigned* p, unsigned v) { return __hip_atomic_fetch_add(p, v, __ATOMIC_RELAXED, __HIP_MEMORY_SCOPE_AGENT); }
__device__ __forceinline__ unsigned xb_xcc_id() { return (unsigned)__builtin_amdgcn_s_getreg((3 << 11) | 20) & 0xFu; }
#define XB_SPIN(cond, bar) do { unsigned _sp = 0; while (cond) { __builtin_amdgcn_s_sleep(1); \
    if ((++_sp & 255u) == 0u) { if (xb_ld(&(bar)[XB_TMO])) break; if (_sp > XB_SPIN_CAP) { atomicAdd(&(bar)[XB_TMO], 1u); break; } } } } while (0)

struct XcdBarrier {
    unsigned* bar; unsigned x;
    volatile LAS unsigned* st;
};

__device__ __forceinline__ XcdBarrier xcd_barrier_post(unsigned* bar, volatile LAS unsigned* st) {
    XcdBarrier b; b.bar = bar; b.x = xb_xcc_id(); b.st = st;
    if (threadIdx.x == 0) (void)xb_add(&bar[XB_XCNT(b.x)], 1u);
    return b;
}
__device__ __forceinline__ void xcd_barrier_complete(unsigned* bar, unsigned x, unsigned& nloc, unsigned& nx) {
    const unsigned G = gridDim.x * gridDim.y * gridDim.z;
    unsigned sum, cnt, mine, sp = 0u;
    for (;;) {
        sum = 0u; cnt = 0u; mine = 0u;
#pragma unroll
        for (unsigned j = 0; j < 16; ++j) { const unsigned c = xb_ld(&bar[XB_XCNT(j)]); sum += c; cnt += (c > 0u) ? 1u : 0u; mine = (j == x) ? c : mine; }
        if (sum == G) break;
        __builtin_amdgcn_s_sleep(1);
        if ((++sp & 255u) == 0u) { if (xb_ld(&bar[XB_TMO])) break; if (sp > XB_SPIN_CAP) { atomicAdd(&bar[XB_TMO], 1u); break; } }
    }
    nloc = mine > 0u ? mine : 1u; nx = cnt > 0u ? cnt : 1u;
}

__device__ __forceinline__ void xcd_barrier(const XcdBarrier& b) {
    asm volatile("s_waitcnt vmcnt(0)" ::: "memory");
    __syncthreads();
    if (threadIdx.x == 0) {
        unsigned* bar = b.bar;
        __builtin_amdgcn_s_waitcnt(0);
        unsigned nloc = b.st[0], nx = b.st[1];
        if (nloc == 0u) { xcd_barrier_complete(bar, b.x, nloc, nx); b.st[0] = nloc; b.st[1] = nx; }
        const unsigned old = xb_add(&bar[XB_XSUB(b.x)], 1u);
        const unsigned gen = old / nloc;
        if (old + 1u == (gen + 1u) * nloc) {
            __builtin_amdgcn_fence(__ATOMIC_RELEASE, "agent");
            asm volatile("s_waitcnt vmcnt(0)" ::: "memory");
            const unsigned og = xb_add(&bar[XB_TOP], 1u);
            const unsigned tg = og / nx;
            if (og + 1u == (tg + 1u) * nx) xb_add(&bar[XB_TOPGEN], 1u);
            else XB_SPIN(xb_ld(&bar[XB_TOPGEN]) == tg, bar);
            __builtin_amdgcn_fence(__ATOMIC_ACQUIRE, "agent");
            xb_add(&bar[XB_XGEN(b.x)], 1u);
            asm volatile("s_waitcnt vmcnt(0)" ::: "memory");
        } else {
            XB_SPIN(xb_ld(&bar[XB_XGEN(b.x)]) == gen, bar);
            __builtin_amdgcn_fence(__ATOMIC_ACQUIRE, "agent");
            asm volatile("s_waitcnt vmcnt(0)" ::: "memory");
        }
    }
    __syncthreads();
}

__device__ __forceinline__ float bf2f(unsigned b) { return __uint_as_float((b & 0xffffu) << 16); }
__device__ __forceinline__ unsigned f2bf(float f) { unsigned u = __float_as_uint(f); return (u + 0x7fffu + ((u >> 16) & 1u)) >> 16; }
__device__ __forceinline__ unsigned pk2(float lo, float hi) { return f2bf(lo) | (f2bf(hi) << 16); }
constexpr float W_SCALE = 256.0f, XS_SCALE = 8.0f, ACT_SCALE = 4.0f;
__device__ __forceinline__ float clamp_fp8(float x) { return __builtin_amdgcn_fmed3f(x, -448.0f, 448.0f); }
__device__ __forceinline__ unsigned pk4_fp8(float a, float b, float c, float d) {
    int w = 0; w = __builtin_amdgcn_cvt_pk_fp8_f32(clamp_fp8(a), clamp_fp8(b), w, false); w = __builtin_amdgcn_cvt_pk_fp8_f32(clamp_fp8(c), clamp_fp8(d), w, true); return (unsigned)w; }
__device__ __forceinline__ float wave_sum(float v) {
#pragma unroll
    for (int o = 1; o < 64; o <<= 1) v += __shfl_xor(v, o);
    return v;
}
__device__ __forceinline__ float wave_max(float v) {
#pragma unroll
    for (int o = 1; o < 64; o <<= 1) v = fmaxf(v, __shfl_xor(v, o));
    return v;
}
__device__ __forceinline__ float sigmoidf_(float x) { return 1.0f / (1.0f + __expf(-x)); }
__device__ __forceinline__ float fast_sigmoid(float x) { return __builtin_amdgcn_rcpf(1.0f + __builtin_amdgcn_exp2f(-1.4426950408889634f * x)); }
__device__ __forceinline__ float fast_gelu_tanh(float x) { const float u2 = 1.5957691216057308f * (x + 0.044715f * x * x * x); return x * __builtin_amdgcn_rcpf(1.0f + __builtin_amdgcn_exp2f(-1.4426950408889634f * u2)); }
__device__ __forceinline__ float gelu_tanh(float x) { const float u = 0.7978845608028654f * (x + 0.044715f * x * x * x); return 0.5f * x * (1.0f + tanhf(u)); }
__device__ __forceinline__ int tok_row(int b, int t) { return t < NMETA ? METAROW0 + t : b * SEQ + (t - NMETA); }

__device__ __forceinline__ void transpose_item(const float* W, int K, int N, bf16* WT, LAS float* scr, int item, int lane) {
    const int nblk = N / 32, kb = item / nblk, nb = item % nblk, k0 = 64 * kb, n0 = 32 * nb;
#pragma unroll 8
    for (int i = 0; i < 32; ++i) { const int kk = 2 * i + (lane >> 5); scr[kk * 33 + (lane & 31)] = W[(size_t)(k0 + kk) * N + n0 + (lane & 31)]; }
    asm volatile("s_waitcnt lgkmcnt(0)" ::: "memory");
    const int c = lane & 7;
#pragma unroll
    for (int j = 0; j < 4; ++j) { const int n = (lane >> 3) + 8 * j; const LAS float* s = scr + (8 * c) * 33 + n;
        u32x4 o; o.x = pk2(s[0 * 33], s[1 * 33]); o.y = pk2(s[2 * 33], s[3 * 33]); o.z = pk2(s[4 * 33], s[5 * 33]); o.w = pk2(s[6 * 33], s[7 * 33]);
        *(u32x4*)(WT + (size_t)(n0 + n) * K + k0 + 8 * c) = o; }
    asm volatile("s_waitcnt lgkmcnt(0)" ::: "memory");
}

__device__ __forceinline__ void phase_prologue(const Args& a, LAS unsigned char* lds, int tid, int lane, int wave) {
    const int gw = blockIdx.x * 8 + wave, NGW = gridDim.x * 8;
    const int gt = blockIdx.x * 512 + tid, NGT = gridDim.x * 512;
    unsigned char* ws = a.ws;
    LAS float* scr = (LAS float*)(lds + wave * 8704);
    {
        constexpr int IT_IN = G1_FP8 ? 0 : 32 * (DIN / 32), IT_OUT = G2_FP8 ? 0 : 32 * (D / 32);
        for (int it = gw; it < IT_IN + IT_OUT; it += NGW) {
            if (it < IT_IN) transpose_item(a.in[I_W_IN], D, DIN, (bf16*)(ws + WS_WINT), scr, it, lane);
            else transpose_item(a.in[I_W_OUT], D, D, (bf16*)(ws + WS_WOUTT), scr, it - IT_IN, lane);
        }
        __syncthreads();
    }
    {
        LAS unsigned* T = (LAS unsigned*)lds;
        const int n4 = tid & 63, kq = tid >> 6;
        constexpr int T_IN = G1_FP8 ? (D / 128) * (DIN / 256) : 0, T_OUT = G2_FP8 ? (D / 128) * (D / 256) : 0, T_E = (D / 128) * (D / 256);
        constexpr int NTILES = T_IN + T_OUT + (BG_WDOWN ? 64 : 96) * T_E;
        auto tile_ptrs = [&](int tile, const float*& sp, unsigned char*& dp, int& ldn) {
            const float* sbase; unsigned char* dbase; int tl, nt;
            if (tile < T_IN) { sbase = a.in[I_W_IN]; dbase = ws + WS_WINT; tl = tile; nt = DIN / 256; ldn = DIN; }
            else if (tile < T_IN + T_OUT) { sbase = a.in[I_W_OUT]; dbase = ws + WS_WOUTT; tl = tile - T_IN; nt = D / 256; ldn = D; }
            else { const int r = tile - T_IN - T_OUT, mat = r / T_E, which = mat / NEXP, e = mat % NEXP; tl = r % T_E; nt = D / 256; ldn = D;
                   sbase = a.in[which == 0 ? I_W_GATE : (which == 1 ? I_W_UP : I_W_DOWN)] + (size_t)e * D * D; dbase = ws + (which == 0 ? WS_WGT : (which == 1 ? WS_WUT : WS_WDT)) + (size_t)e * D * D; }
            const int k0 = (tl / nt) * 128, n0 = (tl % nt) * 256;
            sp = sbase + (size_t)(k0 + 4 * kq) * ldn + n0 + 4 * n4; dp = dbase + (size_t)n0 * D + k0; };
#define CONV_LOAD(R, tile) do { const float* _p; unsigned char* _d; int _ld; tile_ptrs(tile, _p, _d, _ld); _Pragma("unroll") for (int i = 0; i < 4; ++i) _Pragma("unroll") for (int q = 0; q < 4; ++q) \
            R[i][q] = __builtin_nontemporal_load((const f32x4*)(_p + (size_t)(32 * i + q) * _ld)); } while (0)
#define CONV_STORE(R, tile) do { _Pragma("unroll") for (int i = 0; i < 4; ++i) { const int kd = kq + 8 * i; \
            T[(4 * n4 + 0) * 33 + kd] = pk4_fp8(R[i][0].x * W_SCALE, R[i][1].x * W_SCALE, R[i][2].x * W_SCALE, R[i][3].x * W_SCALE); \
            T[(4 * n4 + 1) * 33 + kd] = pk4_fp8(R[i][0].y * W_SCALE, R[i][1].y * W_SCALE, R[i][2].y * W_SCALE, R[i][3].y * W_SCALE); \
            T[(4 * n4 + 2) * 33 + kd] = pk4_fp8(R[i][0].z * W_SCALE, R[i][1].z * W_SCALE, R[i][2].z * W_SCALE, R[i][3].z * W_SCALE); \
            T[(4 * n4 + 3) * 33 + kd] = pk4_fp8(R[i][0].w * W_SCALE, R[i][1].w * W_SCALE, R[i][2].w * W_SCALE, R[i][3].w * W_SCALE); } \
            __syncthreads(); \
            { const float* _p; unsigned char* _d; int _ld; tile_ptrs(tile, _p, _d, _ld); _Pragma("unroll") for (int i = 0; i < 4; ++i) { const int n = (tid >> 3) + 64 * i, c = tid & 7; \
                const u32x4 o = (u32x4){T[n * 33 + 4 * c], T[n * 33 + 4 * c + 1], T[n * 33 + 4 * c + 2], T[n * 33 + 4 * c + 3]}; \
                *(u32x4*)(_d + (size_t)n * D + 16 * c) = o; } } \
            __syncthreads(); } while (0)
        f32x4 RA[4][4], RB[4][4];
        int tile = blockIdx.x;
        if (tile < NTILES) CONV_LOAD(RA, tile);
        while (tile < NTILES) {
            int nxt = tile + gridDim.x;
            if (nxt < NTILES) CONV_LOAD(RB, nxt);
            CONV_STORE(RA, tile);
            tile = nxt; if (tile >= NTILES) break;
            nxt = tile + gridDim.x;
            if (nxt < NTILES) CONV_LOAD(RA, nxt);
            CONV_STORE(RB, tile);
            tile = nxt;
        }
#undef CONV_LOAD
#undef CONV_STORE
    }
    for (int r = gw; r < MROWS; r += NGW) {
        u32x2* orow = (u32x2*)((bf16*)(ws + WS_N1) + (size_t)r * D);
        unsigned* orow8 = (unsigned*)(ws + WS_N1 + (size_t)r * D);
        if (r >= MVALID) {
#pragma unroll
            for (int j = 0; j < 8; ++j) { if (G1_FP8) orow8[lane + 64 * j] = 0u; else orow[lane + 64 * j] = (u32x2){0u, 0u}; }
            continue; }
        const f32x4* xr = (const f32x4*)(r < MREAL ? a.in[I_X] + (size_t)r * D : a.in[I_META] + (size_t)(r - MREAL) * D);
        f32x4 v[8]; float ss = 0.f;
#pragma unroll
        for (int j = 0; j < 8; ++j) { v[j] = xr[lane + 64 * j]; ss += (v[j].x * v[j].x + v[j].y * v[j].y) + (v[j].z * v[j].z + v[j].w * v[j].w); }
        ss = wave_sum(ss);
        const float rstd = (G1_FP8 ? XS_SCALE : 1.0f) / sqrtf(ss * (1.0f / D) + EPS);
#pragma unroll
        for (int j = 0; j < 8; ++j) { const f32x4 g = ((const f32x4*)a.in[I_NORM_MIX])[lane + 64 * j];
            if (G1_FP8) orow8[lane + 64 * j] = pk4_fp8(v[j].x * rstd * g.x, v[j].y * rstd * g.y, v[j].z * rstd * g.z, v[j].w * rstd * g.w);
            else orow[lane + 64 * j] = (u32x2){pk2(v[j].x * rstd * g.x, v[j].y * rstd * g.y), pk2(v[j].z * rstd * g.z, v[j].w * rstd * g.w)}; }
    }
    float* cosT = (float*)(ws + WS_COS); float* sinT = (float*)(ws + WS_SIN);
    for (int i = gt; i < TT * 32; i += NGT) {
        const int pos = i >> 5, j = i & 31;
        const float ang = (float)pos * c_inv_freq[j];
        const double t = (double)ang * 0.15915494309189535; const float fr = (float)(t - floor(t));
        cosT[i] = __builtin_amdgcn_cosf(fr); sinT[i] = __builtin_amdgcn_sinf(fr);
    }
    { bf16* WaT = (bf16*)(ws + WS_WAT); bf16* WiT = (bf16*)(ws + WS_WIT);
      for (int i = gt; i < 16 * 64 * 64; i += NGT) { const int n = i >> 12, d = (i >> 6) & 63, cc = i & 63;
          WaT[i] = (bf16)f2bf(a.in[I_W_A][(n * 64 + cc) * 64 + d]); WiT[i] = (bf16)f2bf(a.in[I_W_I][(n * 64 + cc) * 64 + d]); } }
    { bf16* WRT = (bf16*)(ws + WS_WRT);
      for (int i = gt; i < NEXP * D; i += NGT) { const int e = i >> 11, k = i & 2047; WRT[i] = (bf16)f2bf(a.in[I_NORM_FFN][k] * a.in[I_W_ROUTER][k * NEXP + e]); } }
    int* rowpair = (int*)(ws + WS_ROWPAIR);
    for (int i = gt; i < PROWS; i += NGT) rowpair[i] = -1;
}

namespace pg8 {
constexpr int BM = 256, BK = 64, HALF = 128, HTB = HALF * BK * 2, STAGE_BYTES = 8 * HTB, NXCD = 8, WGM = 8, KD = 2048, NKT = KD / BK;
__host__ __device__ __forceinline__ int lds_byte(int r, int c) { const int st = (r >> 4) * 2 + (c >> 5), rr = r & 15, cc = c & 31, ob = rr * 64 + cc * 2; return st * 1024 + (ob ^ (((ob >> 9) & 1) << 5)); }
__host__ __device__ __forceinline__ void stage_rc(int b, int& R, int& C) { const int st = b / 1024, sb = b % 1024, swz = sb ^ (((sb >> 9) & 1) << 5); R = (st >> 1) * 16 + swz / 64; C = (st & 1) * 32 + (swz % 64) / 2; }
__host__ __device__ __forceinline__ int perm32(int rho) { const int n = rho >> 4, i = rho & 15; return 8 * (i >> 2) + 4 * n + (i & 3); }
struct Unit { const char* a; const char* b0; const char* b1; int pm, pn, e; };
__device__ __forceinline__ bool static_tile(int i, int G, int c, int nM, int nN, int& pm, int& pn) {
    const int nwg = nM * nN; const long L = (long)i * G + c; if (L >= nwg) return false;
    int wgid = (int)L; { const int q = nwg / NXCD, r = nwg % NXCD, xcd = wgid % NXCD, off = wgid / NXCD; wgid = (xcd < r ? xcd * (q + 1) : r * (q + 1) + (xcd - r) * q) + off; }
    const int nig = WGM * nN, gid = wgid / nig, fm = gid * WGM, gsz = (nM - fm) < WGM ? (nM - fm) : WGM;
    pm = fm + ((wgid % nig) % gsz); pn = (wgid % nig) / gsz; return true;
}
__device__ __forceinline__ unsigned cvt_pk_bf16(float lo, float hi) { unsigned r; asm volatile("v_cvt_pk_bf16_f32 %0, %1, %2" : "=v"(r) : "v"(lo), "v"(hi)); return r; }

typedef int i32x8 __attribute__((ext_vector_type(8)));
typedef int i32x4 __attribute__((ext_vector_type(4)));
__device__ __forceinline__ i32x8 cat8(bf16x8 lo, bf16x8 hi) { const i32x4 a = __builtin_bit_cast(i32x4, lo), b = __builtin_bit_cast(i32x4, hi); return __builtin_shufflevector(a, b, 0, 1, 2, 3, 4, 5, 6, 7); }
struct BGNone { static constexpr bool ON = false; };
struct BGConv { static constexpr bool ON = true; const char* src; unsigned char* dst; int next, end; unsigned char* dummy; };
__device__ __forceinline__ void bg_pair_ptrs(const BGConv& bg, int pair, const char*& sp, unsigned char*& dp) {
    const int e = pair >> 10, kbp = (pair >> 6) & 15, nb = pair & 63;
    sp = bg.src + ((size_t)(e * 2048 + 128 * kbp) * 2048 + 32 * nb) * 4; dp = bg.dst + (size_t)e * 2048 * 2048 + (size_t)(32 * nb) * 2048 + 128 * kbp; }
template <bool FP8, class Epi, class Sched, class BG>
__device__ __forceinline__ void gemm_phase(LAS unsigned char* lds, const Sched& S, const Epi& E, BG& bg) {
    constexpr int ROWB = FP8 ? 2048 : 4096, NKTL = ROWB / 128;
    const int tid = threadIdx.x, wid = __builtin_amdgcn_readfirstlane(tid >> 6), lane = tid & 63, wr = wid >> 2, wc = wid & 3, fr = lane & 15, fq = lane >> 4;
    unsigned voffA[2], voffB[2];
#pragma unroll
    for (int i = 0; i < 2; ++i) { int R, C; stage_rc(tid * 16 + i * 8192, R, C); const int Rb = Epi::PERM ? ((R & ~31) + perm32(R & 31)) : R;
        voffA[i] = (unsigned)(R * ROWB + C * 2); voffB[i] = (unsigned)(Rb * ROWB + C * 2); }
    constexpr size_t kstep = (size_t)(BK * 2);
    constexpr size_t hstep = (size_t)HALF * ROWB;
    const unsigned ldsw = (unsigned)wid * 1024u;
    const unsigned bgvoff = (unsigned)((8 * wid + (lane >> 3)) * 8192 + (lane & 7) * 16);
    const int aoff = lds_byte(wr * 64 + fr, fq * 8), boff = lds_byte(wc * 32 + fr, fq * 8);
#define PG8_SA(b, h) (((b) * 2 + (h)) * HTB)
#define PG8_SB(b, h) ((4 + (b) * 2 + (h)) * HTB)
#define PG8_STAGE(bufoff, gbase, voff) do { _Pragma("unroll") for (int _i = 0; _i < 2; ++_i) \
        __builtin_amdgcn_global_load_lds((const unsigned*)((const char*)(gbase) + (voff)[_i]), (LAS unsigned*)(lds + (bufoff) + ldsw + _i * 8192), 16, 0, 0); } while (0)
#define PG8_LDA(dst, b, h) do { _Pragma("unroll") for (int m = 0; m < 4; ++m) { \
        if constexpr (FP8) dst##8[m] = __builtin_shufflevector(*(const LAS i32x4*)(lds + PG8_SA(b, h) + aoff + m * 2048), *(const LAS i32x4*)(lds + PG8_SA(b, h) + aoff + m * 2048 + 1024), 0, 1, 2, 3, 4, 5, 6, 7); \
        else { _Pragma("unroll") for (int k = 0; k < 2; ++k) dst[m][k] = *(const LAS bf16x8*)(lds + PG8_SA(b, h) + aoff + m * 2048 + k * 1024); } } } while (0)
#define PG8_LDB(dst, b, h) do { _Pragma("unroll") for (int n = 0; n < 2; ++n) { \
        if constexpr (FP8) dst##8[n] = __builtin_shufflevector(*(const LAS i32x4*)(lds + PG8_SB(b, h) + boff + n * 2048), *(const LAS i32x4*)(lds + PG8_SB(b, h) + boff + n * 2048 + 1024), 0, 1, 2, 3, 4, 5, 6, 7); \
        else { _Pragma("unroll") for (int k = 0; k < 2; ++k) dst[n][k] = *(const LAS bf16x8*)(lds + PG8_SB(b, h) + boff + n * 2048 + k * 1024); } } } while (0)
#define PG8_MMA(ai, bj, At, Bt) do { __builtin_amdgcn_s_setprio(1); _Pragma("unroll") for (int m = 0; m < 4; ++m) _Pragma("unroll") for (int n = 0; n < 2; ++n) { \
        if constexpr (FP8) asm volatile("v_mfma_f32_16x16x128_f8f6f4 %0, %1, %2, %0" : "+v"(acc[ai][bj][m][n]) : "v"(Bt##8[n]), "v"(At##8[m])); \
        else { _Pragma("unroll") for (int k = 0; k < 2; ++k) acc[ai][bj][m][n] = __builtin_amdgcn_mfma_f32_16x16x32_bf16(Bt[n][k], At[m][k], acc[ai][bj][m][n], 0, 0, 0); } } \
        __builtin_amdgcn_s_setprio(0); } while (0)
#define PG8_WAIT_V(n) asm volatile("s_waitcnt vmcnt(" #n ")" ::: "memory")
#define PG8_WAIT_L(n) asm volatile("s_waitcnt lgkmcnt(" #n ")" ::: "memory")
#define PG8_BAR __builtin_amdgcn_s_barrier()
#define PG8_SCHED __builtin_amdgcn_sched_barrier(0)
    Unit cur, nxt; int ui = 0; bool bg_pending = false;
    if (!S.next(0, cur)) return;
    f32x4 acc[2][2][4][2];
#pragma unroll
    for (int a = 0; a < 2; ++a)
#pragma unroll
        for (int b = 0; b < 2; ++b)
#pragma unroll
            for (int m = 0; m < 4; ++m)
#pragma unroll
                for (int n = 0; n < 2; ++n) acc[a][b][m][n] = (f32x4){0.f, 0.f, 0.f, 0.f};
    bf16x8 At[4][2], B0[2][2], B1[2][2];
    i32x8 At8[4], B08[2], B18[2];
    PG8_STAGE(PG8_SB(0, 0), cur.b0, voffB); PG8_STAGE(PG8_SB(0, 1), cur.b1, voffB); PG8_STAGE(PG8_SA(0, 0), cur.a, voffA); PG8_STAGE(PG8_SA(0, 1), cur.a + hstep, voffA);
    if (wr == 1) PG8_BAR;
    PG8_WAIT_V(2); PG8_BAR;
    PG8_STAGE(PG8_SB(1, 0), cur.b0 + kstep, voffB); PG8_STAGE(PG8_SA(1, 0), cur.a + kstep, voffA); PG8_STAGE(PG8_SB(1, 1), cur.b1 + kstep, voffB);
    PG8_WAIT_V(6); PG8_BAR;
    for (;;) {
        const bool has_next = S.next(ui + 1, nxt);
        const char* nA = has_next ? nxt.a : cur.a; const char* nB0 = has_next ? nxt.b0 : cur.b0; const char* nB1 = has_next ? nxt.b1 : cur.b1;
        for (int t = 0; t < NKTL; t += 2) {
            const bool last = (t == NKTL - 2);
            const char* a1 = cur.a + (size_t)(t + 1) * kstep;
            const char* a2 = last ? nA : cur.a + (size_t)(t + 2) * kstep;
            const char* b20 = last ? nB0 : cur.b0 + (size_t)(t + 2) * kstep; const char* b21 = last ? nB1 : cur.b1 + (size_t)(t + 2) * kstep;
            const char* a3 = a2 + kstep; const char* b30 = b20 + kstep; const char* b31 = b21 + kstep;
            PG8_LDB(B0, 0, 0); PG8_LDB(B1, 0, 1); PG8_SCHED; PG8_LDA(At, 0, 0);
            if constexpr (BG::ON) {
                if (bg_pending) {
#pragma unroll
                    for (int j = 0; j < 2; ++j) { const LAS float* p = (const LAS float*)(lds + LDS_BG + j * 8192 + (tid >> 5) * 512 + (tid & 31) * 4);
                        ((LAS unsigned*)(lds + LDS_T2))[(tid & 31) * 33 + 16 * j + (tid >> 5)] = pk4_fp8(p[0] * W_SCALE, p[32] * W_SCALE, p[64] * W_SCALE, p[96] * W_SCALE); } }
                PG8_SCHED; }
            PG8_STAGE(PG8_SA(1, 1), a1 + hstep, voffA);
            if constexpr (BG::ON) {
                const char* bgs; { unsigned char* dp_; pg8::bg_pair_ptrs(bg, bg.next < bg.end ? bg.next : bg.end - 1, bgs, dp_); }
                PG8_SCHED;
                __builtin_amdgcn_global_load_lds((const unsigned*)(bgs + bgvoff), (LAS unsigned*)(lds + LDS_BG + ldsw), 16, 0, 0);
                __builtin_amdgcn_global_load_lds((const unsigned*)(bgs + 524288 + bgvoff), (LAS unsigned*)(lds + LDS_BG + 8192 + ldsw), 16, 0, 0);
                PG8_WAIT_V(10); } else { PG8_WAIT_V(8); }
            PG8_WAIT_L(0); PG8_BAR; PG8_MMA(0, 0, At, B0); PG8_MMA(0, 1, At, B1); PG8_BAR; PG8_SCHED;
            PG8_LDA(At, 0, 1);
            if constexpr (BG::ON) {
                unsigned char* bgd; { const char* sp_; pg8::bg_pair_ptrs(bg, bg.next - 1 < bg.end ? bg.next - 1 : bg.end - 1, sp_, bgd); }
                const LAS unsigned* q = (const LAS unsigned*)(lds + LDS_T2) + (tid >> 4) * 33 + 2 * (tid & 15);
                const u32x2 w = (u32x2){q[0], q[1]};
                *(u32x2*)(bg_pending ? bgd + (size_t)(tid >> 4) * 2048 + 8 * (tid & 15) : bg.dummy + 8 * tid) = w;
                ++bg.next; bg_pending = true;
                PG8_SCHED; }
            PG8_STAGE(PG8_SB(0, 0), b20, voffB); PG8_STAGE(PG8_SB(0, 1), b21, voffB); PG8_STAGE(PG8_SA(0, 0), a2, voffA);
            if constexpr (BG::ON) { PG8_WAIT_V(11); } else { PG8_WAIT_V(8); }
            PG8_WAIT_L(0); PG8_BAR; PG8_MMA(1, 0, At, B0); PG8_MMA(1, 1, At, B1); PG8_BAR; PG8_SCHED;
            PG8_LDB(B0, 1, 0); PG8_LDB(B1, 1, 1); PG8_SCHED; PG8_LDA(At, 1, 0); PG8_STAGE(PG8_SA(0, 1), a2 + hstep, voffA);
            if constexpr (BG::ON) { PG8_WAIT_V(11); } else { PG8_WAIT_V(8); }
            PG8_WAIT_L(0); PG8_BAR; PG8_MMA(0, 0, At, B0); PG8_MMA(0, 1, At, B1); PG8_BAR; PG8_SCHED;
            PG8_LDA(At, 1, 1); PG8_STAGE(PG8_SB(1, 0), b30, voffB); PG8_STAGE(PG8_SB(1, 1), b31, voffB); PG8_STAGE(PG8_SA(1, 0), a3, voffA);
            PG8_WAIT_V(8);
            PG8_WAIT_L(0); PG8_BAR; PG8_MMA(1, 0, At, B0); PG8_MMA(1, 1, At, B1); PG8_BAR; PG8_SCHED;
        }
        if (wr == 0) PG8_BAR;
        if constexpr (FP8) asm volatile("s_nop 15\n\ts_nop 15" ::: "memory");
        E(acc, cur, wr, wc, fr, fq);
        if (!has_next) break;
#pragma unroll
        for (int a = 0; a < 2; ++a)
#pragma unroll
            for (int b = 0; b < 2; ++b)
#pragma unroll
                for (int m = 0; m < 4; ++m)
#pragma unroll
                    for (int n = 0; n < 2; ++n) acc[a][b][m][n] = (f32x4){0.f, 0.f, 0.f, 0.f};
        cur = nxt; ++ui;
        if (wr == 1) PG8_BAR;
    }
    PG8_WAIT_V(0);
    PG8_BAR;
    if constexpr (BG::ON) { if (bg_pending) {
        unsigned char* bgd; { const char* sp_; pg8::bg_pair_ptrs(bg, bg.next - 1 < bg.end ? bg.next - 1 : bg.end - 1, sp_, bgd); }
#pragma unroll
        for (int j = 0; j < 2; ++j) { const LAS float* p = (const LAS float*)(lds + LDS_BG + j * 8192 + (tid >> 5) * 512 + (tid & 31) * 4);
            ((LAS unsigned*)(lds + LDS_T2))[(tid & 31) * 33 + 16 * j + (tid >> 5)] = pk4_fp8(p[0] * W_SCALE, p[32] * W_SCALE, p[64] * W_SCALE, p[96] * W_SCALE); }
        __syncthreads();
        const LAS unsigned* q = (const LAS unsigned*)(lds + LDS_T2) + (tid >> 4) * 33 + 2 * (tid & 15);
        *(u32x2*)(bgd + (size_t)(tid >> 4) * 2048 + 8 * (tid & 15)) = (u32x2){q[0], q[1]}; } }
#undef PG8_SA
#undef PG8_SB
#undef PG8_STAGE
#undef PG8_LDA
#undef PG8_LDB
#undef PG8_MMA
#undef PG8_WAIT_V
#undef PG8_WAIT_L
#undef PG8_BAR
#undef PG8_SCHED
}

struct SchedDense {
    const char* A; const char* Bt; int nM, nN, G, c, rowb;
    __device__ __forceinline__ bool next(int i, Unit& u) const {
        int pm, pn; if (!static_tile(i, G, c, nM, nN, pm, pn)) return false;
        u.pm = pm; u.pn = pn; u.e = 0; u.a = A + (size_t)pm * BM * rowb; u.b0 = Bt + (size_t)pn * BM * rowb; u.b1 = u.b0 + (size_t)HALF * rowb; return true;
    }
};
struct SchedMoE {
    const char* A; const char* B0; const char* B1; const LAS int* tstart; int nM, nN, G, c; bool split;
    __device__ __forceinline__ bool next(int i, Unit& u) const {
        int pm, pn; if (!static_tile(i, G, c, nM, nN, pm, pn)) return false;
        int e = 0;
#pragma unroll 1
        for (int q = 1; q < 32; ++q) e += (tstart[q] <= pm) ? 1 : 0;
        u.pm = pm; u.pn = pn; u.e = e; u.a = A + (size_t)pm * (BM * 2048);
        const size_t eoff = (size_t)e * ((size_t)2048 * 2048);
        if (split) { u.b0 = B0 + eoff + (size_t)pn * (HALF * 2048); u.b1 = B1 + eoff + (size_t)pn * (HALF * 2048); }
        else { u.b0 = B0 + eoff + (size_t)pn * (BM * 2048); u.b1 = u.b0 + (size_t)HALF * 2048; }
        return true;
    }
};

struct EpiZ {
    static constexpr bool PERM = true;
    bf16* Z; const float* bias; float sc;
    __device__ __forceinline__ void operator()(const f32x4 (&acc)[2][2][4][2], const Unit& u, int wr, int wc, int fr, int fq) const {
        const int row0 = u.pm * BM + wr * 64 + fr, col0 = u.pn * BM + wc * 32 + 8 * fq;
        f32x4 bv[2][2];
#pragma unroll
        for (int bj = 0; bj < 2; ++bj)
#pragma unroll
            for (int n = 0; n < 2; ++n) bv[bj][n] = *(const f32x4*)(bias + col0 + bj * HALF + 4 * n);
#pragma unroll
        for (int ai = 0; ai < 2; ++ai)
#pragma unroll
            for (int m = 0; m < 4; ++m) { bf16* rowp = Z + (size_t)(row0 + ai * HALF + m * 16) * DIN + col0;
#pragma unroll
                for (int bj = 0; bj < 2; ++bj) { const f32x4 v0 = acc[ai][bj][m][0] * sc + bv[bj][0], v1 = acc[ai][bj][m][1] * sc + bv[bj][1];
                    u32x4 w; w.x = cvt_pk_bf16(v0[0], v0[1]); w.y = cvt_pk_bf16(v0[2], v0[3]); w.z = cvt_pk_bf16(v1[0], v1[1]); w.w = cvt_pk_bf16(v1[2], v1[3]);
                    *(u32x4*)(rowp + bj * HALF) = w; } }
    }
};
struct EpiH1 {
    static constexpr bool PERM = true;
    bf16* H1; const float* x; const float* bias; float sc;
    __device__ __forceinline__ void operator()(const f32x4 (&acc)[2][2][4][2], const Unit& u, int wr, int wc, int fr, int fq) const {
        const int row0 = u.pm * BM + wr * 64 + fr, col0 = u.pn * BM + wc * 32 + 8 * fq;
        f32x4 bv[2][2];
#pragma unroll
        for (int bj = 0; bj < 2; ++bj)
#pragma unroll
            for (int n = 0; n < 2; ++n) bv[bj][n] = *(const f32x4*)(bias + col0 + bj * HALF + 4 * n);
#pragma unroll
        for (int ai = 0; ai < 2; ++ai)
#pragma unroll
            for (int m = 0; m < 4; ++m) { const size_t ro = (size_t)(row0 + ai * HALF + m * 16) * D + col0;
#pragma unroll
                for (int bj = 0; bj < 2; ++bj) { const f32x4 v0 = *(const f32x4*)(x + ro + bj * HALF) + acc[ai][bj][m][0] * sc + bv[bj][0], v1 = *(const f32x4*)(x + ro + bj * HALF + 4) + acc[ai][bj][m][1] * sc + bv[bj][1];
                    u32x4 w; w.x = cvt_pk_bf16(v0[0], v0[1]); w.y = cvt_pk_bf16(v0[2], v0[3]); w.z = cvt_pk_bf16(v1[0], v1[1]); w.w = cvt_pk_bf16(v1[2], v1[3]);
                    *(u32x4*)(H1 + ro + bj * HALF) = w; } }
    }
};
struct EpiAct {
    static constexpr bool PERM = true;
    unsigned char* ACT; const float* bg; const float* bu;
    __device__ __forceinline__ void operator()(const f32x4 (&acc)[2][2][4][2], const Unit& u, int wr, int wc, int fr, int fq) const {
        const int row0 = u.pm * BM + wr * 64 + fr, col0 = u.pn * HALF + wc * 32 + 8 * fq;
        f32x4 gv[2], uv[2];
#pragma unroll
        for (int n = 0; n < 2; ++n) { gv[n] = *(const f32x4*)(bg + (size_t)u.e * DFF + col0 + 4 * n); uv[n] = *(const f32x4*)(bu + (size_t)u.e * DFF + col0 + 4 * n); }
#pragma unroll
        for (int ai = 0; ai < 2; ++ai)
#pragma unroll
            for (int m = 0; m < 4; ++m) { float r[8];
#pragma unroll
                for (int n = 0; n < 2; ++n)
#pragma unroll
                    for (int j = 0; j < 4; ++j) { float g = acc[ai][0][m][n][j] * (1.0f / (W_SCALE * XS_SCALE)) + gv[n][j], up = acc[ai][1][m][n][j] * (1.0f / (W_SCALE * XS_SCALE)) + uv[n][j];
                        g = fminf(g, 7.0f); up = fminf(fmaxf(up, -7.0f), 7.0f);
                        r[n * 4 + j] = ACT_SCALE * g * (1.0f / (1.0f + __expf(-1.702f * g))) * (up + 1.0f); }
                *(u32x2*)(ACT + (size_t)(row0 + ai * HALF + m * 16) * DFF + col0) = (u32x2){pk4_fp8(r[0], r[1], r[2], r[3]), pk4_fp8(r[4], r[5], r[6], r[7])}; }
    }
};
struct EpiDown {
    static constexpr bool PERM = true;
    bf16* YB; const float* bd; const int* rowpair; const float* roww;
    __device__ __forceinline__ void operator()(const f32x4 (&acc)[2][2][4][2], const Unit& u, int wr, int wc, int fr, int fq) const {
        const int row0 = u.pm * BM + wr * 64 + fr, col0 = u.pn * BM + wc * 32 + 8 * fq;
        f32x4 bv[2][2];
#pragma unroll
        for (int bj = 0; bj < 2; ++bj)
#pragma unroll
            for (int n = 0; n < 2; ++n) bv[bj][n] = *(const f32x4*)(bd + (size_t)u.e * D + col0 + bj * HALF + 4 * n);
#pragma unroll
        for (int ai = 0; ai < 2; ++ai)
#pragma unroll
            for (int m = 0; m < 4; ++m) { const int row = row0 + ai * HALF + m * 16; const int pair = rowpair[row]; const float wt = roww[row];
                if (pair >= 0) { bf16* rowp = YB + (size_t)pair * D + col0;
#pragma unroll
                    for (int bj = 0; bj < 2; ++bj) { const f32x4 v0 = (acc[ai][bj][m][0] * (1.0f / (W_SCALE * ACT_SCALE)) + bv[bj][0]) * wt, v1 = (acc[ai][bj][m][1] * (1.0f / (W_SCALE * ACT_SCALE)) + bv[bj][1]) * wt;
                        u32x4 w; w.x = cvt_pk_bf16(v0[0], v0[1]); w.y = cvt_pk_bf16(v0[2], v0[3]); w.z = cvt_pk_bf16(v1[0], v1[1]); w.w = cvt_pk_bf16(v1[2], v1[3]);
                        *(u32x4*)(rowp + bj * HALF) = w; } } }
    }
};
}


typedef float f32x16 __attribute__((ext_vector_type(16)));
constexpr int AT_KS = 144, AT_VS = 584, AT_KOFF = 0, AT_VOFF = 288 * AT_KS;
__device__ __forceinline__ float bflo(unsigned w) { return __uint_as_float(w << 16); }
__device__ __forceinline__ float bfhi(unsigned w) { return __uint_as_float(w & 0xffff0000u); }

__device__ __forceinline__ void attn_tile(LAS unsigned char* lds, int slot_base, int kind, int j, int lane, int hq,
                                          const bf16x8 (&qf)[2][4], f32x16 (&oacc)[2][2], float (&mrow)[2], float (&lrow)[2]) {
    const int r31 = lane & 31, h = lane >> 5;
    bf16x8 kf[4], vf[2][2];
#pragma unroll
    for (int ks = 0; ks < 4; ++ks) kf[ks] = *(const LAS bf16x8*)(lds + AT_KOFF + (slot_base + r31) * AT_KS + (16 * ks + 8 * h) * 2);
#pragma unroll
    for (int dt = 0; dt < 2; ++dt)
#pragma unroll
        for (int sp = 0; sp < 2; ++sp) { const LAS unsigned char* p = lds + AT_VOFF + (32 * dt + r31) * AT_VS + (slot_base + 16 * sp + 4 * h) * 2;
            const u32x2 lo = *(const LAS u32x2*)p, hi = *(const LAS u32x2*)(p + 16);
            const u32x4 w = (u32x4){lo.x, lo.y, hi.x, hi.y}; vf[dt][sp] = __builtin_bit_cast(bf16x8, w); }
#pragma unroll
    for (int qt = 0; qt < 2; ++qt) {
        f32x16 s;
#pragma unroll
        for (int r = 0; r < 16; ++r) s[r] = 0.f;
#pragma unroll
        for (int ks = 0; ks < 4; ++ks) s = __builtin_amdgcn_mfma_f32_32x32x16_bf16(kf[ks], qf[qt][ks], s, 0, 0, 0);
        const int i = 64 * hq + 32 * qt + r31;
        float mx = -1.0e30f;
#pragma unroll
        for (int r = 0; r < 16; ++r) { const int key = (r & 3) + 8 * (r >> 2) + 4 * h;
            const bool ok = kind == 0 ? (key < 16) : (kind == 1 ? (32 * j + key >= i + 1) : (32 * j + key <= i));
            s[r] = ok ? s[r] : -1.0e30f; mx = fmaxf(mx, s[r]); }
        mx = fmaxf(mx, __shfl_xor(mx, 32));
        const float mn = fmaxf(mrow[qt], mx), al = __expf(mrow[qt] - mn); mrow[qt] = mn;
        float ps = 0.f;
#pragma unroll
        for (int r = 0; r < 16; ++r) { s[r] = __expf(s[r] - mn); ps += s[r]; }
        lrow[qt] = lrow[qt] * al + ps;
#pragma unroll
        for (int dt = 0; dt < 2; ++dt)
#pragma unroll
            for (int r = 0; r < 16; ++r) oacc[qt][dt][r] *= al;
        bf16x8 pf[2];
#pragma unroll
        for (int sp = 0; sp < 2; ++sp) { const u32x4 w = (u32x4){pk2(s[8 * sp + 0], s[8 * sp + 1]), pk2(s[8 * sp + 2], s[8 * sp + 3]), pk2(s[8 * sp + 4], s[8 * sp + 5]), pk2(s[8 * sp + 6], s[8 * sp + 7])};
            pf[sp] = __builtin_bit_cast(bf16x8, w); }
#pragma unroll
        for (int dt = 0; dt < 2; ++dt)
#pragma unroll
            for (int sp = 0; sp < 2; ++sp) oacc[qt][dt] = __builtin_amdgcn_mfma_f32_32x32x16_bf16(vf[dt][sp], pf[sp], oacc[qt][dt], 0, 0, 0);
    }
}

__device__ __forceinline__ void attn_item(const Args& a, LAS unsigned char* lds, int item, int tid, int lane, int wave) {
    const int kvh = item & 3, qblk = (item >> 2) & 15, b = item >> 6;
    const bf16* Z = (const bf16*)(a.ws + WS_Z); bf16* O = (bf16*)(a.ws + (G2_FP8 ? WS_ATT : WS_O)); constexpr int OLD = G2_FP8 ? 1024 : D;
    const float* cosT = (const float*)(a.ws + WS_COS); const float* sinT = (const float*)(a.ws + WS_SIN);
    __syncthreads();
    for (int task = tid; task < 288 * 4; task += 512) {
        const int slot = task >> 2, c = task & 3;
        int krow, kpos; bool valid;
        if (slot < 32) { valid = slot < NMETA; krow = METAROW0 + slot; kpos = slot; }
        else { const int sp = 128 * (qblk - 1) + (slot - 32); valid = sp >= 0; krow = b * SEQ + sp; kpos = NMETA + sp; }
        u32x4 lo = (u32x4){0u, 0u, 0u, 0u}, hi = lo;
        if (valid) {
            const bf16* kp = Z + (size_t)krow * DIN + ZK + kvh * 64 + c * 8;
            const u32x4 x1 = *(const u32x4*)kp, x2 = *(const u32x4*)(kp + 32);
            const f32x4 c0 = *(const f32x4*)(cosT + kpos * 32 + c * 8), c1 = *(const f32x4*)(cosT + kpos * 32 + c * 8 + 4);
            const f32x4 s0 = *(const f32x4*)(sinT + kpos * 32 + c * 8), s1 = *(const f32x4*)(sinT + kpos * 32 + c * 8 + 4);
#pragma unroll
            for (int q = 0; q < 4; ++q) { const float ca = q < 2 ? c0[2 * q] : c1[2 * q - 4], cb = q < 2 ? c0[2 * q + 1] : c1[2 * q - 3], sa = q < 2 ? s0[2 * q] : s1[2 * q - 4], sb = q < 2 ? s0[2 * q + 1] : s1[2 * q - 3];
                const float a0 = bflo(x1[q]), a1 = bfhi(x1[q]), b0 = bflo(x2[q]), b1 = bfhi(x2[q]);
                lo[q] = pk2(a0 * ca - b0 * sa, a1 * cb - b1 * sb); hi[q] = pk2(b0 * ca + a0 * sa, b1 * cb + a1 * sb); }
        }
        *(LAS u32x4*)(lds + AT_KOFF + slot * AT_KS + c * 16) = lo; *(LAS u32x4*)(lds + AT_KOFF + slot * AT_KS + 64 + c * 16) = hi;
    }
    for (int task = tid; task < 144 * 8; task += 512) {
        const int slot0 = (task >> 3) * 2, c = task & 7;
        int vrow; bool valid;
        if (slot0 < 32) { valid = slot0 < NMETA; vrow = METAROW0 + slot0; }
        else { const int sp = 128 * (qblk - 1) + (slot0 - 32); valid = sp >= 0; vrow = b * SEQ + sp; }
        u32x4 v0 = (u32x4){0u, 0u, 0u, 0u}, v1 = v0;
        if (valid) { const bf16* vp = Z + (size_t)vrow * DIN + ZV + kvh * 64 + c * 8; v0 = *(const u32x4*)vp; v1 = *(const u32x4*)(vp + DIN); }
#pragma unroll
        for (int q = 0; q < 4; ++q) {
            *(LAS unsigned*)(lds + AT_VOFF + (c * 8 + 2 * q) * AT_VS + slot0 * 2) = (v0[q] & 0xffffu) | (v1[q] << 16);
            *(LAS unsigned*)(lds + AT_VOFF + (c * 8 + 2 * q + 1) * AT_VS + slot0 * 2) = (v0[q] >> 16) | (v1[q] & 0xffff0000u); }
    }
    const int g = wave >> 1, hq = wave & 1, head = kvh * 4 + g, r31 = lane & 31, h = lane >> 5;
    bf16x8 qf[2][4];
#pragma unroll
    for (int qt = 0; qt < 2; ++qt) {
        const int s = 128 * qblk + 64 * hq + 32 * qt + r31, pos = NMETA + s;
        const bf16* qp = Z + (size_t)(b * SEQ + s) * DIN + ZQ + head * 64 + 8 * h;
        u32x4 x[4];
#pragma unroll
        for (int ks = 0; ks < 4; ++ks) x[ks] = *(const u32x4*)(qp + 16 * ks);
#pragma unroll
        for (int ks = 0; ks < 2; ++ks) {
            const float* cp = cosT + pos * 32 + 16 * ks + 8 * h; const float* sp = sinT + pos * 32 + 16 * ks + 8 * h;
            const f32x4 c0 = *(const f32x4*)cp, c1 = *(const f32x4*)(cp + 4), s0 = *(const f32x4*)sp, s1 = *(const f32x4*)(sp + 4);
            u32x4 lo, hi;
#pragma unroll
            for (int q = 0; q < 4; ++q) { const float ca = q < 2 ? c0[2 * q] : c1[2 * q - 4], cb = q < 2 ? c0[2 * q + 1] : c1[2 * q - 3], sa = q < 2 ? s0[2 * q] : s1[2 * q - 4], sb = q < 2 ? s0[2 * q + 1] : s1[2 * q - 3];
                const float a0 = bflo(x[ks][q]), a1 = bfhi(x[ks][q]), b0 = bflo(x[ks + 2][q]), b1 = bfhi(x[ks + 2][q]);
                lo[q] = pk2(0.125f * (a0 * ca - b0 * sa), 0.125f * (a1 * cb - b1 * sb)); hi[q] = pk2(0.125f * (b0 * ca + a0 * sa), 0.125f * (b1 * cb + a1 * sb)); }
            qf[qt][ks] = __builtin_bit_cast(bf16x8, lo); qf[qt][ks + 2] = __builtin_bit_cast(bf16x8, hi);
        }
    }
    f32x16 oacc[2][2]; float mrow[2], lrow[2];
#pragma unroll
    for (int qt = 0; qt < 2; ++qt) { mrow[qt] = a.in[I_SINKS][head]; lrow[qt] = h == 0 ? 1.0f : 0.0f;
#pragma unroll
        for (int dt = 0; dt < 2; ++dt)
#pragma unroll
            for (int r = 0; r < 16; ++r) oacc[qt][dt][r] = 0.f; }
    __syncthreads();
    attn_tile(lds, 0, 0, 0, lane, hq, qf, oacc, mrow, lrow);
    if (qblk > 0) {
#pragma unroll 1
        for (int j = hq ? 2 : 0; j < 4; ++j) attn_tile(lds, 32 + 32 * j, 1, j, lane, hq, qf, oacc, mrow, lrow);
    }
#pragma unroll 1
    for (int j = 0; j < (hq ? 4 : 2); ++j) attn_tile(lds, 160 + 32 * j, 2, j, lane, hq, qf, oacc, mrow, lrow);
#pragma unroll
    for (int qt = 0; qt < 2; ++qt) {
        const float lt = lrow[qt] + __shfl_xor(lrow[qt], 32), inv = 1.0f / lt;
        bf16* op = O + (size_t)(b * SEQ + 128 * qblk + 64 * hq + 32 * qt + r31) * OLD + head * 64 + 4 * h;
#pragma unroll
        for (int dt = 0; dt < 2; ++dt)
#pragma unroll
            for (int rr = 0; rr < 4; ++rr)
                *(u32x2*)(op + 32 * dt + 8 * rr) = (u32x2){pk2(oacc[qt][dt][4 * rr] * inv, oacc[qt][dt][4 * rr + 1] * inv), pk2(oacc[qt][dt][4 * rr + 2] * inv, oacc[qt][dt][4 * rr + 3] * inv)};
    }
}

constexpr int LR_XS = 2064;
template <int PASS>
__device__ __forceinline__ void lru_item(const Args& a, LAS unsigned char* lds, int item, int tid, int lane, int wave) {
    const int b = item / 65, c = item % 65; const bool meta = (c == 64);
    const bf16* Z = (const bf16*)(a.ws + WS_Z);
    float* sumA = (float*)(a.ws + WS_LRUSUM); float* sumB = sumA + NBATCH * 64 * DLRU; float* metaB = sumB + NBATCH * 64 * DLRU;
    __syncthreads();
    {
        const int ch0 = (tid & 127) * 8, tq = tid >> 7;
        f32x4 cw[4][2], cb[2];
#pragma unroll
        for (int jj = 0; jj < 4; ++jj) { cw[jj][0] = *(const f32x4*)(a.in[I_CONV_W] + jj * DLRU + ch0); cw[jj][1] = *(const f32x4*)(a.in[I_CONV_W] + jj * DLRU + ch0 + 4); }
        cb[0] = *(const f32x4*)(a.in[I_CONV_B] + ch0); cb[1] = *(const f32x4*)(a.in[I_CONV_B] + ch0 + 4);
#pragma unroll 1
        for (int i0 = 0; i0 < 8; i0 += 4) {
            u32x4 x[4][4];
#pragma unroll
            for (int i = 0; i < 4; ++i) { const int tl = tq + 4 * (i0 + i); const int t = meta ? tl : NMETA + 32 * c + tl;
#pragma unroll
                for (int jj = 0; jj < 4; ++jj) { const int tt = t - 3 + jj; x[i][jj] = (u32x4){0u, 0u, 0u, 0u};
                    if (tt >= 0 && !(meta && tl >= NMETA)) x[i][jj] = *(const u32x4*)(Z + (size_t)tok_row(b, tt) * DIN + ZX + ch0); } }
#pragma unroll
            for (int i = 0; i < 4; ++i) { const int tl = tq + 4 * (i0 + i); const int t = meta ? tl : NMETA + 32 * c + tl;
                f32x4 a0 = cb[0], a1 = cb[1];
#pragma unroll
                for (int jj = 0; jj < 4; ++jj) { const u32x4 xx = x[i][jj];
                    if (t - 3 + jj >= 0) {
                        a0.x += cw[jj][0].x * bflo(xx[0]); a0.y += cw[jj][0].y * bfhi(xx[0]); a0.z += cw[jj][0].z * bflo(xx[1]); a0.w += cw[jj][0].w * bfhi(xx[1]);
                        a1.x += cw[jj][1].x * bflo(xx[2]); a1.y += cw[jj][1].y * bfhi(xx[2]); a1.z += cw[jj][1].z * bflo(xx[3]); a1.w += cw[jj][1].w * bfhi(xx[3]); } }
                u32x4 o = (u32x4){pk2(a0.x, a0.y), pk2(a0.z, a0.w), pk2(a1.x, a1.y), pk2(a1.z, a1.w)};
                if (meta && tl >= NMETA) o = (u32x4){0u, 0u, 0u, 0u};
                *(LAS u32x4*)(lds + tl * LR_XS + ch0 * 2) = o; }
        }
    }
    LAS float* hinL = (LAS float*)(lds + 32 * LR_XS);
    if (PASS == 1) {
        float h0 = metaB[tid], h1 = metaB[tid + 512];
        const float* pa = sumA + (size_t)b * 64 * DLRU + tid; const float* pb = sumB + (size_t)b * 64 * DLRU + tid;
#pragma unroll 8
        for (int jc = 0; jc < c; ++jc) { h0 = pa[jc * DLRU] * h0 + pb[jc * DLRU]; h1 = pa[jc * DLRU + 512] * h1 + pb[jc * DLRU + 512]; }
        hinL[tid] = h0; hinL[tid + 512] = h1;
    }
    __syncthreads();
    const bf16* WaT = (const bf16*)(a.ws + WS_WAT); const bf16* WiT = (const bf16*)(a.ws + WS_WIT);
    const int r31 = lane & 31, h = lane >> 5;
    const int tau = 16 * ((r31 >> 2) & 1) + 4 * (r31 >> 3) + (r31 & 3);
#pragma unroll 1
    for (int nb = 0; nb < 2; ++nb) {
        const int n = 2 * wave + nb;
        bf16x8 af[4];
#pragma unroll
        for (int ks = 0; ks < 4; ++ks) af[ks] = *(const LAS bf16x8*)(lds + tau * LR_XS + (64 * n + 16 * ks + 8 * h) * 2);
#pragma unroll 1
        for (int nt = 0; nt < 2; ++nt) {
            const int ch = 64 * n + 32 * nt + r31;
            f32x16 accR, accI;
#pragma unroll
            for (int r = 0; r < 16; ++r) { accR[r] = 0.f; accI[r] = 0.f; }
#pragma unroll
            for (int ks = 0; ks < 4; ++ks) {
                const bf16x8 wa = *(const bf16x8*)(WaT + ((size_t)(n * 64 + 32 * nt + r31) * 64 + 16 * ks + 8 * h));
                const bf16x8 wi = *(const bf16x8*)(WiT + ((size_t)(n * 64 + 32 * nt + r31) * 64 + 16 * ks + 8 * h));
                accR = __builtin_amdgcn_mfma_f32_32x32x16_bf16(af[ks], wa, accR, 0, 0, 0);
                accI = __builtin_amdgcn_mfma_f32_32x32x16_bf16(af[ks], wi, accI, 0, 0, 0);
            }
            const float ba = a.in[I_B_A][ch], bi = a.in[I_B_I][ch], sp8 = -8.0f * 1.4426950408889634f * log1pf(__expf(-a.in[I_LAMBDA][ch]));
            float av[16], bv[16];
            float Ap = 1.0f, Bp = 0.0f;
#pragma unroll
            for (int r = 0; r < 16; ++r) {
                const float xcv = bf2f(*(const LAS unsigned short*)(lds + (16 * h + r) * LR_XS + ch * 2));
                const float rg = fast_sigmoid(accR[r] + ba), ig = fast_sigmoid(accI[r] + bi);
                av[r] = __builtin_amdgcn_exp2f(sp8 * rg); bv[r] = __builtin_amdgcn_sqrtf(fmaxf(fmaf(-av[r], av[r], 1.0f), 0.0f)) * ig * xcv;
                Ap *= av[r]; Bp = av[r] * Bp + bv[r];
            }
            const float Ao = __shfl_xor(Ap, 32), Bo = __shfl_xor(Bp, 32);
            if (PASS == 0) {
                if (h == 0) {
                    if (meta) metaB[ch] = Bp;
                    else { sumA[((size_t)b * 64 + c) * DLRU + ch] = Ap * Ao; sumB[((size_t)b * 64 + c) * DLRU + ch] = Ao * Bp + Bo; }
                }
            } else {
                const float hin = hinL[ch];
                float hs = h == 0 ? hin : (Ao * hin + Bo);
#pragma unroll
                for (int r = 0; r < 16; ++r) {
                    hs = av[r] * hs + bv[r];
                    const int tl = 16 * h + r;
                    const float gt = bf2f(Z[(size_t)(b * SEQ + 32 * c + tl) * DIN + ZG + ch]);
                    *(LAS unsigned short*)(lds + tl * LR_XS + ch * 2) = (unsigned short)f2bf(hs * fast_gelu_tanh(gt));
                }
            }
        }
    }
    if (PASS == 1) {
        bf16* O = (bf16*)(a.ws + WS_O); unsigned char* O8 = a.ws + WS_O;
        const bf16* ATT = (const bf16*)(a.ws + (G2_FP8 ? WS_ATT : WS_O)); constexpr int ALD = G2_FP8 ? 1024 : D;
        u32x4 aw[4][2];
#pragma unroll
        for (int q = 0; q < 4; ++q)
#pragma unroll
            for (int jj = 0; jj < 2; ++jj) aw[q][jj] = *(const u32x4*)(ATT + ((size_t)b * SEQ + 32 * c + 4 * wave + q) * ALD + (lane + 64 * jj) * 8);
        f32x4 ga[2][2], gl[2][2];
#pragma unroll
        for (int jj = 0; jj < 2; ++jj) { ga[jj][0] = *(const f32x4*)(a.in[I_G_ATTN] + (lane + 64 * jj) * 8); ga[jj][1] = *(const f32x4*)(a.in[I_G_ATTN] + (lane + 64 * jj) * 8 + 4);
            gl[jj][0] = *(const f32x4*)(a.in[I_G_LRU] + (lane + 64 * jj) * 8); gl[jj][1] = *(const f32x4*)(a.in[I_G_LRU] + (lane + 64 * jj) * 8 + 4); }
        __syncthreads();
#pragma unroll
        for (int q = 0; q < 4; ++q) {
            const int tl = 4 * wave + q; const size_t row = (size_t)b * SEQ + 32 * c + tl;
#pragma unroll
            for (int half = 0; half < 2; ++half) {
                u32x4 w[2]; float v[16]; float ss = 0.f;
#pragma unroll
                for (int jj = 0; jj < 2; ++jj) { w[jj] = half == 0 ? *(const LAS u32x4*)(lds + tl * LR_XS + (lane + 64 * jj) * 16) : aw[q][jj];
#pragma unroll
                    for (int k = 0; k < 4; ++k) { v[jj * 8 + 2 * k] = bflo(w[jj][k]); v[jj * 8 + 2 * k + 1] = bfhi(w[jj][k]); } }
#pragma unroll
                for (int k = 0; k < 16; ++k) ss += v[k] * v[k];
                ss = wave_sum(ss);
                const float rstd = (G2_FP8 ? XS_SCALE : 1.0f) * __builtin_amdgcn_rsqf(ss * (1.0f / 1024.0f) + EPS);
#pragma unroll
                for (int jj = 0; jj < 2; ++jj) { const f32x4 g0 = half == 0 ? gl[jj][0] : ga[jj][0], g1 = half == 0 ? gl[jj][1] : ga[jj][1];
                    const size_t col = (half == 0 ? 1024 : 0) + (lane + 64 * jj) * 8;
                    if (G2_FP8) *(u32x2*)(O8 + row * D + col) = (u32x2){pk4_fp8(v[jj * 8 + 0] * rstd * g0.x, v[jj * 8 + 1] * rstd * g0.y, v[jj * 8 + 2] * rstd * g0.z, v[jj * 8 + 3] * rstd * g0.w),
                                                                       pk4_fp8(v[jj * 8 + 4] * rstd * g1.x, v[jj * 8 + 5] * rstd * g1.y, v[jj * 8 + 6] * rstd * g1.z, v[jj * 8 + 7] * rstd * g1.w)};
                    else *(u32x4*)(O + row * D + col) = (u32x4){pk2(v[jj * 8 + 0] * rstd * g0.x, v[jj * 8 + 1] * rstd * g0.y), pk2(v[jj * 8 + 2] * rstd * g0.z, v[jj * 8 + 3] * rstd * g0.w),
                                                                pk2(v[jj * 8 + 4] * rstd * g1.x, v[jj * 8 + 5] * rstd * g1.y), pk2(v[jj * 8 + 6] * rstd * g1.z, v[jj * 8 + 7] * rstd * g1.w)}; }
            }
        }
    }
}

__device__ __forceinline__ void phase_router_mfma(const Args& a, LAS unsigned char* lds, int tid, int lane, int wave) {
    const bf16* H1 = (const bf16*)(a.ws + WS_H1); const bf16* WRT = (const bf16*)(a.ws + WS_WRT);
    int* tope = (int*)(a.ws + WS_TOPE); float* topw = (float*)(a.ws + WS_TOPW); float* rstd2 = (float*)(a.ws + WS_RSTD2);
    unsigned* counts = (unsigned*)(a.ws + WS_CTL) + CW_COUNTS;
    LAS float* lg = (LAS float*)(lds + wave * 2048);
    LAS int* hist = (LAS int*)(lds + 32768);
    if (tid < 32) hist[tid] = 0;
    __syncthreads();
    const int fr = lane & 15, fq = lane >> 4;
    for (int grp = wave * gridDim.x + blockIdx.x; grp < MREAL / 16; grp += 8 * gridDim.x) {
        const int row0 = grp * 16;
        const bf16* hp = H1 + (size_t)(row0 + fr) * D + 8 * fq;
        const bf16* wp = WRT + (size_t)fr * D + 8 * fq;
        f32x4 acc0 = (f32x4){0.f, 0.f, 0.f, 0.f}, acc1 = acc0; float ss = 0.f;
#pragma unroll 4
        for (int kk = 0; kk < 64; ++kk) {
            const u32x4 w = *(const u32x4*)(hp + 32 * kk);
#pragma unroll
            for (int q = 0; q < 4; ++q) { const float lo = bflo(w[q]), hi = bfhi(w[q]); ss += lo * lo + hi * hi; }
            const bf16x8 af = __builtin_bit_cast(bf16x8, w);
            const bf16x8 b0 = *(const bf16x8*)(wp + 32 * kk), b1 = *(const bf16x8*)(wp + (size_t)16 * D + 32 * kk);
            acc0 = __builtin_amdgcn_mfma_f32_16x16x32_bf16(af, b0, acc0, 0, 0, 0);
            acc1 = __builtin_amdgcn_mfma_f32_16x16x32_bf16(af, b1, acc1, 0, 0, 0);
        }
        ss += __shfl_xor(ss, 16); ss += __shfl_xor(ss, 32);
        const float rstd = 1.0f / sqrtf(ss * (1.0f / D) + EPS);
        if (fq == 0) rstd2[row0 + fr] = rstd;
        const float br0 = a.in[I_B_ROUTER][fr], br1 = a.in[I_B_ROUTER][16 + fr];
#pragma unroll
        for (int j = 0; j < 4; ++j) { const int row = 4 * fq + j; const float rs = __shfl(rstd, row);
            lg[row * 32 + fr] = acc0[j] * rs + br0; lg[row * 32 + 16 + fr] = acc1[j] * rs + br1; }
        asm volatile("s_waitcnt lgkmcnt(0)" ::: "memory");
        if (lane < 16) {
            float v[32];
#pragma unroll
            for (int q = 0; q < 8; ++q) { const f32x4 t = *(const LAS f32x4*)(lg + lane * 32 + 4 * q); v[4 * q] = t.x; v[4 * q + 1] = t.y; v[4 * q + 2] = t.z; v[4 * q + 3] = t.w; }
            float tv[4]; int te[4];
#pragma unroll
            for (int r = 0; r < 4; ++r) { float best = -3.0e38f; int bi = 0;
#pragma unroll
                for (int e = 0; e < 32; ++e) { const bool gtb = v[e] > best; best = gtb ? v[e] : best; bi = gtb ? e : bi; }
#pragma unroll
                for (int e = 0; e < 32; ++e) v[e] = (e == bi) ? -3.0e38f : v[e];
                tv[r] = best; te[r] = bi; }
            const float e1 = __expf(tv[1] - tv[0]), e2 = __expf(tv[2] - tv[0]), e3 = __expf(tv[3] - tv[0]);
            const float inv = 1.0f / (1.0f + e1 + e2 + e3);
            const int row = row0 + lane;
            *(int4*)(tope + row * 4) = make_int4(te[0], te[1], te[2], te[3]);
            *(f32x4*)(topw + row * 4) = (f32x4){inv, e1 * inv, e2 * inv, e3 * inv};
#pragma unroll
            for (int r = 0; r < 4; ++r) atomicAdd((int*)&hist[te[r]], 1);
        }
        asm volatile("s_waitcnt lgkmcnt(0)" ::: "memory");
    }
    __syncthreads();
    if (tid < 32 && hist[tid] != 0) atomicAdd(&counts[tid], (unsigned)hist[tid]);
}

__device__ __forceinline__ void build_tile_table(const Args& a, LAS int* tstart, int tid) {
    if (tid == 0) {
        const unsigned* counts = (const unsigned*)(a.ws + WS_CTL) + CW_COUNTS;
        int acc = 0;
        for (int e = 0; e < NEXP; ++e) { tstart[e] = acc; acc += (int)((__hip_atomic_load(counts + e, __ATOMIC_RELAXED, __HIP_MEMORY_SCOPE_AGENT) + 255u) >> 8); }
        tstart[NEXP] = acc;
    }
    __syncthreads();
}
__device__ __forceinline__ int tile_expert(const LAS int* tstart, int tile) {
    int e = 0;
#pragma unroll 1
    for (int i = 1; i < NEXP; ++i) e += (tstart[i] <= tile) ? 1 : 0;
    return e;
}

__device__ __forceinline__ void phase_assign(const Args& a, LAS unsigned char* lds, int tid, int lane, int wave) {
    LAS int* tstart = (LAS int*)(lds + LDS_TAB);
    LAS int* hist = tstart + 64; LAS int* base = hist + 32; LAS int* spos = base + 32;
    build_tile_table(a, tstart, tid);
    const int* tope = (const int*)(a.ws + WS_TOPE); const float* topw = (const float*)(a.ws + WS_TOPW); const float* rstd2 = (const float*)(a.ws + WS_RSTD2);
    int* rowpair = (int*)(a.ws + WS_ROWPAIR); float* roww = (float*)(a.ws + WS_ROWW);
    unsigned* cursor = (unsigned*)(a.ws + WS_CTL) + CW_CURSOR;
    const bf16* H1 = (const bf16*)(a.ws + WS_H1); unsigned char* XS = (unsigned char*)(a.ws + WS_XS);
    for (int blk = blockIdx.x; blk < MREAL / 64; blk += gridDim.x) {
        if (tid < 32) hist[tid] = 0;
        __syncthreads();
        int e = 0, rank = 0, pair = 0;
        if (tid < 256) { pair = blk * 256 + tid; e = tope[pair]; rank = atomicAdd((int*)&hist[e], 1); }
        __syncthreads();
        if (tid < 32) base[tid] = (int)atomicAdd(&cursor[tid], (unsigned)hist[tid]);
        __syncthreads();
        if (tid < 256) { const int pos = tstart[e] * 256 + base[e] + rank; spos[tid] = pos; rowpair[pos] = pair; roww[pos] = topw[pair]; }
        __syncthreads();
        for (int tt = wave * 8; tt < wave * 8 + 8; ++tt) {
            const int token = blk * 64 + tt; const float rstd = rstd2[token] * XS_SCALE;
            const u32x4* hr = (const u32x4*)(H1 + (size_t)token * D);
            u32x2 o[4];
#pragma unroll
            for (int j = 0; j < 4; ++j) { const u32x4 hv = hr[lane + 64 * j];
                const f32x4 g0 = ((const f32x4*)a.in[I_NORM_FFN])[2 * (lane + 64 * j)], g1 = ((const f32x4*)a.in[I_NORM_FFN])[2 * (lane + 64 * j) + 1];
                o[j] = (u32x2){pk4_fp8(bflo(hv[0]) * rstd * g0.x, bfhi(hv[0]) * rstd * g0.y, bflo(hv[1]) * rstd * g0.z, bfhi(hv[1]) * rstd * g0.w),
                               pk4_fp8(bflo(hv[2]) * rstd * g1.x, bfhi(hv[2]) * rstd * g1.y, bflo(hv[3]) * rstd * g1.z, bfhi(hv[3]) * rstd * g1.w)}; }
#pragma unroll
            for (int k = 0; k < 4; ++k) { u32x2* dst = (u32x2*)(XS + (size_t)spos[tt * 4 + k] * D);
#pragma unroll
                for (int j = 0; j < 4; ++j) dst[lane + 64 * j] = o[j]; }
        }
        __syncthreads();
    }
}

__device__ __forceinline__ void phase_final(const Args& a, int lane, int wave) {
    const int gw = blockIdx.x * 8 + wave, NGW = gridDim.x * 8;
    const bf16* H1 = (const bf16*)(a.ws + WS_H1); const bf16* YB = (const bf16*)(a.ws + WS_YB);
    for (int row = gw; row < MREAL; row += NGW) {
        f32x4 v[8]; float ss = 0.f;
#pragma unroll
        for (int j = 0; j < 8; ++j) { { const u32x2 hh = ((const u32x2*)(H1 + (size_t)row * D))[lane + 64 * j]; v[j] = (f32x4){bflo(hh.x), bfhi(hh.x), bflo(hh.y), bfhi(hh.y)}; }
#pragma unroll
            for (int k = 0; k < 4; ++k) { const u32x2 y = ((const u32x2*)(YB + ((size_t)row * 4 + k) * D))[lane + 64 * j];
                v[j].x += bf2f(y.x); v[j].y += bf2f(y.x >> 16); v[j].z += bf2f(y.y); v[j].w += bf2f(y.y >> 16); }
            ss += (v[j].x * v[j].x + v[j].y * v[j].y) + (v[j].z * v[j].z + v[j].w * v[j].w); }
        ss = wave_sum(ss);
        const float rstd = 1.0f / sqrtf(ss * (1.0f / D) + EPS);
        f32x4* op = (f32x4*)(a.out + (size_t)row * D);
#pragma unroll
        for (int j = 0; j < 8; ++j) { const f32x4 g = ((const f32x4*)a.in[I_FINAL_NORM])[lane + 64 * j]; op[lane + 64 * j] = v[j] * rstd * g; }
    }
}

enum { PH_PROLOGUE = 0, PH_G1, PH_ATTN, PH_LRU_B, PH_G2, PH_ROUTER, PH_ASSIGN, PH_G3, PH_G4, PH_FINAL, PH_COUNT };

__global__ void __launch_bounds__(512, 2) fwd(Args a) {
    extern __shared__ __attribute__((aligned(16))) unsigned char lds_raw[];
    LAS unsigned char* lds = (LAS unsigned char*)lds_raw;
    const int tid = threadIdx.x, lane = tid & 63, wave = __builtin_amdgcn_readfirstlane(tid >> 6);
    const int gw = blockIdx.x * 8 + wave, NGW = gridDim.x * 8;
    unsigned char* ws = a.ws;
#define IN(k) (a.ph_lo <= (k) && (k) < a.ph_hi)
    pg8::BGNone nobg;
#define SEAM(k) do { if (IN(k) && IN((k) + 1)) xcd_barrier(bar); } while (0)
    if (tid < 4) ((LAS unsigned*)(lds + LDS_MISC))[tid] = 0u;
    __syncthreads();
    XcdBarrier bar; bar.bar = (unsigned*)(ws + WS_CTL) + CW_BAR; bar.x = 0; bar.st = nullptr;
    if (a.ph_hi - a.ph_lo > 1) bar = xcd_barrier_post((unsigned*)(ws + WS_CTL) + CW_BAR, (volatile LAS unsigned*)(lds + LDS_MISC));

    if (IN(PH_PROLOGUE)) { phase_prologue(a, lds, tid, lane, wave);
#if PROBE_REPEAT == 0
        __syncthreads(); phase_prologue(a, lds, tid, lane, wave);
#endif
    }
    SEAM(PH_PROLOGUE);

    if (IN(PH_G1)) {
        pg8::SchedDense S{(const char*)(ws + WS_N1), (const char*)(ws + WS_WINT), MROWS / 256, DIN / 256, (int)gridDim.x, (int)blockIdx.x, G1_FP8 ? 2048 : 4096};
        pg8::EpiZ E{(bf16*)(ws + WS_Z), a.in[I_B_IN], G1_FP8 ? 1.0f / (W_SCALE * XS_SCALE) : 1.0f};
        pg8::gemm_phase<G1_FP8 != 0>(lds, S, E, nobg);
#if PROBE_REPEAT == 1
        __syncthreads(); pg8::gemm_phase<G1_FP8 != 0>(lds, S, E, nobg);
#endif
    }
    SEAM(PH_G1);
    if (IN(PH_ATTN)) {
        for (int it = blockIdx.x; it < NBATCH * 16 * 4; it += gridDim.x) attn_item(a, lds, it, tid, lane, wave);
        for (int it = blockIdx.x; it < NBATCH * 65; it += gridDim.x) { if (it % 65 == 64 && it != 64) continue; lru_item<0>(a, lds, it, tid, lane, wave); }
#if PROBE_REPEAT == 2
        for (int it = blockIdx.x; it < NBATCH * 16 * 4; it += gridDim.x) attn_item(a, lds, it, tid, lane, wave);
#endif
#if PROBE_REPEAT == 3
        for (int it = blockIdx.x; it < NBATCH * 65; it += gridDim.x) { if (it % 65 == 64 && it != 64) continue; lru_item<0>(a, lds, it, tid, lane, wave); }
#endif
    }
    SEAM(PH_ATTN);
    if (IN(PH_LRU_B)) {
        for (int it = blockIdx.x; it < NBATCH * 65; it += gridDim.x) { if (it % 65 == 64) continue; lru_item<1>(a, lds, it, tid, lane, wave); }
    }
    SEAM(PH_LRU_B);
    if (IN(PH_G2)) {
        pg8::SchedDense S{(const char*)(ws + WS_O), (const char*)(ws + WS_WOUTT), MREAL / 256, D / 256, (int)gridDim.x, (int)blockIdx.x, G2_FP8 ? 2048 : 4096};
        pg8::EpiH1 E{(bf16*)(ws + WS_H1), a.in[I_X], a.in[I_B_OUT], G2_FP8 ? 1.0f / (W_SCALE * XS_SCALE) : 1.0f};
        pg8::gemm_phase<G2_FP8 != 0>(lds, S, E, nobg);
#if PROBE_REPEAT == 4
        __syncthreads(); pg8::gemm_phase<G2_FP8 != 0>(lds, S, E, nobg);
#endif
    }
    SEAM(PH_G2);
    if (IN(PH_ROUTER)) phase_router_mfma(a, lds, tid, lane, wave);
    SEAM(PH_ROUTER);
    if (IN(PH_ASSIGN)) phase_assign(a, lds, tid, lane, wave);
    SEAM(PH_ASSIGN);
    if (IN(PH_G3)) {
        LAS int* tstart = (LAS int*)(lds + LDS_TAB);
        build_tile_table(a, tstart, tid);
        pg8::SchedMoE S{(const char*)(ws + WS_XS), (const char*)(ws + WS_WGT), (const char*)(ws + WS_WUT), tstart, tstart[NEXP], DFF / 128, (int)gridDim.x, (int)blockIdx.x, true};
        pg8::EpiAct E{(unsigned char*)(ws + WS_ACT), a.in[I_B_GATE], a.in[I_B_UP]};
#if BG_WDOWN
        pg8::BGConv bg{(const char*)a.in[I_W_DOWN], ws + WS_WDT, (int)blockIdx.x * (32768 / 256), ((int)blockIdx.x + 1) * (32768 / 256), ws + WS_DUMMY};
        if (gridDim.x != 256) { bg.next = (int)((long)blockIdx.x * 32768 / gridDim.x); bg.end = (int)((long)(blockIdx.x + 1) * 32768 / gridDim.x); }
        pg8::gemm_phase<true>(lds, S, E, bg);
        for (int pair = bg.next < bg.end ? bg.next : bg.end; pair < bg.end; ++pair) { const char* sp; unsigned char* dp; pg8::bg_pair_ptrs(bg, pair, sp, dp);
            const int n = tid >> 4, c = tid & 15;
            const float* p = (const float*)sp + (size_t)(8 * c) * 2048 + n;
            *(u32x2*)(dp + (size_t)n * 2048 + 8 * c) = (u32x2){pk4_fp8(p[0] * W_SCALE, p[2048] * W_SCALE, p[4096] * W_SCALE, p[6144] * W_SCALE), pk4_fp8(p[8192] * W_SCALE, p[10240] * W_SCALE, p[12288] * W_SCALE, p[14336] * W_SCALE)}; }
#else
        pg8::gemm_phase<true>(lds, S, E, nobg);
#endif
#if PROBE_REPEAT == 7
        __syncthreads(); pg8::gemm_phase<true>(lds, S, E, nobg);
#endif
    }
    SEAM(PH_G3);
    if (IN(PH_G4)) {
        LAS int* tstart = (LAS int*)(lds + LDS_TAB);
        build_tile_table(a, tstart, tid);
        pg8::SchedMoE S{(const char*)(ws + WS_ACT), (const char*)(ws + WS_WDT), (const char*)(ws + WS_WDT), tstart, tstart[NEXP], D / 256, (int)gridDim.x, (int)blockIdx.x, false};
        pg8::EpiDown E{(bf16*)(ws + WS_YB), a.in[I_B_DOWN], (const int*)(ws + WS_ROWPAIR), (const float*)(ws + WS_ROWW)};
        pg8::gemm_phase<true>(lds, S, E, nobg);
#if PROBE_REPEAT == 8
        __syncthreads(); pg8::gemm_phase<true>(lds, S, E, nobg);
#endif
    }
    SEAM(PH_G4);
    if (IN(PH_FINAL)) { phase_final(a, lane, wave);
#if PROBE_REPEAT == 9
        phase_final(a, lane, wave);
#endif
    }
#undef IN
#undef SEAM
}

extern "C" void kernel_launch(void* const* d_in, const int* in_sizes, int n_in, void* d_out, int out_size, void* d_ws, size_t ws_size, hipStream_t stream) {
    static int grid = 0;
    if (grid == 0) {
        if (n_in != 27 || out_size != MREAL * D || ws_size < WS_END) { fprintf(stderr, "kernel_launch: unexpected problem (n_in %d, out %d, ws %zu)\n", n_in, out_size, ws_size); grid = -1; return; }
        int dev = 0, cus = 0;
        if (hipGetDevice(&dev) != hipSuccess || hipDeviceGetAttribute(&cus, hipDeviceAttributeMultiprocessorCount, dev) != hipSuccess) { grid = -1; return; }
        if (hipFuncSetAttribute((const void*)fwd, hipFuncAttributeMaxDynamicSharedMemorySize, LDS_BYTES) != hipSuccess) { fprintf(stderr, "kernel_launch: hipFuncSetAttribute failed\n"); grid = -1; return; }
        grid = cus;
    }
    if (grid < 0) return;
    (void)hipMemsetAsync((char*)d_ws + WS_CTL, 0, CTL_BYTES, stream);
    Args a{};
    for (int i = 0; i < 27; ++i) a.in[i] = (const float*)d_in[i];
    a.out = (float*)d_out; a.ws = (unsigned char*)d_ws;
#if MK_ONE_LAUNCH
    a.ph_lo = 0; a.ph_hi = PH_COUNT;
    hipLaunchKernelGGL(fwd, dim3(grid), dim3(512), LDS_BYTES, stream, a);
#else
    for (int ph = 0; ph < PH_COUNT; ++ph) {
        a.ph_lo = ph; a.ph_hi = ph + 1;
        hipLaunchKernelGGL(fwd, dim3(grid), dim3(512), LDS_BYTES, stream, a);
    }
#endif
}
```

```cpp
#include <hip/hip_runtime.h>
#include <cstdio>
#include <cstdint>

#define LAS __attribute__((address_space(3)))
#ifndef PROBE_REPEAT
#define PROBE_REPEAT -1
#endif
#ifndef G1_FP8
#define G1_FP8 0
#endif
#ifndef G2_FP8
#define G2_FP8 0
#endif
#ifndef BG_WDOWN
#define BG_WDOWN 1
#endif
#ifndef BG_WUP
#define BG_WUP 0
#endif
#ifndef BG_EXP
#define BG_EXP 0
#endif
#ifndef MK_ONE_LAUNCH
#define MK_ONE_LAUNCH 1
#endif
typedef unsigned short bf16;
typedef float f32x4 __attribute__((ext_vector_type(4)));
typedef float f32x2 __attribute__((ext_vector_type(2)));
typedef short bf16x8 __attribute__((ext_vector_type(8)));
typedef unsigned u32x4 __attribute__((ext_vector_type(4)));
typedef unsigned u32x2 __attribute__((ext_vector_type(2)));

constexpr int D = 2048, SEQ = 2048, NMETA = 16, TT = 2064, NBATCH = 8;
constexpr int MREAL = 16384, METAROW0 = 16384, MVALID = 16400, MROWS = 16640;
constexpr int DIN = 3584, DLRU = 1024, HD = 64;
constexpr int ZQ = 0, ZK = 1024, ZV = 1280, ZX = 1536, ZG = 2560;
constexpr int NEXP = 32, DFF = 2048, PROWS = 73728;
constexpr float EPS = 1e-5f;

constexpr size_t MiB = 1u << 20;
constexpr size_t WS_CTL = 0, CTL_BYTES = 1 * MiB;
constexpr size_t WS_COS = 1 * MiB, WS_SIN = 1 * MiB + 320 * 1024;
constexpr size_t WS_TOPE = 2 * MiB, WS_TOPW = WS_TOPE + 256 * 1024, WS_RSTD2 = WS_TOPW + 256 * 1024, WS_ROWPAIR = WS_RSTD2 + 64 * 1024, WS_ROWW = WS_ROWPAIR + 320 * 1024;
constexpr size_t WS_DUMMY = 3 * MiB + 512 * 1024;
constexpr size_t WS_LRUSUM = 4 * MiB;
constexpr size_t WS_WAT = 9 * MiB, WS_WIT = WS_WAT + 128 * 1024, WS_WRT = WS_WIT + 128 * 1024;
constexpr size_t WS_WINT = 10 * MiB, WS_WOUTT = 24 * MiB, WS_WGT = 32 * MiB, WS_WUT = 288 * MiB, WS_WDT = 544 * MiB;
constexpr size_t WS_N1 = 800 * MiB, WS_Z = 866 * MiB, WS_O = 980 * MiB, WS_H1 = 1044 * MiB, WS_XS = 1172 * MiB, WS_YB = WS_XS, WS_ACT = 1460 * MiB, WS_END = 1748 * MiB;
constexpr size_t WS_AB = WS_XS;
constexpr size_t WS_ATT = WS_N1;
constexpr size_t WS_XC = WS_XS, WS_AA = WS_XS + 66 * MiB, WS_BB = WS_XS + 132 * MiB, WS_YL = WS_XS + 198 * MiB;
static_assert(WS_ROWW + PROWS * 4 <= WS_LRUSUM, "small map");
constexpr int CW_COUNTS = 1024, CW_CURSOR = 1088, CW_BAR = 4096;

constexpr int LDS_TAB = 131072;
constexpr int LDS_MISC = LDS_TAB + 8192;
constexpr int LDS_BG = LDS_MISC + 1024;
constexpr int LDS_T2 = LDS_BG + 16384;
constexpr int LDS_BYTES = LDS_T2 + 4352;
static_assert(LDS_BYTES <= 163840 && LDS_BG % 1024 == 0, "LDS map");

__device__ const float c_inv_freq[32] = {1.000000000e+00f, 7.498942018e-01f, 5.623413324e-01f, 4.216965139e-01f, 3.162277639e-01f, 2.371373922e-01f, 1.778279394e-01f, 1.333521456e-01f, 1.000000015e-01f, 7.498941571e-02f, 5.623412877e-02f, 4.216964915e-02f, 3.162277862e-02f, 2.371373586e-02f, 1.778279431e-02f, 1.333521493e-02f, 9.999999776e-03f, 7.498942316e-03f, 5.623413250e-03f, 4.216964822e-03f, 3.162277862e-03f, 2.371373819e-03f, 1.778279431e-03f, 1.333521446e-03f, 1.000000047e-03f, 7.498941850e-04f, 5.623413017e-04f, 4.216965463e-04f, 3.162277862e-04f, 2.371373848e-04f, 1.778279402e-04f, 1.333521504e-04f};

struct Args { const float* in[27]; float* out; unsigned char* ws; int ph_lo, ph_hi; };
enum { I_X = 0, I_META, I_NORM_MIX, I_W_IN, I_B_IN, I_SINKS, I_CONV_W, I_CONV_B, I_W_A, I_B_A, I_W_I, I_B_I, I_LAMBDA, I_G_ATTN, I_G_LRU, I_W_OUT, I_B_OUT, I_NORM_FFN,
       I_W_ROUTER, I_B_ROUTER, I_W_GATE, I_B_GATE, I_W_UP, I_B_UP, I_W_DOWN, I_B_DOWN, I_FINAL_NORM };


#define XB_TMO      128
#define XB_XCNT(j)  (256  + 64 * (j))
#define XB_XSUB(j)  (1280 + 64 * (j))
#define XB_XGEN(j)  (2304 + 64 * (j))
#define XB_TOP      3328
#define XB_TOPGEN   3392
#define XCD_BAR_WORDS 3456
#define XB_SPIN_CAP (1u << 18)

__device__ __forceinline__ unsigned xb_ld(unsigned* p)              { return __hip_atomic_load(p, __ATOMIC_RELAXED, __HIP_MEMORY_SCOPE_AGENT); }
__device__ __forceinline__ unsigned xb_add(unsigned* p, unsigned v) { return __hip_atomic_fetch_add(p, v, __ATOMIC_RELAXED, __HIP_MEMORY_SCOPE_AGENT); }
__device__ __forceinline__ unsigned xb_xcc_id() { return (unsigned)__builtin_amdgcn_s_getreg((3 << 11) | 20) & 0xFu; }
#define XB_SPIN(cond, bar) do { unsigned _sp = 0; while (cond) { __builtin_amdgcn_s_sleep(1); \
    if ((++_sp & 255u) == 0u) { if (xb_ld(&(bar)[XB_TMO])) break; if (_sp > XB_SPIN_CAP) { atomicAdd(&(bar)[XB_TMO], 1u); break; } } } } while (0)

struct XcdBarrier {
    unsigned* bar; unsigned x;
    volatile LAS unsigned* st;
};

__device__ __forceinline__ XcdBarrier xcd_barrier_post(unsigned* bar, volatile LAS unsigned* st) {
    XcdBarrier b; b.bar = bar; b.x = xb_xcc_id(); b.st = st;
    if (threadIdx.x == 0) (void)xb_add(&bar[XB_XCNT(b.x)], 1u);
    return b;
}
__device__ __forceinline__ void xcd_barrier_complete(unsigned* bar, unsigned x, unsigned& nloc, unsigned& nx) {
    const unsigned G = gridDim.x * gridDim.y * gridDim.z;
    unsigned sum, cnt, mine, sp = 0u;
    for (;;) {
        sum = 0u; cnt = 0u; mine = 0u;
#pragma unroll
        for (unsigned j = 0; j < 16; ++j) { const unsigned c = xb_ld(&bar[XB_XCNT(j)]); sum += c; cnt += (c > 0u) ? 1u : 0u; mine = (j == x) ? c : mine; }
        if (sum == G) break;
        __builtin_amdgcn_s_sleep(1);
        if ((++sp & 255u) == 0u) { if (xb_ld(&bar[XB_TMO])) break; if (sp > XB_SPIN_CAP) { atomicAdd(&bar[XB_TMO], 1u); break; } }
    }
    nloc = mine > 0u ? mine : 1u; nx = cnt > 0u ? cnt : 1u;
}

__device__ __forceinline__ void xcd_barrier(const XcdBarrier& b) {
    asm volatile("s_waitcnt vmcnt(0)" ::: "memory");
    __syncthreads();
    if (threadIdx.x == 0) {
        unsigned* bar = b.bar;
        __builtin_amdgcn_s_waitcnt(0);
        unsigned nloc = b.st[0], nx = b.st[1];
        if (nloc == 0u) { xcd_barrier_complete(bar, b.x, nloc, nx); b.st[0] = nloc; b.st[1] = nx; }
        const unsigned old = xb_add(&bar[XB_XSUB(b.x)], 1u);
        const unsigned gen = old / nloc;
        if (old + 1u == (gen + 1u) * nloc) {
            __builtin_amdgcn_fence(__ATOMIC_RELEASE, "agent");
            asm volatile("s_waitcnt vmcnt(0)" ::: "memory");
            const unsigned og = xb_add(&bar[XB_TOP], 1u);
            const unsigned tg = og / nx;
            if (og + 1u == (tg + 1u) * nx) xb_add(&bar[XB_TOPGEN], 1u);
            else XB_SPIN(xb_ld(&bar[XB_TOPGEN]) == tg, bar);
            __builtin_amdgcn_fence(__ATOMIC_ACQUIRE, "agent");
            xb_add(&bar[XB_XGEN(b.x)], 1u);
            asm volatile("s_waitcnt vmcnt(0)" ::: "memory");
        } else {
            XB_SPIN(xb_ld(&bar[XB_XGEN(b.x)]) == gen, bar);
            __builtin_amdgcn_fence(__ATOMIC_ACQUIRE, "agent");
            asm volatile("s_waitcnt vmcnt(0)" ::: "memory");
        }
    }
    __syncthreads();
}

__device__ __forceinline__ float bf2f(unsigned b) { return __uint_as_float((b & 0xffffu) << 16); }
__device__ __forceinline__ unsigned f2bf(float f) { unsigned u = __float_as_uint(f); return (u + 0x7fffu + ((u >> 16) & 1u)) >> 16; }
__device__ __forceinline__ unsigned pk2(float lo, float hi) { return f2bf(lo) | (f2bf(hi) << 16); }
constexpr float W_SCALE = 256.0f, XS_SCALE = 8.0f, ACT_SCALE = 4.0f;
__device__ __forceinline__ float clamp_fp8(float x) { return __builtin_amdgcn_fmed3f(x, -448.0f, 448.0f); }
__device__ __forceinline__ unsigned pk4_fp8(float a, float b, float c, float d) {
    int w = 0; w = __builtin_amdgcn_cvt_pk_fp8_f32(clamp_fp8(a), clamp_fp8(b), w, false); w = __builtin_amdgcn_cvt_pk_fp8_f32(clamp_fp8(c), clamp_fp8(d), w, true); return (unsigned)w; }
__device__ __forceinline__ float wave_sum(float v) {
#pragma unroll
    for (int o = 1; o < 64; o <<= 1) v += __shfl_xor(v, o);
    return v;
}
__device__ __forceinline__ float wave_max(float v) {
#pragma unroll
    for (int o = 1; o < 64; o <<= 1) v = fmaxf(v, __shfl_xor(v, o));
    return v;
}
__device__ __forceinline__ float sigmoidf_(float x) { return 1.0f / (1.0f + __expf(-x)); }
__device__ __forceinline__ float fast_sigmoid(float x) { return __builtin_amdgcn_rcpf(1.0f + __builtin_amdgcn_exp2f(-1.4426950408889634f * x)); }
__device__ __forceinline__ float fast_gelu_tanh(float x) { const float u2 = 1.5957691216057308f * (x + 0.044715f * x * x * x); return x * __builtin_amdgcn_rcpf(1.0f + __builtin_amdgcn_exp2f(-1.4426950408889634f * u2)); }
__device__ __forceinline__ float gelu_tanh(float x) { const float u = 0.7978845608028654f * (x + 0.044715f * x * x * x); return 0.5f * x * (1.0f + tanhf(u)); }
__device__ __forceinline__ int tok_row(int b, int t) { return t < NMETA ? METAROW0 + t : b * SEQ + (t - NMETA); }

__device__ __forceinline__ void transpose_item(const float* W, int K, int N, bf16* WT, LAS float* scr, int item, int lane) {
    const int nblk = N / 32, kb = item / nblk, nb = item % nblk, k0 = 64 * kb, n0 = 32 * nb;
#pragma unroll 8
    for (int i = 0; i < 32; ++i) { const int kk = 2 * i + (lane >> 5); scr[kk * 33 + (lane & 31)] = W[(size_t)(k0 + kk) * N + n0 + (lane & 31)]; }
    asm volatile("s_waitcnt lgkmcnt(0)" ::: "memory");
    const int c = lane & 7;
#pragma unroll
    for (int j = 0; j < 4; ++j) { const int n = (lane >> 3) + 8 * j; const LAS float* s = scr + (8 * c) * 33 + n;
        u32x4 o; o.x = pk2(s[0 * 33], s[1 * 33]); o.y = pk2(s[2 * 33], s[3 * 33]); o.z = pk2(s[4 * 33], s[5 * 33]); o.w = pk2(s[6 * 33], s[7 * 33]);
        *(u32x4*)(WT + (size_t)(n0 + n) * K + k0 + 8 * c) = o; }
    asm volatile("s_waitcnt lgkmcnt(0)" ::: "memory");
}

__device__ __forceinline__ void phase_prologue(const Args& a, LAS unsigned char* lds, int tid, int lane, int wave) {
    const int gw = blockIdx.x * 8 + wave, NGW = gridDim.x * 8;
    const int gt = blockIdx.x * 512 + tid, NGT = gridDim.x * 512;
    unsigned char* ws = a.ws;
    LAS float* scr = (LAS float*)(lds + wave * 8704);
    {
        constexpr int IT_IN = G1_FP8 ? 0 : 32 * (DIN / 32), IT_OUT = G2_FP8 ? 0 : 32 * (D / 32);
        for (int it = gw; it < IT_IN + IT_OUT; it += NGW) {
            if (it < IT_IN) transpose_item(a.in[I_W_IN], D, DIN, (bf16*)(ws + WS_WINT), scr, it, lane);
            else transpose_item(a.in[I_W_OUT], D, D, (bf16*)(ws + WS_WOUTT), scr, it - IT_IN, lane);
        }
        __syncthreads();
    }
    {
        LAS unsigned* T = (LAS unsigned*)lds;
        const int n4 = tid & 63, kq = tid >> 6;
        constexpr int T_IN = G1_FP8 ? (D / 128) * (DIN / 256) : 0, T_OUT = G2_FP8 ? (D / 128) * (D / 256) : 0, T_E = (D / 128) * (D / 256);
        constexpr int N_GATE = 32 * T_E, N_UP = (BG_WUP && !BG_EXP) ? 256 * 6 : 32 * T_E, N_DOWN = (BG_WDOWN && !BG_EXP) ? 0 : 32 * T_E;
        constexpr int NTILES = T_IN + T_OUT + N_GATE + N_UP + N_DOWN;
        auto tile_ptrs = [&](int tile, const float*& sp, unsigned char*& dp, int& ldn) {
            const float* sbase; unsigned char* dbase; int tl, nt;
            if (tile < T_IN) { sbase = a.in[I_W_IN]; dbase = ws + WS_WINT; tl = tile; nt = DIN / 256; ldn = DIN; }
            else if (tile < T_IN + T_OUT) { sbase = a.in[I_W_OUT]; dbase = ws + WS_WOUTT; tl = tile - T_IN; nt = D / 256; ldn = D; }
            else { int r = tile - T_IN - T_OUT, which, e; nt = D / 256; ldn = D;
                   if (r < N_GATE) { which = 0; e = r / T_E; tl = r % T_E; }
                   else if (r < N_GATE + N_UP) { r -= N_GATE; which = 1; int g = r; if (BG_WUP && !BG_EXP) g = 16 * (r / 6) + 10 + (r % 6);
                                                 e = g / T_E; tl = g % T_E; }
                   else { r -= N_GATE + N_UP; which = 2; e = r / T_E; tl = r % T_E; }
                   sbase = a.in[which == 0 ? I_W_GATE : (which == 1 ? I_W_UP : I_W_DOWN)] + (size_t)e * D * D; dbase = ws + (which == 0 ? WS_WGT : (which == 1 ? WS_WUT : WS_WDT)) + (size_t)e * D * D; }
            const int k0 = (tl / nt) * 128, n0 = (tl % nt) * 256;
            sp = sbase + (size_t)(k0 + 4 * kq) * ldn + n0 + 4 * n4; dp = dbase + (size_t)n0 * D + k0; };
#define CONV_LOAD(R, tile) do { const float* _p; unsigned char* _d; int _ld; tile_ptrs(tile, _p, _d, _ld); _Pragma("unroll") for (int i = 0; i < 4; ++i) _Pragma("unroll") for (int q = 0; q < 4; ++q) \
            R[i][q] = __builtin_nontemporal_load((const f32x4*)(_p + (size_t)(32 * i + q) * _ld)); } while (0)
#define CONV_STORE(R, tile) do { _Pragma("unroll") for (int i = 0; i < 4; ++i) { const int kd = kq + 8 * i; \
            T[(4 * n4 + 0) * 33 + kd] = pk4_fp8(R[i][0].x * W_SCALE, R[i][1].x * W_SCALE, R[i][2].x * W_SCALE, R[i][3].x * W_SCALE); \
            T[(4 * n4 + 1) * 33 + kd] = pk4_fp8(R[i][0].y * W_SCALE, R[i][1].y * W_SCALE, R[i][2].y * W_SCALE, R[i][3].y * W_SCALE); \
            T[(4 * n4 + 2) * 33 + kd] = pk4_fp8(R[i][0].z * W_SCALE, R[i][1].z * W_SCALE, R[i][2].z * W_SCALE, R[i][3].z * W_SCALE); \
            T[(4 * n4 + 3) * 33 + kd] = pk4_fp8(R[i][0].w * W_SCALE, R[i][1].w * W_SCALE, R[i][2].w * W_SCALE, R[i][3].w * W_SCALE); } \
            __syncthreads(); \
            { const float* _p; unsigned char* _d; int _ld; tile_ptrs(tile, _p, _d, _ld); _Pragma("unroll") for (int i = 0; i < 4; ++i) { const int n = (tid >> 3) + 64 * i, c = tid & 7; \
                const u32x4 o = (u32x4){T[n * 33 + 4 * c], T[n * 33 + 4 * c + 1], T[n * 33 + 4 * c + 2], T[n * 33 + 4 * c + 3]}; \
                *(u32x4*)(_d + (size_t)n * D + 16 * c) = o; } } \
            __syncthreads(); } while (0)
        f32x4 RA[4][4], RB[4][4];
        int tile = blockIdx.x;
        if (tile < NTILES) CONV_LOAD(RA, tile);
        while (tile < NTILES) {
            int nxt = tile + gridDim.x;
            if (nxt < NTILES) CONV_LOAD(RB, nxt);
            CONV_STORE(RA, tile);
            tile = nxt; if (tile >= NTILES) break;
            nxt = tile + gridDim.x;
            if (nxt < NTILES) CONV_LOAD(RA, nxt);
            CONV_STORE(RB, tile);
            tile = nxt;
        }
#undef CONV_LOAD
#undef CONV_STORE
    }
    for (int r = gw; r < MROWS; r += NGW) {
        u32x2* orow = (u32x2*)((bf16*)(ws + WS_N1) + (size_t)r * D);
        unsigned* orow8 = (unsigned*)(ws + WS_N1 + (size_t)r * D);
        if (r >= MVALID) {
#pragma unroll
            for (int j = 0; j < 8; ++j) { if (G1_FP8) orow8[lane + 64 * j] = 0u; else orow[lane + 64 * j] = (u32x2){0u, 0u}; }
            continue; }
        const f32x4* xr = (const f32x4*)(r < MREAL ? a.in[I_X] + (size_t)r * D : a.in[I_META] + (size_t)(r - MREAL) * D);
        f32x4 v[8]; float ss = 0.f;
#pragma unroll
        for (int j = 0; j < 8; ++j) { v[j] = xr[lane + 64 * j]; ss += (v[j].x * v[j].x + v[j].y * v[j].y) + (v[j].z * v[j].z + v[j].w * v[j].w); }
        ss = wave_sum(ss);
        const float rstd = (G1_FP8 ? XS_SCALE : 1.0f) / sqrtf(ss * (1.0f / D) + EPS);
#pragma unroll
        for (int j = 0; j < 8; ++j) { const f32x4 g = ((const f32x4*)a.in[I_NORM_MIX])[lane + 64 * j];
            if (G1_FP8) orow8[lane + 64 * j] = pk4_fp8(v[j].x * rstd * g.x, v[j].y * rstd * g.y, v[j].z * rstd * g.z, v[j].w * rstd * g.w);
            else orow[lane + 64 * j] = (u32x2){pk2(v[j].x * rstd * g.x, v[j].y * rstd * g.y), pk2(v[j].z * rstd * g.z, v[j].w * rstd * g.w)}; }
    }
    float* cosT = (float*)(ws + WS_COS); float* sinT = (float*)(ws + WS_SIN);
    for (int i = gt; i < TT * 32; i += NGT) {
        const int pos = i >> 5, j = i & 31;
        const float ang = (float)pos * c_inv_freq[j];
        const double t = (double)ang * 0.15915494309189535; const float fr = (float)(t - floor(t));
        cosT[i] = __builtin_amdgcn_cosf(fr); sinT[i] = __builtin_amdgcn_sinf(fr);
    }
    { bf16* WaT = (bf16*)(ws + WS_WAT); bf16* WiT = (bf16*)(ws + WS_WIT);
      for (int i = gt; i < 16 * 64 * 64; i += NGT) { const int n = i >> 12, d = (i >> 6) & 63, cc = i & 63;
          WaT[i] = (bf16)f2bf(a.in[I_W_A][(n * 64 + cc) * 64 + d]); WiT[i] = (bf16)f2bf(a.in[I_W_I][(n * 64 + cc) * 64 + d]); } }
    { bf16* WRT = (bf16*)(ws + WS_WRT);
      for (int i = gt; i < NEXP * D; i += NGT) { const int e = i >> 11, k = i & 2047; WRT[i] = (bf16)f2bf(a.in[I_NORM_FFN][k] * a.in[I_W_ROUTER][k * NEXP + e]); } }
    int* rowpair = (int*)(ws + WS_ROWPAIR);
    for (int i = gt; i < PROWS; i += NGT) rowpair[i] = -1;
}

namespace pg8 {
constexpr int BM = 256, BK = 64, HALF = 128, HTB = HALF * BK * 2, STAGE_BYTES = 8 * HTB, NXCD = 8, WGM = 8, KD = 2048, NKT = KD / BK;
__host__ __device__ __forceinline__ int lds_byte(int r, int c) { const int st = (r >> 4) * 2 + (c >> 5), rr = r & 15, cc = c & 31, ob = rr * 64 + cc * 2; return st * 1024 + (ob ^ (((ob >> 9) & 1) << 5)); }
__host__ __device__ __forceinline__ void stage_rc(int b, int& R, int& C) { const int st = b / 1024, sb = b % 1024, swz = sb ^ (((sb >> 9) & 1) << 5); R = (st >> 1) * 16 + swz / 64; C = (st & 1) * 32 + (swz % 64) / 2; }
__host__ __device__ __forceinline__ int perm32(int rho) { const int n = rho >> 4, i = rho & 15; return 8 * (i >> 2) + 4 * n + (i & 3); }
struct Unit { const char* a; const char* b0; const char* b1; int pm, pn, e; };
__device__ __forceinline__ bool static_tile(int i, int G, int c, int nM, int nN, int& pm, int& pn) {
    const int nwg = nM * nN; const long L = (long)i * G + c; if (L >= nwg) return false;
    int wgid = (int)L; { const int q = nwg / NXCD, r = nwg % NXCD, xcd = wgid % NXCD, off = wgid / NXCD; wgid = (xcd < r ? xcd * (q + 1) : r * (q + 1) + (xcd - r) * q) + off; }
    const int nig = WGM * nN, gid = wgid / nig, fm = gid * WGM, gsz = (nM - fm) < WGM ? (nM - fm) : WGM;
    pm = fm + ((wgid % nig) % gsz); pn = (wgid % nig) / gsz; return true;
}
__device__ __forceinline__ unsigned cvt_pk_bf16(float lo, float hi) { unsigned r; asm volatile("v_cvt_pk_bf16_f32 %0, %1, %2" : "=v"(r) : "v"(lo), "v"(hi)); return r; }

typedef int i32x8 __attribute__((ext_vector_type(8)));
typedef int i32x4 __attribute__((ext_vector_type(4)));
__device__ __forceinline__ i32x8 cat8(bf16x8 lo, bf16x8 hi) { const i32x4 a = __builtin_bit_cast(i32x4, lo), b = __builtin_bit_cast(i32x4, hi); return __builtin_shufflevector(a, b, 0, 1, 2, 3, 4, 5, 6, 7); }
struct BGNone { static constexpr bool ON = false; };
struct BGConv { static constexpr bool ON = true; const char* src; unsigned char* dst; int next, end; unsigned char* dummy; };
__device__ __forceinline__ void bg_pair_ptrs(const BGConv& bg, int pair, const char*& sp, unsigned char*& dp) {
    const int e = pair >> 10, kbp = (pair >> 6) & 15, nb = pair & 63;
    sp = bg.src + ((size_t)(e * 2048 + 128 * kbp) * 2048 + 32 * nb) * 4; dp = bg.dst + (size_t)e * 2048 * 2048 + (size_t)(32 * nb) * 2048 + 128 * kbp; }
template <bool FP8, class Epi, class Sched, class BG>
__device__ __forceinline__ void gemm_phase(LAS unsigned char* lds, const Sched& S, const Epi& E, BG& bg) {
    constexpr int ROWB = FP8 ? 2048 : 4096, NKTL = ROWB / 128;
    const int tid = threadIdx.x, wid = __builtin_amdgcn_readfirstlane(tid >> 6), lane = tid & 63, wr = wid >> 2, wc = wid & 3, fr = lane & 15, fq = lane >> 4;
    unsigned voffA[2], voffB[2];
#pragma unroll
    for (int i = 0; i < 2; ++i) { int R, C; stage_rc(tid * 16 + i * 8192, R, C); const int Rb = Epi::PERM ? ((R & ~31) + perm32(R & 31)) : R;
        voffA[i] = (unsigned)(R * ROWB + C * 2); voffB[i] = (unsigned)(Rb * ROWB + C * 2); }
    constexpr size_t kstep = (size_t)(BK * 2);
    constexpr size_t hstep = (size_t)HALF * ROWB;
    const unsigned ldsw = (unsigned)wid * 1024u;
    const unsigned bgvoff = (unsigned)((8 * wid + (lane >> 3)) * 8192 + (lane & 7) * 16);
    const int aoff = lds_byte(wr * 64 + fr, fq * 8), boff = lds_byte(wc * 32 + fr, fq * 8);
#define PG8_SA(b, h) (((b) * 2 + (h)) * HTB)
#define PG8_SB(b, h) ((4 + (b) * 2 + (h)) * HTB)
#define PG8_STAGE(bufoff, gbase, voff) do { _Pragma("unroll") for (int _i = 0; _i < 2; ++_i) \
        __builtin_amdgcn_global_load_lds((const unsigned*)((const char*)(gbase) + (voff)[_i]), (LAS unsigned*)(lds + (bufoff) + ldsw + _i * 8192), 16, 0, 0); } while (0)
#define PG8_LDA(dst, b, h) do { _Pragma("unroll") for (int m = 0; m < 4; ++m) { \
        if constexpr (FP8) dst##8[m] = __builtin_shufflevector(*(const LAS i32x4*)(lds + PG8_SA(b, h) + aoff + m * 2048), *(const LAS i32x4*)(lds + PG8_SA(b, h) + aoff + m * 2048 + 1024), 0, 1, 2, 3, 4, 5, 6, 7); \
        else { _Pragma("unroll") for (int k = 0; k < 2; ++k) dst[m][k] = *(const LAS bf16x8*)(lds + PG8_SA(b, h) + aoff + m * 2048 + k * 1024); } } } while (0)
#define PG8_LDB(dst, b, h) do { _Pragma("unroll") for (int n = 0; n < 2; ++n) { \
        if constexpr (FP8) dst##8[n] = __builtin_shufflevector(*(const LAS i32x4*)(lds + PG8_SB(b, h) + boff + n * 2048), *(const LAS i32x4*)(lds + PG8_SB(b, h) + boff + n * 2048 + 1024), 0, 1, 2, 3, 4, 5, 6, 7); \
        else { _Pragma("unroll") for (int k = 0; k < 2; ++k) dst[n][k] = *(const LAS bf16x8*)(lds + PG8_SB(b, h) + boff + n * 2048 + k * 1024); } } } while (0)
#define PG8_MMA(ai, bj, At, Bt) do { __builtin_amdgcn_s_setprio(1); _Pragma("unroll") for (int m = 0; m < 4; ++m) _Pragma("unroll") for (int n = 0; n < 2; ++n) { \
        if constexpr (FP8) asm volatile("v_mfma_f32_16x16x128_f8f6f4 %0, %1, %2, %0" : "+v"(acc[ai][bj][m][n]) : "v"(Bt##8[n]), "v"(At##8[m])); \
        else { _Pragma("unroll") for (int k = 0; k < 2; ++k) asm volatile("v_mfma_f32_16x16x32_bf16 %0, %1, %2, %0" : "+v"(acc[ai][bj][m][n]) : "v"(Bt[n][k]), "v"(At[m][k])); } } \
        __builtin_amdgcn_s_setprio(0); } while (0)
#define PG8_WAIT_V(n) asm volatile("s_waitcnt vmcnt(" #n ")" ::: "memory")
#define PG8_WAIT_L(n) asm volatile("s_waitcnt lgkmcnt(" #n ")" ::: "memory")
#define PG8_BAR __builtin_amdgcn_s_barrier()
#define PG8_SCHED __builtin_amdgcn_sched_barrier(0)
    Unit cur, nxt; int ui = 0; bool bg_pending = false;
    if (!S.next(0, cur)) return;
    f32x4 acc[2][2][4][2];
#pragma unroll
    for (int a = 0; a < 2; ++a)
#pragma unroll
        for (int b = 0; b < 2; ++b)
#pragma unroll
            for (int m = 0; m < 4; ++m)
#pragma unroll
                for (int n = 0; n < 2; ++n) acc[a][b][m][n] = (f32x4){0.f, 0.f, 0.f, 0.f};
    bf16x8 At[4][2], B0[2][2], B1[2][2];
    i32x8 At8[4], B08[2], B18[2];
    PG8_STAGE(PG8_SB(0, 0), cur.b0, voffB); PG8_STAGE(PG8_SB(0, 1), cur.b1, voffB); PG8_STAGE(PG8_SA(0, 0), cur.a, voffA); PG8_STAGE(PG8_SA(0, 1), cur.a + hstep, voffA);
    if (wr == 1) PG8_BAR;
    PG8_WAIT_V(2); PG8_BAR;
    PG8_STAGE(PG8_SB(1, 0), cur.b0 + kstep, voffB); PG8_STAGE(PG8_SA(1, 0), cur.a + kstep, voffA); PG8_STAGE(PG8_SB(1, 1), cur.b1 + kstep, voffB);
    PG8_WAIT_V(6); PG8_BAR;
    for (;;) {
        const bool has_next = S.next(ui + 1, nxt);
        const char* nA = has_next ? nxt.a : cur.a; const char* nB0 = has_next ? nxt.b0 : cur.b0; const char* nB1 = has_next ? nxt.b1 : cur.b1;
        for (int t = 0; t < NKTL; t += 2) {
            const bool last = (t == NKTL - 2);
            const char* a1 = cur.a + (size_t)(t + 1) * kstep;
            const char* a2 = last ? nA : cur.a + (size_t)(t + 2) * kstep;
            const char* b20 = last ? nB0 : cur.b0 + (size_t)(t + 2) * kstep; const char* b21 = last ? nB1 : cur.b1 + (size_t)(t + 2) * kstep;
            const char* a3 = a2 + kstep; const char* b30 = b20 + kstep; const char* b31 = b21 + kstep;
            PG8_LDB(B0, 0, 0); PG8_LDB(B1, 0, 1); PG8_SCHED; PG8_LDA(At, 0, 0); PG8_STAGE(PG8_SA(1, 1), a1 + hstep, voffA);
            PG8_WAIT_V(8); PG8_WAIT_L(0); PG8_BAR; PG8_MMA(0, 0, At, B0);
            if constexpr (BG::ON) {
                PG8_SCHED;
#pragma unroll
                for (int j = 0; j < (BG_EXP == 1 ? 0 : 2); ++j) { const LAS float* p = (const LAS float*)(lds + LDS_BG + j * 8192 + (tid >> 5) * 512 + (tid & 31) * 4);
                    ((LAS unsigned*)(lds + LDS_T2))[(tid & 31) * 33 + 16 * j + (tid >> 5)] = pk4_fp8(p[0] * W_SCALE, p[32] * W_SCALE, p[64] * W_SCALE, p[96] * W_SCALE); }
                const char* bgs; { unsigned char* dp_; pg8::bg_pair_ptrs(bg, bg.next < bg.end ? bg.next : bg.end - 1, bgs, dp_); }
                PG8_SCHED;
                if (BG_EXP != 2) {
                __builtin_amdgcn_global_load_lds((const unsigned*)(bgs + bgvoff), (LAS unsigned*)(lds + LDS_BG + ldsw), 16, 0, 0);
                __builtin_amdgcn_global_load_lds((const unsigned*)(bgs + 524288 + bgvoff), (LAS unsigned*)(lds + LDS_BG + 8192 + ldsw), 16, 0, 0); }
                PG8_SCHED; }
            PG8_MMA(0, 1, At, B1);
            if constexpr (BG::ON) { PG8_WAIT_L(0); }
            PG8_BAR; PG8_SCHED;
            PG8_LDA(At, 0, 1); PG8_STAGE(PG8_SB(0, 0), b20, voffB); PG8_STAGE(PG8_SB(0, 1), b21, voffB); PG8_STAGE(PG8_SA(0, 0), a2, voffA);
            if constexpr (BG::ON) { if (BG_EXP == 2) PG8_WAIT_V(8); else PG8_WAIT_V(10); } else { PG8_WAIT_V(8); }
            PG8_WAIT_L(0); PG8_BAR; PG8_MMA(1, 0, At, B0);
            if constexpr (BG::ON) {
                PG8_SCHED;
                unsigned char* bgd; { const char* sp_; pg8::bg_pair_ptrs(bg, bg.next - 1 < bg.end ? bg.next - 1 : bg.end - 1, sp_, bgd); }
                const LAS unsigned* q = (const LAS unsigned*)(lds + LDS_T2) + (tid >> 4) * 33 + 2 * (tid & 15);
                const u32x2 w = (u32x2){q[0], q[1]};
                if (BG_EXP != 1) *(u32x2*)((bg_pending && !BG_EXP) ? bgd + (size_t)(tid >> 4) * 2048 + 8 * (tid & 15) : bg.dummy + 8 * tid) = w;
                ++bg.next; bg_pending = true;
                PG8_SCHED; }
            PG8_MMA(1, 1, At, B1); PG8_BAR; PG8_SCHED;
            PG8_LDB(B0, 1, 0); PG8_LDB(B1, 1, 1); PG8_SCHED; PG8_LDA(At, 1, 0); PG8_STAGE(PG8_SA(0, 1), a2 + hstep, voffA);
            if constexpr (BG::ON) { if (BG_EXP == 1) PG8_WAIT_V(10); else if (BG_EXP == 2) PG8_WAIT_V(9); else PG8_WAIT_V(11); } else { PG8_WAIT_V(8); }
            PG8_WAIT_L(0); PG8_BAR; PG8_MMA(0, 0, At, B0); PG8_MMA(0, 1, At, B1); PG8_BAR; PG8_SCHED;
            PG8_LDA(At, 1, 1); PG8_STAGE(PG8_SB(1, 0), b30, voffB); PG8_STAGE(PG8_SB(1, 1), b31, voffB); PG8_STAGE(PG8_SA(1, 0), a3, voffA);
            if constexpr (BG::ON) { if (BG_EXP == 1) PG8_WAIT_V(8); else PG8_WAIT_V(9); } else { PG8_WAIT_V(8); }
            PG8_WAIT_L(0); PG8_BAR; PG8_MMA(1, 0, At, B0); PG8_MMA(1, 1, At, B1); PG8_BAR; PG8_SCHED;
        }
        if (wr == 0) PG8_BAR;
        asm volatile("s_nop 15\n\ts_nop 15" ::: "memory");
        E(acc, cur, wr, wc, fr, fq);
        if (!has_next) break;
#pragma unroll
        for (int a = 0; a < 2; ++a)
#pragma unroll
            for (int b = 0; b < 2; ++b)
#pragma unroll
                for (int m = 0; m < 4; ++m)
#pragma unroll
                    for (int n = 0; n < 2; ++n) acc[a][b][m][n] = (f32x4){0.f, 0.f, 0.f, 0.f};
        cur = nxt; ++ui;
        if (wr == 1) PG8_BAR;
    }
    PG8_WAIT_V(0);
    PG8_BAR;
    if constexpr (BG::ON) { if (bg_pending && !BG_EXP) {
        unsigned char* bgd; { const char* sp_; pg8::bg_pair_ptrs(bg, bg.next - 1 < bg.end ? bg.next - 1 : bg.end - 1, sp_, bgd); }
#pragma unroll
        for (int j = 0; j < 2; ++j) { const LAS float* p = (const LAS float*)(lds + LDS_BG + j * 8192 + (tid >> 5) * 512 + (tid & 31) * 4);
            ((LAS unsigned*)(lds + LDS_T2))[(tid & 31) * 33 + 16 * j + (tid >> 5)] = pk4_fp8(p[0] * W_SCALE, p[32] * W_SCALE, p[64] * W_SCALE, p[96] * W_SCALE); }
        __syncthreads();
        const LAS unsigned* q = (const LAS unsigned*)(lds + LDS_T2) + (tid >> 4) * 33 + 2 * (tid & 15);
        *(u32x2*)(bgd + (size_t)(tid >> 4) * 2048 + 8 * (tid & 15)) = (u32x2){q[0], q[1]}; } }
#undef PG8_SA
#undef PG8_SB
#undef PG8_STAGE
#undef PG8_LDA
#undef PG8_LDB
#undef PG8_MMA
#undef PG8_WAIT_V
#undef PG8_WAIT_L
#undef PG8_BAR
#undef PG8_SCHED
}

struct SchedDense {
    const char* A; const char* Bt; int nM, nN, G, c, rowb;
    __device__ __forceinline__ bool next(int i, Unit& u) const {
        int pm, pn; if (!static_tile(i, G, c, nM, nN, pm, pn)) return false;
        u.pm = pm; u.pn = pn; u.e = 0; u.a = A + (size_t)pm * BM * rowb; u.b0 = Bt + (size_t)pn * BM * rowb; u.b1 = u.b0 + (size_t)HALF * rowb; return true;
    }
};
struct SchedMoE {
    const char* A; const char* B0; const char* B1; const LAS int* tstart; int nM, nN, G, c; bool split;
    __device__ __forceinline__ bool next(int i, Unit& u) const {
        int pm, pn; if (!static_tile(i, G, c, nM, nN, pm, pn)) return false;
        int e = 0;
#pragma unroll 1
        for (int q = 1; q < 32; ++q) e += (tstart[q] <= pm) ? 1 : 0;
        u.pm = pm; u.pn = pn; u.e = e; u.a = A + (size_t)pm * (BM * 2048);
        const size_t eoff = (size_t)e * ((size_t)2048 * 2048);
        if (split) { u.b0 = B0 + eoff + (size_t)pn * (HALF * 2048); u.b1 = B1 + eoff + (size_t)pn * (HALF * 2048); }
        else { u.b0 = B0 + eoff + (size_t)pn * (BM * 2048); u.b1 = u.b0 + (size_t)HALF * 2048; }
        return true;
    }
};

struct EpiZ {
    static constexpr bool PERM = true;
    bf16* Z; const float* bias; float sc;
    __device__ __forceinline__ void operator()(const f32x4 (&acc)[2][2][4][2], const Unit& u, int wr, int wc, int fr, int fq) const {
        const int row0 = u.pm * BM + wr * 64 + fr, col0 = u.pn * BM + wc * 32 + 8 * fq;
        f32x4 bv[2][2];
#pragma unroll
        for (int bj = 0; bj < 2; ++bj)
#pragma unroll
            for (int n = 0; n < 2; ++n) bv[bj][n] = *(const f32x4*)(bias + col0 + bj * HALF + 4 * n);
#pragma unroll
        for (int ai = 0; ai < 2; ++ai)
#pragma unroll
            for (int m = 0; m < 4; ++m) { bf16* rowp = Z + (size_t)(row0 + ai * HALF + m * 16) * DIN + col0;
#pragma unroll
                for (int bj = 0; bj < 2; ++bj) { const f32x4 v0 = acc[ai][bj][m][0] * sc + bv[bj][0], v1 = acc[ai][bj][m][1] * sc + bv[bj][1];
                    u32x4 w; w.x = cvt_pk_bf16(v0[0], v0[1]); w.y = cvt_pk_bf16(v0[2], v0[3]); w.z = cvt_pk_bf16(v1[0], v1[1]); w.w = cvt_pk_bf16(v1[2], v1[3]);
                    *(u32x4*)(rowp + bj * HALF) = w; } }
    }
};
struct EpiH1 {
    static constexpr bool PERM = true;
    bf16* H1; const float* x; const float* bias; float sc;
    __device__ __forceinline__ void operator()(const f32x4 (&acc)[2][2][4][2], const Unit& u, int wr, int wc, int fr, int fq) const {
        const int row0 = u.pm * BM + wr * 64 + fr, col0 = u.pn * BM + wc * 32 + 8 * fq;
        f32x4 bv[2][2];
#pragma unroll
        for (int bj = 0; bj < 2; ++bj)
#pragma unroll
            for (int n = 0; n < 2; ++n) bv[bj][n] = *(const f32x4*)(bias + col0 + bj * HALF + 4 * n);
#pragma unroll
        for (int ai = 0; ai < 2; ++ai)
#pragma unroll
            for (int m = 0; m < 4; ++m) { const size_t ro = (size_t)(row0 + ai * HALF + m * 16) * D + col0;
#pragma unroll
                for (int bj = 0; bj < 2; ++bj) { const f32x4 v0 = *(const f32x4*)(x + ro + bj * HALF) + acc[ai][bj][m][0] * sc + bv[bj][0], v1 = *(const f32x4*)(x + ro + bj * HALF + 4) + acc[ai][bj][m][1] * sc + bv[bj][1];
                    u32x4 w; w.x = cvt_pk_bf16(v0[0], v0[1]); w.y = cvt_pk_bf16(v0[2], v0[3]); w.z = cvt_pk_bf16(v1[0], v1[1]); w.w = cvt_pk_bf16(v1[2], v1[3]);
                    *(u32x4*)(H1 + ro + bj * HALF) = w; } }
    }
};
struct EpiAct {
    static constexpr bool PERM = true;
    unsigned char* ACT; const float* bg; const float* bu;
    __device__ __forceinline__ void operator()(const f32x4 (&acc)[2][2][4][2], const Unit& u, int wr, int wc, int fr, int fq) const {
        const int row0 = u.pm * BM + wr * 64 + fr, col0 = u.pn * HALF + wc * 32 + 8 * fq;
        f32x4 gv[2], uv[2];
#pragma unroll
        for (int n = 0; n < 2; ++n) { gv[n] = *(const f32x4*)(bg + (size_t)u.e * DFF + col0 + 4 * n); uv[n] = *(const f32x4*)(bu + (size_t)u.e * DFF + col0 + 4 * n); }
#pragma unroll
        for (int ai = 0; ai < 2; ++ai)
#pragma unroll
            for (int m = 0; m < 4; ++m) { float r[8];
#pragma unroll
                for (int n = 0; n < 2; ++n)
#pragma unroll
                    for (int j = 0; j < 4; ++j) { float g = acc[ai][0][m][n][j] * (1.0f / (W_SCALE * XS_SCALE)) + gv[n][j], up = acc[ai][1][m][n][j] * (1.0f / (W_SCALE * XS_SCALE)) + uv[n][j];
                        g = fminf(g, 7.0f); up = fminf(fmaxf(up, -7.0f), 7.0f);
                        r[n * 4 + j] = ACT_SCALE * g * (1.0f / (1.0f + __expf(-1.702f * g))) * (up + 1.0f); }
                *(u32x2*)(ACT + (size_t)(row0 + ai * HALF + m * 16) * DFF + col0) = (u32x2){pk4_fp8(r[0], r[1], r[2], r[3]), pk4_fp8(r[4], r[5], r[6], r[7])}; }
    }
};
struct EpiDown {
    static constexpr bool PERM = true;
    bf16* YB; const float* bd; const int* rowpair; const float* roww;
    __device__ __forceinline__ void operator()(const f32x4 (&acc)[2][2][4][2], const Unit& u, int wr, int wc, int fr, int fq) const {
        const int row0 = u.pm * BM + wr * 64 + fr, col0 = u.pn * BM + wc * 32 + 8 * fq;
        f32x4 bv[2][2];
#pragma unroll
        for (int bj = 0; bj < 2; ++bj)
#pragma unroll
            for (int n = 0; n < 2; ++n) bv[bj][n] = *(const f32x4*)(bd + (size_t)u.e * D + col0 + bj * HALF + 4 * n);
#pragma unroll
        for (int ai = 0; ai < 2; ++ai)
#pragma unroll
            for (int m = 0; m < 4; ++m) { const int row = row0 + ai * HALF + m * 16; const int pair = rowpair[row]; const float wt = roww[row];
                if (pair >= 0) { bf16* rowp = YB + (size_t)pair * D + col0;
#pragma unroll
                    for (int bj = 0; bj < 2; ++bj) { const f32x4 v0 = (acc[ai][bj][m][0] * (1.0f / (W_SCALE * ACT_SCALE)) + bv[bj][0]) * wt, v1 = (acc[ai][bj][m][1] * (1.0f / (W_SCALE * ACT_SCALE)) + bv[bj][1]) * wt;
                        u32x4 w; w.x = cvt_pk_bf16(v0[0], v0[1]); w.y = cvt_pk_bf16(v0[2], v0[3]); w.z = cvt_pk_bf16(v1[0], v1[1]); w.w = cvt_pk_bf16(v1[2], v1[3]);
                        *(u32x4*)(rowp + bj * HALF) = w; } } }
    }
};
}


typedef float f32x16 __attribute__((ext_vector_type(16)));
constexpr int AT_KS = 144, AT_VS = 584, AT_KOFF = 0, AT_VOFF = 288 * AT_KS;
__device__ __forceinline__ float bflo(unsigned w) { return __uint_as_float(w << 16); }
__device__ __forceinline__ float bfhi(unsigned w) { return __uint_as_float(w & 0xffff0000u); }

__device__ __forceinline__ void attn_tile(LAS unsigned char* lds, int slot_base, int kind, int j, int lane, int hq,
                                          const bf16x8 (&qf)[2][4], f32x16 (&oacc)[2][2], float (&mrow)[2], float (&lrow)[2]) {
    const int r31 = lane & 31, h = lane >> 5;
    bf16x8 kf[4], vf[2][2];
#pragma unroll
    for (int ks = 0; ks < 4; ++ks) kf[ks] = *(const LAS bf16x8*)(lds + AT_KOFF + (slot_base + r31) * AT_KS + (16 * ks + 8 * h) * 2);
#pragma unroll
    for (int dt = 0; dt < 2; ++dt)
#pragma unroll
        for (int sp = 0; sp < 2; ++sp) { const LAS unsigned char* p = lds + AT_VOFF + (32 * dt + r31) * AT_VS + (slot_base + 16 * sp + 4 * h) * 2;
            const u32x2 lo = *(const LAS u32x2*)p, hi = *(const LAS u32x2*)(p + 16);
            const u32x4 w = (u32x4){lo.x, lo.y, hi.x, hi.y}; vf[dt][sp] = __builtin_bit_cast(bf16x8, w); }
#pragma unroll
    for (int qt = 0; qt < 2; ++qt) {
        f32x16 s;
#pragma unroll
        for (int r = 0; r < 16; ++r) s[r] = 0.f;
#pragma unroll
        for (int ks = 0; ks < 4; ++ks) s = __builtin_amdgcn_mfma_f32_32x32x16_bf16(kf[ks], qf[qt][ks], s, 0, 0, 0);
        const int i = 64 * hq + 32 * qt + r31;
        float mx = -1.0e30f;
#pragma unroll
        for (int r = 0; r < 16; ++r) { const int key = (r & 3) + 8 * (r >> 2) + 4 * h;
            const bool ok = kind == 0 ? (key < 16) : (kind == 1 ? (32 * j + key >= i + 1) : (32 * j + key <= i));
            s[r] = ok ? s[r] : -1.0e30f; mx = fmaxf(mx, s[r]); }
        mx = fmaxf(mx, __shfl_xor(mx, 32));
        const float mn = fmaxf(mrow[qt], mx), al = __expf(mrow[qt] - mn); mrow[qt] = mn;
        float ps = 0.f;
#pragma unroll
        for (int r = 0; r < 16; ++r) { s[r] = __expf(s[r] - mn); ps += s[r]; }
        lrow[qt] = lrow[qt] * al + ps;
#pragma unroll
        for (int dt = 0; dt < 2; ++dt)
#pragma unroll
            for (int r = 0; r < 16; ++r) oacc[qt][dt][r] *= al;
        bf16x8 pf[2];
#pragma unroll
        for (int sp = 0; sp < 2; ++sp) { const u32x4 w = (u32x4){pk2(s[8 * sp + 0], s[8 * sp + 1]), pk2(s[8 * sp + 2], s[8 * sp + 3]), pk2(s[8 * sp + 4], s[8 * sp + 5]), pk2(s[8 * sp + 6], s[8 * sp + 7])};
            pf[sp] = __builtin_bit_cast(bf16x8, w); }
#pragma unroll
        for (int dt = 0; dt < 2; ++dt)
#pragma unroll
            for (int sp = 0; sp < 2; ++sp) oacc[qt][dt] = __builtin_amdgcn_mfma_f32_32x32x16_bf16(vf[dt][sp], pf[sp], oacc[qt][dt], 0, 0, 0);
    }
}

__device__ __forceinline__ void attn_item(const Args& a, LAS unsigned char* lds, int item, int tid, int lane, int wave) {
    const int kvh = item & 3, qblk = (item >> 2) & 15, b = item >> 6;
    const bf16* Z = (const bf16*)(a.ws + WS_Z); bf16* O = (bf16*)(a.ws + (G2_FP8 ? WS_ATT : WS_O)); constexpr int OLD = G2_FP8 ? 1024 : D;
    const float* cosT = (const float*)(a.ws + WS_COS); const float* sinT = (const float*)(a.ws + WS_SIN);
    __syncthreads();
    for (int task = tid; task < 288 * 4; task += 512) {
        const int slot = task >> 2, c = task & 3;
        int krow, kpos; bool valid;
        if (slot < 32) { valid = slot < NMETA; krow = METAROW0 + slot; kpos = slot; }
        else { const int sp = 128 * (qblk - 1) + (slot - 32); valid = sp >= 0; krow = b * SEQ + sp; kpos = NMETA + sp; }
        u32x4 lo = (u32x4){0u, 0u, 0u, 0u}, hi = lo;
        if (valid) {
            const bf16* kp = Z + (size_t)krow * DIN + ZK + kvh * 64 + c * 8;
            const u32x4 x1 = *(const u32x4*)kp, x2 = *(const u32x4*)(kp + 32);
            const f32x4 c0 = *(const f32x4*)(cosT + kpos * 32 + c * 8), c1 = *(const f32x4*)(cosT + kpos * 32 + c * 8 + 4);
            const f32x4 s0 = *(const f32x4*)(sinT + kpos * 32 + c * 8), s1 = *(const f32x4*)(sinT + kpos * 32 + c * 8 + 4);
#pragma unroll
            for (int q = 0; q < 4; ++q) { const float ca = q < 2 ? c0[2 * q] : c1[2 * q - 4], cb = q < 2 ? c0[2 * q + 1] : c1[2 * q - 3], sa = q < 2 ? s0[2 * q] : s1[2 * q - 4], sb = q < 2 ? s0[2 * q + 1] : s1[2 * q - 3];
                const float a0 = bflo(x1[q]), a1 = bfhi(x1[q]), b0 = bflo(x2[q]), b1 = bfhi(x2[q]);
                lo[q] = pk2(a0 * ca - b0 * sa, a1 * cb - b1 * sb); hi[q] = pk2(b0 * ca + a0 * sa, b1 * cb + a1 * sb); }
        }
        *(LAS u32x4*)(lds + AT_KOFF + slot * AT_KS + c * 16) = lo; *(LAS u32x4*)(lds + AT_KOFF + slot * AT_KS + 64 + c * 16) = hi;
    }
    for (int task = tid; task < 144 * 8; task += 512) {
        const int slot0 = (task >> 3) * 2, c = task & 7;
        int vrow; bool valid;
        if (slot0 < 32) { valid = slot0 < NMETA; vrow = METAROW0 + slot0; }
        else { const int sp = 128 * (qblk - 1) + (slot0 - 32); valid = sp >= 0; vrow = b * SEQ + sp; }
        u32x4 v0 = (u32x4){0u, 0u, 0u, 0u}, v1 = v0;
        if (valid) { const bf16* vp = Z + (size_t)vrow * DIN + ZV + kvh * 64 + c * 8; v0 = *(const u32x4*)vp; v1 = *(const u32x4*)(vp + DIN); }
#pragma unroll
        for (int q = 0; q < 4; ++q) {
            *(LAS unsigned*)(lds + AT_VOFF + (c * 8 + 2 * q) * AT_VS + slot0 * 2) = (v0[q] & 0xffffu) | (v1[q] << 16);
            *(LAS unsigned*)(lds + AT_VOFF + (c * 8 + 2 * q + 1) * AT_VS + slot0 * 2) = (v0[q] >> 16) | (v1[q] & 0xffff0000u); }
    }
    const int g = wave >> 1, hq = wave & 1, head = kvh * 4 + g, r31 = lane & 31, h = lane >> 5;
    bf16x8 qf[2][4];
#pragma unroll
    for (int qt = 0; qt < 2; ++qt) {
        const int s = 128 * qblk + 64 * hq + 32 * qt + r31, pos = NMETA + s;
        const bf16* qp = Z + (size_t)(b * SEQ + s) * DIN + ZQ + head * 64 + 8 * h;
        u32x4 x[4];
#pragma unroll
        for (int ks = 0; ks < 4; ++ks) x[ks] = *(const u32x4*)(qp + 16 * ks);
#pragma unroll
        for (int ks = 0; ks < 2; ++ks) {
            const float* cp = cosT + pos * 32 + 16 * ks + 8 * h; const float* sp = sinT + pos * 32 + 16 * ks + 8 * h;
            const f32x4 c0 = *(const f32x4*)cp, c1 = *(const f32x4*)(cp + 4), s0 = *(const f32x4*)sp, s1 = *(const f32x4*)(sp + 4);
            u32x4 lo, hi;
#pragma unroll
            for (int q = 0; q < 4; ++q) { const float ca = q < 2 ? c0[2 * q] : c1[2 * q - 4], cb = q < 2 ? c0[2 * q + 1] : c1[2 * q - 3], sa = q < 2 ? s0[2 * q] : s1[2 * q - 4], sb = q < 2 ? s0[2 * q + 1] : s1[2 * q - 3];
                const float a0 = bflo(x[ks][q]), a1 = bfhi(x[ks][q]), b0 = bflo(x[ks + 2][q]), b1 = bfhi(x[ks + 2][q]);
                lo[q] = pk2(0.125f * (a0 * ca - b0 * sa), 0.125f * (a1 * cb - b1 * sb)); hi[q] = pk2(0.125f * (b0 * ca + a0 * sa), 0.125f * (b1 * cb + a1 * sb)); }
            qf[qt][ks] = __builtin_bit_cast(bf16x8, lo); qf[qt][ks + 2] = __builtin_bit_cast(bf16x8, hi);
        }
    }
    f32x16 oacc[2][2]; float mrow[2], lrow[2];
#pragma unroll
    for (int qt = 0; qt < 2; ++qt) { mrow[qt] = a.in[I_SINKS][head]; lrow[qt] = h == 0 ? 1.0f : 0.0f;
#pragma unroll
        for (int dt = 0; dt < 2; ++dt)
#pragma unroll
            for (int r = 0; r < 16; ++r) oacc[qt][dt][r] = 0.f; }
    __syncthreads();
    attn_tile(lds, 0, 0, 0, lane, hq, qf, oacc, mrow, lrow);
    if (qblk > 0) {
#pragma unroll 1
        for (int j = hq ? 2 : 0; j < 4; ++j) attn_tile(lds, 32 + 32 * j, 1, j, lane, hq, qf, oacc, mrow, lrow);
    }
#pragma unroll 1
    for (int j = 0; j < (hq ? 4 : 2); ++j) attn_tile(lds, 160 + 32 * j, 2, j, lane, hq, qf, oacc, mrow, lrow);
#pragma unroll
    for (int qt = 0; qt < 2; ++qt) {
        const float lt = lrow[qt] + __shfl_xor(lrow[qt], 32), inv = 1.0f / lt;
        bf16* op = O + (size_t)(b * SEQ + 128 * qblk + 64 * hq + 32 * qt + r31) * OLD + head * 64 + 4 * h;
#pragma unroll
        for (int dt = 0; dt < 2; ++dt)
#pragma unroll
            for (int rr = 0; rr < 4; ++rr)
                *(u32x2*)(op + 32 * dt + 8 * rr) = (u32x2){pk2(oacc[qt][dt][4 * rr] * inv, oacc[qt][dt][4 * rr + 1] * inv), pk2(oacc[qt][dt][4 * rr + 2] * inv, oacc[qt][dt][4 * rr + 3] * inv)};
    }
}

constexpr int LR_XS = 2064;
__device__ __forceinline__ void lru_norm_rows(const Args& a, LAS unsigned char* lds, int b, int c, int lane, int wave) {
        bf16* O = (bf16*)(a.ws + WS_O); unsigned char* O8 = a.ws + WS_O;
        const bf16* ATT = (const bf16*)(a.ws + (G2_FP8 ? WS_ATT : WS_O)); constexpr int ALD = G2_FP8 ? 1024 : D;
        u32x4 aw[4][2];
#pragma unroll
        for (int q = 0; q < 4; ++q)
#pragma unroll
            for (int jj = 0; jj < 2; ++jj) aw[q][jj] = *(const u32x4*)(ATT + ((size_t)b * SEQ + 32 * c + 4 * wave + q) * ALD + (lane + 64 * jj) * 8);
        f32x4 ga[2][2], gl[2][2];
#pragma unroll
        for (int jj = 0; jj < 2; ++jj) { ga[jj][0] = *(const f32x4*)(a.in[I_G_ATTN] + (lane + 64 * jj) * 8); ga[jj][1] = *(const f32x4*)(a.in[I_G_ATTN] + (lane + 64 * jj) * 8 + 4);
            gl[jj][0] = *(const f32x4*)(a.in[I_G_LRU] + (lane + 64 * jj) * 8); gl[jj][1] = *(const f32x4*)(a.in[I_G_LRU] + (lane + 64 * jj) * 8 + 4); }
        __syncthreads();
#pragma unroll
        for (int q = 0; q < 4; ++q) {
            const int tl = 4 * wave + q; const size_t row = (size_t)b * SEQ + 32 * c + tl;
#pragma unroll
            for (int half = 0; half < 2; ++half) {
                u32x4 w[2]; float v[16]; float ss = 0.f;
#pragma unroll
                for (int jj = 0; jj < 2; ++jj) { w[jj] = half == 0 ? *(const LAS u32x4*)(lds + tl * LR_XS + (lane + 64 * jj) * 16) : aw[q][jj];
#pragma unroll
                    for (int k = 0; k < 4; ++k) { v[jj * 8 + 2 * k] = bflo(w[jj][k]); v[jj * 8 + 2 * k + 1] = bfhi(w[jj][k]); } }
#pragma unroll
                for (int k = 0; k < 16; ++k) ss += v[k] * v[k];
                ss = wave_sum(ss);
                const float rstd = (G2_FP8 ? XS_SCALE : 1.0f) * __builtin_amdgcn_rsqf(ss * (1.0f / 1024.0f) + EPS);
#pragma unroll
                for (int jj = 0; jj < 2; ++jj) { const f32x4 g0 = half == 0 ? gl[jj][0] : ga[jj][0], g1 = half == 0 ? gl[jj][1] : ga[jj][1];
                    const size_t col = (half == 0 ? 1024 : 0) + (lane + 64 * jj) * 8;
                    if (G2_FP8) *(u32x2*)(O8 + row * D + col) = (u32x2){pk4_fp8(v[jj * 8 + 0] * rstd * g0.x, v[jj * 8 + 1] * rstd * g0.y, v[jj * 8 + 2] * rstd * g0.z, v[jj * 8 + 3] * rstd * g0.w),
                                                                       pk4_fp8(v[jj * 8 + 4] * rstd * g1.x, v[jj * 8 + 5] * rstd * g1.y, v[jj * 8 + 6] * rstd * g1.z, v[jj * 8 + 7] * rstd * g1.w)};
                    else *(u32x4*)(O + row * D + col) = (u32x4){pk2(v[jj * 8 + 0] * rstd * g0.x, v[jj * 8 + 1] * rstd * g0.y), pk2(v[jj * 8 + 2] * rstd * g0.z, v[jj * 8 + 3] * rstd * g0.w),
                                                                pk2(v[jj * 8 + 4] * rstd * g1.x, v[jj * 8 + 5] * rstd * g1.y), pk2(v[jj * 8 + 6] * rstd * g1.z, v[jj * 8 + 7] * rstd * g1.w)}; }
            }
        }
}
template <int PASS>
__device__ __forceinline__ void lru_item(const Args& a, LAS unsigned char* lds, int item, int tid, int lane, int wave) {
    const int b = item / 65, c = item % 65; const bool meta = (c == 64);
    const bf16* Z = (const bf16*)(a.ws + WS_Z);
    float* sumA = (float*)(a.ws + WS_LRUSUM); float* sumB = sumA + NBATCH * 64 * DLRU; float* metaB = sumB + NBATCH * 64 * DLRU;
    __syncthreads();
    {
        const int ch0 = (tid & 127) * 8, tq = tid >> 7;
        f32x4 cw[4][2], cb[2];
#pragma unroll
        for (int jj = 0; jj < 4; ++jj) { cw[jj][0] = *(const f32x4*)(a.in[I_CONV_W] + jj * DLRU + ch0); cw[jj][1] = *(const f32x4*)(a.in[I_CONV_W] + jj * DLRU + ch0 + 4); }
        cb[0] = *(const f32x4*)(a.in[I_CONV_B] + ch0); cb[1] = *(const f32x4*)(a.in[I_CONV_B] + ch0 + 4);
#pragma unroll 1
        for (int i0 = 0; i0 < 8; i0 += 4) {
            u32x4 x[4][4];
#pragma unroll
            for (int i = 0; i < 4; ++i) { const int tl = tq + 4 * (i0 + i); const int t = meta ? tl : NMETA + 32 * c + tl;
#pragma unroll
                for (int jj = 0; jj < 4; ++jj) { const int tt = t - 3 + jj; x[i][jj] = (u32x4){0u, 0u, 0u, 0u};
                    if (tt >= 0 && !(meta && tl >= NMETA)) x[i][jj] = *(const u32x4*)(Z + (size_t)tok_row(b, tt) * DIN + ZX + ch0); } }
#pragma unroll
            for (int i = 0; i < 4; ++i) { const int tl = tq + 4 * (i0 + i); const int t = meta ? tl : NMETA + 32 * c + tl;
                f32x4 a0 = cb[0], a1 = cb[1];
#pragma unroll
                for (int jj = 0; jj < 4; ++jj) { const u32x4 xx = x[i][jj];
                    if (t - 3 + jj >= 0) {
                        a0.x += cw[jj][0].x * bflo(xx[0]); a0.y += cw[jj][0].y * bfhi(xx[0]); a0.z += cw[jj][0].z * bflo(xx[1]); a0.w += cw[jj][0].w * bfhi(xx[1]);
                        a1.x += cw[jj][1].x * bflo(xx[2]); a1.y += cw[jj][1].y * bfhi(xx[2]); a1.z += cw[jj][1].z * bflo(xx[3]); a1.w += cw[jj][1].w * bfhi(xx[3]); } }
                u32x4 o = (u32x4){pk2(a0.x, a0.y), pk2(a0.z, a0.w), pk2(a1.x, a1.y), pk2(a1.z, a1.w)};
                if (meta && tl >= NMETA) o = (u32x4){0u, 0u, 0u, 0u};
                *(LAS u32x4*)(lds + tl * LR_XS + ch0 * 2) = o; }
        }
    }
    LAS float* hinL = (LAS float*)(lds + 32 * LR_XS);
    if (PASS == 1) {
        float h0 = metaB[tid], h1 = metaB[tid + 512];
        const float* pa = sumA + (size_t)b * 64 * DLRU + tid; const float* pb = sumB + (size_t)b * 64 * DLRU + tid;
#pragma unroll 8
        for (int jc = 0; jc < c; ++jc) { h0 = pa[jc * DLRU] * h0 + pb[jc * DLRU]; h1 = pa[jc * DLRU + 512] * h1 + pb[jc * DLRU + 512]; }
        hinL[tid] = h0; hinL[tid + 512] = h1;
    }
    __syncthreads();
    const bf16* WaT = (const bf16*)(a.ws + WS_WAT); const bf16* WiT = (const bf16*)(a.ws + WS_WIT);
    const int r31 = lane & 31, h = lane >> 5;
    const int tau = 16 * ((r31 >> 2) & 1) + 4 * (r31 >> 3) + (r31 & 3);
#pragma unroll 1
    for (int nb = 0; nb < 2; ++nb) {
        const int n = 2 * wave + nb;
        bf16x8 af[4];
#pragma unroll
        for (int ks = 0; ks < 4; ++ks) af[ks] = *(const LAS bf16x8*)(lds + tau * LR_XS + (64 * n + 16 * ks + 8 * h) * 2);
#pragma unroll 1
        for (int nt = 0; nt < 2; ++nt) {
            const int ch = 64 * n + 32 * nt + r31;
            f32x16 accR, accI;
#pragma unroll
            for (int r = 0; r < 16; ++r) { accR[r] = 0.f; accI[r] = 0.f; }
#pragma unroll
            for (int ks = 0; ks < 4; ++ks) {
                const bf16x8 wa = *(const bf16x8*)(WaT + ((size_t)(n * 64 + 32 * nt + r31) * 64 + 16 * ks + 8 * h));
                const bf16x8 wi = *(const bf16x8*)(WiT + ((size_t)(n * 64 + 32 * nt + r31) * 64 + 16 * ks + 8 * h));
                accR = __builtin_amdgcn_mfma_f32_32x32x16_bf16(af[ks], wa, accR, 0, 0, 0);
                accI = __builtin_amdgcn_mfma_f32_32x32x16_bf16(af[ks], wi, accI, 0, 0, 0);
            }
            const float ba = a.in[I_B_A][ch], bi = a.in[I_B_I][ch], sp8 = -8.0f * 1.4426950408889634f * log1pf(__expf(-a.in[I_LAMBDA][ch]));
            float av[16], bv[16];
            float Ap = 1.0f, Bp = 0.0f;
#pragma unroll
            for (int r = 0; r < 16; ++r) {
                const float xcv = bf2f(*(const LAS unsigned short*)(lds + (16 * h + r) * LR_XS + ch * 2));
                const float rg = fast_sigmoid(accR[r] + ba), ig = fast_sigmoid(accI[r] + bi);
                const float l2a = sp8 * rg;
                av[r] = __builtin_amdgcn_exp2f(l2a); bv[r] = __builtin_amdgcn_sqrtf(fmaxf(fmaf(-av[r], av[r], 1.0f), 0.0f)) * ig * xcv;
                Ap *= av[r]; Bp = av[r] * Bp + bv[r];
                if (PASS == 0 && !meta) ((unsigned*)(a.ws + WS_AB))[((size_t)b * SEQ + 32 * c + 16 * h + r) * DLRU + ch] = pk2(l2a, bv[r]);
            }
            const float Ao = __shfl_xor(Ap, 32), Bo = __shfl_xor(Bp, 32);
            if (PASS == 0) {
                if (h == 0) {
                    if (meta) metaB[ch] = Bp;
                    else { sumA[((size_t)b * 64 + c) * DLRU + ch] = Ap * Ao; sumB[((size_t)b * 64 + c) * DLRU + ch] = Ao * Bp + Bo; }
                }
            } else {
                const float hin = hinL[ch];
                float hs = h == 0 ? hin : (Ao * hin + Bo);
#pragma unroll
                for (int r = 0; r < 16; ++r) {
                    hs = av[r] * hs + bv[r];
                    const int tl = 16 * h + r;
                    const float gt = bf2f(Z[(size_t)(b * SEQ + 32 * c + tl) * DIN + ZG + ch]);
                    *(LAS unsigned short*)(lds + tl * LR_XS + ch * 2) = (unsigned short)f2bf(hs * fast_gelu_tanh(gt));
                }
            }
        }
    }
}

__device__ __forceinline__ void lru_item_b(const Args& a, LAS unsigned char* lds, int item, int tid, int lane, int wave) {
    const int b = item >> 6, c = item & 63;
    const bf16* Z = (const bf16*)(a.ws + WS_Z); const unsigned* AB = (const unsigned*)(a.ws + WS_AB);
    const float* sumA = (const float*)(a.ws + WS_LRUSUM); const float* sumB = sumA + NBATCH * 64 * DLRU; const float* metaB = sumB + NBATCH * 64 * DLRU;
    const size_t row0 = (size_t)b * SEQ + 32 * c;
    u32x2 ab[32]; unsigned gt[32];
#pragma unroll
    for (int tl = 0; tl < 32; ++tl) { ab[tl] = *(const u32x2*)(AB + (row0 + tl) * DLRU + 2 * tid); gt[tl] = *(const unsigned*)(Z + (row0 + tl) * DIN + ZG + 2 * tid); }
    float h0, h1; { const f32x2 m = *(const f32x2*)(metaB + 2 * tid); h0 = m.x; h1 = m.y; }
    { const float* pa = sumA + (size_t)b * 64 * DLRU + 2 * tid; const float* pb = sumB + (size_t)b * 64 * DLRU + 2 * tid;
#pragma unroll 8
      for (int jc = 0; jc < c; ++jc) { const f32x2 A2 = *(const f32x2*)(pa + jc * DLRU), B2 = *(const f32x2*)(pb + jc * DLRU); h0 = A2.x * h0 + B2.x; h1 = A2.y * h1 + B2.y; } }
    __syncthreads();
#pragma unroll
    for (int tl = 0; tl < 32; ++tl) {
        h0 = __builtin_amdgcn_exp2f(bflo(ab[tl].x)) * h0 + bfhi(ab[tl].x);
        h1 = __builtin_amdgcn_exp2f(bflo(ab[tl].y)) * h1 + bfhi(ab[tl].y);
        *(LAS unsigned*)(lds + tl * LR_XS + 4 * tid) = pk2(h0 * fast_gelu_tanh(bflo(gt[tl])), h1 * fast_gelu_tanh(bfhi(gt[tl])));
    }
    lru_norm_rows(a, lds, b, c, lane, wave);
}

__device__ __forceinline__ void phase_router_mfma(const Args& a, LAS unsigned char* lds, int tid, int lane, int wave) {
    const bf16* H1 = (const bf16*)(a.ws + WS_H1); const bf16* WRT = (const bf16*)(a.ws + WS_WRT);
    int* tope = (int*)(a.ws + WS_TOPE); float* topw = (float*)(a.ws + WS_TOPW); float* rstd2 = (float*)(a.ws + WS_RSTD2);
    unsigned* counts = (unsigned*)(a.ws + WS_CTL) + CW_COUNTS;
    LAS float* lg = (LAS float*)(lds + wave * 2048);
    LAS int* hist = (LAS int*)(lds + 32768);
    if (tid < 32) hist[tid] = 0;
    __syncthreads();
    const int fr = lane & 15, fq = lane >> 4;
    for (int grp = wave * gridDim.x + blockIdx.x; grp < MREAL / 16; grp += 8 * gridDim.x) {
        const int row0 = grp * 16;
        const bf16* hp = H1 + (size_t)(row0 + fr) * D + 8 * fq;
        const bf16* wp = WRT + (size_t)fr * D + 8 * fq;
        f32x4 acc0 = (f32x4){0.f, 0.f, 0.f, 0.f}, acc1 = acc0; float ss = 0.f;
#pragma unroll 4
        for (int kk = 0; kk < 64; ++kk) {
            const u32x4 w = *(const u32x4*)(hp + 32 * kk);
#pragma unroll
            for (int q = 0; q < 4; ++q) { const float lo = bflo(w[q]), hi = bfhi(w[q]); ss += lo * lo + hi * hi; }
            const bf16x8 af = __builtin_bit_cast(bf16x8, w);
            const bf16x8 b0 = *(const bf16x8*)(wp + 32 * kk), b1 = *(const bf16x8*)(wp + (size_t)16 * D + 32 * kk);
            acc0 = __builtin_amdgcn_mfma_f32_16x16x32_bf16(af, b0, acc0, 0, 0, 0);
            acc1 = __builtin_amdgcn_mfma_f32_16x16x32_bf16(af, b1, acc1, 0, 0, 0);
        }
        ss += __shfl_xor(ss, 16); ss += __shfl_xor(ss, 32);
        const float rstd = 1.0f / sqrtf(ss * (1.0f / D) + EPS);
        if (fq == 0) rstd2[row0 + fr] = rstd;
        const float br0 = a.in[I_B_ROUTER][fr], br1 = a.in[I_B_ROUTER][16 + fr];
#pragma unroll
        for (int j = 0; j < 4; ++j) { const int row = 4 * fq + j; const float rs = __shfl(rstd, row);
            lg[row * 32 + fr] = acc0[j] * rs + br0; lg[row * 32 + 16 + fr] = acc1[j] * rs + br1; }
        asm volatile("s_waitcnt lgkmcnt(0)" ::: "memory");
        if (lane < 16) {
            float v[32];
#pragma unroll
            for (int q = 0; q < 8; ++q) { const f32x4 t = *(const LAS f32x4*)(lg + lane * 32 + 4 * q); v[4 * q] = t.x; v[4 * q + 1] = t.y; v[4 * q + 2] = t.z; v[4 * q + 3] = t.w; }
            float tv[4]; int te[4];
#pragma unroll
            for (int r = 0; r < 4; ++r) { float best = -3.0e38f; int bi = 0;
#pragma unroll
                for (int e = 0; e < 32; ++e) { const bool gtb = v[e] > best; best = gtb ? v[e] : best; bi = gtb ? e : bi; }
#pragma unroll
                for (int e = 0; e < 32; ++e) v[e] = (e == bi) ? -3.0e38f : v[e];
                tv[r] = best; te[r] = bi; }
            const float e1 = __expf(tv[1] - tv[0]), e2 = __expf(tv[2] - tv[0]), e3 = __expf(tv[3] - tv[0]);
            const float inv = 1.0f / (1.0f + e1 + e2 + e3);
            const int row = row0 + lane;
            *(int4*)(tope + row * 4) = make_int4(te[0], te[1], te[2], te[3]);
            *(f32x4*)(topw + row * 4) = (f32x4){inv, e1 * inv, e2 * inv, e3 * inv};
#pragma unroll
            for (int r = 0; r < 4; ++r) atomicAdd((int*)&hist[te[r]], 1);
        }
        asm volatile("s_waitcnt lgkmcnt(0)" ::: "memory");
    }
    __syncthreads();
    if (tid < 32 && hist[tid] != 0) atomicAdd(&counts[tid], (unsigned)hist[tid]);
}

__device__ __forceinline__ void build_tile_table(const Args& a, LAS int* tstart, int tid) {
    if (tid == 0) {
        const unsigned* counts = (const unsigned*)(a.ws + WS_CTL) + CW_COUNTS;
        int acc = 0;
        for (int e = 0; e < NEXP; ++e) { tstart[e] = acc; acc += (int)((__hip_atomic_load(counts + e, __ATOMIC_RELAXED, __HIP_MEMORY_SCOPE_AGENT) + 255u) >> 8); }
        tstart[NEXP] = acc;
    }
    __syncthreads();
}
__device__ __forceinline__ int tile_expert(const LAS int* tstart, int tile) {
    int e = 0;
#pragma unroll 1
    for (int i = 1; i < NEXP; ++i) e += (tstart[i] <= tile) ? 1 : 0;
    return e;
}

__device__ __forceinline__ void phase_assign(const Args& a, LAS unsigned char* lds, int tid, int lane, int wave) {
    LAS int* tstart = (LAS int*)(lds + LDS_TAB);
    LAS int* hist = tstart + 64; LAS int* base = hist + 32; LAS int* spos = base + 32;
    build_tile_table(a, tstart, tid);
    const int* tope = (const int*)(a.ws + WS_TOPE); const float* topw = (const float*)(a.ws + WS_TOPW); const float* rstd2 = (const float*)(a.ws + WS_RSTD2);
    int* rowpair = (int*)(a.ws + WS_ROWPAIR); float* roww = (float*)(a.ws + WS_ROWW);
    unsigned* cursor = (unsigned*)(a.ws + WS_CTL) + CW_CURSOR;
    const bf16* H1 = (const bf16*)(a.ws + WS_H1); unsigned char* XS = (unsigned char*)(a.ws + WS_XS);
    for (int blk = blockIdx.x; blk < MREAL / 64; blk += gridDim.x) {
        if (tid < 32) hist[tid] = 0;
        __syncthreads();
        int e = 0, rank = 0, pair = 0;
        if (tid < 256) { pair = blk * 256 + tid; e = tope[pair]; rank = atomicAdd((int*)&hist[e], 1); }
        __syncthreads();
        if (tid < 32) base[tid] = (int)atomicAdd(&cursor[tid], (unsigned)hist[tid]);
        __syncthreads();
        if (tid < 256) { const int pos = tstart[e] * 256 + base[e] + rank; spos[tid] = pos; rowpair[pos] = pair; roww[pos] = topw[pair]; }
        __syncthreads();
        for (int tt = wave * 8; tt < wave * 8 + 8; ++tt) {
            const int token = blk * 64 + tt; const float rstd = rstd2[token] * XS_SCALE;
            const u32x4* hr = (const u32x4*)(H1 + (size_t)token * D);
            u32x2 o[4];
#pragma unroll
            for (int j = 0; j < 4; ++j) { const u32x4 hv = hr[lane + 64 * j];
                const f32x4 g0 = ((const f32x4*)a.in[I_NORM_FFN])[2 * (lane + 64 * j)], g1 = ((const f32x4*)a.in[I_NORM_FFN])[2 * (lane + 64 * j) + 1];
                o[j] = (u32x2){pk4_fp8(bflo(hv[0]) * rstd * g0.x, bfhi(hv[0]) * rstd * g0.y, bflo(hv[1]) * rstd * g0.z, bfhi(hv[1]) * rstd * g0.w),
                               pk4_fp8(bflo(hv[2]) * rstd * g1.x, bfhi(hv[2]) * rstd * g1.y, bflo(hv[3]) * rstd * g1.z, bfhi(hv[3]) * rstd * g1.w)}; }
#pragma unroll
            for (int k = 0; k < 4; ++k) { u32x2* dst = (u32x2*)(XS + (size_t)spos[tt * 4 + k] * D);
#pragma unroll
                for (int j = 0; j < 4; ++j) dst[lane + 64 * j] = o[j]; }
        }
        __syncthreads();
    }
}

__device__ __forceinline__ void phase_final(const Args& a, int lane, int wave) {
    const int gw = blockIdx.x * 8 + wave, NGW = gridDim.x * 8;
    const bf16* H1 = (const bf16*)(a.ws + WS_H1); const bf16* YB = (const bf16*)(a.ws + WS_YB);
    for (int row = gw; row < MREAL; row += NGW) {
        f32x4 v[8]; float ss = 0.f;
#pragma unroll
        for (int j = 0; j < 8; ++j) { { const u32x2 hh = ((const u32x2*)(H1 + (size_t)row * D))[lane + 64 * j]; v[j] = (f32x4){bflo(hh.x), bfhi(hh.x), bflo(hh.y), bfhi(hh.y)}; }
#pragma unroll
            for (int k = 0; k < 4; ++k) { const u32x2 y = ((const u32x2*)(YB + ((size_t)row * 4 + k) * D))[lane + 64 * j];
                v[j].x += bf2f(y.x); v[j].y += bf2f(y.x >> 16); v[j].z += bf2f(y.y); v[j].w += bf2f(y.y >> 16); }
            ss += (v[j].x * v[j].x + v[j].y * v[j].y) + (v[j].z * v[j].z + v[j].w * v[j].w); }
        ss = wave_sum(ss);
        const float rstd = 1.0f / sqrtf(ss * (1.0f / D) + EPS);
        f32x4* op = (f32x4*)(a.out + (size_t)row * D);
#pragma unroll
        for (int j = 0; j < 8; ++j) { const f32x4 g = ((const f32x4*)a.in[I_FINAL_NORM])[lane + 64 * j]; op[lane + 64 * j] = v[j] * rstd * g; }
    }
}

enum { PH_PROLOGUE = 0, PH_G1, PH_ATTN, PH_LRU_B, PH_G2, PH_ROUTER, PH_ASSIGN, PH_G3, PH_G4, PH_FINAL, PH_COUNT };

__global__ void __launch_bounds__(512, 2) fwd(Args a) {
    extern __shared__ __attribute__((aligned(16))) unsigned char lds_raw[];
    LAS unsigned char* lds = (LAS unsigned char*)lds_raw;
    const int tid = threadIdx.x, lane = tid & 63, wave = __builtin_amdgcn_readfirstlane(tid >> 6);
    const int gw = blockIdx.x * 8 + wave, NGW = gridDim.x * 8;
    unsigned char* ws = a.ws;
#define IN(k) (a.ph_lo <= (k) && (k) < a.ph_hi)
    pg8::BGNone nobg;
    pg8::BGConv bgup{(const char*)a.in[I_W_UP], ws + WS_WUT, (int)blockIdx.x * 128, (int)blockIdx.x * 128 + 80, ws + WS_DUMMY};
#define SEAM(k) do { if (IN(k) && IN((k) + 1)) xcd_barrier(bar); } while (0)
    if (tid < 4) ((LAS unsigned*)(lds + LDS_MISC))[tid] = 0u;
    __syncthreads();
    XcdBarrier bar; bar.bar = (unsigned*)(ws + WS_CTL) + CW_BAR; bar.x = 0; bar.st = nullptr;
    if (a.ph_hi - a.ph_lo > 1) bar = xcd_barrier_post((unsigned*)(ws + WS_CTL) + CW_BAR, (volatile LAS unsigned*)(lds + LDS_MISC));

    if (IN(PH_PROLOGUE)) { phase_prologue(a, lds, tid, lane, wave);
#if PROBE_REPEAT == 0
        __syncthreads(); phase_prologue(a, lds, tid, lane, wave);
#endif
    }
    SEAM(PH_PROLOGUE);

    if (IN(PH_G1)) {
        pg8::SchedDense S{(const char*)(ws + WS_N1), (const char*)(ws + WS_WINT), MROWS / 256, DIN / 256, (int)gridDim.x, (int)blockIdx.x, G1_FP8 ? 2048 : 4096};
        pg8::EpiZ E{(bf16*)(ws + WS_Z), a.in[I_B_IN], G1_FP8 ? 1.0f / (W_SCALE * XS_SCALE) : 1.0f};
#if BG_WUP
        pg8::gemm_phase<G1_FP8 != 0>(lds, S, E, bgup);
#else
        pg8::gemm_phase<G1_FP8 != 0>(lds, S, E, nobg);
#endif
#if PROBE_REPEAT == 1
        __syncthreads(); pg8::gemm_phase<G1_FP8 != 0>(lds, S, E, nobg);
#endif
    }
    SEAM(PH_G1);
    if (IN(PH_ATTN)) {
        for (int it = blockIdx.x; it < NBATCH * 16 * 4; it += gridDim.x) attn_item(a, lds, it, tid, lane, wave);
        for (int it = blockIdx.x; it < NBATCH * 65; it += gridDim.x) { if (it % 65 == 64 && it != 64) continue; lru_item<0>(a, lds, it, tid, lane, wave); }
#if PROBE_REPEAT == 2
        for (int it = blockIdx.x; it < NBATCH * 16 * 4; it += gridDim.x) attn_item(a, lds, it, tid, lane, wave);
#endif
#if PROBE_REPEAT == 3
        for (int it = blockIdx.x; it < NBATCH * 65; it += gridDim.x) { if (it % 65 == 64 && it != 64) continue; lru_item<0>(a, lds, it, tid, lane, wave); }
#endif
    }
    SEAM(PH_ATTN);
    if (IN(PH_LRU_B)) {
        for (int it = blockIdx.x; it < NBATCH * 64; it += gridDim.x) lru_item_b(a, lds, it, tid, lane, wave);
    }
    SEAM(PH_LRU_B);
    if (IN(PH_G2)) {
        pg8::SchedDense S{(const char*)(ws + WS_O), (const char*)(ws + WS_WOUTT), MREAL / 256, D / 256, (int)gridDim.x, (int)blockIdx.x, G2_FP8 ? 2048 : 4096};
        pg8::EpiH1 E{(bf16*)(ws + WS_H1), a.in[I_X], a.in[I_B_OUT], G2_FP8 ? 1.0f / (W_SCALE * XS_SCALE) : 1.0f};
#if BG_WUP
        pg8::gemm_phase<G2_FP8 != 0>(lds, S, E, bgup);
        for (int pair = bgup.next < bgup.end ? bgup.next : bgup.end; pair < bgup.end; ++pair) { const char* sp; unsigned char* dp; pg8::bg_pair_ptrs(bgup, pair, sp, dp);
            const int n = tid >> 4, c = tid & 15; const float* p = (const float*)sp + (size_t)(8 * c) * 2048 + n;
            *(u32x2*)(dp + (size_t)n * 2048 + 8 * c) = (u32x2){pk4_fp8(p[0] * W_SCALE, p[2048] * W_SCALE, p[4096] * W_SCALE, p[6144] * W_SCALE), pk4_fp8(p[8192] * W_SCALE, p[10240] * W_SCALE, p[12288] * W_SCALE, p[14336] * W_SCALE)}; }
#else
        pg8::gemm_phase<G2_FP8 != 0>(lds, S, E, nobg);
#endif
#if PROBE_REPEAT == 4
        __syncthreads(); pg8::gemm_phase<G2_FP8 != 0>(lds, S, E, nobg);
#endif
    }
    SEAM(PH_G2);
    if (IN(PH_ROUTER)) phase_router_mfma(a, lds, tid, lane, wave);
    SEAM(PH_ROUTER);
    if (IN(PH_ASSIGN)) phase_assign(a, lds, tid, lane, wave);
    SEAM(PH_ASSIGN);
    if (IN(PH_G3)) {
        LAS int* tstart = (LAS int*)(lds + LDS_TAB);
        build_tile_table(a, tstart, tid);
        pg8::SchedMoE S{(const char*)(ws + WS_XS), (const char*)(ws + WS_WGT), (const char*)(ws + WS_WUT), tstart, tstart[NEXP], DFF / 128, (int)gridDim.x, (int)blockIdx.x, true};
        pg8::EpiAct E{(unsigned char*)(ws + WS_ACT), a.in[I_B_GATE], a.in[I_B_UP]};
#if BG_WDOWN
        pg8::BGConv bg{(const char*)a.in[I_W_DOWN], ws + WS_WDT, (int)blockIdx.x * (32768 / 256), ((int)blockIdx.x + 1) * (32768 / 256), ws + WS_DUMMY};
        if (gridDim.x != 256) { bg.next = (int)((long)blockIdx.x * 32768 / gridDim.x); bg.end = (int)((long)(blockIdx.x + 1) * 32768 / gridDim.x); }
        pg8::gemm_phase<true>(lds, S, E, bg);
        for (int pair = bg.next < bg.end ? bg.next : bg.end; pair < bg.end; ++pair) { const char* sp; unsigned char* dp; pg8::bg_pair_ptrs(bg, pair, sp, dp);
            const int n = tid >> 4, c = tid & 15;
            const float* p = (const float*)sp + (size_t)(8 * c) * 2048 + n;
            *(u32x2*)(dp + (size_t)n * 2048 + 8 * c) = (u32x2){pk4_fp8(p[0] * W_SCALE, p[2048] * W_SCALE, p[4096] * W_SCALE, p[6144] * W_SCALE), pk4_fp8(p[8192] * W_SCALE, p[10240] * W_SCALE, p[12288] * W_SCALE, p[14336] * W_SCALE)}; }
#else
        pg8::gemm_phase<true>(lds, S, E, nobg);
#endif
#if PROBE_REPEAT == 7
        __syncthreads(); pg8::gemm_phase<true>(lds, S, E, nobg);
#endif
    }
    SEAM(PH_G3);
    if (IN(PH_G4)) {
        LAS int* tstart = (LAS int*)(lds + LDS_TAB);
        build_tile_table(a, tstart, tid);
        pg8::SchedMoE S{(const char*)(ws + WS_ACT), (const char*)(ws + WS_WDT), (const char*)(ws + WS_WDT), tstart, tstart[NEXP], D / 256, (int)gridDim.x, (int)blockIdx.x, false};
        pg8::EpiDown E{(bf16*)(ws + WS_YB), a.in[I_B_DOWN], (const int*)(ws + WS_ROWPAIR), (const float*)(ws + WS_ROWW)};
        pg8::gemm_phase<true>(lds, S, E, nobg);
#if PROBE_REPEAT == 8
        __syncthreads(); pg8::gemm_phase<true>(lds, S, E, nobg);
#endif
    }
    SEAM(PH_G4);
    if (IN(PH_FINAL)) { phase_final(a, lane, wave);
#if PROBE_REPEAT == 9
        phase_final(a, lane, wave);
#endif
    }
#undef IN
#undef SEAM
}

extern "C" void kernel_launch(void* const* d_in, const int* in_sizes, int n_in, void* d_out, int out_size, void* d_ws, size_t ws_size, hipStream_t stream) {
    static int grid = 0;
    if (grid == 0) {
        if (n_in != 27 || out_size != MREAL * D || ws_size < WS_END) { fprintf(stderr, "kernel_launch: unexpected problem (n_in %d, out %d, ws %zu)\n", n_in, out_size, ws_size); grid = -1; return; }
        int dev = 0, cus = 0;
        if (hipGetDevice(&dev) != hipSuccess || hipDeviceGetAttribute(&cus, hipDeviceAttributeMultiprocessorCount, dev) != hipSuccess) { grid = -1; return; }
        if (hipFuncSetAttribute((const void*)fwd, hipFuncAttributeMaxDynamicSharedMemorySize, LDS_BYTES) != hipSuccess) { fprintf(stderr, "kernel_launch: hipFuncSetAttribute failed\n"); grid = -1; return; }
        grid = cus;
    }
    if (grid < 0) return;
    (void)hipMemsetAsync((char*)d_ws + WS_CTL, 0, CTL_BYTES, stream);
    Args a{};
    for (int i = 0; i < 27; ++i) a.in[i] = (const float*)d_in[i];
    a.out = (float*)d_out; a.ws = (unsigned char*)d_ws;
#if MK_ONE_LAUNCH
    a.ph_lo = 0; a.ph_hi = PH_COUNT;
    hipLaunchKernelGGL(fwd, dim3(grid), dim3(512), LDS_BYTES, stream, a);
#else
    for (int ph = 0; ph < PH_COUNT; ++ph) {
        a.ph_lo = ph; a.ph_hi = ph + 1;
        hipLaunchKernelGGL(fwd, dim3(grid), dim3(512), LDS_BYTES, stream, a);
    }
#endif
}
```

```cpp
#include <hip/hip_runtime.h>
#include <cstdio>
#include <cstdint>

#define LAS __attribute__((address_space(3)))
#ifndef PROBE_REPEAT
#define PROBE_REPEAT -1
#endif
#ifndef G1_FP8
#define G1_FP8 0
#endif
#ifndef G2_FP8
#define G2_FP8 0
#endif
#ifndef BG_WDOWN
#define BG_WDOWN 1
#endif
#ifndef BG_WUP
#define BG_WUP 0
#endif
#ifndef BG_EXP
#define BG_EXP 0
#endif
#ifndef MK_ONE_LAUNCH
#define MK_ONE_LAUNCH 1
#endif
typedef unsigned short bf16;
typedef float f32x4 __attribute__((ext_vector_type(4)));
typedef float f32x2 __attribute__((ext_vector_type(2)));
typedef short bf16x8 __attribute__((ext_vector_type(8)));
typedef unsigned u32x4 __attribute__((ext_vector_type(4)));
typedef unsigned u32x2 __attribute__((ext_vector_type(2)));

constexpr int D = 2048, SEQ = 2048, NMETA = 16, TT = 2064, NBATCH = 8;
constexpr int MREAL = 16384, METAROW0 = 16384, MVALID = 16400, MROWS = 16640;
constexpr int DIN = 3584, DLRU = 1024, HD = 64;
constexpr int ZQ = 0, ZK = 1024, ZV = 1280, ZX = 1536, ZG = 2560;
constexpr int NEXP = 32, DFF = 2048, PROWS = 73728;
constexpr float EPS = 1e-5f;

constexpr size_t MiB = 1u << 20;
constexpr size_t WS_CTL = 0, CTL_BYTES = 1 * MiB;
constexpr size_t WS_COS = 1 * MiB, WS_SIN = 1 * MiB + 320 * 1024;
constexpr size_t WS_TOPE = 2 * MiB, WS_TOPW = WS_TOPE + 256 * 1024, WS_RSTD2 = WS_TOPW + 256 * 1024, WS_ROWPAIR = WS_RSTD2 + 64 * 1024, WS_ROWW = WS_ROWPAIR + 320 * 1024;
constexpr size_t WS_DUMMY = 3 * MiB + 512 * 1024;
constexpr size_t WS_LRUSUM = 4 * MiB;
constexpr size_t WS_WAT = 9 * MiB, WS_WIT = WS_WAT + 128 * 1024, WS_WRT = WS_WIT + 128 * 1024;
constexpr size_t WS_WINT = 10 * MiB, WS_WOUTT = 24 * MiB, WS_WGT = 32 * MiB, WS_WUT = 288 * MiB, WS_WDT = 544 * MiB;
constexpr size_t WS_N1 = 800 * MiB, WS_Z = 866 * MiB, WS_O = 980 * MiB, WS_H1 = 1044 * MiB, WS_XS = 1172 * MiB, WS_YB = WS_XS, WS_ACT = 1460 * MiB, WS_END = 1748 * MiB;
constexpr size_t WS_AB = WS_XS;
constexpr size_t WS_ATT = WS_N1;
constexpr size_t WS_XC = WS_XS, WS_AA = WS_XS + 66 * MiB, WS_BB = WS_XS + 132 * MiB, WS_YL = WS_XS + 198 * MiB;
static_assert(WS_ROWW + PROWS * 4 <= WS_LRUSUM, "small map");
constexpr int CW_COUNTS = 1024, CW_CURSOR = 1088, CW_BAR = 4096;

constexpr int LDS_TAB = 131072;
constexpr int LDS_MISC = LDS_TAB + 8192;
constexpr int LDS_BG = LDS_MISC + 1024;
constexpr int LDS_T2 = LDS_BG + 16384;
constexpr int LDS_BYTES = LDS_T2 + 4352;
static_assert(LDS_BYTES <= 163840 && LDS_BG % 1024 == 0, "LDS map");

__device__ const float c_inv_freq[32] = {1.000000000e+00f, 7.498942018e-01f, 5.623413324e-01f, 4.216965139e-01f, 3.162277639e-01f, 2.371373922e-01f, 1.778279394e-01f, 1.333521456e-01f, 1.000000015e-01f, 7.498941571e-02f, 5.623412877e-02f, 4.216964915e-02f, 3.162277862e-02f, 2.371373586e-02f, 1.778279431e-02f, 1.333521493e-02f, 9.999999776e-03f, 7.498942316e-03f, 5.623413250e-03f, 4.216964822e-03f, 3.162277862e-03f, 2.371373819e-03f, 1.778279431e-03f, 1.333521446e-03f, 1.000000047e-03f, 7.498941850e-04f, 5.623413017e-04f, 4.216965463e-04f, 3.162277862e-04f, 2.371373848e-04f, 1.778279402e-04f, 1.333521504e-04f};

struct Args { const float* in[27]; float* out; unsigned char* ws; int ph_lo, ph_hi; };
enum { I_X = 0, I_META, I_NORM_MIX, I_W_IN, I_B_IN, I_SINKS, I_CONV_W, I_CONV_B, I_W_A, I_B_A, I_W_I, I_B_I, I_LAMBDA, I_G_ATTN, I_G_LRU, I_W_OUT, I_B_OUT, I_NORM_FFN,
       I_W_ROUTER, I_B_ROUTER, I_W_GATE, I_B_GATE, I_W_UP, I_B_UP, I_W_DOWN, I_B_DOWN, I_FINAL_NORM };


#define XB_TMO      128
#define XB_XCNT(j)  (256  + 64 * (j))
#define XB_XSUB(j)  (1280 + 64 * (j))
#define XB_XGEN(j)  (2304 + 64 * (j))
#define XB_TOP      3328
#define XB_TOPGEN   3392
#define XCD_BAR_WORDS 3456
#define XB_SPIN_CAP (1u << 18)

__device__ __forceinline__ unsigned xb_ld(unsigned* p)              { return __hip_atomic_load(p, __ATOMIC_RELAXED, __HIP_MEMORY_SCOPE_AGENT); }
__device__ __forceinline__ unsigned xb_add(unsigned* p, unsigned v) { return __hip_atomic_fetch_add(p, v, __ATOMIC_RELAXED, __HIP_MEMORY_SCOPE_AGENT); }
__device__ __forceinline__ unsigned xb_xcc_id() { return (unsigned)__builtin_amdgcn_s_getreg((3 << 11) | 20) & 0xFu; }
#define XB_SPIN(cond, bar) do { unsigned _sp = 0; while (cond) { __builtin_amdgcn_s_sleep(1); \
    if ((++_sp & 255u) == 0u) { if (xb_ld(&(bar)[XB_TMO])) break; if (_sp > XB_SPIN_CAP) { atomicAdd(&(bar)[XB_TMO], 1u); break; } } } } while (0)

struct XcdBarrier {
    unsigned* bar; unsigned x;
    volatile LAS unsigned* st;
};

__device__ __forceinline__ XcdBarrier xcd_barrier_post(unsigned* bar, volatile LAS unsigned* st) {
    XcdBarrier b; b.bar = bar; b.x = xb_xcc_id(); b.st = st;
    if (threadIdx.x == 0) (void)xb_add(&bar[XB_XCNT(b.x)], 1u);
    return b;
}
__device__ __forceinline__ void xcd_barrier_complete(unsigned* bar, unsigned x, unsigned& nloc, unsigned& nx) {
    const unsigned G = gridDim.x * gridDim.y * gridDim.z;
    unsigned sum, cnt, mine, sp = 0u;
    for (;;) {
        sum = 0u; cnt = 0u; mine = 0u;
#pragma unroll
        for (unsigned j = 0; j < 16; ++j) { const unsigned c = xb_ld(&bar[XB_XCNT(j)]); sum += c; cnt += (c > 0u) ? 1u : 0u; mine = (j == x) ? c : mine; }
        if (sum == G) break;
        __builtin_amdgcn_s_sleep(1);
        if ((++sp & 255u) == 0u) { if (xb_ld(&bar[XB_TMO])) break; if (sp > XB_SPIN_CAP) { atomicAdd(&bar[XB_TMO], 1u); break; } }
    }
    nloc = mine > 0u ? mine : 1u; nx = cnt > 0u ? cnt : 1u;
}

__device__ __forceinline__ void xcd_barrier(const XcdBarrier& b) {
    asm volatile("s_waitcnt vmcnt(0)" ::: "memory");
    __syncthreads();
    if (threadIdx.x == 0) {
        unsigned* bar = b.bar;
        __builtin_amdgcn_s_waitcnt(0);
        unsigned nloc = b.st[0], nx = b.st[1];
        if (nloc == 0u) { xcd_barrier_complete(bar, b.x, nloc, nx); b.st[0] = nloc; b.st[1] = nx; }
        const unsigned old = xb_add(&bar[XB_XSUB(b.x)], 1u);
        const unsigned gen = old / nloc;
        if (old + 1u == (gen + 1u) * nloc) {
            __builtin_amdgcn_fence(__ATOMIC_RELEASE, "agent");
            asm volatile("s_waitcnt vmcnt(0)" ::: "memory");
            const unsigned og = xb_add(&bar[XB_TOP], 1u);
            const unsigned tg = og / nx;
            if (og + 1u == (tg + 1u) * nx) xb_add(&bar[XB_TOPGEN], 1u);
            else XB_SPIN(xb_ld(&bar[XB_TOPGEN]) == tg, bar);
            __builtin_amdgcn_fence(__ATOMIC_ACQUIRE, "agent");
            xb_add(&bar[XB_XGEN(b.x)], 1u);
            asm volatile("s_waitcnt vmcnt(0)" ::: "memory");
        } else {
            XB_SPIN(xb_ld(&bar[XB_XGEN(b.x)]) == gen, bar);
            __builtin_amdgcn_fence(__ATOMIC_ACQUIRE, "agent");
            asm volatile("s_waitcnt vmcnt(0)" ::: "memory");
        }
    }
    __syncthreads();
}

__device__ __forceinline__ float bf2f(unsigned b) { return __uint_as_float((b & 0xffffu) << 16); }
__device__ __forceinline__ unsigned f2bf(float f) { unsigned u = __float_as_uint(f); return (u + 0x7fffu + ((u >> 16) & 1u)) >> 16; }
__device__ __forceinline__ unsigned pk2(float lo, float hi) { return f2bf(lo) | (f2bf(hi) << 16); }
constexpr float W_SCALE = 256.0f, XS_SCALE = 8.0f, ACT_SCALE = 4.0f, YB_SCALE = 32.0f;
__device__ __forceinline__ float clamp_fp8(float x) { return __builtin_amdgcn_fmed3f(x, -448.0f, 448.0f); }
__device__ __forceinline__ unsigned pk4_fp8(float a, float b, float c, float d) {
    int w = 0; w = __builtin_amdgcn_cvt_pk_fp8_f32(clamp_fp8(a), clamp_fp8(b), w, false); w = __builtin_amdgcn_cvt_pk_fp8_f32(clamp_fp8(c), clamp_fp8(d), w, true); return (unsigned)w; }
__device__ __forceinline__ float wave_sum(float v) {
#pragma unroll
    for (int o = 1; o < 64; o <<= 1) v += __shfl_xor(v, o);
    return v;
}
__device__ __forceinline__ float wave_max(float v) {
#pragma unroll
    for (int o = 1; o < 64; o <<= 1) v = fmaxf(v, __shfl_xor(v, o));
    return v;
}
__device__ __forceinline__ float sigmoidf_(float x) { return 1.0f / (1.0f + __expf(-x)); }
__device__ __forceinline__ float fast_sigmoid(float x) { return __builtin_amdgcn_rcpf(1.0f + __builtin_amdgcn_exp2f(-1.4426950408889634f * x)); }
__device__ __forceinline__ float fast_gelu_tanh(float x) { const float u2 = 1.5957691216057308f * (x + 0.044715f * x * x * x); return x * __builtin_amdgcn_rcpf(1.0f + __builtin_amdgcn_exp2f(-1.4426950408889634f * u2)); }
__device__ __forceinline__ float gelu_tanh(float x) { const float u = 0.7978845608028654f * (x + 0.044715f * x * x * x); return 0.5f * x * (1.0f + tanhf(u)); }
__device__ __forceinline__ int tok_row(int b, int t) { return t < NMETA ? METAROW0 + t : b * SEQ + (t - NMETA); }

__device__ __forceinline__ void transpose_item(const float* W, int K, int N, bf16* WT, LAS float* scr, int item, int lane) {
    const int nblk = N / 32, kb = item / nblk, nb = item % nblk, k0 = 64 * kb, n0 = 32 * nb;
#pragma unroll 8
    for (int i = 0; i < 32; ++i) { const int kk = 2 * i + (lane >> 5); scr[kk * 33 + (lane & 31)] = W[(size_t)(k0 + kk) * N + n0 + (lane & 31)]; }
    asm volatile("s_waitcnt lgkmcnt(0)" ::: "memory");
    const int c = lane & 7;
#pragma unroll
    for (int j = 0; j < 4; ++j) { const int n = (lane >> 3) + 8 * j; const LAS float* s = scr + (8 * c) * 33 + n;
        u32x4 o; o.x = pk2(s[0 * 33], s[1 * 33]); o.y = pk2(s[2 * 33], s[3 * 33]); o.z = pk2(s[4 * 33], s[5 * 33]); o.w = pk2(s[6 * 33], s[7 * 33]);
        *(u32x4*)(WT + (size_t)(n0 + n) * K + k0 + 8 * c) = o; }
    asm volatile("s_waitcnt lgkmcnt(0)" ::: "memory");
}

__device__ __forceinline__ void phase_prologue(const Args& a, LAS unsigned char* lds, int tid, int lane, int wave) {
    const int gw = blockIdx.x * 8 + wave, NGW = gridDim.x * 8;
    const int gt = blockIdx.x * 512 + tid, NGT = gridDim.x * 512;
    unsigned char* ws = a.ws;
    LAS float* scr = (LAS float*)(lds + wave * 8704);
    {
        constexpr int IT_IN = G1_FP8 ? 0 : 32 * (DIN / 32), IT_OUT = G2_FP8 ? 0 : 32 * (D / 32);
        for (int it = gw; it < IT_IN + IT_OUT; it += NGW) {
            if (it < IT_IN) transpose_item(a.in[I_W_IN], D, DIN, (bf16*)(ws + WS_WINT), scr, it, lane);
            else transpose_item(a.in[I_W_OUT], D, D, (bf16*)(ws + WS_WOUTT), scr, it - IT_IN, lane);
        }
        __syncthreads();
    }
    {
        LAS unsigned* T = (LAS unsigned*)lds;
        const int n4 = tid & 63, kq = tid >> 6;
        constexpr int T_IN = G1_FP8 ? (D / 128) * (DIN / 256) : 0, T_OUT = G2_FP8 ? (D / 128) * (D / 256) : 0, T_E = (D / 128) * (D / 256);
        constexpr int N_GATE = 32 * T_E, N_UP = (BG_WUP && !BG_EXP) ? 256 * 6 : 32 * T_E, N_DOWN = (BG_WDOWN && !BG_EXP) ? 0 : 32 * T_E;
        constexpr int NTILES = T_IN + T_OUT + N_GATE + N_UP + N_DOWN;
        auto tile_ptrs = [&](int tile, const float*& sp, unsigned char*& dp, int& ldn) {
            const float* sbase; unsigned char* dbase; int tl, nt;
            if (tile < T_IN) { sbase = a.in[I_W_IN]; dbase = ws + WS_WINT; tl = tile; nt = DIN / 256; ldn = DIN; }
            else if (tile < T_IN + T_OUT) { sbase = a.in[I_W_OUT]; dbase = ws + WS_WOUTT; tl = tile - T_IN; nt = D / 256; ldn = D; }
            else { int r = tile - T_IN - T_OUT, which, e; nt = D / 256; ldn = D;
                   if (r < N_GATE) { which = 0; e = r / T_E; tl = r % T_E; }
                   else if (r < N_GATE + N_UP) { r -= N_GATE; which = 1; int g = r; if (BG_WUP && !BG_EXP) g = 16 * (r / 6) + 10 + (r % 6);
                                                 e = g / T_E; tl = g % T_E; }
                   else { r -= N_GATE + N_UP; which = 2; e = r / T_E; tl = r % T_E; }
                   sbase = a.in[which == 0 ? I_W_GATE : (which == 1 ? I_W_UP : I_W_DOWN)] + (size_t)e * D * D; dbase = ws + (which == 0 ? WS_WGT : (which == 1 ? WS_WUT : WS_WDT)) + (size_t)e * D * D; }
            const int k0 = (tl / nt) * 128, n0 = (tl % nt) * 256;
            sp = sbase + (size_t)(k0 + 4 * kq) * ldn + n0 + 4 * n4; dp = dbase + (size_t)n0 * D + k0; };
#define CONV_LOAD(R, tile) do { const float* _p; unsigned char* _d; int _ld; tile_ptrs(tile, _p, _d, _ld); _Pragma("unroll") for (int i = 0; i < 4; ++i) _Pragma("unroll") for (int q = 0; q < 4; ++q) \
            R[i][q] = __builtin_nontemporal_load((const f32x4*)(_p + (size_t)(32 * i + q) * _ld)); } while (0)
#define CONV_STORE(R, tile) do { _Pragma("unroll") for (int i = 0; i < 4; ++i) { const int kd = kq + 8 * i; \
            T[(4 * n4 + 0) * 33 + kd] = pk4_fp8(R[i][0].x * W_SCALE, R[i][1].x * W_SCALE, R[i][2].x * W_SCALE, R[i][3].x * W_SCALE); \
            T[(4 * n4 + 1) * 33 + kd] = pk4_fp8(R[i][0].y * W_SCALE, R[i][1].y * W_SCALE, R[i][2].y * W_SCALE, R[i][3].y * W_SCALE); \
            T[(4 * n4 + 2) * 33 + kd] = pk4_fp8(R[i][0].z * W_SCALE, R[i][1].z * W_SCALE, R[i][2].z * W_SCALE, R[i][3].z * W_SCALE); \
            T[(4 * n4 + 3) * 33 + kd] = pk4_fp8(R[i][0].w * W_SCALE, R[i][1].w * W_SCALE, R[i][2].w * W_SCALE, R[i][3].w * W_SCALE); } \
            __syncthreads(); \
            { const float* _p; unsigned char* _d; int _ld; tile_ptrs(tile, _p, _d, _ld); _Pragma("unroll") for (int i = 0; i < 4; ++i) { const int n = (tid >> 3) + 64 * i, c = tid & 7; \
                const u32x4 o = (u32x4){T[n * 33 + 4 * c], T[n * 33 + 4 * c + 1], T[n * 33 + 4 * c + 2], T[n * 33 + 4 * c + 3]}; \
                *(u32x4*)(_d + (size_t)n * D + 16 * c) = o; } } \
            __syncthreads(); } while (0)
        f32x4 RA[4][4], RB[4][4];
        int tile = blockIdx.x;
        if (tile < NTILES) CONV_LOAD(RA, tile);
        while (tile < NTILES) {
            int nxt = tile + gridDim.x;
            if (nxt < NTILES) CONV_LOAD(RB, nxt);
            CONV_STORE(RA, tile);
            tile = nxt; if (tile >= NTILES) break;
            nxt = tile + gridDim.x;
            if (nxt < NTILES) CONV_LOAD(RA, nxt);
            CONV_STORE(RB, tile);
            tile = nxt;
        }
#undef CONV_LOAD
#undef CONV_STORE
    }
    for (int r = gw; r < MROWS; r += NGW) {
        u32x2* orow = (u32x2*)((bf16*)(ws + WS_N1) + (size_t)r * D);
        unsigned* orow8 = (unsigned*)(ws + WS_N1 + (size_t)r * D);
        if (r >= MVALID) {
#pragma unroll
            for (int j = 0; j < 8; ++j) { if (G1_FP8) orow8[lane + 64 * j] = 0u; else orow[lane + 64 * j] = (u32x2){0u, 0u}; }
            continue; }
        const f32x4* xr = (const f32x4*)(r < MREAL ? a.in[I_X] + (size_t)r * D : a.in[I_META] + (size_t)(r - MREAL) * D);
        f32x4 v[8]; float ss = 0.f;
#pragma unroll
        for (int j = 0; j < 8; ++j) { v[j] = xr[lane + 64 * j]; ss += (v[j].x * v[j].x + v[j].y * v[j].y) + (v[j].z * v[j].z + v[j].w * v[j].w); }
        ss = wave_sum(ss);
        const float rstd = (G1_FP8 ? XS_SCALE : 1.0f) / sqrtf(ss * (1.0f / D) + EPS);
#pragma unroll
        for (int j = 0; j < 8; ++j) { const f32x4 g = ((const f32x4*)a.in[I_NORM_MIX])[lane + 64 * j];
            if (G1_FP8) orow8[lane + 64 * j] = pk4_fp8(v[j].x * rstd * g.x, v[j].y * rstd * g.y, v[j].z * rstd * g.z, v[j].w * rstd * g.w);
            else orow[lane + 64 * j] = (u32x2){pk2(v[j].x * rstd * g.x, v[j].y * rstd * g.y), pk2(v[j].z * rstd * g.z, v[j].w * rstd * g.w)}; }
    }
    float* cosT = (float*)(ws + WS_COS); float* sinT = (float*)(ws + WS_SIN);
    for (int i = gt; i < TT * 32; i += NGT) {
        const int pos = i >> 5, j = i & 31;
        const float ang = (float)pos * c_inv_freq[j];
        const double t = (double)ang * 0.15915494309189535; const float fr = (float)(t - floor(t));
        cosT[i] = __builtin_amdgcn_cosf(fr); sinT[i] = __builtin_amdgcn_sinf(fr);
    }
    { bf16* WaT = (bf16*)(ws + WS_WAT); bf16* WiT = (bf16*)(ws + WS_WIT);
      for (int i = gt; i < 16 * 64 * 64; i += NGT) { const int n = i >> 12, d = (i >> 6) & 63, cc = i & 63;
          WaT[i] = (bf16)f2bf(a.in[I_W_A][(n * 64 + cc) * 64 + d]); WiT[i] = (bf16)f2bf(a.in[I_W_I][(n * 64 + cc) * 64 + d]); } }
    { bf16* WRT = (bf16*)(ws + WS_WRT);
      for (int i = gt; i < NEXP * D; i += NGT) { const int e = i >> 11, k = i & 2047; WRT[i] = (bf16)f2bf(a.in[I_NORM_FFN][k] * a.in[I_W_ROUTER][k * NEXP + e]); } }
    int* rowpair = (int*)(ws + WS_ROWPAIR);
    for (int i = gt; i < PROWS; i += NGT) rowpair[i] = -1;
}

namespace pg8 {
constexpr int BM = 256, BK = 64, HALF = 128, HTB = HALF * BK * 2, STAGE_BYTES = 8 * HTB, NXCD = 8, WGM = 8, KD = 2048, NKT = KD / BK;
__host__ __device__ __forceinline__ int lds_byte(int r, int c) { const int st = (r >> 4) * 2 + (c >> 5), rr = r & 15, cc = c & 31, ob = rr * 64 + cc * 2; return st * 1024 + (ob ^ (((ob >> 9) & 1) << 5)); }
__host__ __device__ __forceinline__ void stage_rc(int b, int& R, int& C) { const int st = b / 1024, sb = b % 1024, swz = sb ^ (((sb >> 9) & 1) << 5); R = (st >> 1) * 16 + swz / 64; C = (st & 1) * 32 + (swz % 64) / 2; }
__host__ __device__ __forceinline__ int perm32(int rho) { const int n = rho >> 4, i = rho & 15; return 8 * (i >> 2) + 4 * n + (i & 3); }
struct Unit { const char* a; const char* b0; const char* b1; int pm, pn, e; };
__device__ __forceinline__ bool static_tile(int i, int G, int c, int nM, int nN, int& pm, int& pn) {
    const int nwg = nM * nN; const long L = (long)i * G + c; if (L >= nwg) return false;
    int wgid = (int)L; { const int q = nwg / NXCD, r = nwg % NXCD, xcd = wgid % NXCD, off = wgid / NXCD; wgid = (xcd < r ? xcd * (q + 1) : r * (q + 1) + (xcd - r) * q) + off; }
    const int nig = WGM * nN, gid = wgid / nig, fm = gid * WGM, gsz = (nM - fm) < WGM ? (nM - fm) : WGM;
    pm = fm + ((wgid % nig) % gsz); pn = (wgid % nig) / gsz; return true;
}
__device__ __forceinline__ unsigned cvt_pk_bf16(float lo, float hi) { unsigned r; asm volatile("v_cvt_pk_bf16_f32 %0, %1, %2" : "=v"(r) : "v"(lo), "v"(hi)); return r; }

typedef int i32x8 __attribute__((ext_vector_type(8)));
typedef int i32x4 __attribute__((ext_vector_type(4)));
__device__ __forceinline__ i32x8 cat8(bf16x8 lo, bf16x8 hi) { const i32x4 a = __builtin_bit_cast(i32x4, lo), b = __builtin_bit_cast(i32x4, hi); return __builtin_shufflevector(a, b, 0, 1, 2, 3, 4, 5, 6, 7); }
struct BGNone { static constexpr bool ON = false; };
struct BGConv { static constexpr bool ON = true; const char* src; unsigned char* dst; int next, end; unsigned char* dummy; };
__device__ __forceinline__ void bg_pair_ptrs(const BGConv& bg, int pair, const char*& sp, unsigned char*& dp) {
    const int e = pair >> 10, kbp = (pair >> 6) & 15, nb = pair & 63;
    sp = bg.src + ((size_t)(e * 2048 + 128 * kbp) * 2048 + 32 * nb) * 4; dp = bg.dst + (size_t)e * 2048 * 2048 + (size_t)(32 * nb) * 2048 + 128 * kbp; }
template <bool FP8, class Epi, class Sched, class BG>
__device__ __forceinline__ void gemm_phase(LAS unsigned char* lds, const Sched& S, const Epi& E, BG& bg) {
    constexpr int ROWB = FP8 ? 2048 : 4096, NKTL = ROWB / 128;
    const int tid = threadIdx.x, wid = __builtin_amdgcn_readfirstlane(tid >> 6), lane = tid & 63, wr = wid >> 2, wc = wid & 3, fr = lane & 15, fq = lane >> 4;
    unsigned voffA[2], voffB[2];
#pragma unroll
    for (int i = 0; i < 2; ++i) { int R, C; stage_rc(tid * 16 + i * 8192, R, C); const int Rb = Epi::PERM ? ((R & ~31) + perm32(R & 31)) : R;
        voffA[i] = (unsigned)(R * ROWB + C * 2); voffB[i] = (unsigned)(Rb * ROWB + C * 2); }
    constexpr size_t kstep = (size_t)(BK * 2);
    constexpr size_t hstep = (size_t)HALF * ROWB;
    const unsigned ldsw = (unsigned)wid * 1024u;
    const unsigned bgvoff = (unsigned)((8 * wid + (lane >> 3)) * 8192 + (lane & 7) * 16);
    const int aoff = lds_byte(wr * 64 + fr, fq * 8), boff = lds_byte(wc * 32 + fr, fq * 8);
#define PG8_SA(b, h) (((b) * 2 + (h)) * HTB)
#define PG8_SB(b, h) ((4 + (b) * 2 + (h)) * HTB)
#define PG8_STAGE(bufoff, gbase, voff) do { _Pragma("unroll") for (int _i = 0; _i < 2; ++_i) \
        __builtin_amdgcn_global_load_lds((const unsigned*)((const char*)(gbase) + (voff)[_i]), (LAS unsigned*)(lds + (bufoff) + ldsw + _i * 8192), 16, 0, 0); } while (0)
#define PG8_LDA(dst, b, h) do { _Pragma("unroll") for (int m = 0; m < 4; ++m) { \
        if constexpr (FP8) dst##8[m] = __builtin_shufflevector(*(const LAS i32x4*)(lds + PG8_SA(b, h) + aoff + m * 2048), *(const LAS i32x4*)(lds + PG8_SA(b, h) + aoff + m * 2048 + 1024), 0, 1, 2, 3, 4, 5, 6, 7); \
        else { _Pragma("unroll") for (int k = 0; k < 2; ++k) dst[m][k] = *(const LAS bf16x8*)(lds + PG8_SA(b, h) + aoff + m * 2048 + k * 1024); } } } while (0)
#define PG8_LDB(dst, b, h) do { _Pragma("unroll") for (int n = 0; n < 2; ++n) { \
        if constexpr (FP8) dst##8[n] = __builtin_shufflevector(*(const LAS i32x4*)(lds + PG8_SB(b, h) + boff + n * 2048), *(const LAS i32x4*)(lds + PG8_SB(b, h) + boff + n * 2048 + 1024), 0, 1, 2, 3, 4, 5, 6, 7); \
        else { _Pragma("unroll") for (int k = 0; k < 2; ++k) dst[n][k] = *(const LAS bf16x8*)(lds + PG8_SB(b, h) + boff + n * 2048 + k * 1024); } } } while (0)
#define PG8_MMA(ai, bj, At, Bt) do { __builtin_amdgcn_s_setprio(1); _Pragma("unroll") for (int m = 0; m < 4; ++m) _Pragma("unroll") for (int n = 0; n < 2; ++n) { \
        if constexpr (FP8) asm volatile("v_mfma_f32_16x16x128_f8f6f4 %0, %1, %2, %0" : "+v"(acc[ai][bj][m][n]) : "v"(Bt##8[n]), "v"(At##8[m])); \
        else { _Pragma("unroll") for (int k = 0; k < 2; ++k) asm volatile("v_mfma_f32_16x16x32_bf16 %0, %1, %2, %0" : "+v"(acc[ai][bj][m][n]) : "v"(Bt[n][k]), "v"(At[m][k])); } } \
        __builtin_amdgcn_s_setprio(0); } while (0)
#define PG8_WAIT_V(n) asm volatile("s_waitcnt vmcnt(" #n ")" ::: "memory")
#define PG8_WAIT_L(n) asm volatile("s_waitcnt lgkmcnt(" #n ")" ::: "memory")
#define PG8_BAR __builtin_amdgcn_s_barrier()
#define PG8_SCHED __builtin_amdgcn_sched_barrier(0)
    Unit cur, nxt; int ui = 0; bool bg_pending = false;
    if (!S.next(0, cur)) return;
    f32x4 acc[2][2][4][2];
#pragma unroll
    for (int a = 0; a < 2; ++a)
#pragma unroll
        for (int b = 0; b < 2; ++b)
#pragma unroll
            for (int m = 0; m < 4; ++m)
#pragma unroll
                for (int n = 0; n < 2; ++n) acc[a][b][m][n] = (f32x4){0.f, 0.f, 0.f, 0.f};
    bf16x8 At[4][2], B0[2][2], B1[2][2];
    i32x8 At8[4], B08[2], B18[2];
    PG8_STAGE(PG8_SB(0, 0), cur.b0, voffB); PG8_STAGE(PG8_SB(0, 1), cur.b1, voffB); PG8_STAGE(PG8_SA(0, 0), cur.a, voffA); PG8_STAGE(PG8_SA(0, 1), cur.a + hstep, voffA);
    if (wr == 1) PG8_BAR;
    PG8_WAIT_V(2); PG8_BAR;
    PG8_STAGE(PG8_SB(1, 0), cur.b0 + kstep, voffB); PG8_STAGE(PG8_SA(1, 0), cur.a + kstep, voffA); PG8_STAGE(PG8_SB(1, 1), cur.b1 + kstep, voffB);
    PG8_WAIT_V(6); PG8_BAR;
    for (;;) {
        const bool has_next = S.next(ui + 1, nxt);
        const char* nA = has_next ? nxt.a : cur.a; const char* nB0 = has_next ? nxt.b0 : cur.b0; const char* nB1 = has_next ? nxt.b1 : cur.b1;
        for (int t = 0; t < NKTL; t += 2) {
            const bool last = (t == NKTL - 2);
            const char* a1 = cur.a + (size_t)(t + 1) * kstep;
            const char* a2 = last ? nA : cur.a + (size_t)(t + 2) * kstep;
            const char* b20 = last ? nB0 : cur.b0 + (size_t)(t + 2) * kstep; const char* b21 = last ? nB1 : cur.b1 + (size_t)(t + 2) * kstep;
            const char* a3 = a2 + kstep; const char* b30 = b20 + kstep; const char* b31 = b21 + kstep;
            PG8_LDB(B0, 0, 0); PG8_LDB(B1, 0, 1); PG8_SCHED; PG8_LDA(At, 0, 0); PG8_STAGE(PG8_SA(1, 1), a1 + hstep, voffA);
            PG8_WAIT_V(8); PG8_WAIT_L(0); PG8_BAR; PG8_MMA(0, 0, At, B0);
            if constexpr (BG::ON) {
                PG8_SCHED;
#pragma unroll
                for (int j = 0; j < (BG_EXP == 1 ? 0 : 2); ++j) { const LAS float* p = (const LAS float*)(lds + LDS_BG + j * 8192 + (tid >> 5) * 512 + (tid & 31) * 4);
                    ((LAS unsigned*)(lds + LDS_T2))[(tid & 31) * 33 + 16 * j + (tid >> 5)] = pk4_fp8(p[0] * W_SCALE, p[32] * W_SCALE, p[64] * W_SCALE, p[96] * W_SCALE); }
                const char* bgs; { unsigned char* dp_; pg8::bg_pair_ptrs(bg, bg.next < bg.end ? bg.next : bg.end - 1, bgs, dp_); }
                PG8_SCHED;
                if (BG_EXP != 2) {
                __builtin_amdgcn_global_load_lds((const unsigned*)(bgs + bgvoff), (LAS unsigned*)(lds + LDS_BG + ldsw), 16, 0, 0);
                __builtin_amdgcn_global_load_lds((const unsigned*)(bgs + 524288 + bgvoff), (LAS unsigned*)(lds + LDS_BG + 8192 + ldsw), 16, 0, 0); }
                PG8_SCHED; }
            PG8_MMA(0, 1, At, B1);
            if constexpr (BG::ON) { PG8_WAIT_L(0); }
            PG8_BAR; PG8_SCHED;
            PG8_LDA(At, 0, 1); PG8_STAGE(PG8_SB(0, 0), b20, voffB); PG8_STAGE(PG8_SB(0, 1), b21, voffB); PG8_STAGE(PG8_SA(0, 0), a2, voffA);
            if constexpr (BG::ON) { if (BG_EXP == 2) PG8_WAIT_V(8); else PG8_WAIT_V(10); } else { PG8_WAIT_V(8); }
            PG8_WAIT_L(0); PG8_BAR; PG8_MMA(1, 0, At, B0);
            if constexpr (BG::ON) {
                PG8_SCHED;
                unsigned char* bgd; { const char* sp_; pg8::bg_pair_ptrs(bg, bg.next - 1 < bg.end ? bg.next - 1 : bg.end - 1, sp_, bgd); }
                const LAS unsigned* q = (const LAS unsigned*)(lds + LDS_T2) + (tid >> 4) * 33 + 2 * (tid & 15);
                const u32x2 w = (u32x2){q[0], q[1]};
                if (BG_EXP != 1) *(u32x2*)((bg_pending && !BG_EXP) ? bgd + (size_t)(tid >> 4) * 2048 + 8 * (tid & 15) : bg.dummy + 8 * tid) = w;
                ++bg.next; bg_pending = true;
                PG8_SCHED; }
            PG8_MMA(1, 1, At, B1); PG8_BAR; PG8_SCHED;
            PG8_LDB(B0, 1, 0); PG8_LDB(B1, 1, 1); PG8_SCHED; PG8_LDA(At, 1, 0); PG8_STAGE(PG8_SA(0, 1), a2 + hstep, voffA);
            if constexpr (BG::ON) { if (BG_EXP == 1) PG8_WAIT_V(10); else if (BG_EXP == 2) PG8_WAIT_V(9); else PG8_WAIT_V(11); } else { PG8_WAIT_V(8); }
            PG8_WAIT_L(0); PG8_BAR; PG8_MMA(0, 0, At, B0); PG8_MMA(0, 1, At, B1); PG8_BAR; PG8_SCHED;
            PG8_LDA(At, 1, 1); PG8_STAGE(PG8_SB(1, 0), b30, voffB); PG8_STAGE(PG8_SB(1, 1), b31, voffB); PG8_STAGE(PG8_SA(1, 0), a3, voffA);
            if constexpr (BG::ON) { if (BG_EXP == 1) PG8_WAIT_V(8); else PG8_WAIT_V(9); } else { PG8_WAIT_V(8); }
            PG8_WAIT_L(0); PG8_BAR; PG8_MMA(1, 0, At, B0); PG8_MMA(1, 1, At, B1); PG8_BAR; PG8_SCHED;
        }
        if (wr == 0) PG8_BAR;
        asm volatile("s_nop 15\n\ts_nop 15" ::: "memory");
        E(acc, cur, wr, wc, fr, fq);
        if (!has_next) break;
#pragma unroll
        for (int a = 0; a < 2; ++a)
#pragma unroll
            for (int b = 0; b < 2; ++b)
#pragma unroll
                for (int m = 0; m < 4; ++m)
#pragma unroll
                    for (int n = 0; n < 2; ++n) acc[a][b][m][n] = (f32x4){0.f, 0.f, 0.f, 0.f};
        cur = nxt; ++ui;
        if (wr == 1) PG8_BAR;
    }
    PG8_WAIT_V(0);
    PG8_BAR;
    if constexpr (BG::ON) { if (bg_pending && !BG_EXP) {
        unsigned char* bgd; { const char* sp_; pg8::bg_pair_ptrs(bg, bg.next - 1 < bg.end ? bg.next - 1 : bg.end - 1, sp_, bgd); }
#pragma unroll
        for (int j = 0; j < 2; ++j) { const LAS float* p = (const LAS float*)(lds + LDS_BG + j * 8192 + (tid >> 5) * 512 + (tid & 31) * 4);
            ((LAS unsigned*)(lds + LDS_T2))[(tid & 31) * 33 + 16 * j + (tid >> 5)] = pk4_fp8(p[0] * W_SCALE, p[32] * W_SCALE, p[64] * W_SCALE, p[96] * W_SCALE); }
        __syncthreads();
        const LAS unsigned* q = (const LAS unsigned*)(lds + LDS_T2) + (tid >> 4) * 33 + 2 * (tid & 15);
        *(u32x2*)(bgd + (size_t)(tid >> 4) * 2048 + 8 * (tid & 15)) = (u32x2){q[0], q[1]}; } }
#undef PG8_SA
#undef PG8_SB
#undef PG8_STAGE
#undef PG8_LDA
#undef PG8_LDB
#undef PG8_MMA
#undef PG8_WAIT_V
#undef PG8_WAIT_L
#undef PG8_BAR
#undef PG8_SCHED
}

struct SchedDense {
    const char* A; const char* Bt; int nM, nN, G, c, rowb;
    __device__ __forceinline__ bool next(int i, Unit& u) const {
        int pm, pn; if (!static_tile(i, G, c, nM, nN, pm, pn)) return false;
        u.pm = pm; u.pn = pn; u.e = 0; u.a = A + (size_t)pm * BM * rowb; u.b0 = Bt + (size_t)pn * BM * rowb; u.b1 = u.b0 + (size_t)HALF * rowb; return true;
    }
};
struct SchedMoE {
    const char* A; const char* B0; const char* B1; const LAS int* tstart; int nM, nN, G, c; bool split;
    __device__ __forceinline__ bool next(int i, Unit& u) const {
        int pm, pn; if (!static_tile(i, G, c, nM, nN, pm, pn)) return false;
        int e = 0;
#pragma unroll 1
        for (int q = 1; q < 32; ++q) e += (tstart[q] <= pm) ? 1 : 0;
        u.pm = pm; u.pn = pn; u.e = e; u.a = A + (size_t)pm * (BM * 2048);
        const size_t eoff = (size_t)e * ((size_t)2048 * 2048);
        if (split) { u.b0 = B0 + eoff + (size_t)pn * (HALF * 2048); u.b1 = B1 + eoff + (size_t)pn * (HALF * 2048); }
        else { u.b0 = B0 + eoff + (size_t)pn * (BM * 2048); u.b1 = u.b0 + (size_t)HALF * 2048; }
        return true;
    }
};

struct EpiZ {
    static constexpr bool PERM = true;
    bf16* Z; const float* bias; float sc;
    __device__ __forceinline__ void operator()(const f32x4 (&acc)[2][2][4][2], const Unit& u, int wr, int wc, int fr, int fq) const {
        const int row0 = u.pm * BM + wr * 64 + fr, col0 = u.pn * BM + wc * 32 + 8 * fq;
        f32x4 bv[2][2];
#pragma unroll
        for (int bj = 0; bj < 2; ++bj)
#pragma unroll
            for (int n = 0; n < 2; ++n) bv[bj][n] = *(const f32x4*)(bias + col0 + bj * HALF + 4 * n);
#pragma unroll
        for (int ai = 0; ai < 2; ++ai)
#pragma unroll
            for (int m = 0; m < 4; ++m) { bf16* rowp = Z + (size_t)(row0 + ai * HALF + m * 16) * DIN + col0;
#pragma unroll
                for (int bj = 0; bj < 2; ++bj) { const f32x4 v0 = acc[ai][bj][m][0] * sc + bv[bj][0], v1 = acc[ai][bj][m][1] * sc + bv[bj][1];
                    u32x4 w; w.x = cvt_pk_bf16(v0[0], v0[1]); w.y = cvt_pk_bf16(v0[2], v0[3]); w.z = cvt_pk_bf16(v1[0], v1[1]); w.w = cvt_pk_bf16(v1[2], v1[3]);
                    *(u32x4*)(rowp + bj * HALF) = w; } }
    }
};
struct EpiH1 {
    static constexpr bool PERM = true;
    bf16* H1; const float* x; const float* bias; float sc;
    __device__ __forceinline__ void operator()(const f32x4 (&acc)[2][2][4][2], const Unit& u, int wr, int wc, int fr, int fq) const {
        const int row0 = u.pm * BM + wr * 64 + fr, col0 = u.pn * BM + wc * 32 + 8 * fq;
        f32x4 bv[2][2];
#pragma unroll
        for (int bj = 0; bj < 2; ++bj)
#pragma unroll
            for (int n = 0; n < 2; ++n) bv[bj][n] = *(const f32x4*)(bias + col0 + bj * HALF + 4 * n);
#pragma unroll
        for (int ai = 0; ai < 2; ++ai) {
            f32x4 xv[4][2][2];
#pragma unroll
            for (int m = 0; m < 4; ++m) { const size_t ro = (size_t)(row0 + ai * HALF + m * 16) * D + col0;
#pragma unroll
                for (int bj = 0; bj < 2; ++bj) { xv[m][bj][0] = __builtin_nontemporal_load((const f32x4*)(x + ro + bj * HALF)); xv[m][bj][1] = __builtin_nontemporal_load((const f32x4*)(x + ro + bj * HALF + 4)); } }
#pragma unroll
            for (int m = 0; m < 4; ++m) { const size_t ro = (size_t)(row0 + ai * HALF + m * 16) * D + col0;
#pragma unroll
                for (int bj = 0; bj < 2; ++bj) { const f32x4 v0 = xv[m][bj][0] + acc[ai][bj][m][0] * sc + bv[bj][0], v1 = xv[m][bj][1] + acc[ai][bj][m][1] * sc + bv[bj][1];
                    u32x4 w; w.x = cvt_pk_bf16(v0[0], v0[1]); w.y = cvt_pk_bf16(v0[2], v0[3]); w.z = cvt_pk_bf16(v1[0], v1[1]); w.w = cvt_pk_bf16(v1[2], v1[3]);
                    *(u32x4*)(H1 + ro + bj * HALF) = w; } }
        }
    }
};
struct EpiAct {
    static constexpr bool PERM = true;
    unsigned char* ACT; const float* bg; const float* bu;
    __device__ __forceinline__ void operator()(const f32x4 (&acc)[2][2][4][2], const Unit& u, int wr, int wc, int fr, int fq) const {
        const int row0 = u.pm * BM + wr * 64 + fr, col0 = u.pn * HALF + wc * 32 + 8 * fq;
        f32x4 gv[2], uv[2];
#pragma unroll
        for (int n = 0; n < 2; ++n) { gv[n] = *(const f32x4*)(bg + (size_t)u.e * DFF + col0 + 4 * n); uv[n] = *(const f32x4*)(bu + (size_t)u.e * DFF + col0 + 4 * n); }
#pragma unroll
        for (int ai = 0; ai < 2; ++ai)
#pragma unroll
            for (int m = 0; m < 4; ++m) { float r[8];
#pragma unroll
                for (int n = 0; n < 2; ++n)
#pragma unroll
                    for (int j = 0; j < 4; ++j) { float g = acc[ai][0][m][n][j] * (1.0f / (W_SCALE * XS_SCALE)) + gv[n][j], up = acc[ai][1][m][n][j] * (1.0f / (W_SCALE * XS_SCALE)) + uv[n][j];
                        g = fminf(g, 7.0f); up = fminf(fmaxf(up, -7.0f), 7.0f);
                        r[n * 4 + j] = ACT_SCALE * g * (1.0f / (1.0f + __expf(-1.702f * g))) * (up + 1.0f); }
                *(u32x2*)(ACT + (size_t)(row0 + ai * HALF + m * 16) * DFF + col0) = (u32x2){pk4_fp8(r[0], r[1], r[2], r[3]), pk4_fp8(r[4], r[5], r[6], r[7])}; }
    }
};
struct EpiDown {
    static constexpr bool PERM = true;
    unsigned char* YB; const float* bd; const int* rowpair; const float* roww;
    __device__ __forceinline__ void operator()(const f32x4 (&acc)[2][2][4][2], const Unit& u, int wr, int wc, int fr, int fq) const {
        const int row0 = u.pm * BM + wr * 64 + fr, col0 = u.pn * BM + wc * 32 + 8 * fq;
        f32x4 bv[2][2];
#pragma unroll
        for (int bj = 0; bj < 2; ++bj)
#pragma unroll
            for (int n = 0; n < 2; ++n) bv[bj][n] = *(const f32x4*)(bd + (size_t)u.e * D + col0 + bj * HALF + 4 * n);
        int pr[2][4]; float wv[2][4];
#pragma unroll
        for (int ai = 0; ai < 2; ++ai)
#pragma unroll
            for (int m = 0; m < 4; ++m) { const int row = row0 + ai * HALF + m * 16; pr[ai][m] = rowpair[row]; wv[ai][m] = roww[row]; }
#pragma unroll
        for (int ai = 0; ai < 2; ++ai)
#pragma unroll
            for (int m = 0; m < 4; ++m) { const int pair = pr[ai][m]; const float wt = wv[ai][m] * YB_SCALE;
                if (pair >= 0) { unsigned char* rowp = YB + (size_t)pair * D + col0;
#pragma unroll
                    for (int bj = 0; bj < 2; ++bj) { const f32x4 v0 = (acc[ai][bj][m][0] * (1.0f / (W_SCALE * ACT_SCALE)) + bv[bj][0]) * wt, v1 = (acc[ai][bj][m][1] * (1.0f / (W_SCALE * ACT_SCALE)) + bv[bj][1]) * wt;
                        *(u32x2*)(rowp + bj * HALF) = (u32x2){pk4_fp8(v0[0], v0[1], v0[2], v0[3]), pk4_fp8(v1[0], v1[1], v1[2], v1[3])}; } } }
    }
};
}


typedef float f32x16 __attribute__((ext_vector_type(16)));
constexpr int AT_KS = 144, AT_VS = 584, AT_KOFF = 0, AT_VOFF = 288 * AT_KS;
__device__ __forceinline__ float bflo(unsigned w) { return __uint_as_float(w << 16); }
__device__ __forceinline__ float bfhi(unsigned w) { return __uint_as_float(w & 0xffff0000u); }

__device__ __forceinline__ void attn_tile(LAS unsigned char* lds, int slot_base, int kind, int j, int lane, int hq,
                                          const bf16x8 (&qf)[2][4], f32x16 (&oacc)[2][2], float (&mrow)[2], float (&lrow)[2]) {
    const int r31 = lane & 31, h = lane >> 5;
    bf16x8 kf[4], vf[2][2];
#pragma unroll
    for (int ks = 0; ks < 4; ++ks) kf[ks] = *(const LAS bf16x8*)(lds + AT_KOFF + (slot_base + r31) * AT_KS + (16 * ks + 8 * h) * 2);
#pragma unroll
    for (int dt = 0; dt < 2; ++dt)
#pragma unroll
        for (int sp = 0; sp < 2; ++sp) { const LAS unsigned char* p = lds + AT_VOFF + (32 * dt + r31) * AT_VS + (slot_base + 16 * sp + 4 * h) * 2;
            const u32x2 lo = *(const LAS u32x2*)p, hi = *(const LAS u32x2*)(p + 16);
            const u32x4 w = (u32x4){lo.x, lo.y, hi.x, hi.y}; vf[dt][sp] = __builtin_bit_cast(bf16x8, w); }
#pragma unroll
    for (int qt = 0; qt < 2; ++qt) {
        f32x16 s;
#pragma unroll
        for (int r = 0; r < 16; ++r) s[r] = 0.f;
#pragma unroll
        for (int ks = 0; ks < 4; ++ks) s = __builtin_amdgcn_mfma_f32_32x32x16_bf16(kf[ks], qf[qt][ks], s, 0, 0, 0);
        const int i = 64 * hq + 32 * qt + r31;
        float mx = -1.0e30f;
#pragma unroll
        for (int r = 0; r < 16; ++r) { const int key = (r & 3) + 8 * (r >> 2) + 4 * h;
            const bool ok = kind == 0 ? (key < 16) : (kind == 1 ? (32 * j + key >= i + 1) : (32 * j + key <= i));
            s[r] = ok ? s[r] : -1.0e30f; mx = fmaxf(mx, s[r]); }
        mx = fmaxf(mx, __shfl_xor(mx, 32));
        const float mn = fmaxf(mrow[qt], mx), al = __expf(mrow[qt] - mn); mrow[qt] = mn;
        float ps = 0.f;
#pragma unroll
        for (int r = 0; r < 16; ++r) { s[r] = __expf(s[r] - mn); ps += s[r]; }
        lrow[qt] = lrow[qt] * al + ps;
#pragma unroll
        for (int dt = 0; dt < 2; ++dt)
#pragma unroll
            for (int r = 0; r < 16; ++r) oacc[qt][dt][r] *= al;
        bf16x8 pf[2];
#pragma unroll
        for (int sp = 0; sp < 2; ++sp) { const u32x4 w = (u32x4){pk2(s[8 * sp + 0], s[8 * sp + 1]), pk2(s[8 * sp + 2], s[8 * sp + 3]), pk2(s[8 * sp + 4], s[8 * sp + 5]), pk2(s[8 * sp + 6], s[8 * sp + 7])};
            pf[sp] = __builtin_bit_cast(bf16x8, w); }
#pragma unroll
        for (int dt = 0; dt < 2; ++dt)
#pragma unroll
            for (int sp = 0; sp < 2; ++sp) oacc[qt][dt] = __builtin_amdgcn_mfma_f32_32x32x16_bf16(vf[dt][sp], pf[sp], oacc[qt][dt], 0, 0, 0);
    }
}

__device__ __forceinline__ void attn_item(const Args& a, LAS unsigned char* lds, int item, int tid, int lane, int wave) {
    const int kvh = item & 3, qblk = (item >> 2) & 15, b = item >> 6;
    const bf16* Z = (const bf16*)(a.ws + WS_Z); bf16* O = (bf16*)(a.ws + (G2_FP8 ? WS_ATT : WS_O)); constexpr int OLD = G2_FP8 ? 1024 : D;
    const float* cosT = (const float*)(a.ws + WS_COS); const float* sinT = (const float*)(a.ws + WS_SIN);
    __syncthreads();
    for (int task = tid; task < 288 * 4; task += 512) {
        const int slot = task >> 2, c = task & 3;
        int krow, kpos; bool valid;
        if (slot < 32) { valid = slot < NMETA; krow = METAROW0 + slot; kpos = slot; }
        else { const int sp = 128 * (qblk - 1) + (slot - 32); valid = sp >= 0; krow = b * SEQ + sp; kpos = NMETA + sp; }
        u32x4 lo = (u32x4){0u, 0u, 0u, 0u}, hi = lo;
        if (valid) {
            const bf16* kp = Z + (size_t)krow * DIN + ZK + kvh * 64 + c * 8;
            const u32x4 x1 = *(const u32x4*)kp, x2 = *(const u32x4*)(kp + 32);
            const f32x4 c0 = *(const f32x4*)(cosT + kpos * 32 + c * 8), c1 = *(const f32x4*)(cosT + kpos * 32 + c * 8 + 4);
            const f32x4 s0 = *(const f32x4*)(sinT + kpos * 32 + c * 8), s1 = *(const f32x4*)(sinT + kpos * 32 + c * 8 + 4);
#pragma unroll
            for (int q = 0; q < 4; ++q) { const float ca = q < 2 ? c0[2 * q] : c1[2 * q - 4], cb = q < 2 ? c0[2 * q + 1] : c1[2 * q - 3], sa = q < 2 ? s0[2 * q] : s1[2 * q - 4], sb = q < 2 ? s0[2 * q + 1] : s1[2 * q - 3];
                const float a0 = bflo(x1[q]), a1 = bfhi(x1[q]), b0 = bflo(x2[q]), b1 = bfhi(x2[q]);
                lo[q] = pk2(a0 * ca - b0 * sa, a1 * cb - b1 * sb); hi[q] = pk2(b0 * ca + a0 * sa, b1 * cb + a1 * sb); }
        }
        *(LAS u32x4*)(lds + AT_KOFF + slot * AT_KS + c * 16) = lo; *(LAS u32x4*)(lds + AT_KOFF + slot * AT_KS + 64 + c * 16) = hi;
    }
    for (int task = tid; task < 144 * 8; task += 512) {
        const int slot0 = (task >> 3) * 2, c = task & 7;
        int vrow; bool valid;
        if (slot0 < 32) { valid = slot0 < NMETA; vrow = METAROW0 + slot0; }
        else { const int sp = 128 * (qblk - 1) + (slot0 - 32); valid = sp >= 0; vrow = b * SEQ + sp; }
        u32x4 v0 = (u32x4){0u, 0u, 0u, 0u}, v1 = v0;
        if (valid) { const bf16* vp = Z + (size_t)vrow * DIN + ZV + kvh * 64 + c * 8; v0 = *(const u32x4*)vp; v1 = *(const u32x4*)(vp + DIN); }
#pragma unroll
        for (int q = 0; q < 4; ++q) {
            *(LAS unsigned*)(lds + AT_VOFF + (c * 8 + 2 * q) * AT_VS + slot0 * 2) = (v0[q] & 0xffffu) | (v1[q] << 16);
            *(LAS unsigned*)(lds + AT_VOFF + (c * 8 + 2 * q + 1) * AT_VS + slot0 * 2) = (v0[q] >> 16) | (v1[q] & 0xffff0000u); }
    }
    const int g = wave >> 1, hq = wave & 1, head = kvh * 4 + g, r31 = lane & 31, h = lane >> 5;
    bf16x8 qf[2][4];
#pragma unroll
    for (int qt = 0; qt < 2; ++qt) {
        const int s = 128 * qblk + 64 * hq + 32 * qt + r31, pos = NMETA + s;
        const bf16* qp = Z + (size_t)(b * SEQ + s) * DIN + ZQ + head * 64 + 8 * h;
        u32x4 x[4];
#pragma unroll
        for (int ks = 0; ks < 4; ++ks) x[ks] = *(const u32x4*)(qp + 16 * ks);
#pragma unroll
        for (int ks = 0; ks < 2; ++ks) {
            const float* cp = cosT + pos * 32 + 16 * ks + 8 * h; const float* sp = sinT + pos * 32 + 16 * ks + 8 * h;
            const f32x4 c0 = *(const f32x4*)cp, c1 = *(const f32x4*)(cp + 4), s0 = *(const f32x4*)sp, s1 = *(const f32x4*)(sp + 4);
            u32x4 lo, hi;
#pragma unroll
            for (int q = 0; q < 4; ++q) { const float ca = q < 2 ? c0[2 * q] : c1[2 * q - 4], cb = q < 2 ? c0[2 * q + 1] : c1[2 * q - 3], sa = q < 2 ? s0[2 * q] : s1[2 * q - 4], sb = q < 2 ? s0[2 * q + 1] : s1[2 * q - 3];
                const float a0 = bflo(x[ks][q]), a1 = bfhi(x[ks][q]), b0 = bflo(x[ks + 2][q]), b1 = bfhi(x[ks + 2][q]);
                lo[q] = pk2(0.125f * (a0 * ca - b0 * sa), 0.125f * (a1 * cb - b1 * sb)); hi[q] = pk2(0.125f * (b0 * ca + a0 * sa), 0.125f * (b1 * cb + a1 * sb)); }
            qf[qt][ks] = __builtin_bit_cast(bf16x8, lo); qf[qt][ks + 2] = __builtin_bit_cast(bf16x8, hi);
        }
    }
    f32x16 oacc[2][2]; float mrow[2], lrow[2];
#pragma unroll
    for (int qt = 0; qt < 2; ++qt) { mrow[qt] = a.in[I_SINKS][head]; lrow[qt] = h == 0 ? 1.0f : 0.0f;
#pragma unroll
        for (int dt = 0; dt < 2; ++dt)
#pragma unroll
            for (int r = 0; r < 16; ++r) oacc[qt][dt][r] = 0.f; }
    __syncthreads();
    attn_tile(lds, 0, 0, 0, lane, hq, qf, oacc, mrow, lrow);
    if (qblk > 0) {
#pragma unroll 1
        for (int j = hq ? 2 : 0; j < 4; ++j) attn_tile(lds, 32 + 32 * j, 1, j, lane, hq, qf, oacc, mrow, lrow);
    }
#pragma unroll 1
    for (int j = 0; j < (hq ? 4 : 2); ++j) attn_tile(lds, 160 + 32 * j, 2, j, lane, hq, qf, oacc, mrow, lrow);
#pragma unroll
    for (int qt = 0; qt < 2; ++qt) {
        const float lt = lrow[qt] + __shfl_xor(lrow[qt], 32), inv = 1.0f / lt;
        bf16* op = O + (size_t)(b * SEQ + 128 * qblk + 64 * hq + 32 * qt + r31) * OLD + head * 64 + 4 * h;
#pragma unroll
        for (int dt = 0; dt < 2; ++dt)
#pragma unroll
            for (int rr = 0; rr < 4; ++rr)
                *(u32x2*)(op + 32 * dt + 8 * rr) = (u32x2){pk2(oacc[qt][dt][4 * rr] * inv, oacc[qt][dt][4 * rr + 1] * inv), pk2(oacc[qt][dt][4 * rr + 2] * inv, oacc[qt][dt][4 * rr + 3] * inv)};
    }
}

constexpr int LR_XS = 2064;
__device__ __forceinline__ void lru_norm_rows(const Args& a, LAS unsigned char* lds, int b, int c, int lane, int wave) {
        bf16* O = (bf16*)(a.ws + WS_O); unsigned char* O8 = a.ws + WS_O;
        const bf16* ATT = (const bf16*)(a.ws + (G2_FP8 ? WS_ATT : WS_O)); constexpr int ALD = G2_FP8 ? 1024 : D;
        u32x4 aw[4][2];
#pragma unroll
        for (int q = 0; q < 4; ++q)
#pragma unroll
            for (int jj = 0; jj < 2; ++jj) aw[q][jj] = *(const u32x4*)(ATT + ((size_t)b * SEQ + 32 * c + 4 * wave + q) * ALD + (lane + 64 * jj) * 8);
        f32x4 ga[2][2], gl[2][2];
#pragma unroll
        for (int jj = 0; jj < 2; ++jj) { ga[jj][0] = *(const f32x4*)(a.in[I_G_ATTN] + (lane + 64 * jj) * 8); ga[jj][1] = *(const f32x4*)(a.in[I_G_ATTN] + (lane + 64 * jj) * 8 + 4);
            gl[jj][0] = *(const f32x4*)(a.in[I_G_LRU] + (lane + 64 * jj) * 8); gl[jj][1] = *(const f32x4*)(a.in[I_G_LRU] + (lane + 64 * jj) * 8 + 4); }
        __syncthreads();
#pragma unroll
        for (int q = 0; q < 4; ++q) {
            const int tl = 4 * wave + q; const size_t row = (size_t)b * SEQ + 32 * c + tl;
#pragma unroll
            for (int half = 0; half < 2; ++half) {
                u32x4 w[2]; float v[16]; float ss = 0.f;
#pragma unroll
                for (int jj = 0; jj < 2; ++jj) { w[jj] = half == 0 ? *(const LAS u32x4*)(lds + tl * LR_XS + (lane + 64 * jj) * 16) : aw[q][jj];
#pragma unroll
                    for (int k = 0; k < 4; ++k) { v[jj * 8 + 2 * k] = bflo(w[jj][k]); v[jj * 8 + 2 * k + 1] = bfhi(w[jj][k]); } }
#pragma unroll
                for (int k = 0; k < 16; ++k) ss += v[k] * v[k];
                ss = wave_sum(ss);
                const float rstd = (G2_FP8 ? XS_SCALE : 1.0f) * __builtin_amdgcn_rsqf(ss * (1.0f / 1024.0f) + EPS);
#pragma unroll
                for (int jj = 0; jj < 2; ++jj) { const f32x4 g0 = half == 0 ? gl[jj][0] : ga[jj][0], g1 = half == 0 ? gl[jj][1] : ga[jj][1];
                    const size_t col = (half == 0 ? 1024 : 0) + (lane + 64 * jj) * 8;
                    if (G2_FP8) *(u32x2*)(O8 + row * D + col) = (u32x2){pk4_fp8(v[jj * 8 + 0] * rstd * g0.x, v[jj * 8 + 1] * rstd * g0.y, v[jj * 8 + 2] * rstd * g0.z, v[jj * 8 + 3] * rstd * g0.w),
                                                                       pk4_fp8(v[jj * 8 + 4] * rstd * g1.x, v[jj * 8 + 5] * rstd * g1.y, v[jj * 8 + 6] * rstd * g1.z, v[jj * 8 + 7] * rstd * g1.w)};
                    else *(u32x4*)(O + row * D + col) = (u32x4){pk2(v[jj * 8 + 0] * rstd * g0.x, v[jj * 8 + 1] * rstd * g0.y), pk2(v[jj * 8 + 2] * rstd * g0.z, v[jj * 8 + 3] * rstd * g0.w),
                                                                pk2(v[jj * 8 + 4] * rstd * g1.x, v[jj * 8 + 5] * rstd * g1.y), pk2(v[jj * 8 + 6] * rstd * g1.z, v[jj * 8 + 7] * rstd * g1.w)}; }
            }
        }
}
template <int PASS>
__device__ __forceinline__ void lru_item(const Args& a, LAS unsigned char* lds, int item, int tid, int lane, int wave) {
    const int b = item / 65, c = item % 65; const bool meta = (c == 64);
    const bf16* Z = (const bf16*)(a.ws + WS_Z);
    float* sumA = (float*)(a.ws + WS_LRUSUM); float* sumB = sumA + NBATCH * 64 * DLRU; float* metaB = sumB + NBATCH * 64 * DLRU;
    __syncthreads();
    {
        const int ch0 = (tid & 127) * 8, tq = tid >> 7;
        f32x4 cw[4][2], cb[2];
#pragma unroll
        for (int jj = 0; jj < 4; ++jj) { cw[jj][0] = *(const f32x4*)(a.in[I_CONV_W] + jj * DLRU + ch0); cw[jj][1] = *(const f32x4*)(a.in[I_CONV_W] + jj * DLRU + ch0 + 4); }
        cb[0] = *(const f32x4*)(a.in[I_CONV_B] + ch0); cb[1] = *(const f32x4*)(a.in[I_CONV_B] + ch0 + 4);
#pragma unroll 1
        for (int i0 = 0; i0 < 8; i0 += 4) {
            u32x4 x[4][4];
#pragma unroll
            for (int i = 0; i < 4; ++i) { const int tl = tq + 4 * (i0 + i); const int t = meta ? tl : NMETA + 32 * c + tl;
#pragma unroll
                for (int jj = 0; jj < 4; ++jj) { const int tt = t - 3 + jj; x[i][jj] = (u32x4){0u, 0u, 0u, 0u};
                    if (tt >= 0 && !(meta && tl >= NMETA)) x[i][jj] = *(const u32x4*)(Z + (size_t)tok_row(b, tt) * DIN + ZX + ch0); } }
#pragma unroll
            for (int i = 0; i < 4; ++i) { const int tl = tq + 4 * (i0 + i); const int t = meta ? tl : NMETA + 32 * c + tl;
                f32x4 a0 = cb[0], a1 = cb[1];
#pragma unroll
                for (int jj = 0; jj < 4; ++jj) { const u32x4 xx = x[i][jj];
                    if (t - 3 + jj >= 0) {
                        a0.x += cw[jj][0].x * bflo(xx[0]); a0.y += cw[jj][0].y * bfhi(xx[0]); a0.z += cw[jj][0].z * bflo(xx[1]); a0.w += cw[jj][0].w * bfhi(xx[1]);
                        a1.x += cw[jj][1].x * bflo(xx[2]); a1.y += cw[jj][1].y * bfhi(xx[2]); a1.z += cw[jj][1].z * bflo(xx[3]); a1.w += cw[jj][1].w * bfhi(xx[3]); } }
                u32x4 o = (u32x4){pk2(a0.x, a0.y), pk2(a0.z, a0.w), pk2(a1.x, a1.y), pk2(a1.z, a1.w)};
                if (meta && tl >= NMETA) o = (u32x4){0u, 0u, 0u, 0u};
                *(LAS u32x4*)(lds + tl * LR_XS + ch0 * 2) = o; }
        }
    }
    LAS float* hinL = (LAS float*)(lds + 32 * LR_XS);
    if (PASS == 1) {
        float h0 = metaB[tid], h1 = metaB[tid + 512];
        const float* pa = sumA + (size_t)b * 64 * DLRU + tid; const float* pb = sumB + (size_t)b * 64 * DLRU + tid;
#pragma unroll 8
        for (int jc = 0; jc < c; ++jc) { h0 = pa[jc * DLRU] * h0 + pb[jc * DLRU]; h1 = pa[jc * DLRU + 512] * h1 + pb[jc * DLRU + 512]; }
        hinL[tid] = h0; hinL[tid + 512] = h1;
    }
    __syncthreads();
    const bf16* WaT = (const bf16*)(a.ws + WS_WAT); const bf16* WiT = (const bf16*)(a.ws + WS_WIT);
    const int r31 = lane & 31, h = lane >> 5;
    const int tau = 16 * ((r31 >> 2) & 1) + 4 * (r31 >> 3) + (r31 & 3);
#pragma unroll 1
    for (int nb = 0; nb < 2; ++nb) {
        const int n = 2 * wave + nb;
        bf16x8 af[4];
#pragma unroll
        for (int ks = 0; ks < 4; ++ks) af[ks] = *(const LAS bf16x8*)(lds + tau * LR_XS + (64 * n + 16 * ks + 8 * h) * 2);
#pragma unroll 1
        for (int nt = 0; nt < 2; ++nt) {
            const int ch = 64 * n + 32 * nt + r31;
            f32x16 accR, accI;
#pragma unroll
            for (int r = 0; r < 16; ++r) { accR[r] = 0.f; accI[r] = 0.f; }
#pragma unroll
            for (int ks = 0; ks < 4; ++ks) {
                const bf16x8 wa = *(const bf16x8*)(WaT + ((size_t)(n * 64 + 32 * nt + r31) * 64 + 16 * ks + 8 * h));
                const bf16x8 wi = *(const bf16x8*)(WiT + ((size_t)(n * 64 + 32 * nt + r31) * 64 + 16 * ks + 8 * h));
                accR = __builtin_amdgcn_mfma_f32_32x32x16_bf16(af[ks], wa, accR, 0, 0, 0);
                accI = __builtin_amdgcn_mfma_f32_32x32x16_bf16(af[ks], wi, accI, 0, 0, 0);
            }
            const float ba = a.in[I_B_A][ch], bi = a.in[I_B_I][ch], sp8 = -8.0f * 1.4426950408889634f * log1pf(__expf(-a.in[I_LAMBDA][ch]));
            float av[16], bv[16];
            float Ap = 1.0f, Bp = 0.0f;
#pragma unroll
            for (int r = 0; r < 16; ++r) {
                const float xcv = bf2f(*(const LAS unsigned short*)(lds + (16 * h + r) * LR_XS + ch * 2));
                const float rg = fast_sigmoid(accR[r] + ba), ig = fast_sigmoid(accI[r] + bi);
                const float l2a = sp8 * rg;
                av[r] = __builtin_amdgcn_exp2f(l2a); bv[r] = __builtin_amdgcn_sqrtf(fmaxf(fmaf(-av[r], av[r], 1.0f), 0.0f)) * ig * xcv;
                Ap *= av[r]; Bp = av[r] * Bp + bv[r];
                if (PASS == 0 && !meta) ((unsigned*)(a.ws + WS_AB))[((size_t)b * SEQ + 32 * c + 16 * h + r) * DLRU + ch] = pk2(l2a, bv[r]);
            }
            const float Ao = __shfl_xor(Ap, 32), Bo = __shfl_xor(Bp, 32);
            if (PASS == 0) {
                if (h == 0) {
                    if (meta) metaB[ch] = Bp;
                    else { sumA[((size_t)b * 64 + c) * DLRU + ch] = Ap * Ao; sumB[((size_t)b * 64 + c) * DLRU + ch] = Ao * Bp + Bo; }
                }
            } else {
                const float hin = hinL[ch];
                float hs = h == 0 ? hin : (Ao * hin + Bo);
#pragma unroll
                for (int r = 0; r < 16; ++r) {
                    hs = av[r] * hs + bv[r];
                    const int tl = 16 * h + r;
                    const float gt = bf2f(Z[(size_t)(b * SEQ + 32 * c + tl) * DIN + ZG + ch]);
                    *(LAS unsigned short*)(lds + tl * LR_XS + ch * 2) = (unsigned short)f2bf(hs * fast_gelu_tanh(gt));
                }
            }
        }
    }
}

__device__ __forceinline__ void lru_item_b(const Args& a, LAS unsigned char* lds, int item, int tid, int lane, int wave) {
    const int b = item >> 6, c = item & 63;
    const bf16* Z = (const bf16*)(a.ws + WS_Z); const unsigned* AB = (const unsigned*)(a.ws + WS_AB);
    const float* sumA = (const float*)(a.ws + WS_LRUSUM); const float* sumB = sumA + NBATCH * 64 * DLRU; const float* metaB = sumB + NBATCH * 64 * DLRU;
    const size_t row0 = (size_t)b * SEQ + 32 * c;
    u32x2 ab[32]; unsigned gt[32];
#pragma unroll
    for (int tl = 0; tl < 32; ++tl) { ab[tl] = *(const u32x2*)(AB + (row0 + tl) * DLRU + 2 * tid); gt[tl] = *(const unsigned*)(Z + (row0 + tl) * DIN + ZG + 2 * tid); }
    float h0, h1; { const f32x2 m = *(const f32x2*)(metaB + 2 * tid); h0 = m.x; h1 = m.y; }
    { const float* pa = sumA + (size_t)b * 64 * DLRU + 2 * tid; const float* pb = sumB + (size_t)b * 64 * DLRU + 2 * tid;
#pragma unroll 8
      for (int jc = 0; jc < c; ++jc) { const f32x2 A2 = *(const f32x2*)(pa + jc * DLRU), B2 = *(const f32x2*)(pb + jc * DLRU); h0 = A2.x * h0 + B2.x; h1 = A2.y * h1 + B2.y; } }
    __syncthreads();
#pragma unroll
    for (int tl = 0; tl < 32; ++tl) {
        h0 = __builtin_amdgcn_exp2f(bflo(ab[tl].x)) * h0 + bfhi(ab[tl].x);
        h1 = __builtin_amdgcn_exp2f(bflo(ab[tl].y)) * h1 + bfhi(ab[tl].y);
        *(LAS unsigned*)(lds + tl * LR_XS + 4 * tid) = pk2(h0 * fast_gelu_tanh(bflo(gt[tl])), h1 * fast_gelu_tanh(bfhi(gt[tl])));
    }
    lru_norm_rows(a, lds, b, c, lane, wave);
}

__device__ __forceinline__ void phase_router_mfma(const Args& a, LAS unsigned char* lds, int tid, int lane, int wave) {
    const bf16* H1 = (const bf16*)(a.ws + WS_H1); const bf16* WRT = (const bf16*)(a.ws + WS_WRT);
    int* tope = (int*)(a.ws + WS_TOPE); float* topw = (float*)(a.ws + WS_TOPW); float* rstd2 = (float*)(a.ws + WS_RSTD2);
    unsigned* counts = (unsigned*)(a.ws + WS_CTL) + CW_COUNTS;
    LAS float* lg = (LAS float*)(lds + wave * 2048);
    LAS int* hist = (LAS int*)(lds + 32768);
    if (tid < 32) hist[tid] = 0;
    __syncthreads();
    const int fr = lane & 15, fq = lane >> 4;
    for (int grp = wave * gridDim.x + blockIdx.x; grp < MREAL / 16; grp += 8 * gridDim.x) {
        const int row0 = grp * 16;
        const bf16* hp = H1 + (size_t)(row0 + fr) * D + 8 * fq;
        const bf16* wp = WRT + (size_t)fr * D + 8 * fq;
        f32x4 acc0 = (f32x4){0.f, 0.f, 0.f, 0.f}, acc1 = acc0; float ss = 0.f;
#pragma unroll 4
        for (int kk = 0; kk < 64; ++kk) {
            const u32x4 w = *(const u32x4*)(hp + 32 * kk);
#pragma unroll
            for (int q = 0; q < 4; ++q) { const float lo = bflo(w[q]), hi = bfhi(w[q]); ss += lo * lo + hi * hi; }
            const bf16x8 af = __builtin_bit_cast(bf16x8, w);
            const bf16x8 b0 = *(const bf16x8*)(wp + 32 * kk), b1 = *(const bf16x8*)(wp + (size_t)16 * D + 32 * kk);
            acc0 = __builtin_amdgcn_mfma_f32_16x16x32_bf16(af, b0, acc0, 0, 0, 0);
            acc1 = __builtin_amdgcn_mfma_f32_16x16x32_bf16(af, b1, acc1, 0, 0, 0);
        }
        ss += __shfl_xor(ss, 16); ss += __shfl_xor(ss, 32);
        const float rstd = 1.0f / sqrtf(ss * (1.0f / D) + EPS);
        if (fq == 0) rstd2[row0 + fr] = rstd;
        const float br0 = a.in[I_B_ROUTER][fr], br1 = a.in[I_B_ROUTER][16 + fr];
#pragma unroll
        for (int j = 0; j < 4; ++j) { const int row = 4 * fq + j; const float rs = __shfl(rstd, row);
            lg[row * 32 + fr] = acc0[j] * rs + br0; lg[row * 32 + 16 + fr] = acc1[j] * rs + br1; }
        asm volatile("s_waitcnt lgkmcnt(0)" ::: "memory");
        if (lane < 16) {
            float v[32];
#pragma unroll
            for (int q = 0; q < 8; ++q) { const f32x4 t = *(const LAS f32x4*)(lg + lane * 32 + 4 * q); v[4 * q] = t.x; v[4 * q + 1] = t.y; v[4 * q + 2] = t.z; v[4 * q + 3] = t.w; }
            float tv[4]; int te[4];
#pragma unroll
            for (int r = 0; r < 4; ++r) { float best = -3.0e38f; int bi = 0;
#pragma unroll
                for (int e = 0; e < 32; ++e) { const bool gtb = v[e] > best; best = gtb ? v[e] : best; bi = gtb ? e : bi; }
#pragma unroll
                for (int e = 0; e < 32; ++e) v[e] = (e == bi) ? -3.0e38f : v[e];
                tv[r] = best; te[r] = bi; }
            const float e1 = __expf(tv[1] - tv[0]), e2 = __expf(tv[2] - tv[0]), e3 = __expf(tv[3] - tv[0]);
            const float inv = 1.0f / (1.0f + e1 + e2 + e3);
            const int row = row0 + lane;
            *(int4*)(tope + row * 4) = make_int4(te[0], te[1], te[2], te[3]);
            *(f32x4*)(topw + row * 4) = (f32x4){inv, e1 * inv, e2 * inv, e3 * inv};
#pragma unroll
            for (int r = 0; r < 4; ++r) atomicAdd((int*)&hist[te[r]], 1);
        }
        asm volatile("s_waitcnt lgkmcnt(0)" ::: "memory");
    }
    __syncthreads();
    if (tid < 32 && hist[tid] != 0) atomicAdd(&counts[tid], (unsigned)hist[tid]);
}

__device__ __forceinline__ void build_tile_table(const Args& a, LAS int* tstart, int tid) {
    if (tid == 0) {
        const unsigned* counts = (const unsigned*)(a.ws + WS_CTL) + CW_COUNTS;
        int acc = 0;
        for (int e = 0; e < NEXP; ++e) { tstart[e] = acc; acc += (int)((__hip_atomic_load(counts + e, __ATOMIC_RELAXED, __HIP_MEMORY_SCOPE_AGENT) + 255u) >> 8); }
        tstart[NEXP] = acc;
    }
    __syncthreads();
}
__device__ __forceinline__ int tile_expert(const LAS int* tstart, int tile) {
    int e = 0;
#pragma unroll 1
    for (int i = 1; i < NEXP; ++i) e += (tstart[i] <= tile) ? 1 : 0;
    return e;
}

__device__ __forceinline__ void phase_assign(const Args& a, LAS unsigned char* lds, int tid, int lane, int wave) {
    LAS int* tstart = (LAS int*)(lds + LDS_TAB);
    LAS int* hist = tstart + 64; LAS int* base = hist + 32; LAS int* spos = base + 32;
    build_tile_table(a, tstart, tid);
    const int* tope = (const int*)(a.ws + WS_TOPE); const float* topw = (const float*)(a.ws + WS_TOPW); const float* rstd2 = (const float*)(a.ws + WS_RSTD2);
    int* rowpair = (int*)(a.ws + WS_ROWPAIR); float* roww = (float*)(a.ws + WS_ROWW);
    unsigned* cursor = (unsigned*)(a.ws + WS_CTL) + CW_CURSOR;
    const bf16* H1 = (const bf16*)(a.ws + WS_H1); unsigned char* XS = (unsigned char*)(a.ws + WS_XS);
    for (int blk = blockIdx.x; blk < MREAL / 64; blk += gridDim.x) {
        if (tid < 32) hist[tid] = 0;
        __syncthreads();
        int e = 0, rank = 0, pair = 0;
        if (tid < 256) { pair = blk * 256 + tid; e = tope[pair]; rank = atomicAdd((int*)&hist[e], 1); }
        __syncthreads();
        if (tid < 32) base[tid] = (int)atomicAdd(&cursor[tid], (unsigned)hist[tid]);
        __syncthreads();
        if (tid < 256) { const int pos = tstart[e] * 256 + base[e] + rank; spos[tid] = pos; rowpair[pos] = pair; roww[pos] = topw[pair]; }
        __syncthreads();
        for (int tt = wave * 8; tt < wave * 8 + 8; ++tt) {
            const int token = blk * 64 + tt; const float rstd = rstd2[token] * XS_SCALE;
            const u32x4* hr = (const u32x4*)(H1 + (size_t)token * D);
            u32x2 o[4];
#pragma unroll
            for (int j = 0; j < 4; ++j) { const u32x4 hv = hr[lane + 64 * j];
                const f32x4 g0 = ((const f32x4*)a.in[I_NORM_FFN])[2 * (lane + 64 * j)], g1 = ((const f32x4*)a.in[I_NORM_FFN])[2 * (lane + 64 * j) + 1];
                o[j] = (u32x2){pk4_fp8(bflo(hv[0]) * rstd * g0.x, bfhi(hv[0]) * rstd * g0.y, bflo(hv[1]) * rstd * g0.z, bfhi(hv[1]) * rstd * g0.w),
                               pk4_fp8(bflo(hv[2]) * rstd * g1.x, bfhi(hv[2]) * rstd * g1.y, bflo(hv[3]) * rstd * g1.z, bfhi(hv[3]) * rstd * g1.w)}; }
#pragma unroll
            for (int k = 0; k < 4; ++k) { u32x2* dst = (u32x2*)(XS + (size_t)spos[tt * 4 + k] * D);
#pragma unroll
                for (int j = 0; j < 4; ++j) dst[lane + 64 * j] = o[j]; }
        }
        __syncthreads();
    }
}

__device__ __forceinline__ void phase_final(const Args& a, int lane, int wave) {
    const int gw = blockIdx.x * 8 + wave, NGW = gridDim.x * 8;
    const bf16* H1 = (const bf16*)(a.ws + WS_H1); const unsigned char* YB = a.ws + WS_YB;
    for (int row = gw; row < MREAL; row += NGW) {
        f32x4 v[8]; unsigned y[4][8]; float ss = 0.f;
#pragma unroll
        for (int k = 0; k < 4; ++k)
#pragma unroll
            for (int j = 0; j < 8; ++j) y[k][j] = ((const unsigned*)(YB + ((size_t)row * 4 + k) * D))[lane + 64 * j];
#pragma unroll
        for (int j = 0; j < 8; ++j) { { const u32x2 hh = ((const u32x2*)(H1 + (size_t)row * D))[lane + 64 * j]; v[j] = (f32x4){bflo(hh.x), bfhi(hh.x), bflo(hh.y), bfhi(hh.y)}; }
            f32x4 s = (f32x4){0.f, 0.f, 0.f, 0.f};
#pragma unroll
            for (int k = 0; k < 4; ++k) { const f32x2 lo = __builtin_amdgcn_cvt_pk_f32_fp8((int)y[k][j], false), hi = __builtin_amdgcn_cvt_pk_f32_fp8((int)y[k][j], true);
                s.x += lo.x; s.y += lo.y; s.z += hi.x; s.w += hi.y; }
            v[j] = v[j] + s * (1.0f / YB_SCALE);
            ss += (v[j].x * v[j].x + v[j].y * v[j].y) + (v[j].z * v[j].z + v[j].w * v[j].w); }
        ss = wave_sum(ss);
        const float rstd = 1.0f / sqrtf(ss * (1.0f / D) + EPS);
        f32x4* op = (f32x4*)(a.out + (size_t)row * D);
#pragma unroll
        for (int j = 0; j < 8; ++j) { const f32x4 g = ((const f32x4*)a.in[I_FINAL_NORM])[lane + 64 * j]; op[lane + 64 * j] = v[j] * rstd * g; }
    }
}

enum { PH_PROLOGUE = 0, PH_G1, PH_ATTN, PH_LRU_B, PH_G2, PH_ROUTER, PH_ASSIGN, PH_G3, PH_G4, PH_FINAL, PH_COUNT };

__global__ void __launch_bounds__(512, 2) fwd(Args a) {
    extern __shared__ __attribute__((aligned(16))) unsigned char lds_raw[];
    LAS unsigned char* lds = (LAS unsigned char*)lds_raw;
    const int tid = threadIdx.x, lane = tid & 63, wave = __builtin_amdgcn_readfirstlane(tid >> 6);
    const int gw = blockIdx.x * 8 + wave, NGW = gridDim.x * 8;
    unsigned char* ws = a.ws;
#define IN(k) (a.ph_lo <= (k) && (k) < a.ph_hi)
    pg8::BGNone nobg;
    pg8::BGConv bgup{(const char*)a.in[I_W_UP], ws + WS_WUT, (int)blockIdx.x * 128, (int)blockIdx.x * 128 + 80, ws + WS_DUMMY};
#define SEAM(k) do { if (IN(k) && IN((k) + 1)) xcd_barrier(bar); } while (0)
    if (tid < 4) ((LAS unsigned*)(lds + LDS_MISC))[tid] = 0u;
    __syncthreads();
    XcdBarrier bar; bar.bar = (unsigned*)(ws + WS_CTL) + CW_BAR; bar.x = 0; bar.st = nullptr;
    if (a.ph_hi - a.ph_lo > 1) bar = xcd_barrier_post((unsigned*)(ws + WS_CTL) + CW_BAR, (volatile LAS unsigned*)(lds + LDS_MISC));

    if (IN(PH_PROLOGUE)) { phase_prologue(a, lds, tid, lane, wave);
#if PROBE_REPEAT == 0
        __syncthreads(); phase_prologue(a, lds, tid, lane, wave);
#endif
    }
    SEAM(PH_PROLOGUE);

    if (IN(PH_G1)) {
        pg8::SchedDense S{(const char*)(ws + WS_N1), (const char*)(ws + WS_WINT), MROWS / 256, DIN / 256, (int)gridDim.x, (int)blockIdx.x, G1_FP8 ? 2048 : 4096};
        pg8::EpiZ E{(bf16*)(ws + WS_Z), a.in[I_B_IN], G1_FP8 ? 1.0f / (W_SCALE * XS_SCALE) : 1.0f};
#if BG_WUP
        pg8::gemm_phase<G1_FP8 != 0>(lds, S, E, bgup);
#else
        pg8::gemm_phase<G1_FP8 != 0>(lds, S, E, nobg);
#endif
#if PROBE_REPEAT == 1
        __syncthreads(); pg8::gemm_phase<G1_FP8 != 0>(lds, S, E, nobg);
#endif
    }
    SEAM(PH_G1);
    if (IN(PH_ATTN)) {
        for (int it = blockIdx.x; it < NBATCH * 16 * 4; it += gridDim.x) attn_item(a, lds, it, tid, lane, wave);
        for (int it = blockIdx.x; it < NBATCH * 65; it += gridDim.x) { if (it % 65 == 64 && it != 64) continue; lru_item<0>(a, lds, it, tid, lane, wave); }
#if PROBE_REPEAT == 2
        for (int it = blockIdx.x; it < NBATCH * 16 * 4; it += gridDim.x) attn_item(a, lds, it, tid, lane, wave);
#endif
#if PROBE_REPEAT == 3
        for (int it = blockIdx.x; it < NBATCH * 65; it += gridDim.x) { if (it % 65 == 64 && it != 64) continue; lru_item<0>(a, lds, it, tid, lane, wave); }
#endif
    }
    SEAM(PH_ATTN);
    if (IN(PH_LRU_B)) {
        for (int it = blockIdx.x; it < NBATCH * 64; it += gridDim.x) lru_item_b(a, lds, it, tid, lane, wave);
    }
    SEAM(PH_LRU_B);
    if (IN(PH_G2)) {
        pg8::SchedDense S{(const char*)(ws + WS_O), (const char*)(ws + WS_WOUTT), MREAL / 256, D / 256, (int)gridDim.x, (int)blockIdx.x, G2_FP8 ? 2048 : 4096};
        pg8::EpiH1 E{(bf16*)(ws + WS_H1), a.in[I_X], a.in[I_B_OUT], G2_FP8 ? 1.0f / (W_SCALE * XS_SCALE) : 1.0f};
#if BG_WUP
        pg8::gemm_phase<G2_FP8 != 0>(lds, S, E, bgup);
        for (int pair = bgup.next < bgup.end ? bgup.next : bgup.end; pair < bgup.end; ++pair) { const char* sp; unsigned char* dp; pg8::bg_pair_ptrs(bgup, pair, sp, dp);
            const int n = tid >> 4, c = tid & 15; const float* p = (const float*)sp + (size_t)(8 * c) * 2048 + n;
            *(u32x2*)(dp + (size_t)n * 2048 + 8 * c) = (u32x2){pk4_fp8(p[0] * W_SCALE, p[2048] * W_SCALE, p[4096] * W_SCALE, p[6144] * W_SCALE), pk4_fp8(p[8192] * W_SCALE, p[10240] * W_SCALE, p[12288] * W_SCALE, p[14336] * W_SCALE)}; }
#else
        pg8::gemm_phase<G2_FP8 != 0>(lds, S, E, nobg);
#endif
#if PROBE_REPEAT == 4
        __syncthreads(); pg8::gemm_phase<G2_FP8 != 0>(lds, S, E, nobg);
#endif
    }
    SEAM(PH_G2);
    if (IN(PH_ROUTER)) phase_router_mfma(a, lds, tid, lane, wave);
    SEAM(PH_ROUTER);
    if (IN(PH_ASSIGN)) phase_assign(a, lds, tid, lane, wave);
    SEAM(PH_ASSIGN);
    if (IN(PH_G3)) {
        LAS int* tstart = (LAS int*)(lds + LDS_TAB);
        build_tile_table(a, tstart, tid);
        pg8::SchedMoE S{(const char*)(ws + WS_XS), (const char*)(ws + WS_WGT), (const char*)(ws + WS_WUT), tstart, tstart[NEXP], DFF / 128, (int)gridDim.x, (int)blockIdx.x, true};
        pg8::EpiAct E{(unsigned char*)(ws + WS_ACT), a.in[I_B_GATE], a.in[I_B_UP]};
#if BG_WDOWN
        pg8::BGConv bg{(const char*)a.in[I_W_DOWN], ws + WS_WDT, (int)blockIdx.x * (32768 / 256), ((int)blockIdx.x + 1) * (32768 / 256), ws + WS_DUMMY};
        if (gridDim.x != 256) { bg.next = (int)((long)blockIdx.x * 32768 / gridDim.x); bg.end = (int)((long)(blockIdx.x + 1) * 32768 / gridDim.x); }
        pg8::gemm_phase<true>(lds, S, E, bg);
        for (int pair = bg.next < bg.end ? bg.next : bg.end; pair < bg.end; ++pair) { const char* sp; unsigned char* dp; pg8::bg_pair_ptrs(bg, pair, sp, dp);
            const int n = tid >> 4, c = tid & 15;
            const float* p = (const float*)sp + (size_t)(8 * c) * 2048 + n;
            *(u32x2*)(dp + (size_t)n * 2048 + 8 * c) = (u32x2){pk4_fp8(p[0] * W_SCALE, p[2048] * W_SCALE, p[4096] * W_SCALE, p[6144] * W_SCALE), pk4_fp8(p[8192] * W_SCALE, p[10240] * W_SCALE, p[12288] * W_SCALE, p[14336] * W_SCALE)}; }
#else
        pg8::gemm_phase<true>(lds, S, E, nobg);
#endif
#if PROBE_REPEAT == 7
        __syncthreads(); pg8::gemm_phase<true>(lds, S, E, nobg);
#endif
    }
    SEAM(PH_G3);
    if (IN(PH_G4)) {
        LAS int* tstart = (LAS int*)(lds + LDS_TAB);
        build_tile_table(a, tstart, tid);
        pg8::SchedMoE S{(const char*)(ws + WS_ACT), (const char*)(ws + WS_WDT), (const char*)(ws + WS_WDT), tstart, tstart[NEXP], D / 256, (int)gridDim.x, (int)blockIdx.x, false};
        pg8::EpiDown E{ws + WS_YB, a.in[I_B_DOWN], (const int*)(ws + WS_ROWPAIR), (const float*)(ws + WS_ROWW)};
        pg8::gemm_phase<true>(lds, S, E, nobg);
#if PROBE_REPEAT == 8
        __syncthreads(); pg8::gemm_phase<true>(lds, S, E, nobg);
#endif
    }
    SEAM(PH_G4);
    if (IN(PH_FINAL)) { phase_final(a, lane, wave);
#if PROBE_REPEAT == 9
        phase_final(a, lane, wave);
#endif
    }
#undef IN
#undef SEAM
}

extern "C" void kernel_launch(void* const* d_in, const int* in_sizes, int n_in, void* d_out, int out_size, void* d_ws, size_t ws_size, hipStream_t stream) {
    static int grid = 0;
    if (grid == 0) {
        if (n_in != 27 || out_size != MREAL * D || ws_size < WS_END) { fprintf(stderr, "kernel_launch: unexpected problem (n_in %d, out %d, ws %zu)\n", n_in, out_size, ws_size); grid = -1; return; }
        int dev = 0, cus = 0;
        if (hipGetDevice(&dev) != hipSuccess || hipDeviceGetAttribute(&cus, hipDeviceAttributeMultiprocessorCount, dev) != hipSuccess) { grid = -1; return; }
        if (hipFuncSetAttribute((const void*)fwd, hipFuncAttributeMaxDynamicSharedMemorySize, LDS_BYTES) != hipSuccess) { fprintf(stderr, "kernel_launch: hipFuncSetAttribute failed\n"); grid = -1; return; }
        grid = cus;
    }
    if (grid < 0) return;
    (void)hipMemsetAsync((char*)d_ws + WS_CTL, 0, CTL_BYTES, stream);
    Args a{};
    for (int i = 0; i < 27; ++i) a.in[i] = (const float*)d_in[i];
    a.out = (float*)d_out; a.ws = (unsigned char*)d_ws;
#if MK_ONE_LAUNCH
    a.ph_lo = 0; a.ph_hi = PH_COUNT;
    hipLaunchKernelGGL(fwd, dim3(grid), dim3(512), LDS_BYTES, stream, a);
#else
    for (int ph = 0; ph < PH_COUNT; ++ph) {
        a.ph_lo = ph; a.ph_hi = ph + 1;
        hipLaunchKernelGGL(fwd, dim3(grid), dim3(512), LDS_BYTES, stream, a);
    }
#endif
}
```

```cpp
#include <hip/hip_runtime.h>
#include <cstdio>
#include <cstdint>

#define LAS __attribute__((address_space(3)))
#ifndef PROBE_REPEAT
#define PROBE_REPEAT -1
#endif
#ifndef G1_FP8
#define G1_FP8 0
#endif
#ifndef G2_FP8
#define G2_FP8 0
#endif
#ifndef BG_WDOWN
#define BG_WDOWN 1
#endif
#ifndef BG_WUP
#define BG_WUP 0
#endif
#ifndef BG_EXP
#define BG_EXP 0
#endif
#ifndef MK_ONE_LAUNCH
#define MK_ONE_LAUNCH 1
#endif
typedef unsigned short bf16;
typedef float f32x4 __attribute__((ext_vector_type(4)));
typedef float f32x2 __attribute__((ext_vector_type(2)));
typedef short bf16x8 __attribute__((ext_vector_type(8)));
typedef unsigned u32x4 __attribute__((ext_vector_type(4)));
typedef unsigned u32x2 __attribute__((ext_vector_type(2)));

constexpr int D = 2048, SEQ = 2048, NMETA = 16, TT = 2064, NBATCH = 8;
constexpr int MREAL = 16384, METAROW0 = 16384, MVALID = 16400, MROWS = 16640;
constexpr int DIN = 3584, DLRU = 1024, HD = 64;
constexpr int ZQ = 0, ZK = 1024, ZV = 1280, ZX = 1536, ZG = 2560;
constexpr int NEXP = 32, DFF = 2048, PROWS = 73728;
constexpr float EPS = 1e-5f;

constexpr size_t MiB = 1u << 20;
constexpr size_t WS_CTL = 0, CTL_BYTES = 1 * MiB;
constexpr size_t WS_COS = 1 * MiB, WS_SIN = 1 * MiB + 320 * 1024;
constexpr size_t WS_TOPE = 2 * MiB, WS_TOPW = WS_TOPE + 256 * 1024, WS_RSTD2 = WS_TOPW + 256 * 1024, WS_ROWPAIR = WS_RSTD2 + 64 * 1024, WS_ROWW = WS_ROWPAIR + 320 * 1024;
constexpr size_t WS_PAIRPOS = 3 * MiB + 256 * 1024;
constexpr size_t WS_DUMMY = 3 * MiB + 512 * 1024;
constexpr size_t WS_LRUSUM = 4 * MiB;
constexpr size_t WS_WAT = 9 * MiB, WS_WIT = WS_WAT + 128 * 1024, WS_WRT = WS_WIT + 128 * 1024;
constexpr size_t WS_WINT = 10 * MiB, WS_WOUTT = 24 * MiB, WS_WGT = 32 * MiB, WS_WUT = 288 * MiB, WS_WDT = 544 * MiB;
constexpr size_t WS_N1 = 800 * MiB, WS_Z = 866 * MiB, WS_O = 980 * MiB, WS_H1 = 1044 * MiB, WS_XS = 1172 * MiB, WS_YB = WS_XS, WS_ACT = 1460 * MiB, WS_END = 1748 * MiB;
constexpr size_t WS_AB = WS_XS;
constexpr size_t WS_ATT = WS_N1;
constexpr size_t WS_XC = WS_XS, WS_AA = WS_XS + 66 * MiB, WS_BB = WS_XS + 132 * MiB, WS_YL = WS_XS + 198 * MiB;
static_assert(WS_ROWW + PROWS * 4 <= WS_LRUSUM, "small map");
constexpr int CW_COUNTS = 1024, CW_CURSOR = 1088, CW_BAR = 4096;

constexpr int LDS_TAB = 131072;
constexpr int LDS_META = LDS_TAB + 1024;
constexpr int LDS_MISC = LDS_TAB + 8192;
constexpr int LDS_BG = LDS_MISC + 1024;
constexpr int LDS_T2 = LDS_BG + 16384;
constexpr int LDS_BYTES = LDS_T2 + 4352;
static_assert(LDS_BYTES <= 163840 && LDS_BG % 1024 == 0, "LDS map");

__device__ const float c_inv_freq[32] = {1.000000000e+00f, 7.498942018e-01f, 5.623413324e-01f, 4.216965139e-01f, 3.162277639e-01f, 2.371373922e-01f, 1.778279394e-01f, 1.333521456e-01f, 1.000000015e-01f, 7.498941571e-02f, 5.623412877e-02f, 4.216964915e-02f, 3.162277862e-02f, 2.371373586e-02f, 1.778279431e-02f, 1.333521493e-02f, 9.999999776e-03f, 7.498942316e-03f, 5.623413250e-03f, 4.216964822e-03f, 3.162277862e-03f, 2.371373819e-03f, 1.778279431e-03f, 1.333521446e-03f, 1.000000047e-03f, 7.498941850e-04f, 5.623413017e-04f, 4.216965463e-04f, 3.162277862e-04f, 2.371373848e-04f, 1.778279402e-04f, 1.333521504e-04f};

struct Args { const float* in[27]; float* out; unsigned char* ws; int ph_lo, ph_hi; };
enum { I_X = 0, I_META, I_NORM_MIX, I_W_IN, I_B_IN, I_SINKS, I_CONV_W, I_CONV_B, I_W_A, I_B_A, I_W_I, I_B_I, I_LAMBDA, I_G_ATTN, I_G_LRU, I_W_OUT, I_B_OUT, I_NORM_FFN,
       I_W_ROUTER, I_B_ROUTER, I_W_GATE, I_B_GATE, I_W_UP, I_B_UP, I_W_DOWN, I_B_DOWN, I_FINAL_NORM };


#define XB_TMO      128
#define XB_XCNT(j)  (256  + 64 * (j))
#define XB_XSUB(j)  (1280 + 64 * (j))
#define XB_XGEN(j)  (2304 + 64 * (j))
#define XB_TOP      3328
#define XB_TOPGEN   3392
#define XCD_BAR_WORDS 3456
#define XB_SPIN_CAP (1u << 18)

__device__ __forceinline__ unsigned xb_ld(unsigned* p)              { return __hip_atomic_load(p, __ATOMIC_RELAXED, __HIP_MEMORY_SCOPE_AGENT); }
__device__ __forceinline__ unsigned xb_add(unsigned* p, unsigned v) { return __hip_atomic_fetch_add(p, v, __ATOMIC_RELAXED, __HIP_MEMORY_SCOPE_AGENT); }
__device__ __forceinline__ unsigned xb_xcc_id() { return (unsigned)__builtin_amdgcn_s_getreg((3 << 11) | 20) & 0xFu; }
#define XB_SPIN(cond, bar) do { unsigned _sp = 0; while (cond) { __builtin_amdgcn_s_sleep(1); \
    if ((++_sp & 255u) == 0u) { if (xb_ld(&(bar)[XB_TMO])) break; if (_sp > XB_SPIN_CAP) { atomicAdd(&(bar)[XB_TMO], 1u); break; } } } } while (0)

struct XcdBarrier {
    unsigned* bar; unsigned x;
    volatile LAS unsigned* st;
};

__device__ __forceinline__ XcdBarrier xcd_barrier_post(unsigned* bar, volatile LAS unsigned* st) {
    XcdBarrier b; b.bar = bar; b.x = xb_xcc_id(); b.st = st;
    if (threadIdx.x == 0) (void)xb_add(&bar[XB_XCNT(b.x)], 1u);
    return b;
}
__device__ __forceinline__ void xcd_barrier_complete(unsigned* bar, unsigned x, unsigned& nloc, unsigned& nx) {
    const unsigned G = gridDim.x * gridDim.y * gridDim.z;
    unsigned sum, cnt, mine, sp = 0u;
    for (;;) {
        sum = 0u; cnt = 0u; mine = 0u;
#pragma unroll
        for (unsigned j = 0; j < 16; ++j) { const unsigned c = xb_ld(&bar[XB_XCNT(j)]); sum += c; cnt += (c > 0u) ? 1u : 0u; mine = (j == x) ? c : mine; }
        if (sum == G) break;
        __builtin_amdgcn_s_sleep(1);
        if ((++sp & 255u) == 0u) { if (xb_ld(&bar[XB_TMO])) break; if (sp > XB_SPIN_CAP) { atomicAdd(&bar[XB_TMO], 1u); break; } }
    }
    nloc = mine > 0u ? mine : 1u; nx = cnt > 0u ? cnt : 1u;
}

__device__ __forceinline__ void xcd_barrier(const XcdBarrier& b) {
    asm volatile("s_waitcnt vmcnt(0)" ::: "memory");
    __syncthreads();
    if (threadIdx.x == 0) {
        unsigned* bar = b.bar;
        __builtin_amdgcn_s_waitcnt(0);
        unsigned nloc = b.st[0], nx = b.st[1];
        if (nloc == 0u) { xcd_barrier_complete(bar, b.x, nloc, nx); b.st[0] = nloc; b.st[1] = nx; }
        const unsigned old = xb_add(&bar[XB_XSUB(b.x)], 1u);
        const unsigned gen = old / nloc;
        if (old + 1u == (gen + 1u) * nloc) {
            __builtin_amdgcn_fence(__ATOMIC_RELEASE, "agent");
            asm volatile("s_waitcnt vmcnt(0)" ::: "memory");
            const unsigned og = xb_add(&bar[XB_TOP], 1u);
            const unsigned tg = og / nx;
            if (og + 1u == (tg + 1u) * nx) xb_add(&bar[XB_TOPGEN], 1u);
            else XB_SPIN(xb_ld(&bar[XB_TOPGEN]) == tg, bar);
            __builtin_amdgcn_fence(__ATOMIC_ACQUIRE, "agent");
            xb_add(&bar[XB_XGEN(b.x)], 1u);
            asm volatile("s_waitcnt vmcnt(0)" ::: "memory");
        } else {
            XB_SPIN(xb_ld(&bar[XB_XGEN(b.x)]) == gen, bar);
            __builtin_amdgcn_fence(__ATOMIC_ACQUIRE, "agent");
            asm volatile("s_waitcnt vmcnt(0)" ::: "memory");
        }
    }
    __syncthreads();
}

__device__ __forceinline__ float bf2f(unsigned b) { return __uint_as_float((b & 0xffffu) << 16); }
__device__ __forceinline__ unsigned f2bf(float f) { unsigned u = __float_as_uint(f); return (u + 0x7fffu + ((u >> 16) & 1u)) >> 16; }
__device__ __forceinline__ unsigned pk2(float lo, float hi) { return f2bf(lo) | (f2bf(hi) << 16); }
constexpr float W_SCALE = 256.0f, XS_SCALE = 8.0f, ACT_SCALE = 4.0f, YB_SCALE = 16.0f;
__device__ __forceinline__ float clamp_fp8(float x) { return __builtin_amdgcn_fmed3f(x, -448.0f, 448.0f); }
__device__ __forceinline__ unsigned pk4_fp8(float a, float b, float c, float d) {
    int w = 0; w = __builtin_amdgcn_cvt_pk_fp8_f32(clamp_fp8(a), clamp_fp8(b), w, false); w = __builtin_amdgcn_cvt_pk_fp8_f32(clamp_fp8(c), clamp_fp8(d), w, true); return (unsigned)w; }
__device__ __forceinline__ float wave_sum(float v) {
#pragma unroll
    for (int o = 1; o < 64; o <<= 1) v += __shfl_xor(v, o);
    return v;
}
__device__ __forceinline__ float wave_max(float v) {
#pragma unroll
    for (int o = 1; o < 64; o <<= 1) v = fmaxf(v, __shfl_xor(v, o));
    return v;
}
__device__ __forceinline__ float sigmoidf_(float x) { return 1.0f / (1.0f + __expf(-x)); }
__device__ __forceinline__ float fast_sigmoid(float x) { return __builtin_amdgcn_rcpf(1.0f + __builtin_amdgcn_exp2f(-1.4426950408889634f * x)); }
__device__ __forceinline__ float fast_gelu_tanh(float x) { const float u2 = 1.5957691216057308f * (x + 0.044715f * x * x * x); return x * __builtin_amdgcn_rcpf(1.0f + __builtin_amdgcn_exp2f(-1.4426950408889634f * u2)); }
__device__ __forceinline__ float gelu_tanh(float x) { const float u = 0.7978845608028654f * (x + 0.044715f * x * x * x); return 0.5f * x * (1.0f + tanhf(u)); }
__device__ __forceinline__ int tok_row(int b, int t) { return t < NMETA ? METAROW0 + t : b * SEQ + (t - NMETA); }

__device__ __forceinline__ void transpose_item(const float* W, int K, int N, bf16* WT, LAS float* scr, int item, int lane) {
    const int nblk = N / 32, kb = item / nblk, nb = item % nblk, k0 = 64 * kb, n0 = 32 * nb;
#pragma unroll 8
    for (int i = 0; i < 32; ++i) { const int kk = 2 * i + (lane >> 5); scr[kk * 33 + (lane & 31)] = W[(size_t)(k0 + kk) * N + n0 + (lane & 31)]; }
    asm volatile("s_waitcnt lgkmcnt(0)" ::: "memory");
    const int c = lane & 7;
#pragma unroll
    for (int j = 0; j < 4; ++j) { const int n = (lane >> 3) + 8 * j; const LAS float* s = scr + (8 * c) * 33 + n;
        u32x4 o; o.x = pk2(s[0 * 33], s[1 * 33]); o.y = pk2(s[2 * 33], s[3 * 33]); o.z = pk2(s[4 * 33], s[5 * 33]); o.w = pk2(s[6 * 33], s[7 * 33]);
        *(u32x4*)(WT + (size_t)(n0 + n) * K + k0 + 8 * c) = o; }
    asm volatile("s_waitcnt lgkmcnt(0)" ::: "memory");
}

__device__ __forceinline__ void phase_prologue(const Args& a, LAS unsigned char* lds, int tid, int lane, int wave) {
    const int gw = blockIdx.x * 8 + wave, NGW = gridDim.x * 8;
    const int gt = blockIdx.x * 512 + tid, NGT = gridDim.x * 512;
    unsigned char* ws = a.ws;
    LAS float* scr = (LAS float*)(lds + wave * 8704);
    {
        constexpr int IT_IN = G1_FP8 ? 0 : 32 * (DIN / 32), IT_OUT = G2_FP8 ? 0 : 32 * (D / 32);
        for (int it = gw; it < IT_IN + IT_OUT; it += NGW) {
            if (it < IT_IN) transpose_item(a.in[I_W_IN], D, DIN, (bf16*)(ws + WS_WINT), scr, it, lane);
            else transpose_item(a.in[I_W_OUT], D, D, (bf16*)(ws + WS_WOUTT), scr, it - IT_IN, lane);
        }
        __syncthreads();
    }
    {
        LAS unsigned* T = (LAS unsigned*)lds;
        const int n4 = tid & 63, kq = tid >> 6;
        constexpr int T_IN = G1_FP8 ? (D / 128) * (DIN / 256) : 0, T_OUT = G2_FP8 ? (D / 128) * (D / 256) : 0, T_E = (D / 128) * (D / 256);
        constexpr int N_GATE = 32 * T_E, N_UP = (BG_WUP && !BG_EXP) ? 256 * 6 : 32 * T_E, N_DOWN = (BG_WDOWN && !BG_EXP) ? 0 : 32 * T_E;
        constexpr int NTILES = T_IN + T_OUT + N_GATE + N_UP + N_DOWN;
        auto tile_ptrs = [&](int tile, const float*& sp, unsigned char*& dp, int& ldn) {
            const float* sbase; unsigned char* dbase; int tl, nt;
            if (tile < T_IN) { sbase = a.in[I_W_IN]; dbase = ws + WS_WINT; tl = tile; nt = DIN / 256; ldn = DIN; }
            else if (tile < T_IN + T_OUT) { sbase = a.in[I_W_OUT]; dbase = ws + WS_WOUTT; tl = tile - T_IN; nt = D / 256; ldn = D; }
            else { int r = tile - T_IN - T_OUT, which, e; nt = D / 256; ldn = D;
                   if (r < N_GATE) { which = 0; e = r / T_E; tl = r % T_E; }
                   else if (r < N_GATE + N_UP) { r -= N_GATE; which = 1; int g = r; if (BG_WUP && !BG_EXP) g = 16 * (r / 6) + 10 + (r % 6);
                                                 e = g / T_E; tl = g % T_E; }
                   else { r -= N_GATE + N_UP; which = 2; e = r / T_E; tl = r % T_E; }
                   sbase = a.in[which == 0 ? I_W_GATE : (which == 1 ? I_W_UP : I_W_DOWN)] + (size_t)e * D * D; dbase = ws + (which == 0 ? WS_WGT : (which == 1 ? WS_WUT : WS_WDT)) + (size_t)e * D * D; }
            const int k0 = (tl / nt) * 128, n0 = (tl % nt) * 256;
            sp = sbase + (size_t)(k0 + 4 * kq) * ldn + n0 + 4 * n4; dp = dbase + (size_t)n0 * D + k0; };
#define CONV_LOAD(R, tile) do { const float* _p; unsigned char* _d; int _ld; tile_ptrs(tile, _p, _d, _ld); _Pragma("unroll") for (int i = 0; i < 4; ++i) _Pragma("unroll") for (int q = 0; q < 4; ++q) \
            R[i][q] = __builtin_nontemporal_load((const f32x4*)(_p + (size_t)(32 * i + q) * _ld)); } while (0)
#define CONV_STORE(R, tile) do { _Pragma("unroll") for (int i = 0; i < 4; ++i) { const int kd = kq + 8 * i; \
            T[(4 * n4 + 0) * 33 + kd] = pk4_fp8(R[i][0].x * W_SCALE, R[i][1].x * W_SCALE, R[i][2].x * W_SCALE, R[i][3].x * W_SCALE); \
            T[(4 * n4 + 1) * 33 + kd] = pk4_fp8(R[i][0].y * W_SCALE, R[i][1].y * W_SCALE, R[i][2].y * W_SCALE, R[i][3].y * W_SCALE); \
            T[(4 * n4 + 2) * 33 + kd] = pk4_fp8(R[i][0].z * W_SCALE, R[i][1].z * W_SCALE, R[i][2].z * W_SCALE, R[i][3].z * W_SCALE); \
            T[(4 * n4 + 3) * 33 + kd] = pk4_fp8(R[i][0].w * W_SCALE, R[i][1].w * W_SCALE, R[i][2].w * W_SCALE, R[i][3].w * W_SCALE); } \
            __syncthreads(); \
            { const float* _p; unsigned char* _d; int _ld; tile_ptrs(tile, _p, _d, _ld); _Pragma("unroll") for (int i = 0; i < 4; ++i) { const int n = (tid >> 3) + 64 * i, c = tid & 7; \
                const u32x4 o = (u32x4){T[n * 33 + 4 * c], T[n * 33 + 4 * c + 1], T[n * 33 + 4 * c + 2], T[n * 33 + 4 * c + 3]}; \
                *(u32x4*)(_d + (size_t)n * D + 16 * c) = o; } } \
            __syncthreads(); } while (0)
        f32x4 RA[4][4], RB[4][4];
        int tile = blockIdx.x;
        if (tile < NTILES) CONV_LOAD(RA, tile);
        while (tile < NTILES) {
            int nxt = tile + gridDim.x;
            if (nxt < NTILES) CONV_LOAD(RB, nxt);
            CONV_STORE(RA, tile);
            tile = nxt; if (tile >= NTILES) break;
            nxt = tile + gridDim.x;
            if (nxt < NTILES) CONV_LOAD(RA, nxt);
            CONV_STORE(RB, tile);
            tile = nxt;
        }
#undef CONV_LOAD
#undef CONV_STORE
    }
    for (int r = gw; r < MROWS; r += NGW) {
        u32x2* orow = (u32x2*)((bf16*)(ws + WS_N1) + (size_t)r * D);
        unsigned* orow8 = (unsigned*)(ws + WS_N1 + (size_t)r * D);
        if (r >= MVALID) {
#pragma unroll
            for (int j = 0; j < 8; ++j) { if (G1_FP8) orow8[lane + 64 * j] = 0u; else orow[lane + 64 * j] = (u32x2){0u, 0u}; }
            continue; }
        const f32x4* xr = (const f32x4*)(r < MREAL ? a.in[I_X] + (size_t)r * D : a.in[I_META] + (size_t)(r - MREAL) * D);
        f32x4 v[8]; float ss = 0.f;
#pragma unroll
        for (int j = 0; j < 8; ++j) { v[j] = xr[lane + 64 * j]; ss += (v[j].x * v[j].x + v[j].y * v[j].y) + (v[j].z * v[j].z + v[j].w * v[j].w); }
        ss = wave_sum(ss);
        const float rstd = (G1_FP8 ? XS_SCALE : 1.0f) / sqrtf(ss * (1.0f / D) + EPS);
#pragma unroll
        for (int j = 0; j < 8; ++j) { const f32x4 g = ((const f32x4*)a.in[I_NORM_MIX])[lane + 64 * j];
            if (G1_FP8) orow8[lane + 64 * j] = pk4_fp8(v[j].x * rstd * g.x, v[j].y * rstd * g.y, v[j].z * rstd * g.z, v[j].w * rstd * g.w);
            else orow[lane + 64 * j] = (u32x2){pk2(v[j].x * rstd * g.x, v[j].y * rstd * g.y), pk2(v[j].z * rstd * g.z, v[j].w * rstd * g.w)}; }
    }
    float* cosT = (float*)(ws + WS_COS); float* sinT = (float*)(ws + WS_SIN);
    for (int i = gt; i < TT * 32; i += NGT) {
        const int pos = i >> 5, j = i & 31;
        const float ang = (float)pos * c_inv_freq[j];
        const double t = (double)ang * 0.15915494309189535; const float fr = (float)(t - floor(t));
        cosT[i] = __builtin_amdgcn_cosf(fr); sinT[i] = __builtin_amdgcn_sinf(fr);
    }
    { bf16* WaT = (bf16*)(ws + WS_WAT); bf16* WiT = (bf16*)(ws + WS_WIT);
      for (int i = gt; i < 16 * 64 * 64; i += NGT) { const int n = i >> 12, d = (i >> 6) & 63, cc = i & 63;
          WaT[i] = (bf16)f2bf(a.in[I_W_A][(n * 64 + cc) * 64 + d]); WiT[i] = (bf16)f2bf(a.in[I_W_I][(n * 64 + cc) * 64 + d]); } }
    { bf16* WRT = (bf16*)(ws + WS_WRT);
      for (int i = gt; i < NEXP * D; i += NGT) { const int e = i >> 11, k = i & 2047; WRT[i] = (bf16)f2bf(a.in[I_NORM_FFN][k] * a.in[I_W_ROUTER][k * NEXP + e]); } }
    int* rowpair = (int*)(ws + WS_ROWPAIR);
    for (int i = gt; i < PROWS; i += NGT) rowpair[i] = -1;
}

namespace pg8 {
constexpr int BM = 256, BK = 64, HALF = 128, HTB = HALF * BK * 2, STAGE_BYTES = 8 * HTB, NXCD = 8, WGM = 8, KD = 2048, NKT = KD / BK;
__host__ __device__ __forceinline__ int lds_byte(int r, int c) { const int st = (r >> 4) * 2 + (c >> 5), rr = r & 15, cc = c & 31, ob = rr * 64 + cc * 2; return st * 1024 + (ob ^ (((ob >> 9) & 1) << 5)); }
__host__ __device__ __forceinline__ void stage_rc(int b, int& R, int& C) { const int st = b / 1024, sb = b % 1024, swz = sb ^ (((sb >> 9) & 1) << 5); R = (st >> 1) * 16 + swz / 64; C = (st & 1) * 32 + (swz % 64) / 2; }
__host__ __device__ __forceinline__ int perm32(int rho) { const int n = rho >> 4, i = rho & 15; return 8 * (i >> 2) + 4 * n + (i & 3); }
struct Unit { const char* a; const char* b0; const char* b1; int pm, pn, e; };
__device__ __forceinline__ bool static_tile(int i, int G, int c, int nM, int nN, int& pm, int& pn) {
    const int nwg = nM * nN; const long L = (long)i * G + c; if (L >= nwg) return false;
    int wgid = (int)L; { const int q = nwg / NXCD, r = nwg % NXCD, xcd = wgid % NXCD, off = wgid / NXCD; wgid = (xcd < r ? xcd * (q + 1) : r * (q + 1) + (xcd - r) * q) + off; }
    const int nig = WGM * nN, gid = wgid / nig, fm = gid * WGM, gsz = (nM - fm) < WGM ? (nM - fm) : WGM;
    pm = fm + ((wgid % nig) % gsz); pn = (wgid % nig) / gsz; return true;
}
__device__ __forceinline__ unsigned cvt_pk_bf16(float lo, float hi) { unsigned r; asm volatile("v_cvt_pk_bf16_f32 %0, %1, %2" : "=v"(r) : "v"(lo), "v"(hi)); return r; }

typedef int i32x8 __attribute__((ext_vector_type(8)));
typedef int i32x4 __attribute__((ext_vector_type(4)));
__device__ __forceinline__ i32x8 cat8(bf16x8 lo, bf16x8 hi) { const i32x4 a = __builtin_bit_cast(i32x4, lo), b = __builtin_bit_cast(i32x4, hi); return __builtin_shufflevector(a, b, 0, 1, 2, 3, 4, 5, 6, 7); }
struct BGNone { static constexpr bool ON = false; };
struct BGConv { static constexpr bool ON = true; const char* src; unsigned char* dst; int next, end; unsigned char* dummy; };
__device__ __forceinline__ void bg_pair_ptrs(const BGConv& bg, int pair, const char*& sp, unsigned char*& dp) {
    const int e = pair >> 10, kbp = (pair >> 6) & 15, nb = pair & 63;
    sp = bg.src + ((size_t)(e * 2048 + 128 * kbp) * 2048 + 32 * nb) * 4; dp = bg.dst + (size_t)e * 2048 * 2048 + (size_t)(32 * nb) * 2048 + 128 * kbp; }
template <bool FP8, class Epi, class Sched, class BG>
__device__ __forceinline__ void gemm_phase(LAS unsigned char* lds, const Sched& S, const Epi& E, BG& bg) {
    constexpr int ROWB = FP8 ? 2048 : 4096, NKTL = ROWB / 128;
    const int tid = threadIdx.x, wid = __builtin_amdgcn_readfirstlane(tid >> 6), lane = tid & 63, wr = wid >> 2, wc = wid & 3, fr = lane & 15, fq = lane >> 4;
    unsigned voffA[2], voffB[2];
#pragma unroll
    for (int i = 0; i < 2; ++i) { int R, C; stage_rc(tid * 16 + i * 8192, R, C); const int Rb = Epi::PERM ? ((R & ~31) + perm32(R & 31)) : R;
        voffA[i] = (unsigned)(R * ROWB + C * 2); voffB[i] = (unsigned)(Rb * ROWB + C * 2); }
    constexpr size_t kstep = (size_t)(BK * 2);
    constexpr size_t hstep = (size_t)HALF * ROWB;
    const unsigned ldsw = (unsigned)wid * 1024u;
    const int aoff = lds_byte(wr * 64 + fr, fq * 8), boff = lds_byte(wc * 32 + fr, fq * 8);
#define PG8_SA(b, h) (((b) * 2 + (h)) * HTB)
#define PG8_SB(b, h) ((4 + (b) * 2 + (h)) * HTB)
#define PG8_STAGE(bufoff, gbase, voff) do { _Pragma("unroll") for (int _i = 0; _i < 2; ++_i) \
        __builtin_amdgcn_global_load_lds((const unsigned*)((const char*)(gbase) + (voff)[_i]), (LAS unsigned*)(lds + (bufoff) + ldsw + _i * 8192), 16, 0, 0); } while (0)
#define PG8_LDA(dst, b, h) do { _Pragma("unroll") for (int m = 0; m < 4; ++m) { \
        if constexpr (FP8) dst##8[m] = __builtin_shufflevector(*(const LAS i32x4*)(lds + PG8_SA(b, h) + aoff + m * 2048), *(const LAS i32x4*)(lds + PG8_SA(b, h) + aoff + m * 2048 + 1024), 0, 1, 2, 3, 4, 5, 6, 7); \
        else { _Pragma("unroll") for (int k = 0; k < 2; ++k) dst[m][k] = *(const LAS bf16x8*)(lds + PG8_SA(b, h) + aoff + m * 2048 + k * 1024); } } } while (0)
#define PG8_LDB(dst, b, h) do { _Pragma("unroll") for (int n = 0; n < 2; ++n) { \
        if constexpr (FP8) dst##8[n] = __builtin_shufflevector(*(const LAS i32x4*)(lds + PG8_SB(b, h) + boff + n * 2048), *(const LAS i32x4*)(lds + PG8_SB(b, h) + boff + n * 2048 + 1024), 0, 1, 2, 3, 4, 5, 6, 7); \
        else { _Pragma("unroll") for (int k = 0; k < 2; ++k) dst[n][k] = *(const LAS bf16x8*)(lds + PG8_SB(b, h) + boff + n * 2048 + k * 1024); } } } while (0)
#define PG8_MMA(ai, bj, At, Bt) do { __builtin_amdgcn_s_setprio(1); _Pragma("unroll") for (int m = 0; m < 4; ++m) _Pragma("unroll") for (int n = 0; n < 2; ++n) { \
        if constexpr (FP8) asm volatile("v_mfma_f32_16x16x128_f8f6f4 %0, %1, %2, %0" : "+v"(acc[ai][bj][m][n]) : "v"(Bt##8[n]), "v"(At##8[m])); \
        else { _Pragma("unroll") for (int k = 0; k < 2; ++k) asm volatile("v_mfma_f32_16x16x32_bf16 %0, %1, %2, %0" : "+v"(acc[ai][bj][m][n]) : "v"(Bt[n][k]), "v"(At[m][k])); } } \
        __builtin_amdgcn_s_setprio(0); } while (0)
#define PG8_WAIT_V(n) asm volatile("s_waitcnt vmcnt(" #n ")" ::: "memory")
#define PG8_WAIT_L(n) asm volatile("s_waitcnt lgkmcnt(" #n ")" ::: "memory")
#define PG8_BAR __builtin_amdgcn_s_barrier()
#define PG8_SCHED __builtin_amdgcn_sched_barrier(0)
    Unit cur, nxt; int ui = 0; bool bg_pending = false;
    if (!S.next(0, cur)) return;
    f32x4 acc[2][2][4][2];
#pragma unroll
    for (int a = 0; a < 2; ++a)
#pragma unroll
        for (int b = 0; b < 2; ++b)
#pragma unroll
            for (int m = 0; m < 4; ++m)
#pragma unroll
                for (int n = 0; n < 2; ++n) acc[a][b][m][n] = (f32x4){0.f, 0.f, 0.f, 0.f};
    bf16x8 At[4][2], B0[2][2], B1[2][2];
    i32x8 At8[4], B08[2], B18[2];
    PG8_STAGE(PG8_SB(0, 0), cur.b0, voffB); PG8_STAGE(PG8_SB(0, 1), cur.b1, voffB); PG8_STAGE(PG8_SA(0, 0), cur.a, voffA); PG8_STAGE(PG8_SA(0, 1), cur.a + hstep, voffA);
    if (wr == 1) PG8_BAR;
    PG8_WAIT_V(2); PG8_BAR;
    PG8_STAGE(PG8_SB(1, 0), cur.b0 + kstep, voffB); PG8_STAGE(PG8_SA(1, 0), cur.a + kstep, voffA); PG8_STAGE(PG8_SB(1, 1), cur.b1 + kstep, voffB);
    PG8_WAIT_V(6); PG8_BAR;
    for (;;) {
        const bool has_next = S.next(ui + 1, nxt);
        const char* nA = has_next ? nxt.a : cur.a; const char* nB0 = has_next ? nxt.b0 : cur.b0; const char* nB1 = has_next ? nxt.b1 : cur.b1;
        for (int t = 0; t < NKTL; t += 2) {
            const bool last = (t == NKTL - 2);
            const char* a1 = cur.a + (size_t)(t + 1) * kstep;
            const char* a2 = last ? nA : cur.a + (size_t)(t + 2) * kstep;
            const char* b20 = last ? nB0 : cur.b0 + (size_t)(t + 2) * kstep; const char* b21 = last ? nB1 : cur.b1 + (size_t)(t + 2) * kstep;
            const char* a3 = a2 + kstep; const char* b30 = b20 + kstep; const char* b31 = b21 + kstep;
            PG8_LDB(B0, 0, 0); PG8_LDB(B1, 0, 1); PG8_SCHED; PG8_LDA(At, 0, 0); PG8_STAGE(PG8_SA(1, 1), a1 + hstep, voffA);
            if (t == 2) E.prefetch(cur, lds, wid, lane);
            PG8_WAIT_V(8); PG8_WAIT_L(0); PG8_BAR; PG8_MMA(0, 0, At, B0);
            if constexpr (BG::ON) {
                PG8_SCHED;
                int tz = threadIdx.x; asm volatile("" : "+v"(tz));
#pragma unroll
                for (int j = 0; j < (BG_EXP == 1 ? 0 : 2); ++j) { const LAS float* p = (const LAS float*)(lds + LDS_BG + j * 8192 + (tz >> 5) * 512 + (tz & 31) * 4);
                    ((LAS unsigned*)(lds + LDS_T2))[(tz & 31) * 33 + 16 * j + (tz >> 5)] = pk4_fp8(p[0] * W_SCALE, p[32] * W_SCALE, p[64] * W_SCALE, p[96] * W_SCALE); }
                const char* bgs; { unsigned char* dp_; pg8::bg_pair_ptrs(bg, bg.next < bg.end ? bg.next : bg.end - 1, bgs, dp_); }
                PG8_SCHED;
                if (BG_EXP != 2) {
                const unsigned bgv = (unsigned)((8 * wid + ((tz & 63) >> 3)) * 8192 + (tz & 7) * 16);
                __builtin_amdgcn_global_load_lds((const unsigned*)(bgs + bgv), (LAS unsigned*)(lds + LDS_BG + ldsw), 16, 0, 0);
                __builtin_amdgcn_global_load_lds((const unsigned*)(bgs + 524288 + bgv), (LAS unsigned*)(lds + LDS_BG + 8192 + ldsw), 16, 0, 0); }
                PG8_SCHED; }
            PG8_MMA(0, 1, At, B1);
            if constexpr (BG::ON) { PG8_WAIT_L(0); }
            PG8_BAR; PG8_SCHED;
            PG8_LDA(At, 0, 1); PG8_STAGE(PG8_SB(0, 0), b20, voffB); PG8_STAGE(PG8_SB(0, 1), b21, voffB); PG8_STAGE(PG8_SA(0, 0), a2, voffA);
            if constexpr (BG::ON) { if (BG_EXP == 2) PG8_WAIT_V(8); else PG8_WAIT_V(10); } else { PG8_WAIT_V(8); }
            PG8_WAIT_L(0); PG8_BAR; PG8_MMA(1, 0, At, B0);
            if constexpr (BG::ON) {
                PG8_SCHED;
                unsigned char* bgd; { const char* sp_; pg8::bg_pair_ptrs(bg, bg.next - 1 < bg.end ? bg.next - 1 : bg.end - 1, sp_, bgd); }
                int tz = threadIdx.x; asm volatile("" : "+v"(tz));
                const LAS unsigned* q = (const LAS unsigned*)(lds + LDS_T2) + (tz >> 4) * 33 + 2 * (tz & 15);
                const u32x2 w = (u32x2){q[0], q[1]};
                if (BG_EXP != 1) *(u32x2*)((bg_pending && !BG_EXP) ? bgd + (size_t)(tz >> 4) * 2048 + 8 * (tz & 15) : bg.dummy + 8 * tz) = w;
                ++bg.next; bg_pending = true;
                PG8_SCHED; }
            PG8_MMA(1, 1, At, B1); PG8_BAR; PG8_SCHED;
            PG8_LDB(B0, 1, 0); PG8_LDB(B1, 1, 1); PG8_SCHED; PG8_LDA(At, 1, 0); PG8_STAGE(PG8_SA(0, 1), a2 + hstep, voffA);
            if constexpr (BG::ON) { if (BG_EXP == 1) PG8_WAIT_V(10); else if (BG_EXP == 2) PG8_WAIT_V(9); else PG8_WAIT_V(11); } else { PG8_WAIT_V(8); }
            PG8_WAIT_L(0); PG8_BAR; PG8_MMA(0, 0, At, B0); PG8_MMA(0, 1, At, B1); PG8_BAR; PG8_SCHED;
            PG8_LDA(At, 1, 1); PG8_STAGE(PG8_SB(1, 0), b30, voffB); PG8_STAGE(PG8_SB(1, 1), b31, voffB); PG8_STAGE(PG8_SA(1, 0), a3, voffA);
            if constexpr (BG::ON) { if (BG_EXP == 1) PG8_WAIT_V(8); else PG8_WAIT_V(9); } else { PG8_WAIT_V(8); }
            PG8_WAIT_L(0); PG8_BAR; PG8_MMA(1, 0, At, B0); PG8_MMA(1, 1, At, B1); PG8_BAR; PG8_SCHED;
        }
        if (wr == 0) PG8_BAR;
        asm volatile("s_nop 15\n\ts_nop 15" ::: "memory");
        E(acc, cur, wr, wc, fr, fq, lds);
        if (!has_next) break;
#pragma unroll
        for (int a = 0; a < 2; ++a)
#pragma unroll
            for (int b = 0; b < 2; ++b)
#pragma unroll
                for (int m = 0; m < 4; ++m)
#pragma unroll
                    for (int n = 0; n < 2; ++n) acc[a][b][m][n] = (f32x4){0.f, 0.f, 0.f, 0.f};
        cur = nxt; ++ui;
        if (wr == 1) PG8_BAR;
    }
    PG8_WAIT_V(0);
    PG8_BAR;
    if constexpr (BG::ON) { if (bg_pending && !BG_EXP) {
        unsigned char* bgd; { const char* sp_; pg8::bg_pair_ptrs(bg, bg.next - 1 < bg.end ? bg.next - 1 : bg.end - 1, sp_, bgd); }
#pragma unroll
        for (int j = 0; j < 2; ++j) { const LAS float* p = (const LAS float*)(lds + LDS_BG + j * 8192 + (tid >> 5) * 512 + (tid & 31) * 4);
            ((LAS unsigned*)(lds + LDS_T2))[(tid & 31) * 33 + 16 * j + (tid >> 5)] = pk4_fp8(p[0] * W_SCALE, p[32] * W_SCALE, p[64] * W_SCALE, p[96] * W_SCALE); }
        __syncthreads();
        const LAS unsigned* q = (const LAS unsigned*)(lds + LDS_T2) + (tid >> 4) * 33 + 2 * (tid & 15);
        *(u32x2*)(bgd + (size_t)(tid >> 4) * 2048 + 8 * (tid & 15)) = (u32x2){q[0], q[1]}; } }
#undef PG8_SA
#undef PG8_SB
#undef PG8_STAGE
#undef PG8_LDA
#undef PG8_LDB
#undef PG8_MMA
#undef PG8_WAIT_V
#undef PG8_WAIT_L
#undef PG8_BAR
#undef PG8_SCHED
}

struct SchedDense {
    const char* A; const char* Bt; int nM, nN, G, c, rowb;
    __device__ __forceinline__ bool next(int i, Unit& u) const {
        int pm, pn; if (!static_tile(i, G, c, nM, nN, pm, pn)) return false;
        u.pm = pm; u.pn = pn; u.e = 0; u.a = A + (size_t)pm * BM * rowb; u.b0 = Bt + (size_t)pn * BM * rowb; u.b1 = u.b0 + (size_t)HALF * rowb; return true;
    }
};
struct SchedMoE {
    const char* A; const char* B0; const char* B1; const LAS int* tstart; int nM, nN, G, c; bool split;
    __device__ __forceinline__ bool next(int i, Unit& u) const {
        int pm, pn; if (!static_tile(i, G, c, nM, nN, pm, pn)) return false;
        int e = 0;
#pragma unroll 1
        for (int q = 1; q < 32; ++q) e += (tstart[q] <= pm) ? 1 : 0;
        u.pm = pm; u.pn = pn; u.e = e; u.a = A + (size_t)pm * (BM * 2048);
        const size_t eoff = (size_t)e * ((size_t)2048 * 2048);
        if (split) { u.b0 = B0 + eoff + (size_t)pn * (HALF * 2048); u.b1 = B1 + eoff + (size_t)pn * (HALF * 2048); }
        else { u.b0 = B0 + eoff + (size_t)pn * (BM * 2048); u.b1 = u.b0 + (size_t)HALF * 2048; }
        return true;
    }
};

__device__ __forceinline__ u32x4 widen16(u32x2 x, u32x2 y) {
    const auto r0 = __builtin_amdgcn_permlane16_swap(x.x, y.x, false, false), r1 = __builtin_amdgcn_permlane16_swap(x.y, y.y, false, false);
    return (u32x4){r0[0], r1[0], r0[1], r1[1]};
}
struct EpiZ {
    static constexpr bool PERM = true;
    bf16* Z; const float* bias; float sc;
    __device__ __forceinline__ void prefetch(const Unit&, LAS unsigned char*, int, int) const {}
    __device__ __forceinline__ void operator()(const f32x4 (&acc)[2][2][4][2], const Unit& u, int wr, int wc, int fr, int fq, const LAS unsigned char*) const {
        const int row0 = u.pm * BM + wr * 64 + fr, col0 = u.pn * BM + wc * 32 + 8 * fq;
        f32x4 bv[2][2];
#pragma unroll
        for (int bj = 0; bj < 2; ++bj)
#pragma unroll
            for (int n = 0; n < 2; ++n) bv[bj][n] = *(const f32x4*)(bias + col0 + bj * HALF + 4 * n);
#pragma unroll
        for (int ai = 0; ai < 2; ++ai)
#pragma unroll
            for (int m = 0; m < 4; ++m) { bf16* rowp = Z + (size_t)(row0 + ai * HALF + m * 16) * DIN + col0;
#pragma unroll
                for (int bj = 0; bj < 2; ++bj) { const f32x4 v0 = acc[ai][bj][m][0] * sc + bv[bj][0], v1 = acc[ai][bj][m][1] * sc + bv[bj][1];
                    u32x4 w; w.x = cvt_pk_bf16(v0[0], v0[1]); w.y = cvt_pk_bf16(v0[2], v0[3]); w.z = cvt_pk_bf16(v1[0], v1[1]); w.w = cvt_pk_bf16(v1[2], v1[3]);
                    *(u32x4*)(rowp + bj * HALF) = w; } }
    }
};
struct EpiH1 {
    static constexpr bool PERM = true;
    bf16* H1; const float* x; const float* bias; float sc;
    __device__ __forceinline__ void prefetch(const Unit&, LAS unsigned char*, int, int) const {}
    __device__ __forceinline__ void operator()(const f32x4 (&acc)[2][2][4][2], const Unit& u, int wr, int wc, int fr, int fq, const LAS unsigned char*) const {
        const int row0 = u.pm * BM + wr * 64 + fr, col0 = u.pn * BM + wc * 32 + 8 * fq;
        f32x4 bv[2][2];
#pragma unroll
        for (int bj = 0; bj < 2; ++bj)
#pragma unroll
            for (int n = 0; n < 2; ++n) bv[bj][n] = *(const f32x4*)(bias + col0 + bj * HALF + 4 * n);
#pragma unroll
        for (int ai = 0; ai < 2; ++ai) {
            f32x4 xv[4][2][2];
#pragma unroll
            for (int m = 0; m < 4; ++m) { const size_t ro = (size_t)(row0 + ai * HALF + m * 16) * D + col0;
#pragma unroll
                for (int bj = 0; bj < 2; ++bj) { xv[m][bj][0] = __builtin_nontemporal_load((const f32x4*)(x + ro + bj * HALF)); xv[m][bj][1] = __builtin_nontemporal_load((const f32x4*)(x + ro + bj * HALF + 4)); } }
#pragma unroll
            for (int m = 0; m < 4; ++m) { const size_t ro = (size_t)(row0 + ai * HALF + m * 16) * D + col0;
#pragma unroll
                for (int bj = 0; bj < 2; ++bj) { const f32x4 v0 = xv[m][bj][0] + acc[ai][bj][m][0] * sc + bv[bj][0], v1 = xv[m][bj][1] + acc[ai][bj][m][1] * sc + bv[bj][1];
                    u32x4 w; w.x = cvt_pk_bf16(v0[0], v0[1]); w.y = cvt_pk_bf16(v0[2], v0[3]); w.z = cvt_pk_bf16(v1[0], v1[1]); w.w = cvt_pk_bf16(v1[2], v1[3]);
                    *(u32x4*)(H1 + ro + bj * HALF) = w; } }
        }
    }
};
struct EpiAct {
    static constexpr bool PERM = true;
    unsigned char* ACT; const float* bg; const float* bu;
    __device__ __forceinline__ void prefetch(const Unit& u, LAS unsigned char* lds, int wid, int lane) const {
        if (wid == 0) { const float* p = (lane < 32 ? bg : bu) + (size_t)u.e * DFF + u.pn * HALF + (lane & 31) * 4;
            __builtin_amdgcn_global_load_lds((const unsigned*)p, (LAS unsigned*)(lds + LDS_META), 16, 0, 0); }
    }
    __device__ __forceinline__ void operator()(const f32x4 (&acc)[2][2][4][2], const Unit& u, int wr, int wc, int fr, int fq, const LAS unsigned char* lds) const {
        const int row0 = u.pm * BM + wr * 64 + fr, cl = wc * 32 + 8 * fq, col0 = u.pn * HALF + cl;
        f32x4 gv[2], uv[2];
#pragma unroll
        for (int n = 0; n < 2; ++n) { gv[n] = *(const LAS f32x4*)(lds + LDS_META + (cl + 4 * n) * 4); uv[n] = *(const LAS f32x4*)(lds + LDS_META + 512 + (cl + 4 * n) * 4); }
#pragma unroll
        for (int ai = 0; ai < 2; ++ai)
#pragma unroll
            for (int mp = 0; mp < 2; ++mp) { u32x2 pc[2];
#pragma unroll
                for (int mi = 0; mi < 2; ++mi) { const int m = 2 * mp + mi; float r[8];
#pragma unroll
                    for (int n = 0; n < 2; ++n)
#pragma unroll
                        for (int j = 0; j < 4; ++j) { float g = acc[ai][0][m][n][j] * (1.0f / (W_SCALE * XS_SCALE)) + gv[n][j], up = acc[ai][1][m][n][j] * (1.0f / (W_SCALE * XS_SCALE)) + uv[n][j];
                            g = fminf(g, 7.0f); up = fminf(fmaxf(up, -7.0f), 7.0f);
                            r[n * 4 + j] = ACT_SCALE * g * (1.0f / (1.0f + __expf(-1.702f * g))) * (up + 1.0f); }
                    pc[mi] = (u32x2){pk4_fp8(r[0], r[1], r[2], r[3]), pk4_fp8(r[4], r[5], r[6], r[7])}; }
                const u32x4 w = widen16(pc[0], pc[1]);
                const int m = 2 * mp + (fq & 1);
                *(u32x4*)(ACT + (size_t)(row0 + ai * HALF + m * 16) * DFF + col0 - 8 * (fq & 1)) = w; }
    }
};
struct EpiDown {
    static constexpr bool PERM = true;
    unsigned char* YB; const float* bd;
    __device__ __forceinline__ void prefetch(const Unit& u, LAS unsigned char* lds, int wid, int lane) const {
        if (wid == 0) __builtin_amdgcn_global_load_lds((const unsigned*)(bd + (size_t)u.e * D + u.pn * BM + lane * 4), (LAS unsigned*)(lds + LDS_META), 16, 0, 0);
    }
    __device__ __forceinline__ void operator()(const f32x4 (&acc)[2][2][4][2], const Unit& u, int wr, int wc, int fr, int fq, const LAS unsigned char* lds) const {
        const int row0 = u.pm * BM + wr * 64 + fr, cl = wc * 32 + 8 * fq, col0 = u.pn * BM + cl;
        f32x4 bv[2][2];
#pragma unroll
        for (int bj = 0; bj < 2; ++bj)
#pragma unroll
            for (int n = 0; n < 2; ++n) bv[bj][n] = *(const LAS f32x4*)(lds + LDS_META + (cl + bj * HALF + 4 * n) * 4) * YB_SCALE;
#pragma unroll
        for (int ai = 0; ai < 2; ++ai)
#pragma unroll
            for (int m = 0; m < 4; ++m) { u32x2 pc[2];
#pragma unroll
                for (int bj = 0; bj < 2; ++bj) { const f32x4 v0 = acc[ai][bj][m][0] * (YB_SCALE / (W_SCALE * ACT_SCALE)) + bv[bj][0], v1 = acc[ai][bj][m][1] * (YB_SCALE / (W_SCALE * ACT_SCALE)) + bv[bj][1];
                    pc[bj] = (u32x2){pk4_fp8(v0[0], v0[1], v0[2], v0[3]), pk4_fp8(v1[0], v1[1], v1[2], v1[3])}; }
                const u32x4 w = widen16(pc[0], pc[1]);
                *(u32x4*)(YB + (size_t)(row0 + ai * HALF + m * 16) * D + col0 + (fq & 1) * (HALF - 8)) = w; }
    }
};
}


typedef float f32x16 __attribute__((ext_vector_type(16)));
constexpr int AT_KS = 144, AT_VS = 584, AT_KOFF = 0, AT_VOFF = 288 * AT_KS;
__device__ __forceinline__ float bflo(unsigned w) { return __uint_as_float(w << 16); }
__device__ __forceinline__ float bfhi(unsigned w) { return __uint_as_float(w & 0xffff0000u); }

__device__ __forceinline__ void attn_tile(LAS unsigned char* lds, int slot_base, int kind, int j, int lane, int hq,
                                          const bf16x8 (&qf)[2][4], f32x16 (&oacc)[2][2], float (&mrow)[2], float (&lrow)[2]) {
    const int r31 = lane & 31, h = lane >> 5;
    bf16x8 kf[4], vf[2][2];
#pragma unroll
    for (int ks = 0; ks < 4; ++ks) kf[ks] = *(const LAS bf16x8*)(lds + AT_KOFF + (slot_base + r31) * AT_KS + (16 * ks + 8 * h) * 2);
#pragma unroll
    for (int dt = 0; dt < 2; ++dt)
#pragma unroll
        for (int sp = 0; sp < 2; ++sp) { const LAS unsigned char* p = lds + AT_VOFF + (32 * dt + r31) * AT_VS + (slot_base + 16 * sp + 4 * h) * 2;
            const u32x2 lo = *(const LAS u32x2*)p, hi = *(const LAS u32x2*)(p + 16);
            const u32x4 w = (u32x4){lo.x, lo.y, hi.x, hi.y}; vf[dt][sp] = __builtin_bit_cast(bf16x8, w); }
#pragma unroll
    for (int qt = 0; qt < 2; ++qt) {
        f32x16 s;
#pragma unroll
        for (int r = 0; r < 16; ++r) s[r] = 0.f;
#pragma unroll
        for (int ks = 0; ks < 4; ++ks) s = __builtin_amdgcn_mfma_f32_32x32x16_bf16(kf[ks], qf[qt][ks], s, 0, 0, 0);
        const int i = 64 * hq + 32 * qt + r31;
        float mx = -1.0e30f;
#pragma unroll
        for (int r = 0; r < 16; ++r) { const int key = (r & 3) + 8 * (r >> 2) + 4 * h;
            const bool ok = kind == 0 ? (key < 16) : (kind == 1 ? (32 * j + key >= i + 1) : (32 * j + key <= i));
            s[r] = ok ? s[r] : -1.0e30f; mx = fmaxf(mx, s[r]); }
        mx = fmaxf(mx, __shfl_xor(mx, 32));
        const float mn = fmaxf(mrow[qt], mx), al = __expf(mrow[qt] - mn); mrow[qt] = mn;
        float ps = 0.f;
#pragma unroll
        for (int r = 0; r < 16; ++r) { s[r] = __expf(s[r] - mn); ps += s[r]; }
        lrow[qt] = lrow[qt] * al + ps;
#pragma unroll
        for (int dt = 0; dt < 2; ++dt)
#pragma unroll
            for (int r = 0; r < 16; ++r) oacc[qt][dt][r] *= al;
        bf16x8 pf[2];
#pragma unroll
        for (int sp = 0; sp < 2; ++sp) { const u32x4 w = (u32x4){pk2(s[8 * sp + 0], s[8 * sp + 1]), pk2(s[8 * sp + 2], s[8 * sp + 3]), pk2(s[8 * sp + 4], s[8 * sp + 5]), pk2(s[8 * sp + 6], s[8 * sp + 7])};
            pf[sp] = __builtin_bit_cast(bf16x8, w); }
#pragma unroll
        for (int dt = 0; dt < 2; ++dt)
#pragma unroll
            for (int sp = 0; sp < 2; ++sp) oacc[qt][dt] = __builtin_amdgcn_mfma_f32_32x32x16_bf16(vf[dt][sp], pf[sp], oacc[qt][dt], 0, 0, 0);
    }
}

__device__ __forceinline__ void attn_item(const Args& a, LAS unsigned char* lds, int item, int tid, int lane, int wave) {
    const int kvh = item & 3, qblk = (item >> 2) & 15, b = item >> 6;
    const bf16* Z = (const bf16*)(a.ws + WS_Z); bf16* O = (bf16*)(a.ws + (G2_FP8 ? WS_ATT : WS_O)); constexpr int OLD = G2_FP8 ? 1024 : D;
    const float* cosT = (const float*)(a.ws + WS_COS); const float* sinT = (const float*)(a.ws + WS_SIN);
    __syncthreads();
    for (int task = tid; task < 288 * 4; task += 512) {
        const int slot = task >> 2, c = task & 3;
        int krow, kpos; bool valid;
        if (slot < 32) { valid = slot < NMETA; krow = METAROW0 + slot; kpos = slot; }
        else { const int sp = 128 * (qblk - 1) + (slot - 32); valid = sp >= 0; krow = b * SEQ + sp; kpos = NMETA + sp; }
        u32x4 lo = (u32x4){0u, 0u, 0u, 0u}, hi = lo;
        if (valid) {
            const bf16* kp = Z + (size_t)krow * DIN + ZK + kvh * 64 + c * 8;
            const u32x4 x1 = *(const u32x4*)kp, x2 = *(const u32x4*)(kp + 32);
            const f32x4 c0 = *(const f32x4*)(cosT + kpos * 32 + c * 8), c1 = *(const f32x4*)(cosT + kpos * 32 + c * 8 + 4);
            const f32x4 s0 = *(const f32x4*)(sinT + kpos * 32 + c * 8), s1 = *(const f32x4*)(sinT + kpos * 32 + c * 8 + 4);
#pragma unroll
            for (int q = 0; q < 4; ++q) { const float ca = q < 2 ? c0[2 * q] : c1[2 * q - 4], cb = q < 2 ? c0[2 * q + 1] : c1[2 * q - 3], sa = q < 2 ? s0[2 * q] : s1[2 * q - 4], sb = q < 2 ? s0[2 * q + 1] : s1[2 * q - 3];
                const float a0 = bflo(x1[q]), a1 = bfhi(x1[q]), b0 = bflo(x2[q]), b1 = bfhi(x2[q]);
                lo[q] = pk2(a0 * ca - b0 * sa, a1 * cb - b1 * sb); hi[q] = pk2(b0 * ca + a0 * sa, b1 * cb + a1 * sb); }
        }
        *(LAS u32x4*)(lds + AT_KOFF + slot * AT_KS + c * 16) = lo; *(LAS u32x4*)(lds + AT_KOFF + slot * AT_KS + 64 + c * 16) = hi;
    }
    for (int task = tid; task < 144 * 8; task += 512) {
        const int slot0 = (task >> 3) * 2, c = task & 7;
        int vrow; bool valid;
        if (slot0 < 32) { valid = slot0 < NMETA; vrow = METAROW0 + slot0; }
        else { const int sp = 128 * (qblk - 1) + (slot0 - 32); valid = sp >= 0; vrow = b * SEQ + sp; }
        u32x4 v0 = (u32x4){0u, 0u, 0u, 0u}, v1 = v0;
        if (valid) { const bf16* vp = Z + (size_t)vrow * DIN + ZV + kvh * 64 + c * 8; v0 = *(const u32x4*)vp; v1 = *(const u32x4*)(vp + DIN); }
#pragma unroll
        for (int q = 0; q < 4; ++q) {
            *(LAS unsigned*)(lds + AT_VOFF + (c * 8 + 2 * q) * AT_VS + slot0 * 2) = (v0[q] & 0xffffu) | (v1[q] << 16);
            *(LAS unsigned*)(lds + AT_VOFF + (c * 8 + 2 * q + 1) * AT_VS + slot0 * 2) = (v0[q] >> 16) | (v1[q] & 0xffff0000u); }
    }
    const int g = wave >> 1, hq = wave & 1, head = kvh * 4 + g, r31 = lane & 31, h = lane >> 5;
    bf16x8 qf[2][4];
#pragma unroll
    for (int qt = 0; qt < 2; ++qt) {
        const int s = 128 * qblk + 64 * hq + 32 * qt + r31, pos = NMETA + s;
        const bf16* qp = Z + (size_t)(b * SEQ + s) * DIN + ZQ + head * 64 + 8 * h;
        u32x4 x[4];
#pragma unroll
        for (int ks = 0; ks < 4; ++ks) x[ks] = *(const u32x4*)(qp + 16 * ks);
#pragma unroll
        for (int ks = 0; ks < 2; ++ks) {
            const float* cp = cosT + pos * 32 + 16 * ks + 8 * h; const float* sp = sinT + pos * 32 + 16 * ks + 8 * h;
            const f32x4 c0 = *(const f32x4*)cp, c1 = *(const f32x4*)(cp + 4), s0 = *(const f32x4*)sp, s1 = *(const f32x4*)(sp + 4);
            u32x4 lo, hi;
#pragma unroll
            for (int q = 0; q < 4; ++q) { const float ca = q < 2 ? c0[2 * q] : c1[2 * q - 4], cb = q < 2 ? c0[2 * q + 1] : c1[2 * q - 3], sa = q < 2 ? s0[2 * q] : s1[2 * q - 4], sb = q < 2 ? s0[2 * q + 1] : s1[2 * q - 3];
                const float a0 = bflo(x[ks][q]), a1 = bfhi(x[ks][q]), b0 = bflo(x[ks + 2][q]), b1 = bfhi(x[ks + 2][q]);
                lo[q] = pk2(0.125f * (a0 * ca - b0 * sa), 0.125f * (a1 * cb - b1 * sb)); hi[q] = pk2(0.125f * (b0 * ca + a0 * sa), 0.125f * (b1 * cb + a1 * sb)); }
            qf[qt][ks] = __builtin_bit_cast(bf16x8, lo); qf[qt][ks + 2] = __builtin_bit_cast(bf16x8, hi);
        }
    }
    f32x16 oacc[2][2]; float mrow[2], lrow[2];
#pragma unroll
    for (int qt = 0; qt < 2; ++qt) { mrow[qt] = a.in[I_SINKS][head]; lrow[qt] = h == 0 ? 1.0f : 0.0f;
#pragma unroll
        for (int dt = 0; dt < 2; ++dt)
#pragma unroll
            for (int r = 0; r < 16; ++r) oacc[qt][dt][r] = 0.f; }
    __syncthreads();
    attn_tile(lds, 0, 0, 0, lane, hq, qf, oacc, mrow, lrow);
    if (qblk > 0) {
#pragma unroll 1
        for (int j = hq ? 2 : 0; j < 4; ++j) attn_tile(lds, 32 + 32 * j, 1, j, lane, hq, qf, oacc, mrow, lrow);
    }
#pragma unroll 1
    for (int j = 0; j < (hq ? 4 : 2); ++j) attn_tile(lds, 160 + 32 * j, 2, j, lane, hq, qf, oacc, mrow, lrow);
#pragma unroll
    for (int qt = 0; qt < 2; ++qt) {
        const float lt = lrow[qt] + __shfl_xor(lrow[qt], 32), inv = 1.0f / lt;
        bf16* op = O + (size_t)(b * SEQ + 128 * qblk + 64 * hq + 32 * qt + r31) * OLD + head * 64 + 4 * h;
#pragma unroll
        for (int dt = 0; dt < 2; ++dt)
#pragma unroll
            for (int rr = 0; rr < 4; ++rr)
                *(u32x2*)(op + 32 * dt + 8 * rr) = (u32x2){pk2(oacc[qt][dt][4 * rr] * inv, oacc[qt][dt][4 * rr + 1] * inv), pk2(oacc[qt][dt][4 * rr + 2] * inv, oacc[qt][dt][4 * rr + 3] * inv)};
    }
}

constexpr int LR_XS = 2064;
__device__ __forceinline__ void lru_norm_rows(const Args& a, LAS unsigned char* lds, int b, int c, int lane, int wave) {
        bf16* O = (bf16*)(a.ws + WS_O); unsigned char* O8 = a.ws + WS_O;
        const bf16* ATT = (const bf16*)(a.ws + (G2_FP8 ? WS_ATT : WS_O)); constexpr int ALD = G2_FP8 ? 1024 : D;
        u32x4 aw[4][2];
#pragma unroll
        for (int q = 0; q < 4; ++q)
#pragma unroll
            for (int jj = 0; jj < 2; ++jj) aw[q][jj] = *(const u32x4*)(ATT + ((size_t)b * SEQ + 32 * c + 4 * wave + q) * ALD + (lane + 64 * jj) * 8);
        f32x4 ga[2][2], gl[2][2];
#pragma unroll
        for (int jj = 0; jj < 2; ++jj) { ga[jj][0] = *(const f32x4*)(a.in[I_G_ATTN] + (lane + 64 * jj) * 8); ga[jj][1] = *(const f32x4*)(a.in[I_G_ATTN] + (lane + 64 * jj) * 8 + 4);
            gl[jj][0] = *(const f32x4*)(a.in[I_G_LRU] + (lane + 64 * jj) * 8); gl[jj][1] = *(const f32x4*)(a.in[I_G_LRU] + (lane + 64 * jj) * 8 + 4); }
        __syncthreads();
#pragma unroll
        for (int q = 0; q < 4; ++q) {
            const int tl = 4 * wave + q; const size_t row = (size_t)b * SEQ + 32 * c + tl;
#pragma unroll
            for (int half = 0; half < 2; ++half) {
                u32x4 w[2]; float v[16]; float ss = 0.f;
#pragma unroll
                for (int jj = 0; jj < 2; ++jj) { w[jj] = half == 0 ? *(const LAS u32x4*)(lds + tl * LR_XS + (lane + 64 * jj) * 16) : aw[q][jj];
#pragma unroll
                    for (int k = 0; k < 4; ++k) { v[jj * 8 + 2 * k] = bflo(w[jj][k]); v[jj * 8 + 2 * k + 1] = bfhi(w[jj][k]); } }
#pragma unroll
                for (int k = 0; k < 16; ++k) ss += v[k] * v[k];
                ss = wave_sum(ss);
                const float rstd = (G2_FP8 ? XS_SCALE : 1.0f) * __builtin_amdgcn_rsqf(ss * (1.0f / 1024.0f) + EPS);
#pragma unroll
                for (int jj = 0; jj < 2; ++jj) { const f32x4 g0 = half == 0 ? gl[jj][0] : ga[jj][0], g1 = half == 0 ? gl[jj][1] : ga[jj][1];
                    const size_t col = (half == 0 ? 1024 : 0) + (lane + 64 * jj) * 8;
                    if (G2_FP8) *(u32x2*)(O8 + row * D + col) = (u32x2){pk4_fp8(v[jj * 8 + 0] * rstd * g0.x, v[jj * 8 + 1] * rstd * g0.y, v[jj * 8 + 2] * rstd * g0.z, v[jj * 8 + 3] * rstd * g0.w),
                                                                       pk4_fp8(v[jj * 8 + 4] * rstd * g1.x, v[jj * 8 + 5] * rstd * g1.y, v[jj * 8 + 6] * rstd * g1.z, v[jj * 8 + 7] * rstd * g1.w)};
                    else *(u32x4*)(O + row * D + col) = (u32x4){pk2(v[jj * 8 + 0] * rstd * g0.x, v[jj * 8 + 1] * rstd * g0.y), pk2(v[jj * 8 + 2] * rstd * g0.z, v[jj * 8 + 3] * rstd * g0.w),
                                                                pk2(v[jj * 8 + 4] * rstd * g1.x, v[jj * 8 + 5] * rstd * g1.y), pk2(v[jj * 8 + 6] * rstd * g1.z, v[jj * 8 + 7] * rstd * g1.w)}; }
            }
        }
}
template <int PASS>
__device__ __forceinline__ void lru_item(const Args& a, LAS unsigned char* lds, int item, int tid, int lane, int wave) {
    const int b = item / 65, c = item % 65; const bool meta = (c == 64);
    const bf16* Z = (const bf16*)(a.ws + WS_Z);
    float* sumA = (float*)(a.ws + WS_LRUSUM); float* sumB = sumA + NBATCH * 64 * DLRU; float* metaB = sumB + NBATCH * 64 * DLRU;
    __syncthreads();
    {
        const int ch0 = (tid & 127) * 8, tq = tid >> 7;
        f32x4 cw[4][2], cb[2];
#pragma unroll
        for (int jj = 0; jj < 4; ++jj) { cw[jj][0] = *(const f32x4*)(a.in[I_CONV_W] + jj * DLRU + ch0); cw[jj][1] = *(const f32x4*)(a.in[I_CONV_W] + jj * DLRU + ch0 + 4); }
        cb[0] = *(const f32x4*)(a.in[I_CONV_B] + ch0); cb[1] = *(const f32x4*)(a.in[I_CONV_B] + ch0 + 4);
#pragma unroll 1
        for (int i0 = 0; i0 < 8; i0 += 4) {
            u32x4 x[4][4];
#pragma unroll
            for (int i = 0; i < 4; ++i) { const int tl = tq + 4 * (i0 + i); const int t = meta ? tl : NMETA + 32 * c + tl;
#pragma unroll
                for (int jj = 0; jj < 4; ++jj) { const int tt = t - 3 + jj; x[i][jj] = (u32x4){0u, 0u, 0u, 0u};
                    if (tt >= 0 && !(meta && tl >= NMETA)) x[i][jj] = *(const u32x4*)(Z + (size_t)tok_row(b, tt) * DIN + ZX + ch0); } }
#pragma unroll
            for (int i = 0; i < 4; ++i) { const int tl = tq + 4 * (i0 + i); const int t = meta ? tl : NMETA + 32 * c + tl;
                f32x4 a0 = cb[0], a1 = cb[1];
#pragma unroll
                for (int jj = 0; jj < 4; ++jj) { const u32x4 xx = x[i][jj];
                    if (t - 3 + jj >= 0) {
                        a0.x += cw[jj][0].x * bflo(xx[0]); a0.y += cw[jj][0].y * bfhi(xx[0]); a0.z += cw[jj][0].z * bflo(xx[1]); a0.w += cw[jj][0].w * bfhi(xx[1]);
                        a1.x += cw[jj][1].x * bflo(xx[2]); a1.y += cw[jj][1].y * bfhi(xx[2]); a1.z += cw[jj][1].z * bflo(xx[3]); a1.w += cw[jj][1].w * bfhi(xx[3]); } }
                u32x4 o = (u32x4){pk2(a0.x, a0.y), pk2(a0.z, a0.w), pk2(a1.x, a1.y), pk2(a1.z, a1.w)};
                if (meta && tl >= NMETA) o = (u32x4){0u, 0u, 0u, 0u};
                *(LAS u32x4*)(lds + tl * LR_XS + ch0 * 2) = o; }
        }
    }
    LAS float* hinL = (LAS float*)(lds + 32 * LR_XS);
    if (PASS == 1) {
        float h0 = metaB[tid], h1 = metaB[tid + 512];
        const float* pa = sumA + (size_t)b * 64 * DLRU + tid; const float* pb = sumB + (size_t)b * 64 * DLRU + tid;
#pragma unroll 8
        for (int jc = 0; jc < c; ++jc) { h0 = pa[jc * DLRU] * h0 + pb[jc * DLRU]; h1 = pa[jc * DLRU + 512] * h1 + pb[jc * DLRU + 512]; }
        hinL[tid] = h0; hinL[tid + 512] = h1;
    }
    __syncthreads();
    const bf16* WaT = (const bf16*)(a.ws + WS_WAT); const bf16* WiT = (const bf16*)(a.ws + WS_WIT);
    const int r31 = lane & 31, h = lane >> 5;
    const int tau = 16 * ((r31 >> 2) & 1) + 4 * (r31 >> 3) + (r31 & 3);
#pragma unroll 1
    for (int nb = 0; nb < 2; ++nb) {
        const int n = 2 * wave + nb;
        bf16x8 af[4];
#pragma unroll
        for (int ks = 0; ks < 4; ++ks) af[ks] = *(const LAS bf16x8*)(lds + tau * LR_XS + (64 * n + 16 * ks + 8 * h) * 2);
#pragma unroll 1
        for (int nt = 0; nt < 2; ++nt) {
            const int ch = 64 * n + 32 * nt + r31;
            f32x16 accR, accI;
#pragma unroll
            for (int r = 0; r < 16; ++r) { accR[r] = 0.f; accI[r] = 0.f; }
#pragma unroll
            for (int ks = 0; ks < 4; ++ks) {
                const bf16x8 wa = *(const bf16x8*)(WaT + ((size_t)(n * 64 + 32 * nt + r31) * 64 + 16 * ks + 8 * h));
                const bf16x8 wi = *(const bf16x8*)(WiT + ((size_t)(n * 64 + 32 * nt + r31) * 64 + 16 * ks + 8 * h));
                accR = __builtin_amdgcn_mfma_f32_32x32x16_bf16(af[ks], wa, accR, 0, 0, 0);
                accI = __builtin_amdgcn_mfma_f32_32x32x16_bf16(af[ks], wi, accI, 0, 0, 0);
            }
            const float ba = a.in[I_B_A][ch], bi = a.in[I_B_I][ch], sp8 = -8.0f * 1.4426950408889634f * log1pf(__expf(-a.in[I_LAMBDA][ch]));
            float av[16], bv[16];
            float Ap = 1.0f, Bp = 0.0f;
#pragma unroll
            for (int r = 0; r < 16; ++r) {
                const float xcv = bf2f(*(const LAS unsigned short*)(lds + (16 * h + r) * LR_XS + ch * 2));
                const float rg = fast_sigmoid(accR[r] + ba), ig = fast_sigmoid(accI[r] + bi);
                const float l2a = sp8 * rg;
                av[r] = __builtin_amdgcn_exp2f(l2a); bv[r] = __builtin_amdgcn_sqrtf(fmaxf(fmaf(-av[r], av[r], 1.0f), 0.0f)) * ig * xcv;
                Ap *= av[r]; Bp = av[r] * Bp + bv[r];
                if (PASS == 0 && !meta) ((unsigned*)(a.ws + WS_AB))[((size_t)b * SEQ + 32 * c + 16 * h + r) * DLRU + ch] = pk2(l2a, bv[r]);
            }
            const float Ao = __shfl_xor(Ap, 32), Bo = __shfl_xor(Bp, 32);
            if (PASS == 0) {
                if (h == 0) {
                    if (meta) metaB[ch] = Bp;
                    else { sumA[((size_t)b * 64 + c) * DLRU + ch] = Ap * Ao; sumB[((size_t)b * 64 + c) * DLRU + ch] = Ao * Bp + Bo; }
                }
            } else {
                const float hin = hinL[ch];
                float hs = h == 0 ? hin : (Ao * hin + Bo);
#pragma unroll
                for (int r = 0; r < 16; ++r) {
                    hs = av[r] * hs + bv[r];
                    const int tl = 16 * h + r;
                    const float gt = bf2f(Z[(size_t)(b * SEQ + 32 * c + tl) * DIN + ZG + ch]);
                    *(LAS unsigned short*)(lds + tl * LR_XS + ch * 2) = (unsigned short)f2bf(hs * fast_gelu_tanh(gt));
                }
            }
        }
    }
}

__device__ __forceinline__ void lru_item_b(const Args& a, LAS unsigned char* lds, int item, int tid, int lane, int wave) {
    const int b = item >> 6, c = item & 63;
    const bf16* Z = (const bf16*)(a.ws + WS_Z); const unsigned* AB = (const unsigned*)(a.ws + WS_AB);
    const float* sumA = (const float*)(a.ws + WS_LRUSUM); const float* sumB = sumA + NBATCH * 64 * DLRU; const float* metaB = sumB + NBATCH * 64 * DLRU;
    const size_t row0 = (size_t)b * SEQ + 32 * c;
    u32x2 ab[32]; unsigned gt[32];
#pragma unroll
    for (int tl = 0; tl < 32; ++tl) { ab[tl] = *(const u32x2*)(AB + (row0 + tl) * DLRU + 2 * tid); gt[tl] = *(const unsigned*)(Z + (row0 + tl) * DIN + ZG + 2 * tid); }
    float h0, h1; { const f32x2 m = *(const f32x2*)(metaB + 2 * tid); h0 = m.x; h1 = m.y; }
    { const float* pa = sumA + (size_t)b * 64 * DLRU + 2 * tid; const float* pb = sumB + (size_t)b * 64 * DLRU + 2 * tid;
#pragma unroll 8
      for (int jc = 0; jc < c; ++jc) { const f32x2 A2 = *(const f32x2*)(pa + jc * DLRU), B2 = *(const f32x2*)(pb + jc * DLRU); h0 = A2.x * h0 + B2.x; h1 = A2.y * h1 + B2.y; } }
    __syncthreads();
#pragma unroll
    for (int tl = 0; tl < 32; ++tl) {
        h0 = __builtin_amdgcn_exp2f(bflo(ab[tl].x)) * h0 + bfhi(ab[tl].x);
        h1 = __builtin_amdgcn_exp2f(bflo(ab[tl].y)) * h1 + bfhi(ab[tl].y);
        *(LAS unsigned*)(lds + tl * LR_XS + 4 * tid) = pk2(h0 * fast_gelu_tanh(bflo(gt[tl])), h1 * fast_gelu_tanh(bfhi(gt[tl])));
    }
    lru_norm_rows(a, lds, b, c, lane, wave);
}

__device__ __forceinline__ void phase_router_mfma(const Args& a, LAS unsigned char* lds, int tid, int lane, int wave) {
    const bf16* H1 = (const bf16*)(a.ws + WS_H1); const bf16* WRT = (const bf16*)(a.ws + WS_WRT);
    int* tope = (int*)(a.ws + WS_TOPE); float* topw = (float*)(a.ws + WS_TOPW); float* rstd2 = (float*)(a.ws + WS_RSTD2);
    unsigned* counts = (unsigned*)(a.ws + WS_CTL) + CW_COUNTS;
    LAS float* lg = (LAS float*)(lds + wave * 2048);
    LAS int* hist = (LAS int*)(lds + 32768);
    if (tid < 32) hist[tid] = 0;
    __syncthreads();
    const int fr = lane & 15, fq = lane >> 4;
    for (int grp = wave * gridDim.x + blockIdx.x; grp < MREAL / 16; grp += 8 * gridDim.x) {
        const int row0 = grp * 16;
        const bf16* hp = H1 + (size_t)(row0 + fr) * D + 8 * fq;
        const bf16* wp = WRT + (size_t)fr * D + 8 * fq;
        f32x4 acc0 = (f32x4){0.f, 0.f, 0.f, 0.f}, acc1 = acc0; float ss = 0.f;
#pragma unroll 4
        for (int kk = 0; kk < 64; ++kk) {
            const u32x4 w = *(const u32x4*)(hp + 32 * kk);
#pragma unroll
            for (int q = 0; q < 4; ++q) { const float lo = bflo(w[q]), hi = bfhi(w[q]); ss += lo * lo + hi * hi; }
            const bf16x8 af = __builtin_bit_cast(bf16x8, w);
            const bf16x8 b0 = *(const bf16x8*)(wp + 32 * kk), b1 = *(const bf16x8*)(wp + (size_t)16 * D + 32 * kk);
            acc0 = __builtin_amdgcn_mfma_f32_16x16x32_bf16(af, b0, acc0, 0, 0, 0);
            acc1 = __builtin_amdgcn_mfma_f32_16x16x32_bf16(af, b1, acc1, 0, 0, 0);
        }
        ss += __shfl_xor(ss, 16); ss += __shfl_xor(ss, 32);
        const float rstd = 1.0f / sqrtf(ss * (1.0f / D) + EPS);
        if (fq == 0) rstd2[row0 + fr] = rstd;
        const float br0 = a.in[I_B_ROUTER][fr], br1 = a.in[I_B_ROUTER][16 + fr];
#pragma unroll
        for (int j = 0; j < 4; ++j) { const int row = 4 * fq + j; const float rs = __shfl(rstd, row);
            lg[row * 32 + fr] = acc0[j] * rs + br0; lg[row * 32 + 16 + fr] = acc1[j] * rs + br1; }
        asm volatile("s_waitcnt lgkmcnt(0)" ::: "memory");
        if (lane < 16) {
            float v[32];
#pragma unroll
            for (int q = 0; q < 8; ++q) { const f32x4 t = *(const LAS f32x4*)(lg + lane * 32 + 4 * q); v[4 * q] = t.x; v[4 * q + 1] = t.y; v[4 * q + 2] = t.z; v[4 * q + 3] = t.w; }
            float tv[4]; int te[4];
#pragma unroll
            for (int r = 0; r < 4; ++r) { float best = -3.0e38f; int bi = 0;
#pragma unroll
                for (int e = 0; e < 32; ++e) { const bool gtb = v[e] > best; best = gtb ? v[e] : best; bi = gtb ? e : bi; }
#pragma unroll
                for (int e = 0; e < 32; ++e) v[e] = (e == bi) ? -3.0e38f : v[e];
                tv[r] = best; te[r] = bi; }
            const float e1 = __expf(tv[1] - tv[0]), e2 = __expf(tv[2] - tv[0]), e3 = __expf(tv[3] - tv[0]);
            const float inv = 1.0f / (1.0f + e1 + e2 + e3);
            const int row = row0 + lane;
            *(int4*)(tope + row * 4) = make_int4(te[0], te[1], te[2], te[3]);
            *(f32x4*)(topw + row * 4) = (f32x4){inv, e1 * inv, e2 * inv, e3 * inv};
#pragma unroll
            for (int r = 0; r < 4; ++r) atomicAdd((int*)&hist[te[r]], 1);
        }
        asm volatile("s_waitcnt lgkmcnt(0)" ::: "memory");
    }
    __syncthreads();
    if (tid < 32 && hist[tid] != 0) atomicAdd(&counts[tid], (unsigned)hist[tid]);
}

__device__ __forceinline__ void build_tile_table(const Args& a, LAS int* tstart, int tid) {
    if (tid == 0) {
        const unsigned* counts = (const unsigned*)(a.ws + WS_CTL) + CW_COUNTS;
        int acc = 0;
        for (int e = 0; e < NEXP; ++e) { tstart[e] = acc; acc += (int)((__hip_atomic_load(counts + e, __ATOMIC_RELAXED, __HIP_MEMORY_SCOPE_AGENT) + 255u) >> 8); }
        tstart[NEXP] = acc;
    }
    __syncthreads();
}
__device__ __forceinline__ int tile_expert(const LAS int* tstart, int tile) {
    int e = 0;
#pragma unroll 1
    for (int i = 1; i < NEXP; ++i) e += (tstart[i] <= tile) ? 1 : 0;
    return e;
}

__device__ __forceinline__ void phase_assign(const Args& a, LAS unsigned char* lds, int tid, int lane, int wave) {
    LAS int* tstart = (LAS int*)(lds + LDS_TAB);
    LAS int* hist = tstart + 64; LAS int* base = hist + 32; LAS int* spos = base + 32;
    build_tile_table(a, tstart, tid);
    const int* tope = (const int*)(a.ws + WS_TOPE); const float* topw = (const float*)(a.ws + WS_TOPW); const float* rstd2 = (const float*)(a.ws + WS_RSTD2);
    int* rowpair = (int*)(a.ws + WS_ROWPAIR); float* roww = (float*)(a.ws + WS_ROWW);
    unsigned* cursor = (unsigned*)(a.ws + WS_CTL) + CW_CURSOR;
    const bf16* H1 = (const bf16*)(a.ws + WS_H1); unsigned char* XS = (unsigned char*)(a.ws + WS_XS);
    for (int blk = blockIdx.x; blk < MREAL / 64; blk += gridDim.x) {
        if (tid < 32) hist[tid] = 0;
        __syncthreads();
        int e = 0, rank = 0, pair = 0;
        if (tid < 256) { pair = blk * 256 + tid; e = tope[pair]; rank = atomicAdd((int*)&hist[e], 1); }
        __syncthreads();
        if (tid < 32) base[tid] = (int)atomicAdd(&cursor[tid], (unsigned)hist[tid]);
        __syncthreads();
        if (tid < 256) { const int pos = tstart[e] * 256 + base[e] + rank; spos[tid] = pos; rowpair[pos] = pair; roww[pos] = topw[pair]; ((int*)(a.ws + WS_PAIRPOS))[pair] = pos; }
        __syncthreads();
        for (int tt = wave * 8; tt < wave * 8 + 8; ++tt) {
            const int token = blk * 64 + tt; const float rstd = rstd2[token] * XS_SCALE;
            const u32x4* hr = (const u32x4*)(H1 + (size_t)token * D);
            u32x2 o[4];
#pragma unroll
            for (int j = 0; j < 4; ++j) { const u32x4 hv = hr[lane + 64 * j];
                const f32x4 g0 = ((const f32x4*)a.in[I_NORM_FFN])[2 * (lane + 64 * j)], g1 = ((const f32x4*)a.in[I_NORM_FFN])[2 * (lane + 64 * j) + 1];
                o[j] = (u32x2){pk4_fp8(bflo(hv[0]) * rstd * g0.x, bfhi(hv[0]) * rstd * g0.y, bflo(hv[1]) * rstd * g0.z, bfhi(hv[1]) * rstd * g0.w),
                               pk4_fp8(bflo(hv[2]) * rstd * g1.x, bfhi(hv[2]) * rstd * g1.y, bflo(hv[3]) * rstd * g1.z, bfhi(hv[3]) * rstd * g1.w)}; }
#pragma unroll
            for (int k = 0; k < 4; ++k) { u32x2* dst = (u32x2*)(XS + (size_t)spos[tt * 4 + k] * D);
#pragma unroll
                for (int j = 0; j < 4; ++j) dst[lane + 64 * j] = o[j]; }
        }
        __syncthreads();
    }
}

__device__ __forceinline__ void phase_final(const Args& a, int lane, int wave) {
    const int gw = blockIdx.x * 8 + wave, NGW = gridDim.x * 8;
    const bf16* H1 = (const bf16*)(a.ws + WS_H1); const unsigned char* YB = a.ws + WS_YB;
    const int* pairpos = (const int*)(a.ws + WS_PAIRPOS); const float* topw = (const float*)(a.ws + WS_TOPW);
    for (int row = gw; row < MREAL; row += NGW) {
        const int4 pp = *(const int4*)(pairpos + row * 4); const f32x4 pw = *(const f32x4*)(topw + row * 4) * (1.0f / YB_SCALE);
        const int pos[4] = {pp.x, pp.y, pp.z, pp.w}; const float w4[4] = {pw.x, pw.y, pw.z, pw.w};
        f32x4 v[8]; unsigned y[4][8]; float ss = 0.f;
#pragma unroll
        for (int k = 0; k < 4; ++k)
#pragma unroll
            for (int j = 0; j < 8; ++j) y[k][j] = ((const unsigned*)(YB + (size_t)pos[k] * D))[lane + 64 * j];
#pragma unroll
        for (int j = 0; j < 8; ++j) { { const u32x2 hh = ((const u32x2*)(H1 + (size_t)row * D))[lane + 64 * j]; v[j] = (f32x4){bflo(hh.x), bfhi(hh.x), bflo(hh.y), bfhi(hh.y)}; }
#pragma unroll
            for (int k = 0; k < 4; ++k) { const f32x2 lo = __builtin_amdgcn_cvt_pk_f32_fp8((int)y[k][j], false), hi = __builtin_amdgcn_cvt_pk_f32_fp8((int)y[k][j], true);
                v[j].x += w4[k] * lo.x; v[j].y += w4[k] * lo.y; v[j].z += w4[k] * hi.x; v[j].w += w4[k] * hi.y; }
            ss += (v[j].x * v[j].x + v[j].y * v[j].y) + (v[j].z * v[j].z + v[j].w * v[j].w); }
        ss = wave_sum(ss);
        const float rstd = 1.0f / sqrtf(ss * (1.0f / D) + EPS);
        f32x4* op = (f32x4*)(a.out + (size_t)row * D);
#pragma unroll
        for (int j = 0; j < 8; ++j) { const f32x4 g = ((const f32x4*)a.in[I_FINAL_NORM])[lane + 64 * j]; op[lane + 64 * j] = v[j] * rstd * g; }
    }
}

enum { PH_PROLOGUE = 0, PH_G1, PH_ATTN, PH_LRU_B, PH_G2, PH_ROUTER, PH_ASSIGN, PH_G3, PH_G4, PH_FINAL, PH_COUNT };

__global__ void __launch_bounds__(512, 2) fwd(Args a) {
    extern __shared__ __attribute__((aligned(16))) unsigned char lds_raw[];
    LAS unsigned char* lds = (LAS unsigned char*)lds_raw;
    const int tid = threadIdx.x, lane = tid & 63, wave = __builtin_amdgcn_readfirstlane(tid >> 6);
    const int gw = blockIdx.x * 8 + wave, NGW = gridDim.x * 8;
    unsigned char* ws = a.ws;
#define IN(k) (a.ph_lo <= (k) && (k) < a.ph_hi)
    pg8::BGNone nobg;
    pg8::BGConv bgup{(const char*)a.in[I_W_UP], ws + WS_WUT, (int)blockIdx.x * 128, (int)blockIdx.x * 128 + 80, ws + WS_DUMMY};
#define SEAM(k) do { if (IN(k) && IN((k) + 1)) xcd_barrier(bar); } while (0)
    if (tid < 4) ((LAS unsigned*)(lds + LDS_MISC))[tid] = 0u;
    __syncthreads();
    XcdBarrier bar; bar.bar = (unsigned*)(ws + WS_CTL) + CW_BAR; bar.x = 0; bar.st = nullptr;
    if (a.ph_hi - a.ph_lo > 1) bar = xcd_barrier_post((unsigned*)(ws + WS_CTL) + CW_BAR, (volatile LAS unsigned*)(lds + LDS_MISC));

    if (IN(PH_PROLOGUE)) { phase_prologue(a, lds, tid, lane, wave);
#if PROBE_REPEAT == 0
        __syncthreads(); phase_prologue(a, lds, tid, lane, wave);
#endif
    }
    SEAM(PH_PROLOGUE);

    if (IN(PH_G1)) {
        pg8::SchedDense S{(const char*)(ws + WS_N1), (const char*)(ws + WS_WINT), MROWS / 256, DIN / 256, (int)gridDim.x, (int)blockIdx.x, G1_FP8 ? 2048 : 4096};
        pg8::EpiZ E{(bf16*)(ws + WS_Z), a.in[I_B_IN], G1_FP8 ? 1.0f / (W_SCALE * XS_SCALE) : 1.0f};
#if BG_WUP
        pg8::gemm_phase<G1_FP8 != 0>(lds, S, E, bgup);
#else
        pg8::gemm_phase<G1_FP8 != 0>(lds, S, E, nobg);
#endif
#if PROBE_REPEAT == 1
        __syncthreads(); pg8::gemm_phase<G1_FP8 != 0>(lds, S, E, nobg);
#endif
    }
    SEAM(PH_G1);
    if (IN(PH_ATTN)) {
        for (int it = blockIdx.x; it < NBATCH * 16 * 4; it += gridDim.x) attn_item(a, lds, it, tid, lane, wave);
        for (int it = blockIdx.x; it < NBATCH * 65; it += gridDim.x) { if (it % 65 == 64 && it != 64) continue; lru_item<0>(a, lds, it, tid, lane, wave); }
#if PROBE_REPEAT == 2
        for (int it = blockIdx.x; it < NBATCH * 16 * 4; it += gridDim.x) attn_item(a, lds, it, tid, lane, wave);
#endif
#if PROBE_REPEAT == 3
        for (int it = blockIdx.x; it < NBATCH * 65; it += gridDim.x) { if (it % 65 == 64 && it != 64) continue; lru_item<0>(a, lds, it, tid, lane, wave); }
#endif
    }
    SEAM(PH_ATTN);
    if (IN(PH_LRU_B)) {
        for (int it = blockIdx.x; it < NBATCH * 64; it += gridDim.x) lru_item_b(a, lds, it, tid, lane, wave);
    }
    SEAM(PH_LRU_B);
    if (IN(PH_G2)) {
        pg8::SchedDense S{(const char*)(ws + WS_O), (const char*)(ws + WS_WOUTT), MREAL / 256, D / 256, (int)gridDim.x, (int)blockIdx.x, G2_FP8 ? 2048 : 4096};
        pg8::EpiH1 E{(bf16*)(ws + WS_H1), a.in[I_X], a.in[I_B_OUT], G2_FP8 ? 1.0f / (W_SCALE * XS_SCALE) : 1.0f};
#if BG_WUP
        pg8::gemm_phase<G2_FP8 != 0>(lds, S, E, bgup);
        for (int pair = bgup.next < bgup.end ? bgup.next : bgup.end; pair < bgup.end; ++pair) { const char* sp; unsigned char* dp; pg8::bg_pair_ptrs(bgup, pair, sp, dp);
            const int n = tid >> 4, c = tid & 15; const float* p = (const float*)sp + (size_t)(8 * c) * 2048 + n;
            *(u32x2*)(dp + (size_t)n * 2048 + 8 * c) = (u32x2){pk4_fp8(p[0] * W_SCALE, p[2048] * W_SCALE, p[4096] * W_SCALE, p[6144] * W_SCALE), pk4_fp8(p[8192] * W_SCALE, p[10240] * W_SCALE, p[12288] * W_SCALE, p[14336] * W_SCALE)}; }
#else
        pg8::gemm_phase<G2_FP8 != 0>(lds, S, E, nobg);
#endif
#if PROBE_REPEAT == 4
        __syncthreads(); pg8::gemm_phase<G2_FP8 != 0>(lds, S, E, nobg);
#endif
    }
    SEAM(PH_G2);
    if (IN(PH_ROUTER)) phase_router_mfma(a, lds, tid, lane, wave);
    SEAM(PH_ROUTER);
    if (IN(PH_ASSIGN)) phase_assign(a, lds, tid, lane, wave);
    SEAM(PH_ASSIGN);
    if (IN(PH_G3)) {
        LAS int* tstart = (LAS int*)(lds + LDS_TAB);
        build_tile_table(a, tstart, tid);
        pg8::SchedMoE S{(const char*)(ws + WS_XS), (const char*)(ws + WS_WGT), (const char*)(ws + WS_WUT), tstart, tstart[NEXP], DFF / 128, (int)gridDim.x, (int)blockIdx.x, true};
        pg8::EpiAct E{(unsigned char*)(ws + WS_ACT), a.in[I_B_GATE], a.in[I_B_UP]};
#if BG_WDOWN
        pg8::BGConv bg{(const char*)a.in[I_W_DOWN], ws + WS_WDT, (int)blockIdx.x * (32768 / 256), ((int)blockIdx.x + 1) * (32768 / 256), ws + WS_DUMMY};
        if (gridDim.x != 256) { bg.next = (int)((long)blockIdx.x * 32768 / gridDim.x); bg.end = (int)((long)(blockIdx.x + 1) * 32768 / gridDim.x); }
        pg8::gemm_phase<true>(lds, S, E, bg);
        for (int pair = bg.next < bg.end ? bg.next : bg.end; pair < bg.end; ++pair) { const char* sp; unsigned char* dp; pg8::bg_pair_ptrs(bg, pair, sp, dp);
            const int n = tid >> 4, c = tid & 15;
            const float* p = (const float*)sp + (size_t)(8 * c) * 2048 + n;
            *(u32x2*)(dp + (size_t)n * 2048 + 8 * c) = (u32x2){pk4_fp8(p[0] * W_SCALE, p[2048] * W_SCALE, p[4096] * W_SCALE, p[6144] * W_SCALE), pk4_fp8(p[8192] * W_SCALE, p[10240] * W_SCALE, p[12288] * W_SCALE, p[14336] * W_SCALE)}; }
#else
        pg8::gemm_phase<true>(lds, S, E, nobg);
#endif
#if PROBE_REPEAT == 7
        __syncthreads(); pg8::gemm_phase<true>(lds, S, E, nobg);
#endif
    }
    SEAM(PH_G3);
    if (IN(PH_G4)) {
        LAS int* tstart = (LAS int*)(lds + LDS_TAB);
        build_tile_table(a, tstart, tid);
        pg8::SchedMoE S{(const char*)(ws + WS_ACT), (const char*)(ws + WS_WDT), (const char*)(ws + WS_WDT), tstart, tstart[NEXP], D / 256, (int)gridDim.x, (int)blockIdx.x, false};
        pg8::EpiDown E{ws + WS_YB, a.in[I_B_DOWN]};
        pg8::gemm_phase<true>(lds, S, E, nobg);
#if PROBE_REPEAT == 8
        __syncthreads(); pg8::gemm_phase<true>(lds, S, E, nobg);
#endif
    }
    SEAM(PH_G4);
    if (IN(PH_FINAL)) { phase_final(a, lane, wave);
#if PROBE_REPEAT == 9
        phase_final(a, lane, wave);
#endif
    }
#undef IN
#undef SEAM
}

extern "C" void kernel_launch(void* const* d_in, const int* in_sizes, int n_in, void* d_out, int out_size, void* d_ws, size_t ws_size, hipStream_t stream) {
    static int grid = 0;
    if (grid == 0) {
        if (n_in != 27 || out_size != MREAL * D || ws_size < WS_END) { fprintf(stderr, "kernel_launch: unexpected problem (n_in %d, out %d, ws %zu)\n", n_in, out_size, ws_size); grid = -1; return; }
        int dev = 0, cus = 0;
        if (hipGetDevice(&dev) != hipSuccess || hipDeviceGetAttribute(&cus, hipDeviceAttributeMultiprocessorCount, dev) != hipSuccess) { grid = -1; return; }
        if (hipFuncSetAttribute((const void*)fwd, hipFuncAttributeMaxDynamicSharedMemorySize, LDS_BYTES) != hipSuccess) { fprintf(stderr, "kernel_launch: hipFuncSetAttribute failed\n"); grid = -1; return; }
        grid = cus;
    }
    if (grid < 0) return;
    (void)hipMemsetAsync((char*)d_ws + WS_CTL, 0, CTL_BYTES, stream);
    Args a{};
    for (int i = 0; i < 27; ++i) a.in[i] = (const float*)d_in[i];
    a.out = (float*)d_out; a.ws = (unsigned char*)d_ws;
#if MK_ONE_LAUNCH
    a.ph_lo = 0; a.ph_hi = PH_COUNT;
    hipLaunchKernelGGL(fwd, dim3(grid), dim3(512), LDS_BYTES, stream, a);
#else
    for (int ph = 0; ph < PH_COUNT; ++ph) {
        a.ph_lo = ph; a.ph_hi = ph + 1;
        hipLaunchKernelGGL(fwd, dim3(grid), dim3(512), LDS_BYTES, stream, a);
    }
#endif
}
```

```cpp
#include <hip/hip_runtime.h>
#include <cstdio>
#include <cstdint>

#define LAS __attribute__((address_space(3)))
#ifndef PROBE_REPEAT
#define PROBE_REPEAT -1
#endif
#ifndef G1_FP8
#define G1_FP8 0
#endif
#ifndef G2_FP8
#define G2_FP8 0
#endif
#ifndef BG_WDOWN
#define BG_WDOWN 1
#endif
#ifndef BG_WUP
#define BG_WUP 0
#endif
#ifndef BG_EXP
#define BG_EXP 0
#endif
#ifndef MK_ONE_LAUNCH
#define MK_ONE_LAUNCH 1
#endif
typedef unsigned short bf16;
typedef float f32x4 __attribute__((ext_vector_type(4)));
typedef float f32x2 __attribute__((ext_vector_type(2)));
typedef short bf16x8 __attribute__((ext_vector_type(8)));
typedef unsigned u32x4 __attribute__((ext_vector_type(4)));
typedef unsigned u32x2 __attribute__((ext_vector_type(2)));

constexpr int D = 2048, SEQ = 2048, NMETA = 16, TT = 2064, NBATCH = 8;
constexpr int MREAL = 16384, METAROW0 = 16384, MVALID = 16400, MROWS = 16640;
constexpr int DIN = 3584, DLRU = 1024, HD = 64;
constexpr int ZQ = 0, ZK = 1024, ZV = 1280, ZX = 1536, ZG = 2560;
constexpr int NEXP = 32, DFF = 2048, PROWS = 73728;
constexpr float EPS = 1e-5f;

constexpr size_t MiB = 1u << 20;
constexpr size_t WS_CTL = 0, CTL_BYTES = 1 * MiB;
constexpr size_t WS_COS = 1 * MiB, WS_SIN = 1 * MiB + 320 * 1024;
constexpr size_t WS_TOPE = 2 * MiB, WS_TOPW = WS_TOPE + 256 * 1024, WS_RSTD2 = WS_TOPW + 256 * 1024, WS_ROWPAIR = WS_RSTD2 + 64 * 1024, WS_ROWW = WS_ROWPAIR + 320 * 1024;
constexpr size_t WS_PAIRPOS = 3 * MiB + 256 * 1024;
constexpr size_t WS_DUMMY = 3 * MiB + 512 * 1024;
constexpr size_t WS_LRUSUM = 4 * MiB;
constexpr size_t WS_WAT = 9 * MiB, WS_WIT = WS_WAT + 128 * 1024, WS_WRT = WS_WIT + 128 * 1024;
constexpr size_t WS_WINT = 10 * MiB, WS_WOUTT = 24 * MiB, WS_WGT = 32 * MiB, WS_WUT = 288 * MiB, WS_WDT = 544 * MiB;
constexpr size_t WS_N1 = 800 * MiB, WS_Z = 866 * MiB, WS_O = 980 * MiB, WS_H1 = 1044 * MiB, WS_XS = 1172 * MiB, WS_YB = WS_XS, WS_ACT = 1460 * MiB, WS_END = 1748 * MiB;
constexpr size_t WS_N2 = WS_XS;
constexpr size_t WS_AB = WS_XS;
constexpr size_t WS_ATT = WS_N1;
constexpr size_t WS_XC = WS_XS, WS_AA = WS_XS + 66 * MiB, WS_BB = WS_XS + 132 * MiB, WS_YL = WS_XS + 198 * MiB;
static_assert(WS_ROWW + PROWS * 4 <= WS_LRUSUM, "small map");
constexpr int CW_COUNTS = 1024, CW_CURSOR = 1088, CW_BAR = 4096;

constexpr int LDS_TAB = 131072;
constexpr int LDS_META = LDS_TAB + 1024;
constexpr int LDS_RID = LDS_META + 3072;
constexpr int LDS_MISC = LDS_TAB + 8192;
constexpr int LDS_BG = LDS_MISC + 1024;
constexpr int LDS_T2 = LDS_BG + 16384;
constexpr int LDS_BYTES = LDS_T2 + 4352;
static_assert(LDS_BYTES <= 163840 && LDS_BG % 1024 == 0, "LDS map");

__device__ const float c_inv_freq[32] = {1.000000000e+00f, 7.498942018e-01f, 5.623413324e-01f, 4.216965139e-01f, 3.162277639e-01f, 2.371373922e-01f, 1.778279394e-01f, 1.333521456e-01f, 1.000000015e-01f, 7.498941571e-02f, 5.623412877e-02f, 4.216964915e-02f, 3.162277862e-02f, 2.371373586e-02f, 1.778279431e-02f, 1.333521493e-02f, 9.999999776e-03f, 7.498942316e-03f, 5.623413250e-03f, 4.216964822e-03f, 3.162277862e-03f, 2.371373819e-03f, 1.778279431e-03f, 1.333521446e-03f, 1.000000047e-03f, 7.498941850e-04f, 5.623413017e-04f, 4.216965463e-04f, 3.162277862e-04f, 2.371373848e-04f, 1.778279402e-04f, 1.333521504e-04f};

struct Args { const float* in[27]; float* out; unsigned char* ws; int ph_lo, ph_hi; };
enum { I_X = 0, I_META, I_NORM_MIX, I_W_IN, I_B_IN, I_SINKS, I_CONV_W, I_CONV_B, I_W_A, I_B_A, I_W_I, I_B_I, I_LAMBDA, I_G_ATTN, I_G_LRU, I_W_OUT, I_B_OUT, I_NORM_FFN,
       I_W_ROUTER, I_B_ROUTER, I_W_GATE, I_B_GATE, I_W_UP, I_B_UP, I_W_DOWN, I_B_DOWN, I_FINAL_NORM };


#define XB_TMO      128
#define XB_XCNT(j)  (256  + 64 * (j))
#define XB_XSUB(j)  (1280 + 64 * (j))
#define XB_XGEN(j)  (2304 + 64 * (j))
#define XB_TOP      3328
#define XB_TOPGEN   3392
#define XCD_BAR_WORDS 3456
#define XB_SPIN_CAP (1u << 18)

__device__ __forceinline__ unsigned xb_ld(unsigned* p)              { return __hip_atomic_load(p, __ATOMIC_RELAXED, __HIP_MEMORY_SCOPE_AGENT); }
__device__ __forceinline__ unsigned xb_add(unsigned* p, unsigned v) { return __hip_atomic_fetch_add(p, v, __ATOMIC_RELAXED, __HIP_MEMORY_SCOPE_AGENT); }
__device__ __forceinline__ unsigned xb_xcc_id() { return (unsigned)__builtin_amdgcn_s_getreg((3 << 11) | 20) & 0xFu; }
#define XB_SPIN(cond, bar) do { unsigned _sp = 0; while (cond) { __builtin_amdgcn_s_sleep(1); \
    if ((++_sp & 255u) == 0u) { if (xb_ld(&(bar)[XB_TMO])) break; if (_sp > XB_SPIN_CAP) { atomicAdd(&(bar)[XB_TMO], 1u); break; } } } } while (0)

struct XcdBarrier {
    unsigned* bar; unsigned x;
    volatile LAS unsigned* st;
};

__device__ __forceinline__ XcdBarrier xcd_barrier_post(unsigned* bar, volatile LAS unsigned* st) {
    XcdBarrier b; b.bar = bar; b.x = xb_xcc_id(); b.st = st;
    if (threadIdx.x == 0) (void)xb_add(&bar[XB_XCNT(b.x)], 1u);
    return b;
}
__device__ __forceinline__ void xcd_barrier_complete(unsigned* bar, unsigned x, unsigned& nloc, unsigned& nx) {
    const unsigned G = gridDim.x * gridDim.y * gridDim.z;
    unsigned sum, cnt, mine, sp = 0u;
    for (;;) {
        sum = 0u; cnt = 0u; mine = 0u;
#pragma unroll
        for (unsigned j = 0; j < 16; ++j) { const unsigned c = xb_ld(&bar[XB_XCNT(j)]); sum += c; cnt += (c > 0u) ? 1u : 0u; mine = (j == x) ? c : mine; }
        if (sum == G) break;
        __builtin_amdgcn_s_sleep(1);
        if ((++sp & 255u) == 0u) { if (xb_ld(&bar[XB_TMO])) break; if (sp > XB_SPIN_CAP) { atomicAdd(&bar[XB_TMO], 1u); break; } }
    }
    nloc = mine > 0u ? mine : 1u; nx = cnt > 0u ? cnt : 1u;
}

__device__ __forceinline__ void xcd_barrier(const XcdBarrier& b) {
    asm volatile("s_waitcnt vmcnt(0)" ::: "memory");
    __syncthreads();
    if (threadIdx.x == 0) {
        unsigned* bar = b.bar;
        __builtin_amdgcn_s_waitcnt(0);
        unsigned nloc = b.st[0], nx = b.st[1];
        if (nloc == 0u) { xcd_barrier_complete(bar, b.x, nloc, nx); b.st[0] = nloc; b.st[1] = nx; }
        const unsigned old = xb_add(&bar[XB_XSUB(b.x)], 1u);
        const unsigned gen = old / nloc;
        if (old + 1u == (gen + 1u) * nloc) {
            __builtin_amdgcn_fence(__ATOMIC_RELEASE, "agent");
            asm volatile("s_waitcnt vmcnt(0)" ::: "memory");
            const unsigned og = xb_add(&bar[XB_TOP], 1u);
            const unsigned tg = og / nx;
            if (og + 1u == (tg + 1u) * nx) xb_add(&bar[XB_TOPGEN], 1u);
            else XB_SPIN(xb_ld(&bar[XB_TOPGEN]) == tg, bar);
            __builtin_amdgcn_fence(__ATOMIC_ACQUIRE, "agent");
            xb_add(&bar[XB_XGEN(b.x)], 1u);
            asm volatile("s_waitcnt vmcnt(0)" ::: "memory");
        } else {
            XB_SPIN(xb_ld(&bar[XB_XGEN(b.x)]) == gen, bar);
            __builtin_amdgcn_fence(__ATOMIC_ACQUIRE, "agent");
            asm volatile("s_waitcnt vmcnt(0)" ::: "memory");
        }
    }
    __syncthreads();
}

__device__ __forceinline__ float bf2f(unsigned b) { return __uint_as_float((b & 0xffffu) << 16); }
__device__ __forceinline__ unsigned f2bf(float f) { unsigned u = __float_as_uint(f); return (u + 0x7fffu + ((u >> 16) & 1u)) >> 16; }
__device__ __forceinline__ unsigned pk2(float lo, float hi) { return f2bf(lo) | (f2bf(hi) << 16); }
constexpr float W_SCALE = 256.0f, XS_SCALE = 8.0f, ACT_SCALE = 4.0f, YB_SCALE = 16.0f;
__device__ __forceinline__ float clamp_fp8(float x) { return __builtin_amdgcn_fmed3f(x, -448.0f, 448.0f); }
__device__ __forceinline__ unsigned pk4_fp8(float a, float b, float c, float d) {
    int w = 0; w = __builtin_amdgcn_cvt_pk_fp8_f32(clamp_fp8(a), clamp_fp8(b), w, false); w = __builtin_amdgcn_cvt_pk_fp8_f32(clamp_fp8(c), clamp_fp8(d), w, true); return (unsigned)w; }
__device__ __forceinline__ float wave_sum(float v) {
#pragma unroll
    for (int o = 1; o < 64; o <<= 1) v += __shfl_xor(v, o);
    return v;
}
__device__ __forceinline__ float wave_max(float v) {
#pragma unroll
    for (int o = 1; o < 64; o <<= 1) v = fmaxf(v, __shfl_xor(v, o));
    return v;
}
__device__ __forceinline__ float sigmoidf_(float x) { return 1.0f / (1.0f + __expf(-x)); }
__device__ __forceinline__ float fast_sigmoid(float x) { return __builtin_amdgcn_rcpf(1.0f + __builtin_amdgcn_exp2f(-1.4426950408889634f * x)); }
__device__ __forceinline__ float fast_gelu_tanh(float x) { const float u2 = 1.5957691216057308f * (x + 0.044715f * x * x * x); return x * __builtin_amdgcn_rcpf(1.0f + __builtin_amdgcn_exp2f(-1.4426950408889634f * u2)); }
__device__ __forceinline__ float gelu_tanh(float x) { const float u = 0.7978845608028654f * (x + 0.044715f * x * x * x); return 0.5f * x * (1.0f + tanhf(u)); }
__device__ __forceinline__ int tok_row(int b, int t) { return t < NMETA ? METAROW0 + t : b * SEQ + (t - NMETA); }

__device__ __forceinline__ void transpose_item(const float* W, int K, int N, bf16* WT, LAS float* scr, int item, int lane) {
    const int nblk = N / 32, kb = item / nblk, nb = item % nblk, k0 = 64 * kb, n0 = 32 * nb;
#pragma unroll 8
    for (int i = 0; i < 32; ++i) { const int kk = 2 * i + (lane >> 5); scr[kk * 33 + (lane & 31)] = W[(size_t)(k0 + kk) * N + n0 + (lane & 31)]; }
    asm volatile("s_waitcnt lgkmcnt(0)" ::: "memory");
    const int c = lane & 7;
#pragma unroll
    for (int j = 0; j < 4; ++j) { const int n = (lane >> 3) + 8 * j; const LAS float* s = scr + (8 * c) * 33 + n;
        u32x4 o; o.x = pk2(s[0 * 33], s[1 * 33]); o.y = pk2(s[2 * 33], s[3 * 33]); o.z = pk2(s[4 * 33], s[5 * 33]); o.w = pk2(s[6 * 33], s[7 * 33]);
        *(u32x4*)(WT + (size_t)(n0 + n) * K + k0 + 8 * c) = o; }
    asm volatile("s_waitcnt lgkmcnt(0)" ::: "memory");
}

__device__ __forceinline__ void phase_prologue(const Args& a, LAS unsigned char* lds, int tid, int lane, int wave) {
    const int gw = blockIdx.x * 8 + wave, NGW = gridDim.x * 8;
    const int gt = blockIdx.x * 512 + tid, NGT = gridDim.x * 512;
    unsigned char* ws = a.ws;
    LAS float* scr = (LAS float*)(lds + wave * 8704);
    {
        constexpr int IT_IN = G1_FP8 ? 0 : 32 * (DIN / 32), IT_OUT = G2_FP8 ? 0 : 32 * (D / 32);
        for (int it = gw; it < IT_IN + IT_OUT; it += NGW) {
            if (it < IT_IN) transpose_item(a.in[I_W_IN], D, DIN, (bf16*)(ws + WS_WINT), scr, it, lane);
            else transpose_item(a.in[I_W_OUT], D, D, (bf16*)(ws + WS_WOUTT), scr, it - IT_IN, lane);
        }
        __syncthreads();
    }
    {
        LAS unsigned* T = (LAS unsigned*)lds;
        const int n4 = tid & 63, kq = tid >> 6;
        constexpr int T_IN = G1_FP8 ? (D / 128) * (DIN / 256) : 0, T_OUT = G2_FP8 ? (D / 128) * (D / 256) : 0, T_E = (D / 128) * (D / 256);
        constexpr int N_GATE = 32 * T_E, N_UP = (BG_WUP && !BG_EXP) ? 256 * 6 : 32 * T_E, N_DOWN = (BG_WDOWN && !BG_EXP) ? 0 : 32 * T_E;
        constexpr int NTILES = T_IN + T_OUT + N_GATE + N_UP + N_DOWN;
        auto tile_ptrs = [&](int tile, const float*& sp, unsigned char*& dp, int& ldn) {
            const float* sbase; unsigned char* dbase; int tl, nt;
            if (tile < T_IN) { sbase = a.in[I_W_IN]; dbase = ws + WS_WINT; tl = tile; nt = DIN / 256; ldn = DIN; }
            else if (tile < T_IN + T_OUT) { sbase = a.in[I_W_OUT]; dbase = ws + WS_WOUTT; tl = tile - T_IN; nt = D / 256; ldn = D; }
            else { int r = tile - T_IN - T_OUT, which, e; nt = D / 256; ldn = D;
                   if (r < N_GATE) { which = 0; e = r / T_E; tl = r % T_E; }
                   else if (r < N_GATE + N_UP) { r -= N_GATE; which = 1; int g = r; if (BG_WUP && !BG_EXP) g = 16 * (r / 6) + 10 + (r % 6);
                                                 e = g / T_E; tl = g % T_E; }
                   else { r -= N_GATE + N_UP; which = 2; e = r / T_E; tl = r % T_E; }
                   sbase = a.in[which == 0 ? I_W_GATE : (which == 1 ? I_W_UP : I_W_DOWN)] + (size_t)e * D * D; dbase = ws + (which == 0 ? WS_WGT : (which == 1 ? WS_WUT : WS_WDT)) + (size_t)e * D * D; }
            const int k0 = (tl / nt) * 128, n0 = (tl % nt) * 256;
            sp = sbase + (size_t)(k0 + 4 * kq) * ldn + n0 + 4 * n4; dp = dbase + (size_t)n0 * D + k0; };
#define CONV_LOAD(R, tile) do { const float* _p; unsigned char* _d; int _ld; tile_ptrs(tile, _p, _d, _ld); _Pragma("unroll") for (int i = 0; i < 4; ++i) _Pragma("unroll") for (int q = 0; q < 4; ++q) \
            R[i][q] = __builtin_nontemporal_load((const f32x4*)(_p + (size_t)(32 * i + q) * _ld)); } while (0)
#define CONV_STORE(R, tile) do { _Pragma("unroll") for (int i = 0; i < 4; ++i) { const int kd = kq + 8 * i; \
            T[(4 * n4 + 0) * 33 + kd] = pk4_fp8(R[i][0].x * W_SCALE, R[i][1].x * W_SCALE, R[i][2].x * W_SCALE, R[i][3].x * W_SCALE); \
            T[(4 * n4 + 1) * 33 + kd] = pk4_fp8(R[i][0].y * W_SCALE, R[i][1].y * W_SCALE, R[i][2].y * W_SCALE, R[i][3].y * W_SCALE); \
            T[(4 * n4 + 2) * 33 + kd] = pk4_fp8(R[i][0].z * W_SCALE, R[i][1].z * W_SCALE, R[i][2].z * W_SCALE, R[i][3].z * W_SCALE); \
            T[(4 * n4 + 3) * 33 + kd] = pk4_fp8(R[i][0].w * W_SCALE, R[i][1].w * W_SCALE, R[i][2].w * W_SCALE, R[i][3].w * W_SCALE); } \
            __syncthreads(); \
            { const float* _p; unsigned char* _d; int _ld; tile_ptrs(tile, _p, _d, _ld); _Pragma("unroll") for (int i = 0; i < 4; ++i) { const int n = (tid >> 3) + 64 * i, c = tid & 7; \
                const u32x4 o = (u32x4){T[n * 33 + 4 * c], T[n * 33 + 4 * c + 1], T[n * 33 + 4 * c + 2], T[n * 33 + 4 * c + 3]}; \
                *(u32x4*)(_d + (size_t)n * D + 16 * c) = o; } } \
            __syncthreads(); } while (0)
        f32x4 RA[4][4], RB[4][4];
        int tile = blockIdx.x;
        if (tile < NTILES) CONV_LOAD(RA, tile);
        while (tile < NTILES) {
            int nxt = tile + gridDim.x;
            if (nxt < NTILES) CONV_LOAD(RB, nxt);
            CONV_STORE(RA, tile);
            tile = nxt; if (tile >= NTILES) break;
            nxt = tile + gridDim.x;
            if (nxt < NTILES) CONV_LOAD(RA, nxt);
            CONV_STORE(RB, tile);
            tile = nxt;
        }
#undef CONV_LOAD
#undef CONV_STORE
    }
    static_assert(!G1_FP8, "n1 is written as bf16");
    for (int r = gw; r < MROWS; r += NGW) {
        u32x4* orow = (u32x4*)((bf16*)(ws + WS_N1) + (size_t)r * D);
        if (r >= MVALID) {
#pragma unroll
            for (int j = 0; j < 4; ++j) orow[lane + 64 * j] = (u32x4){0u, 0u, 0u, 0u};
            continue; }
        const f32x4* xr = (const f32x4*)(r < MREAL ? a.in[I_X] + (size_t)r * D : a.in[I_META] + (size_t)(r - MREAL) * D);
        f32x4 v[4][2]; float ss = 0.f;
#pragma unroll
        for (int j = 0; j < 4; ++j)
#pragma unroll
            for (int q = 0; q < 2; ++q) { v[j][q] = xr[2 * (lane + 64 * j) + q]; ss += (v[j][q].x * v[j][q].x + v[j][q].y * v[j][q].y) + (v[j][q].z * v[j][q].z + v[j][q].w * v[j][q].w); }
        ss = wave_sum(ss);
        const float rstd = 1.0f / sqrtf(ss * (1.0f / D) + EPS);
#pragma unroll
        for (int j = 0; j < 4; ++j) { const f32x4 g0 = ((const f32x4*)a.in[I_NORM_MIX])[2 * (lane + 64 * j)], g1 = ((const f32x4*)a.in[I_NORM_MIX])[2 * (lane + 64 * j) + 1];
            orow[lane + 64 * j] = (u32x4){pk2(v[j][0].x * rstd * g0.x, v[j][0].y * rstd * g0.y), pk2(v[j][0].z * rstd * g0.z, v[j][0].w * rstd * g0.w),
                                          pk2(v[j][1].x * rstd * g1.x, v[j][1].y * rstd * g1.y), pk2(v[j][1].z * rstd * g1.z, v[j][1].w * rstd * g1.w)}; }
    }
    float* cosT = (float*)(ws + WS_COS); float* sinT = (float*)(ws + WS_SIN);
    for (int i = gt; i < TT * 32; i += NGT) {
        const int pos = i >> 5, j = i & 31;
        const float ang = (float)pos * c_inv_freq[j];
        const double t = (double)ang * 0.15915494309189535; const float fr = (float)(t - floor(t));
        cosT[i] = __builtin_amdgcn_cosf(fr); sinT[i] = __builtin_amdgcn_sinf(fr);
    }
    { bf16* WaT = (bf16*)(ws + WS_WAT); bf16* WiT = (bf16*)(ws + WS_WIT);
      for (int i = gt; i < 16 * 64 * 64; i += NGT) { const int n = i >> 12, d = (i >> 6) & 63, cc = i & 63;
          WaT[i] = (bf16)f2bf(a.in[I_W_A][(n * 64 + cc) * 64 + d]); WiT[i] = (bf16)f2bf(a.in[I_W_I][(n * 64 + cc) * 64 + d]); } }
    { bf16* WRT = (bf16*)(ws + WS_WRT);
      for (int i = gt; i < NEXP * D; i += NGT) { const int e = i >> 11, k = i & 2047; WRT[i] = (bf16)f2bf(a.in[I_NORM_FFN][k] * a.in[I_W_ROUTER][k * NEXP + e]); } }
    int* rowpair = (int*)(ws + WS_ROWPAIR);
    for (int i = gt; i < PROWS; i += NGT) rowpair[i] = -1;
}

namespace pg8 {
constexpr int BM = 256, BK = 64, HALF = 128, HTB = HALF * BK * 2, STAGE_BYTES = 8 * HTB, NXCD = 8, WGM = 8, KD = 2048, NKT = KD / BK;
__host__ __device__ __forceinline__ int lds_byte(int r, int c) { const int st = (r >> 4) * 2 + (c >> 5), rr = r & 15, cc = c & 31, ob = rr * 64 + cc * 2; return st * 1024 + (ob ^ (((ob >> 9) & 1) << 5)); }
__host__ __device__ __forceinline__ void stage_rc(int b, int& R, int& C) { const int st = b / 1024, sb = b % 1024, swz = sb ^ (((sb >> 9) & 1) << 5); R = (st >> 1) * 16 + swz / 64; C = (st & 1) * 32 + (swz % 64) / 2; }
__host__ __device__ __forceinline__ int perm32(int rho) { const int n = rho >> 4, i = rho & 15; return 8 * (i >> 2) + 4 * n + (i & 3); }
struct Unit { unsigned a, b0, b1; int pm, pn, e; };
__device__ __forceinline__ bool static_tile(int i, int G, int c, int nM, int nN, int& pm, int& pn) {
    const int nwg = nM * nN; const long L = (long)i * G + c; if (L >= nwg) return false;
    int wgid = (int)L; { const int q = nwg / NXCD, r = nwg % NXCD, xcd = wgid % NXCD, off = wgid / NXCD; wgid = (xcd < r ? xcd * (q + 1) : r * (q + 1) + (xcd - r) * q) + off; }
    const int nig = WGM * nN, gid = wgid / nig, fm = gid * WGM, gsz = (nM - fm) < WGM ? (nM - fm) : WGM;
    pm = fm + ((wgid % nig) % gsz); pn = (wgid % nig) / gsz; return true;
}
__device__ __forceinline__ unsigned cvt_pk_bf16(float lo, float hi) { unsigned r; asm volatile("v_cvt_pk_bf16_f32 %0, %1, %2" : "=v"(r) : "v"(lo), "v"(hi)); return r; }

typedef int i32x8 __attribute__((ext_vector_type(8)));
typedef int i32x4 __attribute__((ext_vector_type(4)));
__device__ __forceinline__ i32x8 cat8(bf16x8 lo, bf16x8 hi) { const i32x4 a = __builtin_bit_cast(i32x4, lo), b = __builtin_bit_cast(i32x4, hi); return __builtin_shufflevector(a, b, 0, 1, 2, 3, 4, 5, 6, 7); }
struct BGNone { static constexpr bool ON = false; };
struct BGConv { static constexpr bool ON = true; const char* src; unsigned char* dst; int next, end; unsigned char* dummy; };
__device__ __forceinline__ void bg_pair_ptrs(const BGConv& bg, int pair, const char*& sp, unsigned char*& dp) {
    const int e = pair >> 10, kbp = (pair >> 6) & 15, nb = pair & 63;
    sp = bg.src + ((size_t)(e * 2048 + 128 * kbp) * 2048 + 32 * nb) * 4; dp = bg.dst + (size_t)e * 2048 * 2048 + (size_t)(32 * nb) * 2048 + 128 * kbp; }
template <bool FP8, class Epi, class Sched, class BG, bool GATHER = false>
__device__ __forceinline__ void gemm_phase(LAS unsigned char* lds, const Sched& S, const Epi& E, BG& bg) {
    constexpr int ROWB = FP8 ? 2048 : 4096, NKTL = ROWB / 128;
    const int tid = threadIdx.x, wid = __builtin_amdgcn_readfirstlane(tid >> 6), lane = tid & 63, wr = wid >> 2, wc = wid & 3, fr = lane & 15, fq = lane >> 4;
    unsigned voffA[2], voffB[2];
#pragma unroll
    for (int i = 0; i < 2; ++i) { int R, C; stage_rc(tid * 16 + i * 8192, R, C); const int Rb = Epi::PERM ? ((R & ~31) + perm32(R & 31)) : R;
        voffA[i] = (unsigned)(R * ROWB + C * 2); voffB[i] = (unsigned)(Rb * ROWB + C * 2); }
    constexpr unsigned KS = BK * 2, HS = HALF * ROWB;
    const unsigned ldsw = (unsigned)wid * 1024u;
    const __amdgpu_buffer_rsrc_t rsA = __builtin_amdgcn_make_buffer_rsrc((void*)S.A, 0, 0x7ffffff0, 0x00020000), rsB0 = __builtin_amdgcn_make_buffer_rsrc((void*)S.B0, 0, 0x7ffffff0, 0x00020000), rsB1 = __builtin_amdgcn_make_buffer_rsrc((void*)S.B1, 0, 0x7ffffff0, 0x00020000);
    const int aoff = lds_byte(wr * 64 + fr, fq * 8), boff = lds_byte(wc * 32 + fr, fq * 8);
#define PG8_SA(b, h) (((b) * 2 + (h)) * HTB)
#define PG8_SB(b, h) ((4 + (b) * 2 + (h)) * HTB)
#define PG8_STAGE(bufoff, rs, soff, voff) do { _Pragma("unroll") for (int _i = 0; _i < 2; ++_i) \
        __builtin_amdgcn_raw_ptr_buffer_load_lds(rs, (LAS void*)(lds + (bufoff) + ldsw + _i * 8192), 16, (int)(voff)[_i], (int)(soff), 0, 0); } while (0)
    unsigned gA[2][2] = {{0u, 0u}, {0u, 0u}}, gN[2][2] = {{0u, 0u}, {0u, 0u}};
#define PG8_GOFF(dst, slot) do { int tz_ = threadIdx.x; asm volatile("" : "+v"(tz_)); _Pragma("unroll") for (int _i = 0; _i < 2; ++_i) { int R_, C_; stage_rc(tz_ * 16 + _i * 8192, R_, C_); \
        _Pragma("unroll") for (int _h = 0; _h < 2; ++_h) { const int id_ = *(const LAS int*)(lds + LDS_RID + (slot) * 1024 + (_h * 128 + R_) * 4); dst[_h][_i] = (unsigned)((id_ < 0 ? 0 : (id_ >> 2)) * ROWB + C_ * 2); } } } while (0)
#define PG8_STAGEA(bufoff, h, soff_dense, koff, nx) do { if constexpr (GATHER) { unsigned v_[2]; v_[0] = (nx) ? gN[h][0] : gA[h][0]; v_[1] = (nx) ? gN[h][1] : gA[h][1]; PG8_STAGE(bufoff, rsA, koff, v_); } \
        else PG8_STAGE(bufoff, rsA, (soff_dense) + (h) * HS, voffA); } while (0)
#define PG8_LDA(dst, b, h) do { _Pragma("unroll") for (int m = 0; m < 4; ++m) { \
        if constexpr (FP8) dst##8[m] = __builtin_shufflevector(*(const LAS i32x4*)(lds + PG8_SA(b, h) + aoff + m * 2048), *(const LAS i32x4*)(lds + PG8_SA(b, h) + aoff + m * 2048 + 1024), 0, 1, 2, 3, 4, 5, 6, 7); \
        else { _Pragma("unroll") for (int k = 0; k < 2; ++k) dst[m][k] = *(const LAS bf16x8*)(lds + PG8_SA(b, h) + aoff + m * 2048 + k * 1024); } } } while (0)
#define PG8_LDB(dst, b, h) do { _Pragma("unroll") for (int n = 0; n < 2; ++n) { \
        if constexpr (FP8) dst##8[n] = __builtin_shufflevector(*(const LAS i32x4*)(lds + PG8_SB(b, h) + boff + n * 2048), *(const LAS i32x4*)(lds + PG8_SB(b, h) + boff + n * 2048 + 1024), 0, 1, 2, 3, 4, 5, 6, 7); \
        else { _Pragma("unroll") for (int k = 0; k < 2; ++k) dst[n][k] = *(const LAS bf16x8*)(lds + PG8_SB(b, h) + boff + n * 2048 + k * 1024); } } } while (0)
#define PG8_MMA(ai, bj, At, Bt) do { _Pragma("unroll") for (int m = 0; m < 4; ++m) _Pragma("unroll") for (int n = 0; n < 2; ++n) { \
        if constexpr (FP8) asm volatile("v_mfma_f32_16x16x128_f8f6f4 %0, %1, %2, %0" : "+v"(acc[ai][bj][m][n]) : "v"(Bt##8[n]), "v"(At##8[m])); \
        else { _Pragma("unroll") for (int k = 0; k < 2; ++k) asm volatile("v_mfma_f32_16x16x32_bf16 %0, %1, %2, %0" : "+v"(acc[ai][bj][m][n]) : "v"(Bt[n][k]), "v"(At[m][k])); } } \
        } while (0)
#define PG8_WAIT_V(n) asm volatile("s_waitcnt vmcnt(" #n ")" ::: "memory")
#define PG8_WAIT_L(n) asm volatile("s_waitcnt lgkmcnt(" #n ")" ::: "memory")
#define PG8_BAR __builtin_amdgcn_s_barrier()
#define PG8_SCHED __builtin_amdgcn_sched_barrier(0)
    Unit cur, nxt; int ui = 0; bool bg_pending = false;
    if (!S.next(0, cur)) return;
    f32x4 acc[2][2][4][2];
#pragma unroll
    for (int a = 0; a < 2; ++a)
#pragma unroll
        for (int b = 0; b < 2; ++b)
#pragma unroll
            for (int m = 0; m < 4; ++m)
#pragma unroll
                for (int n = 0; n < 2; ++n) acc[a][b][m][n] = (f32x4){0.f, 0.f, 0.f, 0.f};
    bf16x8 At[4][2], B0[2][2], B1[2][2];
    i32x8 At8[4], B08[2], B18[2];
    if constexpr (GATHER) {
        if (tid < 256) *(LAS int*)(lds + LDS_RID + tid * 4) = S.rows[cur.pm * BM + tid];
        __syncthreads();
        PG8_GOFF(gA, 0);
    }
    PG8_STAGE(PG8_SB(0, 0), rsB0, cur.b0, voffB); PG8_STAGE(PG8_SB(0, 1), rsB1, cur.b1, voffB); PG8_STAGEA(PG8_SA(0, 0), 0, cur.a, 0u, false); PG8_STAGEA(PG8_SA(0, 1), 1, cur.a, 0u, false);
    if (wr == 1) PG8_BAR;
    PG8_WAIT_V(2); PG8_BAR;
    PG8_STAGE(PG8_SB(1, 0), rsB0, cur.b0 + KS, voffB); PG8_STAGEA(PG8_SA(1, 0), 0, cur.a + KS, KS, false); PG8_STAGE(PG8_SB(1, 1), rsB1, cur.b1 + KS, voffB);
    PG8_WAIT_V(6); PG8_BAR;
    for (;;) {
        const bool has_next = S.next(ui + 1, nxt);
        const unsigned nA = has_next ? nxt.a : cur.a, nB0 = has_next ? nxt.b0 : cur.b0, nB1 = has_next ? nxt.b1 : cur.b1;
        for (int t = 0; t < NKTL; t += 2) {
            const bool last = (t == NKTL - 2);
            const unsigned a1 = cur.a + (unsigned)(t + 1) * KS;
            const unsigned a2 = last ? nA : cur.a + (unsigned)(t + 2) * KS;
            const unsigned b20 = last ? nB0 : cur.b0 + (unsigned)(t + 2) * KS, b21 = last ? nB1 : cur.b1 + (unsigned)(t + 2) * KS;
            const unsigned a3 = a2 + KS, b30 = b20 + KS, b31 = b21 + KS;
            const unsigned k1 = (unsigned)(t + 1) * KS, k2 = last ? 0u : (unsigned)(t + 2) * KS;
            if constexpr (GATHER) { if (last) { if (has_next) PG8_GOFF(gN, (ui + 1) & 1); else { gN[0][0] = gA[0][0]; gN[0][1] = gA[0][1]; gN[1][0] = gA[1][0]; gN[1][1] = gA[1][1]; } } }
            PG8_LDB(B0, 0, 0); PG8_LDB(B1, 0, 1); PG8_SCHED; PG8_LDA(At, 0, 0); PG8_STAGEA(PG8_SA(1, 1), 1, a1, k1, false);
            if constexpr (GATHER) { if (t == 2 && has_next && wid == 3) __builtin_amdgcn_global_load_lds((const unsigned*)(S.rows + nxt.pm * BM + lane * 4), (LAS unsigned*)(lds + LDS_RID + ((ui + 1) & 1) * 1024), 16, 0, 0); }
            if (t == 2) E.prefetch(cur, lds, wid, lane);
            PG8_WAIT_V(8); PG8_WAIT_L(0); PG8_BAR; PG8_MMA(0, 0, At, B0);
            if constexpr (BG::ON) {
                PG8_SCHED;
                int tz = threadIdx.x; asm volatile("" : "+v"(tz));
#pragma unroll
                for (int j = 0; j < (BG_EXP == 1 ? 0 : 2); ++j) { const LAS float* p = (const LAS float*)(lds + LDS_BG + j * 8192 + (tz >> 5) * 512 + (tz & 31) * 4);
                    ((LAS unsigned*)(lds + LDS_T2))[(tz & 31) * 33 + 16 * j + (tz >> 5)] = pk4_fp8(p[0] * W_SCALE, p[32] * W_SCALE, p[64] * W_SCALE, p[96] * W_SCALE); }
                const char* bgs; { unsigned char* dp_; pg8::bg_pair_ptrs(bg, bg.next < bg.end ? bg.next : bg.end - 1, bgs, dp_); }
                PG8_SCHED;
                if (BG_EXP != 2) {
                const unsigned bgv = (unsigned)((8 * wid + ((tz & 63) >> 3)) * 8192 + (tz & 7) * 16);
                __builtin_amdgcn_global_load_lds((const unsigned*)(bgs + bgv), (LAS unsigned*)(lds + LDS_BG + ldsw), 16, 0, 0);
                __builtin_amdgcn_global_load_lds((const unsigned*)(bgs + 524288 + bgv), (LAS unsigned*)(lds + LDS_BG + 8192 + ldsw), 16, 0, 0); }
                PG8_SCHED; }
            PG8_MMA(0, 1, At, B1);
            if constexpr (BG::ON) { PG8_WAIT_L(0); }
            PG8_BAR; PG8_SCHED;
            PG8_LDA(At, 0, 1); PG8_STAGE(PG8_SB(0, 0), rsB0, b20, voffB); PG8_STAGE(PG8_SB(0, 1), rsB1, b21, voffB); PG8_STAGEA(PG8_SA(0, 0), 0, a2, k2, last);
            if constexpr (BG::ON) { if (BG_EXP == 2) PG8_WAIT_V(8); else PG8_WAIT_V(10); } else { PG8_WAIT_V(8); }
            PG8_WAIT_L(0); PG8_BAR; PG8_MMA(1, 0, At, B0);
            if constexpr (BG::ON) {
                PG8_SCHED;
                unsigned char* bgd; { const char* sp_; pg8::bg_pair_ptrs(bg, bg.next - 1 < bg.end ? bg.next - 1 : bg.end - 1, sp_, bgd); }
                int tz = threadIdx.x; asm volatile("" : "+v"(tz));
                const LAS unsigned* q = (const LAS unsigned*)(lds + LDS_T2) + (tz >> 4) * 33 + 2 * (tz & 15);
                const u32x2 w = (u32x2){q[0], q[1]};
                if (BG_EXP != 1) *(u32x2*)((bg_pending && !BG_EXP) ? bgd + (size_t)(tz >> 4) * 2048 + 8 * (tz & 15) : bg.dummy + 8 * tz) = w;
                ++bg.next; bg_pending = true;
                PG8_SCHED; }
            PG8_MMA(1, 1, At, B1); PG8_BAR; PG8_SCHED;
            PG8_LDB(B0, 1, 0); PG8_LDB(B1, 1, 1); PG8_SCHED; PG8_LDA(At, 1, 0); PG8_STAGEA(PG8_SA(0, 1), 1, a2, k2, last);
            if constexpr (BG::ON) { if (BG_EXP == 1) PG8_WAIT_V(10); else if (BG_EXP == 2) PG8_WAIT_V(9); else PG8_WAIT_V(11); } else { PG8_WAIT_V(8); }
            PG8_WAIT_L(0); PG8_BAR; PG8_MMA(0, 0, At, B0); PG8_MMA(0, 1, At, B1); PG8_BAR; PG8_SCHED;
            PG8_LDA(At, 1, 1); PG8_STAGE(PG8_SB(1, 0), rsB0, b30, voffB); PG8_STAGE(PG8_SB(1, 1), rsB1, b31, voffB); PG8_STAGEA(PG8_SA(1, 0), 0, a3, k2 + KS, last);
            if constexpr (BG::ON) { if (BG_EXP == 1) PG8_WAIT_V(8); else PG8_WAIT_V(9); } else { PG8_WAIT_V(8); }
            PG8_WAIT_L(0); PG8_BAR; PG8_MMA(1, 0, At, B0); PG8_MMA(1, 1, At, B1); PG8_BAR; PG8_SCHED;
        }
        if (wr == 0) PG8_BAR;
        asm volatile("s_nop 15\n\ts_nop 15" ::: "memory");
        E(acc, cur, wr, wc, fr, fq, lds);
        if (!has_next) break;
#pragma unroll
        for (int a = 0; a < 2; ++a)
#pragma unroll
            for (int b = 0; b < 2; ++b)
#pragma unroll
                for (int m = 0; m < 4; ++m)
#pragma unroll
                    for (int n = 0; n < 2; ++n) acc[a][b][m][n] = (f32x4){0.f, 0.f, 0.f, 0.f};
        cur = nxt; ++ui;
        if constexpr (GATHER) { gA[0][0] = gN[0][0]; gA[0][1] = gN[0][1]; gA[1][0] = gN[1][0]; gA[1][1] = gN[1][1]; }
        if (wr == 1) PG8_BAR;
    }
    PG8_WAIT_V(0);
    PG8_BAR;
    if constexpr (BG::ON) { if (bg_pending && !BG_EXP) {
        unsigned char* bgd; { const char* sp_; pg8::bg_pair_ptrs(bg, bg.next - 1 < bg.end ? bg.next - 1 : bg.end - 1, sp_, bgd); }
#pragma unroll
        for (int j = 0; j < 2; ++j) { const LAS float* p = (const LAS float*)(lds + LDS_BG + j * 8192 + (tid >> 5) * 512 + (tid & 31) * 4);
            ((LAS unsigned*)(lds + LDS_T2))[(tid & 31) * 33 + 16 * j + (tid >> 5)] = pk4_fp8(p[0] * W_SCALE, p[32] * W_SCALE, p[64] * W_SCALE, p[96] * W_SCALE); }
        __syncthreads();
        const LAS unsigned* q = (const LAS unsigned*)(lds + LDS_T2) + (tid >> 4) * 33 + 2 * (tid & 15);
        *(u32x2*)(bgd + (size_t)(tid >> 4) * 2048 + 8 * (tid & 15)) = (u32x2){q[0], q[1]}; } }
#undef PG8_SA
#undef PG8_SB
#undef PG8_STAGE
#undef PG8_STAGEA
#undef PG8_GOFF
#undef PG8_LDA
#undef PG8_LDB
#undef PG8_MMA
#undef PG8_WAIT_V
#undef PG8_WAIT_L
#undef PG8_BAR
#undef PG8_SCHED
}

struct SchedDense {
    const char* A; const char* B0; const char* B1; const int* rows; int nM, nN, G, c, rowb;
    __device__ __forceinline__ bool next(int i, Unit& u) const {
        int pm, pn; if (!static_tile(i, G, c, nM, nN, pm, pn)) return false;
        u.pm = pm; u.pn = pn; u.e = 0; u.a = (unsigned)pm * BM * rowb; u.b0 = (unsigned)pn * BM * rowb; u.b1 = u.b0 + (unsigned)HALF * rowb; return true;
    }
};
struct SchedMoE {
    const char* A; const char* B0; const char* B1; const int* rows; const LAS int* tstart; int nM, nN, G, c; bool split;
    __device__ __forceinline__ bool next(int i, Unit& u) const {
        int pm, pn; if (!static_tile(i, G, c, nM, nN, pm, pn)) return false;
        int e = 0;
#pragma unroll 1
        for (int q = 1; q < 32; ++q) e += (tstart[q] <= pm) ? 1 : 0;
        u.pm = pm; u.pn = pn; u.e = e; u.a = (unsigned)pm * (BM * 2048);
        const unsigned eoff = (unsigned)e * (2048u * 2048u);
        if (split) { u.b0 = eoff + (unsigned)pn * (HALF * 2048); u.b1 = u.b0; }
        else { u.b0 = eoff + (unsigned)pn * (BM * 2048); u.b1 = u.b0 + (unsigned)HALF * 2048; }
        return true;
    }
};

__device__ __forceinline__ u32x4 widen16(u32x2 x, u32x2 y) {
    const auto r0 = __builtin_amdgcn_permlane16_swap(x.x, y.x, false, false), r1 = __builtin_amdgcn_permlane16_swap(x.y, y.y, false, false);
    return (u32x4){r0[0], r1[0], r0[1], r1[1]};
}
struct EpiZ {
    static constexpr bool PERM = true;
    bf16* Z; const float* bias; float sc;
    __device__ __forceinline__ void prefetch(const Unit&, LAS unsigned char*, int, int) const {}
    __device__ __forceinline__ void operator()(const f32x4 (&acc)[2][2][4][2], const Unit& u, int wr, int wc, int fr, int fq, const LAS unsigned char*) const {
        const int row0 = u.pm * BM + wr * 64 + fr, col0 = u.pn * BM + wc * 32 + 8 * fq;
        f32x4 bv[2][2];
#pragma unroll
        for (int bj = 0; bj < 2; ++bj)
#pragma unroll
            for (int n = 0; n < 2; ++n) bv[bj][n] = *(const f32x4*)(bias + col0 + bj * HALF + 4 * n);
#pragma unroll
        for (int ai = 0; ai < 2; ++ai)
#pragma unroll
            for (int m = 0; m < 4; ++m) { bf16* rowp = Z + (size_t)(row0 + ai * HALF + m * 16) * DIN + col0;
#pragma unroll
                for (int bj = 0; bj < 2; ++bj) { const f32x4 v0 = acc[ai][bj][m][0] * sc + bv[bj][0], v1 = acc[ai][bj][m][1] * sc + bv[bj][1];
                    u32x4 w; w.x = cvt_pk_bf16(v0[0], v0[1]); w.y = cvt_pk_bf16(v0[2], v0[3]); w.z = cvt_pk_bf16(v1[0], v1[1]); w.w = cvt_pk_bf16(v1[2], v1[3]);
                    *(u32x4*)(rowp + bj * HALF) = w; } }
    }
};
struct EpiH1 {
    static constexpr bool PERM = true;
    bf16* H1; const float* x; const float* bias; float sc;
    __device__ __forceinline__ void prefetch(const Unit&, LAS unsigned char*, int, int) const {}
    __device__ __forceinline__ void operator()(const f32x4 (&acc)[2][2][4][2], const Unit& u, int wr, int wc, int fr, int fq, const LAS unsigned char*) const {
        const int row0 = u.pm * BM + wr * 64 + fr, col0 = u.pn * BM + wc * 32 + 8 * fq;
        f32x4 bv[2][2];
#pragma unroll
        for (int bj = 0; bj < 2; ++bj)
#pragma unroll
            for (int n = 0; n < 2; ++n) bv[bj][n] = *(const f32x4*)(bias + col0 + bj * HALF + 4 * n);
#pragma unroll
        for (int ai = 0; ai < 2; ++ai) {
            f32x4 xv[4][2][2];
#pragma unroll
            for (int m = 0; m < 4; ++m) { const size_t ro = (size_t)(row0 + ai * HALF + m * 16) * D + col0;
#pragma unroll
                for (int bj = 0; bj < 2; ++bj) { xv[m][bj][0] = __builtin_nontemporal_load((const f32x4*)(x + ro + bj * HALF)); xv[m][bj][1] = __builtin_nontemporal_load((const f32x4*)(x + ro + bj * HALF + 4)); } }
#pragma unroll
            for (int m = 0; m < 4; ++m) { const size_t ro = (size_t)(row0 + ai * HALF + m * 16) * D + col0;
#pragma unroll
                for (int bj = 0; bj < 2; ++bj) { const f32x4 v0 = xv[m][bj][0] + acc[ai][bj][m][0] * sc + bv[bj][0], v1 = xv[m][bj][1] + acc[ai][bj][m][1] * sc + bv[bj][1];
                    u32x4 w; w.x = cvt_pk_bf16(v0[0], v0[1]); w.y = cvt_pk_bf16(v0[2], v0[3]); w.z = cvt_pk_bf16(v1[0], v1[1]); w.w = cvt_pk_bf16(v1[2], v1[3]);
                    *(u32x4*)(H1 + ro + bj * HALF) = w; } }
        }
    }
};
struct EpiAct {
    static constexpr bool PERM = true;
    unsigned char* ACT; const float* bg; const float* bu;
    __device__ __forceinline__ void prefetch(const Unit& u, LAS unsigned char* lds, int wid, int lane) const {
        if (wid == 0) { const float* p = (lane < 32 ? bg : bu) + (size_t)u.e * DFF + u.pn * HALF + (lane & 31) * 4;
            __builtin_amdgcn_global_load_lds((const unsigned*)p, (LAS unsigned*)(lds + LDS_META), 16, 0, 0); }
    }
    __device__ __forceinline__ void operator()(const f32x4 (&acc)[2][2][4][2], const Unit& u, int wr, int wc, int fr, int fq, const LAS unsigned char* lds) const {
        const int row0 = u.pm * BM + wr * 64 + fr, cl = wc * 32 + 8 * fq, col0 = u.pn * HALF + cl;
        f32x4 gv[2], uv[2];
#pragma unroll
        for (int n = 0; n < 2; ++n) { gv[n] = *(const LAS f32x4*)(lds + LDS_META + (cl + 4 * n) * 4); uv[n] = *(const LAS f32x4*)(lds + LDS_META + 512 + (cl + 4 * n) * 4); }
#pragma unroll
        for (int ai = 0; ai < 2; ++ai)
#pragma unroll
            for (int mp = 0; mp < 2; ++mp) { u32x2 pc[2];
#pragma unroll
                for (int mi = 0; mi < 2; ++mi) { const int m = 2 * mp + mi; float r[8];
#pragma unroll
                    for (int n = 0; n < 2; ++n)
#pragma unroll
                        for (int j = 0; j < 4; ++j) { float g = acc[ai][0][m][n][j] * (1.0f / (W_SCALE * XS_SCALE)) + gv[n][j], up = acc[ai][1][m][n][j] * (1.0f / (W_SCALE * XS_SCALE)) + uv[n][j];
                            g = fminf(g, 7.0f); up = fminf(fmaxf(up, -7.0f), 7.0f);
                            r[n * 4 + j] = ACT_SCALE * g * (1.0f / (1.0f + __expf(-1.702f * g))) * (up + 1.0f); }
                    pc[mi] = (u32x2){pk4_fp8(r[0], r[1], r[2], r[3]), pk4_fp8(r[4], r[5], r[6], r[7])}; }
                const u32x4 w = widen16(pc[0], pc[1]);
                const int m = 2 * mp + (fq & 1);
                *(u32x4*)(ACT + (size_t)(row0 + ai * HALF + m * 16) * DFF + col0 - 8 * (fq & 1)) = w; }
    }
};
struct EpiDown {
    static constexpr bool PERM = true;
    unsigned char* YB; const float* bd;
    __device__ __forceinline__ void prefetch(const Unit& u, LAS unsigned char* lds, int wid, int lane) const {
        if (wid == 0) __builtin_amdgcn_global_load_lds((const unsigned*)(bd + (size_t)u.e * D + u.pn * BM + lane * 4), (LAS unsigned*)(lds + LDS_META), 16, 0, 0);
    }
    __device__ __forceinline__ void operator()(const f32x4 (&acc)[2][2][4][2], const Unit& u, int wr, int wc, int fr, int fq, const LAS unsigned char* lds) const {
        const int row0 = u.pm * BM + wr * 64 + fr, cl = wc * 32 + 8 * fq, col0 = u.pn * BM + cl;
        f32x4 bv[2][2];
#pragma unroll
        for (int bj = 0; bj < 2; ++bj)
#pragma unroll
            for (int n = 0; n < 2; ++n) bv[bj][n] = *(const LAS f32x4*)(lds + LDS_META + (cl + bj * HALF + 4 * n) * 4) * YB_SCALE;
#pragma unroll
        for (int ai = 0; ai < 2; ++ai)
#pragma unroll
            for (int m = 0; m < 4; ++m) { u32x2 pc[2];
#pragma unroll
                for (int bj = 0; bj < 2; ++bj) { const f32x4 v0 = acc[ai][bj][m][0] * (YB_SCALE / (W_SCALE * ACT_SCALE)) + bv[bj][0], v1 = acc[ai][bj][m][1] * (YB_SCALE / (W_SCALE * ACT_SCALE)) + bv[bj][1];
                    pc[bj] = (u32x2){pk4_fp8(v0[0], v0[1], v0[2], v0[3]), pk4_fp8(v1[0], v1[1], v1[2], v1[3])}; }
                const u32x4 w = widen16(pc[0], pc[1]);
                *(u32x4*)(YB + (size_t)(row0 + ai * HALF + m * 16) * D + col0 + (fq & 1) * (HALF - 8)) = w; }
    }
};
}


typedef float f32x16 __attribute__((ext_vector_type(16)));
constexpr int AT_KS = 144, AT_VS = 584, AT_KOFF = 0, AT_VOFF = 288 * AT_KS;
__device__ __forceinline__ float bflo(unsigned w) { return __uint_as_float(w << 16); }
__device__ __forceinline__ float bfhi(unsigned w) { return __uint_as_float(w & 0xffff0000u); }

__device__ __forceinline__ void attn_tile(LAS unsigned char* lds, int slot_base, int kind, int j, int lane, int hq,
                                          const bf16x8 (&qf)[2][4], f32x16 (&oacc)[2][2], float (&mrow)[2], float (&lrow)[2]) {
    const int r31 = lane & 31, h = lane >> 5;
    bf16x8 kf[4], vf[2][2];
#pragma unroll
    for (int ks = 0; ks < 4; ++ks) kf[ks] = *(const LAS bf16x8*)(lds + AT_KOFF + (slot_base + r31) * AT_KS + (16 * ks + 8 * h) * 2);
#pragma unroll
    for (int dt = 0; dt < 2; ++dt)
#pragma unroll
        for (int sp = 0; sp < 2; ++sp) { const LAS unsigned char* p = lds + AT_VOFF + (32 * dt + r31) * AT_VS + (slot_base + 16 * sp + 4 * h) * 2;
            const u32x2 lo = *(const LAS u32x2*)p, hi = *(const LAS u32x2*)(p + 16);
            const u32x4 w = (u32x4){lo.x, lo.y, hi.x, hi.y}; vf[dt][sp] = __builtin_bit_cast(bf16x8, w); }
#pragma unroll
    for (int qt = 0; qt < 2; ++qt) {
        f32x16 s;
#pragma unroll
        for (int r = 0; r < 16; ++r) s[r] = 0.f;
#pragma unroll
        for (int ks = 0; ks < 4; ++ks) s = __builtin_amdgcn_mfma_f32_32x32x16_bf16(kf[ks], qf[qt][ks], s, 0, 0, 0);
        const int i = 64 * hq + 32 * qt + r31;
        float mx = -1.0e30f;
#pragma unroll
        for (int r = 0; r < 16; ++r) { const int key = (r & 3) + 8 * (r >> 2) + 4 * h;
            const bool ok = kind == 0 ? (key < 16) : (kind == 1 ? (32 * j + key >= i + 1) : (32 * j + key <= i));
            s[r] = ok ? s[r] : -1.0e30f; mx = fmaxf(mx, s[r]); }
        mx = fmaxf(mx, __shfl_xor(mx, 32));
        const float mn = fmaxf(mrow[qt], mx), al = __expf(mrow[qt] - mn); mrow[qt] = mn;
        float ps = 0.f;
#pragma unroll
        for (int r = 0; r < 16; ++r) { s[r] = __expf(s[r] - mn); ps += s[r]; }
        lrow[qt] = lrow[qt] * al + ps;
#pragma unroll
        for (int dt = 0; dt < 2; ++dt)
#pragma unroll
            for (int r = 0; r < 16; ++r) oacc[qt][dt][r] *= al;
        bf16x8 pf[2];
#pragma unroll
        for (int sp = 0; sp < 2; ++sp) { const u32x4 w = (u32x4){pk2(s[8 * sp + 0], s[8 * sp + 1]), pk2(s[8 * sp + 2], s[8 * sp + 3]), pk2(s[8 * sp + 4], s[8 * sp + 5]), pk2(s[8 * sp + 6], s[8 * sp + 7])};
            pf[sp] = __builtin_bit_cast(bf16x8, w); }
#pragma unroll
        for (int dt = 0; dt < 2; ++dt)
#pragma unroll
            for (int sp = 0; sp < 2; ++sp) oacc[qt][dt] = __builtin_amdgcn_mfma_f32_32x32x16_bf16(vf[dt][sp], pf[sp], oacc[qt][dt], 0, 0, 0);
    }
}

__device__ __forceinline__ void attn_item(const Args& a, LAS unsigned char* lds, int item, int tid, int lane, int wave) {
    const int kvh = item & 3, qblk = (item >> 2) & 15, b = item >> 6;
    const bf16* Z = (const bf16*)(a.ws + WS_Z); bf16* O = (bf16*)(a.ws + (G2_FP8 ? WS_ATT : WS_O)); constexpr int OLD = G2_FP8 ? 1024 : D;
    const float* cosT = (const float*)(a.ws + WS_COS); const float* sinT = (const float*)(a.ws + WS_SIN);
    __syncthreads();
    for (int task = tid; task < 288 * 4; task += 512) {
        const int slot = task >> 2, c = task & 3;
        int krow, kpos; bool valid;
        if (slot < 32) { valid = slot < NMETA; krow = METAROW0 + slot; kpos = slot; }
        else { const int sp = 128 * (qblk - 1) + (slot - 32); valid = sp >= 0; krow = b * SEQ + sp; kpos = NMETA + sp; }
        u32x4 lo = (u32x4){0u, 0u, 0u, 0u}, hi = lo;
        if (valid) {
            const bf16* kp = Z + (size_t)krow * DIN + ZK + kvh * 64 + c * 8;
            const u32x4 x1 = *(const u32x4*)kp, x2 = *(const u32x4*)(kp + 32);
            const f32x4 c0 = *(const f32x4*)(cosT + kpos * 32 + c * 8), c1 = *(const f32x4*)(cosT + kpos * 32 + c * 8 + 4);
            const f32x4 s0 = *(const f32x4*)(sinT + kpos * 32 + c * 8), s1 = *(const f32x4*)(sinT + kpos * 32 + c * 8 + 4);
#pragma unroll
            for (int q = 0; q < 4; ++q) { const float ca = q < 2 ? c0[2 * q] : c1[2 * q - 4], cb = q < 2 ? c0[2 * q + 1] : c1[2 * q - 3], sa = q < 2 ? s0[2 * q] : s1[2 * q - 4], sb = q < 2 ? s0[2 * q + 1] : s1[2 * q - 3];
                const float a0 = bflo(x1[q]), a1 = bfhi(x1[q]), b0 = bflo(x2[q]), b1 = bfhi(x2[q]);
                lo[q] = pk2(a0 * ca - b0 * sa, a1 * cb - b1 * sb); hi[q] = pk2(b0 * ca + a0 * sa, b1 * cb + a1 * sb); }
        }
        *(LAS u32x4*)(lds + AT_KOFF + slot * AT_KS + c * 16) = lo; *(LAS u32x4*)(lds + AT_KOFF + slot * AT_KS + 64 + c * 16) = hi;
    }
    for (int task = tid; task < 144 * 8; task += 512) {
        const int slot0 = (task >> 3) * 2, c = task & 7;
        int vrow; bool valid;
        if (slot0 < 32) { valid = slot0 < NMETA; vrow = METAROW0 + slot0; }
        else { const int sp = 128 * (qblk - 1) + (slot0 - 32); valid = sp >= 0; vrow = b * SEQ + sp; }
        u32x4 v0 = (u32x4){0u, 0u, 0u, 0u}, v1 = v0;
        if (valid) { const bf16* vp = Z + (size_t)vrow * DIN + ZV + kvh * 64 + c * 8; v0 = *(const u32x4*)vp; v1 = *(const u32x4*)(vp + DIN); }
#pragma unroll
        for (int q = 0; q < 4; ++q) {
            *(LAS unsigned*)(lds + AT_VOFF + (c * 8 + 2 * q) * AT_VS + slot0 * 2) = (v0[q] & 0xffffu) | (v1[q] << 16);
            *(LAS unsigned*)(lds + AT_VOFF + (c * 8 + 2 * q + 1) * AT_VS + slot0 * 2) = (v0[q] >> 16) | (v1[q] & 0xffff0000u); }
    }
    const int g = wave >> 1, hq = wave & 1, head = kvh * 4 + g, r31 = lane & 31, h = lane >> 5;
    bf16x8 qf[2][4];
#pragma unroll
    for (int qt = 0; qt < 2; ++qt) {
        const int s = 128 * qblk + 64 * hq + 32 * qt + r31, pos = NMETA + s;
        const bf16* qp = Z + (size_t)(b * SEQ + s) * DIN + ZQ + head * 64 + 8 * h;
        u32x4 x[4];
#pragma unroll
        for (int ks = 0; ks < 4; ++ks) x[ks] = *(const u32x4*)(qp + 16 * ks);
#pragma unroll
        for (int ks = 0; ks < 2; ++ks) {
            const float* cp = cosT + pos * 32 + 16 * ks + 8 * h; const float* sp = sinT + pos * 32 + 16 * ks + 8 * h;
            const f32x4 c0 = *(const f32x4*)cp, c1 = *(const f32x4*)(cp + 4), s0 = *(const f32x4*)sp, s1 = *(const f32x4*)(sp + 4);
            u32x4 lo, hi;
#pragma unroll
            for (int q = 0; q < 4; ++q) { const float ca = q < 2 ? c0[2 * q] : c1[2 * q - 4], cb = q < 2 ? c0[2 * q + 1] : c1[2 * q - 3], sa = q < 2 ? s0[2 * q] : s1[2 * q - 4], sb = q < 2 ? s0[2 * q + 1] : s1[2 * q - 3];
                const float a0 = bflo(x[ks][q]), a1 = bfhi(x[ks][q]), b0 = bflo(x[ks + 2][q]), b1 = bfhi(x[ks + 2][q]);
                lo[q] = pk2(0.125f * (a0 * ca - b0 * sa), 0.125f * (a1 * cb - b1 * sb)); hi[q] = pk2(0.125f * (b0 * ca + a0 * sa), 0.125f * (b1 * cb + a1 * sb)); }
            qf[qt][ks] = __builtin_bit_cast(bf16x8, lo); qf[qt][ks + 2] = __builtin_bit_cast(bf16x8, hi);
        }
    }
    f32x16 oacc[2][2]; float mrow[2], lrow[2];
#pragma unroll
    for (int qt = 0; qt < 2; ++qt) { mrow[qt] = a.in[I_SINKS][head]; lrow[qt] = h == 0 ? 1.0f : 0.0f;
#pragma unroll
        for (int dt = 0; dt < 2; ++dt)
#pragma unroll
            for (int r = 0; r < 16; ++r) oacc[qt][dt][r] = 0.f; }
    __syncthreads();
    attn_tile(lds, 0, 0, 0, lane, hq, qf, oacc, mrow, lrow);
    if (qblk > 0) {
#pragma unroll 1
        for (int j = hq ? 2 : 0; j < 4; ++j) attn_tile(lds, 32 + 32 * j, 1, j, lane, hq, qf, oacc, mrow, lrow);
    }
#pragma unroll 1
    for (int j = 0; j < (hq ? 4 : 2); ++j) attn_tile(lds, 160 + 32 * j, 2, j, lane, hq, qf, oacc, mrow, lrow);
#pragma unroll
    for (int qt = 0; qt < 2; ++qt) {
        const float lt = lrow[qt] + __shfl_xor(lrow[qt], 32), inv = 1.0f / lt;
        bf16* op = O + (size_t)(b * SEQ + 128 * qblk + 64 * hq + 32 * qt + r31) * OLD + head * 64 + 4 * h;
#pragma unroll
        for (int dt = 0; dt < 2; ++dt)
#pragma unroll
            for (int rr = 0; rr < 4; ++rr)
                *(u32x2*)(op + 32 * dt + 8 * rr) = (u32x2){pk2(oacc[qt][dt][4 * rr] * inv, oacc[qt][dt][4 * rr + 1] * inv), pk2(oacc[qt][dt][4 * rr + 2] * inv, oacc[qt][dt][4 * rr + 3] * inv)};
    }
}

constexpr int LR_XS = 2064;
__device__ __forceinline__ void lru_norm_rows(const Args& a, LAS unsigned char* lds, int b, int c, int lane, int wave) {
        bf16* O = (bf16*)(a.ws + WS_O); unsigned char* O8 = a.ws + WS_O;
        const bf16* ATT = (const bf16*)(a.ws + (G2_FP8 ? WS_ATT : WS_O)); constexpr int ALD = G2_FP8 ? 1024 : D;
        u32x4 aw[4][2];
#pragma unroll
        for (int q = 0; q < 4; ++q)
#pragma unroll
            for (int jj = 0; jj < 2; ++jj) aw[q][jj] = *(const u32x4*)(ATT + ((size_t)b * SEQ + 32 * c + 4 * wave + q) * ALD + (lane + 64 * jj) * 8);
        f32x4 ga[2][2], gl[2][2];
#pragma unroll
        for (int jj = 0; jj < 2; ++jj) { ga[jj][0] = *(const f32x4*)(a.in[I_G_ATTN] + (lane + 64 * jj) * 8); ga[jj][1] = *(const f32x4*)(a.in[I_G_ATTN] + (lane + 64 * jj) * 8 + 4);
            gl[jj][0] = *(const f32x4*)(a.in[I_G_LRU] + (lane + 64 * jj) * 8); gl[jj][1] = *(const f32x4*)(a.in[I_G_LRU] + (lane + 64 * jj) * 8 + 4); }
        __syncthreads();
#pragma unroll
        for (int q = 0; q < 4; ++q) {
            const int tl = 4 * wave + q; const size_t row = (size_t)b * SEQ + 32 * c + tl;
#pragma unroll
            for (int half = 0; half < 2; ++half) {
                u32x4 w[2]; float v[16]; float ss = 0.f;
#pragma unroll
                for (int jj = 0; jj < 2; ++jj) { w[jj] = half == 0 ? *(const LAS u32x4*)(lds + tl * LR_XS + (lane + 64 * jj) * 16) : aw[q][jj];
#pragma unroll
                    for (int k = 0; k < 4; ++k) { v[jj * 8 + 2 * k] = bflo(w[jj][k]); v[jj * 8 + 2 * k + 1] = bfhi(w[jj][k]); } }
#pragma unroll
                for (int k = 0; k < 16; ++k) ss += v[k] * v[k];
                ss = wave_sum(ss);
                const float rstd = (G2_FP8 ? XS_SCALE : 1.0f) * __builtin_amdgcn_rsqf(ss * (1.0f / 1024.0f) + EPS);
#pragma unroll
                for (int jj = 0; jj < 2; ++jj) { const f32x4 g0 = half == 0 ? gl[jj][0] : ga[jj][0], g1 = half == 0 ? gl[jj][1] : ga[jj][1];
                    const size_t col = (half == 0 ? 1024 : 0) + (lane + 64 * jj) * 8;
                    if (G2_FP8) *(u32x2*)(O8 + row * D + col) = (u32x2){pk4_fp8(v[jj * 8 + 0] * rstd * g0.x, v[jj * 8 + 1] * rstd * g0.y, v[jj * 8 + 2] * rstd * g0.z, v[jj * 8 + 3] * rstd * g0.w),
                                                                       pk4_fp8(v[jj * 8 + 4] * rstd * g1.x, v[jj * 8 + 5] * rstd * g1.y, v[jj * 8 + 6] * rstd * g1.z, v[jj * 8 + 7] * rstd * g1.w)};
                    else *(u32x4*)(O + row * D + col) = (u32x4){pk2(v[jj * 8 + 0] * rstd * g0.x, v[jj * 8 + 1] * rstd * g0.y), pk2(v[jj * 8 + 2] * rstd * g0.z, v[jj * 8 + 3] * rstd * g0.w),
                                                                pk2(v[jj * 8 + 4] * rstd * g1.x, v[jj * 8 + 5] * rstd * g1.y), pk2(v[jj * 8 + 6] * rstd * g1.z, v[jj * 8 + 7] * rstd * g1.w)}; }
            }
        }
}
template <int PASS>
__device__ __forceinline__ void lru_item(const Args& a, LAS unsigned char* lds, int item, int tid, int lane, int wave) {
    const int b = item / 65, c = item % 65; const bool meta = (c == 64);
    const bf16* Z = (const bf16*)(a.ws + WS_Z);
    float* sumA = (float*)(a.ws + WS_LRUSUM); float* sumB = sumA + NBATCH * 64 * DLRU; float* metaB = sumB + NBATCH * 64 * DLRU;
    __syncthreads();
    {
        const int ch0 = (tid & 127) * 8, tq = tid >> 7;
        f32x4 cw[4][2], cb[2];
#pragma unroll
        for (int jj = 0; jj < 4; ++jj) { cw[jj][0] = *(const f32x4*)(a.in[I_CONV_W] + jj * DLRU + ch0); cw[jj][1] = *(const f32x4*)(a.in[I_CONV_W] + jj * DLRU + ch0 + 4); }
        cb[0] = *(const f32x4*)(a.in[I_CONV_B] + ch0); cb[1] = *(const f32x4*)(a.in[I_CONV_B] + ch0 + 4);
#pragma unroll 1
        for (int i0 = 0; i0 < 8; i0 += 4) {
            u32x4 x[4][4];
#pragma unroll
            for (int i = 0; i < 4; ++i) { const int tl = tq + 4 * (i0 + i); const int t = meta ? tl : NMETA + 32 * c + tl;
#pragma unroll
                for (int jj = 0; jj < 4; ++jj) { const int tt = t - 3 + jj; x[i][jj] = (u32x4){0u, 0u, 0u, 0u};
                    if (tt >= 0 && !(meta && tl >= NMETA)) x[i][jj] = *(const u32x4*)(Z + (size_t)tok_row(b, tt) * DIN + ZX + ch0); } }
#pragma unroll
            for (int i = 0; i < 4; ++i) { const int tl = tq + 4 * (i0 + i); const int t = meta ? tl : NMETA + 32 * c + tl;
                f32x4 a0 = cb[0], a1 = cb[1];
#pragma unroll
                for (int jj = 0; jj < 4; ++jj) { const u32x4 xx = x[i][jj];
                    if (t - 3 + jj >= 0) {
                        a0.x += cw[jj][0].x * bflo(xx[0]); a0.y += cw[jj][0].y * bfhi(xx[0]); a0.z += cw[jj][0].z * bflo(xx[1]); a0.w += cw[jj][0].w * bfhi(xx[1]);
                        a1.x += cw[jj][1].x * bflo(xx[2]); a1.y += cw[jj][1].y * bfhi(xx[2]); a1.z += cw[jj][1].z * bflo(xx[3]); a1.w += cw[jj][1].w * bfhi(xx[3]); } }
                u32x4 o = (u32x4){pk2(a0.x, a0.y), pk2(a0.z, a0.w), pk2(a1.x, a1.y), pk2(a1.z, a1.w)};
                if (meta && tl >= NMETA) o = (u32x4){0u, 0u, 0u, 0u};
                *(LAS u32x4*)(lds + tl * LR_XS + ch0 * 2) = o; }
        }
    }
    LAS float* hinL = (LAS float*)(lds + 32 * LR_XS);
    if (PASS == 1) {
        float h0 = metaB[tid], h1 = metaB[tid + 512];
        const float* pa = sumA + (size_t)b * 64 * DLRU + tid; const float* pb = sumB + (size_t)b * 64 * DLRU + tid;
#pragma unroll 8
        for (int jc = 0; jc < c; ++jc) { h0 = pa[jc * DLRU] * h0 + pb[jc * DLRU]; h1 = pa[jc * DLRU + 512] * h1 + pb[jc * DLRU + 512]; }
        hinL[tid] = h0; hinL[tid + 512] = h1;
    }
    __syncthreads();
    const bf16* WaT = (const bf16*)(a.ws + WS_WAT); const bf16* WiT = (const bf16*)(a.ws + WS_WIT);
    const int r31 = lane & 31, h = lane >> 5;
    const int tau = 16 * ((r31 >> 2) & 1) + 4 * (r31 >> 3) + (r31 & 3);
#pragma unroll 1
    for (int nb = 0; nb < 2; ++nb) {
        const int n = 2 * wave + nb;
        bf16x8 af[4];
#pragma unroll
        for (int ks = 0; ks < 4; ++ks) af[ks] = *(const LAS bf16x8*)(lds + tau * LR_XS + (64 * n + 16 * ks + 8 * h) * 2);
#pragma unroll 1
        for (int nt = 0; nt < 2; ++nt) {
            const int ch = 64 * n + 32 * nt + r31;
            f32x16 accR, accI;
#pragma unroll
            for (int r = 0; r < 16; ++r) { accR[r] = 0.f; accI[r] = 0.f; }
#pragma unroll
            for (int ks = 0; ks < 4; ++ks) {
                const bf16x8 wa = *(const bf16x8*)(WaT + ((size_t)(n * 64 + 32 * nt + r31) * 64 + 16 * ks + 8 * h));
                const bf16x8 wi = *(const bf16x8*)(WiT + ((size_t)(n * 64 + 32 * nt + r31) * 64 + 16 * ks + 8 * h));
                accR = __builtin_amdgcn_mfma_f32_32x32x16_bf16(af[ks], wa, accR, 0, 0, 0);
                accI = __builtin_amdgcn_mfma_f32_32x32x16_bf16(af[ks], wi, accI, 0, 0, 0);
            }
            const float ba = a.in[I_B_A][ch], bi = a.in[I_B_I][ch], sp8 = -8.0f * 1.4426950408889634f * log1pf(__expf(-a.in[I_LAMBDA][ch]));
            float av[16], bv[16];
            float Ap = 1.0f, Bp = 0.0f;
#pragma unroll
            for (int r = 0; r < 16; ++r) {
                const float xcv = bf2f(*(const LAS unsigned short*)(lds + (16 * h + r) * LR_XS + ch * 2));
                const float rg = fast_sigmoid(accR[r] + ba), ig = fast_sigmoid(accI[r] + bi);
                const float l2a = sp8 * rg;
                av[r] = __builtin_amdgcn_exp2f(l2a); bv[r] = __builtin_amdgcn_sqrtf(fmaxf(fmaf(-av[r], av[r], 1.0f), 0.0f)) * ig * xcv;
                Ap *= av[r]; Bp = av[r] * Bp + bv[r];
                if (PASS == 0 && !meta) ((unsigned*)(a.ws + WS_AB))[((size_t)b * SEQ + 32 * c + 16 * h + r) * DLRU + ch] = pk2(l2a, bv[r]);
            }
            const float Ao = __shfl_xor(Ap, 32), Bo = __shfl_xor(Bp, 32);
            if (PASS == 0) {
                if (h == 0) {
                    if (meta) metaB[ch] = Bp;
                    else { sumA[((size_t)b * 64 + c) * DLRU + ch] = Ap * Ao; sumB[((size_t)b * 64 + c) * DLRU + ch] = Ao * Bp + Bo; }
                }
            } else {
                const float hin = hinL[ch];
                float hs = h == 0 ? hin : (Ao * hin + Bo);
#pragma unroll
                for (int r = 0; r < 16; ++r) {
                    hs = av[r] * hs + bv[r];
                    const int tl = 16 * h + r;
                    const float gt = bf2f(Z[(size_t)(b * SEQ + 32 * c + tl) * DIN + ZG + ch]);
                    *(LAS unsigned short*)(lds + tl * LR_XS + ch * 2) = (unsigned short)f2bf(hs * fast_gelu_tanh(gt));
                }
            }
        }
    }
}

__device__ __forceinline__ void lru_item_b(const Args& a, LAS unsigned char* lds, int item, int tid, int lane, int wave) {
    const int b = item >> 6, c = item & 63;
    const bf16* Z = (const bf16*)(a.ws + WS_Z); const unsigned* AB = (const unsigned*)(a.ws + WS_AB);
    const float* sumA = (const float*)(a.ws + WS_LRUSUM); const float* sumB = sumA + NBATCH * 64 * DLRU; const float* metaB = sumB + NBATCH * 64 * DLRU;
    const size_t row0 = (size_t)b * SEQ + 32 * c;
    u32x2 ab[32]; unsigned gt[32];
#pragma unroll
    for (int tl = 0; tl < 32; ++tl) { ab[tl] = *(const u32x2*)(AB + (row0 + tl) * DLRU + 2 * tid); gt[tl] = *(const unsigned*)(Z + (row0 + tl) * DIN + ZG + 2 * tid); }
    float h0, h1; { const f32x2 m = *(const f32x2*)(metaB + 2 * tid); h0 = m.x; h1 = m.y; }
    { const float* pa = sumA + (size_t)b * 64 * DLRU + 2 * tid; const float* pb = sumB + (size_t)b * 64 * DLRU + 2 * tid;
#pragma unroll 8
      for (int jc = 0; jc < c; ++jc) { const f32x2 A2 = *(const f32x2*)(pa + jc * DLRU), B2 = *(const f32x2*)(pb + jc * DLRU); h0 = A2.x * h0 + B2.x; h1 = A2.y * h1 + B2.y; } }
    __syncthreads();
#pragma unroll
    for (int tl = 0; tl < 32; ++tl) {
        h0 = __builtin_amdgcn_exp2f(bflo(ab[tl].x)) * h0 + bfhi(ab[tl].x);
        h1 = __builtin_amdgcn_exp2f(bflo(ab[tl].y)) * h1 + bfhi(ab[tl].y);
        *(LAS unsigned*)(lds + tl * LR_XS + 4 * tid) = pk2(h0 * fast_gelu_tanh(bflo(gt[tl])), h1 * fast_gelu_tanh(bfhi(gt[tl])));
    }
    lru_norm_rows(a, lds, b, c, lane, wave);
}

__device__ __forceinline__ void phase_router_mfma(const Args& a, LAS unsigned char* lds, int tid, int lane, int wave) {
    const bf16* H1 = (const bf16*)(a.ws + WS_H1); const bf16* WRT = (const bf16*)(a.ws + WS_WRT);
    int* tope = (int*)(a.ws + WS_TOPE); float* topw = (float*)(a.ws + WS_TOPW); float* rstd2 = (float*)(a.ws + WS_RSTD2);
    unsigned* counts = (unsigned*)(a.ws + WS_CTL) + CW_COUNTS;
    LAS float* lg = (LAS float*)(lds + wave * 2048);
    LAS int* hist = (LAS int*)(lds + 32768);
    if (tid < 32) hist[tid] = 0;
    __syncthreads();
    const int fr = lane & 15, fq = lane >> 4;
    for (int grp = wave * gridDim.x + blockIdx.x; grp < MREAL / 16; grp += 8 * gridDim.x) {
        const int row0 = grp * 16;
        const bf16* hp = H1 + (size_t)(row0 + fr) * D + 8 * fq;
        const bf16* wp = WRT + (size_t)fr * D + 8 * fq;
        f32x4 acc0 = (f32x4){0.f, 0.f, 0.f, 0.f}, acc1 = acc0; float ss = 0.f;
#pragma unroll 4
        for (int kk = 0; kk < 64; ++kk) {
            const u32x4 w = *(const u32x4*)(hp + 32 * kk);
#pragma unroll
            for (int q = 0; q < 4; ++q) { const float lo = bflo(w[q]), hi = bfhi(w[q]); ss += lo * lo + hi * hi; }
            const bf16x8 af = __builtin_bit_cast(bf16x8, w);
            const bf16x8 b0 = *(const bf16x8*)(wp + 32 * kk), b1 = *(const bf16x8*)(wp + (size_t)16 * D + 32 * kk);
            acc0 = __builtin_amdgcn_mfma_f32_16x16x32_bf16(af, b0, acc0, 0, 0, 0);
            acc1 = __builtin_amdgcn_mfma_f32_16x16x32_bf16(af, b1, acc1, 0, 0, 0);
        }
        ss += __shfl_xor(ss, 16); ss += __shfl_xor(ss, 32);
        const float rstd = 1.0f / sqrtf(ss * (1.0f / D) + EPS);
        if (fq == 0) rstd2[row0 + fr] = rstd;
        const float br0 = a.in[I_B_ROUTER][fr], br1 = a.in[I_B_ROUTER][16 + fr];
#pragma unroll
        for (int j = 0; j < 4; ++j) { const int row = 4 * fq + j; const float rs = __shfl(rstd, row);
            lg[row * 32 + fr] = acc0[j] * rs + br0; lg[row * 32 + 16 + fr] = acc1[j] * rs + br1; }
        asm volatile("s_waitcnt lgkmcnt(0)" ::: "memory");
        if (lane < 16) {
            float v[32];
#pragma unroll
            for (int q = 0; q < 8; ++q) { const f32x4 t = *(const LAS f32x4*)(lg + lane * 32 + 4 * q); v[4 * q] = t.x; v[4 * q + 1] = t.y; v[4 * q + 2] = t.z; v[4 * q + 3] = t.w; }
            float tv[4]; int te[4];
#pragma unroll
            for (int r = 0; r < 4; ++r) { float best = -3.0e38f; int bi = 0;
#pragma unroll
                for (int e = 0; e < 32; ++e) { const bool gtb = v[e] > best; best = gtb ? v[e] : best; bi = gtb ? e : bi; }
#pragma unroll
                for (int e = 0; e < 32; ++e) v[e] = (e == bi) ? -3.0e38f : v[e];
                tv[r] = best; te[r] = bi; }
            const float e1 = __expf(tv[1] - tv[0]), e2 = __expf(tv[2] - tv[0]), e3 = __expf(tv[3] - tv[0]);
            const float inv = 1.0f / (1.0f + e1 + e2 + e3);
            const int row = row0 + lane;
            *(int4*)(tope + row * 4) = make_int4(te[0], te[1], te[2], te[3]);
            *(f32x4*)(topw + row * 4) = (f32x4){inv, e1 * inv, e2 * inv, e3 * inv};
#pragma unroll
            for (int r = 0; r < 4; ++r) atomicAdd((int*)&hist[te[r]], 1);
        }
        asm volatile("s_waitcnt lgkmcnt(0)" ::: "memory");
    }
    __syncthreads();
    if (tid < 32 && hist[tid] != 0) atomicAdd(&counts[tid], (unsigned)hist[tid]);
}

__device__ __forceinline__ void build_tile_table(const Args& a, LAS int* tstart, int tid) {
    if (tid == 0) {
        const unsigned* counts = (const unsigned*)(a.ws + WS_CTL) + CW_COUNTS;
        int acc = 0;
        for (int e = 0; e < NEXP; ++e) { tstart[e] = acc; acc += (int)((__hip_atomic_load(counts + e, __ATOMIC_RELAXED, __HIP_MEMORY_SCOPE_AGENT) + 255u) >> 8); }
        tstart[NEXP] = acc;
    }
    __syncthreads();
}
__device__ __forceinline__ int tile_expert(const LAS int* tstart, int tile) {
    int e = 0;
#pragma unroll 1
    for (int i = 1; i < NEXP; ++i) e += (tstart[i] <= tile) ? 1 : 0;
    return e;
}

__device__ __forceinline__ void phase_assign(const Args& a, LAS unsigned char* lds, int tid, int lane, int wave) {
    LAS int* tstart = (LAS int*)(lds + LDS_TAB);
    LAS int* hist = tstart + 64; LAS int* base = hist + 32; LAS int* spos = base + 32;
    build_tile_table(a, tstart, tid);
    const int* tope = (const int*)(a.ws + WS_TOPE); const float* topw = (const float*)(a.ws + WS_TOPW); const float* rstd2 = (const float*)(a.ws + WS_RSTD2);
    int* rowpair = (int*)(a.ws + WS_ROWPAIR); float* roww = (float*)(a.ws + WS_ROWW);
    unsigned* cursor = (unsigned*)(a.ws + WS_CTL) + CW_CURSOR;
    const bf16* H1 = (const bf16*)(a.ws + WS_H1); unsigned char* XS = (unsigned char*)(a.ws + WS_XS);
    for (int blk = blockIdx.x; blk < MREAL / 64; blk += gridDim.x) {
        if (tid < 32) hist[tid] = 0;
        __syncthreads();
        int e = 0, rank = 0, pair = 0;
        if (tid < 256) { pair = blk * 256 + tid; e = tope[pair]; rank = atomicAdd((int*)&hist[e], 1); }
        __syncthreads();
        if (tid < 32) base[tid] = (int)atomicAdd(&cursor[tid], (unsigned)hist[tid]);
        __syncthreads();
        if (tid < 256) { const int pos = tstart[e] * 256 + base[e] + rank; spos[tid] = pos; rowpair[pos] = pair; roww[pos] = topw[pair]; ((int*)(a.ws + WS_PAIRPOS))[pair] = pos; }
        __syncthreads();
        for (int tt = wave * 8; tt < wave * 8 + 8; ++tt) {
            const int token = blk * 64 + tt; const float rstd = rstd2[token] * XS_SCALE;
            const u32x4* hr = (const u32x4*)(H1 + (size_t)token * D);
            u32x4* dst = (u32x4*)(XS + (size_t)token * D);
#pragma unroll
            for (int j = 0; j < 2; ++j) { const u32x4 ha = hr[2 * (lane + 64 * j)], hb = hr[2 * (lane + 64 * j) + 1];
                const f32x4* gp = (const f32x4*)a.in[I_NORM_FFN] + 4 * (lane + 64 * j); const f32x4 g0 = gp[0], g1 = gp[1], g2 = gp[2], g3 = gp[3];
                dst[lane + 64 * j] = (u32x4){pk4_fp8(bflo(ha[0]) * rstd * g0.x, bfhi(ha[0]) * rstd * g0.y, bflo(ha[1]) * rstd * g0.z, bfhi(ha[1]) * rstd * g0.w),
                                             pk4_fp8(bflo(ha[2]) * rstd * g1.x, bfhi(ha[2]) * rstd * g1.y, bflo(ha[3]) * rstd * g1.z, bfhi(ha[3]) * rstd * g1.w),
                                             pk4_fp8(bflo(hb[0]) * rstd * g2.x, bfhi(hb[0]) * rstd * g2.y, bflo(hb[1]) * rstd * g2.z, bfhi(hb[1]) * rstd * g2.w),
                                             pk4_fp8(bflo(hb[2]) * rstd * g3.x, bfhi(hb[2]) * rstd * g3.y, bflo(hb[3]) * rstd * g3.z, bfhi(hb[3]) * rstd * g3.w)}; }
        }
        __syncthreads();
    }
}

__device__ __forceinline__ void phase_final(const Args& a, int lane, int wave) {
    const int gw = blockIdx.x * 8 + wave, NGW = gridDim.x * 8;
    const bf16* H1 = (const bf16*)(a.ws + WS_H1); const unsigned char* YB = a.ws + WS_YB;
    const int* pairpos = (const int*)(a.ws + WS_PAIRPOS); const float* topw = (const float*)(a.ws + WS_TOPW);
    for (int row = gw; row < MREAL; row += NGW) {
        const int4 pp = *(const int4*)(pairpos + row * 4); const f32x4 pw = *(const f32x4*)(topw + row * 4) * (1.0f / YB_SCALE);
        const int pos[4] = {pp.x, pp.y, pp.z, pp.w}; const float w4[4] = {pw.x, pw.y, pw.z, pw.w};
        f32x4 v[8]; unsigned y[4][8]; float ss = 0.f;
#pragma unroll
        for (int k = 0; k < 4; ++k)
#pragma unroll
            for (int j = 0; j < 8; ++j) y[k][j] = ((const unsigned*)(YB + (size_t)pos[k] * D))[lane + 64 * j];
#pragma unroll
        for (int j = 0; j < 8; ++j) { { const u32x2 hh = ((const u32x2*)(H1 + (size_t)row * D))[lane + 64 * j]; v[j] = (f32x4){bflo(hh.x), bfhi(hh.x), bflo(hh.y), bfhi(hh.y)}; }
#pragma unroll
            for (int k = 0; k < 4; ++k) { const f32x2 lo = __builtin_amdgcn_cvt_pk_f32_fp8((int)y[k][j], false), hi = __builtin_amdgcn_cvt_pk_f32_fp8((int)y[k][j], true);
                v[j].x += w4[k] * lo.x; v[j].y += w4[k] * lo.y; v[j].z += w4[k] * hi.x; v[j].w += w4[k] * hi.y; }
            ss += (v[j].x * v[j].x + v[j].y * v[j].y) + (v[j].z * v[j].z + v[j].w * v[j].w); }
        ss = wave_sum(ss);
        const float rstd = 1.0f / sqrtf(ss * (1.0f / D) + EPS);
        f32x4* op = (f32x4*)(a.out + (size_t)row * D);
#pragma unroll
        for (int j = 0; j < 8; ++j) { const f32x4 g = ((const f32x4*)a.in[I_FINAL_NORM])[lane + 64 * j]; op[lane + 64 * j] = v[j] * rstd * g; }
    }
}

enum { PH_PROLOGUE = 0, PH_G1, PH_ATTN, PH_LRU_B, PH_G2, PH_ROUTER, PH_ASSIGN, PH_G3, PH_G4, PH_FINAL, PH_COUNT };

__global__ void __launch_bounds__(512, 2) fwd(Args a) {
    extern __shared__ __attribute__((aligned(16))) unsigned char lds_raw[];
    LAS unsigned char* lds = (LAS unsigned char*)lds_raw;
    const int tid = threadIdx.x, lane = tid & 63, wave = __builtin_amdgcn_readfirstlane(tid >> 6);
    const int gw = blockIdx.x * 8 + wave, NGW = gridDim.x * 8;
    unsigned char* ws = a.ws;
#define IN(k) (a.ph_lo <= (k) && (k) < a.ph_hi)
    pg8::BGNone nobg;
    pg8::BGConv bgup{(const char*)a.in[I_W_UP], ws + WS_WUT, (int)blockIdx.x * 128, (int)blockIdx.x * 128 + 80, ws + WS_DUMMY};
#define SEAM(k) do { if (IN(k) && IN((k) + 1)) xcd_barrier(bar); } while (0)
    if (tid < 4) ((LAS unsigned*)(lds + LDS_MISC))[tid] = 0u;
    __syncthreads();
    XcdBarrier bar; bar.bar = (unsigned*)(ws + WS_CTL) + CW_BAR; bar.x = 0; bar.st = nullptr;
    if (a.ph_hi - a.ph_lo > 1) bar = xcd_barrier_post((unsigned*)(ws + WS_CTL) + CW_BAR, (volatile LAS unsigned*)(lds + LDS_MISC));

    if (IN(PH_PROLOGUE)) { phase_prologue(a, lds, tid, lane, wave);
#if PROBE_REPEAT == 0
        __syncthreads(); phase_prologue(a, lds, tid, lane, wave);
#endif
    }
    SEAM(PH_PROLOGUE);

    if (IN(PH_G1)) {
        pg8::SchedDense S{(const char*)(ws + WS_N1), (const char*)(ws + WS_WINT), (const char*)(ws + WS_WINT), nullptr, MROWS / 256, DIN / 256, (int)gridDim.x, (int)blockIdx.x, G1_FP8 ? 2048 : 4096};
        pg8::EpiZ E{(bf16*)(ws + WS_Z), a.in[I_B_IN], G1_FP8 ? 1.0f / (W_SCALE * XS_SCALE) : 1.0f};
#if BG_WUP
        pg8::gemm_phase<G1_FP8 != 0>(lds, S, E, bgup);
#else
        pg8::gemm_phase<G1_FP8 != 0>(lds, S, E, nobg);
#endif
#if PROBE_REPEAT == 1
        __syncthreads(); pg8::gemm_phase<G1_FP8 != 0>(lds, S, E, nobg);
#endif
    }
    SEAM(PH_G1);
    if (IN(PH_ATTN)) {
        for (int it = blockIdx.x; it < NBATCH * 16 * 4; it += gridDim.x) attn_item(a, lds, it, tid, lane, wave);
        for (int it = blockIdx.x; it < NBATCH * 65; it += gridDim.x) { if (it % 65 == 64 && it != 64) continue; lru_item<0>(a, lds, it, tid, lane, wave); }
#if PROBE_REPEAT == 2
        for (int it = blockIdx.x; it < NBATCH * 16 * 4; it += gridDim.x) attn_item(a, lds, it, tid, lane, wave);
#endif
#if PROBE_REPEAT == 3
        for (int it = blockIdx.x; it < NBATCH * 65; it += gridDim.x) { if (it % 65 == 64 && it != 64) continue; lru_item<0>(a, lds, it, tid, lane, wave); }
#endif
    }
    SEAM(PH_ATTN);
    if (IN(PH_LRU_B)) {
        for (int it = blockIdx.x; it < NBATCH * 64; it += gridDim.x) lru_item_b(a, lds, it, tid, lane, wave);
    }
    SEAM(PH_LRU_B);
    if (IN(PH_G2)) {
        pg8::SchedDense S{(const char*)(ws + WS_O), (const char*)(ws + WS_WOUTT), (const char*)(ws + WS_WOUTT), nullptr, MREAL / 256, D / 256, (int)gridDim.x, (int)blockIdx.x, G2_FP8 ? 2048 : 4096};
        pg8::EpiH1 E{(bf16*)(ws + WS_H1), a.in[I_X], a.in[I_B_OUT], G2_FP8 ? 1.0f / (W_SCALE * XS_SCALE) : 1.0f};
#if BG_WUP
        pg8::gemm_phase<G2_FP8 != 0>(lds, S, E, bgup);
        for (int pair = bgup.next < bgup.end ? bgup.next : bgup.end; pair < bgup.end; ++pair) { const char* sp; unsigned char* dp; pg8::bg_pair_ptrs(bgup, pair, sp, dp);
            const int n = tid >> 4, c = tid & 15; const float* p = (const float*)sp + (size_t)(8 * c) * 2048 + n;
            *(u32x2*)(dp + (size_t)n * 2048 + 8 * c) = (u32x2){pk4_fp8(p[0] * W_SCALE, p[2048] * W_SCALE, p[4096] * W_SCALE, p[6144] * W_SCALE), pk4_fp8(p[8192] * W_SCALE, p[10240] * W_SCALE, p[12288] * W_SCALE, p[14336] * W_SCALE)}; }
#else
        pg8::gemm_phase<G2_FP8 != 0>(lds, S, E, nobg);
#endif
#if PROBE_REPEAT == 4
        __syncthreads(); pg8::gemm_phase<G2_FP8 != 0>(lds, S, E, nobg);
#endif
    }
    SEAM(PH_G2);
    if (IN(PH_ROUTER)) phase_router_mfma(a, lds, tid, lane, wave);
    SEAM(PH_ROUTER);
    if (IN(PH_ASSIGN)) phase_assign(a, lds, tid, lane, wave);
    SEAM(PH_ASSIGN);
    if (IN(PH_G3)) {
        LAS int* tstart = (LAS int*)(lds + LDS_TAB);
        build_tile_table(a, tstart, tid);
        pg8::SchedMoE S{(const char*)(ws + WS_N2), (const char*)(ws + WS_WGT), (const char*)(ws + WS_WUT), (const int*)(ws + WS_ROWPAIR), tstart, tstart[NEXP], DFF / 128, (int)gridDim.x, (int)blockIdx.x, true};
        pg8::EpiAct E{(unsigned char*)(ws + WS_ACT), a.in[I_B_GATE], a.in[I_B_UP]};
#if BG_WDOWN
        pg8::BGConv bg{(const char*)a.in[I_W_DOWN], ws + WS_WDT, (int)blockIdx.x * (32768 / 256), ((int)blockIdx.x + 1) * (32768 / 256), ws + WS_DUMMY};
        if (gridDim.x != 256) { bg.next = (int)((long)blockIdx.x * 32768 / gridDim.x); bg.end = (int)((long)(blockIdx.x + 1) * 32768 / gridDim.x); }
        pg8::gemm_phase<true, pg8::EpiAct, pg8::SchedMoE, pg8::BGConv, true>(lds, S, E, bg);
        for (int pair = bg.next < bg.end ? bg.next : bg.end; pair < bg.end; ++pair) { const char* sp; unsigned char* dp; pg8::bg_pair_ptrs(bg, pair, sp, dp);
            const int n = tid >> 4, c = tid & 15;
            const float* p = (const float*)sp + (size_t)(8 * c) * 2048 + n;
            *(u32x2*)(dp + (size_t)n * 2048 + 8 * c) = (u32x2){pk4_fp8(p[0] * W_SCALE, p[2048] * W_SCALE, p[4096] * W_SCALE, p[6144] * W_SCALE), pk4_fp8(p[8192] * W_SCALE, p[10240] * W_SCALE, p[12288] * W_SCALE, p[14336] * W_SCALE)}; }
#else
        pg8::gemm_phase<true>(lds, S, E, nobg);
#endif
#if PROBE_REPEAT == 7
        __syncthreads(); pg8::gemm_phase<true>(lds, S, E, nobg);
#endif
    }
    SEAM(PH_G3);
    if (IN(PH_G4)) {
        LAS int* tstart = (LAS int*)(lds + LDS_TAB);
        build_tile_table(a, tstart, tid);
        pg8::SchedMoE S{(const char*)(ws + WS_ACT), (const char*)(ws + WS_WDT), (const char*)(ws + WS_WDT), nullptr, tstart, tstart[NEXP], D / 256, (int)gridDim.x, (int)blockIdx.x, false};
        pg8::EpiDown E{ws + WS_YB, a.in[I_B_DOWN]};
        pg8::gemm_phase<true>(lds, S, E, nobg);
#if PROBE_REPEAT == 8
        __syncthreads(); pg8::gemm_phase<true>(lds, S, E, nobg);
#endif
    }
    SEAM(PH_G4);
    if (IN(PH_FINAL)) { phase_final(a, lane, wave);
#if PROBE_REPEAT == 9
        phase_final(a, lane, wave);
#endif
    }
#undef IN
#undef SEAM
}

extern "C" void kernel_launch(void* const* d_in, const int* in_sizes, int n_in, void* d_out, int out_size, void* d_ws, size_t ws_size, hipStream_t stream) {
    static int grid = 0;
    if (grid == 0) {
        if (n_in != 27 || out_size != MREAL * D || ws_size < WS_END) { fprintf(stderr, "kernel_launch: unexpected problem (n_in %d, out %d, ws %zu)\n", n_in, out_size, ws_size); grid = -1; return; }
        int dev = 0, cus = 0;
        if (hipGetDevice(&dev) != hipSuccess || hipDeviceGetAttribute(&cus, hipDeviceAttributeMultiprocessorCount, dev) != hipSuccess) { grid = -1; return; }
        if (hipFuncSetAttribute((const void*)fwd, hipFuncAttributeMaxDynamicSharedMemorySize, LDS_BYTES) != hipSuccess) { fprintf(stderr, "kernel_launch: hipFuncSetAttribute failed\n"); grid = -1; return; }
        grid = cus;
    }
    if (grid < 0) return;
    (void)hipMemsetAsync((char*)d_ws + WS_CTL, 0, CTL_BYTES, stream);
    Args a{};
    for (int i = 0; i < 27; ++i) a.in[i] = (const float*)d_in[i];
    a.out = (float*)d_out; a.ws = (unsigned char*)d_ws;
#if MK_ONE_LAUNCH
    a.ph_lo = 0; a.ph_hi = PH_COUNT;
    hipLaunchKernelGGL(fwd, dim3(grid), dim3(512), LDS_BYTES, stream, a);
#else
    for (int ph = 0; ph < PH_COUNT; ++ph) {
        a.ph_lo = ph; a.ph_hi = ph + 1;
        hipLaunchKernelGGL(fwd, dim3(grid), dim3(512), LDS_BYTES, stream, a);
    }
#endif
}
```

```cpp
#include <hip/hip_runtime.h>
#include <cstdio>
#include <cstdint>

#define LAS __attribute__((address_space(3)))
#ifndef PROBE_REPEAT
#define PROBE_REPEAT -1
#endif
#ifndef G1_FP8
#define G1_FP8 0
#endif
#ifndef G2_FP8
#define G2_FP8 0
#endif
#ifndef BG_WDOWN
#define BG_WDOWN 1
#endif
#ifndef BG_WUP
#define BG_WUP 0
#endif
#ifndef BG_EXP
#define BG_EXP 0
#endif
#ifndef MK_ONE_LAUNCH
#define MK_ONE_LAUNCH 1
#endif
typedef unsigned short bf16;
typedef float f32x4 __attribute__((ext_vector_type(4)));
typedef float f32x2 __attribute__((ext_vector_type(2)));
typedef short bf16x8 __attribute__((ext_vector_type(8)));
typedef unsigned u32x4 __attribute__((ext_vector_type(4)));
typedef unsigned u32x2 __attribute__((ext_vector_type(2)));

constexpr int D = 2048, SEQ = 2048, NMETA = 16, TT = 2064, NBATCH = 8;
constexpr int MREAL = 16384, METAROW0 = 16384, MVALID = 16400, MROWS = 16640;
constexpr int DIN = 3584, DLRU = 1024, HD = 64;
constexpr int ZQ = 0, ZK = 1024, ZV = 1280, ZX = 1536, ZG = 2560;
constexpr int NEXP = 32, DFF = 2048, PROWS = 73728;
constexpr float EPS = 1e-5f;

constexpr size_t MiB = 1u << 20;
constexpr size_t WS_CTL = 0, CTL_BYTES = 1 * MiB;
constexpr size_t WS_COS = 1 * MiB, WS_SIN = 1 * MiB + 320 * 1024;
constexpr size_t WS_TOPE = 2 * MiB, WS_TOPW = WS_TOPE + 256 * 1024, WS_RSTD2 = WS_TOPW + 256 * 1024, WS_ROWPAIR = WS_RSTD2 + 64 * 1024, WS_ROWW = WS_ROWPAIR + 320 * 1024;
constexpr size_t WS_PAIRPOS = 3 * MiB + 256 * 1024;
constexpr size_t WS_DUMMY = 3 * MiB + 512 * 1024;
constexpr size_t WS_LRUSUM = 4 * MiB;
constexpr size_t WS_WAT = 9 * MiB, WS_WIT = WS_WAT + 128 * 1024, WS_WRT = WS_WIT + 128 * 1024;
constexpr size_t WS_WINT = 10 * MiB, WS_WOUTT = 24 * MiB, WS_WGT = 32 * MiB, WS_WUT = 288 * MiB, WS_WDT = 544 * MiB;
constexpr size_t WS_N1 = 800 * MiB, WS_Z = 866 * MiB, WS_O = 980 * MiB, WS_H1 = 1044 * MiB, WS_XS = 1172 * MiB, WS_YB = WS_XS, WS_ACT = 1460 * MiB, WS_END = 1748 * MiB;
constexpr size_t WS_N2 = WS_XS;
constexpr size_t WS_AB = WS_XS;
constexpr size_t WS_ATT = WS_N1;
constexpr size_t WS_XC = WS_XS, WS_AA = WS_XS + 66 * MiB, WS_BB = WS_XS + 132 * MiB, WS_YL = WS_XS + 198 * MiB;
static_assert(WS_ROWW + PROWS * 4 <= WS_LRUSUM, "small map");
constexpr int CW_COUNTS = 1024, CW_CURSOR = 1088, CW_BAR = 4096;

constexpr int LDS_TAB = 131072;
constexpr int LDS_META = LDS_TAB + 1024;
constexpr int LDS_RID = LDS_META + 3072;
constexpr int LDS_MISC = LDS_TAB + 8192;
constexpr int LDS_BG = LDS_MISC + 1024;
constexpr int LDS_T2 = LDS_BG + 16384;
constexpr int LDS_BYTES = LDS_T2 + 4352;
static_assert(LDS_BYTES <= 163840 && LDS_BG % 1024 == 0, "LDS map");

__device__ const float c_inv_freq[32] = {1.000000000e+00f, 7.498942018e-01f, 5.623413324e-01f, 4.216965139e-01f, 3.162277639e-01f, 2.371373922e-01f, 1.778279394e-01f, 1.333521456e-01f, 1.000000015e-01f, 7.498941571e-02f, 5.623412877e-02f, 4.216964915e-02f, 3.162277862e-02f, 2.371373586e-02f, 1.778279431e-02f, 1.333521493e-02f, 9.999999776e-03f, 7.498942316e-03f, 5.623413250e-03f, 4.216964822e-03f, 3.162277862e-03f, 2.371373819e-03f, 1.778279431e-03f, 1.333521446e-03f, 1.000000047e-03f, 7.498941850e-04f, 5.623413017e-04f, 4.216965463e-04f, 3.162277862e-04f, 2.371373848e-04f, 1.778279402e-04f, 1.333521504e-04f};

struct Args { const float* in[27]; float* out; unsigned char* ws; int ph_lo, ph_hi; };
enum { I_X = 0, I_META, I_NORM_MIX, I_W_IN, I_B_IN, I_SINKS, I_CONV_W, I_CONV_B, I_W_A, I_B_A, I_W_I, I_B_I, I_LAMBDA, I_G_ATTN, I_G_LRU, I_W_OUT, I_B_OUT, I_NORM_FFN,
       I_W_ROUTER, I_B_ROUTER, I_W_GATE, I_B_GATE, I_W_UP, I_B_UP, I_W_DOWN, I_B_DOWN, I_FINAL_NORM };


#define XB_TMO      128
#define XB_XCNT(j)  (256  + 64 * (j))
#define XB_XSUB(j)  (1280 + 64 * (j))
#define XB_XGEN(j)  (2304 + 64 * (j))
#define XB_TOP      3328
#define XB_TOPGEN   3392
#define XCD_BAR_WORDS 3456
#define XB_SPIN_CAP (1u << 18)

__device__ __forceinline__ unsigned xb_ld(unsigned* p)              { return __hip_atomic_load(p, __ATOMIC_RELAXED, __HIP_MEMORY_SCOPE_AGENT); }
__device__ __forceinline__ unsigned xb_add(unsigned* p, unsigned v) { return __hip_atomic_fetch_add(p, v, __ATOMIC_RELAXED, __HIP_MEMORY_SCOPE_AGENT); }
__device__ __forceinline__ unsigned xb_xcc_id() { return (unsigned)__builtin_amdgcn_s_getreg((3 << 11) | 20) & 0xFu; }
#define XB_SPIN(cond, bar) do { unsigned _sp = 0; while (cond) { __builtin_amdgcn_s_sleep(1); \
    if ((++_sp & 255u) == 0u) { if (xb_ld(&(bar)[XB_TMO])) break; if (_sp > XB_SPIN_CAP) { atomicAdd(&(bar)[XB_TMO], 1u); break; } } } } while (0)

struct XcdBarrier {
    unsigned* bar; unsigned x;
    volatile LAS unsigned* st;
};

__device__ __forceinline__ XcdBarrier xcd_barrier_post(unsigned* bar, volatile LAS unsigned* st) {
    XcdBarrier b; b.bar = bar; b.x = xb_xcc_id(); b.st = st;
    if (threadIdx.x == 0) (void)xb_add(&bar[XB_XCNT(b.x)], 1u);
    return b;
}
__device__ __forceinline__ void xcd_barrier_complete(unsigned* bar, unsigned x, unsigned& nloc, unsigned& nx) {
    const unsigned G = gridDim.x * gridDim.y * gridDim.z;
    unsigned sum, cnt, mine, sp = 0u;
    for (;;) {
        sum = 0u; cnt = 0u; mine = 0u;
#pragma unroll
        for (unsigned j = 0; j < 16; ++j) { const unsigned c = xb_ld(&bar[XB_XCNT(j)]); sum += c; cnt += (c > 0u) ? 1u : 0u; mine = (j == x) ? c : mine; }
        if (sum == G) break;
        __builtin_amdgcn_s_sleep(1);
        if ((++sp & 255u) == 0u) { if (xb_ld(&bar[XB_TMO])) break; if (sp > XB_SPIN_CAP) { atomicAdd(&bar[XB_TMO], 1u); break; } }
    }
    nloc = mine > 0u ? mine : 1u; nx = cnt > 0u ? cnt : 1u;
}

__device__ __forceinline__ void xcd_barrier(const XcdBarrier& b) {
    asm volatile("s_waitcnt vmcnt(0)" ::: "memory");
    __syncthreads();
    if (threadIdx.x == 0) {
        unsigned* bar = b.bar;
        __builtin_amdgcn_s_waitcnt(0);
        unsigned nloc = b.st[0], nx = b.st[1];
        if (nloc == 0u) { xcd_barrier_complete(bar, b.x, nloc, nx); b.st[0] = nloc; b.st[1] = nx; }
        const unsigned old = xb_add(&bar[XB_XSUB(b.x)], 1u);
        const unsigned gen = old / nloc;
        if (old + 1u == (gen + 1u) * nloc) {
            __builtin_amdgcn_fence(__ATOMIC_RELEASE, "agent");
            asm volatile("s_waitcnt vmcnt(0)" ::: "memory");
            const unsigned og = xb_add(&bar[XB_TOP], 1u);
            const unsigned tg = og / nx;
            if (og + 1u == (tg + 1u) * nx) xb_add(&bar[XB_TOPGEN], 1u);
            else XB_SPIN(xb_ld(&bar[XB_TOPGEN]) == tg, bar);
            __builtin_amdgcn_fence(__ATOMIC_ACQUIRE, "agent");
            xb_add(&bar[XB_XGEN(b.x)], 1u);
            asm volatile("s_waitcnt vmcnt(0)" ::: "memory");
        } else {
            XB_SPIN(xb_ld(&bar[XB_XGEN(b.x)]) == gen, bar);
            __builtin_amdgcn_fence(__ATOMIC_ACQUIRE, "agent");
            asm volatile("s_waitcnt vmcnt(0)" ::: "memory");
        }
    }
    __syncthreads();
}

__device__ __forceinline__ float bf2f(unsigned b) { return __uint_as_float((b & 0xffffu) << 16); }
__device__ __forceinline__ unsigned f2bf(float f) { unsigned u = __float_as_uint(f); return (u + 0x7fffu + ((u >> 16) & 1u)) >> 16; }
__device__ __forceinline__ unsigned pk2(float lo, float hi) { return f2bf(lo) | (f2bf(hi) << 16); }
constexpr float W_SCALE = 256.0f, XS_SCALE = 8.0f, ACT_SCALE = 4.0f, YB_SCALE = 16.0f;
__device__ __forceinline__ float clamp_fp8(float x) { return __builtin_amdgcn_fmed3f(x, -448.0f, 448.0f); }
__device__ __forceinline__ unsigned pk4_fp8(float a, float b, float c, float d) {
    int w = 0; w = __builtin_amdgcn_cvt_pk_fp8_f32(clamp_fp8(a), clamp_fp8(b), w, false); w = __builtin_amdgcn_cvt_pk_fp8_f32(clamp_fp8(c), clamp_fp8(d), w, true); return (unsigned)w; }
__device__ __forceinline__ float wave_sum(float v) {
#pragma unroll
    for (int o = 1; o < 64; o <<= 1) v += __shfl_xor(v, o);
    return v;
}
__device__ __forceinline__ float wave_max(float v) {
#pragma unroll
    for (int o = 1; o < 64; o <<= 1) v = fmaxf(v, __shfl_xor(v, o));
    return v;
}
__device__ __forceinline__ float sigmoidf_(float x) { return 1.0f / (1.0f + __expf(-x)); }
__device__ __forceinline__ float fast_sigmoid(float x) { return __builtin_amdgcn_rcpf(1.0f + __builtin_amdgcn_exp2f(-1.4426950408889634f * x)); }
__device__ __forceinline__ float fast_gelu_tanh(float x) { const float u2 = 1.5957691216057308f * (x + 0.044715f * x * x * x); return x * __builtin_amdgcn_rcpf(1.0f + __builtin_amdgcn_exp2f(-1.4426950408889634f * u2)); }
__device__ __forceinline__ float gelu_tanh(float x) { const float u = 0.7978845608028654f * (x + 0.044715f * x * x * x); return 0.5f * x * (1.0f + tanhf(u)); }
__device__ __forceinline__ int tok_row(int b, int t) { return t < NMETA ? METAROW0 + t : b * SEQ + (t - NMETA); }

__device__ __forceinline__ void transpose_item(const float* W, int K, int N, bf16* WT, LAS float* scr, int item, int lane) {
    const int nblk = N / 32, kb = item / nblk, nb = item % nblk, k0 = 64 * kb, n0 = 32 * nb;
#pragma unroll 8
    for (int i = 0; i < 32; ++i) { const int kk = 2 * i + (lane >> 5); scr[kk * 33 + (lane & 31)] = W[(size_t)(k0 + kk) * N + n0 + (lane & 31)]; }
    asm volatile("s_waitcnt lgkmcnt(0)" ::: "memory");
    const int c = lane & 7;
#pragma unroll
    for (int j = 0; j < 4; ++j) { const int n = (lane >> 3) + 8 * j; const LAS float* s = scr + (8 * c) * 33 + n;
        u32x4 o; o.x = pk2(s[0 * 33], s[1 * 33]); o.y = pk2(s[2 * 33], s[3 * 33]); o.z = pk2(s[4 * 33], s[5 * 33]); o.w = pk2(s[6 * 33], s[7 * 33]);
        *(u32x4*)(WT + (size_t)(n0 + n) * K + k0 + 8 * c) = o; }
    asm volatile("s_waitcnt lgkmcnt(0)" ::: "memory");
}

__device__ __forceinline__ void phase_prologue(const Args& a, LAS unsigned char* lds, int tid, int lane, int wave) {
    const int gw = blockIdx.x * 8 + wave, NGW = gridDim.x * 8;
    const int gt = blockIdx.x * 512 + tid, NGT = gridDim.x * 512;
    unsigned char* ws = a.ws;
    LAS float* scr = (LAS float*)(lds + wave * 8704);
    {
        constexpr int IT_IN = G1_FP8 ? 0 : 32 * (DIN / 32), IT_OUT = G2_FP8 ? 0 : 32 * (D / 32);
        for (int it = gw; it < IT_IN + IT_OUT; it += NGW) {
            if (it < IT_IN) transpose_item(a.in[I_W_IN], D, DIN, (bf16*)(ws + WS_WINT), scr, it, lane);
            else transpose_item(a.in[I_W_OUT], D, D, (bf16*)(ws + WS_WOUTT), scr, it - IT_IN, lane);
        }
        __syncthreads();
    }
    {
        LAS unsigned* T = (LAS unsigned*)lds;
        const int n4 = tid & 63, kq = tid >> 6;
        constexpr int T_IN = G1_FP8 ? (D / 128) * (DIN / 256) : 0, T_OUT = G2_FP8 ? (D / 128) * (D / 256) : 0, T_E = (D / 128) * (D / 256);
        constexpr int N_GATE = 32 * T_E, N_UP = (BG_WUP && !BG_EXP) ? 256 * 6 : 32 * T_E, N_DOWN = (BG_WDOWN && !BG_EXP) ? 0 : 32 * T_E;
        constexpr int NTILES = T_IN + T_OUT + N_GATE + N_UP + N_DOWN;
        auto tile_ptrs = [&](int tile, const float*& sp, unsigned char*& dp, int& ldn) {
            const float* sbase; unsigned char* dbase; int tl, nt;
            if (tile < T_IN) { sbase = a.in[I_W_IN]; dbase = ws + WS_WINT; tl = tile; nt = DIN / 256; ldn = DIN; }
            else if (tile < T_IN + T_OUT) { sbase = a.in[I_W_OUT]; dbase = ws + WS_WOUTT; tl = tile - T_IN; nt = D / 256; ldn = D; }
            else { int r = tile - T_IN - T_OUT, which, e; nt = D / 256; ldn = D;
                   if (r < N_GATE) { which = 0; e = r / T_E; tl = r % T_E; }
                   else if (r < N_GATE + N_UP) { r -= N_GATE; which = 1; int g = r; if (BG_WUP && !BG_EXP) g = 16 * (r / 6) + 10 + (r % 6);
                                                 e = g / T_E; tl = g % T_E; }
                   else { r -= N_GATE + N_UP; which = 2; e = r / T_E; tl = r % T_E; }
                   sbase = a.in[which == 0 ? I_W_GATE : (which == 1 ? I_W_UP : I_W_DOWN)] + (size_t)e * D * D; dbase = ws + (which == 0 ? WS_WGT : (which == 1 ? WS_WUT : WS_WDT)) + (size_t)e * D * D; }
            const int k0 = (tl / nt) * 128, n0 = (tl % nt) * 256;
            sp = sbase + (size_t)(k0 + 4 * kq) * ldn + n0 + 4 * n4; dp = dbase + (size_t)n0 * D + k0; };
#define CONV_LOAD(R, tile) do { const float* _p; unsigned char* _d; int _ld; tile_ptrs(tile, _p, _d, _ld); _Pragma("unroll") for (int i = 0; i < 4; ++i) _Pragma("unroll") for (int q = 0; q < 4; ++q) \
            R[i][q] = __builtin_nontemporal_load((const f32x4*)(_p + (size_t)(32 * i + q) * _ld)); } while (0)
#define CONV_STORE(R, tile) do { _Pragma("unroll") for (int i = 0; i < 4; ++i) { const int kd = kq + 8 * i; \
            T[(4 * n4 + 0) * 33 + kd] = pk4_fp8(R[i][0].x * W_SCALE, R[i][1].x * W_SCALE, R[i][2].x * W_SCALE, R[i][3].x * W_SCALE); \
            T[(4 * n4 + 1) * 33 + kd] = pk4_fp8(R[i][0].y * W_SCALE, R[i][1].y * W_SCALE, R[i][2].y * W_SCALE, R[i][3].y * W_SCALE); \
            T[(4 * n4 + 2) * 33 + kd] = pk4_fp8(R[i][0].z * W_SCALE, R[i][1].z * W_SCALE, R[i][2].z * W_SCALE, R[i][3].z * W_SCALE); \
            T[(4 * n4 + 3) * 33 + kd] = pk4_fp8(R[i][0].w * W_SCALE, R[i][1].w * W_SCALE, R[i][2].w * W_SCALE, R[i][3].w * W_SCALE); } \
            __syncthreads(); \
            { const float* _p; unsigned char* _d; int _ld; tile_ptrs(tile, _p, _d, _ld); _Pragma("unroll") for (int i = 0; i < 4; ++i) { const int n = (tid >> 3) + 64 * i, c = tid & 7; \
                const u32x4 o = (u32x4){T[n * 33 + 4 * c], T[n * 33 + 4 * c + 1], T[n * 33 + 4 * c + 2], T[n * 33 + 4 * c + 3]}; \
                *(u32x4*)(_d + (size_t)n * D + 16 * c) = o; } } \
            __syncthreads(); } while (0)
        f32x4 RA[4][4], RB[4][4];
        int tile = blockIdx.x;
        if (tile < NTILES) CONV_LOAD(RA, tile);
        while (tile < NTILES) {
            int nxt = tile + gridDim.x;
            if (nxt < NTILES) CONV_LOAD(RB, nxt);
            CONV_STORE(RA, tile);
            tile = nxt; if (tile >= NTILES) break;
            nxt = tile + gridDim.x;
            if (nxt < NTILES) CONV_LOAD(RA, nxt);
            CONV_STORE(RB, tile);
            tile = nxt;
        }
#undef CONV_LOAD
#undef CONV_STORE
    }
    static_assert(!G1_FP8, "n1 is written as bf16");
    for (int r = gw; r < MROWS; r += NGW) {
        u32x4* orow = (u32x4*)((bf16*)(ws + WS_N1) + (size_t)r * D);
        if (r >= MVALID) {
#pragma unroll
            for (int j = 0; j < 4; ++j) orow[lane + 64 * j] = (u32x4){0u, 0u, 0u, 0u};
            continue; }
        const f32x4* xr = (const f32x4*)(r < MREAL ? a.in[I_X] + (size_t)r * D : a.in[I_META] + (size_t)(r - MREAL) * D);
        f32x4 v[4][2]; float ss = 0.f;
#pragma unroll
        for (int j = 0; j < 4; ++j)
#pragma unroll
            for (int q = 0; q < 2; ++q) { v[j][q] = xr[2 * (lane + 64 * j) + q]; ss += (v[j][q].x * v[j][q].x + v[j][q].y * v[j][q].y) + (v[j][q].z * v[j][q].z + v[j][q].w * v[j][q].w); }
        ss = wave_sum(ss);
        const float rstd = 1.0f / sqrtf(ss * (1.0f / D) + EPS);
#pragma unroll
        for (int j = 0; j < 4; ++j) { const f32x4 g0 = ((const f32x4*)a.in[I_NORM_MIX])[2 * (lane + 64 * j)], g1 = ((const f32x4*)a.in[I_NORM_MIX])[2 * (lane + 64 * j) + 1];
            orow[lane + 64 * j] = (u32x4){pk2(v[j][0].x * rstd * g0.x, v[j][0].y * rstd * g0.y), pk2(v[j][0].z * rstd * g0.z, v[j][0].w * rstd * g0.w),
                                          pk2(v[j][1].x * rstd * g1.x, v[j][1].y * rstd * g1.y), pk2(v[j][1].z * rstd * g1.z, v[j][1].w * rstd * g1.w)}; }
    }
    float* cosT = (float*)(ws + WS_COS); float* sinT = (float*)(ws + WS_SIN);
    for (int i = gt; i < TT * 32; i += NGT) {
        const int pos = i >> 5, j = i & 31;
        const float ang = (float)pos * c_inv_freq[j];
        const double t = (double)ang * 0.15915494309189535; const float fr = (float)(t - floor(t));
        cosT[i] = __builtin_amdgcn_cosf(fr); sinT[i] = __builtin_amdgcn_sinf(fr);
    }
    { bf16* WaT = (bf16*)(ws + WS_WAT); bf16* WiT = (bf16*)(ws + WS_WIT);
      for (int i = gt; i < 16 * 64 * 64; i += NGT) { const int n = i >> 12, d = (i >> 6) & 63, cc = i & 63;
          WaT[i] = (bf16)f2bf(a.in[I_W_A][(n * 64 + cc) * 64 + d]); WiT[i] = (bf16)f2bf(a.in[I_W_I][(n * 64 + cc) * 64 + d]); } }
    { bf16* WRT = (bf16*)(ws + WS_WRT);
      for (int i = gt; i < NEXP * D; i += NGT) { const int e = i >> 11, k = i & 2047; WRT[i] = (bf16)f2bf(a.in[I_NORM_FFN][k] * a.in[I_W_ROUTER][k * NEXP + e]); } }
    int* rowpair = (int*)(ws + WS_ROWPAIR);
    for (int i = gt; i < PROWS; i += NGT) rowpair[i] = -1;
}

namespace pg8 {
constexpr int BM = 256, BK = 64, HALF = 128, HTB = HALF * BK * 2, STAGE_BYTES = 8 * HTB, NXCD = 8, WGM = 8, KD = 2048, NKT = KD / BK;
__host__ __device__ __forceinline__ int lds_byte(int r, int c) { const int st = (r >> 4) * 2 + (c >> 5), rr = r & 15, cc = c & 31, ob = rr * 64 + cc * 2; return st * 1024 + (ob ^ (((ob >> 9) & 1) << 5)); }
__host__ __device__ __forceinline__ void stage_rc(int b, int& R, int& C) { const int st = b / 1024, sb = b % 1024, swz = sb ^ (((sb >> 9) & 1) << 5); R = (st >> 1) * 16 + swz / 64; C = (st & 1) * 32 + (swz % 64) / 2; }
__host__ __device__ __forceinline__ int perm32(int rho) { const int n = rho >> 4, i = rho & 15; return 8 * (i >> 2) + 4 * n + (i & 3); }
struct Unit { unsigned a, b0, b1; int pm, pn, e; };
__device__ __forceinline__ bool static_tile(int i, int G, int c, int nM, int nN, int& pm, int& pn) {
    const int nwg = nM * nN; const long L = (long)i * G + c; if (L >= nwg) return false;
    int wgid = (int)L; { const int q = nwg >> 3, r = nwg & 7, xcd = wgid & 7, off = wgid >> 3; wgid = (xcd < r ? xcd * (q + 1) : r * (q + 1) + (xcd - r) * q) + off; }
    const int nig = WGM * nN; int gid, rem;
    if ((nN & (nN - 1)) == 0) { const int sh = 3 + (31 - __builtin_clz(nN)); gid = wgid >> sh; rem = wgid & (nig - 1); } else { gid = wgid / nig; rem = wgid - gid * nig; }
    const int fm = gid * WGM, gsz = (nM - fm) < WGM ? (nM - fm) : WGM;
    if (gsz == WGM) { pm = fm + (rem & 7); pn = rem >> 3; } else { pm = fm + rem % gsz; pn = rem / gsz; }
    return true;
}
__device__ __forceinline__ unsigned cvt_pk_bf16(float lo, float hi) { unsigned r; asm volatile("v_cvt_pk_bf16_f32 %0, %1, %2" : "=v"(r) : "v"(lo), "v"(hi)); return r; }

typedef int i32x8 __attribute__((ext_vector_type(8)));
typedef int i32x4 __attribute__((ext_vector_type(4)));
__device__ __forceinline__ i32x8 cat8(bf16x8 lo, bf16x8 hi) { const i32x4 a = __builtin_bit_cast(i32x4, lo), b = __builtin_bit_cast(i32x4, hi); return __builtin_shufflevector(a, b, 0, 1, 2, 3, 4, 5, 6, 7); }
struct BGNone { static constexpr bool ON = false; };
struct BGConv { static constexpr bool ON = true; const char* src; unsigned char* dst; int next, end; unsigned char* dummy; };
__device__ __forceinline__ void bg_pair_ptrs(const BGConv& bg, int pair, const char*& sp, unsigned char*& dp) {
    const int e = pair >> 10, kbp = (pair >> 6) & 15, nb = pair & 63;
    sp = bg.src + ((size_t)(e * 2048 + 128 * kbp) * 2048 + 32 * nb) * 4; dp = bg.dst + (size_t)e * 2048 * 2048 + (size_t)(32 * nb) * 2048 + 128 * kbp; }
template <bool FP8, class Epi, class Sched, class BG, bool GATHER = false>
__device__ __forceinline__ void gemm_phase(LAS unsigned char* lds, const Sched& S, const Epi& E, BG& bg) {
    constexpr int ROWB = FP8 ? 2048 : 4096, NKTL = ROWB / 128;
    const int tid = threadIdx.x, wid = __builtin_amdgcn_readfirstlane(tid >> 6), lane = tid & 63, wr = wid >> 2, wc = wid & 3, fr = lane & 15, fq = lane >> 4;
    unsigned voffA[2], voffB[2];
#pragma unroll
    for (int i = 0; i < 2; ++i) { int R, C; stage_rc(tid * 16 + i * 8192, R, C); const int Rb = Epi::PERM ? ((R & ~31) + perm32(R & 31)) : R;
        voffA[i] = (unsigned)(R * ROWB + C * 2); voffB[i] = (unsigned)(Rb * ROWB + C * 2); }
    constexpr unsigned KS = BK * 2, HS = HALF * ROWB;
    const unsigned ldsw = (unsigned)wid * 1024u;
    const __amdgpu_buffer_rsrc_t rsA = __builtin_amdgcn_make_buffer_rsrc((void*)S.A, 0, 0x7ffffff0, 0x00020000), rsB0 = __builtin_amdgcn_make_buffer_rsrc((void*)S.B0, 0, 0x7ffffff0, 0x00020000), rsB1 = __builtin_amdgcn_make_buffer_rsrc((void*)S.B1, 0, 0x7ffffff0, 0x00020000);
    const int aoff = lds_byte(wr * 64 + fr, fq * 8), boff = lds_byte(wc * 32 + fr, fq * 8);
#define PG8_SA(b, h) (((b) * 2 + (h)) * HTB)
#define PG8_SB(b, h) ((4 + (b) * 2 + (h)) * HTB)
#define PG8_STAGE(bufoff, rs, soff, voff) do { _Pragma("unroll") for (int _i = 0; _i < 2; ++_i) \
        __builtin_amdgcn_raw_ptr_buffer_load_lds(rs, (LAS void*)(lds + (bufoff) + ldsw + _i * 8192), 16, (int)(voff)[_i], (int)(soff), 0, 0); } while (0)
    unsigned gA[2][2] = {{0u, 0u}, {0u, 0u}}, gN[2][2] = {{0u, 0u}, {0u, 0u}};
#define PG8_GOFF(dst, slot) do { int tz_ = threadIdx.x; asm volatile("" : "+v"(tz_)); _Pragma("unroll") for (int _i = 0; _i < 2; ++_i) { int R_, C_; stage_rc(tz_ * 16 + _i * 8192, R_, C_); \
        _Pragma("unroll") for (int _h = 0; _h < 2; ++_h) { const int id_ = *(const LAS int*)(lds + LDS_RID + (slot) * 1024 + (_h * 128 + R_) * 4); dst[_h][_i] = (unsigned)((id_ < 0 ? 0 : (id_ >> 2)) * ROWB + C_ * 2); } } } while (0)
#define PG8_STAGEA(bufoff, h, soff_dense, koff, nx) do { if constexpr (GATHER) { unsigned v_[2]; v_[0] = (nx) ? gN[h][0] : gA[h][0]; v_[1] = (nx) ? gN[h][1] : gA[h][1]; PG8_STAGE(bufoff, rsA, koff, v_); } \
        else PG8_STAGE(bufoff, rsA, (soff_dense) + (h) * HS, voffA); } while (0)
#define PG8_LDA(dst, b, h) do { _Pragma("unroll") for (int m = 0; m < 4; ++m) { \
        if constexpr (FP8) dst##8[m] = __builtin_shufflevector(*(const LAS i32x4*)(lds + PG8_SA(b, h) + aoff + m * 2048), *(const LAS i32x4*)(lds + PG8_SA(b, h) + aoff + m * 2048 + 1024), 0, 1, 2, 3, 4, 5, 6, 7); \
        else { _Pragma("unroll") for (int k = 0; k < 2; ++k) dst[m][k] = *(const LAS bf16x8*)(lds + PG8_SA(b, h) + aoff + m * 2048 + k * 1024); } } } while (0)
#define PG8_LDB(dst, b, h) do { _Pragma("unroll") for (int n = 0; n < 2; ++n) { \
        if constexpr (FP8) dst##8[n] = __builtin_shufflevector(*(const LAS i32x4*)(lds + PG8_SB(b, h) + boff + n * 2048), *(const LAS i32x4*)(lds + PG8_SB(b, h) + boff + n * 2048 + 1024), 0, 1, 2, 3, 4, 5, 6, 7); \
        else { _Pragma("unroll") for (int k = 0; k < 2; ++k) dst[n][k] = *(const LAS bf16x8*)(lds + PG8_SB(b, h) + boff + n * 2048 + k * 1024); } } } while (0)
#define PG8_MMA(ai, bj, At, Bt) do { _Pragma("unroll") for (int m = 0; m < 4; ++m) _Pragma("unroll") for (int n = 0; n < 2; ++n) { \
        if constexpr (FP8) asm volatile("v_mfma_f32_16x16x128_f8f6f4 %0, %1, %2, %0" : "+v"(acc[ai][bj][m][n]) : "v"(Bt##8[n]), "v"(At##8[m])); \
        else { _Pragma("unroll") for (int k = 0; k < 2; ++k) asm volatile("v_mfma_f32_16x16x32_bf16 %0, %1, %2, %0" : "+v"(acc[ai][bj][m][n]) : "v"(Bt[n][k]), "v"(At[m][k])); } } \
        } while (0)
#define PG8_WAIT_V(n) asm volatile("s_waitcnt vmcnt(" #n ")" ::: "memory")
#define PG8_WAIT_L(n) asm volatile("s_waitcnt lgkmcnt(" #n ")" ::: "memory")
#define PG8_BAR __builtin_amdgcn_s_barrier()
#define PG8_SCHED __builtin_amdgcn_sched_barrier(0)
    Unit cur, nxt; int ui = 0; bool bg_pending = false;
    if (!S.next(0, cur)) return;
    f32x4 acc[2][2][4][2];
#pragma unroll
    for (int a = 0; a < 2; ++a)
#pragma unroll
        for (int b = 0; b < 2; ++b)
#pragma unroll
            for (int m = 0; m < 4; ++m)
#pragma unroll
                for (int n = 0; n < 2; ++n) acc[a][b][m][n] = (f32x4){0.f, 0.f, 0.f, 0.f};
    bf16x8 At[4][2], B0[2][2], B1[2][2];
    i32x8 At8[4], B08[2], B18[2];
    if constexpr (GATHER) {
        if (tid < 256) *(LAS int*)(lds + LDS_RID + tid * 4) = S.rows[cur.pm * BM + tid];
        __syncthreads();
        PG8_GOFF(gA, 0);
    }
    PG8_STAGE(PG8_SB(0, 0), rsB0, cur.b0, voffB); PG8_STAGE(PG8_SB(0, 1), rsB1, cur.b1, voffB); PG8_STAGEA(PG8_SA(0, 0), 0, cur.a, 0u, false); PG8_STAGEA(PG8_SA(0, 1), 1, cur.a, 0u, false);
    if (wr == 1) PG8_BAR;
    PG8_WAIT_V(2); PG8_BAR;
    PG8_STAGE(PG8_SB(1, 0), rsB0, cur.b0 + KS, voffB); PG8_STAGEA(PG8_SA(1, 0), 0, cur.a + KS, KS, false); PG8_STAGE(PG8_SB(1, 1), rsB1, cur.b1 + KS, voffB);
    PG8_WAIT_V(6); PG8_BAR;
    for (;;) {
        const bool has_next = S.next(ui + 1, nxt);
        const unsigned nA = has_next ? nxt.a : cur.a, nB0 = has_next ? nxt.b0 : cur.b0, nB1 = has_next ? nxt.b1 : cur.b1;
        for (int t = 0; t < NKTL; t += 2) {
            const bool last = (t == NKTL - 2);
            const unsigned a1 = cur.a + (unsigned)(t + 1) * KS;
            const unsigned a2 = last ? nA : cur.a + (unsigned)(t + 2) * KS;
            const unsigned b20 = last ? nB0 : cur.b0 + (unsigned)(t + 2) * KS, b21 = last ? nB1 : cur.b1 + (unsigned)(t + 2) * KS;
            const unsigned a3 = a2 + KS, b30 = b20 + KS, b31 = b21 + KS;
            const unsigned k1 = (unsigned)(t + 1) * KS, k2 = last ? 0u : (unsigned)(t + 2) * KS;
            if constexpr (GATHER) { if (last) { if (has_next) PG8_GOFF(gN, (ui + 1) & 1); else { gN[0][0] = gA[0][0]; gN[0][1] = gA[0][1]; gN[1][0] = gA[1][0]; gN[1][1] = gA[1][1]; } } }
            PG8_LDB(B0, 0, 0); PG8_LDB(B1, 0, 1); PG8_SCHED; PG8_LDA(At, 0, 0); PG8_STAGEA(PG8_SA(1, 1), 1, a1, k1, false);
            if constexpr (GATHER) { if (t == 2 && has_next && wid == 3) __builtin_amdgcn_global_load_lds((const unsigned*)(S.rows + nxt.pm * BM + lane * 4), (LAS unsigned*)(lds + LDS_RID + ((ui + 1) & 1) * 1024), 16, 0, 0); }
            if (t == 2) E.prefetch(cur, lds, wid, lane);
            PG8_WAIT_V(8); PG8_WAIT_L(0); PG8_BAR; PG8_MMA(0, 0, At, B0);
            if constexpr (BG::ON) {
                PG8_SCHED;
                int tz = threadIdx.x; asm volatile("" : "+v"(tz));
#pragma unroll
                for (int j = 0; j < (BG_EXP == 1 ? 0 : 2); ++j) { const LAS float* p = (const LAS float*)(lds + LDS_BG + j * 8192 + (tz >> 5) * 512 + (tz & 31) * 4);
                    ((LAS unsigned*)(lds + LDS_T2))[(tz & 31) * 33 + 16 * j + (tz >> 5)] = pk4_fp8(p[0] * W_SCALE, p[32] * W_SCALE, p[64] * W_SCALE, p[96] * W_SCALE); }
                const char* bgs; { unsigned char* dp_; pg8::bg_pair_ptrs(bg, bg.next < bg.end ? bg.next : bg.end - 1, bgs, dp_); }
                PG8_SCHED;
                if (BG_EXP != 2) {
                const unsigned bgv = (unsigned)((8 * wid + ((tz & 63) >> 3)) * 8192 + (tz & 7) * 16);
                __builtin_amdgcn_global_load_lds((const unsigned*)(bgs + bgv), (LAS unsigned*)(lds + LDS_BG + ldsw), 16, 0, 0);
                __builtin_amdgcn_global_load_lds((const unsigned*)(bgs + 524288 + bgv), (LAS unsigned*)(lds + LDS_BG + 8192 + ldsw), 16, 0, 0); }
                PG8_SCHED; }
            PG8_MMA(0, 1, At, B1);
            if constexpr (BG::ON) { PG8_WAIT_L(0); }
            PG8_BAR; PG8_SCHED;
            PG8_LDA(At, 0, 1); PG8_STAGE(PG8_SB(0, 0), rsB0, b20, voffB); PG8_STAGE(PG8_SB(0, 1), rsB1, b21, voffB); PG8_STAGEA(PG8_SA(0, 0), 0, a2, k2, last);
            if constexpr (BG::ON) { if (BG_EXP == 2) PG8_WAIT_V(8); else PG8_WAIT_V(10); } else { PG8_WAIT_V(8); }
            PG8_WAIT_L(0); PG8_BAR; PG8_MMA(1, 0, At, B0);
            if constexpr (BG::ON) {
                PG8_SCHED;
                unsigned char* bgd; { const char* sp_; pg8::bg_pair_ptrs(bg, bg.next - 1 < bg.end ? bg.next - 1 : bg.end - 1, sp_, bgd); }
                int tz = threadIdx.x; asm volatile("" : "+v"(tz));
                const LAS unsigned* q = (const LAS unsigned*)(lds + LDS_T2) + (tz >> 4) * 33 + 2 * (tz & 15);
                const u32x2 w = (u32x2){q[0], q[1]};
                if (BG_EXP != 1) *(u32x2*)((bg_pending && !BG_EXP) ? bgd + (size_t)(tz >> 4) * 2048 + 8 * (tz & 15) : bg.dummy + 8 * tz) = w;
                ++bg.next; bg_pending = true;
                PG8_SCHED; }
            PG8_MMA(1, 1, At, B1); PG8_BAR; PG8_SCHED;
            PG8_LDB(B0, 1, 0); PG8_LDB(B1, 1, 1); PG8_SCHED; PG8_LDA(At, 1, 0); PG8_STAGEA(PG8_SA(0, 1), 1, a2, k2, last);
            if constexpr (BG::ON) { if (BG_EXP == 1) PG8_WAIT_V(10); else if (BG_EXP == 2) PG8_WAIT_V(9); else PG8_WAIT_V(11); } else { PG8_WAIT_V(8); }
            PG8_WAIT_L(0); PG8_BAR; PG8_MMA(0, 0, At, B0); PG8_MMA(0, 1, At, B1); PG8_BAR; PG8_SCHED;
            PG8_LDA(At, 1, 1); PG8_STAGE(PG8_SB(1, 0), rsB0, b30, voffB); PG8_STAGE(PG8_SB(1, 1), rsB1, b31, voffB); PG8_STAGEA(PG8_SA(1, 0), 0, a3, k2 + KS, last);
            if constexpr (BG::ON) { if (BG_EXP == 1) PG8_WAIT_V(8); else PG8_WAIT_V(9); } else { PG8_WAIT_V(8); }
            PG8_WAIT_L(0); PG8_BAR; PG8_MMA(1, 0, At, B0); PG8_MMA(1, 1, At, B1); PG8_BAR; PG8_SCHED;
        }
        if (wr == 0) PG8_BAR;
        asm volatile("s_nop 15\n\ts_nop 15" ::: "memory");
        E(acc, cur, wr, wc, fr, fq, lds);
        if (!has_next) break;
#pragma unroll
        for (int a = 0; a < 2; ++a)
#pragma unroll
            for (int b = 0; b < 2; ++b)
#pragma unroll
                for (int m = 0; m < 4; ++m)
#pragma unroll
                    for (int n = 0; n < 2; ++n) acc[a][b][m][n] = (f32x4){0.f, 0.f, 0.f, 0.f};
        cur = nxt; ++ui;
        if constexpr (GATHER) { gA[0][0] = gN[0][0]; gA[0][1] = gN[0][1]; gA[1][0] = gN[1][0]; gA[1][1] = gN[1][1]; }
        if (wr == 1) PG8_BAR;
    }
    PG8_WAIT_V(0);
    PG8_BAR;
    if constexpr (BG::ON) { if (bg_pending && !BG_EXP) {
        unsigned char* bgd; { const char* sp_; pg8::bg_pair_ptrs(bg, bg.next - 1 < bg.end ? bg.next - 1 : bg.end - 1, sp_, bgd); }
#pragma unroll
        for (int j = 0; j < 2; ++j) { const LAS float* p = (const LAS float*)(lds + LDS_BG + j * 8192 + (tid >> 5) * 512 + (tid & 31) * 4);
            ((LAS unsigned*)(lds + LDS_T2))[(tid & 31) * 33 + 16 * j + (tid >> 5)] = pk4_fp8(p[0] * W_SCALE, p[32] * W_SCALE, p[64] * W_SCALE, p[96] * W_SCALE); }
        __syncthreads();
        const LAS unsigned* q = (const LAS unsigned*)(lds + LDS_T2) + (tid >> 4) * 33 + 2 * (tid & 15);
        *(u32x2*)(bgd + (size_t)(tid >> 4) * 2048 + 8 * (tid & 15)) = (u32x2){q[0], q[1]}; } }
#undef PG8_SA
#undef PG8_SB
#undef PG8_STAGE
#undef PG8_STAGEA
#undef PG8_GOFF
#undef PG8_LDA
#undef PG8_LDB
#undef PG8_MMA
#undef PG8_WAIT_V
#undef PG8_WAIT_L
#undef PG8_BAR
#undef PG8_SCHED
}

struct SchedDense {
    const char* A; const char* B0; const char* B1; const int* rows; int nM, nN, G, c, rowb;
    __device__ __forceinline__ bool next(int i, Unit& u) const {
        int pm, pn; if (!static_tile(i, G, c, nM, nN, pm, pn)) return false;
        u.pm = pm; u.pn = pn; u.e = 0; u.a = (unsigned)pm * BM * rowb; u.b0 = (unsigned)pn * BM * rowb; u.b1 = u.b0 + (unsigned)HALF * rowb; return true;
    }
};
struct SchedMoE {
    const char* A; const char* B0; const char* B1; const int* rows; const LAS int* tstart; int nM, nN, G, c; bool split;
    __device__ __forceinline__ bool next(int i, Unit& u) const {
        int pm, pn; if (!static_tile(i, G, c, nM, nN, pm, pn)) return false;
        const int e = ((const LAS unsigned char*)(tstart + 64))[pm];
        u.pm = pm; u.pn = pn; u.e = e; u.a = (unsigned)pm * (BM * 2048);
        const unsigned eoff = (unsigned)e * (2048u * 2048u);
        if (split) { u.b0 = eoff + (unsigned)pn * (HALF * 2048); u.b1 = u.b0; }
        else { u.b0 = eoff + (unsigned)pn * (BM * 2048); u.b1 = u.b0 + (unsigned)HALF * 2048; }
        return true;
    }
};

__device__ __forceinline__ u32x4 widen16(u32x2 x, u32x2 y) {
    const auto r0 = __builtin_amdgcn_permlane16_swap(x.x, y.x, false, false), r1 = __builtin_amdgcn_permlane16_swap(x.y, y.y, false, false);
    return (u32x4){r0[0], r1[0], r0[1], r1[1]};
}
struct EpiZ {
    static constexpr bool PERM = true;
    bf16* Z; const float* bias; float sc;
    __device__ __forceinline__ void prefetch(const Unit&, LAS unsigned char*, int, int) const {}
    __device__ __forceinline__ void operator()(const f32x4 (&acc)[2][2][4][2], const Unit& u, int wr, int wc, int fr, int fq, const LAS unsigned char*) const {
        const int row0 = u.pm * BM + wr * 64 + fr, col0 = u.pn * BM + wc * 32 + 8 * fq;
        f32x4 bv[2][2];
#pragma unroll
        for (int bj = 0; bj < 2; ++bj)
#pragma unroll
            for (int n = 0; n < 2; ++n) bv[bj][n] = *(const f32x4*)(bias + col0 + bj * HALF + 4 * n);
#pragma unroll
        for (int ai = 0; ai < 2; ++ai)
#pragma unroll
            for (int m = 0; m < 4; ++m) { bf16* rowp = Z + (size_t)(row0 + ai * HALF + m * 16) * DIN + col0;
#pragma unroll
                for (int bj = 0; bj < 2; ++bj) { const f32x4 v0 = acc[ai][bj][m][0] * sc + bv[bj][0], v1 = acc[ai][bj][m][1] * sc + bv[bj][1];
                    u32x4 w; w.x = cvt_pk_bf16(v0[0], v0[1]); w.y = cvt_pk_bf16(v0[2], v0[3]); w.z = cvt_pk_bf16(v1[0], v1[1]); w.w = cvt_pk_bf16(v1[2], v1[3]);
                    *(u32x4*)(rowp + bj * HALF) = w; } }
    }
};
struct EpiH1 {
    static constexpr bool PERM = true;
    bf16* H1; const float* x; const float* bias; float sc;
    __device__ __forceinline__ void prefetch(const Unit&, LAS unsigned char*, int, int) const {}
    __device__ __forceinline__ void operator()(const f32x4 (&acc)[2][2][4][2], const Unit& u, int wr, int wc, int fr, int fq, const LAS unsigned char*) const {
        const int row0 = u.pm * BM + wr * 64 + fr, col0 = u.pn * BM + wc * 32 + 8 * fq;
        f32x4 bv[2][2];
#pragma unroll
        for (int bj = 0; bj < 2; ++bj)
#pragma unroll
            for (int n = 0; n < 2; ++n) bv[bj][n] = *(const f32x4*)(bias + col0 + bj * HALF + 4 * n);
#pragma unroll
        for (int ai = 0; ai < 2; ++ai) {
            f32x4 xv[4][2][2];
#pragma unroll
            for (int m = 0; m < 4; ++m) { const size_t ro = (size_t)(row0 + ai * HALF + m * 16) * D + col0;
#pragma unroll
                for (int bj = 0; bj < 2; ++bj) { xv[m][bj][0] = __builtin_nontemporal_load((const f32x4*)(x + ro + bj * HALF)); xv[m][bj][1] = __builtin_nontemporal_load((const f32x4*)(x + ro + bj * HALF + 4)); } }
#pragma unroll
            for (int m = 0; m < 4; ++m) { const size_t ro = (size_t)(row0 + ai * HALF + m * 16) * D + col0;
#pragma unroll
                for (int bj = 0; bj < 2; ++bj) { const f32x4 v0 = xv[m][bj][0] + acc[ai][bj][m][0] * sc + bv[bj][0], v1 = xv[m][bj][1] + acc[ai][bj][m][1] * sc + bv[bj][1];
                    u32x4 w; w.x = cvt_pk_bf16(v0[0], v0[1]); w.y = cvt_pk_bf16(v0[2], v0[3]); w.z = cvt_pk_bf16(v1[0], v1[1]); w.w = cvt_pk_bf16(v1[2], v1[3]);
                    *(u32x4*)(H1 + ro + bj * HALF) = w; } }
        }
    }
};
struct EpiAct {
    static constexpr bool PERM = true;
    unsigned char* ACT; const float* bg; const float* bu;
    __device__ __forceinline__ void prefetch(const Unit& u, LAS unsigned char* lds, int wid, int lane) const {
        if (wid == 0) { const float* p = (lane < 32 ? bg : bu) + (size_t)u.e * DFF + u.pn * HALF + (lane & 31) * 4;
            __builtin_amdgcn_global_load_lds((const unsigned*)p, (LAS unsigned*)(lds + LDS_META), 16, 0, 0); }
    }
    __device__ __forceinline__ void operator()(const f32x4 (&acc)[2][2][4][2], const Unit& u, int wr, int wc, int fr, int fq, const LAS unsigned char* lds) const {
        const int row0 = u.pm * BM + wr * 64 + fr, cl = wc * 32 + 8 * fq, col0 = u.pn * HALF + cl;
        f32x4 gv[2], uv[2];
#pragma unroll
        for (int n = 0; n < 2; ++n) { gv[n] = *(const LAS f32x4*)(lds + LDS_META + (cl + 4 * n) * 4); uv[n] = *(const LAS f32x4*)(lds + LDS_META + 512 + (cl + 4 * n) * 4); }
#pragma unroll
        for (int ai = 0; ai < 2; ++ai)
#pragma unroll
            for (int mp = 0; mp < 2; ++mp) { u32x2 pc[2];
#pragma unroll
                for (int mi = 0; mi < 2; ++mi) { const int m = 2 * mp + mi; float r[8];
#pragma unroll
                    for (int n = 0; n < 2; ++n)
#pragma unroll
                        for (int j = 0; j < 4; ++j) { float g = acc[ai][0][m][n][j] * (1.0f / (W_SCALE * XS_SCALE)) + gv[n][j], up = acc[ai][1][m][n][j] * (1.0f / (W_SCALE * XS_SCALE)) + uv[n][j];
                            g = fminf(g, 7.0f); up = fminf(fmaxf(up, -7.0f), 7.0f);
                            r[n * 4 + j] = ACT_SCALE * g * (1.0f / (1.0f + __expf(-1.702f * g))) * (up + 1.0f); }
                    pc[mi] = (u32x2){pk4_fp8(r[0], r[1], r[2], r[3]), pk4_fp8(r[4], r[5], r[6], r[7])}; }
                const u32x4 w = widen16(pc[0], pc[1]);
                const int m = 2 * mp + (fq & 1);
                *(u32x4*)(ACT + (size_t)(row0 + ai * HALF + m * 16) * DFF + col0 - 8 * (fq & 1)) = w; }
    }
};
struct EpiDown {
    static constexpr bool PERM = true;
    unsigned char* YB; const float* bd;
    __device__ __forceinline__ void prefetch(const Unit& u, LAS unsigned char* lds, int wid, int lane) const {
        if (wid == 0) __builtin_amdgcn_global_load_lds((const unsigned*)(bd + (size_t)u.e * D + u.pn * BM + lane * 4), (LAS unsigned*)(lds + LDS_META), 16, 0, 0);
    }
    __device__ __forceinline__ void operator()(const f32x4 (&acc)[2][2][4][2], const Unit& u, int wr, int wc, int fr, int fq, const LAS unsigned char* lds) const {
        const int row0 = u.pm * BM + wr * 64 + fr, cl = wc * 32 + 8 * fq, col0 = u.pn * BM + cl;
        f32x4 bv[2][2];
#pragma unroll
        for (int bj = 0; bj < 2; ++bj)
#pragma unroll
            for (int n = 0; n < 2; ++n) bv[bj][n] = *(const LAS f32x4*)(lds + LDS_META + (cl + bj * HALF + 4 * n) * 4) * YB_SCALE;
#pragma unroll
        for (int ai = 0; ai < 2; ++ai)
#pragma unroll
            for (int m = 0; m < 4; ++m) { u32x2 pc[2];
#pragma unroll
                for (int bj = 0; bj < 2; ++bj) { const f32x4 v0 = acc[ai][bj][m][0] * (YB_SCALE / (W_SCALE * ACT_SCALE)) + bv[bj][0], v1 = acc[ai][bj][m][1] * (YB_SCALE / (W_SCALE * ACT_SCALE)) + bv[bj][1];
                    pc[bj] = (u32x2){pk4_fp8(v0[0], v0[1], v0[2], v0[3]), pk4_fp8(v1[0], v1[1], v1[2], v1[3])}; }
                const u32x4 w = widen16(pc[0], pc[1]);
                *(u32x4*)(YB + (size_t)(row0 + ai * HALF + m * 16) * D + col0 + (fq & 1) * (HALF - 8)) = w; }
    }
};
}


typedef float f32x16 __attribute__((ext_vector_type(16)));
constexpr int AT_KS = 144, AT_VS = 584, AT_KOFF = 0, AT_VOFF = 288 * AT_KS;
__device__ __forceinline__ float bflo(unsigned w) { return __uint_as_float(w << 16); }
__device__ __forceinline__ float bfhi(unsigned w) { return __uint_as_float(w & 0xffff0000u); }

__device__ __forceinline__ void attn_tile(LAS unsigned char* lds, int slot_base, int kind, int j, int lane, int hq,
                                          const bf16x8 (&qf)[2][4], f32x16 (&oacc)[2][2], float (&mrow)[2], float (&lrow)[2]) {
    const int r31 = lane & 31, h = lane >> 5;
    bf16x8 kf[4], vf[2][2];
#pragma unroll
    for (int ks = 0; ks < 4; ++ks) kf[ks] = *(const LAS bf16x8*)(lds + AT_KOFF + (slot_base + r31) * AT_KS + (16 * ks + 8 * h) * 2);
#pragma unroll
    for (int dt = 0; dt < 2; ++dt)
#pragma unroll
        for (int sp = 0; sp < 2; ++sp) { const LAS unsigned char* p = lds + AT_VOFF + (32 * dt + r31) * AT_VS + (slot_base + 16 * sp + 4 * h) * 2;
            const u32x2 lo = *(const LAS u32x2*)p, hi = *(const LAS u32x2*)(p + 16);
            const u32x4 w = (u32x4){lo.x, lo.y, hi.x, hi.y}; vf[dt][sp] = __builtin_bit_cast(bf16x8, w); }
#pragma unroll
    for (int qt = 0; qt < 2; ++qt) {
        f32x16 s;
#pragma unroll
        for (int r = 0; r < 16; ++r) s[r] = 0.f;
#pragma unroll
        for (int ks = 0; ks < 4; ++ks) s = __builtin_amdgcn_mfma_f32_32x32x16_bf16(kf[ks], qf[qt][ks], s, 0, 0, 0);
        const int i = 64 * hq + 32 * qt + r31;
        float mx = -1.0e30f;
#pragma unroll
        for (int r = 0; r < 16; ++r) { const int key = (r & 3) + 8 * (r >> 2) + 4 * h;
            const bool ok = kind == 0 ? (key < 16) : (kind == 1 ? (32 * j + key >= i + 1) : (32 * j + key <= i));
            s[r] = ok ? s[r] : -1.0e30f; mx = fmaxf(mx, s[r]); }
        mx = fmaxf(mx, __shfl_xor(mx, 32));
        const float mn = fmaxf(mrow[qt], mx), al = __expf(mrow[qt] - mn); mrow[qt] = mn;
        float ps = 0.f;
#pragma unroll
        for (int r = 0; r < 16; ++r) { s[r] = __expf(s[r] - mn); ps += s[r]; }
        lrow[qt] = lrow[qt] * al + ps;
#pragma unroll
        for (int dt = 0; dt < 2; ++dt)
#pragma unroll
            for (int r = 0; r < 16; ++r) oacc[qt][dt][r] *= al;
        bf16x8 pf[2];
#pragma unroll
        for (int sp = 0; sp < 2; ++sp) { const u32x4 w = (u32x4){pk2(s[8 * sp + 0], s[8 * sp + 1]), pk2(s[8 * sp + 2], s[8 * sp + 3]), pk2(s[8 * sp + 4], s[8 * sp + 5]), pk2(s[8 * sp + 6], s[8 * sp + 7])};
            pf[sp] = __builtin_bit_cast(bf16x8, w); }
#pragma unroll
        for (int dt = 0; dt < 2; ++dt)
#pragma unroll
            for (int sp = 0; sp < 2; ++sp) oacc[qt][dt] = __builtin_amdgcn_mfma_f32_32x32x16_bf16(vf[dt][sp], pf[sp], oacc[qt][dt], 0, 0, 0);
    }
}

__device__ __forceinline__ void attn_item(const Args& a, LAS unsigned char* lds, int item, int tid, int lane, int wave) {
    const int kvh = item & 3, qblk = (item >> 2) & 15, b = item >> 6;
    const bf16* Z = (const bf16*)(a.ws + WS_Z); bf16* O = (bf16*)(a.ws + (G2_FP8 ? WS_ATT : WS_O)); constexpr int OLD = G2_FP8 ? 1024 : D;
    const float* cosT = (const float*)(a.ws + WS_COS); const float* sinT = (const float*)(a.ws + WS_SIN);
    __syncthreads();
    for (int task = tid; task < 288 * 4; task += 512) {
        const int slot = task >> 2, c = task & 3;
        int krow, kpos; bool valid;
        if (slot < 32) { valid = slot < NMETA; krow = METAROW0 + slot; kpos = slot; }
        else { const int sp = 128 * (qblk - 1) + (slot - 32); valid = sp >= 0; krow = b * SEQ + sp; kpos = NMETA + sp; }
        u32x4 lo = (u32x4){0u, 0u, 0u, 0u}, hi = lo;
        if (valid) {
            const bf16* kp = Z + (size_t)krow * DIN + ZK + kvh * 64 + c * 8;
            const u32x4 x1 = *(const u32x4*)kp, x2 = *(const u32x4*)(kp + 32);
            const f32x4 c0 = *(const f32x4*)(cosT + kpos * 32 + c * 8), c1 = *(const f32x4*)(cosT + kpos * 32 + c * 8 + 4);
            const f32x4 s0 = *(const f32x4*)(sinT + kpos * 32 + c * 8), s1 = *(const f32x4*)(sinT + kpos * 32 + c * 8 + 4);
#pragma unroll
            for (int q = 0; q < 4; ++q) { const float ca = q < 2 ? c0[2 * q] : c1[2 * q - 4], cb = q < 2 ? c0[2 * q + 1] : c1[2 * q - 3], sa = q < 2 ? s0[2 * q] : s1[2 * q - 4], sb = q < 2 ? s0[2 * q + 1] : s1[2 * q - 3];
                const float a0 = bflo(x1[q]), a1 = bfhi(x1[q]), b0 = bflo(x2[q]), b1 = bfhi(x2[q]);
                lo[q] = pk2(a0 * ca - b0 * sa, a1 * cb - b1 * sb); hi[q] = pk2(b0 * ca + a0 * sa, b1 * cb + a1 * sb); }
        }
        *(LAS u32x4*)(lds + AT_KOFF + slot * AT_KS + c * 16) = lo; *(LAS u32x4*)(lds + AT_KOFF + slot * AT_KS + 64 + c * 16) = hi;
    }
    for (int task = tid; task < 144 * 8; task += 512) {
        const int slot0 = (task >> 3) * 2, c = task & 7;
        int vrow; bool valid;
        if (slot0 < 32) { valid = slot0 < NMETA; vrow = METAROW0 + slot0; }
        else { const int sp = 128 * (qblk - 1) + (slot0 - 32); valid = sp >= 0; vrow = b * SEQ + sp; }
        u32x4 v0 = (u32x4){0u, 0u, 0u, 0u}, v1 = v0;
        if (valid) { const bf16* vp = Z + (size_t)vrow * DIN + ZV + kvh * 64 + c * 8; v0 = *(const u32x4*)vp; v1 = *(const u32x4*)(vp + DIN); }
#pragma unroll
        for (int q = 0; q < 4; ++q) {
            *(LAS unsigned*)(lds + AT_VOFF + (c * 8 + 2 * q) * AT_VS + slot0 * 2) = (v0[q] & 0xffffu) | (v1[q] << 16);
            *(LAS unsigned*)(lds + AT_VOFF + (c * 8 + 2 * q + 1) * AT_VS + slot0 * 2) = (v0[q] >> 16) | (v1[q] & 0xffff0000u); }
    }
    const int g = wave >> 1, hq = wave & 1, head = kvh * 4 + g, r31 = lane & 31, h = lane >> 5;
    bf16x8 qf[2][4];
#pragma unroll
    for (int qt = 0; qt < 2; ++qt) {
        const int s = 128 * qblk + 64 * hq + 32 * qt + r31, pos = NMETA + s;
        const bf16* qp = Z + (size_t)(b * SEQ + s) * DIN + ZQ + head * 64 + 8 * h;
        u32x4 x[4];
#pragma unroll
        for (int ks = 0; ks < 4; ++ks) x[ks] = *(const u32x4*)(qp + 16 * ks);
#pragma unroll
        for (int ks = 0; ks < 2; ++ks) {
            const float* cp = cosT + pos * 32 + 16 * ks + 8 * h; const float* sp = sinT + pos * 32 + 16 * ks + 8 * h;
            const f32x4 c0 = *(const f32x4*)cp, c1 = *(const f32x4*)(cp + 4), s0 = *(const f32x4*)sp, s1 = *(const f32x4*)(sp + 4);
            u32x4 lo, hi;
#pragma unroll
            for (int q = 0; q < 4; ++q) { const float ca = q < 2 ? c0[2 * q] : c1[2 * q - 4], cb = q < 2 ? c0[2 * q + 1] : c1[2 * q - 3], sa = q < 2 ? s0[2 * q] : s1[2 * q - 4], sb = q < 2 ? s0[2 * q + 1] : s1[2 * q - 3];
                const float a0 = bflo(x[ks][q]), a1 = bfhi(x[ks][q]), b0 = bflo(x[ks + 2][q]), b1 = bfhi(x[ks + 2][q]);
                lo[q] = pk2(0.125f * (a0 * ca - b0 * sa), 0.125f * (a1 * cb - b1 * sb)); hi[q] = pk2(0.125f * (b0 * ca + a0 * sa), 0.125f * (b1 * cb + a1 * sb)); }
            qf[qt][ks] = __builtin_bit_cast(bf16x8, lo); qf[qt][ks + 2] = __builtin_bit_cast(bf16x8, hi);
        }
    }
    f32x16 oacc[2][2]; float mrow[2], lrow[2];
#pragma unroll
    for (int qt = 0; qt < 2; ++qt) { mrow[qt] = a.in[I_SINKS][head]; lrow[qt] = h == 0 ? 1.0f : 0.0f;
#pragma unroll
        for (int dt = 0; dt < 2; ++dt)
#pragma unroll
            for (int r = 0; r < 16; ++r) oacc[qt][dt][r] = 0.f; }
    __syncthreads();
    attn_tile(lds, 0, 0, 0, lane, hq, qf, oacc, mrow, lrow);
    if (qblk > 0) {
#pragma unroll 1
        for (int j = hq ? 2 : 0; j < 4; ++j) attn_tile(lds, 32 + 32 * j, 1, j, lane, hq, qf, oacc, mrow, lrow);
    }
#pragma unroll 1
    for (int j = 0; j < (hq ? 4 : 2); ++j) attn_tile(lds, 160 + 32 * j, 2, j, lane, hq, qf, oacc, mrow, lrow);
#pragma unroll
    for (int qt = 0; qt < 2; ++qt) {
        const float lt = lrow[qt] + __shfl_xor(lrow[qt], 32), inv = 1.0f / lt;
        bf16* op = O + (size_t)(b * SEQ + 128 * qblk + 64 * hq + 32 * qt + r31) * OLD + head * 64 + 4 * h;
#pragma unroll
        for (int dt = 0; dt < 2; ++dt)
#pragma unroll
            for (int rr = 0; rr < 4; ++rr)
                *(u32x2*)(op + 32 * dt + 8 * rr) = (u32x2){pk2(oacc[qt][dt][4 * rr] * inv, oacc[qt][dt][4 * rr + 1] * inv), pk2(oacc[qt][dt][4 * rr + 2] * inv, oacc[qt][dt][4 * rr + 3] * inv)};
    }
}

constexpr int LR_XS = 2064;
__device__ __forceinline__ void lru_norm_rows(const Args& a, LAS unsigned char* lds, int b, int c, int lane, int wave) {
        bf16* O = (bf16*)(a.ws + WS_O); unsigned char* O8 = a.ws + WS_O;
        const bf16* ATT = (const bf16*)(a.ws + (G2_FP8 ? WS_ATT : WS_O)); constexpr int ALD = G2_FP8 ? 1024 : D;
        u32x4 aw[4][2];
#pragma unroll
        for (int q = 0; q < 4; ++q)
#pragma unroll
            for (int jj = 0; jj < 2; ++jj) aw[q][jj] = *(const u32x4*)(ATT + ((size_t)b * SEQ + 32 * c + 4 * wave + q) * ALD + (lane + 64 * jj) * 8);
        f32x4 ga[2][2], gl[2][2];
#pragma unroll
        for (int jj = 0; jj < 2; ++jj) { ga[jj][0] = *(const f32x4*)(a.in[I_G_ATTN] + (lane + 64 * jj) * 8); ga[jj][1] = *(const f32x4*)(a.in[I_G_ATTN] + (lane + 64 * jj) * 8 + 4);
            gl[jj][0] = *(const f32x4*)(a.in[I_G_LRU] + (lane + 64 * jj) * 8); gl[jj][1] = *(const f32x4*)(a.in[I_G_LRU] + (lane + 64 * jj) * 8 + 4); }
        __syncthreads();
#pragma unroll
        for (int q = 0; q < 4; ++q) {
            const int tl = 4 * wave + q; const size_t row = (size_t)b * SEQ + 32 * c + tl;
#pragma unroll
            for (int half = 0; half < 2; ++half) {
                u32x4 w[2]; float v[16]; float ss = 0.f;
#pragma unroll
                for (int jj = 0; jj < 2; ++jj) { w[jj] = half == 0 ? *(const LAS u32x4*)(lds + tl * LR_XS + (lane + 64 * jj) * 16) : aw[q][jj];
#pragma unroll
                    for (int k = 0; k < 4; ++k) { v[jj * 8 + 2 * k] = bflo(w[jj][k]); v[jj * 8 + 2 * k + 1] = bfhi(w[jj][k]); } }
#pragma unroll
                for (int k = 0; k < 16; ++k) ss += v[k] * v[k];
                ss = wave_sum(ss);
                const float rstd = (G2_FP8 ? XS_SCALE : 1.0f) * __builtin_amdgcn_rsqf(ss * (1.0f / 1024.0f) + EPS);
#pragma unroll
                for (int jj = 0; jj < 2; ++jj) { const f32x4 g0 = half == 0 ? gl[jj][0] : ga[jj][0], g1 = half == 0 ? gl[jj][1] : ga[jj][1];
                    const size_t col = (half == 0 ? 1024 : 0) + (lane + 64 * jj) * 8;
                    if (G2_FP8) *(u32x2*)(O8 + row * D + col) = (u32x2){pk4_fp8(v[jj * 8 + 0] * rstd * g0.x, v[jj * 8 + 1] * rstd * g0.y, v[jj * 8 + 2] * rstd * g0.z, v[jj * 8 + 3] * rstd * g0.w),
                                                                       pk4_fp8(v[jj * 8 + 4] * rstd * g1.x, v[jj * 8 + 5] * rstd * g1.y, v[jj * 8 + 6] * rstd * g1.z, v[jj * 8 + 7] * rstd * g1.w)};
                    else *(u32x4*)(O + row * D + col) = (u32x4){pk2(v[jj * 8 + 0] * rstd * g0.x, v[jj * 8 + 1] * rstd * g0.y), pk2(v[jj * 8 + 2] * rstd * g0.z, v[jj * 8 + 3] * rstd * g0.w),
                                                                pk2(v[jj * 8 + 4] * rstd * g1.x, v[jj * 8 + 5] * rstd * g1.y), pk2(v[jj * 8 + 6] * rstd * g1.z, v[jj * 8 + 7] * rstd * g1.w)}; }
            }
        }
}
template <int PASS>
__device__ __forceinline__ void lru_item(const Args& a, LAS unsigned char* lds, int item, int tid, int lane, int wave) {
    const int b = item / 65, c = item % 65; const bool meta = (c == 64);
    const bf16* Z = (const bf16*)(a.ws + WS_Z);
    float* sumA = (float*)(a.ws + WS_LRUSUM); float* sumB = sumA + NBATCH * 64 * DLRU; float* metaB = sumB + NBATCH * 64 * DLRU;
    __syncthreads();
    {
        const int ch0 = (tid & 127) * 8, tq = tid >> 7;
        f32x4 cw[4][2], cb[2];
#pragma unroll
        for (int jj = 0; jj < 4; ++jj) { cw[jj][0] = *(const f32x4*)(a.in[I_CONV_W] + jj * DLRU + ch0); cw[jj][1] = *(const f32x4*)(a.in[I_CONV_W] + jj * DLRU + ch0 + 4); }
        cb[0] = *(const f32x4*)(a.in[I_CONV_B] + ch0); cb[1] = *(const f32x4*)(a.in[I_CONV_B] + ch0 + 4);
#pragma unroll 1
        for (int i0 = 0; i0 < 8; i0 += 4) {
            u32x4 x[4][4];
#pragma unroll
            for (int i = 0; i < 4; ++i) { const int tl = tq + 4 * (i0 + i); const int t = meta ? tl : NMETA + 32 * c + tl;
#pragma unroll
                for (int jj = 0; jj < 4; ++jj) { const int tt = t - 3 + jj; x[i][jj] = (u32x4){0u, 0u, 0u, 0u};
                    if (tt >= 0 && !(meta && tl >= NMETA)) x[i][jj] = *(const u32x4*)(Z + (size_t)tok_row(b, tt) * DIN + ZX + ch0); } }
#pragma unroll
            for (int i = 0; i < 4; ++i) { const int tl = tq + 4 * (i0 + i); const int t = meta ? tl : NMETA + 32 * c + tl;
                f32x4 a0 = cb[0], a1 = cb[1];
#pragma unroll
                for (int jj = 0; jj < 4; ++jj) { const u32x4 xx = x[i][jj];
                    if (t - 3 + jj >= 0) {
                        a0.x += cw[jj][0].x * bflo(xx[0]); a0.y += cw[jj][0].y * bfhi(xx[0]); a0.z += cw[jj][0].z * bflo(xx[1]); a0.w += cw[jj][0].w * bfhi(xx[1]);
                        a1.x += cw[jj][1].x * bflo(xx[2]); a1.y += cw[jj][1].y * bfhi(xx[2]); a1.z += cw[jj][1].z * bflo(xx[3]); a1.w += cw[jj][1].w * bfhi(xx[3]); } }
                u32x4 o = (u32x4){pk2(a0.x, a0.y), pk2(a0.z, a0.w), pk2(a1.x, a1.y), pk2(a1.z, a1.w)};
                if (meta && tl >= NMETA) o = (u32x4){0u, 0u, 0u, 0u};
                *(LAS u32x4*)(lds + tl * LR_XS + ch0 * 2) = o; }
        }
    }
    LAS float* hinL = (LAS float*)(lds + 32 * LR_XS);
    if (PASS == 1) {
        float h0 = metaB[tid], h1 = metaB[tid + 512];
        const float* pa = sumA + (size_t)b * 64 * DLRU + tid; const float* pb = sumB + (size_t)b * 64 * DLRU + tid;
#pragma unroll 8
        for (int jc = 0; jc < c; ++jc) { h0 = pa[jc * DLRU] * h0 + pb[jc * DLRU]; h1 = pa[jc * DLRU + 512] * h1 + pb[jc * DLRU + 512]; }
        hinL[tid] = h0; hinL[tid + 512] = h1;
    }
    __syncthreads();
    const bf16* WaT = (const bf16*)(a.ws + WS_WAT); const bf16* WiT = (const bf16*)(a.ws + WS_WIT);
    const int r31 = lane & 31, h = lane >> 5;
    const int tau = 16 * ((r31 >> 2) & 1) + 4 * (r31 >> 3) + (r31 & 3);
#pragma unroll 1
    for (int nb = 0; nb < 2; ++nb) {
        const int n = 2 * wave + nb;
        bf16x8 af[4];
#pragma unroll
        for (int ks = 0; ks < 4; ++ks) af[ks] = *(const LAS bf16x8*)(lds + tau * LR_XS + (64 * n + 16 * ks + 8 * h) * 2);
#pragma unroll 1
        for (int nt = 0; nt < 2; ++nt) {
            const int ch = 64 * n + 32 * nt + r31;
            f32x16 accR, accI;
#pragma unroll
            for (int r = 0; r < 16; ++r) { accR[r] = 0.f; accI[r] = 0.f; }
#pragma unroll
            for (int ks = 0; ks < 4; ++ks) {
                const bf16x8 wa = *(const bf16x8*)(WaT + ((size_t)(n * 64 + 32 * nt + r31) * 64 + 16 * ks + 8 * h));
                const bf16x8 wi = *(const bf16x8*)(WiT + ((size_t)(n * 64 + 32 * nt + r31) * 64 + 16 * ks + 8 * h));
                accR = __builtin_amdgcn_mfma_f32_32x32x16_bf16(af[ks], wa, accR, 0, 0, 0);
                accI = __builtin_amdgcn_mfma_f32_32x32x16_bf16(af[ks], wi, accI, 0, 0, 0);
            }
            const float ba = a.in[I_B_A][ch], bi = a.in[I_B_I][ch], sp8 = -8.0f * 1.4426950408889634f * log1pf(__expf(-a.in[I_LAMBDA][ch]));
            float av[16], bv[16];
            float Ap = 1.0f, Bp = 0.0f;
#pragma unroll
            for (int r = 0; r < 16; ++r) {
                const float xcv = bf2f(*(const LAS unsigned short*)(lds + (16 * h + r) * LR_XS + ch * 2));
                const float rg = fast_sigmoid(accR[r] + ba), ig = fast_sigmoid(accI[r] + bi);
                const float l2a = sp8 * rg;
                av[r] = __builtin_amdgcn_exp2f(l2a); bv[r] = __builtin_amdgcn_sqrtf(fmaxf(fmaf(-av[r], av[r], 1.0f), 0.0f)) * ig * xcv;
                Ap *= av[r]; Bp = av[r] * Bp + bv[r];
                if (PASS == 0 && !meta) ((unsigned*)(a.ws + WS_AB))[((size_t)b * SEQ + 32 * c + 16 * h + r) * DLRU + ch] = pk2(l2a, bv[r]);
            }
            const float Ao = __shfl_xor(Ap, 32), Bo = __shfl_xor(Bp, 32);
            if (PASS == 0) {
                if (h == 0) {
                    if (meta) metaB[ch] = Bp;
                    else { sumA[((size_t)b * 64 + c) * DLRU + ch] = Ap * Ao; sumB[((size_t)b * 64 + c) * DLRU + ch] = Ao * Bp + Bo; }
                }
            } else {
                const float hin = hinL[ch];
                float hs = h == 0 ? hin : (Ao * hin + Bo);
#pragma unroll
                for (int r = 0; r < 16; ++r) {
                    hs = av[r] * hs + bv[r];
                    const int tl = 16 * h + r;
                    const float gt = bf2f(Z[(size_t)(b * SEQ + 32 * c + tl) * DIN + ZG + ch]);
                    *(LAS unsigned short*)(lds + tl * LR_XS + ch * 2) = (unsigned short)f2bf(hs * fast_gelu_tanh(gt));
                }
            }
        }
    }
}

__device__ __forceinline__ void lru_item_b(const Args& a, LAS unsigned char* lds, int item, int tid, int lane, int wave) {
    const int b = item >> 6, c = item & 63;
    const bf16* Z = (const bf16*)(a.ws + WS_Z); const unsigned* AB = (const unsigned*)(a.ws + WS_AB);
    const float* sumA = (const float*)(a.ws + WS_LRUSUM); const float* sumB = sumA + NBATCH * 64 * DLRU; const float* metaB = sumB + NBATCH * 64 * DLRU;
    const size_t row0 = (size_t)b * SEQ + 32 * c;
    u32x2 ab[32]; unsigned gt[32];
#pragma unroll
    for (int tl = 0; tl < 32; ++tl) { ab[tl] = *(const u32x2*)(AB + (row0 + tl) * DLRU + 2 * tid); gt[tl] = *(const unsigned*)(Z + (row0 + tl) * DIN + ZG + 2 * tid); }
    float h0, h1; { const f32x2 m = *(const f32x2*)(metaB + 2 * tid); h0 = m.x; h1 = m.y; }
    { const float* pa = sumA + (size_t)b * 64 * DLRU + 2 * tid; const float* pb = sumB + (size_t)b * 64 * DLRU + 2 * tid;
#pragma unroll 8
      for (int jc = 0; jc < c; ++jc) { const f32x2 A2 = *(const f32x2*)(pa + jc * DLRU), B2 = *(const f32x2*)(pb + jc * DLRU); h0 = A2.x * h0 + B2.x; h1 = A2.y * h1 + B2.y; } }
    __syncthreads();
#pragma unroll
    for (int tl = 0; tl < 32; ++tl) {
        h0 = __builtin_amdgcn_exp2f(bflo(ab[tl].x)) * h0 + bfhi(ab[tl].x);
        h1 = __builtin_amdgcn_exp2f(bflo(ab[tl].y)) * h1 + bfhi(ab[tl].y);
        *(LAS unsigned*)(lds + tl * LR_XS + 4 * tid) = pk2(h0 * fast_gelu_tanh(bflo(gt[tl])), h1 * fast_gelu_tanh(bfhi(gt[tl])));
    }
    lru_norm_rows(a, lds, b, c, lane, wave);
}

__device__ __forceinline__ void phase_router_mfma(const Args& a, LAS unsigned char* lds, int tid, int lane, int wave) {
    const bf16* H1 = (const bf16*)(a.ws + WS_H1); const bf16* WRT = (const bf16*)(a.ws + WS_WRT);
    int* tope = (int*)(a.ws + WS_TOPE); float* topw = (float*)(a.ws + WS_TOPW); float* rstd2 = (float*)(a.ws + WS_RSTD2);
    unsigned* counts = (unsigned*)(a.ws + WS_CTL) + CW_COUNTS;
    LAS float* lg = (LAS float*)(lds + wave * 2048);
    LAS int* hist = (LAS int*)(lds + 32768);
    if (tid < 32) hist[tid] = 0;
    __syncthreads();
    const int fr = lane & 15, fq = lane >> 4;
    for (int grp = wave * gridDim.x + blockIdx.x; grp < MREAL / 16; grp += 8 * gridDim.x) {
        const int row0 = grp * 16;
        const bf16* hp = H1 + (size_t)(row0 + fr) * D + 8 * fq;
        const bf16* wp = WRT + (size_t)fr * D + 8 * fq;
        f32x4 acc0 = (f32x4){0.f, 0.f, 0.f, 0.f}, acc1 = acc0; float ss = 0.f;
#pragma unroll 4
        for (int kk = 0; kk < 64; ++kk) {
            const u32x4 w = *(const u32x4*)(hp + 32 * kk);
#pragma unroll
            for (int q = 0; q < 4; ++q) { const float lo = bflo(w[q]), hi = bfhi(w[q]); ss += lo * lo + hi * hi; }
            const bf16x8 af = __builtin_bit_cast(bf16x8, w);
            const bf16x8 b0 = *(const bf16x8*)(wp + 32 * kk), b1 = *(const bf16x8*)(wp + (size_t)16 * D + 32 * kk);
            acc0 = __builtin_amdgcn_mfma_f32_16x16x32_bf16(af, b0, acc0, 0, 0, 0);
            acc1 = __builtin_amdgcn_mfma_f32_16x16x32_bf16(af, b1, acc1, 0, 0, 0);
        }
        ss += __shfl_xor(ss, 16); ss += __shfl_xor(ss, 32);
        const float rstd = 1.0f / sqrtf(ss * (1.0f / D) + EPS);
        if (fq == 0) rstd2[row0 + fr] = rstd;
        const float br0 = a.in[I_B_ROUTER][fr], br1 = a.in[I_B_ROUTER][16 + fr];
#pragma unroll
        for (int j = 0; j < 4; ++j) { const int row = 4 * fq + j; const float rs = __shfl(rstd, row);
            lg[row * 32 + fr] = acc0[j] * rs + br0; lg[row * 32 + 16 + fr] = acc1[j] * rs + br1; }
        asm volatile("s_waitcnt lgkmcnt(0)" ::: "memory");
        if (lane < 16) {
            float v[32];
#pragma unroll
            for (int q = 0; q < 8; ++q) { const f32x4 t = *(const LAS f32x4*)(lg + lane * 32 + 4 * q); v[4 * q] = t.x; v[4 * q + 1] = t.y; v[4 * q + 2] = t.z; v[4 * q + 3] = t.w; }
            float tv[4]; int te[4];
#pragma unroll
            for (int r = 0; r < 4; ++r) { float best = -3.0e38f; int bi = 0;
#pragma unroll
                for (int e = 0; e < 32; ++e) { const bool gtb = v[e] > best; best = gtb ? v[e] : best; bi = gtb ? e : bi; }
#pragma unroll
                for (int e = 0; e < 32; ++e) v[e] = (e == bi) ? -3.0e38f : v[e];
                tv[r] = best; te[r] = bi; }
            const float e1 = __expf(tv[1] - tv[0]), e2 = __expf(tv[2] - tv[0]), e3 = __expf(tv[3] - tv[0]);
            const float inv = 1.0f / (1.0f + e1 + e2 + e3);
            const int row = row0 + lane;
            *(int4*)(tope + row * 4) = make_int4(te[0], te[1], te[2], te[3]);
            *(f32x4*)(topw + row * 4) = (f32x4){inv, e1 * inv, e2 * inv, e3 * inv};
#pragma unroll
            for (int r = 0; r < 4; ++r) atomicAdd((int*)&hist[te[r]], 1);
        }
        asm volatile("s_waitcnt lgkmcnt(0)" ::: "memory");
    }
    __syncthreads();
    if (tid < 32 && hist[tid] != 0) atomicAdd(&counts[tid], (unsigned)hist[tid]);
}

__device__ __forceinline__ void build_tile_table(const Args& a, LAS int* tstart, int tid) {
    if (tid < 64) {
        const unsigned* counts = (const unsigned*)(a.ws + WS_CTL) + CW_COUNTS;
        const int nt = tid < NEXP ? (int)((__hip_atomic_load(counts + tid, __ATOMIC_RELAXED, __HIP_MEMORY_SCOPE_AGENT) + 255u) >> 8) : 0;
        int inc = nt;
#pragma unroll
        for (int o = 1; o < 32; o <<= 1) { const int v = __shfl_up(inc, o); if ((tid & 63) >= o) inc += v; }
        if (tid < NEXP) tstart[tid] = inc - nt;
        if (tid == NEXP - 1) tstart[NEXP] = inc;
    }
    __syncthreads();
    if (tid < 288) { int e = 0;
#pragma unroll 1
        for (int i = 1; i < NEXP; ++i) e += (tstart[i] <= tid) ? 1 : 0;
        ((LAS unsigned char*)(tstart + 64))[tid] = (unsigned char)e; }
    __syncthreads();
}
__device__ __forceinline__ int tile_expert(const LAS int* tstart, int tile) {
    int e = 0;
#pragma unroll 1
    for (int i = 1; i < NEXP; ++i) e += (tstart[i] <= tile) ? 1 : 0;
    return e;
}

__device__ __forceinline__ void phase_assign(const Args& a, LAS unsigned char* lds, int tid, int lane, int wave) {
    LAS int* tstart = (LAS int*)(lds + LDS_TAB);
    LAS int* hist = tstart + 64; LAS int* base = hist + 32; LAS int* spos = base + 32;
    build_tile_table(a, tstart, tid);
    const int* tope = (const int*)(a.ws + WS_TOPE); const float* topw = (const float*)(a.ws + WS_TOPW); const float* rstd2 = (const float*)(a.ws + WS_RSTD2);
    int* rowpair = (int*)(a.ws + WS_ROWPAIR); float* roww = (float*)(a.ws + WS_ROWW);
    unsigned* cursor = (unsigned*)(a.ws + WS_CTL) + CW_CURSOR;
    const bf16* H1 = (const bf16*)(a.ws + WS_H1); unsigned char* XS = (unsigned char*)(a.ws + WS_XS);
    for (int blk = blockIdx.x; blk < MREAL / 64; blk += gridDim.x) {
        if (tid < 32) hist[tid] = 0;
        __syncthreads();
        int e = 0, rank = 0, pair = 0;
        if (tid < 256) { pair = blk * 256 + tid; e = tope[pair]; rank = atomicAdd((int*)&hist[e], 1); }
        __syncthreads();
        if (tid < 32) base[tid] = (int)atomicAdd(&cursor[tid], (unsigned)hist[tid]);
        __syncthreads();
        if (tid < 256) { const int pos = tstart[e] * 256 + base[e] + rank; spos[tid] = pos; rowpair[pos] = pair; roww[pos] = topw[pair]; ((int*)(a.ws + WS_PAIRPOS))[pair] = pos; }
        __syncthreads();
        for (int tt = wave * 8; tt < wave * 8 + 8; ++tt) {
            const int token = blk * 64 + tt; const float rstd = rstd2[token] * XS_SCALE;
            const u32x4* hr = (const u32x4*)(H1 + (size_t)token * D);
            u32x4* dst = (u32x4*)(XS + (size_t)token * D);
#pragma unroll
            for (int j = 0; j < 2; ++j) { const u32x4 ha = hr[2 * (lane + 64 * j)], hb = hr[2 * (lane + 64 * j) + 1];
                const f32x4* gp = (const f32x4*)a.in[I_NORM_FFN] + 4 * (lane + 64 * j); const f32x4 g0 = gp[0], g1 = gp[1], g2 = gp[2], g3 = gp[3];
                dst[lane + 64 * j] = (u32x4){pk4_fp8(bflo(ha[0]) * rstd * g0.x, bfhi(ha[0]) * rstd * g0.y, bflo(ha[1]) * rstd * g0.z, bfhi(ha[1]) * rstd * g0.w),
                                             pk4_fp8(bflo(ha[2]) * rstd * g1.x, bfhi(ha[2]) * rstd * g1.y, bflo(ha[3]) * rstd * g1.z, bfhi(ha[3]) * rstd * g1.w),
                                             pk4_fp8(bflo(hb[0]) * rstd * g2.x, bfhi(hb[0]) * rstd * g2.y, bflo(hb[1]) * rstd * g2.z, bfhi(hb[1]) * rstd * g2.w),
                                             pk4_fp8(bflo(hb[2]) * rstd * g3.x, bfhi(hb[2]) * rstd * g3.y, bflo(hb[3]) * rstd * g3.z, bfhi(hb[3]) * rstd * g3.w)}; }
        }
        __syncthreads();
    }
}

__device__ __forceinline__ void phase_final(const Args& a, int lane, int wave) {
    const int gw = blockIdx.x * 8 + wave, NGW = gridDim.x * 8;
    const bf16* H1 = (const bf16*)(a.ws + WS_H1); const unsigned char* YB = a.ws + WS_YB;
    const int* pairpos = (const int*)(a.ws + WS_PAIRPOS); const float* topw = (const float*)(a.ws + WS_TOPW);
    for (int row = gw; row < MREAL; row += NGW) {
        const int4 pp = *(const int4*)(pairpos + row * 4); const f32x4 pw = *(const f32x4*)(topw + row * 4) * (1.0f / YB_SCALE);
        const int pos[4] = {pp.x, pp.y, pp.z, pp.w}; const float w4[4] = {pw.x, pw.y, pw.z, pw.w};
        f32x4 v[8]; unsigned y[4][8]; float ss = 0.f;
#pragma unroll
        for (int k = 0; k < 4; ++k)
#pragma unroll
            for (int j = 0; j < 8; ++j) y[k][j] = ((const unsigned*)(YB + (size_t)pos[k] * D))[lane + 64 * j];
#pragma unroll
        for (int j = 0; j < 8; ++j) { { const u32x2 hh = ((const u32x2*)(H1 + (size_t)row * D))[lane + 64 * j]; v[j] = (f32x4){bflo(hh.x), bfhi(hh.x), bflo(hh.y), bfhi(hh.y)}; }
#pragma unroll
            for (int k = 0; k < 4; ++k) { const f32x2 lo = __builtin_amdgcn_cvt_pk_f32_fp8((int)y[k][j], false), hi = __builtin_amdgcn_cvt_pk_f32_fp8((int)y[k][j], true);
                v[j].x += w4[k] * lo.x; v[j].y += w4[k] * lo.y; v[j].z += w4[k] * hi.x; v[j].w += w4[k] * hi.y; }
            ss += (v[j].x * v[j].x + v[j].y * v[j].y) + (v[j].z * v[j].z + v[j].w * v[j].w); }
        ss = wave_sum(ss);
        const float rstd = 1.0f / sqrtf(ss * (1.0f / D) + EPS);
        f32x4* op = (f32x4*)(a.out + (size_t)row * D);
#pragma unroll
        for (int j = 0; j < 8; ++j) { const f32x4 g = ((const f32x4*)a.in[I_FINAL_NORM])[lane + 64 * j]; op[lane + 64 * j] = v[j] * rstd * g; }
    }
}

enum { PH_PROLOGUE = 0, PH_G1, PH_ATTN, PH_LRU_B, PH_G2, PH_ROUTER, PH_ASSIGN, PH_G3, PH_G4, PH_FINAL, PH_COUNT };

__global__ void __launch_bounds__(512, 2) fwd(Args a) {
    extern __shared__ __attribute__((aligned(16))) unsigned char lds_raw[];
    LAS unsigned char* lds = (LAS unsigned char*)lds_raw;
    const int tid = threadIdx.x, lane = tid & 63, wave = __builtin_amdgcn_readfirstlane(tid >> 6);
    const int gw = blockIdx.x * 8 + wave, NGW = gridDim.x * 8;
    unsigned char* ws = a.ws;
#define IN(k) (a.ph_lo <= (k) && (k) < a.ph_hi)
    pg8::BGNone nobg;
    pg8::BGConv bgup{(const char*)a.in[I_W_UP], ws + WS_WUT, (int)blockIdx.x * 128, (int)blockIdx.x * 128 + 80, ws + WS_DUMMY};
#define SEAM(k) do { if (IN(k) && IN((k) + 1)) xcd_barrier(bar); } while (0)
    if (tid < 4) ((LAS unsigned*)(lds + LDS_MISC))[tid] = 0u;
    __syncthreads();
    XcdBarrier bar; bar.bar = (unsigned*)(ws + WS_CTL) + CW_BAR; bar.x = 0; bar.st = nullptr;
    if (a.ph_hi - a.ph_lo > 1) bar = xcd_barrier_post((unsigned*)(ws + WS_CTL) + CW_BAR, (volatile LAS unsigned*)(lds + LDS_MISC));

    if (IN(PH_PROLOGUE)) { phase_prologue(a, lds, tid, lane, wave);
#if PROBE_REPEAT == 0
        __syncthreads(); phase_prologue(a, lds, tid, lane, wave);
#endif
    }
    SEAM(PH_PROLOGUE);

    if (IN(PH_G1)) {
        pg8::SchedDense S{(const char*)(ws + WS_N1), (const char*)(ws + WS_WINT), (const char*)(ws + WS_WINT), nullptr, MROWS / 256, DIN / 256, (int)gridDim.x, (int)blockIdx.x, G1_FP8 ? 2048 : 4096};
        pg8::EpiZ E{(bf16*)(ws + WS_Z), a.in[I_B_IN], G1_FP8 ? 1.0f / (W_SCALE * XS_SCALE) : 1.0f};
#if BG_WUP
        pg8::gemm_phase<G1_FP8 != 0>(lds, S, E, bgup);
#else
        pg8::gemm_phase<G1_FP8 != 0>(lds, S, E, nobg);
#endif
#if PROBE_REPEAT == 1
        __syncthreads(); pg8::gemm_phase<G1_FP8 != 0>(lds, S, E, nobg);
#endif
    }
    SEAM(PH_G1);
    if (IN(PH_ATTN)) {
        for (int it = blockIdx.x; it < NBATCH * 16 * 4; it += gridDim.x) attn_item(a, lds, it, tid, lane, wave);
        for (int it = blockIdx.x; it < NBATCH * 65; it += gridDim.x) { if (it % 65 == 64 && it != 64) continue; lru_item<0>(a, lds, it, tid, lane, wave); }
#if PROBE_REPEAT == 2
        for (int it = blockIdx.x; it < NBATCH * 16 * 4; it += gridDim.x) attn_item(a, lds, it, tid, lane, wave);
#endif
#if PROBE_REPEAT == 3
        for (int it = blockIdx.x; it < NBATCH * 65; it += gridDim.x) { if (it % 65 == 64 && it != 64) continue; lru_item<0>(a, lds, it, tid, lane, wave); }
#endif
    }
    SEAM(PH_ATTN);
    if (IN(PH_LRU_B)) {
        for (int it = blockIdx.x; it < NBATCH * 64; it += gridDim.x) lru_item_b(a, lds, it, tid, lane, wave);
    }
    SEAM(PH_LRU_B);
    if (IN(PH_G2)) {
        pg8::SchedDense S{(const char*)(ws + WS_O), (const char*)(ws + WS_WOUTT), (const char*)(ws + WS_WOUTT), nullptr, MREAL / 256, D / 256, (int)gridDim.x, (int)blockIdx.x, G2_FP8 ? 2048 : 4096};
        pg8::EpiH1 E{(bf16*)(ws + WS_H1), a.in[I_X], a.in[I_B_OUT], G2_FP8 ? 1.0f / (W_SCALE * XS_SCALE) : 1.0f};
#if BG_WUP
        pg8::gemm_phase<G2_FP8 != 0>(lds, S, E, bgup);
        for (int pair = bgup.next < bgup.end ? bgup.next : bgup.end; pair < bgup.end; ++pair) { const char* sp; unsigned char* dp; pg8::bg_pair_ptrs(bgup, pair, sp, dp);
            const int n = tid >> 4, c = tid & 15; const float* p = (const float*)sp + (size_t)(8 * c) * 2048 + n;
            *(u32x2*)(dp + (size_t)n * 2048 + 8 * c) = (u32x2){pk4_fp8(p[0] * W_SCALE, p[2048] * W_SCALE, p[4096] * W_SCALE, p[6144] * W_SCALE), pk4_fp8(p[8192] * W_SCALE, p[10240] * W_SCALE, p[12288] * W_SCALE, p[14336] * W_SCALE)}; }
#else
        pg8::gemm_phase<G2_FP8 != 0>(lds, S, E, nobg);
#endif
#if PROBE_REPEAT == 4
        __syncthreads(); pg8::gemm_phase<G2_FP8 != 0>(lds, S, E, nobg);
#endif
    }
    SEAM(PH_G2);
    if (IN(PH_ROUTER)) phase_router_mfma(a, lds, tid, lane, wave);
    SEAM(PH_ROUTER);
    if (IN(PH_ASSIGN)) phase_assign(a, lds, tid, lane, wave);
    SEAM(PH_ASSIGN);
    if (IN(PH_G3)) {
        LAS int* tstart = (LAS int*)(lds + LDS_TAB);
        build_tile_table(a, tstart, tid);
        pg8::SchedMoE S{(const char*)(ws + WS_N2), (const char*)(ws + WS_WGT), (const char*)(ws + WS_WUT), (const int*)(ws + WS_ROWPAIR), tstart, tstart[NEXP], DFF / 128, (int)gridDim.x, (int)blockIdx.x, true};
        pg8::EpiAct E{(unsigned char*)(ws + WS_ACT), a.in[I_B_GATE], a.in[I_B_UP]};
#if BG_WDOWN
        pg8::BGConv bg{(const char*)a.in[I_W_DOWN], ws + WS_WDT, (int)blockIdx.x * (32768 / 256), ((int)blockIdx.x + 1) * (32768 / 256), ws + WS_DUMMY};
        if (gridDim.x != 256) { bg.next = (int)((long)blockIdx.x * 32768 / gridDim.x); bg.end = (int)((long)(blockIdx.x + 1) * 32768 / gridDim.x); }
        pg8::gemm_phase<true, pg8::EpiAct, pg8::SchedMoE, pg8::BGConv, true>(lds, S, E, bg);
        for (int pair = bg.next < bg.end ? bg.next : bg.end; pair < bg.end; ++pair) { const char* sp; unsigned char* dp; pg8::bg_pair_ptrs(bg, pair, sp, dp);
            const int n = tid >> 4, c = tid & 15;
            const float* p = (const float*)sp + (size_t)(8 * c) * 2048 + n;
            *(u32x2*)(dp + (size_t)n * 2048 + 8 * c) = (u32x2){pk4_fp8(p[0] * W_SCALE, p[2048] * W_SCALE, p[4096] * W_SCALE, p[6144] * W_SCALE), pk4_fp8(p[8192] * W_SCALE, p[10240] * W_SCALE, p[12288] * W_SCALE, p[14336] * W_SCALE)}; }
#else
        pg8::gemm_phase<true>(lds, S, E, nobg);
#endif
#if PROBE_REPEAT == 7
        __syncthreads(); pg8::gemm_phase<true>(lds, S, E, nobg);
#endif
    }
    SEAM(PH_G3);
    if (IN(PH_G4)) {
        LAS int* tstart = (LAS int*)(lds + LDS_TAB);
        build_tile_table(a, tstart, tid);
        pg8::SchedMoE S{(const char*)(ws + WS_ACT), (const char*)(ws + WS_WDT), (const char*)(ws + WS_WDT), nullptr, tstart, tstart[NEXP], D / 256, (int)gridDim.x, (int)blockIdx.x, false};
        pg8::EpiDown E{ws + WS_YB, a.in[I_B_DOWN]};
        pg8::gemm_phase<true>(lds, S, E, nobg);
#if PROBE_REPEAT == 8
        __syncthreads(); pg8::gemm_phase<true>(lds, S, E, nobg);
#endif
    }
    SEAM(PH_G4);
    if (IN(PH_FINAL)) { phase_final(a, lane, wave);
#if PROBE_REPEAT == 9
        phase_final(a, lane, wave);
#endif
    }
#undef IN
#undef SEAM
}

extern "C" void kernel_launch(void* const* d_in, const int* in_sizes, int n_in, void* d_out, int out_size, void* d_ws, size_t ws_size, hipStream_t stream) {
    static int grid = 0;
    if (grid == 0) {
        if (n_in != 27 || out_size != MREAL * D || ws_size < WS_END) { fprintf(stderr, "kernel_launch: unexpected problem (n_in %d, out %d, ws %zu)\n", n_in, out_size, ws_size); grid = -1; return; }
        int dev = 0, cus = 0;
        if (hipGetDevice(&dev) != hipSuccess || hipDeviceGetAttribute(&cus, hipDeviceAttributeMultiprocessorCount, dev) != hipSuccess) { grid = -1; return; }
        if (hipFuncSetAttribute((const void*)fwd, hipFuncAttributeMaxDynamicSharedMemorySize, LDS_BYTES) != hipSuccess) { fprintf(stderr, "kernel_launch: hipFuncSetAttribute failed\n"); grid = -1; return; }
        grid = cus;
    }
    if (grid < 0) return;
    (void)hipMemsetAsync((char*)d_ws + WS_CTL, 0, CTL_BYTES, stream);
    Args a{};
    for (int i = 0; i < 27; ++i) a.in[i] = (const float*)d_in[i];
    a.out = (float*)d_out; a.ws = (unsigned char*)d_ws;
#if MK_ONE_LAUNCH
    a.ph_lo = 0; a.ph_hi = PH_COUNT;
    hipLaunchKernelGGL(fwd, dim3(grid), dim3(512), LDS_BYTES, stream, a);
#else
    for (int ph = 0; ph < PH_COUNT; ++ph) {
        a.ph_lo = ph; a.ph_hi = ph + 1;
        hipLaunchKernelGGL(fwd, dim3(grid), dim3(512), LDS_BYTES, stream, a);
    }
#endif
}
```

```cpp
#include <hip/hip_runtime.h>
#include <cstdio>
#include <cstdint>

#define LAS __attribute__((address_space(3)))
#ifndef PROBE_REPEAT
#define PROBE_REPEAT -1
#endif
#ifndef G1_FP8
#define G1_FP8 0
#endif
#ifndef G2_FP8
#define G2_FP8 0
#endif
#ifndef BG_WDOWN
#define BG_WDOWN 1
#endif
#ifndef BG_WUP
#define BG_WUP 0
#endif
#ifndef BG_EXP
#define BG_EXP 0
#endif
#ifndef MK_ONE_LAUNCH
#define MK_ONE_LAUNCH 1
#endif
typedef unsigned short bf16;
typedef float f32x4 __attribute__((ext_vector_type(4)));
typedef float f32x2 __attribute__((ext_vector_type(2)));
typedef short bf16x8 __attribute__((ext_vector_type(8)));
typedef unsigned u32x4 __attribute__((ext_vector_type(4)));
typedef unsigned u32x2 __attribute__((ext_vector_type(2)));

constexpr int D = 2048, SEQ = 2048, NMETA = 16, TT = 2064, NBATCH = 8;
constexpr int MREAL = 16384, METAROW0 = 16384, MVALID = 16400, MROWS = 16640;
constexpr int DIN = 3584, DLRU = 1024, HD = 64;
constexpr int ZQ = 0, ZK = 1024, ZV = 1280, ZX = 1536, ZG = 2560;
constexpr int NEXP = 32, DFF = 2048, PROWS = 73728;
constexpr float EPS = 1e-5f;

constexpr size_t MiB = 1u << 20;
constexpr size_t WS_CTL = 0, CTL_BYTES = 1 * MiB;
constexpr size_t WS_COS = 1 * MiB, WS_SIN = 1 * MiB + 320 * 1024;
constexpr size_t WS_TOPE = 2 * MiB, WS_TOPW = WS_TOPE + 256 * 1024, WS_RSTD2 = WS_TOPW + 256 * 1024, WS_ROWPAIR = WS_RSTD2 + 64 * 1024, WS_ROWW = WS_ROWPAIR + 320 * 1024;
constexpr size_t WS_PAIRPOS = 3 * MiB + 256 * 1024;
constexpr size_t WS_DUMMY = 3 * MiB + 512 * 1024;
constexpr size_t WS_LRUSUM = 4 * MiB;
constexpr size_t WS_WAT = 9 * MiB, WS_WIT = WS_WAT + 128 * 1024, WS_WRT = WS_WIT + 128 * 1024;
constexpr size_t WS_WINT = 10 * MiB, WS_WOUTT = 24 * MiB, WS_WGT = 32 * MiB, WS_WUT = 288 * MiB, WS_WDT = 544 * MiB;
constexpr size_t WS_N1 = 800 * MiB, WS_Z = 866 * MiB, WS_O = 980 * MiB, WS_H1 = 1044 * MiB, WS_XS = 1172 * MiB, WS_YB = WS_XS, WS_ACT = 1460 * MiB, WS_END = 1748 * MiB;
constexpr size_t WS_N2 = WS_XS;
constexpr size_t WS_AB = WS_XS;
constexpr size_t WS_ATT = WS_N1;
constexpr size_t WS_XC = WS_XS, WS_AA = WS_XS + 66 * MiB, WS_BB = WS_XS + 132 * MiB, WS_YL = WS_XS + 198 * MiB;
static_assert(WS_ROWW + PROWS * 4 <= WS_LRUSUM, "small map");
constexpr int CW_COUNTS = 1024, CW_CURSOR = 1088, CW_BAR = 4096;

constexpr int LDS_TAB = 131072;
constexpr int LDS_META = LDS_TAB + 1024;
constexpr int LDS_RID = LDS_META + 3072;
constexpr int LDS_MISC = LDS_TAB + 8192;
constexpr int LDS_BG = LDS_MISC + 1024;
constexpr int LDS_T2 = LDS_BG + 16384;
constexpr int LDS_BYTES = LDS_T2 + 4352;
static_assert(LDS_BYTES <= 163840 && LDS_BG % 1024 == 0, "LDS map");

__device__ const float c_inv_freq[32] = {1.000000000e+00f, 7.498942018e-01f, 5.623413324e-01f, 4.216965139e-01f, 3.162277639e-01f, 2.371373922e-01f, 1.778279394e-01f, 1.333521456e-01f, 1.000000015e-01f, 7.498941571e-02f, 5.623412877e-02f, 4.216964915e-02f, 3.162277862e-02f, 2.371373586e-02f, 1.778279431e-02f, 1.333521493e-02f, 9.999999776e-03f, 7.498942316e-03f, 5.623413250e-03f, 4.216964822e-03f, 3.162277862e-03f, 2.371373819e-03f, 1.778279431e-03f, 1.333521446e-03f, 1.000000047e-03f, 7.498941850e-04f, 5.623413017e-04f, 4.216965463e-04f, 3.162277862e-04f, 2.371373848e-04f, 1.778279402e-04f, 1.333521504e-04f};

struct Args { const float* in[27]; float* out; unsigned char* ws; int ph_lo, ph_hi; };
enum { I_X = 0, I_META, I_NORM_MIX, I_W_IN, I_B_IN, I_SINKS, I_CONV_W, I_CONV_B, I_W_A, I_B_A, I_W_I, I_B_I, I_LAMBDA, I_G_ATTN, I_G_LRU, I_W_OUT, I_B_OUT, I_NORM_FFN,
       I_W_ROUTER, I_B_ROUTER, I_W_GATE, I_B_GATE, I_W_UP, I_B_UP, I_W_DOWN, I_B_DOWN, I_FINAL_NORM };


#define XB_TMO      128
#define XB_XCNT(j)  (256  + 64 * (j))
#define XB_XSUB(j)  (1280 + 64 * (j))
#define XB_XGEN(j)  (2304 + 64 * (j))
#define XB_TOP      3328
#define XB_TOPGEN   3392
#define XCD_BAR_WORDS 3456
#define XB_SPIN_CAP (1u << 18)

__device__ __forceinline__ unsigned xb_ld(unsigned* p)              { return __hip_atomic_load(p, __ATOMIC_RELAXED, __HIP_MEMORY_SCOPE_AGENT); }
__device__ __forceinline__ unsigned xb_add(unsigned* p, unsigned v) { return __hip_atomic_fetch_add(p, v, __ATOMIC_RELAXED, __HIP_MEMORY_SCOPE_AGENT); }
__device__ __forceinline__ unsigned xb_xcc_id() { return (unsigned)__builtin_amdgcn_s_getreg((3 << 11) | 20) & 0xFu; }
#define XB_SPIN(cond, bar) do { unsigned _sp = 0; while (cond) { __builtin_amdgcn_s_sleep(1); \
    if ((++_sp & 255u) == 0u) { if (xb_ld(&(bar)[XB_TMO])) break; if (_sp > XB_SPIN_CAP) { atomicAdd(&(bar)[XB_TMO], 1u); break; } } } } while (0)

struct XcdBarrier {
    unsigned* bar; unsigned x;
    volatile LAS unsigned* st;
};

__device__ __forceinline__ XcdBarrier xcd_barrier_post(unsigned* bar, volatile LAS unsigned* st) {
    XcdBarrier b; b.bar = bar; b.x = xb_xcc_id(); b.st = st;
    if (threadIdx.x == 0) (void)xb_add(&bar[XB_XCNT(b.x)], 1u);
    return b;
}
__device__ __forceinline__ void xcd_barrier_complete(unsigned* bar, unsigned x, unsigned& nloc, unsigned& nx) {
    const unsigned G = gridDim.x * gridDim.y * gridDim.z;
    unsigned sum, cnt, mine, sp = 0u;
    for (;;) {
        sum = 0u; cnt = 0u; mine = 0u;
#pragma unroll
        for (unsigned j = 0; j < 16; ++j) { const unsigned c = xb_ld(&bar[XB_XCNT(j)]); sum += c; cnt += (c > 0u) ? 1u : 0u; mine = (j == x) ? c : mine; }
        if (sum == G) break;
        __builtin_amdgcn_s_sleep(1);
        if ((++sp & 255u) == 0u) { if (xb_ld(&bar[XB_TMO])) break; if (sp > XB_SPIN_CAP) { atomicAdd(&bar[XB_TMO], 1u); break; } }
    }
    nloc = mine > 0u ? mine : 1u; nx = cnt > 0u ? cnt : 1u;
}

__device__ __forceinline__ void xcd_barrier(const XcdBarrier& b) {
    asm volatile("s_waitcnt vmcnt(0)" ::: "memory");
    __syncthreads();
    if (threadIdx.x == 0) {
        unsigned* bar = b.bar;
        __builtin_amdgcn_s_waitcnt(0);
        unsigned nloc = b.st[0], nx = b.st[1];
        if (nloc == 0u) { xcd_barrier_complete(bar, b.x, nloc, nx); b.st[0] = nloc; b.st[1] = nx; }
        const unsigned old = xb_add(&bar[XB_XSUB(b.x)], 1u);
        const unsigned gen = old / nloc;
        if (old + 1u == (gen + 1u) * nloc) {
            __builtin_amdgcn_fence(__ATOMIC_RELEASE, "agent");
            asm volatile("s_waitcnt vmcnt(0)" ::: "memory");
            const unsigned og = xb_add(&bar[XB_TOP], 1u);
            const unsigned tg = og / nx;
            if (og + 1u == (tg + 1u) * nx) xb_add(&bar[XB_TOPGEN], 1u);
            else XB_SPIN(xb_ld(&bar[XB_TOPGEN]) == tg, bar);
            __builtin_amdgcn_fence(__ATOMIC_ACQUIRE, "agent");
            xb_add(&bar[XB_XGEN(b.x)], 1u);
            asm volatile("s_waitcnt vmcnt(0)" ::: "memory");
        } else {
            XB_SPIN(xb_ld(&bar[XB_XGEN(b.x)]) == gen, bar);
            __builtin_amdgcn_fence(__ATOMIC_ACQUIRE, "agent");
            asm volatile("s_waitcnt vmcnt(0)" ::: "memory");
        }
    }
    __syncthreads();
}

__device__ __forceinline__ float bf2f(unsigned b) { return __uint_as_float((b & 0xffffu) << 16); }
__device__ __forceinline__ unsigned f2bf(float f) { unsigned u = __float_as_uint(f); return (u + 0x7fffu + ((u >> 16) & 1u)) >> 16; }
__device__ __forceinline__ unsigned pk2(float lo, float hi) { return f2bf(lo) | (f2bf(hi) << 16); }
constexpr float W_SCALE = 256.0f, XS_SCALE = 8.0f, ACT_SCALE = 4.0f, YB_SCALE = 16.0f;
__device__ __forceinline__ float clamp_fp8(float x) { return __builtin_amdgcn_fmed3f(x, -448.0f, 448.0f); }
__device__ __forceinline__ unsigned pk4_fp8(float a, float b, float c, float d) {
    int w = 0; w = __builtin_amdgcn_cvt_pk_fp8_f32(clamp_fp8(a), clamp_fp8(b), w, false); w = __builtin_amdgcn_cvt_pk_fp8_f32(clamp_fp8(c), clamp_fp8(d), w, true); return (unsigned)w; }
__device__ __forceinline__ float wave_sum(float v) {
#pragma unroll
    for (int o = 1; o < 64; o <<= 1) v += __shfl_xor(v, o);
    return v;
}
__device__ __forceinline__ float wave_max(float v) {
#pragma unroll
    for (int o = 1; o < 64; o <<= 1) v = fmaxf(v, __shfl_xor(v, o));
    return v;
}
__device__ __forceinline__ float sigmoidf_(float x) { return 1.0f / (1.0f + __expf(-x)); }
__device__ __forceinline__ float fast_sigmoid(float x) { return __builtin_amdgcn_rcpf(1.0f + __builtin_amdgcn_exp2f(-1.4426950408889634f * x)); }
__device__ __forceinline__ float fast_gelu_tanh(float x) { const float u2 = 1.5957691216057308f * (x + 0.044715f * x * x * x); return x * __builtin_amdgcn_rcpf(1.0f + __builtin_amdgcn_exp2f(-1.4426950408889634f * u2)); }
__device__ __forceinline__ float gelu_tanh(float x) { const float u = 0.7978845608028654f * (x + 0.044715f * x * x * x); return 0.5f * x * (1.0f + tanhf(u)); }
__device__ __forceinline__ int tok_row(int b, int t) { return t < NMETA ? METAROW0 + t : b * SEQ + (t - NMETA); }

__device__ __forceinline__ void transpose_item(const float* W, int K, int N, bf16* WT, LAS float* scr, int item, int lane) {
    const int nblk = N / 32, kb = item / nblk, nb = item % nblk, k0 = 64 * kb, n0 = 32 * nb;
#pragma unroll 8
    for (int i = 0; i < 32; ++i) { const int kk = 2 * i + (lane >> 5); scr[kk * 33 + (lane & 31)] = W[(size_t)(k0 + kk) * N + n0 + (lane & 31)]; }
    asm volatile("s_waitcnt lgkmcnt(0)" ::: "memory");
    const int c = lane & 7;
#pragma unroll
    for (int j = 0; j < 4; ++j) { const int n = (lane >> 3) + 8 * j; const LAS float* s = scr + (8 * c) * 33 + n;
        u32x4 o; o.x = pk2(s[0 * 33], s[1 * 33]); o.y = pk2(s[2 * 33], s[3 * 33]); o.z = pk2(s[4 * 33], s[5 * 33]); o.w = pk2(s[6 * 33], s[7 * 33]);
        *(u32x4*)(WT + (size_t)(n0 + n) * K + k0 + 8 * c) = o; }
    asm volatile("s_waitcnt lgkmcnt(0)" ::: "memory");
}

__device__ __forceinline__ void phase_prologue(const Args& a, LAS unsigned char* lds, int tid, int lane, int wave) {
    const int gw = blockIdx.x * 8 + wave, NGW = gridDim.x * 8;
    const int gt = blockIdx.x * 512 + tid, NGT = gridDim.x * 512;
    unsigned char* ws = a.ws;
    LAS float* scr = (LAS float*)(lds + wave * 8704);
    {
        constexpr int IT_IN = G1_FP8 ? 0 : 32 * (DIN / 32), IT_OUT = G2_FP8 ? 0 : 32 * (D / 32);
        for (int it = gw; it < IT_IN + IT_OUT; it += NGW) {
            if (it < IT_IN) transpose_item(a.in[I_W_IN], D, DIN, (bf16*)(ws + WS_WINT), scr, it, lane);
            else transpose_item(a.in[I_W_OUT], D, D, (bf16*)(ws + WS_WOUTT), scr, it - IT_IN, lane);
        }
        __syncthreads();
    }
    {
        LAS unsigned* T = (LAS unsigned*)lds;
        const int n4 = tid & 63, kq = tid >> 6;
        constexpr int T_IN = G1_FP8 ? (D / 128) * (DIN / 256) : 0, T_OUT = G2_FP8 ? (D / 128) * (D / 256) : 0, T_E = (D / 128) * (D / 256);
        constexpr int N_GATE = 32 * T_E, N_UP = (BG_WUP && !BG_EXP) ? 256 * 6 : 32 * T_E, N_DOWN = (BG_WDOWN && !BG_EXP) ? 0 : 32 * T_E;
        constexpr int NTILES = T_IN + T_OUT + N_GATE + N_UP + N_DOWN;
        auto tile_ptrs = [&](int tile, const float*& sp, unsigned char*& dp, int& ldn) {
            const float* sbase; unsigned char* dbase; int tl, nt;
            if (tile < T_IN) { sbase = a.in[I_W_IN]; dbase = ws + WS_WINT; tl = tile; nt = DIN / 256; ldn = DIN; }
            else if (tile < T_IN + T_OUT) { sbase = a.in[I_W_OUT]; dbase = ws + WS_WOUTT; tl = tile - T_IN; nt = D / 256; ldn = D; }
            else { int r = tile - T_IN - T_OUT, which, e; nt = D / 256; ldn = D;
                   if (r < N_GATE) { which = 0; e = r / T_E; tl = r % T_E; }
                   else if (r < N_GATE + N_UP) { r -= N_GATE; which = 1; int g = r; if (BG_WUP && !BG_EXP) g = 16 * (r / 6) + 10 + (r % 6);
                                                 e = g / T_E; tl = g % T_E; }
                   else { r -= N_GATE + N_UP; which = 2; e = r / T_E; tl = r % T_E; }
                   sbase = a.in[which == 0 ? I_W_GATE : (which == 1 ? I_W_UP : I_W_DOWN)] + (size_t)e * D * D; dbase = ws + (which == 0 ? WS_WGT : (which == 1 ? WS_WUT : WS_WDT)) + (size_t)e * D * D; }
            const int k0 = (tl / nt) * 128, n0 = (tl % nt) * 256;
            sp = sbase + (size_t)(k0 + 4 * kq) * ldn + n0 + 4 * n4; dp = dbase + (size_t)n0 * D + k0; };
#define CONV_LOAD(R, tile) do { const float* _p; unsigned char* _d; int _ld; tile_ptrs(tile, _p, _d, _ld); _Pragma("unroll") for (int i = 0; i < 4; ++i) _Pragma("unroll") for (int q = 0; q < 4; ++q) \
            R[i][q] = __builtin_nontemporal_load((const f32x4*)(_p + (size_t)(32 * i + q) * _ld)); } while (0)
#define CONV_STORE(R, tile) do { _Pragma("unroll") for (int i = 0; i < 4; ++i) { const int kd = kq + 8 * i; \
            T[(4 * n4 + 0) * 33 + kd] = pk4_fp8(R[i][0].x * W_SCALE, R[i][1].x * W_SCALE, R[i][2].x * W_SCALE, R[i][3].x * W_SCALE); \
            T[(4 * n4 + 1) * 33 + kd] = pk4_fp8(R[i][0].y * W_SCALE, R[i][1].y * W_SCALE, R[i][2].y * W_SCALE, R[i][3].y * W_SCALE); \
            T[(4 * n4 + 2) * 33 + kd] = pk4_fp8(R[i][0].z * W_SCALE, R[i][1].z * W_SCALE, R[i][2].z * W_SCALE, R[i][3].z * W_SCALE); \
            T[(4 * n4 + 3) * 33 + kd] = pk4_fp8(R[i][0].w * W_SCALE, R[i][1].w * W_SCALE, R[i][2].w * W_SCALE, R[i][3].w * W_SCALE); } \
            __syncthreads(); \
            { const float* _p; unsigned char* _d; int _ld; tile_ptrs(tile, _p, _d, _ld); _Pragma("unroll") for (int i = 0; i < 4; ++i) { const int n = (tid >> 3) + 64 * i, c = tid & 7; \
                const u32x4 o = (u32x4){T[n * 33 + 4 * c], T[n * 33 + 4 * c + 1], T[n * 33 + 4 * c + 2], T[n * 33 + 4 * c + 3]}; \
                *(u32x4*)(_d + (size_t)n * D + 16 * c) = o; } } \
            __syncthreads(); } while (0)
        f32x4 RA[4][4], RB[4][4];
        int tile = blockIdx.x;
        if (tile < NTILES) CONV_LOAD(RA, tile);
        while (tile < NTILES) {
            int nxt = tile + gridDim.x;
            if (nxt < NTILES) CONV_LOAD(RB, nxt);
            CONV_STORE(RA, tile);
            tile = nxt; if (tile >= NTILES) break;
            nxt = tile + gridDim.x;
            if (nxt < NTILES) CONV_LOAD(RA, nxt);
            CONV_STORE(RB, tile);
            tile = nxt;
        }
#undef CONV_LOAD
#undef CONV_STORE
    }
    static_assert(!G1_FP8, "n1 is written as bf16");
    for (int r = gw; r < MROWS; r += NGW) {
        u32x4* orow = (u32x4*)((bf16*)(ws + WS_N1) + (size_t)r * D);
        if (r >= MVALID) {
#pragma unroll
            for (int j = 0; j < 4; ++j) orow[lane + 64 * j] = (u32x4){0u, 0u, 0u, 0u};
            continue; }
        const f32x4* xr = (const f32x4*)(r < MREAL ? a.in[I_X] + (size_t)r * D : a.in[I_META] + (size_t)(r - MREAL) * D);
        f32x4 v[4][2]; float ss = 0.f;
#pragma unroll
        for (int j = 0; j < 4; ++j)
#pragma unroll
            for (int q = 0; q < 2; ++q) { v[j][q] = xr[2 * (lane + 64 * j) + q]; ss += (v[j][q].x * v[j][q].x + v[j][q].y * v[j][q].y) + (v[j][q].z * v[j][q].z + v[j][q].w * v[j][q].w); }
        ss = wave_sum(ss);
        const float rstd = 1.0f / sqrtf(ss * (1.0f / D) + EPS);
#pragma unroll
        for (int j = 0; j < 4; ++j) { const f32x4 g0 = ((const f32x4*)a.in[I_NORM_MIX])[2 * (lane + 64 * j)], g1 = ((const f32x4*)a.in[I_NORM_MIX])[2 * (lane + 64 * j) + 1];
            orow[lane + 64 * j] = (u32x4){pk2(v[j][0].x * rstd * g0.x, v[j][0].y * rstd * g0.y), pk2(v[j][0].z * rstd * g0.z, v[j][0].w * rstd * g0.w),
                                          pk2(v[j][1].x * rstd * g1.x, v[j][1].y * rstd * g1.y), pk2(v[j][1].z * rstd * g1.z, v[j][1].w * rstd * g1.w)}; }
    }
    float* cosT = (float*)(ws + WS_COS); float* sinT = (float*)(ws + WS_SIN);
    for (int i = gt; i < TT * 32; i += NGT) {
        const int pos = i >> 5, j = i & 31;
        const float ang = (float)pos * c_inv_freq[j];
        const double t = (double)ang * 0.15915494309189535; const float fr = (float)(t - floor(t));
        cosT[i] = __builtin_amdgcn_cosf(fr); sinT[i] = __builtin_amdgcn_sinf(fr);
    }
    { bf16* WaT = (bf16*)(ws + WS_WAT); bf16* WiT = (bf16*)(ws + WS_WIT);
      for (int i = gt; i < 16 * 64 * 64; i += NGT) { const int n = i >> 12, d = (i >> 6) & 63, cc = i & 63;
          WaT[i] = (bf16)f2bf(a.in[I_W_A][(n * 64 + cc) * 64 + d]); WiT[i] = (bf16)f2bf(a.in[I_W_I][(n * 64 + cc) * 64 + d]); } }
    { bf16* WRT = (bf16*)(ws + WS_WRT);
      for (int i = gt; i < NEXP * D; i += NGT) { const int e = i >> 11, k = i & 2047; WRT[i] = (bf16)f2bf(a.in[I_NORM_FFN][k] * a.in[I_W_ROUTER][k * NEXP + e]); } }
    int* rowpair = (int*)(ws + WS_ROWPAIR);
    for (int i = gt; i < PROWS; i += NGT) rowpair[i] = -1;
}

namespace pg8 {
constexpr int BM = 256, BK = 64, HALF = 128, HTB = HALF * BK * 2, STAGE_BYTES = 8 * HTB, NXCD = 8, WGM = 8, KD = 2048, NKT = KD / BK;
__host__ __device__ __forceinline__ int lds_byte(int r, int c) { const int st = (r >> 4) * 2 + (c >> 5), rr = r & 15, cc = c & 31, ob = rr * 64 + cc * 2; return st * 1024 + (ob ^ (((ob >> 9) & 1) << 5)); }
__host__ __device__ __forceinline__ void stage_rc(int b, int& R, int& C) { const int st = b / 1024, sb = b % 1024, swz = sb ^ (((sb >> 9) & 1) << 5); R = (st >> 1) * 16 + swz / 64; C = (st & 1) * 32 + (swz % 64) / 2; }
__host__ __device__ __forceinline__ int perm32(int rho) { const int n = rho >> 4, i = rho & 15; return 8 * (i >> 2) + 4 * n + (i & 3); }
struct Unit { unsigned a, b0, b1; int pm, pn, e; };
__device__ __forceinline__ bool static_tile(int i, int G, int c, int nM, int nN, int& pm, int& pn) {
    const int nwg = nM * nN; const long L = (long)i * G + c; if (L >= nwg) return false;
    int wgid = (int)L; { const int q = nwg >> 3, r = nwg & 7, xcd = wgid & 7, off = wgid >> 3; wgid = (xcd < r ? xcd * (q + 1) : r * (q + 1) + (xcd - r) * q) + off; }
    const int nig = WGM * nN; int gid, rem;
    if ((nN & (nN - 1)) == 0) { const int sh = 3 + (31 - __builtin_clz(nN)); gid = wgid >> sh; rem = wgid & (nig - 1); } else { gid = wgid / nig; rem = wgid - gid * nig; }
    const int fm = gid * WGM, gsz = (nM - fm) < WGM ? (nM - fm) : WGM;
    if (gsz == WGM) { pm = fm + (rem & 7); pn = rem >> 3; } else { pm = fm + rem % gsz; pn = rem / gsz; }
    return true;
}
__device__ __forceinline__ unsigned cvt_pk_bf16(float lo, float hi) { unsigned r; asm volatile("v_cvt_pk_bf16_f32 %0, %1, %2" : "=v"(r) : "v"(lo), "v"(hi)); return r; }

typedef int i32x8 __attribute__((ext_vector_type(8)));
typedef int i32x4 __attribute__((ext_vector_type(4)));
__device__ __forceinline__ i32x8 cat8(bf16x8 lo, bf16x8 hi) { const i32x4 a = __builtin_bit_cast(i32x4, lo), b = __builtin_bit_cast(i32x4, hi); return __builtin_shufflevector(a, b, 0, 1, 2, 3, 4, 5, 6, 7); }
struct BGNone { static constexpr bool ON = false; };
struct BGConv { static constexpr bool ON = true; const char* src; unsigned char* dst; int next, end; unsigned char* dummy; };
__device__ __forceinline__ void bg_pair_ptrs(const BGConv& bg, int pair, const char*& sp, unsigned char*& dp) {
    const int e = pair >> 10, kbp = (pair >> 6) & 15, nb = pair & 63;
    sp = bg.src + ((size_t)(e * 2048 + 128 * kbp) * 2048 + 32 * nb) * 4; dp = bg.dst + (size_t)e * 2048 * 2048 + (size_t)(32 * nb) * 2048 + 128 * kbp; }
template <bool FP8, class Epi, class Sched, class BG, bool GATHER = false>
__device__ __forceinline__ void gemm_phase(LAS unsigned char* lds, const Sched& S, const Epi& E, BG& bg) {
    constexpr int ROWB = FP8 ? 2048 : 4096, NKTL = ROWB / 128;
    const int tid = threadIdx.x, wid = __builtin_amdgcn_readfirstlane(tid >> 6), lane = tid & 63, wr = wid >> 2, wc = wid & 3, fr = lane & 15, fq = lane >> 4;
    unsigned voffA[2], voffB[2];
#pragma unroll
    for (int i = 0; i < 2; ++i) { int R, C; stage_rc(tid * 16 + i * 8192, R, C); const int Rb = Epi::PERM ? ((R & ~31) + perm32(R & 31)) : R;
        voffA[i] = (unsigned)(R * ROWB + C * 2); voffB[i] = (unsigned)(Rb * ROWB + C * 2); }
    constexpr unsigned KS = BK * 2, HS = HALF * ROWB;
    const unsigned ldsw = (unsigned)wid * 1024u;
    const __amdgpu_buffer_rsrc_t rsA = __builtin_amdgcn_make_buffer_rsrc((void*)S.A, 0, 0x7ffffff0, 0x00020000), rsB0 = __builtin_amdgcn_make_buffer_rsrc((void*)S.B0, 0, 0x7ffffff0, 0x00020000), rsB1 = __builtin_amdgcn_make_buffer_rsrc((void*)S.B1, 0, 0x7ffffff0, 0x00020000);
    const int aoff = lds_byte(wr * 64 + fr, fq * 8), boff = lds_byte(wc * 32 + fr, fq * 8);
#define PG8_SA(b, h) (((b) * 2 + (h)) * HTB)
#define PG8_SB(b, h) ((4 + (b) * 2 + (h)) * HTB)
#define PG8_STAGE(bufoff, rs, soff, voff) do { _Pragma("unroll") for (int _i = 0; _i < 2; ++_i) \
        __builtin_amdgcn_raw_ptr_buffer_load_lds(rs, (LAS void*)(lds + (bufoff) + ldsw + _i * 8192), 16, (int)(voff)[_i], (int)(soff), 0, 0); } while (0)
    unsigned gA[2][2] = {{0u, 0u}, {0u, 0u}}, gN[2][2] = {{0u, 0u}, {0u, 0u}};
#define PG8_GOFF(dst, slot) do { int tz_ = threadIdx.x; asm volatile("" : "+v"(tz_)); _Pragma("unroll") for (int _i = 0; _i < 2; ++_i) { int R_, C_; stage_rc(tz_ * 16 + _i * 8192, R_, C_); \
        _Pragma("unroll") for (int _h = 0; _h < 2; ++_h) { const int id_ = *(const LAS int*)(lds + LDS_RID + (slot) * 1024 + (_h * 128 + R_) * 4); dst[_h][_i] = (unsigned)((id_ < 0 ? 0 : (id_ >> 2)) * ROWB + C_ * 2); } } } while (0)
#define PG8_STAGEA(bufoff, h, soff_dense, koff, nx) do { if constexpr (GATHER) { unsigned v_[2]; v_[0] = (nx) ? gN[h][0] : gA[h][0]; v_[1] = (nx) ? gN[h][1] : gA[h][1]; PG8_STAGE(bufoff, rsA, koff, v_); } \
        else PG8_STAGE(bufoff, rsA, (soff_dense) + (h) * HS, voffA); } while (0)
#define PG8_LDA(dst, b, h) do { _Pragma("unroll") for (int m = 0; m < 4; ++m) { \
        if constexpr (FP8) dst##8[m] = __builtin_shufflevector(*(const LAS i32x4*)(lds + PG8_SA(b, h) + aoff + m * 2048), *(const LAS i32x4*)(lds + PG8_SA(b, h) + aoff + m * 2048 + 1024), 0, 1, 2, 3, 4, 5, 6, 7); \
        else { _Pragma("unroll") for (int k = 0; k < 2; ++k) dst[m][k] = *(const LAS bf16x8*)(lds + PG8_SA(b, h) + aoff + m * 2048 + k * 1024); } } } while (0)
#define PG8_LDB(dst, b, h) do { _Pragma("unroll") for (int n = 0; n < 2; ++n) { \
        if constexpr (FP8) dst##8[n] = __builtin_shufflevector(*(const LAS i32x4*)(lds + PG8_SB(b, h) + boff + n * 2048), *(const LAS i32x4*)(lds + PG8_SB(b, h) + boff + n * 2048 + 1024), 0, 1, 2, 3, 4, 5, 6, 7); \
        else { _Pragma("unroll") for (int k = 0; k < 2; ++k) dst[n][k] = *(const LAS bf16x8*)(lds + PG8_SB(b, h) + boff + n * 2048 + k * 1024); } } } while (0)
#define PG8_MMA(ai, bj, At, Bt) do { _Pragma("unroll") for (int m = 0; m < 4; ++m) _Pragma("unroll") for (int n = 0; n < 2; ++n) { \
        if constexpr (FP8) asm volatile("v_mfma_f32_16x16x128_f8f6f4 %0, %1, %2, %0" : "+v"(acc[ai][bj][m][n]) : "v"(Bt##8[n]), "v"(At##8[m])); \
        else { _Pragma("unroll") for (int k = 0; k < 2; ++k) asm volatile("v_mfma_f32_16x16x32_bf16 %0, %1, %2, %0" : "+v"(acc[ai][bj][m][n]) : "v"(Bt[n][k]), "v"(At[m][k])); } } \
        } while (0)
#define PG8_WAIT_V(n) asm volatile("s_waitcnt vmcnt(" #n ")" ::: "memory")
#define PG8_WAIT_L(n) asm volatile("s_waitcnt lgkmcnt(" #n ")" ::: "memory")
#define PG8_BAR __builtin_amdgcn_s_barrier()
#define PG8_SCHED __builtin_amdgcn_sched_barrier(0)
    Unit cur, nxt; int ui = 0; bool bg_pending = false;
    if (!S.next(0, cur)) return;
    f32x4 acc[2][2][4][2];
#pragma unroll
    for (int a = 0; a < 2; ++a)
#pragma unroll
        for (int b = 0; b < 2; ++b)
#pragma unroll
            for (int m = 0; m < 4; ++m)
#pragma unroll
                for (int n = 0; n < 2; ++n) acc[a][b][m][n] = (f32x4){0.f, 0.f, 0.f, 0.f};
    bf16x8 At[4][2], B0[2][2], B1[2][2];
    i32x8 At8[4], B08[2], B18[2];
    if constexpr (GATHER) {
        if (tid < 256) *(LAS int*)(lds + LDS_RID + tid * 4) = S.rows[cur.pm * BM + tid];
        __syncthreads();
        PG8_GOFF(gA, 0);
    }
    PG8_STAGE(PG8_SB(0, 0), rsB0, cur.b0, voffB); PG8_STAGE(PG8_SB(0, 1), rsB1, cur.b1, voffB); PG8_STAGEA(PG8_SA(0, 0), 0, cur.a, 0u, false); PG8_STAGEA(PG8_SA(0, 1), 1, cur.a, 0u, false);
    if (wr == 1) PG8_BAR;
    PG8_WAIT_V(2); PG8_BAR;
    PG8_STAGE(PG8_SB(1, 0), rsB0, cur.b0 + KS, voffB); PG8_STAGEA(PG8_SA(1, 0), 0, cur.a + KS, KS, false); PG8_STAGE(PG8_SB(1, 1), rsB1, cur.b1 + KS, voffB);
    PG8_WAIT_V(6); PG8_BAR;
    for (;;) {
        const bool has_next = S.next(ui + 1, nxt);
        const unsigned nA = has_next ? nxt.a : cur.a, nB0 = has_next ? nxt.b0 : cur.b0, nB1 = has_next ? nxt.b1 : cur.b1;
        for (int t = 0; t < NKTL; t += 2) {
            const bool last = (t == NKTL - 2);
            const unsigned a1 = cur.a + (unsigned)(t + 1) * KS;
            const unsigned a2 = last ? nA : cur.a + (unsigned)(t + 2) * KS;
            const unsigned b20 = last ? nB0 : cur.b0 + (unsigned)(t + 2) * KS, b21 = last ? nB1 : cur.b1 + (unsigned)(t + 2) * KS;
            const unsigned a3 = a2 + KS, b30 = b20 + KS, b31 = b21 + KS;
            const unsigned k1 = (unsigned)(t + 1) * KS, k2 = last ? 0u : (unsigned)(t + 2) * KS;
            if constexpr (GATHER) { if (last) { if (has_next) PG8_GOFF(gN, (ui + 1) & 1); else { gN[0][0] = gA[0][0]; gN[0][1] = gA[0][1]; gN[1][0] = gA[1][0]; gN[1][1] = gA[1][1]; } } }
            PG8_LDB(B0, 0, 0); PG8_LDB(B1, 0, 1); PG8_SCHED; PG8_LDA(At, 0, 0); PG8_STAGEA(PG8_SA(1, 1), 1, a1, k1, false);
            if constexpr (GATHER) { if (t == 2 && has_next && wid == 3) __builtin_amdgcn_global_load_lds((const unsigned*)(S.rows + nxt.pm * BM + lane * 4), (LAS unsigned*)(lds + LDS_RID + ((ui + 1) & 1) * 1024), 16, 0, 0); }
            if (t == 2) E.prefetch(cur, lds, wid, lane);
            PG8_WAIT_V(8); PG8_WAIT_L(0); PG8_BAR; PG8_MMA(0, 0, At, B0);
            if constexpr (BG::ON) {
                PG8_SCHED;
                int tz = threadIdx.x; asm volatile("" : "+v"(tz));
#pragma unroll
                for (int j = 0; j < (BG_EXP == 1 ? 0 : 2); ++j) { const LAS float* p = (const LAS float*)(lds + LDS_BG + j * 8192 + (tz >> 5) * 512 + (tz & 31) * 4);
                    ((LAS unsigned*)(lds + LDS_T2))[(tz & 31) * 33 + 16 * j + (tz >> 5)] = pk4_fp8(p[0] * W_SCALE, p[32] * W_SCALE, p[64] * W_SCALE, p[96] * W_SCALE); }
                const char* bgs; { unsigned char* dp_; pg8::bg_pair_ptrs(bg, bg.next < bg.end ? bg.next : bg.end - 1, bgs, dp_); }
                PG8_SCHED;
                if (BG_EXP != 2) {
                const unsigned bgv = (unsigned)((8 * wid + ((tz & 63) >> 3)) * 8192 + (tz & 7) * 16);
                __builtin_amdgcn_global_load_lds((const unsigned*)(bgs + bgv), (LAS unsigned*)(lds + LDS_BG + ldsw), 16, 0, 0);
                __builtin_amdgcn_global_load_lds((const unsigned*)(bgs + 524288 + bgv), (LAS unsigned*)(lds + LDS_BG + 8192 + ldsw), 16, 0, 0); }
                PG8_SCHED; }
            PG8_MMA(0, 1, At, B1);
            if constexpr (BG::ON) { PG8_WAIT_L(0); }
            PG8_BAR; PG8_SCHED;
            PG8_LDA(At, 0, 1); PG8_STAGE(PG8_SB(0, 0), rsB0, b20, voffB); PG8_STAGE(PG8_SB(0, 1), rsB1, b21, voffB); PG8_STAGEA(PG8_SA(0, 0), 0, a2, k2, last);
            if constexpr (BG::ON) { if (BG_EXP == 2) PG8_WAIT_V(8); else PG8_WAIT_V(10); } else { PG8_WAIT_V(8); }
            PG8_WAIT_L(0); PG8_BAR; PG8_MMA(1, 0, At, B0);
            if constexpr (BG::ON) {
                PG8_SCHED;
                unsigned char* bgd; { const char* sp_; pg8::bg_pair_ptrs(bg, bg.next - 1 < bg.end ? bg.next - 1 : bg.end - 1, sp_, bgd); }
                int tz = threadIdx.x; asm volatile("" : "+v"(tz));
                const LAS unsigned* q = (const LAS unsigned*)(lds + LDS_T2) + (tz >> 4) * 33 + 2 * (tz & 15);
                const u32x2 w = (u32x2){q[0], q[1]};
                if (BG_EXP != 1) *(u32x2*)((bg_pending && !BG_EXP) ? bgd + (size_t)(tz >> 4) * 2048 + 8 * (tz & 15) : bg.dummy + 8 * tz) = w;
                ++bg.next; bg_pending = true;
                PG8_SCHED; }
            PG8_MMA(1, 1, At, B1); PG8_BAR; PG8_SCHED;
            PG8_LDB(B0, 1, 0); PG8_LDB(B1, 1, 1); PG8_SCHED; PG8_LDA(At, 1, 0); PG8_STAGEA(PG8_SA(0, 1), 1, a2, k2, last);
            if constexpr (BG::ON) { if (BG_EXP == 1) PG8_WAIT_V(10); else if (BG_EXP == 2) PG8_WAIT_V(9); else PG8_WAIT_V(11); } else { PG8_WAIT_V(8); }
            PG8_WAIT_L(0); PG8_BAR; PG8_MMA(0, 0, At, B0); PG8_MMA(0, 1, At, B1); PG8_BAR; PG8_SCHED;
            PG8_LDA(At, 1, 1); PG8_STAGE(PG8_SB(1, 0), rsB0, b30, voffB); PG8_STAGE(PG8_SB(1, 1), rsB1, b31, voffB); PG8_STAGEA(PG8_SA(1, 0), 0, a3, k2 + KS, last);
            if constexpr (BG::ON) { if (BG_EXP == 1) PG8_WAIT_V(8); else PG8_WAIT_V(9); } else { PG8_WAIT_V(8); }
            PG8_WAIT_L(0); PG8_BAR; PG8_MMA(1, 0, At, B0); PG8_MMA(1, 1, At, B1); PG8_BAR; PG8_SCHED;
        }
        if (wr == 0) PG8_BAR;
        asm volatile("s_nop 15\n\ts_nop 15" ::: "memory");
        E(acc, cur, wr, wc, fr, fq, lds);
        if (!has_next) break;
#pragma unroll
        for (int a = 0; a < 2; ++a)
#pragma unroll
            for (int b = 0; b < 2; ++b)
#pragma unroll
                for (int m = 0; m < 4; ++m)
#pragma unroll
                    for (int n = 0; n < 2; ++n) acc[a][b][m][n] = (f32x4){0.f, 0.f, 0.f, 0.f};
        cur = nxt; ++ui;
        if constexpr (GATHER) { gA[0][0] = gN[0][0]; gA[0][1] = gN[0][1]; gA[1][0] = gN[1][0]; gA[1][1] = gN[1][1]; }
        if (wr == 1) PG8_BAR;
    }
    PG8_WAIT_V(0);
    PG8_BAR;
    if constexpr (BG::ON) { if (bg_pending && !BG_EXP) {
        unsigned char* bgd; { const char* sp_; pg8::bg_pair_ptrs(bg, bg.next - 1 < bg.end ? bg.next - 1 : bg.end - 1, sp_, bgd); }
#pragma unroll
        for (int j = 0; j < 2; ++j) { const LAS float* p = (const LAS float*)(lds + LDS_BG + j * 8192 + (tid >> 5) * 512 + (tid & 31) * 4);
            ((LAS unsigned*)(lds + LDS_T2))[(tid & 31) * 33 + 16 * j + (tid >> 5)] = pk4_fp8(p[0] * W_SCALE, p[32] * W_SCALE, p[64] * W_SCALE, p[96] * W_SCALE); }
        __syncthreads();
        const LAS unsigned* q = (const LAS unsigned*)(lds + LDS_T2) + (tid >> 4) * 33 + 2 * (tid & 15);
        *(u32x2*)(bgd + (size_t)(tid >> 4) * 2048 + 8 * (tid & 15)) = (u32x2){q[0], q[1]}; } }
#undef PG8_SA
#undef PG8_SB
#undef PG8_STAGE
#undef PG8_STAGEA
#undef PG8_GOFF
#undef PG8_LDA
#undef PG8_LDB
#undef PG8_MMA
#undef PG8_WAIT_V
#undef PG8_WAIT_L
#undef PG8_BAR
#undef PG8_SCHED
}

struct SchedDense {
    const char* A; const char* B0; const char* B1; const int* rows; int nM, nN, G, c, rowb;
    __device__ __forceinline__ bool next(int i, Unit& u) const {
        int pm, pn; if (!static_tile(i, G, c, nM, nN, pm, pn)) return false;
        u.pm = pm; u.pn = pn; u.e = 0; u.a = (unsigned)pm * BM * rowb; u.b0 = (unsigned)pn * BM * rowb; u.b1 = u.b0 + (unsigned)HALF * rowb; return true;
    }
};
struct SchedMoE {
    const char* A; const char* B0; const char* B1; const int* rows; const LAS int* tstart; int nM, nN, G, c; bool split;
    __device__ __forceinline__ bool next(int i, Unit& u) const {
        int pm, pn; if (!static_tile(i, G, c, nM, nN, pm, pn)) return false;
        const int e = ((const LAS unsigned char*)(tstart + 64))[pm];
        u.pm = pm; u.pn = pn; u.e = e; u.a = (unsigned)pm * (BM * 2048);
        const unsigned eoff = (unsigned)e * (2048u * 2048u);
        if (split) { u.b0 = eoff + (unsigned)pn * (HALF * 2048); u.b1 = u.b0; }
        else { u.b0 = eoff + (unsigned)pn * (BM * 2048); u.b1 = u.b0 + (unsigned)HALF * 2048; }
        return true;
    }
};

__device__ __forceinline__ u32x4 widen16(u32x2 x, u32x2 y) {
    const auto r0 = __builtin_amdgcn_permlane16_swap(x.x, y.x, false, false), r1 = __builtin_amdgcn_permlane16_swap(x.y, y.y, false, false);
    return (u32x4){r0[0], r1[0], r0[1], r1[1]};
}
struct EpiZ {
    static constexpr bool PERM = true;
    bf16* Z; const float* bias; float sc;
    __device__ __forceinline__ void prefetch(const Unit&, LAS unsigned char*, int, int) const {}
    __device__ __forceinline__ void operator()(const f32x4 (&acc)[2][2][4][2], const Unit& u, int wr, int wc, int fr, int fq, const LAS unsigned char*) const {
        const int row0 = u.pm * BM + wr * 64 + fr, col0 = u.pn * BM + wc * 32 + 8 * fq;
        f32x4 bv[2][2];
#pragma unroll
        for (int bj = 0; bj < 2; ++bj)
#pragma unroll
            for (int n = 0; n < 2; ++n) bv[bj][n] = *(const f32x4*)(bias + col0 + bj * HALF + 4 * n);
#pragma unroll
        for (int ai = 0; ai < 2; ++ai)
#pragma unroll
            for (int m = 0; m < 4; ++m) { bf16* rowp = Z + (size_t)(row0 + ai * HALF + m * 16) * DIN + col0;
#pragma unroll
                for (int bj = 0; bj < 2; ++bj) { const f32x4 v0 = acc[ai][bj][m][0] * sc + bv[bj][0], v1 = acc[ai][bj][m][1] * sc + bv[bj][1];
                    u32x4 w; w.x = cvt_pk_bf16(v0[0], v0[1]); w.y = cvt_pk_bf16(v0[2], v0[3]); w.z = cvt_pk_bf16(v1[0], v1[1]); w.w = cvt_pk_bf16(v1[2], v1[3]);
                    *(u32x4*)(rowp + bj * HALF) = w; } }
    }
};
struct EpiH1 {
    static constexpr bool PERM = true;
    bf16* H1; const float* x; const float* bias; float sc;
    __device__ __forceinline__ void prefetch(const Unit&, LAS unsigned char*, int, int) const {}
    __device__ __forceinline__ void operator()(const f32x4 (&acc)[2][2][4][2], const Unit& u, int wr, int wc, int fr, int fq, const LAS unsigned char*) const {
        const int row0 = u.pm * BM + wr * 64 + fr, col0 = u.pn * BM + wc * 32 + 8 * fq;
        f32x4 bv[2][2];
#pragma unroll
        for (int bj = 0; bj < 2; ++bj)
#pragma unroll
            for (int n = 0; n < 2; ++n) bv[bj][n] = *(const f32x4*)(bias + col0 + bj * HALF + 4 * n);
#pragma unroll
        for (int ai = 0; ai < 2; ++ai) {
            f32x4 xv[4][2][2];
#pragma unroll
            for (int m = 0; m < 4; ++m) { const size_t ro = (size_t)(row0 + ai * HALF + m * 16) * D + col0;
#pragma unroll
                for (int bj = 0; bj < 2; ++bj) { xv[m][bj][0] = __builtin_nontemporal_load((const f32x4*)(x + ro + bj * HALF)); xv[m][bj][1] = __builtin_nontemporal_load((const f32x4*)(x + ro + bj * HALF + 4)); } }
#pragma unroll
            for (int m = 0; m < 4; ++m) { const size_t ro = (size_t)(row0 + ai * HALF + m * 16) * D + col0;
#pragma unroll
                for (int bj = 0; bj < 2; ++bj) { const f32x4 v0 = xv[m][bj][0] + acc[ai][bj][m][0] * sc + bv[bj][0], v1 = xv[m][bj][1] + acc[ai][bj][m][1] * sc + bv[bj][1];
                    u32x4 w; w.x = cvt_pk_bf16(v0[0], v0[1]); w.y = cvt_pk_bf16(v0[2], v0[3]); w.z = cvt_pk_bf16(v1[0], v1[1]); w.w = cvt_pk_bf16(v1[2], v1[3]);
                    *(u32x4*)(H1 + ro + bj * HALF) = w; } }
        }
    }
};
struct EpiAct {
    static constexpr bool PERM = true;
    unsigned char* ACT; const float* bg; const float* bu;
    __device__ __forceinline__ void prefetch(const Unit& u, LAS unsigned char* lds, int wid, int lane) const {
        if (wid == 0) { const float* p = (lane < 32 ? bg : bu) + (size_t)u.e * DFF + u.pn * HALF + (lane & 31) * 4;
            __builtin_amdgcn_global_load_lds((const unsigned*)p, (LAS unsigned*)(lds + LDS_META), 16, 0, 0); }
    }
    __device__ __forceinline__ void operator()(const f32x4 (&acc)[2][2][4][2], const Unit& u, int wr, int wc, int fr, int fq, const LAS unsigned char* lds) const {
        const int row0 = u.pm * BM + wr * 64 + fr, cl = wc * 32 + 8 * fq, col0 = u.pn * HALF + cl;
        f32x4 gv[2], uv[2];
#pragma unroll
        for (int n = 0; n < 2; ++n) { gv[n] = *(const LAS f32x4*)(lds + LDS_META + (cl + 4 * n) * 4); uv[n] = *(const LAS f32x4*)(lds + LDS_META + 512 + (cl + 4 * n) * 4); }
#pragma unroll
        for (int ai = 0; ai < 2; ++ai)
#pragma unroll
            for (int mp = 0; mp < 2; ++mp) { u32x2 pc[2];
#pragma unroll
                for (int mi = 0; mi < 2; ++mi) { const int m = 2 * mp + mi; float r[8];
#pragma unroll
                    for (int n = 0; n < 2; ++n)
#pragma unroll
                        for (int j = 0; j < 4; ++j) { float g = acc[ai][0][m][n][j] * (1.0f / (W_SCALE * XS_SCALE)) + gv[n][j], up = acc[ai][1][m][n][j] * (1.0f / (W_SCALE * XS_SCALE)) + uv[n][j];
                            g = fminf(g, 7.0f); up = fminf(fmaxf(up, -7.0f), 7.0f);
                            r[n * 4 + j] = ACT_SCALE * g * (1.0f / (1.0f + __expf(-1.702f * g))) * (up + 1.0f); }
                    pc[mi] = (u32x2){pk4_fp8(r[0], r[1], r[2], r[3]), pk4_fp8(r[4], r[5], r[6], r[7])}; }
                const u32x4 w = widen16(pc[0], pc[1]);
                const int m = 2 * mp + (fq & 1);
                *(u32x4*)(ACT + (size_t)(row0 + ai * HALF + m * 16) * DFF + col0 - 8 * (fq & 1)) = w; }
    }
};
struct EpiDown {
    static constexpr bool PERM = true;
    unsigned char* YB; const float* bd;
    __device__ __forceinline__ void prefetch(const Unit& u, LAS unsigned char* lds, int wid, int lane) const {
        if (wid == 0) __builtin_amdgcn_global_load_lds((const unsigned*)(bd + (size_t)u.e * D + u.pn * BM + lane * 4), (LAS unsigned*)(lds + LDS_META), 16, 0, 0);
    }
    __device__ __forceinline__ void operator()(const f32x4 (&acc)[2][2][4][2], const Unit& u, int wr, int wc, int fr, int fq, const LAS unsigned char* lds) const {
        const int row0 = u.pm * BM + wr * 64 + fr, cl = wc * 32 + 8 * fq, col0 = u.pn * BM + cl;
        f32x4 bv[2][2];
#pragma unroll
        for (int bj = 0; bj < 2; ++bj)
#pragma unroll
            for (int n = 0; n < 2; ++n) bv[bj][n] = *(const LAS f32x4*)(lds + LDS_META + (cl + bj * HALF + 4 * n) * 4) * YB_SCALE;
#pragma unroll
        for (int ai = 0; ai < 2; ++ai)
#pragma unroll
            for (int m = 0; m < 4; ++m) { u32x2 pc[2];
#pragma unroll
                for (int bj = 0; bj < 2; ++bj) { const f32x4 v0 = acc[ai][bj][m][0] * (YB_SCALE / (W_SCALE * ACT_SCALE)) + bv[bj][0], v1 = acc[ai][bj][m][1] * (YB_SCALE / (W_SCALE * ACT_SCALE)) + bv[bj][1];
                    pc[bj] = (u32x2){pk4_fp8(v0[0], v0[1], v0[2], v0[3]), pk4_fp8(v1[0], v1[1], v1[2], v1[3])}; }
                const u32x4 w = widen16(pc[0], pc[1]);
                *(u32x4*)(YB + (size_t)(row0 + ai * HALF + m * 16) * D + col0 + (fq & 1) * (HALF - 8)) = w; }
    }
};
}


typedef float f32x16 __attribute__((ext_vector_type(16)));
constexpr int AT_KS = 144, AT_VS = 584, AT_KOFF = 0, AT_VOFF = 288 * AT_KS;
__device__ __forceinline__ float bflo(unsigned w) { return __uint_as_float(w << 16); }
__device__ __forceinline__ float bfhi(unsigned w) { return __uint_as_float(w & 0xffff0000u); }

__device__ __forceinline__ void attn_tile(LAS unsigned char* lds, int slot_base, int kind, int j, int lane, int hq,
                                          const bf16x8 (&qf)[2][4], f32x16 (&oacc)[2][2], float (&mrow)[2], float (&lrow)[2]) {
    const int r31 = lane & 31, h = lane >> 5;
    bf16x8 kf[4], vf[2][2];
#pragma unroll
    for (int ks = 0; ks < 4; ++ks) kf[ks] = *(const LAS bf16x8*)(lds + AT_KOFF + (slot_base + r31) * AT_KS + (16 * ks + 8 * h) * 2);
#pragma unroll
    for (int dt = 0; dt < 2; ++dt)
#pragma unroll
        for (int sp = 0; sp < 2; ++sp) { const LAS unsigned char* p = lds + AT_VOFF + (32 * dt + r31) * AT_VS + (slot_base + 16 * sp + 4 * h) * 2;
            const u32x2 lo = *(const LAS u32x2*)p, hi = *(const LAS u32x2*)(p + 16);
            const u32x4 w = (u32x4){lo.x, lo.y, hi.x, hi.y}; vf[dt][sp] = __builtin_bit_cast(bf16x8, w); }
#pragma unroll
    for (int qt = 0; qt < 2; ++qt) {
        f32x16 s;
#pragma unroll
        for (int r = 0; r < 16; ++r) s[r] = 0.f;
#pragma unroll
        for (int ks = 0; ks < 4; ++ks) s = __builtin_amdgcn_mfma_f32_32x32x16_bf16(kf[ks], qf[qt][ks], s, 0, 0, 0);
        const int i = 64 * hq + 32 * qt + r31;
        float mx = -1.0e30f;
#pragma unroll
        for (int r = 0; r < 16; ++r) { const int key = (r & 3) + 8 * (r >> 2) + 4 * h;
            const bool ok = kind == 0 ? (key < 16) : (kind == 1 ? (32 * j + key >= i + 1) : (32 * j + key <= i));
            s[r] = ok ? s[r] : -1.0e30f; mx = fmaxf(mx, s[r]); }
        mx = fmaxf(mx, __shfl_xor(mx, 32));
        const float mn = fmaxf(mrow[qt], mx), al = __expf(mrow[qt] - mn); mrow[qt] = mn;
        float ps = 0.f;
#pragma unroll
        for (int r = 0; r < 16; ++r) { s[r] = __expf(s[r] - mn); ps += s[r]; }
        lrow[qt] = lrow[qt] * al + ps;
#pragma unroll
        for (int dt = 0; dt < 2; ++dt)
#pragma unroll
            for (int r = 0; r < 16; ++r) oacc[qt][dt][r] *= al;
        bf16x8 pf[2];
#pragma unroll
        for (int sp = 0; sp < 2; ++sp) { const u32x4 w = (u32x4){pk2(s[8 * sp + 0], s[8 * sp + 1]), pk2(s[8 * sp + 2], s[8 * sp + 3]), pk2(s[8 * sp + 4], s[8 * sp + 5]), pk2(s[8 * sp + 6], s[8 * sp + 7])};
            pf[sp] = __builtin_bit_cast(bf16x8, w); }
#pragma unroll
        for (int dt = 0; dt < 2; ++dt)
#pragma unroll
            for (int sp = 0; sp < 2; ++sp) oacc[qt][dt] = __builtin_amdgcn_mfma_f32_32x32x16_bf16(vf[dt][sp], pf[sp], oacc[qt][dt], 0, 0, 0);
    }
}

__device__ __forceinline__ void attn_item(const Args& a, LAS unsigned char* lds, int item, int tid, int lane, int wave) {
    const int kvh = item & 3, qblk = (item >> 2) & 15, b = item >> 6;
    const bf16* Z = (const bf16*)(a.ws + WS_Z); bf16* O = (bf16*)(a.ws + (G2_FP8 ? WS_ATT : WS_O)); constexpr int OLD = G2_FP8 ? 1024 : D;
    const float* cosT = (const float*)(a.ws + WS_COS); const float* sinT = (const float*)(a.ws + WS_SIN);
    __syncthreads();
    for (int task = tid; task < 288 * 4; task += 512) {
        const int slot = task >> 2, c = task & 3;
        int krow, kpos; bool valid;
        if (slot < 32) { valid = slot < NMETA; krow = METAROW0 + slot; kpos = slot; }
        else { const int sp = 128 * (qblk - 1) + (slot - 32); valid = sp >= 0; krow = b * SEQ + sp; kpos = NMETA + sp; }
        u32x4 lo = (u32x4){0u, 0u, 0u, 0u}, hi = lo;
        if (valid) {
            const bf16* kp = Z + (size_t)krow * DIN + ZK + kvh * 64 + c * 8;
            const u32x4 x1 = *(const u32x4*)kp, x2 = *(const u32x4*)(kp + 32);
            const f32x4 c0 = *(const f32x4*)(cosT + kpos * 32 + c * 8), c1 = *(const f32x4*)(cosT + kpos * 32 + c * 8 + 4);
            const f32x4 s0 = *(const f32x4*)(sinT + kpos * 32 + c * 8), s1 = *(const f32x4*)(sinT + kpos * 32 + c * 8 + 4);
#pragma unroll
            for (int q = 0; q < 4; ++q) { const float ca = q < 2 ? c0[2 * q] : c1[2 * q - 4], cb = q < 2 ? c0[2 * q + 1] : c1[2 * q - 3], sa = q < 2 ? s0[2 * q] : s1[2 * q - 4], sb = q < 2 ? s0[2 * q + 1] : s1[2 * q - 3];
                const float a0 = bflo(x1[q]), a1 = bfhi(x1[q]), b0 = bflo(x2[q]), b1 = bfhi(x2[q]);
                lo[q] = pk2(a0 * ca - b0 * sa, a1 * cb - b1 * sb); hi[q] = pk2(b0 * ca + a0 * sa, b1 * cb + a1 * sb); }
        }
        *(LAS u32x4*)(lds + AT_KOFF + slot * AT_KS + c * 16) = lo; *(LAS u32x4*)(lds + AT_KOFF + slot * AT_KS + 64 + c * 16) = hi;
    }
    for (int task = tid; task < 144 * 8; task += 512) {
        const int slot0 = (task >> 3) * 2, c = task & 7;
        int vrow; bool valid;
        if (slot0 < 32) { valid = slot0 < NMETA; vrow = METAROW0 + slot0; }
        else { const int sp = 128 * (qblk - 1) + (slot0 - 32); valid = sp >= 0; vrow = b * SEQ + sp; }
        u32x4 v0 = (u32x4){0u, 0u, 0u, 0u}, v1 = v0;
        if (valid) { const bf16* vp = Z + (size_t)vrow * DIN + ZV + kvh * 64 + c * 8; v0 = *(const u32x4*)vp; v1 = *(const u32x4*)(vp + DIN); }
#pragma unroll
        for (int q = 0; q < 4; ++q) {
            *(LAS unsigned*)(lds + AT_VOFF + (c * 8 + 2 * q) * AT_VS + slot0 * 2) = (v0[q] & 0xffffu) | (v1[q] << 16);
            *(LAS unsigned*)(lds + AT_VOFF + (c * 8 + 2 * q + 1) * AT_VS + slot0 * 2) = (v0[q] >> 16) | (v1[q] & 0xffff0000u); }
    }
    const int g = wave >> 1, hq = wave & 1, head = kvh * 4 + g, r31 = lane & 31, h = lane >> 5;
    bf16x8 qf[2][4];
#pragma unroll
    for (int qt = 0; qt < 2; ++qt) {
        const int s = 128 * qblk + 64 * hq + 32 * qt + r31, pos = NMETA + s;
        const bf16* qp = Z + (size_t)(b * SEQ + s) * DIN + ZQ + head * 64 + 8 * h;
        u32x4 x[4];
#pragma unroll
        for (int ks = 0; ks < 4; ++ks) x[ks] = *(const u32x4*)(qp + 16 * ks);
#pragma unroll
        for (int ks = 0; ks < 2; ++ks) {
            const float* cp = cosT + pos * 32 + 16 * ks + 8 * h; const float* sp = sinT + pos * 32 + 16 * ks + 8 * h;
            const f32x4 c0 = *(const f32x4*)cp, c1 = *(const f32x4*)(cp + 4), s0 = *(const f32x4*)sp, s1 = *(const f32x4*)(sp + 4);
            u32x4 lo, hi;
#pragma unroll
            for (int q = 0; q < 4; ++q) { const float ca = q < 2 ? c0[2 * q] : c1[2 * q - 4], cb = q < 2 ? c0[2 * q + 1] : c1[2 * q - 3], sa = q < 2 ? s0[2 * q] : s1[2 * q - 4], sb = q < 2 ? s0[2 * q + 1] : s1[2 * q - 3];
                const float a0 = bflo(x[ks][q]), a1 = bfhi(x[ks][q]), b0 = bflo(x[ks + 2][q]), b1 = bfhi(x[ks + 2][q]);
                lo[q] = pk2(0.125f * (a0 * ca - b0 * sa), 0.125f * (a1 * cb - b1 * sb)); hi[q] = pk2(0.125f * (b0 * ca + a0 * sa), 0.125f * (b1 * cb + a1 * sb)); }
            qf[qt][ks] = __builtin_bit_cast(bf16x8, lo); qf[qt][ks + 2] = __builtin_bit_cast(bf16x8, hi);
        }
    }
    f32x16 oacc[2][2]; float mrow[2], lrow[2];
#pragma unroll
    for (int qt = 0; qt < 2; ++qt) { mrow[qt] = a.in[I_SINKS][head]; lrow[qt] = h == 0 ? 1.0f : 0.0f;
#pragma unroll
        for (int dt = 0; dt < 2; ++dt)
#pragma unroll
            for (int r = 0; r < 16; ++r) oacc[qt][dt][r] = 0.f; }
    __syncthreads();
    attn_tile(lds, 0, 0, 0, lane, hq, qf, oacc, mrow, lrow);
    if (qblk > 0) {
#pragma unroll 1
        for (int j = hq ? 2 : 0; j < 4; ++j) attn_tile(lds, 32 + 32 * j, 1, j, lane, hq, qf, oacc, mrow, lrow);
    }
#pragma unroll 1
    for (int j = 0; j < (hq ? 4 : 2); ++j) attn_tile(lds, 160 + 32 * j, 2, j, lane, hq, qf, oacc, mrow, lrow);
#pragma unroll
    for (int qt = 0; qt < 2; ++qt) {
        const float lt = lrow[qt] + __shfl_xor(lrow[qt], 32), inv = 1.0f / lt;
        bf16* op = O + (size_t)(b * SEQ + 128 * qblk + 64 * hq + 32 * qt + r31) * OLD + head * 64 + 4 * h;
#pragma unroll
        for (int dt = 0; dt < 2; ++dt)
#pragma unroll
            for (int rr = 0; rr < 4; ++rr)
                *(u32x2*)(op + 32 * dt + 8 * rr) = (u32x2){pk2(oacc[qt][dt][4 * rr] * inv, oacc[qt][dt][4 * rr + 1] * inv), pk2(oacc[qt][dt][4 * rr + 2] * inv, oacc[qt][dt][4 * rr + 3] * inv)};
    }
}

constexpr int LR_XS = 2064;
__device__ __forceinline__ void lru_norm_rows(const Args& a, LAS unsigned char* lds, int b, int c, int lane, int wave) {
        bf16* O = (bf16*)(a.ws + WS_O); unsigned char* O8 = a.ws + WS_O;
        const bf16* ATT = (const bf16*)(a.ws + (G2_FP8 ? WS_ATT : WS_O)); constexpr int ALD = G2_FP8 ? 1024 : D;
        u32x4 aw[4][2];
#pragma unroll
        for (int q = 0; q < 4; ++q)
#pragma unroll
            for (int jj = 0; jj < 2; ++jj) aw[q][jj] = *(const u32x4*)(ATT + ((size_t)b * SEQ + 32 * c + 4 * wave + q) * ALD + (lane + 64 * jj) * 8);
        f32x4 ga[2][2], gl[2][2];
#pragma unroll
        for (int jj = 0; jj < 2; ++jj) { ga[jj][0] = *(const f32x4*)(a.in[I_G_ATTN] + (lane + 64 * jj) * 8); ga[jj][1] = *(const f32x4*)(a.in[I_G_ATTN] + (lane + 64 * jj) * 8 + 4);
            gl[jj][0] = *(const f32x4*)(a.in[I_G_LRU] + (lane + 64 * jj) * 8); gl[jj][1] = *(const f32x4*)(a.in[I_G_LRU] + (lane + 64 * jj) * 8 + 4); }
        __syncthreads();
#pragma unroll
        for (int q = 0; q < 4; ++q) {
            const int tl = 4 * wave + q; const size_t row = (size_t)b * SEQ + 32 * c + tl;
#pragma unroll
            for (int half = 0; half < 2; ++half) {
                u32x4 w[2]; float v[16]; float ss = 0.f;
#pragma unroll
                for (int jj = 0; jj < 2; ++jj) { w[jj] = half == 0 ? *(const LAS u32x4*)(lds + tl * LR_XS + (lane + 64 * jj) * 16) : aw[q][jj];
#pragma unroll
                    for (int k = 0; k < 4; ++k) { v[jj * 8 + 2 * k] = bflo(w[jj][k]); v[jj * 8 + 2 * k + 1] = bfhi(w[jj][k]); } }
#pragma unroll
                for (int k = 0; k < 16; ++k) ss += v[k] * v[k];
                ss = wave_sum(ss);
                const float rstd = (G2_FP8 ? XS_SCALE : 1.0f) * __builtin_amdgcn_rsqf(ss * (1.0f / 1024.0f) + EPS);
#pragma unroll
                for (int jj = 0; jj < 2; ++jj) { const f32x4 g0 = half == 0 ? gl[jj][0] : ga[jj][0], g1 = half == 0 ? gl[jj][1] : ga[jj][1];
                    const size_t col = (half == 0 ? 1024 : 0) + (lane + 64 * jj) * 8;
                    if (G2_FP8) *(u32x2*)(O8 + row * D + col) = (u32x2){pk4_fp8(v[jj * 8 + 0] * rstd * g0.x, v[jj * 8 + 1] * rstd * g0.y, v[jj * 8 + 2] * rstd * g0.z, v[jj * 8 + 3] * rstd * g0.w),
                                                                       pk4_fp8(v[jj * 8 + 4] * rstd * g1.x, v[jj * 8 + 5] * rstd * g1.y, v[jj * 8 + 6] * rstd * g1.z, v[jj * 8 + 7] * rstd * g1.w)};
                    else *(u32x4*)(O + row * D + col) = (u32x4){pk2(v[jj * 8 + 0] * rstd * g0.x, v[jj * 8 + 1] * rstd * g0.y), pk2(v[jj * 8 + 2] * rstd * g0.z, v[jj * 8 + 3] * rstd * g0.w),
                                                                pk2(v[jj * 8 + 4] * rstd * g1.x, v[jj * 8 + 5] * rstd * g1.y), pk2(v[jj * 8 + 6] * rstd * g1.z, v[jj * 8 + 7] * rstd * g1.w)}; }
            }
        }
}
template <int PASS>
__device__ __forceinline__ void lru_item(const Args& a, LAS unsigned char* lds, int item, int tid, int lane, int wave) {
    const int b = item / 65, c = item % 65; const bool meta = (c == 64);
    const bf16* Z = (const bf16*)(a.ws + WS_Z);
    float* sumA = (float*)(a.ws + WS_LRUSUM); float* sumB = sumA + NBATCH * 64 * DLRU; float* metaB = sumB + NBATCH * 64 * DLRU;
    __syncthreads();
    {
        const int ch0 = (tid & 127) * 8, tq = tid >> 7;
        f32x4 cw[4][2], cb[2];
#pragma unroll
        for (int jj = 0; jj < 4; ++jj) { cw[jj][0] = *(const f32x4*)(a.in[I_CONV_W] + jj * DLRU + ch0); cw[jj][1] = *(const f32x4*)(a.in[I_CONV_W] + jj * DLRU + ch0 + 4); }
        cb[0] = *(const f32x4*)(a.in[I_CONV_B] + ch0); cb[1] = *(const f32x4*)(a.in[I_CONV_B] + ch0 + 4);
#pragma unroll 1
        for (int i0 = 0; i0 < 8; i0 += 4) {
            u32x4 x[4][4];
#pragma unroll
            for (int i = 0; i < 4; ++i) { const int tl = tq + 4 * (i0 + i); const int t = meta ? tl : NMETA + 32 * c + tl;
#pragma unroll
                for (int jj = 0; jj < 4; ++jj) { const int tt = t - 3 + jj; x[i][jj] = (u32x4){0u, 0u, 0u, 0u};
                    if (tt >= 0 && !(meta && tl >= NMETA)) x[i][jj] = *(const u32x4*)(Z + (size_t)tok_row(b, tt) * DIN + ZX + ch0); } }
#pragma unroll
            for (int i = 0; i < 4; ++i) { const int tl = tq + 4 * (i0 + i); const int t = meta ? tl : NMETA + 32 * c + tl;
                f32x4 a0 = cb[0], a1 = cb[1];
#pragma unroll
                for (int jj = 0; jj < 4; ++jj) { const u32x4 xx = x[i][jj];
                    if (t - 3 + jj >= 0) {
                        a0.x += cw[jj][0].x * bflo(xx[0]); a0.y += cw[jj][0].y * bfhi(xx[0]); a0.z += cw[jj][0].z * bflo(xx[1]); a0.w += cw[jj][0].w * bfhi(xx[1]);
                        a1.x += cw[jj][1].x * bflo(xx[2]); a1.y += cw[jj][1].y * bfhi(xx[2]); a1.z += cw[jj][1].z * bflo(xx[3]); a1.w += cw[jj][1].w * bfhi(xx[3]); } }
                u32x4 o = (u32x4){pk2(a0.x, a0.y), pk2(a0.z, a0.w), pk2(a1.x, a1.y), pk2(a1.z, a1.w)};
                if (meta && tl >= NMETA) o = (u32x4){0u, 0u, 0u, 0u};
                *(LAS u32x4*)(lds + tl * LR_XS + ch0 * 2) = o; }
        }
    }
    LAS float* hinL = (LAS float*)(lds + 32 * LR_XS);
    if (PASS == 1) {
        float h0 = metaB[tid], h1 = metaB[tid + 512];
        const float* pa = sumA + (size_t)b * 64 * DLRU + tid; const float* pb = sumB + (size_t)b * 64 * DLRU + tid;
#pragma unroll 8
        for (int jc = 0; jc < c; ++jc) { h0 = pa[jc * DLRU] * h0 + pb[jc * DLRU]; h1 = pa[jc * DLRU + 512] * h1 + pb[jc * DLRU + 512]; }
        hinL[tid] = h0; hinL[tid + 512] = h1;
    }
    __syncthreads();
    const bf16* WaT = (const bf16*)(a.ws + WS_WAT); const bf16* WiT = (const bf16*)(a.ws + WS_WIT);
    const int r31 = lane & 31, h = lane >> 5;
    const int tau = 16 * ((r31 >> 2) & 1) + 4 * (r31 >> 3) + (r31 & 3);
#pragma unroll 1
    for (int nb = 0; nb < 2; ++nb) {
        const int n = 2 * wave + nb;
        bf16x8 af[4];
#pragma unroll
        for (int ks = 0; ks < 4; ++ks) af[ks] = *(const LAS bf16x8*)(lds + tau * LR_XS + (64 * n + 16 * ks + 8 * h) * 2);
#pragma unroll 1
        for (int nt = 0; nt < 2; ++nt) {
            const int ch = 64 * n + 32 * nt + r31;
            f32x16 accR, accI;
#pragma unroll
            for (int r = 0; r < 16; ++r) { accR[r] = 0.f; accI[r] = 0.f; }
#pragma unroll
            for (int ks = 0; ks < 4; ++ks) {
                const bf16x8 wa = *(const bf16x8*)(WaT + ((size_t)(n * 64 + 32 * nt + r31) * 64 + 16 * ks + 8 * h));
                const bf16x8 wi = *(const bf16x8*)(WiT + ((size_t)(n * 64 + 32 * nt + r31) * 64 + 16 * ks + 8 * h));
                accR = __builtin_amdgcn_mfma_f32_32x32x16_bf16(af[ks], wa, accR, 0, 0, 0);
                accI = __builtin_amdgcn_mfma_f32_32x32x16_bf16(af[ks], wi, accI, 0, 0, 0);
            }
            const float ba = a.in[I_B_A][ch], bi = a.in[I_B_I][ch], sp8 = -8.0f * 1.4426950408889634f * log1pf(__expf(-a.in[I_LAMBDA][ch]));
            float av[16], bv[16];
            float Ap = 1.0f, Bp = 0.0f;
#pragma unroll
            for (int r = 0; r < 16; ++r) {
                const float xcv = bf2f(*(const LAS unsigned short*)(lds + (16 * h + r) * LR_XS + ch * 2));
                const float rg = fast_sigmoid(accR[r] + ba), ig = fast_sigmoid(accI[r] + bi);
                const float l2a = sp8 * rg;
                av[r] = __builtin_amdgcn_exp2f(l2a); bv[r] = __builtin_amdgcn_sqrtf(fmaxf(fmaf(-av[r], av[r], 1.0f), 0.0f)) * ig * xcv;
                Ap *= av[r]; Bp = av[r] * Bp + bv[r];
                if (PASS == 0 && !meta) ((unsigned*)(a.ws + WS_AB))[((size_t)b * SEQ + 32 * c + 16 * h + r) * DLRU + ch] = pk2(l2a, bv[r]);
            }
            const float Ao = __shfl_xor(Ap, 32), Bo = __shfl_xor(Bp, 32);
            if (PASS == 0) {
                if (h == 0) {
                    if (meta) metaB[ch] = Bp;
                    else { sumA[((size_t)b * 64 + c) * DLRU + ch] = Ap * Ao; sumB[((size_t)b * 64 + c) * DLRU + ch] = Ao * Bp + Bo; }
                }
            } else {
                const float hin = hinL[ch];
                float hs = h == 0 ? hin : (Ao * hin + Bo);
#pragma unroll
                for (int r = 0; r < 16; ++r) {
                    hs = av[r] * hs + bv[r];
                    const int tl = 16 * h + r;
                    const float gt = bf2f(Z[(size_t)(b * SEQ + 32 * c + tl) * DIN + ZG + ch]);
                    *(LAS unsigned short*)(lds + tl * LR_XS + ch * 2) = (unsigned short)f2bf(hs * fast_gelu_tanh(gt));
                }
            }
        }
    }
}

__device__ __forceinline__ void lru_item_b(const Args& a, LAS unsigned char* lds, int item, int tid, int lane, int wave) {
    const int b = item >> 6, c = item & 63;
    const bf16* Z = (const bf16*)(a.ws + WS_Z); const unsigned* AB = (const unsigned*)(a.ws + WS_AB);
    const float* sumA = (const float*)(a.ws + WS_LRUSUM); const float* sumB = sumA + NBATCH * 64 * DLRU; const float* metaB = sumB + NBATCH * 64 * DLRU;
    const size_t row0 = (size_t)b * SEQ + 32 * c;
    u32x2 ab[32]; unsigned gt[32];
#pragma unroll
    for (int tl = 0; tl < 32; ++tl) { ab[tl] = *(const u32x2*)(AB + (row0 + tl) * DLRU + 2 * tid); gt[tl] = *(const unsigned*)(Z + (row0 + tl) * DIN + ZG + 2 * tid); }
    float h0, h1; { const f32x2 m = *(const f32x2*)(metaB + 2 * tid); h0 = m.x; h1 = m.y; }
    { const float* pa = sumA + (size_t)b * 64 * DLRU + 2 * tid; const float* pb = sumB + (size_t)b * 64 * DLRU + 2 * tid;
#pragma unroll 8
      for (int jc = 0; jc < c; ++jc) { const f32x2 A2 = *(const f32x2*)(pa + jc * DLRU), B2 = *(const f32x2*)(pb + jc * DLRU); h0 = A2.x * h0 + B2.x; h1 = A2.y * h1 + B2.y; } }
    __syncthreads();
#pragma unroll
    for (int tl = 0; tl < 32; ++tl) {
        h0 = __builtin_amdgcn_exp2f(bflo(ab[tl].x)) * h0 + bfhi(ab[tl].x);
        h1 = __builtin_amdgcn_exp2f(bflo(ab[tl].y)) * h1 + bfhi(ab[tl].y);
        *(LAS unsigned*)(lds + tl * LR_XS + 4 * tid) = pk2(h0 * fast_gelu_tanh(bflo(gt[tl])), h1 * fast_gelu_tanh(bfhi(gt[tl])));
    }
    lru_norm_rows(a, lds, b, c, lane, wave);
}

__device__ __forceinline__ void phase_router_mfma(const Args& a, LAS unsigned char* lds, int tid, int lane, int wave) {
    const bf16* H1 = (const bf16*)(a.ws + WS_H1); const bf16* WRT = (const bf16*)(a.ws + WS_WRT);
    int* tope = (int*)(a.ws + WS_TOPE); float* topw = (float*)(a.ws + WS_TOPW); float* rstd2 = (float*)(a.ws + WS_RSTD2);
    unsigned* counts = (unsigned*)(a.ws + WS_CTL) + CW_COUNTS;
    LAS float* lg = (LAS float*)(lds + wave * 2048);
    LAS int* hist = (LAS int*)(lds + 32768);
    if (tid < 32) hist[tid] = 0;
    __syncthreads();
    const int fr = lane & 15, fq = lane >> 4;
    for (int grp = wave * gridDim.x + blockIdx.x; grp < MREAL / 16; grp += 8 * gridDim.x) {
        const int row0 = grp * 16;
        const bf16* hp = H1 + (size_t)(row0 + fr) * D + 8 * fq;
        const bf16* wp = WRT + (size_t)fr * D + 8 * fq;
        f32x4 acc0 = (f32x4){0.f, 0.f, 0.f, 0.f}, acc1 = acc0; float ss = 0.f;
#pragma unroll 4
        for (int kk = 0; kk < 64; ++kk) {
            const u32x4 w = *(const u32x4*)(hp + 32 * kk);
#pragma unroll
            for (int q = 0; q < 4; ++q) { const float lo = bflo(w[q]), hi = bfhi(w[q]); ss += lo * lo + hi * hi; }
            const bf16x8 af = __builtin_bit_cast(bf16x8, w);
            const bf16x8 b0 = *(const bf16x8*)(wp + 32 * kk), b1 = *(const bf16x8*)(wp + (size_t)16 * D + 32 * kk);
            acc0 = __builtin_amdgcn_mfma_f32_16x16x32_bf16(af, b0, acc0, 0, 0, 0);
            acc1 = __builtin_amdgcn_mfma_f32_16x16x32_bf16(af, b1, acc1, 0, 0, 0);
        }
        ss += __shfl_xor(ss, 16); ss += __shfl_xor(ss, 32);
        const float rstd = 1.0f / sqrtf(ss * (1.0f / D) + EPS);
        if (fq == 0) rstd2[row0 + fr] = rstd;
        const float br0 = a.in[I_B_ROUTER][fr], br1 = a.in[I_B_ROUTER][16 + fr];
#pragma unroll
        for (int j = 0; j < 4; ++j) { const int row = 4 * fq + j; const float rs = __shfl(rstd, row);
            lg[row * 32 + fr] = acc0[j] * rs + br0; lg[row * 32 + 16 + fr] = acc1[j] * rs + br1; }
        asm volatile("s_waitcnt lgkmcnt(0)" ::: "memory");
        if (lane < 16) {
            float v[32];
#pragma unroll
            for (int q = 0; q < 8; ++q) { const f32x4 t = *(const LAS f32x4*)(lg + lane * 32 + 4 * q); v[4 * q] = t.x; v[4 * q + 1] = t.y; v[4 * q + 2] = t.z; v[4 * q + 3] = t.w; }
            float tv[4]; int te[4];
#pragma unroll
            for (int r = 0; r < 4; ++r) { float best = -3.0e38f; int bi = 0;
#pragma unroll
                for (int e = 0; e < 32; ++e) { const bool gtb = v[e] > best; best = gtb ? v[e] : best; bi = gtb ? e : bi; }
#pragma unroll
                for (int e = 0; e < 32; ++e) v[e] = (e == bi) ? -3.0e38f : v[e];
                tv[r] = best; te[r] = bi; }
            const float e1 = __expf(tv[1] - tv[0]), e2 = __expf(tv[2] - tv[0]), e3 = __expf(tv[3] - tv[0]);
            const float inv = 1.0f / (1.0f + e1 + e2 + e3);
            const int row = row0 + lane;
            *(int4*)(tope + row * 4) = make_int4(te[0], te[1], te[2], te[3]);
            *(f32x4*)(topw + row * 4) = (f32x4){inv, e1 * inv, e2 * inv, e3 * inv};
#pragma unroll
            for (int r = 0; r < 4; ++r) atomicAdd((int*)&hist[te[r]], 1);
        }
        asm volatile("s_waitcnt lgkmcnt(0)" ::: "memory");
    }
    __syncthreads();
    if (tid < 32 && hist[tid] != 0) atomicAdd(&counts[tid], (unsigned)hist[tid]);
}

__device__ __forceinline__ void build_tile_table(const Args& a, LAS int* tstart, int tid) {
    if (tid < 64) {
        const unsigned* counts = (const unsigned*)(a.ws + WS_CTL) + CW_COUNTS;
        const int nt = tid < NEXP ? (int)((__hip_atomic_load(counts + tid, __ATOMIC_RELAXED, __HIP_MEMORY_SCOPE_AGENT) + 255u) >> 8) : 0;
        int inc = nt;
#pragma unroll
        for (int o = 1; o < 32; o <<= 1) { const int v = __shfl_up(inc, o); if ((tid & 63) >= o) inc += v; }
        if (tid < NEXP) tstart[tid] = inc - nt;
        if (tid == NEXP - 1) tstart[NEXP] = inc;
    }
    __syncthreads();
    if (tid < 288) { int e = 0;
#pragma unroll 1
        for (int i = 1; i < NEXP; ++i) e += (tstart[i] <= tid) ? 1 : 0;
        ((LAS unsigned char*)(tstart + 64))[tid] = (unsigned char)e; }
    __syncthreads();
}
__device__ __forceinline__ int tile_expert(const LAS int* tstart, int tile) {
    int e = 0;
#pragma unroll 1
    for (int i = 1; i < NEXP; ++i) e += (tstart[i] <= tile) ? 1 : 0;
    return e;
}

__device__ __forceinline__ void phase_assign(const Args& a, LAS unsigned char* lds, int tid, int lane, int wave) {
    LAS int* tstart = (LAS int*)(lds + LDS_TAB);
    LAS int* hist = tstart + 64; LAS int* base = hist + 32; LAS int* spos = base + 32;
    build_tile_table(a, tstart, tid);
    const int* tope = (const int*)(a.ws + WS_TOPE); const float* topw = (const float*)(a.ws + WS_TOPW); const float* rstd2 = (const float*)(a.ws + WS_RSTD2);
    int* rowpair = (int*)(a.ws + WS_ROWPAIR); float* roww = (float*)(a.ws + WS_ROWW);
    unsigned* cursor = (unsigned*)(a.ws + WS_CTL) + CW_CURSOR;
    const bf16* H1 = (const bf16*)(a.ws + WS_H1); unsigned char* XS = (unsigned char*)(a.ws + WS_XS);
    for (int blk = blockIdx.x; blk < MREAL / 64; blk += gridDim.x) {
        if (tid < 32) hist[tid] = 0;
        __syncthreads();
        int e = 0, rank = 0, pair = 0;
        if (tid < 256) { pair = blk * 256 + tid; e = tope[pair]; rank = atomicAdd((int*)&hist[e], 1); }
        __syncthreads();
        if (tid < 32) base[tid] = (int)atomicAdd(&cursor[tid], (unsigned)hist[tid]);
        __syncthreads();
        if (tid < 256) { const int pos = tstart[e] * 256 + base[e] + rank; spos[tid] = pos; rowpair[pos] = pair; roww[pos] = topw[pair]; ((int*)(a.ws + WS_PAIRPOS))[pair] = pos; }
        __syncthreads();
        for (int tt = wave * 8; tt < wave * 8 + 8; ++tt) {
            const int token = blk * 64 + tt; const float rstd = rstd2[token] * XS_SCALE;
            const u32x4* hr = (const u32x4*)(H1 + (size_t)token * D);
            u32x4* dst = (u32x4*)(XS + (size_t)token * D);
#pragma unroll
            for (int j = 0; j < 2; ++j) { const u32x4 ha = hr[2 * (lane + 64 * j)], hb = hr[2 * (lane + 64 * j) + 1];
                const f32x4* gp = (const f32x4*)a.in[I_NORM_FFN] + 4 * (lane + 64 * j); const f32x4 g0 = gp[0], g1 = gp[1], g2 = gp[2], g3 = gp[3];
                dst[lane + 64 * j] = (u32x4){pk4_fp8(bflo(ha[0]) * rstd * g0.x, bfhi(ha[0]) * rstd * g0.y, bflo(ha[1]) * rstd * g0.z, bfhi(ha[1]) * rstd * g0.w),
                                             pk4_fp8(bflo(ha[2]) * rstd * g1.x, bfhi(ha[2]) * rstd * g1.y, bflo(ha[3]) * rstd * g1.z, bfhi(ha[3]) * rstd * g1.w),
                                             pk4_fp8(bflo(hb[0]) * rstd * g2.x, bfhi(hb[0]) * rstd * g2.y, bflo(hb[1]) * rstd * g2.z, bfhi(hb[1]) * rstd * g2.w),
                                             pk4_fp8(bflo(hb[2]) * rstd * g3.x, bfhi(hb[2]) * rstd * g3.y, bflo(hb[3]) * rstd * g3.z, bfhi(hb[3]) * rstd * g3.w)}; }
        }
        __syncthreads();
    }
}

__device__ __forceinline__ void phase_final(const Args& a, int lane, int wave) {
    const int gw = blockIdx.x * 8 + wave, NGW = gridDim.x * 8;
    const bf16* H1 = (const bf16*)(a.ws + WS_H1); const unsigned char* YB = a.ws + WS_YB;
    const int* pairpos = (const int*)(a.ws + WS_PAIRPOS); const float* topw = (const float*)(a.ws + WS_TOPW);
    for (int row = gw; row < MREAL; row += NGW) {
        const int4 pp = *(const int4*)(pairpos + row * 4); const f32x4 pw = *(const f32x4*)(topw + row * 4) * (1.0f / YB_SCALE);
        const int pos[4] = {pp.x, pp.y, pp.z, pp.w}; const float w4[4] = {pw.x, pw.y, pw.z, pw.w};
        f32x4 v[8]; unsigned y[4][8]; float ss = 0.f;
#pragma unroll
        for (int k = 0; k < 4; ++k)
#pragma unroll
            for (int j = 0; j < 8; ++j) y[k][j] = ((const unsigned*)(YB + (size_t)pos[k] * D))[lane + 64 * j];
#pragma unroll
        for (int j = 0; j < 8; ++j) { { const u32x2 hh = ((const u32x2*)(H1 + (size_t)row * D))[lane + 64 * j]; v[j] = (f32x4){bflo(hh.x), bfhi(hh.x), bflo(hh.y), bfhi(hh.y)}; }
#pragma unroll
            for (int k = 0; k < 4; ++k) { const f32x2 lo = __builtin_amdgcn_cvt_pk_f32_fp8((int)y[k][j], false), hi = __builtin_amdgcn_cvt_pk_f32_fp8((int)y[k][j], true);
                v[j].x += w4[k] * lo.x; v[j].y += w4[k] * lo.y; v[j].z += w4[k] * hi.x; v[j].w += w4[k] * hi.y; }
            ss += (v[j].x * v[j].x + v[j].y * v[j].y) + (v[j].z * v[j].z + v[j].w * v[j].w); }
        ss = wave_sum(ss);
        const float rstd = 1.0f / sqrtf(ss * (1.0f / D) + EPS);
        f32x4* op = (f32x4*)(a.out + (size_t)row * D);
#pragma unroll
        for (int j = 0; j < 8; ++j) { const f32x4 g = ((const f32x4*)a.in[I_FINAL_NORM])[lane + 64 * j]; op[lane + 64 * j] = v[j] * rstd * g; }
    }
}

enum { PH_PROLOGUE = 0, PH_G1, PH_ATTN, PH_LRU_B, PH_G2, PH_ROUTER, PH_ASSIGN, PH_G3, PH_G4, PH_FINAL, PH_COUNT };

__global__ void __launch_bounds__(512, 2) fwd(Args a) {
    extern __shared__ __attribute__((aligned(16))) unsigned char lds_raw[];
    LAS unsigned char* lds = (LAS unsigned char*)lds_raw;
    const int tid = threadIdx.x, lane = tid & 63, wave = __builtin_amdgcn_readfirstlane(tid >> 6);
    const int gw = blockIdx.x * 8 + wave, NGW = gridDim.x * 8;
    unsigned char* ws = a.ws;
#define IN(k) (a.ph_lo <= (k) && (k) < a.ph_hi)
    pg8::BGNone nobg;
    pg8::BGConv bgup{(const char*)a.in[I_W_UP], ws + WS_WUT, (int)blockIdx.x * 128, (int)blockIdx.x * 128 + 80, ws + WS_DUMMY};
#define SEAM(k) do { if (IN(k) && IN((k) + 1)) xcd_barrier(bar); } while (0)
    if (tid < 4) ((LAS unsigned*)(lds + LDS_MISC))[tid] = 0u;
    __syncthreads();
    XcdBarrier bar; bar.bar = (unsigned*)(ws + WS_CTL) + CW_BAR; bar.x = 0; bar.st = nullptr;
    if (a.ph_hi - a.ph_lo > 1) bar = xcd_barrier_post((unsigned*)(ws + WS_CTL) + CW_BAR, (volatile LAS unsigned*)(lds + LDS_MISC));

    if (IN(PH_PROLOGUE)) { phase_prologue(a, lds, tid, lane, wave);
#if PROBE_REPEAT == 0
        __syncthreads(); phase_prologue(a, lds, tid, lane, wave);
#endif
    }
    SEAM(PH_PROLOGUE);

    if (IN(PH_G1)) {
        pg8::SchedDense S{(const char*)(ws + WS_N1), (const char*)(ws + WS_WINT), (const char*)(ws + WS_WINT), nullptr, MROWS / 256, DIN / 256, (int)gridDim.x, (int)blockIdx.x, G1_FP8 ? 2048 : 4096};
        pg8::EpiZ E{(bf16*)(ws + WS_Z), a.in[I_B_IN], G1_FP8 ? 1.0f / (W_SCALE * XS_SCALE) : 1.0f};
#if BG_WUP
        pg8::gemm_phase<G1_FP8 != 0>(lds, S, E, bgup);
#else
        pg8::gemm_phase<G1_FP8 != 0>(lds, S, E, nobg);
#endif
#if PROBE_REPEAT == 1
        __syncthreads(); pg8::gemm_phase<G1_FP8 != 0>(lds, S, E, nobg);
#endif
    }
    SEAM(PH_G1);
    if (IN(PH_ATTN)) {
        for (int it = blockIdx.x; it < NBATCH * 16 * 4; it += gridDim.x) attn_item(a, lds, it, tid, lane, wave);
        for (int it = blockIdx.x; it < NBATCH * 65; it += gridDim.x) { if (it % 65 == 64 && it != 64) continue; lru_item<0>(a, lds, it, tid, lane, wave); }
#if PROBE_REPEAT == 2
        for (int it = blockIdx.x; it < NBATCH * 16 * 4; it += gridDim.x) attn_item(a, lds, it, tid, lane, wave);
#endif
#if PROBE_REPEAT == 3
        for (int it = blockIdx.x; it < NBATCH * 65; it += gridDim.x) { if (it % 65 == 64 && it != 64) continue; lru_item<0>(a, lds, it, tid, lane, wave); }
#endif
    }
    SEAM(PH_ATTN);
    if (IN(PH_LRU_B)) {
        for (int it = blockIdx.x; it < NBATCH * 64; it += gridDim.x) lru_item_b(a, lds, it, tid, lane, wave);
    }
    SEAM(PH_LRU_B);
    if (IN(PH_G2)) {
        pg8::SchedDense S{(const char*)(ws + WS_O), (const char*)(ws + WS_WOUTT), (const char*)(ws + WS_WOUTT), nullptr, MREAL / 256, D / 256, (int)gridDim.x, (int)blockIdx.x, G2_FP8 ? 2048 : 4096};
        pg8::EpiH1 E{(bf16*)(ws + WS_H1), a.in[I_X], a.in[I_B_OUT], G2_FP8 ? 1.0f / (W_SCALE * XS_SCALE) : 1.0f};
#if BG_WUP
        pg8::gemm_phase<G2_FP8 != 0>(lds, S, E, bgup);
        for (int pair = bgup.next < bgup.end ? bgup.next : bgup.end; pair < bgup.end; ++pair) { const char* sp; unsigned char* dp; pg8::bg_pair_ptrs(bgup, pair, sp, dp);
            const int n = tid >> 4, c = tid & 15; const float* p = (const float*)sp + (size_t)(8 * c) * 2048 + n;
            *(u32x2*)(dp + (size_t)n * 2048 + 8 * c) = (u32x2){pk4_fp8(p[0] * W_SCALE, p[2048] * W_SCALE, p[4096] * W_SCALE, p[6144] * W_SCALE), pk4_fp8(p[8192] * W_SCALE, p[10240] * W_SCALE, p[12288] * W_SCALE, p[14336] * W_SCALE)}; }
#else
        pg8::gemm_phase<G2_FP8 != 0>(lds, S, E, nobg);
#endif
#if PROBE_REPEAT == 4
        __syncthreads(); pg8::gemm_phase<G2_FP8 != 0>(lds, S, E, nobg);
#endif
    }
    SEAM(PH_G2);
    if (IN(PH_ROUTER)) phase_router_mfma(a, lds, tid, lane, wave);
    SEAM(PH_ROUTER);
    if (IN(PH_ASSIGN)) phase_assign(a, lds, tid, lane, wave);
    SEAM(PH_ASSIGN);
    if (IN(PH_G3)) {
        LAS int* tstart = (LAS int*)(lds + LDS_TAB);
        build_tile_table(a, tstart, tid);
        pg8::SchedMoE S{(const char*)(ws + WS_N2), (const char*)(ws + WS_WGT), (const char*)(ws + WS_WUT), (const int*)(ws + WS_ROWPAIR), tstart, tstart[NEXP], DFF / 128, (int)gridDim.x, (int)blockIdx.x, true};
        pg8::EpiAct E{(unsigned char*)(ws + WS_ACT), a.in[I_B_GATE], a.in[I_B_UP]};
#if BG_WDOWN
        pg8::BGConv bg{(const char*)a.in[I_W_DOWN], ws + WS_WDT, (int)blockIdx.x * (32768 / 256), ((int)blockIdx.x + 1) * (32768 / 256), ws + WS_DUMMY};
        if (gridDim.x != 256) { bg.next = (int)((long)blockIdx.x * 32768 / gridDim.x); bg.end = (int)((long)(blockIdx.x + 1) * 32768 / gridDim.x); }
        pg8::gemm_phase<true, pg8::EpiAct, pg8::SchedMoE, pg8::BGConv, true>(lds, S, E, bg);
        for (int pair = bg.next < bg.end ? bg.next : bg.end; pair < bg.end; ++pair) { const char* sp; unsigned char* dp; pg8::bg_pair_ptrs(bg, pair, sp, dp);
            const int n = tid >> 4, c = tid & 15;
            const float* p = (const float*)sp + (size_t)(8 * c) * 2048 + n;
            *(u32x2*)(dp + (size_t)n * 2048 + 8 * c) = (u32x2){pk4_fp8(p[0] * W_SCALE, p[2048] * W_SCALE, p[4096] * W_SCALE, p[6144] * W_SCALE), pk4_fp8(p[8192] * W_SCALE, p[10240] * W_SCALE, p[12288] * W_SCALE, p[14336] * W_SCALE)}; }
#else
        pg8::gemm_phase<true, pg8::EpiAct, pg8::SchedMoE, pg8::BGNone, true>(lds, S, E, nobg);
#endif
#if PROBE_REPEAT == 7
        __syncthreads(); pg8::gemm_phase<true, pg8::EpiAct, pg8::SchedMoE, pg8::BGNone, true>(lds, S, E, nobg);
#endif
    }
    SEAM(PH_G3);
    if (IN(PH_G4)) {
        LAS int* tstart = (LAS int*)(lds + LDS_TAB);
        build_tile_table(a, tstart, tid);
        pg8::SchedMoE S{(const char*)(ws + WS_ACT), (const char*)(ws + WS_WDT), (const char*)(ws + WS_WDT), nullptr, tstart, tstart[NEXP], D / 256, (int)gridDim.x, (int)blockIdx.x, false};
        pg8::EpiDown E{ws + WS_YB, a.in[I_B_DOWN]};
        pg8::gemm_phase<true>(lds, S, E, nobg);
#if PROBE_REPEAT == 8
        __syncthreads(); pg8::gemm_phase<true>(lds, S, E, nobg);
#endif
    }
    SEAM(PH_G4);
    if (IN(PH_FINAL)) { phase_final(a, lane, wave);
#if PROBE_REPEAT == 9
        phase_final(a, lane, wave);
#endif
    }
#undef IN
#undef SEAM
}

extern "C" void kernel_launch(void* const* d_in, const int* in_sizes, int n_in, void* d_out, int out_size, void* d_ws, size_t ws_size, hipStream_t stream) {
    static int grid = 0;
    if (grid == 0) {
        if (n_in != 27 || out_size != MREAL * D || ws_size < WS_END) { fprintf(stderr, "kernel_launch: unexpected problem (n_in %d, out %d, ws %zu)\n", n_in, out_size, ws_size); grid = -1; return; }
        int dev = 0, cus = 0;
        if (hipGetDevice(&dev) != hipSuccess || hipDeviceGetAttribute(&cus, hipDeviceAttributeMultiprocessorCount, dev) != hipSuccess) { grid = -1; return; }
        if (hipFuncSetAttribute((const void*)fwd, hipFuncAttributeMaxDynamicSharedMemorySize, LDS_BYTES) != hipSuccess) { fprintf(stderr, "kernel_launch: hipFuncSetAttribute failed\n"); grid = -1; return; }
        grid = cus;
    }
    if (grid < 0) return;
    (void)hipMemsetAsync((char*)d_ws + WS_CTL, 0, CTL_BYTES, stream);
    Args a{};
    for (int i = 0; i < 27; ++i) a.in[i] = (const float*)d_in[i];
    a.out = (float*)d_out; a.ws = (unsigned char*)d_ws;
#if MK_ONE_LAUNCH
    a.ph_lo = 0; a.ph_hi = PH_COUNT;
    hipLaunchKernelGGL(fwd, dim3(grid), dim3(512), LDS_BYTES, stream, a);
#else
    for (int ph = 0; ph < PH_COUNT; ++ph) {
        a.ph_lo = ph; a.ph_hi = ph + 1;
        hipLaunchKernelGGL(fwd, dim3(grid), dim3(512), LDS_BYTES, stream, a);
    }
#endif
}
```

```cpp
#include <hip/hip_runtime.h>
#include <cstdio>
#include <cstdint>

#define LAS __attribute__((address_space(3)))
#ifndef PROBE_REPEAT
#define PROBE_REPEAT -1
#endif
#ifndef G1_FP8
#define G1_FP8 0
#endif
#ifndef G2_FP8
#define G2_FP8 0
#endif
#ifndef BG_WDOWN
#define BG_WDOWN 1
#ifndef G3_TEST_IDLE
#define G3_TEST_IDLE 0
#endif
#endif
#ifndef BG_WUP
#define BG_WUP 0
#endif
#ifndef BG_EXP
#define BG_EXP 0
#endif
#ifndef MK_ONE_LAUNCH
#define MK_ONE_LAUNCH 1
#endif
typedef unsigned short bf16;
typedef float f32x4 __attribute__((ext_vector_type(4)));
typedef float f32x2 __attribute__((ext_vector_type(2)));
typedef short bf16x8 __attribute__((ext_vector_type(8)));
typedef unsigned u32x4 __attribute__((ext_vector_type(4)));
typedef unsigned u32x2 __attribute__((ext_vector_type(2)));

constexpr int D = 2048, SEQ = 2048, NMETA = 16, TT = 2064, NBATCH = 8;
constexpr int MREAL = 16384, METAROW0 = 16384, MVALID = 16400, MROWS = 16640;
constexpr int DIN = 3584, DLRU = 1024, HD = 64;
constexpr int ZQ = 0, ZK = 1024, ZV = 1280, ZX = 1536, ZG = 2560;
constexpr int NEXP = 32, DFF = 2048, PROWS = 73728;
constexpr float EPS = 1e-5f;

constexpr size_t MiB = 1u << 20;
constexpr size_t WS_CTL = 0, CTL_BYTES = 1 * MiB;
constexpr size_t WS_COS = 1 * MiB, WS_SIN = 1 * MiB + 320 * 1024;
constexpr size_t WS_TOPE = 2 * MiB, WS_TOPW = WS_TOPE + 256 * 1024, WS_RSTD2 = WS_TOPW + 256 * 1024, WS_ROWPAIR = WS_RSTD2 + 64 * 1024, WS_ROWW = WS_ROWPAIR + 320 * 1024;
constexpr size_t WS_PAIRPOS = 3 * MiB + 256 * 1024;
constexpr size_t WS_DUMMY = 3 * MiB + 512 * 1024;
constexpr size_t WS_LRUSUM = 4 * MiB;
constexpr size_t WS_WAT = 9 * MiB, WS_WIT = WS_WAT + 128 * 1024, WS_WRT = WS_WIT + 128 * 1024;
constexpr size_t WS_WINT = 10 * MiB, WS_WOUTT = 24 * MiB, WS_WGT = 32 * MiB, WS_WUT = 288 * MiB, WS_WDT = 544 * MiB;
constexpr size_t WS_N1 = 800 * MiB, WS_Z = 866 * MiB, WS_O = 980 * MiB, WS_H1 = 1044 * MiB, WS_XS = 1172 * MiB, WS_YB = WS_XS, WS_ACT = 1460 * MiB, WS_END = 1748 * MiB;
constexpr size_t WS_N2 = WS_XS;
constexpr size_t WS_AB = WS_XS;
constexpr size_t WS_ATT = WS_N1;
constexpr size_t WS_XC = WS_XS, WS_AA = WS_XS + 66 * MiB, WS_BB = WS_XS + 132 * MiB, WS_YL = WS_XS + 198 * MiB;
static_assert(WS_ROWW + PROWS * 4 <= WS_LRUSUM, "small map");
constexpr int CW_COUNTS = 1024, CW_CURSOR = 1088, CW_RSYNC = 1280, CW_BAR = 4096;

constexpr int LDS_TAB = 131072;
constexpr int LDS_META = LDS_TAB + 1024;
constexpr int LDS_RID = LDS_META + 3072;
constexpr int LDS_MISC = LDS_TAB + 8192;
constexpr int LDS_BG = LDS_MISC + 1024;
constexpr int LDS_T2 = LDS_BG + 16384;
constexpr int LDS_BYTES = LDS_T2 + 4352;
static_assert(LDS_BYTES <= 163840 && LDS_BG % 1024 == 0, "LDS map");

__device__ const float c_inv_freq[32] = {1.000000000e+00f, 7.498942018e-01f, 5.623413324e-01f, 4.216965139e-01f, 3.162277639e-01f, 2.371373922e-01f, 1.778279394e-01f, 1.333521456e-01f, 1.000000015e-01f, 7.498941571e-02f, 5.623412877e-02f, 4.216964915e-02f, 3.162277862e-02f, 2.371373586e-02f, 1.778279431e-02f, 1.333521493e-02f, 9.999999776e-03f, 7.498942316e-03f, 5.623413250e-03f, 4.216964822e-03f, 3.162277862e-03f, 2.371373819e-03f, 1.778279431e-03f, 1.333521446e-03f, 1.000000047e-03f, 7.498941850e-04f, 5.623413017e-04f, 4.216965463e-04f, 3.162277862e-04f, 2.371373848e-04f, 1.778279402e-04f, 1.333521504e-04f};

struct Args { const float* in[27]; float* out; unsigned char* ws; int ph_lo, ph_hi; };
enum { I_X = 0, I_META, I_NORM_MIX, I_W_IN, I_B_IN, I_SINKS, I_CONV_W, I_CONV_B, I_W_A, I_B_A, I_W_I, I_B_I, I_LAMBDA, I_G_ATTN, I_G_LRU, I_W_OUT, I_B_OUT, I_NORM_FFN,
       I_W_ROUTER, I_B_ROUTER, I_W_GATE, I_B_GATE, I_W_UP, I_B_UP, I_W_DOWN, I_B_DOWN, I_FINAL_NORM };


#define XB_TMO      128
#define XB_XCNT(j)  (256  + 64 * (j))
#define XB_XSUB(j)  (1280 + 64 * (j))
#define XB_XGEN(j)  (2304 + 64 * (j))
#define XB_TOP      3328
#define XB_TOPGEN   3392
#define XCD_BAR_WORDS 3456
#define XB_SPIN_CAP (1u << 18)

__device__ __forceinline__ unsigned xb_ld(unsigned* p)              { return __hip_atomic_load(p, __ATOMIC_RELAXED, __HIP_MEMORY_SCOPE_AGENT); }
__device__ __forceinline__ unsigned xb_add(unsigned* p, unsigned v) { return __hip_atomic_fetch_add(p, v, __ATOMIC_RELAXED, __HIP_MEMORY_SCOPE_AGENT); }
__device__ __forceinline__ unsigned xb_xcc_id() { return (unsigned)__builtin_amdgcn_s_getreg((3 << 11) | 20) & 0xFu; }
#define XB_SPIN(cond, bar) do { unsigned _sp = 0; while (cond) { __builtin_amdgcn_s_sleep(1); \
    if ((++_sp & 255u) == 0u) { if (xb_ld(&(bar)[XB_TMO])) break; if (_sp > XB_SPIN_CAP) { atomicAdd(&(bar)[XB_TMO], 1u); break; } } } } while (0)

struct XcdBarrier {
    unsigned* bar; unsigned x;
    volatile LAS unsigned* st;
};

__device__ __forceinline__ XcdBarrier xcd_barrier_post(unsigned* bar, volatile LAS unsigned* st) {
    XcdBarrier b; b.bar = bar; b.x = xb_xcc_id(); b.st = st;
    if (threadIdx.x == 0) (void)xb_add(&bar[XB_XCNT(b.x)], 1u);
    return b;
}
__device__ __forceinline__ void xcd_barrier_complete(unsigned* bar, unsigned x, unsigned& nloc, unsigned& nx) {
    const unsigned G = gridDim.x * gridDim.y * gridDim.z;
    unsigned sum, cnt, mine, sp = 0u;
    for (;;) {
        sum = 0u; cnt = 0u; mine = 0u;
#pragma unroll
        for (unsigned j = 0; j < 16; ++j) { const unsigned c = xb_ld(&bar[XB_XCNT(j)]); sum += c; cnt += (c > 0u) ? 1u : 0u; mine = (j == x) ? c : mine; }
        if (sum == G) break;
        __builtin_amdgcn_s_sleep(1);
        if ((++sp & 255u) == 0u) { if (xb_ld(&bar[XB_TMO])) break; if (sp > XB_SPIN_CAP) { atomicAdd(&bar[XB_TMO], 1u); break; } }
    }
    nloc = mine > 0u ? mine : 1u; nx = cnt > 0u ? cnt : 1u;
}

__device__ __forceinline__ void xcd_barrier(const XcdBarrier& b) {
    asm volatile("s_waitcnt vmcnt(0)" ::: "memory");
    __syncthreads();
    if (threadIdx.x == 0) {
        unsigned* bar = b.bar;
        __builtin_amdgcn_s_waitcnt(0);
        unsigned nloc = b.st[0], nx = b.st[1];
        if (nloc == 0u) { xcd_barrier_complete(bar, b.x, nloc, nx); b.st[0] = nloc; b.st[1] = nx; }
        const unsigned old = xb_add(&bar[XB_XSUB(b.x)], 1u);
        const unsigned gen = old / nloc;
        if (old + 1u == (gen + 1u) * nloc) {
            __builtin_amdgcn_fence(__ATOMIC_RELEASE, "agent");
            asm volatile("s_waitcnt vmcnt(0)" ::: "memory");
            const unsigned og = xb_add(&bar[XB_TOP], 1u);
            const unsigned tg = og / nx;
            if (og + 1u == (tg + 1u) * nx) xb_add(&bar[XB_TOPGEN], 1u);
            else XB_SPIN(xb_ld(&bar[XB_TOPGEN]) == tg, bar);
            __builtin_amdgcn_fence(__ATOMIC_ACQUIRE, "agent");
            xb_add(&bar[XB_XGEN(b.x)], 1u);
            asm volatile("s_waitcnt vmcnt(0)" ::: "memory");
        } else {
            XB_SPIN(xb_ld(&bar[XB_XGEN(b.x)]) == gen, bar);
            __builtin_amdgcn_fence(__ATOMIC_ACQUIRE, "agent");
            asm volatile("s_waitcnt vmcnt(0)" ::: "memory");
        }
    }
    __syncthreads();
}

__device__ __forceinline__ float bf2f(unsigned b) { return __uint_as_float((b & 0xffffu) << 16); }
__device__ __forceinline__ unsigned f2bf(float f) { unsigned u = __float_as_uint(f); return (u + 0x7fffu + ((u >> 16) & 1u)) >> 16; }
typedef __bf16 bf16x2n __attribute__((ext_vector_type(2)));
typedef float f32x2n __attribute__((ext_vector_type(2)));
__device__ __forceinline__ unsigned pk2(float lo, float hi) { const f32x2n v = {lo, hi}; return __builtin_bit_cast(unsigned, __builtin_convertvector(v, bf16x2n)); }
constexpr float W_SCALE = 256.0f, XS_SCALE = 8.0f, ACT_SCALE = 4.0f, YB_SCALE = 16.0f;
__device__ __forceinline__ float clamp_fp8(float x) { return __builtin_amdgcn_fmed3f(x, -448.0f, 448.0f); }
__device__ __forceinline__ unsigned pk4_fp8(float a, float b, float c, float d) {
    int w = 0; w = __builtin_amdgcn_cvt_pk_fp8_f32(clamp_fp8(a), clamp_fp8(b), w, false); w = __builtin_amdgcn_cvt_pk_fp8_f32(clamp_fp8(c), clamp_fp8(d), w, true); return (unsigned)w; }
__device__ __forceinline__ unsigned pk4_fp8_nc(float a, float b, float c, float d) {
    int w = 0; w = __builtin_amdgcn_cvt_pk_fp8_f32(a, b, w, false); w = __builtin_amdgcn_cvt_pk_fp8_f32(c, d, w, true); return (unsigned)w; }
__device__ __forceinline__ float wave_sum(float v) {
#pragma unroll
    for (int o = 1; o < 64; o <<= 1) v += __shfl_xor(v, o);
    return v;
}
__device__ __forceinline__ float wave_max(float v) {
#pragma unroll
    for (int o = 1; o < 64; o <<= 1) v = fmaxf(v, __shfl_xor(v, o));
    return v;
}
__device__ __forceinline__ float sigmoidf_(float x) { return 1.0f / (1.0f + __expf(-x)); }
__device__ __forceinline__ float fast_sigmoid(float x) { return __builtin_amdgcn_rcpf(1.0f + __builtin_amdgcn_exp2f(-1.4426950408889634f * x)); }
__device__ __forceinline__ float fast_gelu_tanh(float x) { const float u2 = 1.5957691216057308f * (x + 0.044715f * x * x * x); return x * __builtin_amdgcn_rcpf(1.0f + __builtin_amdgcn_exp2f(-1.4426950408889634f * u2)); }
__device__ __forceinline__ float gelu_tanh(float x) { const float u = 0.7978845608028654f * (x + 0.044715f * x * x * x); return 0.5f * x * (1.0f + tanhf(u)); }
__device__ __forceinline__ int tok_row(int b, int t) { return t < NMETA ? METAROW0 + t : b * SEQ + (t - NMETA); }

__device__ __forceinline__ void transpose_item(const float* W, int K, int N, bf16* WT, LAS float* scr, int item, int lane) {
    const int nblk = N / 32, kb = item / nblk, nb = item % nblk, k0 = 64 * kb, n0 = 32 * nb;
#pragma unroll 8
    for (int i = 0; i < 32; ++i) { const int kk = 2 * i + (lane >> 5); scr[kk * 33 + (lane & 31)] = W[(size_t)(k0 + kk) * N + n0 + (lane & 31)]; }
    asm volatile("s_waitcnt lgkmcnt(0)" ::: "memory");
    const int c = lane & 7;
#pragma unroll
    for (int j = 0; j < 4; ++j) { const int n = (lane >> 3) + 8 * j; const LAS float* s = scr + (8 * c) * 33 + n;
        u32x4 o; o.x = pk2(s[0 * 33], s[1 * 33]); o.y = pk2(s[2 * 33], s[3 * 33]); o.z = pk2(s[4 * 33], s[5 * 33]); o.w = pk2(s[6 * 33], s[7 * 33]);
        *(u32x4*)(WT + (size_t)(n0 + n) * K + k0 + 8 * c) = o; }
    asm volatile("s_waitcnt lgkmcnt(0)" ::: "memory");
}

#define G1_CONV_WG 24
#define G1_CONV_PER_WG 43
constexpr int CONV_ALL_TILES = (2 + (BG_WDOWN ? 0 : 1)) * 32 * (D / 128) * (D / 256);
__device__ __forceinline__ int g1_conv_wg() { return gridDim.x == 256 ? G1_CONV_WG : 0; }
__device__ __forceinline__ int conv_pro_tiles() { return CONV_ALL_TILES - g1_conv_wg() * G1_CONV_PER_WG; }
__device__ __forceinline__ void conv_tiles(const Args& a, LAS unsigned char* lds, int tid, int first, int last, int stride) {
    unsigned char* ws = a.ws;
    __syncthreads();
    {
        LAS unsigned* T = (LAS unsigned*)lds;
        const int n4 = tid & 63, kq = tid >> 6;
        constexpr int T_IN = G1_FP8 ? (D / 128) * (DIN / 256) : 0, T_OUT = G2_FP8 ? (D / 128) * (D / 256) : 0, T_E = (D / 128) * (D / 256);
        constexpr int N_GATE = 32 * T_E, N_UP = (BG_WUP && !BG_EXP) ? 256 * 6 : 32 * T_E, N_DOWN = (BG_WDOWN && !BG_EXP) ? 0 : 32 * T_E;
        constexpr int NTILES = T_IN + T_OUT + N_GATE + N_UP + N_DOWN;
        static_assert(NTILES == CONV_ALL_TILES, "tile list size");
        auto tile_ptrs = [&](int tile, const float*& sp, unsigned char*& dp, int& ldn) {
            const float* sbase; unsigned char* dbase; int tl, nt;
            if (tile < T_IN) { sbase = a.in[I_W_IN]; dbase = ws + WS_WINT; tl = tile; nt = DIN / 256; ldn = DIN; }
            else if (tile < T_IN + T_OUT) { sbase = a.in[I_W_OUT]; dbase = ws + WS_WOUTT; tl = tile - T_IN; nt = D / 256; ldn = D; }
            else { int r = tile - T_IN - T_OUT, which, e; nt = D / 256; ldn = D;
                   if (r < N_GATE) { which = 0; e = r / T_E; tl = r % T_E; }
                   else if (r < N_GATE + N_UP) { r -= N_GATE; which = 1; int g = r; if (BG_WUP && !BG_EXP) g = 16 * (r / 6) + 10 + (r % 6);
                                                 e = g / T_E; tl = g % T_E; }
                   else { r -= N_GATE + N_UP; which = 2; e = r / T_E; tl = r % T_E; }
                   sbase = a.in[which == 0 ? I_W_GATE : (which == 1 ? I_W_UP : I_W_DOWN)] + (size_t)e * D * D; dbase = ws + (which == 0 ? WS_WGT : (which == 1 ? WS_WUT : WS_WDT)) + (size_t)e * D * D; }
            const int k0 = (tl / nt) * 128, n0 = (tl % nt) * 256;
            sp = sbase + (size_t)(k0 + 4 * kq) * ldn + n0 + 4 * n4; dp = dbase + (size_t)n0 * D + k0; };
#define CONV_LOAD(R, tile) do { const float* _p; unsigned char* _d; int _ld; tile_ptrs(tile, _p, _d, _ld); _Pragma("unroll") for (int i = 0; i < 4; ++i) _Pragma("unroll") for (int q = 0; q < 4; ++q) \
            R[i][q] = __builtin_nontemporal_load((const f32x4*)(_p + (size_t)(32 * i + q) * _ld)); } while (0)
#define CONV_STORE(R, tile) do { _Pragma("unroll") for (int i = 0; i < 4; ++i) { const int kd = kq + 8 * i; \
            T[(4 * n4 + 0) * 33 + kd] = pk4_fp8(R[i][0].x * W_SCALE, R[i][1].x * W_SCALE, R[i][2].x * W_SCALE, R[i][3].x * W_SCALE); \
            T[(4 * n4 + 1) * 33 + kd] = pk4_fp8(R[i][0].y * W_SCALE, R[i][1].y * W_SCALE, R[i][2].y * W_SCALE, R[i][3].y * W_SCALE); \
            T[(4 * n4 + 2) * 33 + kd] = pk4_fp8(R[i][0].z * W_SCALE, R[i][1].z * W_SCALE, R[i][2].z * W_SCALE, R[i][3].z * W_SCALE); \
            T[(4 * n4 + 3) * 33 + kd] = pk4_fp8(R[i][0].w * W_SCALE, R[i][1].w * W_SCALE, R[i][2].w * W_SCALE, R[i][3].w * W_SCALE); } \
            __syncthreads(); \
            { const float* _p; unsigned char* _d; int _ld; tile_ptrs(tile, _p, _d, _ld); _Pragma("unroll") for (int i = 0; i < 4; ++i) { const int n = (tid >> 3) + 64 * i, c = tid & 7; \
                const u32x4 o = (u32x4){T[n * 33 + 4 * c], T[n * 33 + 4 * c + 1], T[n * 33 + 4 * c + 2], T[n * 33 + 4 * c + 3]}; \
                *(u32x4*)(_d + (size_t)n * D + 16 * c) = o; } } \
            __syncthreads(); } while (0)
        f32x4 RA[4][4], RB[4][4];
        int tile = first;
        if (tile < last) CONV_LOAD(RA, tile);
        while (tile < last) {
            int nxt = tile + stride;
            if (nxt < last) CONV_LOAD(RB, nxt);
            CONV_STORE(RA, tile);
            tile = nxt; if (tile >= last) break;
            nxt = tile + stride;
            if (nxt < last) CONV_LOAD(RA, nxt);
            CONV_STORE(RB, tile);
            tile = nxt;
        }
#undef CONV_LOAD
#undef CONV_STORE
    }
}
__device__ __forceinline__ void phase_prologue(const Args& a, LAS unsigned char* lds, int tid, int lane, int wave) {
    const int gw = blockIdx.x * 8 + wave, NGW = gridDim.x * 8;
    const int gt = blockIdx.x * 512 + tid, NGT = gridDim.x * 512;
    unsigned char* ws = a.ws;
    LAS float* scr = (LAS float*)(lds + wave * 8704);
    {
        constexpr int IT_IN = G1_FP8 ? 0 : 32 * (DIN / 32), IT_OUT = G2_FP8 ? 0 : 32 * (D / 32);
        for (int it = gw; it < IT_IN + IT_OUT; it += NGW) {
            if (it < IT_IN) transpose_item(a.in[I_W_IN], D, DIN, (bf16*)(ws + WS_WINT), scr, it, lane);
            else transpose_item(a.in[I_W_OUT], D, D, (bf16*)(ws + WS_WOUTT), scr, it - IT_IN, lane);
        }
        __syncthreads();
    }
    conv_tiles(a, lds, tid, blockIdx.x, conv_pro_tiles(), gridDim.x);
    static_assert(!G1_FP8, "n1 is written as bf16");
    for (int r = gw; r < MROWS; r += NGW) {
        u32x4* orow = (u32x4*)((bf16*)(ws + WS_N1) + (size_t)r * D);
        if (r >= MVALID) {
#pragma unroll
            for (int j = 0; j < 4; ++j) orow[lane + 64 * j] = (u32x4){0u, 0u, 0u, 0u};
            continue; }
        const f32x4* xr = (const f32x4*)(r < MREAL ? a.in[I_X] + (size_t)r * D : a.in[I_META] + (size_t)(r - MREAL) * D);
        f32x4 v[4][2]; float ss = 0.f;
#pragma unroll
        for (int j = 0; j < 4; ++j)
#pragma unroll
            for (int q = 0; q < 2; ++q) { v[j][q] = xr[2 * (lane + 64 * j) + q]; ss += (v[j][q].x * v[j][q].x + v[j][q].y * v[j][q].y) + (v[j][q].z * v[j][q].z + v[j][q].w * v[j][q].w); }
        ss = wave_sum(ss);
        const float rstd = 1.0f / sqrtf(ss * (1.0f / D) + EPS);
#pragma unroll
        for (int j = 0; j < 4; ++j) { const f32x4 g0 = ((const f32x4*)a.in[I_NORM_MIX])[2 * (lane + 64 * j)], g1 = ((const f32x4*)a.in[I_NORM_MIX])[2 * (lane + 64 * j) + 1];
            orow[lane + 64 * j] = (u32x4){pk2(v[j][0].x * rstd * g0.x, v[j][0].y * rstd * g0.y), pk2(v[j][0].z * rstd * g0.z, v[j][0].w * rstd * g0.w),
                                          pk2(v[j][1].x * rstd * g1.x, v[j][1].y * rstd * g1.y), pk2(v[j][1].z * rstd * g1.z, v[j][1].w * rstd * g1.w)}; }
    }
    float* cosT = (float*)(ws + WS_COS); float* sinT = (float*)(ws + WS_SIN);
    for (int i = gt; i < TT * 32; i += NGT) {
        const int pos = i >> 5, j = i & 31;
        const float ang = (float)pos * c_inv_freq[j];
        const double t = (double)ang * 0.15915494309189535; const float fr = (float)(t - floor(t));
        cosT[i] = __builtin_amdgcn_cosf(fr); sinT[i] = __builtin_amdgcn_sinf(fr);
    }
    { bf16* WaT = (bf16*)(ws + WS_WAT); bf16* WiT = (bf16*)(ws + WS_WIT);
      for (int i = gt; i < 16 * 64 * 64; i += NGT) { const int n = i >> 12, d = (i >> 6) & 63, cc = i & 63;
          WaT[i] = (bf16)f2bf(a.in[I_W_A][(n * 64 + cc) * 64 + d]); WiT[i] = (bf16)f2bf(a.in[I_W_I][(n * 64 + cc) * 64 + d]); } }
    { bf16* WRT = (bf16*)(ws + WS_WRT);
      for (int i = gt; i < NEXP * D; i += NGT) { const int e = i >> 11, k = i & 2047; WRT[i] = (bf16)f2bf(a.in[I_NORM_FFN][k] * a.in[I_W_ROUTER][k * NEXP + e]); } }
    int* rowpair = (int*)(ws + WS_ROWPAIR);
    for (int i = gt; i < PROWS; i += NGT) rowpair[i] = -1;
}

namespace pg8 {
constexpr int BM = 256, BK = 64, HALF = 128, HTB = HALF * BK * 2, STAGE_BYTES = 8 * HTB, NXCD = 8, WGM = 8, KD = 2048, NKT = KD / BK;
__host__ __device__ __forceinline__ int lds_byte(int r, int c) { const int st = (r >> 4) * 2 + (c >> 5), rr = r & 15, cc = c & 31, ob = rr * 64 + cc * 2; return st * 1024 + (ob ^ (((ob >> 9) & 1) << 5)); }
__host__ __device__ __forceinline__ void stage_rc(int b, int& R, int& C) { const int st = b / 1024, sb = b % 1024, swz = sb ^ (((sb >> 9) & 1) << 5); R = (st >> 1) * 16 + swz / 64; C = (st & 1) * 32 + (swz % 64) / 2; }
__host__ __device__ __forceinline__ int perm32(int rho) { const int n = rho >> 4, i = rho & 15; return 8 * (i >> 2) + 4 * n + (i & 3); }
struct Unit { unsigned a, b0, b1; int pm, pn, e; };
__device__ __forceinline__ bool static_tile(int i, int G, int c, int nM, int nN, int& pm, int& pn) {
    const int nwg = nM * nN; const long L = (long)i * G + c; if (L >= nwg) return false;
    int wgid = (int)L; { const int q = nwg >> 3, r = nwg & 7, xcd = wgid & 7, off = wgid >> 3; wgid = (xcd < r ? xcd * (q + 1) : r * (q + 1) + (xcd - r) * q) + off; }
    const int nig = WGM * nN; int gid, rem;
    if ((nN & (nN - 1)) == 0) { const int sh = 3 + (31 - __builtin_clz(nN)); gid = wgid >> sh; rem = wgid & (nig - 1); } else { gid = wgid / nig; rem = wgid - gid * nig; }
    const int fm = gid * WGM, gsz = (nM - fm) < WGM ? (nM - fm) : WGM;
    if (gsz == WGM) { pm = fm + (rem & 7); pn = rem >> 3; } else { pm = fm + rem % gsz; pn = rem / gsz; }
    return true;
}

typedef int i32x8 __attribute__((ext_vector_type(8)));
typedef int i32x4 __attribute__((ext_vector_type(4)));
__device__ __forceinline__ i32x8 cat8(bf16x8 lo, bf16x8 hi) { const i32x4 a = __builtin_bit_cast(i32x4, lo), b = __builtin_bit_cast(i32x4, hi); return __builtin_shufflevector(a, b, 0, 1, 2, 3, 4, 5, 6, 7); }
struct BGNone { static constexpr bool ON = false; };
struct BGConv { static constexpr bool ON = true; const char* src; unsigned char* dst; int next, end; unsigned char* dummy; };
__device__ __forceinline__ void bg_pair_ptrs(const BGConv& bg, int pair, const char*& sp, unsigned char*& dp) {
    const int e = pair >> 10, kbp = (pair >> 6) & 15, nb = pair & 63;
    sp = bg.src + ((size_t)(e * 2048 + 128 * kbp) * 2048 + 32 * nb) * 4; dp = bg.dst + (size_t)e * 2048 * 2048 + (size_t)(32 * nb) * 2048 + 128 * kbp; }
template <bool FP8, class Epi, class Sched, class BG, bool GATHER = false>
__device__ __forceinline__ void gemm_phase(LAS unsigned char* lds, const Sched& S, const Epi& E, BG& bg) {
    constexpr int ROWB = FP8 ? 2048 : 4096, NKTL = ROWB / 128;
    const int tid = threadIdx.x, wid = __builtin_amdgcn_readfirstlane(tid >> 6), lane = tid & 63, wr = wid >> 2, wc = wid & 3, fr = lane & 15, fq = lane >> 4;
    unsigned voffA[2], voffB[2];
#pragma unroll
    for (int i = 0; i < 2; ++i) { int R, C; stage_rc(tid * 16 + i * 8192, R, C); const int Rb = Epi::PERM ? ((R & ~31) + perm32(R & 31)) : R;
        voffA[i] = (unsigned)(R * ROWB + C * 2); voffB[i] = (unsigned)(Rb * ROWB + C * 2); }
    constexpr unsigned KS = BK * 2, HS = HALF * ROWB;
    const unsigned ldsw = (unsigned)wid * 1024u;
    const __amdgpu_buffer_rsrc_t rsA = __builtin_amdgcn_make_buffer_rsrc((void*)S.A, 0, 0x7ffffff0, 0x00020000), rsB0 = __builtin_amdgcn_make_buffer_rsrc((void*)S.B0, 0, 0x7ffffff0, 0x00020000), rsB1 = __builtin_amdgcn_make_buffer_rsrc((void*)S.B1, 0, 0x7ffffff0, 0x00020000);
    const int aoff = lds_byte(wr * 64 + fr, fq * 8), boff = lds_byte(wc * 32 + fr, fq * 8);
#define PG8_SA(b, h) (((b) * 2 + (h)) * HTB)
#define PG8_SB(b, h) ((4 + (b) * 2 + (h)) * HTB)
#define PG8_STAGE(bufoff, rs, soff, voff) do { _Pragma("unroll") for (int _i = 0; _i < 2; ++_i) \
        __builtin_amdgcn_raw_ptr_buffer_load_lds(rs, (LAS void*)(lds + (bufoff) + ldsw + _i * 8192), 16, (int)(voff)[_i], (int)(soff), 0, 0); } while (0)
    unsigned gA[2][2] = {{0u, 0u}, {0u, 0u}}, gN[2][2] = {{0u, 0u}, {0u, 0u}};
#define PG8_GOFF(dst, slot) do { int tz_ = threadIdx.x; asm volatile("" : "+v"(tz_)); _Pragma("unroll") for (int _i = 0; _i < 2; ++_i) { int R_, C_; stage_rc(tz_ * 16 + _i * 8192, R_, C_); \
        _Pragma("unroll") for (int _h = 0; _h < 2; ++_h) { const int id_ = *(const LAS int*)(lds + LDS_RID + (slot) * 1024 + (_h * 128 + R_) * 4); dst[_h][_i] = (unsigned)((id_ < 0 ? 0 : (id_ >> 2)) * ROWB + C_ * 2); } } } while (0)
#define PG8_STAGEA(bufoff, h, soff_dense, koff, nx) do { if constexpr (GATHER) { unsigned v_[2]; v_[0] = (nx) ? gN[h][0] : gA[h][0]; v_[1] = (nx) ? gN[h][1] : gA[h][1]; PG8_STAGE(bufoff, rsA, koff, v_); } \
        else PG8_STAGE(bufoff, rsA, (soff_dense) + (h) * HS, voffA); } while (0)
#define PG8_LDA(dst, b, h) do { _Pragma("unroll") for (int m = 0; m < 4; ++m) { \
        if constexpr (FP8) dst##8[m] = __builtin_shufflevector(*(const LAS i32x4*)(lds + PG8_SA(b, h) + aoff + m * 2048), *(const LAS i32x4*)(lds + PG8_SA(b, h) + aoff + m * 2048 + 1024), 0, 1, 2, 3, 4, 5, 6, 7); \
        else { _Pragma("unroll") for (int k = 0; k < 2; ++k) dst[m][k] = *(const LAS bf16x8*)(lds + PG8_SA(b, h) + aoff + m * 2048 + k * 1024); } } } while (0)
#define PG8_LDB(dst, b, h) do { _Pragma("unroll") for (int n = 0; n < 2; ++n) { \
        if constexpr (FP8) dst##8[n] = __builtin_shufflevector(*(const LAS i32x4*)(lds + PG8_SB(b, h) + boff + n * 2048), *(const LAS i32x4*)(lds + PG8_SB(b, h) + boff + n * 2048 + 1024), 0, 1, 2, 3, 4, 5, 6, 7); \
        else { _Pragma("unroll") for (int k = 0; k < 2; ++k) dst[n][k] = *(const LAS bf16x8*)(lds + PG8_SB(b, h) + boff + n * 2048 + k * 1024); } } } while (0)
#define PG8_MMA(ai, bj, At, Bt) do { _Pragma("unroll") for (int m = 0; m < 4; ++m) _Pragma("unroll") for (int n = 0; n < 2; ++n) { \
        if constexpr (FP8) asm volatile("v_mfma_f32_16x16x128_f8f6f4 %0, %1, %2, %0" : "+v"(acc[ai][bj][m][n]) : "v"(Bt##8[n]), "v"(At##8[m])); \
        else { _Pragma("unroll") for (int k = 0; k < 2; ++k) asm volatile("v_mfma_f32_16x16x32_bf16 %0, %1, %2, %0" : "+v"(acc[ai][bj][m][n]) : "v"(Bt[n][k]), "v"(At[m][k])); } } \
        } while (0)
#define PG8_WAIT_V(n) asm volatile("s_waitcnt vmcnt(" #n ")" ::: "memory")
#define PG8_WAIT_L(n) asm volatile("s_waitcnt lgkmcnt(" #n ")" ::: "memory")
#define PG8_BAR __builtin_amdgcn_s_barrier()
#define PG8_SCHED __builtin_amdgcn_sched_barrier(0)
    Unit cur, nxt; int ui = 0; bool bg_pending = false;
    if (!S.next(0, cur)) return;
    f32x4 acc[2][2][4][2];
#pragma unroll
    for (int a = 0; a < 2; ++a)
#pragma unroll
        for (int b = 0; b < 2; ++b)
#pragma unroll
            for (int m = 0; m < 4; ++m)
#pragma unroll
                for (int n = 0; n < 2; ++n) acc[a][b][m][n] = (f32x4){0.f, 0.f, 0.f, 0.f};
    bf16x8 At[4][2], B0[2][2], B1[2][2];
    i32x8 At8[4], B08[2], B18[2];
    if constexpr (GATHER) {
        if (tid < 256) *(LAS int*)(lds + LDS_RID + tid * 4) = S.rows[cur.pm * BM + tid];
        __syncthreads();
        PG8_GOFF(gA, 0);
    }
    PG8_STAGE(PG8_SB(0, 0), rsB0, cur.b0, voffB); PG8_STAGE(PG8_SB(0, 1), rsB1, cur.b1, voffB); PG8_STAGEA(PG8_SA(0, 0), 0, cur.a, 0u, false); PG8_STAGEA(PG8_SA(0, 1), 1, cur.a, 0u, false);
    if (wr == 1) PG8_BAR;
    PG8_WAIT_V(2); PG8_BAR;
    PG8_STAGE(PG8_SB(1, 0), rsB0, cur.b0 + KS, voffB); PG8_STAGEA(PG8_SA(1, 0), 0, cur.a + KS, KS, false); PG8_STAGE(PG8_SB(1, 1), rsB1, cur.b1 + KS, voffB);
    PG8_WAIT_V(6); PG8_BAR;
    for (;;) {
        const bool has_next = S.next(ui + 1, nxt);
        const unsigned nA = has_next ? nxt.a : cur.a, nB0 = has_next ? nxt.b0 : cur.b0, nB1 = has_next ? nxt.b1 : cur.b1;
        for (int t = 0; t < NKTL; t += 2) {
            const bool last = (t == NKTL - 2);
            const unsigned a1 = cur.a + (unsigned)(t + 1) * KS;
            const unsigned a2 = last ? nA : cur.a + (unsigned)(t + 2) * KS;
            const unsigned b20 = last ? nB0 : cur.b0 + (unsigned)(t + 2) * KS, b21 = last ? nB1 : cur.b1 + (unsigned)(t + 2) * KS;
            const unsigned a3 = a2 + KS, b30 = b20 + KS, b31 = b21 + KS;
            const unsigned k1 = (unsigned)(t + 1) * KS, k2 = last ? 0u : (unsigned)(t + 2) * KS;
            if constexpr (GATHER) { if (last) { if (has_next) PG8_GOFF(gN, (ui + 1) & 1); else { gN[0][0] = gA[0][0]; gN[0][1] = gA[0][1]; gN[1][0] = gA[1][0]; gN[1][1] = gA[1][1]; } } }
            PG8_LDB(B0, 0, 0); PG8_LDB(B1, 0, 1); PG8_SCHED; PG8_LDA(At, 0, 0); PG8_STAGEA(PG8_SA(1, 1), 1, a1, k1, false);
            if constexpr (GATHER) { if (t == 2 && has_next && wid == 3) __builtin_amdgcn_global_load_lds((const unsigned*)(S.rows + nxt.pm * BM + lane * 4), (LAS unsigned*)(lds + LDS_RID + ((ui + 1) & 1) * 1024), 16, 0, 0); }
            if (t == 2) E.prefetch(cur, lds, wid, lane);
            PG8_WAIT_V(8); PG8_WAIT_L(0); PG8_BAR; PG8_MMA(0, 0, At, B0);
            if constexpr (BG::ON) {
                PG8_SCHED;
                int tz = threadIdx.x; asm volatile("" : "+v"(tz));
#pragma unroll
                for (int j = 0; j < (BG_EXP == 1 ? 0 : 2); ++j) { const LAS float* p = (const LAS float*)(lds + LDS_BG + j * 8192 + (tz >> 5) * 512 + (tz & 31) * 4);
                    ((LAS unsigned*)(lds + LDS_T2))[(tz & 31) * 33 + 16 * j + (tz >> 5)] = pk4_fp8(p[0] * W_SCALE, p[32] * W_SCALE, p[64] * W_SCALE, p[96] * W_SCALE); }
                const char* bgs; { unsigned char* dp_; pg8::bg_pair_ptrs(bg, bg.next < bg.end ? bg.next : bg.end - 1, bgs, dp_); }
                PG8_SCHED;
                if (BG_EXP != 2) {
                const unsigned bgv = (unsigned)((8 * wid + ((tz & 63) >> 3)) * 8192 + (tz & 7) * 16);
                __builtin_amdgcn_global_load_lds((const unsigned*)(bgs + bgv), (LAS unsigned*)(lds + LDS_BG + ldsw), 16, 0, 0);
                __builtin_amdgcn_global_load_lds((const unsigned*)(bgs + 524288 + bgv), (LAS unsigned*)(lds + LDS_BG + 8192 + ldsw), 16, 0, 0); }
                PG8_SCHED; }
            PG8_MMA(0, 1, At, B1);
            if constexpr (BG::ON) { PG8_WAIT_L(0); }
            PG8_BAR; PG8_SCHED;
            PG8_LDA(At, 0, 1); PG8_STAGE(PG8_SB(0, 0), rsB0, b20, voffB); PG8_STAGE(PG8_SB(0, 1), rsB1, b21, voffB); PG8_STAGEA(PG8_SA(0, 0), 0, a2, k2, last);
            if constexpr (BG::ON) { if (BG_EXP == 2) PG8_WAIT_V(8); else PG8_WAIT_V(10); } else { PG8_WAIT_V(8); }
            PG8_WAIT_L(0); PG8_BAR; PG8_MMA(1, 0, At, B0);
            if constexpr (BG::ON) {
                PG8_SCHED;
                unsigned char* bgd; { const char* sp_; pg8::bg_pair_ptrs(bg, bg.next - 1 < bg.end ? bg.next - 1 : bg.end - 1, sp_, bgd); }
                int tz = threadIdx.x; asm volatile("" : "+v"(tz));
                const LAS unsigned* q = (const LAS unsigned*)(lds + LDS_T2) + (tz >> 4) * 33 + 2 * (tz & 15);
                const u32x2 w = (u32x2){q[0], q[1]};
                if (BG_EXP != 1) *(u32x2*)((bg_pending && !BG_EXP) ? bgd + (size_t)(tz >> 4) * 2048 + 8 * (tz & 15) : bg.dummy + 8 * tz) = w;
                ++bg.next; bg_pending = true;
                PG8_SCHED; }
            PG8_MMA(1, 1, At, B1); PG8_BAR; PG8_SCHED;
            PG8_LDB(B0, 1, 0); PG8_LDB(B1, 1, 1); PG8_SCHED; PG8_LDA(At, 1, 0); PG8_STAGEA(PG8_SA(0, 1), 1, a2, k2, last);
            if constexpr (BG::ON) { if (BG_EXP == 1) PG8_WAIT_V(10); else if (BG_EXP == 2) PG8_WAIT_V(9); else PG8_WAIT_V(11); } else { PG8_WAIT_V(8); }
            PG8_WAIT_L(0); PG8_BAR; PG8_MMA(0, 0, At, B0); PG8_MMA(0, 1, At, B1); PG8_BAR; PG8_SCHED;
            PG8_LDA(At, 1, 1); PG8_STAGE(PG8_SB(1, 0), rsB0, b30, voffB); PG8_STAGE(PG8_SB(1, 1), rsB1, b31, voffB); PG8_STAGEA(PG8_SA(1, 0), 0, a3, k2 + KS, last);
            if constexpr (BG::ON) { if (BG_EXP == 1) PG8_WAIT_V(8); else PG8_WAIT_V(9); } else { PG8_WAIT_V(8); }
            PG8_WAIT_L(0); PG8_BAR; PG8_MMA(1, 0, At, B0); PG8_MMA(1, 1, At, B1); PG8_BAR; PG8_SCHED;
        }
        if (wr == 0) PG8_BAR;
        asm volatile("s_nop 15\n\ts_nop 15" ::: "memory");
        E(acc, cur, wr, wc, fr, fq, lds);
        if (!has_next) break;
#pragma unroll
        for (int a = 0; a < 2; ++a)
#pragma unroll
            for (int b = 0; b < 2; ++b)
#pragma unroll
                for (int m = 0; m < 4; ++m)
#pragma unroll
                    for (int n = 0; n < 2; ++n) acc[a][b][m][n] = (f32x4){0.f, 0.f, 0.f, 0.f};
        cur = nxt; ++ui;
        if constexpr (GATHER) { gA[0][0] = gN[0][0]; gA[0][1] = gN[0][1]; gA[1][0] = gN[1][0]; gA[1][1] = gN[1][1]; }
        if (wr == 1) PG8_BAR;
    }
    PG8_WAIT_V(0);
    PG8_BAR;
    if constexpr (BG::ON) { if (bg_pending && !BG_EXP) {
        unsigned char* bgd; { const char* sp_; pg8::bg_pair_ptrs(bg, bg.next - 1 < bg.end ? bg.next - 1 : bg.end - 1, sp_, bgd); }
#pragma unroll
        for (int j = 0; j < 2; ++j) { const LAS float* p = (const LAS float*)(lds + LDS_BG + j * 8192 + (tid >> 5) * 512 + (tid & 31) * 4);
            ((LAS unsigned*)(lds + LDS_T2))[(tid & 31) * 33 + 16 * j + (tid >> 5)] = pk4_fp8(p[0] * W_SCALE, p[32] * W_SCALE, p[64] * W_SCALE, p[96] * W_SCALE); }
        __syncthreads();
        const LAS unsigned* q = (const LAS unsigned*)(lds + LDS_T2) + (tid >> 4) * 33 + 2 * (tid & 15);
        *(u32x2*)(bgd + (size_t)(tid >> 4) * 2048 + 8 * (tid & 15)) = (u32x2){q[0], q[1]}; } }
#undef PG8_SA
#undef PG8_SB
#undef PG8_STAGE
#undef PG8_STAGEA
#undef PG8_GOFF
#undef PG8_LDA
#undef PG8_LDB
#undef PG8_MMA
#undef PG8_WAIT_V
#undef PG8_WAIT_L
#undef PG8_BAR
#undef PG8_SCHED
}

struct SchedDense {
    const char* A; const char* B0; const char* B1; const int* rows; int nM, nN, G, c, rowb;
    __device__ __forceinline__ bool next(int i, Unit& u) const {
        int pm, pn; if (!static_tile(i, G, c, nM, nN, pm, pn)) return false;
        u.pm = pm; u.pn = pn; u.e = 0; u.a = (unsigned)pm * BM * rowb; u.b0 = (unsigned)pn * BM * rowb; u.b1 = u.b0 + (unsigned)HALF * rowb; return true;
    }
};
struct SchedMoE {
    const char* A; const char* B0; const char* B1; const int* rows; const LAS int* tstart; int nM, nN, G, c; bool split;
    __device__ __forceinline__ bool next(int i, Unit& u) const {
        int pm, pn; if (!static_tile(i, G, c, nM, nN, pm, pn)) return false;
        const int e = ((const LAS unsigned char*)(tstart + 64))[pm];
        u.pm = pm; u.pn = pn; u.e = e; u.a = (unsigned)pm * (BM * 2048);
        const unsigned eoff = (unsigned)e * (2048u * 2048u);
        if (split) { u.b0 = eoff + (unsigned)pn * (HALF * 2048); u.b1 = u.b0; }
        else { u.b0 = eoff + (unsigned)pn * (BM * 2048); u.b1 = u.b0 + (unsigned)HALF * 2048; }
        return true;
    }
};

__device__ __forceinline__ u32x4 widen16(u32x2 x, u32x2 y) {
    const auto r0 = __builtin_amdgcn_permlane16_swap(x.x, y.x, false, false), r1 = __builtin_amdgcn_permlane16_swap(x.y, y.y, false, false);
    return (u32x4){r0[0], r1[0], r0[1], r1[1]};
}
struct EpiZ {
    static constexpr bool PERM = true;
    bf16* Z; const float* bias; float sc;
    __device__ __forceinline__ void prefetch(const Unit&, LAS unsigned char*, int, int) const {}
    __device__ __forceinline__ void operator()(const f32x4 (&acc)[2][2][4][2], const Unit& u, int wr, int wc, int fr, int fq, const LAS unsigned char*) const {
        const int row0 = u.pm * BM + wr * 64 + fr, col0 = u.pn * BM + wc * 32 + 8 * fq;
        f32x4 bv[2][2];
#pragma unroll
        for (int bj = 0; bj < 2; ++bj)
#pragma unroll
            for (int n = 0; n < 2; ++n) bv[bj][n] = *(const f32x4*)(bias + col0 + bj * HALF + 4 * n);
#pragma unroll
        for (int ai = 0; ai < 2; ++ai)
#pragma unroll
            for (int m = 0; m < 4; ++m) { bf16* rowp = Z + (size_t)(row0 + ai * HALF + m * 16) * DIN + col0;
#pragma unroll
                for (int bj = 0; bj < 2; ++bj) { const f32x4 v0 = acc[ai][bj][m][0] * sc + bv[bj][0], v1 = acc[ai][bj][m][1] * sc + bv[bj][1];
                    u32x4 w; w.x = pk2(v0[0], v0[1]); w.y = pk2(v0[2], v0[3]); w.z = pk2(v1[0], v1[1]); w.w = pk2(v1[2], v1[3]);
                    *(u32x4*)(rowp + bj * HALF) = w; } }
    }
};
struct EpiH1 {
    static constexpr bool PERM = true;
    bf16* H1; const float* x; const float* bias; float sc;
    __device__ __forceinline__ void prefetch(const Unit&, LAS unsigned char*, int, int) const {}
    __device__ __forceinline__ void operator()(const f32x4 (&acc)[2][2][4][2], const Unit& u, int wr, int wc, int fr, int fq, const LAS unsigned char*) const {
        const int row0 = u.pm * BM + wr * 64 + fr, col0 = u.pn * BM + wc * 32 + 8 * fq;
        f32x4 bv[2][2];
#pragma unroll
        for (int bj = 0; bj < 2; ++bj)
#pragma unroll
            for (int n = 0; n < 2; ++n) bv[bj][n] = *(const f32x4*)(bias + col0 + bj * HALF + 4 * n);
#pragma unroll
        for (int ai = 0; ai < 2; ++ai) {
            f32x4 xv[4][2][2];
#pragma unroll
            for (int m = 0; m < 4; ++m) { const size_t ro = (size_t)(row0 + ai * HALF + m * 16) * D + col0;
#pragma unroll
                for (int bj = 0; bj < 2; ++bj) { xv[m][bj][0] = __builtin_nontemporal_load((const f32x4*)(x + ro + bj * HALF)); xv[m][bj][1] = __builtin_nontemporal_load((const f32x4*)(x + ro + bj * HALF + 4)); } }
#pragma unroll
            for (int m = 0; m < 4; ++m) { const size_t ro = (size_t)(row0 + ai * HALF + m * 16) * D + col0;
#pragma unroll
                for (int bj = 0; bj < 2; ++bj) { const f32x4 v0 = xv[m][bj][0] + acc[ai][bj][m][0] * sc + bv[bj][0], v1 = xv[m][bj][1] + acc[ai][bj][m][1] * sc + bv[bj][1];
                    u32x4 w; w.x = pk2(v0[0], v0[1]); w.y = pk2(v0[2], v0[3]); w.z = pk2(v1[0], v1[1]); w.w = pk2(v1[2], v1[3]);
                    *(u32x4*)(H1 + ro + bj * HALF) = w; } }
        }
    }
};
struct EpiAct {
    static constexpr bool PERM = true;
    unsigned char* ACT; const float* bg; const float* bu;
    __device__ __forceinline__ void prefetch(const Unit& u, LAS unsigned char* lds, int wid, int lane) const {
        if (wid == 0) { const float* p = (lane < 32 ? bg : bu) + (size_t)u.e * DFF + u.pn * HALF + (lane & 31) * 4;
            __builtin_amdgcn_global_load_lds((const unsigned*)p, (LAS unsigned*)(lds + LDS_META), 16, 0, 0); }
    }
    __device__ __forceinline__ void operator()(const f32x4 (&acc)[2][2][4][2], const Unit& u, int wr, int wc, int fr, int fq, const LAS unsigned char* lds) const {
        const int row0 = u.pm * BM + wr * 64 + fr, cl = wc * 32 + 8 * fq, col0 = u.pn * HALF + cl;
        f32x4 gv[2], uv[2];
#pragma unroll
        for (int n = 0; n < 2; ++n) { gv[n] = *(const LAS f32x4*)(lds + LDS_META + (cl + 4 * n) * 4); uv[n] = *(const LAS f32x4*)(lds + LDS_META + 512 + (cl + 4 * n) * 4); }
#pragma unroll
        for (int ai = 0; ai < 2; ++ai)
#pragma unroll
            for (int mp = 0; mp < 2; ++mp) { u32x2 pc[2];
#pragma unroll
                for (int mi = 0; mi < 2; ++mi) { const int m = 2 * mp + mi; float r[8];
#pragma unroll
                    for (int n = 0; n < 2; ++n)
#pragma unroll
                        for (int j = 0; j < 4; ++j) { float g = acc[ai][0][m][n][j] * (1.0f / (W_SCALE * XS_SCALE)) + gv[n][j], up = acc[ai][1][m][n][j] * (1.0f / (W_SCALE * XS_SCALE)) + uv[n][j];
                            g = fminf(g, 7.0f); up = fminf(fmaxf(up, -7.0f), 7.0f);
                            r[n * 4 + j] = g * __builtin_amdgcn_rcpf(1.0f + __builtin_amdgcn_exp2f((-1.702f * 1.4426950408889634f) * g)) * fmaf(up, ACT_SCALE, ACT_SCALE); }
                    pc[mi] = (u32x2){pk4_fp8_nc(r[0], r[1], r[2], r[3]), pk4_fp8_nc(r[4], r[5], r[6], r[7])}; }
                const u32x4 w = widen16(pc[0], pc[1]);
                const int m = 2 * mp + (fq & 1);
                *(u32x4*)(ACT + (size_t)(row0 + ai * HALF + m * 16) * DFF + col0 - 8 * (fq & 1)) = w; }
    }
};
struct EpiDown {
    static constexpr bool PERM = true;
    unsigned char* YB; const float* bd;
    __device__ __forceinline__ void prefetch(const Unit& u, LAS unsigned char* lds, int wid, int lane) const {
        if (wid == 0) __builtin_amdgcn_global_load_lds((const unsigned*)(bd + (size_t)u.e * D + u.pn * BM + lane * 4), (LAS unsigned*)(lds + LDS_META), 16, 0, 0);
    }
    __device__ __forceinline__ void operator()(const f32x4 (&acc)[2][2][4][2], const Unit& u, int wr, int wc, int fr, int fq, const LAS unsigned char* lds) const {
        const int row0 = u.pm * BM + wr * 64 + fr, cl = wc * 32 + 8 * fq, col0 = u.pn * BM + cl;
        f32x4 bv[2][2];
#pragma unroll
        for (int bj = 0; bj < 2; ++bj)
#pragma unroll
            for (int n = 0; n < 2; ++n) bv[bj][n] = *(const LAS f32x4*)(lds + LDS_META + (cl + bj * HALF + 4 * n) * 4) * YB_SCALE;
#pragma unroll
        for (int ai = 0; ai < 2; ++ai)
#pragma unroll
            for (int m = 0; m < 4; ++m) { u32x2 pc[2];
#pragma unroll
                for (int bj = 0; bj < 2; ++bj) { const f32x4 v0 = acc[ai][bj][m][0] * (YB_SCALE / (W_SCALE * ACT_SCALE)) + bv[bj][0], v1 = acc[ai][bj][m][1] * (YB_SCALE / (W_SCALE * ACT_SCALE)) + bv[bj][1];
                    pc[bj] = (u32x2){pk4_fp8(v0[0], v0[1], v0[2], v0[3]), pk4_fp8(v1[0], v1[1], v1[2], v1[3])}; }
                const u32x4 w = widen16(pc[0], pc[1]);
                *(u32x4*)(YB + (size_t)(row0 + ai * HALF + m * 16) * D + col0 + (fq & 1) * (HALF - 8)) = w; }
    }
};
}


typedef float f32x16 __attribute__((ext_vector_type(16)));
constexpr int AT_KS = 144, AT_VS = 584, AT_KOFF = 0, AT_VOFF = 288 * AT_KS;
__device__ __forceinline__ float bflo(unsigned w) { return __uint_as_float(w << 16); }
__device__ __forceinline__ float bfhi(unsigned w) { return __uint_as_float(w & 0xffff0000u); }

__device__ __forceinline__ void attn_tile(LAS unsigned char* lds, int slot_base, int kind, int j, int lane, int hq,
                                          const bf16x8 (&qf)[2][4], f32x16 (&oacc)[2][2], float (&mrow)[2], float (&lrow)[2]) {
    const int r31 = lane & 31, h = lane >> 5;
    bf16x8 kf[4], vf[2][2];
#pragma unroll
    for (int ks = 0; ks < 4; ++ks) kf[ks] = *(const LAS bf16x8*)(lds + AT_KOFF + (slot_base + r31) * AT_KS + (16 * ks + 8 * h) * 2);
#pragma unroll
    for (int dt = 0; dt < 2; ++dt)
#pragma unroll
        for (int sp = 0; sp < 2; ++sp) { const LAS unsigned char* p = lds + AT_VOFF + (32 * dt + r31) * AT_VS + (slot_base + 16 * sp + 4 * h) * 2;
            const u32x2 lo = *(const LAS u32x2*)p, hi = *(const LAS u32x2*)(p + 16);
            const u32x4 w = (u32x4){lo.x, lo.y, hi.x, hi.y}; vf[dt][sp] = __builtin_bit_cast(bf16x8, w); }
#pragma unroll
    for (int qt = 0; qt < 2; ++qt) {
        f32x16 s;
#pragma unroll
        for (int r = 0; r < 16; ++r) s[r] = 0.f;
#pragma unroll
        for (int ks = 0; ks < 4; ++ks) s = __builtin_amdgcn_mfma_f32_32x32x16_bf16(kf[ks], qf[qt][ks], s, 0, 0, 0);
        const int i = 64 * hq + 32 * qt + r31;
        float mx = -1.0e30f;
#pragma unroll
        for (int r = 0; r < 16; ++r) { const int key = (r & 3) + 8 * (r >> 2) + 4 * h;
            const bool ok = kind == 0 ? (key < 16) : (kind == 1 ? (32 * j + key >= i + 1) : (32 * j + key <= i));
            s[r] = ok ? s[r] : -1.0e30f; mx = fmaxf(mx, s[r]); }
        mx = fmaxf(mx, __shfl_xor(mx, 32));
        const float mn = fmaxf(mrow[qt], mx), al = __expf(mrow[qt] - mn); mrow[qt] = mn;
        float ps = 0.f;
#pragma unroll
        for (int r = 0; r < 16; ++r) { s[r] = __expf(s[r] - mn); ps += s[r]; }
        lrow[qt] = lrow[qt] * al + ps;
#pragma unroll
        for (int dt = 0; dt < 2; ++dt)
#pragma unroll
            for (int r = 0; r < 16; ++r) oacc[qt][dt][r] *= al;
        bf16x8 pf[2];
#pragma unroll
        for (int sp = 0; sp < 2; ++sp) { const u32x4 w = (u32x4){pk2(s[8 * sp + 0], s[8 * sp + 1]), pk2(s[8 * sp + 2], s[8 * sp + 3]), pk2(s[8 * sp + 4], s[8 * sp + 5]), pk2(s[8 * sp + 6], s[8 * sp + 7])};
            pf[sp] = __builtin_bit_cast(bf16x8, w); }
#pragma unroll
        for (int dt = 0; dt < 2; ++dt)
#pragma unroll
            for (int sp = 0; sp < 2; ++sp) oacc[qt][dt] = __builtin_amdgcn_mfma_f32_32x32x16_bf16(vf[dt][sp], pf[sp], oacc[qt][dt], 0, 0, 0);
    }
}

__device__ __forceinline__ void attn_item(const Args& a, LAS unsigned char* lds, int item, int tid, int lane, int wave) {
    const int kvh = item & 3, qblk = (item >> 2) & 15, b = item >> 6;
    const bf16* Z = (const bf16*)(a.ws + WS_Z); bf16* O = (bf16*)(a.ws + (G2_FP8 ? WS_ATT : WS_O)); constexpr int OLD = G2_FP8 ? 1024 : D;
    const float* cosT = (const float*)(a.ws + WS_COS); const float* sinT = (const float*)(a.ws + WS_SIN);
    __syncthreads();
    for (int task = tid; task < 288 * 4; task += 512) {
        const int slot = task >> 2, c = task & 3;
        int krow, kpos; bool valid;
        if (slot < 32) { valid = slot < NMETA; krow = METAROW0 + slot; kpos = slot; }
        else { const int sp = 128 * (qblk - 1) + (slot - 32); valid = sp >= 0; krow = b * SEQ + sp; kpos = NMETA + sp; }
        u32x4 lo = (u32x4){0u, 0u, 0u, 0u}, hi = lo;
        if (valid) {
            const bf16* kp = Z + (size_t)krow * DIN + ZK + kvh * 64 + c * 8;
            const u32x4 x1 = *(const u32x4*)kp, x2 = *(const u32x4*)(kp + 32);
            const f32x4 c0 = *(const f32x4*)(cosT + kpos * 32 + c * 8), c1 = *(const f32x4*)(cosT + kpos * 32 + c * 8 + 4);
            const f32x4 s0 = *(const f32x4*)(sinT + kpos * 32 + c * 8), s1 = *(const f32x4*)(sinT + kpos * 32 + c * 8 + 4);
#pragma unroll
            for (int q = 0; q < 4; ++q) { const float ca = q < 2 ? c0[2 * q] : c1[2 * q - 4], cb = q < 2 ? c0[2 * q + 1] : c1[2 * q - 3], sa = q < 2 ? s0[2 * q] : s1[2 * q - 4], sb = q < 2 ? s0[2 * q + 1] : s1[2 * q - 3];
                const float a0 = bflo(x1[q]), a1 = bfhi(x1[q]), b0 = bflo(x2[q]), b1 = bfhi(x2[q]);
                lo[q] = pk2(a0 * ca - b0 * sa, a1 * cb - b1 * sb); hi[q] = pk2(b0 * ca + a0 * sa, b1 * cb + a1 * sb); }
        }
        *(LAS u32x4*)(lds + AT_KOFF + slot * AT_KS + c * 16) = lo; *(LAS u32x4*)(lds + AT_KOFF + slot * AT_KS + 64 + c * 16) = hi;
    }
    for (int task = tid; task < 144 * 8; task += 512) {
        const int slot0 = (task >> 3) * 2, c = task & 7;
        int vrow; bool valid;
        if (slot0 < 32) { valid = slot0 < NMETA; vrow = METAROW0 + slot0; }
        else { const int sp = 128 * (qblk - 1) + (slot0 - 32); valid = sp >= 0; vrow = b * SEQ + sp; }
        u32x4 v0 = (u32x4){0u, 0u, 0u, 0u}, v1 = v0;
        if (valid) { const bf16* vp = Z + (size_t)vrow * DIN + ZV + kvh * 64 + c * 8; v0 = *(const u32x4*)vp; v1 = *(const u32x4*)(vp + DIN); }
#pragma unroll
        for (int q = 0; q < 4; ++q) {
            *(LAS unsigned*)(lds + AT_VOFF + (c * 8 + 2 * q) * AT_VS + slot0 * 2) = (v0[q] & 0xffffu) | (v1[q] << 16);
            *(LAS unsigned*)(lds + AT_VOFF + (c * 8 + 2 * q + 1) * AT_VS + slot0 * 2) = (v0[q] >> 16) | (v1[q] & 0xffff0000u); }
    }
    const int g = wave >> 1, hq = wave & 1, head = kvh * 4 + g, r31 = lane & 31, h = lane >> 5;
    bf16x8 qf[2][4];
#pragma unroll
    for (int qt = 0; qt < 2; ++qt) {
        const int s = 128 * qblk + 64 * hq + 32 * qt + r31, pos = NMETA + s;
        const bf16* qp = Z + (size_t)(b * SEQ + s) * DIN + ZQ + head * 64 + 8 * h;
        u32x4 x[4];
#pragma unroll
        for (int ks = 0; ks < 4; ++ks) x[ks] = *(const u32x4*)(qp + 16 * ks);
#pragma unroll
        for (int ks = 0; ks < 2; ++ks) {
            const float* cp = cosT + pos * 32 + 16 * ks + 8 * h; const float* sp = sinT + pos * 32 + 16 * ks + 8 * h;
            const f32x4 c0 = *(const f32x4*)cp, c1 = *(const f32x4*)(cp + 4), s0 = *(const f32x4*)sp, s1 = *(const f32x4*)(sp + 4);
            u32x4 lo, hi;
#pragma unroll
            for (int q = 0; q < 4; ++q) { const float ca = q < 2 ? c0[2 * q] : c1[2 * q - 4], cb = q < 2 ? c0[2 * q + 1] : c1[2 * q - 3], sa = q < 2 ? s0[2 * q] : s1[2 * q - 4], sb = q < 2 ? s0[2 * q + 1] : s1[2 * q - 3];
                const float a0 = bflo(x[ks][q]), a1 = bfhi(x[ks][q]), b0 = bflo(x[ks + 2][q]), b1 = bfhi(x[ks + 2][q]);
                lo[q] = pk2(0.125f * (a0 * ca - b0 * sa), 0.125f * (a1 * cb - b1 * sb)); hi[q] = pk2(0.125f * (b0 * ca + a0 * sa), 0.125f * (b1 * cb + a1 * sb)); }
            qf[qt][ks] = __builtin_bit_cast(bf16x8, lo); qf[qt][ks + 2] = __builtin_bit_cast(bf16x8, hi);
        }
    }
    f32x16 oacc[2][2]; float mrow[2], lrow[2];
#pragma unroll
    for (int qt = 0; qt < 2; ++qt) { mrow[qt] = a.in[I_SINKS][head]; lrow[qt] = h == 0 ? 1.0f : 0.0f;
#pragma unroll
        for (int dt = 0; dt < 2; ++dt)
#pragma unroll
            for (int r = 0; r < 16; ++r) oacc[qt][dt][r] = 0.f; }
    __syncthreads();
    attn_tile(lds, 0, 0, 0, lane, hq, qf, oacc, mrow, lrow);
    if (qblk > 0) {
#pragma unroll 1
        for (int j = hq ? 2 : 0; j < 4; ++j) attn_tile(lds, 32 + 32 * j, 1, j, lane, hq, qf, oacc, mrow, lrow);
    }
#pragma unroll 1
    for (int j = 0; j < (hq ? 4 : 2); ++j) attn_tile(lds, 160 + 32 * j, 2, j, lane, hq, qf, oacc, mrow, lrow);
#pragma unroll
    for (int qt = 0; qt < 2; ++qt) {
        const float lt = lrow[qt] + __shfl_xor(lrow[qt], 32), inv = 1.0f / lt;
        bf16* op = O + (size_t)(b * SEQ + 128 * qblk + 64 * hq + 32 * qt + r31) * OLD + head * 64 + 4 * h;
#pragma unroll
        for (int dt = 0; dt < 2; ++dt)
#pragma unroll
            for (int rr = 0; rr < 4; ++rr)
                *(u32x2*)(op + 32 * dt + 8 * rr) = (u32x2){pk2(oacc[qt][dt][4 * rr] * inv, oacc[qt][dt][4 * rr + 1] * inv), pk2(oacc[qt][dt][4 * rr + 2] * inv, oacc[qt][dt][4 * rr + 3] * inv)};
    }
}

constexpr int LR_XS = 2064;
__device__ __forceinline__ void lru_norm_rows(const Args& a, LAS unsigned char* lds, int b, int c, int lane, int wave) {
        bf16* O = (bf16*)(a.ws + WS_O); unsigned char* O8 = a.ws + WS_O;
        const bf16* ATT = (const bf16*)(a.ws + (G2_FP8 ? WS_ATT : WS_O)); constexpr int ALD = G2_FP8 ? 1024 : D;
        u32x4 aw[4][2];
#pragma unroll
        for (int q = 0; q < 4; ++q)
#pragma unroll
            for (int jj = 0; jj < 2; ++jj) aw[q][jj] = *(const u32x4*)(ATT + ((size_t)b * SEQ + 32 * c + 4 * wave + q) * ALD + (lane + 64 * jj) * 8);
        f32x4 ga[2][2], gl[2][2];
#pragma unroll
        for (int jj = 0; jj < 2; ++jj) { ga[jj][0] = *(const f32x4*)(a.in[I_G_ATTN] + (lane + 64 * jj) * 8); ga[jj][1] = *(const f32x4*)(a.in[I_G_ATTN] + (lane + 64 * jj) * 8 + 4);
            gl[jj][0] = *(const f32x4*)(a.in[I_G_LRU] + (lane + 64 * jj) * 8); gl[jj][1] = *(const f32x4*)(a.in[I_G_LRU] + (lane + 64 * jj) * 8 + 4); }
        __syncthreads();
#pragma unroll
        for (int q = 0; q < 4; ++q) {
            const int tl = 4 * wave + q; const size_t row = (size_t)b * SEQ + 32 * c + tl;
#pragma unroll
            for (int half = 0; half < 2; ++half) {
                u32x4 w[2]; float v[16]; float ss = 0.f;
#pragma unroll
                for (int jj = 0; jj < 2; ++jj) { w[jj] = half == 0 ? *(const LAS u32x4*)(lds + tl * LR_XS + (lane + 64 * jj) * 16) : aw[q][jj];
#pragma unroll
                    for (int k = 0; k < 4; ++k) { v[jj * 8 + 2 * k] = bflo(w[jj][k]); v[jj * 8 + 2 * k + 1] = bfhi(w[jj][k]); } }
#pragma unroll
                for (int k = 0; k < 16; ++k) ss += v[k] * v[k];
                ss = wave_sum(ss);
                const float rstd = (G2_FP8 ? XS_SCALE : 1.0f) * __builtin_amdgcn_rsqf(ss * (1.0f / 1024.0f) + EPS);
#pragma unroll
                for (int jj = 0; jj < 2; ++jj) { const f32x4 g0 = half == 0 ? gl[jj][0] : ga[jj][0], g1 = half == 0 ? gl[jj][1] : ga[jj][1];
                    const size_t col = (half == 0 ? 1024 : 0) + (lane + 64 * jj) * 8;
                    if (G2_FP8) *(u32x2*)(O8 + row * D + col) = (u32x2){pk4_fp8(v[jj * 8 + 0] * rstd * g0.x, v[jj * 8 + 1] * rstd * g0.y, v[jj * 8 + 2] * rstd * g0.z, v[jj * 8 + 3] * rstd * g0.w),
                                                                       pk4_fp8(v[jj * 8 + 4] * rstd * g1.x, v[jj * 8 + 5] * rstd * g1.y, v[jj * 8 + 6] * rstd * g1.z, v[jj * 8 + 7] * rstd * g1.w)};
                    else *(u32x4*)(O + row * D + col) = (u32x4){pk2(v[jj * 8 + 0] * rstd * g0.x, v[jj * 8 + 1] * rstd * g0.y), pk2(v[jj * 8 + 2] * rstd * g0.z, v[jj * 8 + 3] * rstd * g0.w),
                                                                pk2(v[jj * 8 + 4] * rstd * g1.x, v[jj * 8 + 5] * rstd * g1.y), pk2(v[jj * 8 + 6] * rstd * g1.z, v[jj * 8 + 7] * rstd * g1.w)}; }
            }
        }
}
template <int PASS>
__device__ __forceinline__ void lru_item(const Args& a, LAS unsigned char* lds, int item, int part, int tid, int lane, int wave) {
    const int b = item / 65, c = item % 65; const bool meta = (c == 64);
    const bf16* Z = (const bf16*)(a.ws + WS_Z);
    float* sumA = (float*)(a.ws + WS_LRUSUM); float* sumB = sumA + NBATCH * 64 * DLRU; float* metaB = sumB + NBATCH * 64 * DLRU;
    __syncthreads();
    {
        const int ch0 = (tid & 127) * 8, tq = tid >> 7;
        f32x4 cw[4][2], cb[2];
#pragma unroll
        for (int jj = 0; jj < 4; ++jj) { cw[jj][0] = *(const f32x4*)(a.in[I_CONV_W] + jj * DLRU + ch0); cw[jj][1] = *(const f32x4*)(a.in[I_CONV_W] + jj * DLRU + ch0 + 4); }
        cb[0] = *(const f32x4*)(a.in[I_CONV_B] + ch0); cb[1] = *(const f32x4*)(a.in[I_CONV_B] + ch0 + 4);
#pragma unroll 1
        for (int i0 = 0; i0 < 8; i0 += 4) {
            u32x4 x[4][4];
#pragma unroll
            for (int i = 0; i < 4; ++i) { const int tl = tq + 4 * (i0 + i); const int t = meta ? tl : NMETA + 32 * c + tl;
#pragma unroll
                for (int jj = 0; jj < 4; ++jj) { const int tt = t - 3 + jj; x[i][jj] = (u32x4){0u, 0u, 0u, 0u};
                    if (tt >= 0 && !(meta && tl >= NMETA)) x[i][jj] = *(const u32x4*)(Z + (size_t)tok_row(b, tt) * DIN + ZX + ch0); } }
#pragma unroll
            for (int i = 0; i < 4; ++i) { const int tl = tq + 4 * (i0 + i); const int t = meta ? tl : NMETA + 32 * c + tl;
                f32x4 a0 = cb[0], a1 = cb[1];
#pragma unroll
                for (int jj = 0; jj < 4; ++jj) { const u32x4 xx = x[i][jj];
                    if (t - 3 + jj >= 0) {
                        a0.x += cw[jj][0].x * bflo(xx[0]); a0.y += cw[jj][0].y * bfhi(xx[0]); a0.z += cw[jj][0].z * bflo(xx[1]); a0.w += cw[jj][0].w * bfhi(xx[1]);
                        a1.x += cw[jj][1].x * bflo(xx[2]); a1.y += cw[jj][1].y * bfhi(xx[2]); a1.z += cw[jj][1].z * bflo(xx[3]); a1.w += cw[jj][1].w * bfhi(xx[3]); } }
                u32x4 o = (u32x4){pk2(a0.x, a0.y), pk2(a0.z, a0.w), pk2(a1.x, a1.y), pk2(a1.z, a1.w)};
                if (meta && tl >= NMETA) o = (u32x4){0u, 0u, 0u, 0u};
                *(LAS u32x4*)(lds + tl * LR_XS + ch0 * 2) = o; }
        }
    }
    LAS float* hinL = (LAS float*)(lds + 32 * LR_XS);
    if (PASS == 1) {
        float h0 = metaB[tid], h1 = metaB[tid + 512];
        const float* pa = sumA + (size_t)b * 64 * DLRU + tid; const float* pb = sumB + (size_t)b * 64 * DLRU + tid;
#pragma unroll 8
        for (int jc = 0; jc < c; ++jc) { h0 = pa[jc * DLRU] * h0 + pb[jc * DLRU]; h1 = pa[jc * DLRU + 512] * h1 + pb[jc * DLRU + 512]; }
        hinL[tid] = h0; hinL[tid + 512] = h1;
    }
    __syncthreads();
    const bf16* WaT = (const bf16*)(a.ws + WS_WAT); const bf16* WiT = (const bf16*)(a.ws + WS_WIT);
    const int r31 = lane & 31, h = lane >> 5;
    const int tau = 16 * ((r31 >> 2) & 1) + 4 * (r31 >> 3) + (r31 & 3);
#pragma unroll 1
    for (int nb = 0; nb < 2; ++nb) {
        const int n = 2 * wave + nb;
        bf16x8 af[4];
#pragma unroll
        for (int ks = 0; ks < 4; ++ks) af[ks] = *(const LAS bf16x8*)(lds + tau * LR_XS + (64 * n + 16 * ks + 8 * h) * 2);
#pragma unroll 1
        for (int nt = 0; nt < 2; ++nt) {
            if (part >= 0 && 2 * nb + nt != part) continue;
            const int ch = 64 * n + 32 * nt + r31;
            f32x16 accR, accI;
#pragma unroll
            for (int r = 0; r < 16; ++r) { accR[r] = 0.f; accI[r] = 0.f; }
#pragma unroll
            for (int ks = 0; ks < 4; ++ks) {
                const bf16x8 wa = *(const bf16x8*)(WaT + ((size_t)(n * 64 + 32 * nt + r31) * 64 + 16 * ks + 8 * h));
                const bf16x8 wi = *(const bf16x8*)(WiT + ((size_t)(n * 64 + 32 * nt + r31) * 64 + 16 * ks + 8 * h));
                accR = __builtin_amdgcn_mfma_f32_32x32x16_bf16(af[ks], wa, accR, 0, 0, 0);
                accI = __builtin_amdgcn_mfma_f32_32x32x16_bf16(af[ks], wi, accI, 0, 0, 0);
            }
            const float ba = a.in[I_B_A][ch], bi = a.in[I_B_I][ch], sp8 = -8.0f * 1.4426950408889634f * log1pf(__expf(-a.in[I_LAMBDA][ch]));
            float av[16], bv[16];
            float Ap = 1.0f, Bp = 0.0f;
#pragma unroll
            for (int r = 0; r < 16; ++r) {
                const float xcv = bf2f(*(const LAS unsigned short*)(lds + (16 * h + r) * LR_XS + ch * 2));
                const float rg = fast_sigmoid(accR[r] + ba), ig = fast_sigmoid(accI[r] + bi);
                const float l2a = sp8 * rg;
                av[r] = __builtin_amdgcn_exp2f(l2a); bv[r] = __builtin_amdgcn_sqrtf(fmaxf(fmaf(-av[r], av[r], 1.0f), 0.0f)) * ig * xcv;
                Ap *= av[r]; Bp = av[r] * Bp + bv[r];
                if (PASS == 0 && !meta) ((unsigned*)(a.ws + WS_AB))[((size_t)b * SEQ + 32 * c + 16 * h + r) * DLRU + ch] = pk2(l2a, bv[r]);
            }
            const float Ao = __shfl_xor(Ap, 32), Bo = __shfl_xor(Bp, 32);
            if (PASS == 0) {
                if (h == 0) {
                    if (meta) metaB[ch] = Bp;
                    else { sumA[((size_t)b * 64 + c) * DLRU + ch] = Ap * Ao; sumB[((size_t)b * 64 + c) * DLRU + ch] = Ao * Bp + Bo; }
                }
            } else {
                const float hin = hinL[ch];
                float hs = h == 0 ? hin : (Ao * hin + Bo);
#pragma unroll
                for (int r = 0; r < 16; ++r) {
                    hs = av[r] * hs + bv[r];
                    const int tl = 16 * h + r;
                    const float gt = bf2f(Z[(size_t)(b * SEQ + 32 * c + tl) * DIN + ZG + ch]);
                    *(LAS unsigned short*)(lds + tl * LR_XS + ch * 2) = (unsigned short)f2bf(hs * fast_gelu_tanh(gt));
                }
            }
        }
    }
}

__device__ __forceinline__ void lru_item_b(const Args& a, LAS unsigned char* lds, int item, int tid, int lane, int wave) {
    const int b = item >> 6, c = item & 63;
    const bf16* Z = (const bf16*)(a.ws + WS_Z); const unsigned* AB = (const unsigned*)(a.ws + WS_AB);
    const float* sumA = (const float*)(a.ws + WS_LRUSUM); const float* sumB = sumA + NBATCH * 64 * DLRU; const float* metaB = sumB + NBATCH * 64 * DLRU;
    const size_t row0 = (size_t)b * SEQ + 32 * c;
    u32x2 ab[32]; unsigned gt[32];
#pragma unroll
    for (int tl = 0; tl < 32; ++tl) { ab[tl] = *(const u32x2*)(AB + (row0 + tl) * DLRU + 2 * tid); gt[tl] = *(const unsigned*)(Z + (row0 + tl) * DIN + ZG + 2 * tid); }
    float h0, h1; { const f32x2 m = *(const f32x2*)(metaB + 2 * tid); h0 = m.x; h1 = m.y; }
    { const float* pa = sumA + (size_t)b * 64 * DLRU + 2 * tid; const float* pb = sumB + (size_t)b * 64 * DLRU + 2 * tid;
#pragma unroll 16
      for (int jc = 0; jc < c; ++jc) { const f32x2 A2 = *(const f32x2*)(pa + jc * DLRU), B2 = *(const f32x2*)(pb + jc * DLRU); h0 = A2.x * h0 + B2.x; h1 = A2.y * h1 + B2.y; } }
    __syncthreads();
#pragma unroll
    for (int tl = 0; tl < 32; ++tl) {
        h0 = __builtin_amdgcn_exp2f(bflo(ab[tl].x)) * h0 + bfhi(ab[tl].x);
        h1 = __builtin_amdgcn_exp2f(bflo(ab[tl].y)) * h1 + bfhi(ab[tl].y);
        *(LAS unsigned*)(lds + tl * LR_XS + 4 * tid) = pk2(h0 * fast_gelu_tanh(bflo(gt[tl])), h1 * fast_gelu_tanh(bfhi(gt[tl])));
    }
    lru_norm_rows(a, lds, b, c, lane, wave);
}

__device__ __forceinline__ void phase_router_mfma(const Args& a, LAS unsigned char* lds, int tid, int lane, int wave) {
    const bf16* H1 = (const bf16*)(a.ws + WS_H1); const bf16* WRT = (const bf16*)(a.ws + WS_WRT);
    int* tope = (int*)(a.ws + WS_TOPE); float* topw = (float*)(a.ws + WS_TOPW); float* rstd2 = (float*)(a.ws + WS_RSTD2);
    unsigned* counts = (unsigned*)(a.ws + WS_CTL) + CW_COUNTS;
    LAS float* lg = (LAS float*)(lds + wave * 2048);
    LAS int* hist = (LAS int*)(lds + 32768);
    if (tid < 32) hist[tid] = 0;
    __syncthreads();
    const int fr = lane & 15, fq = lane >> 4;
    const int kh = wave >> 2;
    LAS float* part = (LAS float*)(lds + 40960 + (wave & 3) * 2560);
    for (int g0 = 4 * blockIdx.x; g0 < MREAL / 16; g0 += 4 * gridDim.x) {
        const int grp = g0 + (wave & 3);
        const int row0 = grp * 16;
        const bf16* hp = H1 + (size_t)(row0 + fr) * D + 8 * fq + 1024 * kh;
        const bf16* wp = WRT + (size_t)fr * D + 8 * fq + 1024 * kh;
        f32x4 acc0 = (f32x4){0.f, 0.f, 0.f, 0.f}, acc1 = acc0; float ss = 0.f;
#pragma unroll 8
        for (int kk = 0; kk < 32; ++kk) {
            const u32x4 w = *(const u32x4*)(hp + 32 * kk);
#pragma unroll
            for (int q = 0; q < 4; ++q) { const float lo = bflo(w[q]), hi = bfhi(w[q]); ss += lo * lo + hi * hi; }
            const bf16x8 af = __builtin_bit_cast(bf16x8, w);
            const bf16x8 b0 = *(const bf16x8*)(wp + 32 * kk), b1 = *(const bf16x8*)(wp + (size_t)16 * D + 32 * kk);
            acc0 = __builtin_amdgcn_mfma_f32_16x16x32_bf16(af, b0, acc0, 0, 0, 0);
            acc1 = __builtin_amdgcn_mfma_f32_16x16x32_bf16(af, b1, acc1, 0, 0, 0);
        }
        if (kh == 1) {
#pragma unroll
            for (int j = 0; j < 4; ++j) { part[j * 64 + lane] = acc0[j]; part[(4 + j) * 64 + lane] = acc1[j]; }
            part[8 * 64 + lane] = ss; }
        __syncthreads();
        if (kh == 0) {
#pragma unroll
            for (int j = 0; j < 4; ++j) { acc0[j] += part[j * 64 + lane]; acc1[j] += part[(4 + j) * 64 + lane]; }
            ss += part[8 * 64 + lane]; }
        __syncthreads();
        if (kh == 1) continue;
        ss += __shfl_xor(ss, 16); ss += __shfl_xor(ss, 32);
        const float rstd = 1.0f / sqrtf(ss * (1.0f / D) + EPS);
        if (fq == 0) rstd2[row0 + fr] = rstd;
        const float br0 = a.in[I_B_ROUTER][fr], br1 = a.in[I_B_ROUTER][16 + fr];
#pragma unroll
        for (int j = 0; j < 4; ++j) { const int row = 4 * fq + j; const float rs = __shfl(rstd, row);
            lg[row * 32 + fr] = acc0[j] * rs + br0; lg[row * 32 + 16 + fr] = acc1[j] * rs + br1; }
        asm volatile("s_waitcnt lgkmcnt(0)" ::: "memory");
        if (lane < 16) {
            float v[32];
#pragma unroll
            for (int q = 0; q < 8; ++q) { const f32x4 t = *(const LAS f32x4*)(lg + lane * 32 + 4 * q); v[4 * q] = t.x; v[4 * q + 1] = t.y; v[4 * q + 2] = t.z; v[4 * q + 3] = t.w; }
            float tv[4]; int te[4];
#pragma unroll
            for (int r = 0; r < 4; ++r) { float best = -3.0e38f; int bi = 0;
#pragma unroll
                for (int e = 0; e < 32; ++e) { const bool gtb = v[e] > best; best = gtb ? v[e] : best; bi = gtb ? e : bi; }
#pragma unroll
                for (int e = 0; e < 32; ++e) v[e] = (e == bi) ? -3.0e38f : v[e];
                tv[r] = best; te[r] = bi; }
            const float e1 = __expf(tv[1] - tv[0]), e2 = __expf(tv[2] - tv[0]), e3 = __expf(tv[3] - tv[0]);
            const float inv = 1.0f / (1.0f + e1 + e2 + e3);
            const int row = row0 + lane;
            *(int4*)(tope + row * 4) = make_int4(te[0], te[1], te[2], te[3]);
            *(f32x4*)(topw + row * 4) = (f32x4){inv, e1 * inv, e2 * inv, e3 * inv};
#pragma unroll
            for (int r = 0; r < 4; ++r) atomicAdd((int*)&hist[te[r]], 1);
        }
        asm volatile("s_waitcnt lgkmcnt(0)" ::: "memory");
    }
    __syncthreads();
    if (tid < 32 && hist[tid] != 0) atomicAdd(&counts[tid], (unsigned)hist[tid]);
}

__device__ __forceinline__ void build_tile_table(const Args& a, LAS int* tstart, int tid) {
    if (tid < 64) {
        const unsigned* counts = (const unsigned*)(a.ws + WS_CTL) + CW_COUNTS;
        const int nt = tid < NEXP ? (int)((__hip_atomic_load(counts + tid, __ATOMIC_RELAXED, __HIP_MEMORY_SCOPE_AGENT) + 255u) >> 8) : 0;
        int inc = nt;
#pragma unroll
        for (int o = 1; o < 32; o <<= 1) { const int v = __shfl_up(inc, o); if ((tid & 63) >= o) inc += v; }
        if (tid < NEXP) tstart[tid] = inc - nt;
        if (tid == NEXP - 1) tstart[NEXP] = inc;
    }
    __syncthreads();
    if (tid < 288) { int e = 0;
#pragma unroll 1
        for (int i = 1; i < NEXP; ++i) e += (tstart[i] <= tid) ? 1 : 0;
        ((LAS unsigned char*)(tstart + 64))[tid] = (unsigned char)e; }
    __syncthreads();
}
__device__ __forceinline__ int tile_expert(const LAS int* tstart, int tile) {
    int e = 0;
#pragma unroll 1
    for (int i = 1; i < NEXP; ++i) e += (tstart[i] <= tile) ? 1 : 0;
    return e;
}

__device__ __forceinline__ void phase_assign(const Args& a, LAS unsigned char* lds, int tid, int lane, int wave) {
    LAS int* tstart = (LAS int*)(lds + LDS_TAB);
    LAS int* hist = (LAS int*)lds; LAS int* base = hist + 32; LAS int* spos = base + 32;
    build_tile_table(a, tstart, tid);
    const int* tope = (const int*)(a.ws + WS_TOPE); const float* topw = (const float*)(a.ws + WS_TOPW); const float* rstd2 = (const float*)(a.ws + WS_RSTD2);
    int* rowpair = (int*)(a.ws + WS_ROWPAIR); float* roww = (float*)(a.ws + WS_ROWW);
    unsigned* cursor = (unsigned*)(a.ws + WS_CTL) + CW_CURSOR;
    const bf16* H1 = (const bf16*)(a.ws + WS_H1); unsigned char* XS = (unsigned char*)(a.ws + WS_XS);
    for (int blk = blockIdx.x; blk < MREAL / 64; blk += gridDim.x) {
        if (tid < 32) hist[tid] = 0;
        __syncthreads();
        int e = 0, rank = 0, pair = 0;
        if (tid < 256) { pair = blk * 256 + tid; e = tope[pair]; rank = atomicAdd((int*)&hist[e], 1); }
        __syncthreads();
        if (tid < 32) base[tid] = (int)atomicAdd(&cursor[tid], (unsigned)hist[tid]);
        __syncthreads();
        if (tid < 256) { const int pos = tstart[e] * 256 + base[e] + rank; spos[tid] = pos; rowpair[pos] = pair; roww[pos] = topw[pair]; ((int*)(a.ws + WS_PAIRPOS))[pair] = pos; }
        __syncthreads();
        for (int tt = wave * 8; tt < wave * 8 + 8; ++tt) {
            const int token = blk * 64 + tt; const float rstd = rstd2[token] * XS_SCALE;
            const u32x4* hr = (const u32x4*)(H1 + (size_t)token * D);
            u32x4* dst = (u32x4*)(XS + (size_t)token * D);
#pragma unroll
            for (int j = 0; j < 2; ++j) { const u32x4 ha = hr[2 * (lane + 64 * j)], hb = hr[2 * (lane + 64 * j) + 1];
                const f32x4* gp = (const f32x4*)a.in[I_NORM_FFN] + 4 * (lane + 64 * j); const f32x4 g0 = gp[0], g1 = gp[1], g2 = gp[2], g3 = gp[3];
                dst[lane + 64 * j] = (u32x4){pk4_fp8(bflo(ha[0]) * rstd * g0.x, bfhi(ha[0]) * rstd * g0.y, bflo(ha[1]) * rstd * g0.z, bfhi(ha[1]) * rstd * g0.w),
                                             pk4_fp8(bflo(ha[2]) * rstd * g1.x, bfhi(ha[2]) * rstd * g1.y, bflo(ha[3]) * rstd * g1.z, bfhi(ha[3]) * rstd * g1.w),
                                             pk4_fp8(bflo(hb[0]) * rstd * g2.x, bfhi(hb[0]) * rstd * g2.y, bflo(hb[1]) * rstd * g2.z, bfhi(hb[1]) * rstd * g2.w),
                                             pk4_fp8(bflo(hb[2]) * rstd * g3.x, bfhi(hb[2]) * rstd * g3.y, bflo(hb[3]) * rstd * g3.z, bfhi(hb[3]) * rstd * g3.w)}; }
        }
        __syncthreads();
    }
}

__device__ __forceinline__ void phase_final(const Args& a, int lane, int wave) {
    const int gw = blockIdx.x * 8 + wave, NGW = gridDim.x * 8;
    const bf16* H1 = (const bf16*)(a.ws + WS_H1); const unsigned char* YB = a.ws + WS_YB;
    const int* pairpos = (const int*)(a.ws + WS_PAIRPOS); const float* topw = (const float*)(a.ws + WS_TOPW);
    for (int row = gw; row < MREAL; row += NGW) {
        const int4 pp = *(const int4*)(pairpos + row * 4); const f32x4 pw = *(const f32x4*)(topw + row * 4) * (1.0f / YB_SCALE);
        const int pos[4] = {pp.x, pp.y, pp.z, pp.w}; const float w4[4] = {pw.x, pw.y, pw.z, pw.w};
        f32x4 v[8]; unsigned y[4][8]; float ss = 0.f;
#pragma unroll
        for (int k = 0; k < 4; ++k)
#pragma unroll
            for (int j = 0; j < 8; ++j) y[k][j] = ((const unsigned*)(YB + (size_t)pos[k] * D))[lane + 64 * j];
#pragma unroll
        for (int j = 0; j < 8; ++j) { { const u32x2 hh = ((const u32x2*)(H1 + (size_t)row * D))[lane + 64 * j]; v[j] = (f32x4){bflo(hh.x), bfhi(hh.x), bflo(hh.y), bfhi(hh.y)}; }
#pragma unroll
            for (int k = 0; k < 4; ++k) { const f32x2 lo = __builtin_amdgcn_cvt_pk_f32_fp8((int)y[k][j], false), hi = __builtin_amdgcn_cvt_pk_f32_fp8((int)y[k][j], true);
                v[j].x += w4[k] * lo.x; v[j].y += w4[k] * lo.y; v[j].z += w4[k] * hi.x; v[j].w += w4[k] * hi.y; }
            ss += (v[j].x * v[j].x + v[j].y * v[j].y) + (v[j].z * v[j].z + v[j].w * v[j].w); }
        ss = wave_sum(ss);
        const float rstd = 1.0f / sqrtf(ss * (1.0f / D) + EPS);
        f32x4* op = (f32x4*)(a.out + (size_t)row * D);
#pragma unroll
        for (int j = 0; j < 8; ++j) { const f32x4 g = ((const f32x4*)a.in[I_FINAL_NORM])[lane + 64 * j]; op[lane + 64 * j] = v[j] * rstd * g; }
    }
}

enum { PH_PROLOGUE = 0, PH_G1, PH_ATTN, PH_LRU_B, PH_G2, PH_ROUTER, PH_ASSIGN, PH_G3, PH_G4, PH_FINAL, PH_COUNT };

__global__ void __launch_bounds__(512, 2) fwd(Args a) {
    extern __shared__ __attribute__((aligned(16))) unsigned char lds_raw[];
    LAS unsigned char* lds = (LAS unsigned char*)lds_raw;
    const int tid = threadIdx.x, lane = tid & 63, wave = __builtin_amdgcn_readfirstlane(tid >> 6);
    const int gw = blockIdx.x * 8 + wave, NGW = gridDim.x * 8;
    unsigned char* ws = a.ws;
#define IN(k) (a.ph_lo <= (k) && (k) < a.ph_hi)
    pg8::BGNone nobg;
    pg8::BGConv bgup{(const char*)a.in[I_W_UP], ws + WS_WUT, (int)blockIdx.x * 128, (int)blockIdx.x * 128 + 80, ws + WS_DUMMY};
#define SEAM(k) do { if (IN(k) && IN((k) + 1)) xcd_barrier(bar); } while (0)
    if (tid < 4) ((LAS unsigned*)(lds + LDS_MISC))[tid] = 0u;
    __syncthreads();
    XcdBarrier bar; bar.bar = (unsigned*)(ws + WS_CTL) + CW_BAR; bar.x = 0; bar.st = nullptr;
    if (a.ph_hi - a.ph_lo > 1) bar = xcd_barrier_post((unsigned*)(ws + WS_CTL) + CW_BAR, (volatile LAS unsigned*)(lds + LDS_MISC));

    if (IN(PH_PROLOGUE)) { phase_prologue(a, lds, tid, lane, wave);
#if PROBE_REPEAT == 0
        __syncthreads(); phase_prologue(a, lds, tid, lane, wave);
#endif
    }
    SEAM(PH_PROLOGUE);

    if (IN(PH_G1)) {
        const int ncv = g1_conv_wg(), G1G = (int)gridDim.x - ncv;
        pg8::SchedDense S{(const char*)(ws + WS_N1), (const char*)(ws + WS_WINT), (const char*)(ws + WS_WINT), nullptr, MROWS / 256, DIN / 256, G1G, (int)blockIdx.x, G1_FP8 ? 2048 : 4096};
        pg8::EpiZ E{(bf16*)(ws + WS_Z), a.in[I_B_IN], G1_FP8 ? 1.0f / (W_SCALE * XS_SCALE) : 1.0f};
        if ((int)blockIdx.x >= G1G) conv_tiles(a, lds, tid, conv_pro_tiles() + ((int)blockIdx.x - G1G), CONV_ALL_TILES, ncv);
        else
#if BG_WUP
        pg8::gemm_phase<G1_FP8 != 0>(lds, S, E, bgup);
#else
        pg8::gemm_phase<G1_FP8 != 0>(lds, S, E, nobg);
#endif
#if PROBE_REPEAT == 1
        __syncthreads(); pg8::gemm_phase<G1_FP8 != 0>(lds, S, E, nobg);
#endif
    }
    SEAM(PH_G1);
    if (IN(PH_ATTN)) {
        for (int it = blockIdx.x; it < NBATCH * 16 * 4; it += gridDim.x) attn_item(a, lds, it, tid, lane, wave);
        for (int j = blockIdx.x; j < NBATCH * 64 + 4; j += gridDim.x) {
            if (j < NBATCH * 64) lru_item<0>(a, lds, (j >> 6) * 65 + (j & 63), -1, tid, lane, wave); else lru_item<0>(a, lds, 64, j - NBATCH * 64, tid, lane, wave); }
#if PROBE_REPEAT == 2
        for (int it = blockIdx.x; it < NBATCH * 16 * 4; it += gridDim.x) attn_item(a, lds, it, tid, lane, wave);
#endif
#if PROBE_REPEAT == 3
        for (int j = blockIdx.x; j < NBATCH * 64 + 4; j += gridDim.x) {
            if (j < NBATCH * 64) lru_item<0>(a, lds, (j >> 6) * 65 + (j & 63), -1, tid, lane, wave); else lru_item<0>(a, lds, 64, j - NBATCH * 64, tid, lane, wave); }
#endif
    }
    SEAM(PH_ATTN);
    if (IN(PH_LRU_B)) {
        for (int it = blockIdx.x; it < NBATCH * 64; it += gridDim.x) lru_item_b(a, lds, (it & 256) ? (it ^ 63) : it, tid, lane, wave);
    }
    SEAM(PH_LRU_B);
    if (IN(PH_G2)) {
        pg8::SchedDense S{(const char*)(ws + WS_O), (const char*)(ws + WS_WOUTT), (const char*)(ws + WS_WOUTT), nullptr, MREAL / 256, D / 256, (int)gridDim.x, (int)blockIdx.x, G2_FP8 ? 2048 : 4096};
        pg8::EpiH1 E{(bf16*)(ws + WS_H1), a.in[I_X], a.in[I_B_OUT], G2_FP8 ? 1.0f / (W_SCALE * XS_SCALE) : 1.0f};
#if BG_WUP
        pg8::gemm_phase<G2_FP8 != 0>(lds, S, E, bgup);
        for (int pair = bgup.next < bgup.end ? bgup.next : bgup.end; pair < bgup.end; ++pair) { const char* sp; unsigned char* dp; pg8::bg_pair_ptrs(bgup, pair, sp, dp);
            const int n = tid >> 4, c = tid & 15; const float* p = (const float*)sp + (size_t)(8 * c) * 2048 + n;
            *(u32x2*)(dp + (size_t)n * 2048 + 8 * c) = (u32x2){pk4_fp8(p[0] * W_SCALE, p[2048] * W_SCALE, p[4096] * W_SCALE, p[6144] * W_SCALE), pk4_fp8(p[8192] * W_SCALE, p[10240] * W_SCALE, p[12288] * W_SCALE, p[14336] * W_SCALE)}; }
#else
        pg8::gemm_phase<G2_FP8 != 0>(lds, S, E, nobg);
#endif
#if PROBE_REPEAT == 4
        __syncthreads(); pg8::gemm_phase<G2_FP8 != 0>(lds, S, E, nobg);
#endif
    }
    SEAM(PH_G2);
    if (IN(PH_ROUTER)) phase_router_mfma(a, lds, tid, lane, wave);
    if (IN(PH_ROUTER) && IN(PH_ASSIGN)) {
        asm volatile("s_waitcnt vmcnt(0)" ::: "memory"); __syncthreads();
        if (tid == 0) { unsigned* rs = (unsigned*)(ws + WS_CTL) + CW_RSYNC; unsigned* tmo = (unsigned*)(ws + WS_CTL) + CW_BAR + XB_TMO;
            __hip_atomic_fetch_add(rs, 1u, __ATOMIC_RELAXED, __HIP_MEMORY_SCOPE_AGENT);
            unsigned sp = 0; while (__hip_atomic_load(rs, __ATOMIC_RELAXED, __HIP_MEMORY_SCOPE_AGENT) < gridDim.x) { __builtin_amdgcn_s_sleep(1);
                if ((++sp & 255u) == 0u) { if (__hip_atomic_load(tmo, __ATOMIC_RELAXED, __HIP_MEMORY_SCOPE_AGENT)) break; if (sp > XB_SPIN_CAP) { atomicAdd(tmo, 1u); break; } } } }
        __syncthreads();
    } else SEAM(PH_ROUTER);
    if (IN(PH_ASSIGN)) phase_assign(a, lds, tid, lane, wave);
    SEAM(PH_ASSIGN);
    if (IN(PH_G3)) {
        LAS int* tstart = (LAS int*)(lds + LDS_TAB);
        if (!IN(PH_ASSIGN)) build_tile_table(a, tstart, tid);
        const int G3G = (int)gridDim.x - G3_TEST_IDLE;
        pg8::SchedMoE S{(const char*)(ws + WS_N2), (const char*)(ws + WS_WGT), (const char*)(ws + WS_WUT), (const int*)(ws + WS_ROWPAIR), tstart, tstart[NEXP], DFF / 128, G3G, (int)blockIdx.x, true};
        pg8::EpiAct E{(unsigned char*)(ws + WS_ACT), a.in[I_B_GATE], a.in[I_B_UP]};
#if BG_WDOWN
        int bg0, bg1;
        { const int U = tstart[NEXP] * (DFF / 128), ulo = U / G3G, nhi = U - ulo * G3G, c = (int)blockIdx.x;
          int plo = (32768 + nhi * 48 + G3G - 1) / G3G; if (nhi != 0 && plo > 8 * ulo) plo = 8 * ulo > 0 ? 8 * ulo : 1;
          int phi = nhi ? (32768 - (G3G - nhi) * plo + nhi - 1) / nhi : 0; if (phi < 0) phi = 0;
          bg0 = c < nhi ? c * phi : nhi * phi + (c - nhi) * plo; bg1 = bg0 + (c < nhi ? phi : plo);
          if (c >= G3G) { bg0 = bg1 = 32768; }
          if (c == G3G - 1) bg1 = 32768;
          bg0 = bg0 < 32768 ? bg0 : 32768; bg1 = bg1 < 32768 ? bg1 : 32768; }
        pg8::BGConv bg{(const char*)a.in[I_W_DOWN], ws + WS_WDT, bg0, bg1, ws + WS_DUMMY};
        if ((int)blockIdx.x < G3G) pg8::gemm_phase<true, pg8::EpiAct, pg8::SchedMoE, pg8::BGConv, true>(lds, S, E, bg);
        for (int pair = bg.next < bg.end ? bg.next : bg.end; pair < bg.end; ++pair) { const char* sp; unsigned char* dp; pg8::bg_pair_ptrs(bg, pair, sp, dp);
            const int n = tid >> 4, c = tid & 15;
            const float* p = (const float*)sp + (size_t)(8 * c) * 2048 + n;
            *(u32x2*)(dp + (size_t)n * 2048 + 8 * c) = (u32x2){pk4_fp8(p[0] * W_SCALE, p[2048] * W_SCALE, p[4096] * W_SCALE, p[6144] * W_SCALE), pk4_fp8(p[8192] * W_SCALE, p[10240] * W_SCALE, p[12288] * W_SCALE, p[14336] * W_SCALE)}; }
#else
        pg8::gemm_phase<true, pg8::EpiAct, pg8::SchedMoE, pg8::BGNone, true>(lds, S, E, nobg);
#endif
#if PROBE_REPEAT == 7
        __syncthreads(); pg8::gemm_phase<true, pg8::EpiAct, pg8::SchedMoE, pg8::BGNone, true>(lds, S, E, nobg);
#endif
    }
    SEAM(PH_G3);
    if (IN(PH_G4)) {
        LAS int* tstart = (LAS int*)(lds + LDS_TAB);
        if (!IN(PH_ASSIGN) && !IN(PH_G3)) build_tile_table(a, tstart, tid);
        pg8::SchedMoE S{(const char*)(ws + WS_ACT), (const char*)(ws + WS_WDT), (const char*)(ws + WS_WDT), nullptr, tstart, tstart[NEXP], D / 256, (int)gridDim.x, (int)blockIdx.x, false};
        pg8::EpiDown E{ws + WS_YB, a.in[I_B_DOWN]};
        pg8::gemm_phase<true>(lds, S, E, nobg);
#if PROBE_REPEAT == 8
        __syncthreads(); pg8::gemm_phase<true>(lds, S, E, nobg);
#endif
    }
    SEAM(PH_G4);
    if (IN(PH_FINAL)) { phase_final(a, lane, wave);
#if PROBE_REPEAT == 9
        phase_final(a, lane, wave);
#endif
    }
#undef IN
#undef SEAM
}

extern "C" void kernel_launch(void* const* d_in, const int* in_sizes, int n_in, void* d_out, int out_size, void* d_ws, size_t ws_size, hipStream_t stream) {
    static int grid = 0;
    if (grid == 0) {
        if (n_in != 27 || out_size != MREAL * D || ws_size < WS_END) { fprintf(stderr, "kernel_launch: unexpected problem (n_in %d, out %d, ws %zu)\n", n_in, out_size, ws_size); grid = -1; return; }
        int dev = 0, cus = 0;
        if (hipGetDevice(&dev) != hipSuccess || hipDeviceGetAttribute(&cus, hipDeviceAttributeMultiprocessorCount, dev) != hipSuccess) { grid = -1; return; }
        if (hipFuncSetAttribute((const void*)fwd, hipFuncAttributeMaxDynamicSharedMemorySize, LDS_BYTES) != hipSuccess) { fprintf(stderr, "kernel_launch: hipFuncSetAttribute failed\n"); grid = -1; return; }
        grid = cus;
    }
    if (grid < 0) return;
    (void)hipMemsetAsync((char*)d_ws + WS_CTL, 0, CTL_BYTES, stream);
    Args a{};
    for (int i = 0; i < 27; ++i) a.in[i] = (const float*)d_in[i];
    a.out = (float*)d_out; a.ws = (unsigned char*)d_ws;
#if MK_ONE_LAUNCH
    a.ph_lo = 0; a.ph_hi = PH_COUNT;
    hipLaunchKernelGGL(fwd, dim3(grid), dim3(512), LDS_BYTES, stream, a);
#else
    for (int ph = 0; ph < PH_COUNT; ++ph) {
        a.ph_lo = ph; a.ph_hi = ph + 1;
        hipLaunchKernelGGL(fwd, dim3(grid), dim3(512), LDS_BYTES, stream, a);
    }
#endif
}
```

```cpp
#include <hip/hip_runtime.h>
#include <cstdio>
#include <cstdint>

#define LAS __attribute__((address_space(3)))
#ifndef PROBE_REPEAT
#define PROBE_REPEAT -1
#endif
#ifndef G1_FP8
#define G1_FP8 0
#endif
#ifndef G2_FP8
#define G2_FP8 0
#endif
#ifndef BG_WDOWN
#define BG_WDOWN 1
#ifndef G3_TEST_IDLE
#define G3_TEST_IDLE 0
#endif
#endif
#ifndef BG_WUP
#define BG_WUP 0
#endif
#ifndef BG_EXP
#define BG_EXP 0
#endif
#ifndef MK_ONE_LAUNCH
#define MK_ONE_LAUNCH 1
#endif
typedef unsigned short bf16;
typedef float f32x4 __attribute__((ext_vector_type(4)));
typedef float f32x2 __attribute__((ext_vector_type(2)));
typedef short bf16x8 __attribute__((ext_vector_type(8)));
typedef unsigned u32x4 __attribute__((ext_vector_type(4)));
typedef unsigned u32x2 __attribute__((ext_vector_type(2)));

constexpr int D = 2048, SEQ = 2048, NMETA = 16, TT = 2064, NBATCH = 8;
constexpr int MREAL = 16384, METAROW0 = 16384, MVALID = 16400, MROWS = 16640;
constexpr int DIN = 3584, DLRU = 1024, HD = 64;
constexpr int ZQ = 0, ZK = 1024, ZV = 1280, ZX = 1536, ZG = 2560;
constexpr int NEXP = 32, DFF = 2048, PROWS = 73728;
constexpr float EPS = 1e-5f;

constexpr size_t MiB = 1u << 20;
constexpr size_t WS_CTL = 0, CTL_BYTES = 1 * MiB;
constexpr size_t WS_COS = 1 * MiB, WS_SIN = 1 * MiB + 320 * 1024;
constexpr size_t WS_TOPE = 2 * MiB, WS_TOPW = WS_TOPE + 256 * 1024, WS_RSTD2 = WS_TOPW + 256 * 1024, WS_ROWPAIR = WS_RSTD2 + 64 * 1024, WS_ROWW = WS_ROWPAIR + 320 * 1024;
constexpr size_t WS_PAIRPOS = 3 * MiB + 256 * 1024;
constexpr size_t WS_DUMMY = 3 * MiB + 512 * 1024;
constexpr size_t WS_LRUSUM = 4 * MiB;
constexpr size_t WS_RSTD1 = 8 * MiB + 256 * 1024;
constexpr size_t WS_WAT = 9 * MiB, WS_WIT = WS_WAT + 128 * 1024, WS_WRT = WS_WIT + 128 * 1024;
constexpr size_t WS_WINT = 10 * MiB, WS_WOUTT = 24 * MiB, WS_WGT = 32 * MiB, WS_WUT = 288 * MiB, WS_WDT = 544 * MiB;
constexpr size_t WS_N1 = 800 * MiB, WS_Z = 866 * MiB, WS_O = 980 * MiB, WS_H1 = 1044 * MiB, WS_XS = 1172 * MiB, WS_YB = WS_XS, WS_ACT = 1460 * MiB, WS_END = 1748 * MiB;
constexpr size_t WS_N2 = WS_XS;
constexpr size_t WS_AB = WS_XS;
constexpr size_t WS_ATT = WS_N1;
constexpr size_t WS_XC = WS_XS, WS_AA = WS_XS + 66 * MiB, WS_BB = WS_XS + 132 * MiB, WS_YL = WS_XS + 198 * MiB;
static_assert(WS_ROWW + PROWS * 4 <= WS_LRUSUM, "small map");
constexpr int CW_COUNTS = 1024, CW_CURSOR = 1088, CW_RSYNC = 1280, CW_BAR = 4096;

constexpr int LDS_TAB = 131072;
constexpr int LDS_META = LDS_TAB + 1024;
constexpr int LDS_RID = LDS_META + 3072;
constexpr int LDS_MISC = LDS_TAB + 8192;
constexpr int LDS_BG = LDS_MISC + 1024;
constexpr int LDS_T2 = LDS_BG + 16384;
constexpr int LDS_BYTES = LDS_T2 + 4352;
static_assert(LDS_BYTES <= 163840 && LDS_BG % 1024 == 0, "LDS map");

__device__ const float c_inv_freq[32] = {1.000000000e+00f, 7.498942018e-01f, 5.623413324e-01f, 4.216965139e-01f, 3.162277639e-01f, 2.371373922e-01f, 1.778279394e-01f, 1.333521456e-01f, 1.000000015e-01f, 7.498941571e-02f, 5.623412877e-02f, 4.216964915e-02f, 3.162277862e-02f, 2.371373586e-02f, 1.778279431e-02f, 1.333521493e-02f, 9.999999776e-03f, 7.498942316e-03f, 5.623413250e-03f, 4.216964822e-03f, 3.162277862e-03f, 2.371373819e-03f, 1.778279431e-03f, 1.333521446e-03f, 1.000000047e-03f, 7.498941850e-04f, 5.623413017e-04f, 4.216965463e-04f, 3.162277862e-04f, 2.371373848e-04f, 1.778279402e-04f, 1.333521504e-04f};

struct Args { const float* in[27]; float* out; unsigned char* ws; int ph_lo, ph_hi; };
enum { I_X = 0, I_META, I_NORM_MIX, I_W_IN, I_B_IN, I_SINKS, I_CONV_W, I_CONV_B, I_W_A, I_B_A, I_W_I, I_B_I, I_LAMBDA, I_G_ATTN, I_G_LRU, I_W_OUT, I_B_OUT, I_NORM_FFN,
       I_W_ROUTER, I_B_ROUTER, I_W_GATE, I_B_GATE, I_W_UP, I_B_UP, I_W_DOWN, I_B_DOWN, I_FINAL_NORM };


#define XB_TMO      128
#define XB_XCNT(j)  (256  + 64 * (j))
#define XB_XSUB(j)  (1280 + 64 * (j))
#define XB_XGEN(j)  (2304 + 64 * (j))
#define XB_TOP      3328
#define XB_TOPGEN   3392
#define XCD_BAR_WORDS 3456
#define XB_SPIN_CAP (1u << 18)

__device__ __forceinline__ unsigned xb_ld(unsigned* p)              { return __hip_atomic_load(p, __ATOMIC_RELAXED, __HIP_MEMORY_SCOPE_AGENT); }
__device__ __forceinline__ unsigned xb_add(unsigned* p, unsigned v) { return __hip_atomic_fetch_add(p, v, __ATOMIC_RELAXED, __HIP_MEMORY_SCOPE_AGENT); }
__device__ __forceinline__ unsigned xb_xcc_id() { return (unsigned)__builtin_amdgcn_s_getreg((3 << 11) | 20) & 0xFu; }
#define XB_SPIN(cond, bar) do { unsigned _sp = 0; while (cond) { __builtin_amdgcn_s_sleep(1); \
    if ((++_sp & 255u) == 0u) { if (xb_ld(&(bar)[XB_TMO])) break; if (_sp > XB_SPIN_CAP) { atomicAdd(&(bar)[XB_TMO], 1u); break; } } } } while (0)

struct XcdBarrier {
    unsigned* bar; unsigned x;
    volatile LAS unsigned* st;
};

__device__ __forceinline__ XcdBarrier xcd_barrier_post(unsigned* bar, volatile LAS unsigned* st) {
    XcdBarrier b; b.bar = bar; b.x = xb_xcc_id(); b.st = st;
    if (threadIdx.x == 0) (void)xb_add(&bar[XB_XCNT(b.x)], 1u);
    return b;
}
__device__ __forceinline__ void xcd_barrier_complete(unsigned* bar, unsigned x, unsigned& nloc, unsigned& nx) {
    const unsigned G = gridDim.x * gridDim.y * gridDim.z;
    unsigned sum, cnt, mine, sp = 0u;
    for (;;) {
        sum = 0u; cnt = 0u; mine = 0u;
#pragma unroll
        for (unsigned j = 0; j < 16; ++j) { const unsigned c = xb_ld(&bar[XB_XCNT(j)]); sum += c; cnt += (c > 0u) ? 1u : 0u; mine = (j == x) ? c : mine; }
        if (sum == G) break;
        __builtin_amdgcn_s_sleep(1);
        if ((++sp & 255u) == 0u) { if (xb_ld(&bar[XB_TMO])) break; if (sp > XB_SPIN_CAP) { atomicAdd(&bar[XB_TMO], 1u); break; } }
    }
    nloc = mine > 0u ? mine : 1u; nx = cnt > 0u ? cnt : 1u;
}

__device__ __forceinline__ void xcd_barrier(const XcdBarrier& b) {
    asm volatile("s_waitcnt vmcnt(0)" ::: "memory");
    __syncthreads();
    if (threadIdx.x == 0) {
        unsigned* bar = b.bar;
        __builtin_amdgcn_s_waitcnt(0);
        unsigned nloc = b.st[0], nx = b.st[1];
        if (nloc == 0u) { xcd_barrier_complete(bar, b.x, nloc, nx); b.st[0] = nloc; b.st[1] = nx; }
        const unsigned old = xb_add(&bar[XB_XSUB(b.x)], 1u);
        const unsigned gen = old / nloc;
        if (old + 1u == (gen + 1u) * nloc) {
            __builtin_amdgcn_fence(__ATOMIC_RELEASE, "agent");
            asm volatile("s_waitcnt vmcnt(0)" ::: "memory");
            const unsigned og = xb_add(&bar[XB_TOP], 1u);
            const unsigned tg = og / nx;
            if (og + 1u == (tg + 1u) * nx) xb_add(&bar[XB_TOPGEN], 1u);
            else XB_SPIN(xb_ld(&bar[XB_TOPGEN]) == tg, bar);
            __builtin_amdgcn_fence(__ATOMIC_ACQUIRE, "agent");
            xb_add(&bar[XB_XGEN(b.x)], 1u);
            asm volatile("s_waitcnt vmcnt(0)" ::: "memory");
        } else {
            XB_SPIN(xb_ld(&bar[XB_XGEN(b.x)]) == gen, bar);
            __builtin_amdgcn_fence(__ATOMIC_ACQUIRE, "agent");
            asm volatile("s_waitcnt vmcnt(0)" ::: "memory");
        }
    }
    __syncthreads();
}

__device__ __forceinline__ float bf2f(unsigned b) { return __uint_as_float((b & 0xffffu) << 16); }
__device__ __forceinline__ float bflo(unsigned w) { return __uint_as_float(w << 16); }
__device__ __forceinline__ float bfhi(unsigned w) { return __uint_as_float(w & 0xffff0000u); }
__device__ __forceinline__ unsigned f2bf(float f) { unsigned u = __float_as_uint(f); return (u + 0x7fffu + ((u >> 16) & 1u)) >> 16; }
typedef __bf16 bf16x2n __attribute__((ext_vector_type(2)));
typedef float f32x2n __attribute__((ext_vector_type(2)));
__device__ __forceinline__ unsigned pk2(float lo, float hi) { const f32x2n v = {lo, hi}; return __builtin_bit_cast(unsigned, __builtin_convertvector(v, bf16x2n)); }
constexpr float W_SCALE = 256.0f, XS_SCALE = 8.0f, ACT_SCALE = 4.0f, YB_SCALE = 16.0f;
__device__ __forceinline__ float clamp_fp8(float x) { return __builtin_amdgcn_fmed3f(x, -448.0f, 448.0f); }
__device__ __forceinline__ unsigned pk4_fp8(float a, float b, float c, float d) {
    int w = 0; w = __builtin_amdgcn_cvt_pk_fp8_f32(clamp_fp8(a), clamp_fp8(b), w, false); w = __builtin_amdgcn_cvt_pk_fp8_f32(clamp_fp8(c), clamp_fp8(d), w, true); return (unsigned)w; }
__device__ __forceinline__ unsigned pk4_fp8_nc(float a, float b, float c, float d) {
    int w = 0; w = __builtin_amdgcn_cvt_pk_fp8_f32(a, b, w, false); w = __builtin_amdgcn_cvt_pk_fp8_f32(c, d, w, true); return (unsigned)w; }
__device__ __forceinline__ float wave_sum(float v) {
#pragma unroll
    for (int o = 1; o < 64; o <<= 1) v += __shfl_xor(v, o);
    return v;
}
__device__ __forceinline__ float wave_max(float v) {
#pragma unroll
    for (int o = 1; o < 64; o <<= 1) v = fmaxf(v, __shfl_xor(v, o));
    return v;
}
__device__ __forceinline__ float sigmoidf_(float x) { return 1.0f / (1.0f + __expf(-x)); }
__device__ __forceinline__ float fast_sigmoid(float x) { return __builtin_amdgcn_rcpf(1.0f + __builtin_amdgcn_exp2f(-1.4426950408889634f * x)); }
__device__ __forceinline__ float fast_gelu_tanh(float x) { const float u2 = 1.5957691216057308f * (x + 0.044715f * x * x * x); return x * __builtin_amdgcn_rcpf(1.0f + __builtin_amdgcn_exp2f(-1.4426950408889634f * u2)); }
__device__ __forceinline__ float gelu_tanh(float x) { const float u = 0.7978845608028654f * (x + 0.044715f * x * x * x); return 0.5f * x * (1.0f + tanhf(u)); }
__device__ __forceinline__ int tok_row(int b, int t) { return t < NMETA ? METAROW0 + t : b * SEQ + (t - NMETA); }

__device__ __forceinline__ void transpose_item(const float* W, int K, int N, bf16* WT, LAS float* scr, int item, int lane, const float* kgain = nullptr, int kgain_n = 0) {
    const int nblk = N / 32, kb = item / nblk, nb = item % nblk, k0 = 64 * kb, n0 = 32 * nb;
    const int c = lane & 7;
    f32x4 g0 = (f32x4){1.f, 1.f, 1.f, 1.f}, g1 = g0;
    if (kgain != nullptr && k0 < kgain_n) { g0 = *(const f32x4*)(kgain + k0 + 8 * c); g1 = *(const f32x4*)(kgain + k0 + 8 * c + 4); }
#pragma unroll 8
    for (int i = 0; i < 32; ++i) { const int kk = 2 * i + (lane >> 5); scr[kk * 33 + (lane & 31)] = W[(size_t)(k0 + kk) * N + n0 + (lane & 31)]; }
    asm volatile("s_waitcnt lgkmcnt(0)" ::: "memory");
#pragma unroll
    for (int j = 0; j < 4; ++j) { const int n = (lane >> 3) + 8 * j; const LAS float* s = scr + (8 * c) * 33 + n;
        u32x4 o; o.x = pk2(s[0 * 33] * g0.x, s[1 * 33] * g0.y); o.y = pk2(s[2 * 33] * g0.z, s[3 * 33] * g0.w); o.z = pk2(s[4 * 33] * g1.x, s[5 * 33] * g1.y); o.w = pk2(s[6 * 33] * g1.z, s[7 * 33] * g1.w);
        *(u32x4*)(WT + (size_t)(n0 + n) * K + k0 + 8 * c) = o; }
    asm volatile("s_waitcnt lgkmcnt(0)" ::: "memory");
}

#define G1_CONV_WG 24
#define G1_CONV_PER_WG 43
constexpr int CONV_ALL_TILES = (2 + (BG_WDOWN ? 0 : 1)) * 32 * (D / 128) * (D / 256);
__device__ __forceinline__ int g1_conv_wg() { return gridDim.x == 256 ? G1_CONV_WG : 0; }
__device__ __forceinline__ int conv_pro_tiles() { return CONV_ALL_TILES - g1_conv_wg() * G1_CONV_PER_WG; }
__device__ __forceinline__ void conv_tiles(const Args& a, LAS unsigned char* lds, int tid, int first, int last, int stride) {
    unsigned char* ws = a.ws;
    __syncthreads();
    {
        LAS unsigned* T = (LAS unsigned*)lds;
        const int n4 = tid & 63, kq = tid >> 6;
        constexpr int T_IN = G1_FP8 ? (D / 128) * (DIN / 256) : 0, T_OUT = G2_FP8 ? (D / 128) * (D / 256) : 0, T_E = (D / 128) * (D / 256);
        constexpr int N_GATE = 32 * T_E, N_UP = (BG_WUP && !BG_EXP) ? 256 * 6 : 32 * T_E, N_DOWN = (BG_WDOWN && !BG_EXP) ? 0 : 32 * T_E;
        constexpr int NTILES = T_IN + T_OUT + N_GATE + N_UP + N_DOWN;
        static_assert(NTILES == CONV_ALL_TILES, "tile list size");
        auto tile_ptrs = [&](int tile, const float*& sp, unsigned char*& dp, int& ldn) {
            const float* sbase; unsigned char* dbase; int tl, nt;
            if (tile < T_IN) { sbase = a.in[I_W_IN]; dbase = ws + WS_WINT; tl = tile; nt = DIN / 256; ldn = DIN; }
            else if (tile < T_IN + T_OUT) { sbase = a.in[I_W_OUT]; dbase = ws + WS_WOUTT; tl = tile - T_IN; nt = D / 256; ldn = D; }
            else { int r = tile - T_IN - T_OUT, which, e; nt = D / 256; ldn = D;
                   if (r < N_GATE) { which = 0; e = r / T_E; tl = r % T_E; }
                   else if (r < N_GATE + N_UP) { r -= N_GATE; which = 1; int g = r; if (BG_WUP && !BG_EXP) g = 16 * (r / 6) + 10 + (r % 6);
                                                 e = g / T_E; tl = g % T_E; }
                   else { r -= N_GATE + N_UP; which = 2; e = r / T_E; tl = r % T_E; }
                   sbase = a.in[which == 0 ? I_W_GATE : (which == 1 ? I_W_UP : I_W_DOWN)] + (size_t)e * D * D; dbase = ws + (which == 0 ? WS_WGT : (which == 1 ? WS_WUT : WS_WDT)) + (size_t)e * D * D; }
            const int k0 = (tl / nt) * 128, n0 = (tl % nt) * 256;
            sp = sbase + (size_t)(k0 + 4 * kq) * ldn + n0 + 4 * n4; dp = dbase + (size_t)n0 * D + k0; };
#define CONV_LOAD(R, tile) do { const float* _p; unsigned char* _d; int _ld; tile_ptrs(tile, _p, _d, _ld); _Pragma("unroll") for (int i = 0; i < 4; ++i) _Pragma("unroll") for (int q = 0; q < 4; ++q) \
            R[i][q] = __builtin_nontemporal_load((const f32x4*)(_p + (size_t)(32 * i + q) * _ld)); } while (0)
#define CONV_STORE(R, tile) do { _Pragma("unroll") for (int i = 0; i < 4; ++i) { const int kd = kq + 8 * i; \
            T[(4 * n4 + 0) * 33 + kd] = pk4_fp8(R[i][0].x * W_SCALE, R[i][1].x * W_SCALE, R[i][2].x * W_SCALE, R[i][3].x * W_SCALE); \
            T[(4 * n4 + 1) * 33 + kd] = pk4_fp8(R[i][0].y * W_SCALE, R[i][1].y * W_SCALE, R[i][2].y * W_SCALE, R[i][3].y * W_SCALE); \
            T[(4 * n4 + 2) * 33 + kd] = pk4_fp8(R[i][0].z * W_SCALE, R[i][1].z * W_SCALE, R[i][2].z * W_SCALE, R[i][3].z * W_SCALE); \
            T[(4 * n4 + 3) * 33 + kd] = pk4_fp8(R[i][0].w * W_SCALE, R[i][1].w * W_SCALE, R[i][2].w * W_SCALE, R[i][3].w * W_SCALE); } \
            __syncthreads(); \
            { const float* _p; unsigned char* _d; int _ld; tile_ptrs(tile, _p, _d, _ld); _Pragma("unroll") for (int i = 0; i < 4; ++i) { const int n = (tid >> 3) + 64 * i, c = tid & 7; \
                const u32x4 o = (u32x4){T[n * 33 + 4 * c], T[n * 33 + 4 * c + 1], T[n * 33 + 4 * c + 2], T[n * 33 + 4 * c + 3]}; \
                *(u32x4*)(_d + (size_t)n * D + 16 * c) = o; } } \
            __syncthreads(); } while (0)
        f32x4 RA[4][4], RB[4][4];
        int tile = first;
        if (tile < last) CONV_LOAD(RA, tile);
        while (tile < last) {
            int nxt = tile + stride;
            if (nxt < last) CONV_LOAD(RB, nxt);
            CONV_STORE(RA, tile);
            tile = nxt; if (tile >= last) break;
            nxt = tile + stride;
            if (nxt < last) CONV_LOAD(RA, nxt);
            CONV_STORE(RB, tile);
            tile = nxt;
        }
#undef CONV_LOAD
#undef CONV_STORE
    }
}
__device__ __forceinline__ void phase_prologue(const Args& a, LAS unsigned char* lds, int tid, int lane, int wave) {
    const int gw = blockIdx.x * 8 + wave, NGW = gridDim.x * 8;
    const int gt = blockIdx.x * 512 + tid, NGT = gridDim.x * 512;
    unsigned char* ws = a.ws;
    LAS float* scr = (LAS float*)(lds + wave * 8704);
    {
        constexpr int IT_IN = G1_FP8 ? 0 : 32 * (DIN / 32), IT_OUT = G2_FP8 ? 0 : 32 * (D / 32);
        for (int it = gw; it < IT_IN + IT_OUT; it += NGW) {
            if (it < IT_IN) transpose_item(a.in[I_W_IN], D, DIN, (bf16*)(ws + WS_WINT), scr, it, lane, a.in[I_NORM_MIX], D);
            else transpose_item(a.in[I_W_OUT], D, D, (bf16*)(ws + WS_WOUTT), scr, it - IT_IN, lane);
        }
        __syncthreads();
    }
    conv_tiles(a, lds, tid, blockIdx.x, conv_pro_tiles(), gridDim.x);
    static_assert(!G1_FP8, "xb is written as bf16");
    for (int r = gw; r < MROWS; r += NGW) {
        u32x4* orow = (u32x4*)((bf16*)(ws + WS_N1) + (size_t)r * D);
        if (r >= MVALID) {
#pragma unroll
            for (int j = 0; j < 4; ++j) orow[lane + 64 * j] = (u32x4){0u, 0u, 0u, 0u};
            if (lane == 0) ((float*)(ws + WS_RSTD1))[r] = 0.f;
            continue; }
        const f32x4* xr = (const f32x4*)(r < MREAL ? a.in[I_X] + (size_t)r * D : a.in[I_META] + (size_t)(r - MREAL) * D);
        f32x4 v[4][2]; float ss = 0.f;
#pragma unroll
        for (int j = 0; j < 4; ++j)
#pragma unroll
            for (int q = 0; q < 2; ++q) { v[j][q] = xr[2 * (lane + 64 * j) + q]; ss += (v[j][q].x * v[j][q].x + v[j][q].y * v[j][q].y) + (v[j][q].z * v[j][q].z + v[j][q].w * v[j][q].w); }
#pragma unroll
        for (int j = 0; j < 4; ++j) orow[lane + 64 * j] = (u32x4){pk2(v[j][0].x, v[j][0].y), pk2(v[j][0].z, v[j][0].w), pk2(v[j][1].x, v[j][1].y), pk2(v[j][1].z, v[j][1].w)};
        ss = wave_sum(ss);
        if (lane == 0) ((float*)(ws + WS_RSTD1))[r] = 1.0f / sqrtf(ss * (1.0f / D) + EPS);
    }
    float* cosT = (float*)(ws + WS_COS); float* sinT = (float*)(ws + WS_SIN);
    for (int i = gt; i < TT * 32; i += NGT) {
        const int pos = i >> 5, j = i & 31;
        const float ang = (float)pos * c_inv_freq[j];
        const double t = (double)ang * 0.15915494309189535; const float fr = (float)(t - floor(t));
        cosT[i] = __builtin_amdgcn_cosf(fr); sinT[i] = __builtin_amdgcn_sinf(fr);
    }
    { bf16* WaT = (bf16*)(ws + WS_WAT); bf16* WiT = (bf16*)(ws + WS_WIT);
      for (int i = gt; i < 16 * 64 * 64; i += NGT) { const int n = i >> 12, d = (i >> 6) & 63, cc = i & 63;
          WaT[i] = (bf16)f2bf(a.in[I_W_A][(n * 64 + cc) * 64 + d]); WiT[i] = (bf16)f2bf(a.in[I_W_I][(n * 64 + cc) * 64 + d]); } }
    { bf16* WRT = (bf16*)(ws + WS_WRT);
      for (int i = gt; i < NEXP * D; i += NGT) { const int e = i >> 11, k = i & 2047; WRT[i] = (bf16)f2bf(a.in[I_NORM_FFN][k] * a.in[I_W_ROUTER][k * NEXP + e]); } }
    int* rowpair = (int*)(ws + WS_ROWPAIR);
    for (int i = gt; i < PROWS; i += NGT) rowpair[i] = -1;
}

namespace pg8 {
constexpr int BM = 256, BK = 64, HALF = 128, HTB = HALF * BK * 2, STAGE_BYTES = 8 * HTB, NXCD = 8, WGM = 8, KD = 2048, NKT = KD / BK;
__host__ __device__ __forceinline__ int lds_byte(int r, int c) { const int st = (r >> 4) * 2 + (c >> 5), rr = r & 15, cc = c & 31, ob = rr * 64 + cc * 2; return st * 1024 + (ob ^ (((ob >> 9) & 1) << 5)); }
__host__ __device__ __forceinline__ void stage_rc(int b, int& R, int& C) { const int st = b / 1024, sb = b % 1024, swz = sb ^ (((sb >> 9) & 1) << 5); R = (st >> 1) * 16 + swz / 64; C = (st & 1) * 32 + (swz % 64) / 2; }
__host__ __device__ __forceinline__ int perm32(int rho) { const int n = rho >> 4, i = rho & 15; return 8 * (i >> 2) + 4 * n + (i & 3); }
struct Unit { unsigned a, b0, b1; int pm, pn, e; };
__device__ __forceinline__ bool static_tile(int i, int G, int c, int nM, int nN, int& pm, int& pn) {
    const int nwg = nM * nN; const long L = (long)i * G + c; if (L >= nwg) return false;
    int wgid = (int)L; { const int q = nwg >> 3, r = nwg & 7, xcd = wgid & 7, off = wgid >> 3; wgid = (xcd < r ? xcd * (q + 1) : r * (q + 1) + (xcd - r) * q) + off; }
    const int nig = WGM * nN; int gid, rem;
    if ((nN & (nN - 1)) == 0) { const int sh = 3 + (31 - __builtin_clz(nN)); gid = wgid >> sh; rem = wgid & (nig - 1); } else { gid = wgid / nig; rem = wgid - gid * nig; }
    const int fm = gid * WGM, gsz = (nM - fm) < WGM ? (nM - fm) : WGM;
    if (gsz == WGM) { pm = fm + (rem & 7); pn = rem >> 3; } else { pm = fm + rem % gsz; pn = rem / gsz; }
    return true;
}

typedef int i32x8 __attribute__((ext_vector_type(8)));
typedef int i32x4 __attribute__((ext_vector_type(4)));
__device__ __forceinline__ i32x8 cat8(bf16x8 lo, bf16x8 hi) { const i32x4 a = __builtin_bit_cast(i32x4, lo), b = __builtin_bit_cast(i32x4, hi); return __builtin_shufflevector(a, b, 0, 1, 2, 3, 4, 5, 6, 7); }
struct BGNone { static constexpr bool ON = false; };
struct BGConv { static constexpr bool ON = true; const char* src; unsigned char* dst; int next, end; unsigned char* dummy; };
__device__ __forceinline__ void bg_pair_ptrs(const BGConv& bg, int pair, const char*& sp, unsigned char*& dp) {
    const int e = pair >> 10, kbp = (pair >> 6) & 15, nb = pair & 63;
    sp = bg.src + ((size_t)(e * 2048 + 128 * kbp) * 2048 + 32 * nb) * 4; dp = bg.dst + (size_t)e * 2048 * 2048 + (size_t)(32 * nb) * 2048 + 128 * kbp; }
template <bool FP8, class Epi, class Sched, class BG, bool GATHER = false>
__device__ __forceinline__ void gemm_phase(LAS unsigned char* lds, const Sched& S, const Epi& E, BG& bg) {
    constexpr int ROWB = FP8 ? 2048 : 4096, NKTL = ROWB / 128;
    const int tid = threadIdx.x, wid = __builtin_amdgcn_readfirstlane(tid >> 6), lane = tid & 63, wr = wid >> 2, wc = wid & 3, fr = lane & 15, fq = lane >> 4;
    unsigned voffA[2], voffB[2];
#pragma unroll
    for (int i = 0; i < 2; ++i) { int R, C; stage_rc(tid * 16 + i * 8192, R, C); const int Rb = Epi::PERM ? ((R & ~31) + perm32(R & 31)) : R;
        voffA[i] = (unsigned)(R * ROWB + C * 2); voffB[i] = (unsigned)(Rb * ROWB + C * 2); }
    constexpr unsigned KS = BK * 2, HS = HALF * ROWB;
    const unsigned ldsw = (unsigned)wid * 1024u;
    const __amdgpu_buffer_rsrc_t rsA = __builtin_amdgcn_make_buffer_rsrc((void*)S.A, 0, 0x7ffffff0, 0x00020000), rsB0 = __builtin_amdgcn_make_buffer_rsrc((void*)S.B0, 0, 0x7ffffff0, 0x00020000), rsB1 = __builtin_amdgcn_make_buffer_rsrc((void*)S.B1, 0, 0x7ffffff0, 0x00020000);
    const int aoff = lds_byte(wr * 64 + fr, fq * 8), boff = lds_byte(wc * 32 + fr, fq * 8);
#define PG8_SA(b, h) (((b) * 2 + (h)) * HTB)
#define PG8_SB(b, h) ((4 + (b) * 2 + (h)) * HTB)
#define PG8_STAGE(bufoff, rs, soff, voff) do { _Pragma("unroll") for (int _i = 0; _i < 2; ++_i) \
        __builtin_amdgcn_raw_ptr_buffer_load_lds(rs, (LAS void*)(lds + (bufoff) + ldsw + _i * 8192), 16, (int)(voff)[_i], (int)(soff), 0, 0); } while (0)
    unsigned gA[2][2] = {{0u, 0u}, {0u, 0u}}, gN[2][2] = {{0u, 0u}, {0u, 0u}};
#define PG8_GOFF(dst, slot) do { int tz_ = threadIdx.x; asm volatile("" : "+v"(tz_)); _Pragma("unroll") for (int _i = 0; _i < 2; ++_i) { int R_, C_; stage_rc(tz_ * 16 + _i * 8192, R_, C_); \
        _Pragma("unroll") for (int _h = 0; _h < 2; ++_h) { const int id_ = *(const LAS int*)(lds + LDS_RID + (slot) * 1024 + (_h * 128 + R_) * 4); dst[_h][_i] = (unsigned)((id_ < 0 ? 0 : (id_ >> 2)) * ROWB + C_ * 2); } } } while (0)
#define PG8_STAGEA(bufoff, h, soff_dense, koff, nx) do { if constexpr (GATHER) { unsigned v_[2]; v_[0] = (nx) ? gN[h][0] : gA[h][0]; v_[1] = (nx) ? gN[h][1] : gA[h][1]; PG8_STAGE(bufoff, rsA, koff, v_); } \
        else PG8_STAGE(bufoff, rsA, (soff_dense) + (h) * HS, voffA); } while (0)
#define PG8_LDA(dst, b, h) do { _Pragma("unroll") for (int m = 0; m < 4; ++m) { \
        if constexpr (FP8) dst##8[m] = __builtin_shufflevector(*(const LAS i32x4*)(lds + PG8_SA(b, h) + aoff + m * 2048), *(const LAS i32x4*)(lds + PG8_SA(b, h) + aoff + m * 2048 + 1024), 0, 1, 2, 3, 4, 5, 6, 7); \
        else { _Pragma("unroll") for (int k = 0; k < 2; ++k) dst[m][k] = *(const LAS bf16x8*)(lds + PG8_SA(b, h) + aoff + m * 2048 + k * 1024); } } } while (0)
#define PG8_LDB(dst, b, h) do { _Pragma("unroll") for (int n = 0; n < 2; ++n) { \
        if constexpr (FP8) dst##8[n] = __builtin_shufflevector(*(const LAS i32x4*)(lds + PG8_SB(b, h) + boff + n * 2048), *(const LAS i32x4*)(lds + PG8_SB(b, h) + boff + n * 2048 + 1024), 0, 1, 2, 3, 4, 5, 6, 7); \
        else { _Pragma("unroll") for (int k = 0; k < 2; ++k) dst[n][k] = *(const LAS bf16x8*)(lds + PG8_SB(b, h) + boff + n * 2048 + k * 1024); } } } while (0)
#define PG8_MMA(ai, bj, At, Bt) do { _Pragma("unroll") for (int m = 0; m < 4; ++m) _Pragma("unroll") for (int n = 0; n < 2; ++n) { \
        if constexpr (FP8) asm volatile("v_mfma_f32_16x16x128_f8f6f4 %0, %1, %2, %0" : "+v"(acc[ai][bj][m][n]) : "v"(Bt##8[n]), "v"(At##8[m])); \
        else { _Pragma("unroll") for (int k = 0; k < 2; ++k) asm volatile("v_mfma_f32_16x16x32_bf16 %0, %1, %2, %0" : "+v"(acc[ai][bj][m][n]) : "v"(Bt[n][k]), "v"(At[m][k])); } } \
        } while (0)
#define PG8_WAIT_V(n) asm volatile("s_waitcnt vmcnt(" #n ")" ::: "memory")
#define PG8_WAIT_L(n) asm volatile("s_waitcnt lgkmcnt(" #n ")" ::: "memory")
#define PG8_BAR __builtin_amdgcn_s_barrier()
#define PG8_SCHED __builtin_amdgcn_sched_barrier(0)
    Unit cur, nxt; int ui = 0; bool bg_pending = false;
    if (!S.next(0, cur)) return;
    f32x4 acc[2][2][4][2];
#pragma unroll
    for (int a = 0; a < 2; ++a)
#pragma unroll
        for (int b = 0; b < 2; ++b)
#pragma unroll
            for (int m = 0; m < 4; ++m)
#pragma unroll
                for (int n = 0; n < 2; ++n) acc[a][b][m][n] = (f32x4){0.f, 0.f, 0.f, 0.f};
    bf16x8 At[4][2], B0[2][2], B1[2][2];
    i32x8 At8[4], B08[2], B18[2];
    if constexpr (GATHER) {
        if (tid < 256) *(LAS int*)(lds + LDS_RID + tid * 4) = S.rows[cur.pm * BM + tid];
        __syncthreads();
        PG8_GOFF(gA, 0);
    }
    PG8_STAGE(PG8_SB(0, 0), rsB0, cur.b0, voffB); PG8_STAGE(PG8_SB(0, 1), rsB1, cur.b1, voffB); PG8_STAGEA(PG8_SA(0, 0), 0, cur.a, 0u, false); PG8_STAGEA(PG8_SA(0, 1), 1, cur.a, 0u, false);
    if (wr == 1) PG8_BAR;
    PG8_WAIT_V(2); PG8_BAR;
    PG8_STAGE(PG8_SB(1, 0), rsB0, cur.b0 + KS, voffB); PG8_STAGEA(PG8_SA(1, 0), 0, cur.a + KS, KS, false); PG8_STAGE(PG8_SB(1, 1), rsB1, cur.b1 + KS, voffB);
    PG8_WAIT_V(6); PG8_BAR;
    for (;;) {
        const bool has_next = S.next(ui + 1, nxt);
        const unsigned nA = has_next ? nxt.a : cur.a, nB0 = has_next ? nxt.b0 : cur.b0, nB1 = has_next ? nxt.b1 : cur.b1;
        for (int t = 0; t < NKTL; t += 2) {
            const bool last = (t == NKTL - 2);
            const unsigned a1 = cur.a + (unsigned)(t + 1) * KS;
            const unsigned a2 = last ? nA : cur.a + (unsigned)(t + 2) * KS;
            const unsigned b20 = last ? nB0 : cur.b0 + (unsigned)(t + 2) * KS, b21 = last ? nB1 : cur.b1 + (unsigned)(t + 2) * KS;
            const unsigned a3 = a2 + KS, b30 = b20 + KS, b31 = b21 + KS;
            const unsigned k1 = (unsigned)(t + 1) * KS, k2 = last ? 0u : (unsigned)(t + 2) * KS;
            if constexpr (GATHER) { if (last) { if (has_next) PG8_GOFF(gN, (ui + 1) & 1); else { gN[0][0] = gA[0][0]; gN[0][1] = gA[0][1]; gN[1][0] = gA[1][0]; gN[1][1] = gA[1][1]; } } }
            PG8_LDB(B0, 0, 0); PG8_LDB(B1, 0, 1); PG8_SCHED; PG8_LDA(At, 0, 0); PG8_STAGEA(PG8_SA(1, 1), 1, a1, k1, false);
            if constexpr (GATHER) { if (t == 2 && has_next && wid == 3) __builtin_amdgcn_global_load_lds((const unsigned*)(S.rows + nxt.pm * BM + lane * 4), (LAS unsigned*)(lds + LDS_RID + ((ui + 1) & 1) * 1024), 16, 0, 0); }
            if (t == 2) E.prefetch(cur, lds, wid, lane);
            PG8_WAIT_V(8); PG8_WAIT_L(0); PG8_BAR; PG8_MMA(0, 0, At, B0);
            if constexpr (BG::ON) {
                PG8_SCHED;
                int tz = threadIdx.x; asm volatile("" : "+v"(tz));
#pragma unroll
                for (int j = 0; j < (BG_EXP == 1 ? 0 : 2); ++j) { const LAS float* p = (const LAS float*)(lds + LDS_BG + j * 8192 + (tz >> 5) * 512 + (tz & 31) * 4);
                    ((LAS unsigned*)(lds + LDS_T2))[(tz & 31) * 33 + 16 * j + (tz >> 5)] = pk4_fp8(p[0] * W_SCALE, p[32] * W_SCALE, p[64] * W_SCALE, p[96] * W_SCALE); }
                const char* bgs; { unsigned char* dp_; pg8::bg_pair_ptrs(bg, bg.next < bg.end ? bg.next : bg.end - 1, bgs, dp_); }
                PG8_SCHED;
                if (BG_EXP != 2) {
                const unsigned bgv = (unsigned)((8 * wid + ((tz & 63) >> 3)) * 8192 + (tz & 7) * 16);
                __builtin_amdgcn_global_load_lds((const unsigned*)(bgs + bgv), (LAS unsigned*)(lds + LDS_BG + ldsw), 16, 0, 0);
                __builtin_amdgcn_global_load_lds((const unsigned*)(bgs + 524288 + bgv), (LAS unsigned*)(lds + LDS_BG + 8192 + ldsw), 16, 0, 0); }
                PG8_SCHED; }
            PG8_MMA(0, 1, At, B1);
            if constexpr (BG::ON) { PG8_WAIT_L(0); }
            PG8_BAR; PG8_SCHED;
            PG8_LDA(At, 0, 1); PG8_STAGE(PG8_SB(0, 0), rsB0, b20, voffB); PG8_STAGE(PG8_SB(0, 1), rsB1, b21, voffB); PG8_STAGEA(PG8_SA(0, 0), 0, a2, k2, last);
            if constexpr (BG::ON) { if (BG_EXP == 2) PG8_WAIT_V(8); else PG8_WAIT_V(10); } else { PG8_WAIT_V(8); }
            PG8_WAIT_L(0); PG8_BAR; PG8_MMA(1, 0, At, B0);
            if constexpr (BG::ON) {
                PG8_SCHED;
                unsigned char* bgd; { const char* sp_; pg8::bg_pair_ptrs(bg, bg.next - 1 < bg.end ? bg.next - 1 : bg.end - 1, sp_, bgd); }
                int tz = threadIdx.x; asm volatile("" : "+v"(tz));
                const LAS unsigned* q = (const LAS unsigned*)(lds + LDS_T2) + (tz >> 4) * 33 + 2 * (tz & 15);
                const u32x2 w = (u32x2){q[0], q[1]};
                if (BG_EXP != 1) *(u32x2*)((bg_pending && !BG_EXP) ? bgd + (size_t)(tz >> 4) * 2048 + 8 * (tz & 15) : bg.dummy + 8 * tz) = w;
                ++bg.next; bg_pending = true;
                PG8_SCHED; }
            PG8_MMA(1, 1, At, B1); PG8_BAR; PG8_SCHED;
            PG8_LDB(B0, 1, 0); PG8_LDB(B1, 1, 1); PG8_SCHED; PG8_LDA(At, 1, 0); PG8_STAGEA(PG8_SA(0, 1), 1, a2, k2, last);
            if constexpr (BG::ON) { if (BG_EXP == 1) PG8_WAIT_V(10); else if (BG_EXP == 2) PG8_WAIT_V(9); else PG8_WAIT_V(11); } else { PG8_WAIT_V(8); }
            PG8_WAIT_L(0); PG8_BAR; PG8_MMA(0, 0, At, B0); PG8_MMA(0, 1, At, B1); PG8_BAR; PG8_SCHED;
            PG8_LDA(At, 1, 1); PG8_STAGE(PG8_SB(1, 0), rsB0, b30, voffB); PG8_STAGE(PG8_SB(1, 1), rsB1, b31, voffB); PG8_STAGEA(PG8_SA(1, 0), 0, a3, k2 + KS, last);
            if constexpr (BG::ON) { if (BG_EXP == 1) PG8_WAIT_V(8); else PG8_WAIT_V(9); } else { PG8_WAIT_V(8); }
            PG8_WAIT_L(0); PG8_BAR; PG8_MMA(1, 0, At, B0); PG8_MMA(1, 1, At, B1); PG8_BAR; PG8_SCHED;
        }
        if (wr == 0) PG8_BAR;
        asm volatile("s_nop 15\n\ts_nop 15" ::: "memory");
        E(acc, cur, wr, wc, fr, fq, lds);
        if (!has_next) break;
#pragma unroll
        for (int a = 0; a < 2; ++a)
#pragma unroll
            for (int b = 0; b < 2; ++b)
#pragma unroll
                for (int m = 0; m < 4; ++m)
#pragma unroll
                    for (int n = 0; n < 2; ++n) acc[a][b][m][n] = (f32x4){0.f, 0.f, 0.f, 0.f};
        cur = nxt; ++ui;
        if constexpr (GATHER) { gA[0][0] = gN[0][0]; gA[0][1] = gN[0][1]; gA[1][0] = gN[1][0]; gA[1][1] = gN[1][1]; }
        if (wr == 1) PG8_BAR;
    }
    PG8_WAIT_V(0);
    PG8_BAR;
    if constexpr (BG::ON) { if (bg_pending && !BG_EXP) {
        unsigned char* bgd; { const char* sp_; pg8::bg_pair_ptrs(bg, bg.next - 1 < bg.end ? bg.next - 1 : bg.end - 1, sp_, bgd); }
#pragma unroll
        for (int j = 0; j < 2; ++j) { const LAS float* p = (const LAS float*)(lds + LDS_BG + j * 8192 + (tid >> 5) * 512 + (tid & 31) * 4);
            ((LAS unsigned*)(lds + LDS_T2))[(tid & 31) * 33 + 16 * j + (tid >> 5)] = pk4_fp8(p[0] * W_SCALE, p[32] * W_SCALE, p[64] * W_SCALE, p[96] * W_SCALE); }
        __syncthreads();
        const LAS unsigned* q = (const LAS unsigned*)(lds + LDS_T2) + (tid >> 4) * 33 + 2 * (tid & 15);
        *(u32x2*)(bgd + (size_t)(tid >> 4) * 2048 + 8 * (tid & 15)) = (u32x2){q[0], q[1]}; } }
#undef PG8_SA
#undef PG8_SB
#undef PG8_STAGE
#undef PG8_STAGEA
#undef PG8_GOFF
#undef PG8_LDA
#undef PG8_LDB
#undef PG8_MMA
#undef PG8_WAIT_V
#undef PG8_WAIT_L
#undef PG8_BAR
#undef PG8_SCHED
}

struct SchedDense {
    const char* A; const char* B0; const char* B1; const int* rows; int nM, nN, G, c, rowb;
    __device__ __forceinline__ bool next(int i, Unit& u) const {
        int pm, pn; if (!static_tile(i, G, c, nM, nN, pm, pn)) return false;
        u.pm = pm; u.pn = pn; u.e = 0; u.a = (unsigned)pm * BM * rowb; u.b0 = (unsigned)pn * BM * rowb; u.b1 = u.b0 + (unsigned)HALF * rowb; return true;
    }
};
struct SchedMoE {
    const char* A; const char* B0; const char* B1; const int* rows; const LAS int* tstart; int nM, nN, G, c; bool split;
    __device__ __forceinline__ bool next(int i, Unit& u) const {
        int pm, pn; if (!static_tile(i, G, c, nM, nN, pm, pn)) return false;
        const int e = ((const LAS unsigned char*)(tstart + 64))[pm];
        u.pm = pm; u.pn = pn; u.e = e; u.a = (unsigned)pm * (BM * 2048);
        const unsigned eoff = (unsigned)e * (2048u * 2048u);
        if (split) { u.b0 = eoff + (unsigned)pn * (HALF * 2048); u.b1 = u.b0; }
        else { u.b0 = eoff + (unsigned)pn * (BM * 2048); u.b1 = u.b0 + (unsigned)HALF * 2048; }
        return true;
    }
};

__device__ __forceinline__ u32x4 widen16(u32x2 x, u32x2 y) {
    const auto r0 = __builtin_amdgcn_permlane16_swap(x.x, y.x, false, false), r1 = __builtin_amdgcn_permlane16_swap(x.y, y.y, false, false);
    return (u32x4){r0[0], r1[0], r0[1], r1[1]};
}
struct EpiZ {
    static constexpr bool PERM = true;
    bf16* Z; const float* bias; const float* rstd1;
    __device__ __forceinline__ void prefetch(const Unit& u, LAS unsigned char* lds, int wid, int lane) const {
        if (wid == 0) __builtin_amdgcn_global_load_lds((const unsigned*)(rstd1 + u.pm * BM + lane * 4), (LAS unsigned*)(lds + LDS_META), 16, 0, 0);
    }
    __device__ __forceinline__ void operator()(const f32x4 (&acc)[2][2][4][2], const Unit& u, int wr, int wc, int fr, int fq, const LAS unsigned char* lds) const {
        const int row0 = u.pm * BM + wr * 64 + fr, col0 = u.pn * BM + wc * 32 + 8 * fq;
        f32x4 bv[2][2];
#pragma unroll
        for (int bj = 0; bj < 2; ++bj)
#pragma unroll
            for (int n = 0; n < 2; ++n) bv[bj][n] = *(const f32x4*)(bias + col0 + bj * HALF + 4 * n);
#pragma unroll
        for (int ai = 0; ai < 2; ++ai)
#pragma unroll
            for (int m = 0; m < 4; ++m) { bf16* rowp = Z + (size_t)(row0 + ai * HALF + m * 16) * DIN + col0;
                const float sc = ((const LAS float*)(lds + LDS_META))[ai * HALF + wr * 64 + m * 16 + fr];
#pragma unroll
                for (int bj = 0; bj < 2; ++bj) { const f32x4 v0 = acc[ai][bj][m][0] * sc + bv[bj][0], v1 = acc[ai][bj][m][1] * sc + bv[bj][1];
                    u32x4 w; w.x = pk2(v0[0], v0[1]); w.y = pk2(v0[2], v0[3]); w.z = pk2(v1[0], v1[1]); w.w = pk2(v1[2], v1[3]);
                    *(u32x4*)(rowp + bj * HALF) = w; } }
    }
};
struct EpiH1 {
    static constexpr bool PERM = true;
    bf16* H1; const bf16* x; const float* bias; float sc;
    __device__ __forceinline__ void prefetch(const Unit&, LAS unsigned char*, int, int) const {}
    __device__ __forceinline__ void operator()(const f32x4 (&acc)[2][2][4][2], const Unit& u, int wr, int wc, int fr, int fq, const LAS unsigned char*) const {
        const int row0 = u.pm * BM + wr * 64 + fr, col0 = u.pn * BM + wc * 32 + 8 * fq;
        f32x4 bv[2][2];
#pragma unroll
        for (int bj = 0; bj < 2; ++bj)
#pragma unroll
            for (int n = 0; n < 2; ++n) bv[bj][n] = *(const f32x4*)(bias + col0 + bj * HALF + 4 * n);
#pragma unroll
        for (int ai = 0; ai < 2; ++ai) {
            u32x4 xv[4][2];
#pragma unroll
            for (int m = 0; m < 4; ++m) { const size_t ro = (size_t)(row0 + ai * HALF + m * 16) * D + col0;
#pragma unroll
                for (int bj = 0; bj < 2; ++bj) xv[m][bj] = __builtin_nontemporal_load((const u32x4*)(x + ro + bj * HALF)); }
#pragma unroll
            for (int m = 0; m < 4; ++m) { const size_t ro = (size_t)(row0 + ai * HALF + m * 16) * D + col0;
#pragma unroll
                for (int bj = 0; bj < 2; ++bj) { const u32x4 xx = xv[m][bj];
                    const f32x4 v0 = (f32x4){bflo(xx[0]), bfhi(xx[0]), bflo(xx[1]), bfhi(xx[1])} + acc[ai][bj][m][0] * sc + bv[bj][0], v1 = (f32x4){bflo(xx[2]), bfhi(xx[2]), bflo(xx[3]), bfhi(xx[3])} + acc[ai][bj][m][1] * sc + bv[bj][1];
                    u32x4 w; w.x = pk2(v0[0], v0[1]); w.y = pk2(v0[2], v0[3]); w.z = pk2(v1[0], v1[1]); w.w = pk2(v1[2], v1[3]);
                    *(u32x4*)(H1 + ro + bj * HALF) = w; } }
        }
    }
};
struct EpiAct {
    static constexpr bool PERM = true;
    unsigned char* ACT; const float* bg; const float* bu;
    __device__ __forceinline__ void prefetch(const Unit& u, LAS unsigned char* lds, int wid, int lane) const {
        if (wid == 0) { const float* p = (lane < 32 ? bg : bu) + (size_t)u.e * DFF + u.pn * HALF + (lane & 31) * 4;
            __builtin_amdgcn_global_load_lds((const unsigned*)p, (LAS unsigned*)(lds + LDS_META), 16, 0, 0); }
    }
    __device__ __forceinline__ void operator()(const f32x4 (&acc)[2][2][4][2], const Unit& u, int wr, int wc, int fr, int fq, const LAS unsigned char* lds) const {
        const int row0 = u.pm * BM + wr * 64 + fr, cl = wc * 32 + 8 * fq, col0 = u.pn * HALF + cl;
        f32x4 gv[2], uv[2];
#pragma unroll
        for (int n = 0; n < 2; ++n) { gv[n] = *(const LAS f32x4*)(lds + LDS_META + (cl + 4 * n) * 4); uv[n] = *(const LAS f32x4*)(lds + LDS_META + 512 + (cl + 4 * n) * 4); }
#pragma unroll
        for (int ai = 0; ai < 2; ++ai)
#pragma unroll
            for (int mp = 0; mp < 2; ++mp) { u32x2 pc[2];
#pragma unroll
                for (int mi = 0; mi < 2; ++mi) { const int m = 2 * mp + mi; float r[8];
#pragma unroll
                    for (int n = 0; n < 2; ++n)
#pragma unroll
                        for (int j = 0; j < 4; ++j) { float g = acc[ai][0][m][n][j] * (1.0f / (W_SCALE * XS_SCALE)) + gv[n][j], up = acc[ai][1][m][n][j] * (1.0f / (W_SCALE * XS_SCALE)) + uv[n][j];
                            g = fminf(g, 7.0f); up = fminf(fmaxf(up, -7.0f), 7.0f);
                            r[n * 4 + j] = g * __builtin_amdgcn_rcpf(1.0f + __builtin_amdgcn_exp2f((-1.702f * 1.4426950408889634f) * g)) * fmaf(up, ACT_SCALE, ACT_SCALE); }
                    pc[mi] = (u32x2){pk4_fp8_nc(r[0], r[1], r[2], r[3]), pk4_fp8_nc(r[4], r[5], r[6], r[7])}; }
                const u32x4 w = widen16(pc[0], pc[1]);
                const int m = 2 * mp + (fq & 1);
                *(u32x4*)(ACT + (size_t)(row0 + ai * HALF + m * 16) * DFF + col0 - 8 * (fq & 1)) = w; }
    }
};
struct EpiDown {
    static constexpr bool PERM = true;
    unsigned char* YB; const float* bd;
    __device__ __forceinline__ void prefetch(const Unit& u, LAS unsigned char* lds, int wid, int lane) const {
        if (wid == 0) __builtin_amdgcn_global_load_lds((const unsigned*)(bd + (size_t)u.e * D + u.pn * BM + lane * 4), (LAS unsigned*)(lds + LDS_META), 16, 0, 0);
    }
    __device__ __forceinline__ void operator()(const f32x4 (&acc)[2][2][4][2], const Unit& u, int wr, int wc, int fr, int fq, const LAS unsigned char* lds) const {
        const int row0 = u.pm * BM + wr * 64 + fr, cl = wc * 32 + 8 * fq, col0 = u.pn * BM + cl;
        f32x4 bv[2][2];
#pragma unroll
        for (int bj = 0; bj < 2; ++bj)
#pragma unroll
            for (int n = 0; n < 2; ++n) bv[bj][n] = *(const LAS f32x4*)(lds + LDS_META + (cl + bj * HALF + 4 * n) * 4) * YB_SCALE;
#pragma unroll
        for (int ai = 0; ai < 2; ++ai)
#pragma unroll
            for (int m = 0; m < 4; ++m) { u32x2 pc[2];
#pragma unroll
                for (int bj = 0; bj < 2; ++bj) { const f32x4 v0 = acc[ai][bj][m][0] * (YB_SCALE / (W_SCALE * ACT_SCALE)) + bv[bj][0], v1 = acc[ai][bj][m][1] * (YB_SCALE / (W_SCALE * ACT_SCALE)) + bv[bj][1];
                    pc[bj] = (u32x2){pk4_fp8(v0[0], v0[1], v0[2], v0[3]), pk4_fp8(v1[0], v1[1], v1[2], v1[3])}; }
                const u32x4 w = widen16(pc[0], pc[1]);
                *(u32x4*)(YB + (size_t)(row0 + ai * HALF + m * 16) * D + col0 + (fq & 1) * (HALF - 8)) = w; }
    }
};
}


typedef float f32x16 __attribute__((ext_vector_type(16)));
constexpr int AT_KS = 144, AT_VS = 584, AT_KOFF = 0, AT_VOFF = 288 * AT_KS;

__device__ __forceinline__ void attn_tile(LAS unsigned char* lds, int slot_base, int kind, int j, int lane, int hq,
                                          const bf16x8 (&qf)[2][4], f32x16 (&oacc)[2][2], float (&mrow)[2], float (&lrow)[2]) {
    const int r31 = lane & 31, h = lane >> 5;
    bf16x8 kf[4], vf[2][2];
#pragma unroll
    for (int ks = 0; ks < 4; ++ks) kf[ks] = *(const LAS bf16x8*)(lds + AT_KOFF + (slot_base + r31) * AT_KS + (16 * ks + 8 * h) * 2);
#pragma unroll
    for (int dt = 0; dt < 2; ++dt)
#pragma unroll
        for (int sp = 0; sp < 2; ++sp) { const LAS unsigned char* p = lds + AT_VOFF + (32 * dt + r31) * AT_VS + (slot_base + 16 * sp + 4 * h) * 2;
            const u32x2 lo = *(const LAS u32x2*)p, hi = *(const LAS u32x2*)(p + 16);
            const u32x4 w = (u32x4){lo.x, lo.y, hi.x, hi.y}; vf[dt][sp] = __builtin_bit_cast(bf16x8, w); }
#pragma unroll
    for (int qt = 0; qt < 2; ++qt) {
        f32x16 s;
#pragma unroll
        for (int r = 0; r < 16; ++r) s[r] = 0.f;
#pragma unroll
        for (int ks = 0; ks < 4; ++ks) s = __builtin_amdgcn_mfma_f32_32x32x16_bf16(kf[ks], qf[qt][ks], s, 0, 0, 0);
        const int i = 64 * hq + 32 * qt + r31;
        float mx = -1.0e30f;
#pragma unroll
        for (int r = 0; r < 16; ++r) { const int key = (r & 3) + 8 * (r >> 2) + 4 * h;
            const bool ok = kind == 0 ? (key < 16) : (kind == 1 ? (32 * j + key >= i + 1) : (32 * j + key <= i));
            s[r] = ok ? s[r] : -1.0e30f; mx = fmaxf(mx, s[r]); }
        mx = fmaxf(mx, __shfl_xor(mx, 32));
        const float mn = fmaxf(mrow[qt], mx), al = __expf(mrow[qt] - mn); mrow[qt] = mn;
        float ps = 0.f;
#pragma unroll
        for (int r = 0; r < 16; ++r) { s[r] = __expf(s[r] - mn); ps += s[r]; }
        lrow[qt] = lrow[qt] * al + ps;
#pragma unroll
        for (int dt = 0; dt < 2; ++dt)
#pragma unroll
            for (int r = 0; r < 16; ++r) oacc[qt][dt][r] *= al;
        bf16x8 pf[2];
#pragma unroll
        for (int sp = 0; sp < 2; ++sp) { const u32x4 w = (u32x4){pk2(s[8 * sp + 0], s[8 * sp + 1]), pk2(s[8 * sp + 2], s[8 * sp + 3]), pk2(s[8 * sp + 4], s[8 * sp + 5]), pk2(s[8 * sp + 6], s[8 * sp + 7])};
            pf[sp] = __builtin_bit_cast(bf16x8, w); }
#pragma unroll
        for (int dt = 0; dt < 2; ++dt)
#pragma unroll
            for (int sp = 0; sp < 2; ++sp) oacc[qt][dt] = __builtin_amdgcn_mfma_f32_32x32x16_bf16(vf[dt][sp], pf[sp], oacc[qt][dt], 0, 0, 0);
    }
}

__device__ __forceinline__ void attn_item(const Args& a, LAS unsigned char* lds, int item, int tid, int lane, int wave) {
    const int kvh = item & 3, qblk = (item >> 2) & 15, b = item >> 6;
    const bf16* Z = (const bf16*)(a.ws + WS_Z); bf16* O = (bf16*)(a.ws + (G2_FP8 ? WS_ATT : WS_O)); constexpr int OLD = G2_FP8 ? 1024 : D;
    const float* cosT = (const float*)(a.ws + WS_COS); const float* sinT = (const float*)(a.ws + WS_SIN);
    __syncthreads();
    for (int task = tid; task < 288 * 4; task += 512) {
        const int slot = task >> 2, c = task & 3;
        int krow, kpos; bool valid;
        if (slot < 32) { valid = slot < NMETA; krow = METAROW0 + slot; kpos = slot; }
        else { const int sp = 128 * (qblk - 1) + (slot - 32); valid = sp >= 0; krow = b * SEQ + sp; kpos = NMETA + sp; }
        u32x4 lo = (u32x4){0u, 0u, 0u, 0u}, hi = lo;
        if (valid) {
            const bf16* kp = Z + (size_t)krow * DIN + ZK + kvh * 64 + c * 8;
            const u32x4 x1 = *(const u32x4*)kp, x2 = *(const u32x4*)(kp + 32);
            const f32x4 c0 = *(const f32x4*)(cosT + kpos * 32 + c * 8), c1 = *(const f32x4*)(cosT + kpos * 32 + c * 8 + 4);
            const f32x4 s0 = *(const f32x4*)(sinT + kpos * 32 + c * 8), s1 = *(const f32x4*)(sinT + kpos * 32 + c * 8 + 4);
#pragma unroll
            for (int q = 0; q < 4; ++q) { const float ca = q < 2 ? c0[2 * q] : c1[2 * q - 4], cb = q < 2 ? c0[2 * q + 1] : c1[2 * q - 3], sa = q < 2 ? s0[2 * q] : s1[2 * q - 4], sb = q < 2 ? s0[2 * q + 1] : s1[2 * q - 3];
                const float a0 = bflo(x1[q]), a1 = bfhi(x1[q]), b0 = bflo(x2[q]), b1 = bfhi(x2[q]);
                lo[q] = pk2(a0 * ca - b0 * sa, a1 * cb - b1 * sb); hi[q] = pk2(b0 * ca + a0 * sa, b1 * cb + a1 * sb); }
        }
        *(LAS u32x4*)(lds + AT_KOFF + slot * AT_KS + c * 16) = lo; *(LAS u32x4*)(lds + AT_KOFF + slot * AT_KS + 64 + c * 16) = hi;
    }
    for (int task = tid; task < 144 * 8; task += 512) {
        const int slot0 = (task >> 3) * 2, c = task & 7;
        int vrow; bool valid;
        if (slot0 < 32) { valid = slot0 < NMETA; vrow = METAROW0 + slot0; }
        else { const int sp = 128 * (qblk - 1) + (slot0 - 32); valid = sp >= 0; vrow = b * SEQ + sp; }
        u32x4 v0 = (u32x4){0u, 0u, 0u, 0u}, v1 = v0;
        if (valid) { const bf16* vp = Z + (size_t)vrow * DIN + ZV + kvh * 64 + c * 8; v0 = *(const u32x4*)vp; v1 = *(const u32x4*)(vp + DIN); }
#pragma unroll
        for (int q = 0; q < 4; ++q) {
            *(LAS unsigned*)(lds + AT_VOFF + (c * 8 + 2 * q) * AT_VS + slot0 * 2) = (v0[q] & 0xffffu) | (v1[q] << 16);
            *(LAS unsigned*)(lds + AT_VOFF + (c * 8 + 2 * q + 1) * AT_VS + slot0 * 2) = (v0[q] >> 16) | (v1[q] & 0xffff0000u); }
    }
    const int g = wave >> 1, hq = wave & 1, head = kvh * 4 + g, r31 = lane & 31, h = lane >> 5;
    bf16x8 qf[2][4];
#pragma unroll
    for (int qt = 0; qt < 2; ++qt) {
        const int s = 128 * qblk + 64 * hq + 32 * qt + r31, pos = NMETA + s;
        const bf16* qp = Z + (size_t)(b * SEQ + s) * DIN + ZQ + head * 64 + 8 * h;
        u32x4 x[4];
#pragma unroll
        for (int ks = 0; ks < 4; ++ks) x[ks] = *(const u32x4*)(qp + 16 * ks);
#pragma unroll
        for (int ks = 0; ks < 2; ++ks) {
            const float* cp = cosT + pos * 32 + 16 * ks + 8 * h; const float* sp = sinT + pos * 32 + 16 * ks + 8 * h;
            const f32x4 c0 = *(const f32x4*)cp, c1 = *(const f32x4*)(cp + 4), s0 = *(const f32x4*)sp, s1 = *(const f32x4*)(sp + 4);
            u32x4 lo, hi;
#pragma unroll
            for (int q = 0; q < 4; ++q) { const float ca = q < 2 ? c0[2 * q] : c1[2 * q - 4], cb = q < 2 ? c0[2 * q + 1] : c1[2 * q - 3], sa = q < 2 ? s0[2 * q] : s1[2 * q - 4], sb = q < 2 ? s0[2 * q + 1] : s1[2 * q - 3];
                const float a0 = bflo(x[ks][q]), a1 = bfhi(x[ks][q]), b0 = bflo(x[ks + 2][q]), b1 = bfhi(x[ks + 2][q]);
                lo[q] = pk2(0.125f * (a0 * ca - b0 * sa), 0.125f * (a1 * cb - b1 * sb)); hi[q] = pk2(0.125f * (b0 * ca + a0 * sa), 0.125f * (b1 * cb + a1 * sb)); }
            qf[qt][ks] = __builtin_bit_cast(bf16x8, lo); qf[qt][ks + 2] = __builtin_bit_cast(bf16x8, hi);
        }
    }
    f32x16 oacc[2][2]; float mrow[2], lrow[2];
#pragma unroll
    for (int qt = 0; qt < 2; ++qt) { mrow[qt] = a.in[I_SINKS][head]; lrow[qt] = h == 0 ? 1.0f : 0.0f;
#pragma unroll
        for (int dt = 0; dt < 2; ++dt)
#pragma unroll
            for (int r = 0; r < 16; ++r) oacc[qt][dt][r] = 0.f; }
    __syncthreads();
    attn_tile(lds, 0, 0, 0, lane, hq, qf, oacc, mrow, lrow);
    if (qblk > 0) {
#pragma unroll 1
        for (int j = hq ? 2 : 0; j < 4; ++j) attn_tile(lds, 32 + 32 * j, 1, j, lane, hq, qf, oacc, mrow, lrow);
    }
#pragma unroll 1
    for (int j = 0; j < (hq ? 4 : 2); ++j) attn_tile(lds, 160 + 32 * j, 2, j, lane, hq, qf, oacc, mrow, lrow);
#pragma unroll
    for (int qt = 0; qt < 2; ++qt) {
        const float lt = lrow[qt] + __shfl_xor(lrow[qt], 32), inv = 1.0f / lt;
        bf16* op = O + (size_t)(b * SEQ + 128 * qblk + 64 * hq + 32 * qt + r31) * OLD + head * 64 + 4 * h;
#pragma unroll
        for (int dt = 0; dt < 2; ++dt)
#pragma unroll
            for (int rr = 0; rr < 4; ++rr)
                *(u32x2*)(op + 32 * dt + 8 * rr) = (u32x2){pk2(oacc[qt][dt][4 * rr] * inv, oacc[qt][dt][4 * rr + 1] * inv), pk2(oacc[qt][dt][4 * rr + 2] * inv, oacc[qt][dt][4 * rr + 3] * inv)};
    }
}

constexpr int LR_XS = 2064;
__device__ __forceinline__ void lru_norm_rows(const Args& a, LAS unsigned char* lds, int b, int c, int lane, int wave) {
        bf16* O = (bf16*)(a.ws + WS_O); unsigned char* O8 = a.ws + WS_O;
        const bf16* ATT = (const bf16*)(a.ws + (G2_FP8 ? WS_ATT : WS_O)); constexpr int ALD = G2_FP8 ? 1024 : D;
        u32x4 aw[4][2];
#pragma unroll
        for (int q = 0; q < 4; ++q)
#pragma unroll
            for (int jj = 0; jj < 2; ++jj) aw[q][jj] = *(const u32x4*)(ATT + ((size_t)b * SEQ + 32 * c + 4 * wave + q) * ALD + (lane + 64 * jj) * 8);
        f32x4 ga[2][2], gl[2][2];
#pragma unroll
        for (int jj = 0; jj < 2; ++jj) { ga[jj][0] = *(const f32x4*)(a.in[I_G_ATTN] + (lane + 64 * jj) * 8); ga[jj][1] = *(const f32x4*)(a.in[I_G_ATTN] + (lane + 64 * jj) * 8 + 4);
            gl[jj][0] = *(const f32x4*)(a.in[I_G_LRU] + (lane + 64 * jj) * 8); gl[jj][1] = *(const f32x4*)(a.in[I_G_LRU] + (lane + 64 * jj) * 8 + 4); }
        __syncthreads();
#pragma unroll
        for (int q = 0; q < 4; ++q) {
            const int tl = 4 * wave + q; const size_t row = (size_t)b * SEQ + 32 * c + tl;
#pragma unroll
            for (int half = 0; half < 2; ++half) {
                u32x4 w[2]; float v[16]; float ss = 0.f;
#pragma unroll
                for (int jj = 0; jj < 2; ++jj) { w[jj] = half == 0 ? *(const LAS u32x4*)(lds + tl * LR_XS + (lane + 64 * jj) * 16) : aw[q][jj];
#pragma unroll
                    for (int k = 0; k < 4; ++k) { v[jj * 8 + 2 * k] = bflo(w[jj][k]); v[jj * 8 + 2 * k + 1] = bfhi(w[jj][k]); } }
#pragma unroll
                for (int k = 0; k < 16; ++k) ss += v[k] * v[k];
                ss = wave_sum(ss);
                const float rstd = (G2_FP8 ? XS_SCALE : 1.0f) * __builtin_amdgcn_rsqf(ss * (1.0f / 1024.0f) + EPS);
#pragma unroll
                for (int jj = 0; jj < 2; ++jj) { const f32x4 g0 = half == 0 ? gl[jj][0] : ga[jj][0], g1 = half == 0 ? gl[jj][1] : ga[jj][1];
                    const size_t col = (half == 0 ? 1024 : 0) + (lane + 64 * jj) * 8;
                    if (G2_FP8) *(u32x2*)(O8 + row * D + col) = (u32x2){pk4_fp8(v[jj * 8 + 0] * rstd * g0.x, v[jj * 8 + 1] * rstd * g0.y, v[jj * 8 + 2] * rstd * g0.z, v[jj * 8 + 3] * rstd * g0.w),
                                                                       pk4_fp8(v[jj * 8 + 4] * rstd * g1.x, v[jj * 8 + 5] * rstd * g1.y, v[jj * 8 + 6] * rstd * g1.z, v[jj * 8 + 7] * rstd * g1.w)};
                    else *(u32x4*)(O + row * D + col) = (u32x4){pk2(v[jj * 8 + 0] * rstd * g0.x, v[jj * 8 + 1] * rstd * g0.y), pk2(v[jj * 8 + 2] * rstd * g0.z, v[jj * 8 + 3] * rstd * g0.w),
                                                                pk2(v[jj * 8 + 4] * rstd * g1.x, v[jj * 8 + 5] * rstd * g1.y), pk2(v[jj * 8 + 6] * rstd * g1.z, v[jj * 8 + 7] * rstd * g1.w)}; }
            }
        }
}
template <int PASS>
__device__ __forceinline__ void lru_item(const Args& a, LAS unsigned char* lds, int item, int part, int tid, int lane, int wave) {
    const int b = item / 65, c = item % 65; const bool meta = (c == 64);
    const bf16* Z = (const bf16*)(a.ws + WS_Z);
    float* sumA = (float*)(a.ws + WS_LRUSUM); float* sumB = sumA + NBATCH * 64 * DLRU; float* metaB = sumB + NBATCH * 64 * DLRU;
    __syncthreads();
    {
        const int ch0 = (tid & 127) * 8, tq = tid >> 7;
        f32x4 cw[4][2], cb[2];
#pragma unroll
        for (int jj = 0; jj < 4; ++jj) { cw[jj][0] = *(const f32x4*)(a.in[I_CONV_W] + jj * DLRU + ch0); cw[jj][1] = *(const f32x4*)(a.in[I_CONV_W] + jj * DLRU + ch0 + 4); }
        cb[0] = *(const f32x4*)(a.in[I_CONV_B] + ch0); cb[1] = *(const f32x4*)(a.in[I_CONV_B] + ch0 + 4);
#pragma unroll 1
        for (int i0 = 0; i0 < 8; i0 += 4) {
            u32x4 x[4][4];
#pragma unroll
            for (int i = 0; i < 4; ++i) { const int tl = tq + 4 * (i0 + i); const int t = meta ? tl : NMETA + 32 * c + tl;
#pragma unroll
                for (int jj = 0; jj < 4; ++jj) { const int tt = t - 3 + jj; x[i][jj] = (u32x4){0u, 0u, 0u, 0u};
                    if (tt >= 0 && !(meta && tl >= NMETA)) x[i][jj] = *(const u32x4*)(Z + (size_t)tok_row(b, tt) * DIN + ZX + ch0); } }
#pragma unroll
            for (int i = 0; i < 4; ++i) { const int tl = tq + 4 * (i0 + i); const int t = meta ? tl : NMETA + 32 * c + tl;
                f32x4 a0 = cb[0], a1 = cb[1];
#pragma unroll
                for (int jj = 0; jj < 4; ++jj) { const u32x4 xx = x[i][jj];
                    if (t - 3 + jj >= 0) {
                        a0.x += cw[jj][0].x * bflo(xx[0]); a0.y += cw[jj][0].y * bfhi(xx[0]); a0.z += cw[jj][0].z * bflo(xx[1]); a0.w += cw[jj][0].w * bfhi(xx[1]);
                        a1.x += cw[jj][1].x * bflo(xx[2]); a1.y += cw[jj][1].y * bfhi(xx[2]); a1.z += cw[jj][1].z * bflo(xx[3]); a1.w += cw[jj][1].w * bfhi(xx[3]); } }
                u32x4 o = (u32x4){pk2(a0.x, a0.y), pk2(a0.z, a0.w), pk2(a1.x, a1.y), pk2(a1.z, a1.w)};
                if (meta && tl >= NMETA) o = (u32x4){0u, 0u, 0u, 0u};
                *(LAS u32x4*)(lds + tl * LR_XS + ch0 * 2) = o; }
        }
    }
    LAS float* hinL = (LAS float*)(lds + 32 * LR_XS);
    if (PASS == 1) {
        float h0 = metaB[tid], h1 = metaB[tid + 512];
        const float* pa = sumA + (size_t)b * 64 * DLRU + tid; const float* pb = sumB + (size_t)b * 64 * DLRU + tid;
#pragma unroll 8
        for (int jc = 0; jc < c; ++jc) { h0 = pa[jc * DLRU] * h0 + pb[jc * DLRU]; h1 = pa[jc * DLRU + 512] * h1 + pb[jc * DLRU + 512]; }
        hinL[tid] = h0; hinL[tid + 512] = h1;
    }
    __syncthreads();
    const bf16* WaT = (const bf16*)(a.ws + WS_WAT); const bf16* WiT = (const bf16*)(a.ws + WS_WIT);
    const int r31 = lane & 31, h = lane >> 5;
    const int tau = 16 * ((r31 >> 2) & 1) + 4 * (r31 >> 3) + (r31 & 3);
#pragma unroll 1
    for (int nb = 0; nb < 2; ++nb) {
        const int n = 2 * wave + nb;
        bf16x8 af[4];
#pragma unroll
        for (int ks = 0; ks < 4; ++ks) af[ks] = *(const LAS bf16x8*)(lds + tau * LR_XS + (64 * n + 16 * ks + 8 * h) * 2);
#pragma unroll 1
        for (int nt = 0; nt < 2; ++nt) {
            if (part >= 0 && 2 * nb + nt != part) continue;
            const int ch = 64 * n + 32 * nt + r31;
            f32x16 accR, accI;
#pragma unroll
            for (int r = 0; r < 16; ++r) { accR[r] = 0.f; accI[r] = 0.f; }
#pragma unroll
            for (int ks = 0; ks < 4; ++ks) {
                const bf16x8 wa = *(const bf16x8*)(WaT + ((size_t)(n * 64 + 32 * nt + r31) * 64 + 16 * ks + 8 * h));
                const bf16x8 wi = *(const bf16x8*)(WiT + ((size_t)(n * 64 + 32 * nt + r31) * 64 + 16 * ks + 8 * h));
                accR = __builtin_amdgcn_mfma_f32_32x32x16_bf16(af[ks], wa, accR, 0, 0, 0);
                accI = __builtin_amdgcn_mfma_f32_32x32x16_bf16(af[ks], wi, accI, 0, 0, 0);
            }
            const float ba = a.in[I_B_A][ch], bi = a.in[I_B_I][ch], sp8 = -8.0f * 1.4426950408889634f * log1pf(__expf(-a.in[I_LAMBDA][ch]));
            float av[16], bv[16];
            float Ap = 1.0f, Bp = 0.0f;
#pragma unroll
            for (int r = 0; r < 16; ++r) {
                const float xcv = bf2f(*(const LAS unsigned short*)(lds + (16 * h + r) * LR_XS + ch * 2));
                const float rg = fast_sigmoid(accR[r] + ba), ig = fast_sigmoid(accI[r] + bi);
                const float l2a = sp8 * rg;
                av[r] = __builtin_amdgcn_exp2f(l2a); bv[r] = __builtin_amdgcn_sqrtf(fmaxf(fmaf(-av[r], av[r], 1.0f), 0.0f)) * ig * xcv;
                Ap *= av[r]; Bp = av[r] * Bp + bv[r];
                if (PASS == 0 && !meta) ((unsigned*)(a.ws + WS_AB))[((size_t)b * SEQ + 32 * c + 16 * h + r) * DLRU + ch] = pk2(l2a, bv[r]);
            }
            const float Ao = __shfl_xor(Ap, 32), Bo = __shfl_xor(Bp, 32);
            if (PASS == 0) {
                if (h == 0) {
                    if (meta) metaB[ch] = Bp;
                    else { sumA[((size_t)b * 64 + c) * DLRU + ch] = Ap * Ao; sumB[((size_t)b * 64 + c) * DLRU + ch] = Ao * Bp + Bo; }
                }
            } else {
                const float hin = hinL[ch];
                float hs = h == 0 ? hin : (Ao * hin + Bo);
#pragma unroll
                for (int r = 0; r < 16; ++r) {
                    hs = av[r] * hs + bv[r];
                    const int tl = 16 * h + r;
                    const float gt = bf2f(Z[(size_t)(b * SEQ + 32 * c + tl) * DIN + ZG + ch]);
                    *(LAS unsigned short*)(lds + tl * LR_XS + ch * 2) = (unsigned short)f2bf(hs * fast_gelu_tanh(gt));
                }
            }
        }
    }
}

__device__ __forceinline__ void lru_item_b(const Args& a, LAS unsigned char* lds, int item, int tid, int lane, int wave) {
    const int b = item >> 6, c = item & 63;
    const bf16* Z = (const bf16*)(a.ws + WS_Z); const unsigned* AB = (const unsigned*)(a.ws + WS_AB);
    const float* sumA = (const float*)(a.ws + WS_LRUSUM); const float* sumB = sumA + NBATCH * 64 * DLRU; const float* metaB = sumB + NBATCH * 64 * DLRU;
    const size_t row0 = (size_t)b * SEQ + 32 * c;
    u32x2 ab[32]; unsigned gt[32];
#pragma unroll
    for (int tl = 0; tl < 32; ++tl) { ab[tl] = *(const u32x2*)(AB + (row0 + tl) * DLRU + 2 * tid); gt[tl] = *(const unsigned*)(Z + (row0 + tl) * DIN + ZG + 2 * tid); }
    float h0, h1; { const f32x2 m = *(const f32x2*)(metaB + 2 * tid); h0 = m.x; h1 = m.y; }
    { const float* pa = sumA + (size_t)b * 64 * DLRU + 2 * tid; const float* pb = sumB + (size_t)b * 64 * DLRU + 2 * tid;
#pragma unroll 16
      for (int jc = 0; jc < c; ++jc) { const f32x2 A2 = *(const f32x2*)(pa + jc * DLRU), B2 = *(const f32x2*)(pb + jc * DLRU); h0 = A2.x * h0 + B2.x; h1 = A2.y * h1 + B2.y; } }
    __syncthreads();
#pragma unroll
    for (int tl = 0; tl < 32; ++tl) {
        h0 = __builtin_amdgcn_exp2f(bflo(ab[tl].x)) * h0 + bfhi(ab[tl].x);
        h1 = __builtin_amdgcn_exp2f(bflo(ab[tl].y)) * h1 + bfhi(ab[tl].y);
        *(LAS unsigned*)(lds + tl * LR_XS + 4 * tid) = pk2(h0 * fast_gelu_tanh(bflo(gt[tl])), h1 * fast_gelu_tanh(bfhi(gt[tl])));
    }
    lru_norm_rows(a, lds, b, c, lane, wave);
}

__device__ __forceinline__ void phase_router_mfma(const Args& a, LAS unsigned char* lds, int tid, int lane, int wave) {
    const bf16* H1 = (const bf16*)(a.ws + WS_H1); const bf16* WRT = (const bf16*)(a.ws + WS_WRT);
    int* tope = (int*)(a.ws + WS_TOPE); float* topw = (float*)(a.ws + WS_TOPW); float* rstd2 = (float*)(a.ws + WS_RSTD2);
    unsigned* counts = (unsigned*)(a.ws + WS_CTL) + CW_COUNTS;
    LAS float* lg = (LAS float*)(lds + wave * 2048);
    LAS int* hist = (LAS int*)(lds + 32768);
    if (tid < 32) hist[tid] = 0;
    __syncthreads();
    const int fr = lane & 15, fq = lane >> 4;
    const int kh = wave >> 2;
    LAS float* part = (LAS float*)(lds + 40960 + (wave & 3) * 2560);
    for (int g0 = 4 * blockIdx.x; g0 < MREAL / 16; g0 += 4 * gridDim.x) {
        const int grp = g0 + (wave & 3);
        const int row0 = grp * 16;
        const bf16* hp = H1 + (size_t)(row0 + fr) * D + 8 * fq + 1024 * kh;
        const bf16* wp = WRT + (size_t)fr * D + 8 * fq + 1024 * kh;
        f32x4 acc0 = (f32x4){0.f, 0.f, 0.f, 0.f}, acc1 = acc0; float ss = 0.f;
#pragma unroll 8
        for (int kk = 0; kk < 32; ++kk) {
            const u32x4 w = *(const u32x4*)(hp + 32 * kk);
#pragma unroll
            for (int q = 0; q < 4; ++q) { const float lo = bflo(w[q]), hi = bfhi(w[q]); ss += lo * lo + hi * hi; }
            const bf16x8 af = __builtin_bit_cast(bf16x8, w);
            const bf16x8 b0 = *(const bf16x8*)(wp + 32 * kk), b1 = *(const bf16x8*)(wp + (size_t)16 * D + 32 * kk);
            acc0 = __builtin_amdgcn_mfma_f32_16x16x32_bf16(af, b0, acc0, 0, 0, 0);
            acc1 = __builtin_amdgcn_mfma_f32_16x16x32_bf16(af, b1, acc1, 0, 0, 0);
        }
        if (kh == 1) {
#pragma unroll
            for (int j = 0; j < 4; ++j) { part[j * 64 + lane] = acc0[j]; part[(4 + j) * 64 + lane] = acc1[j]; }
            part[8 * 64 + lane] = ss; }
        __syncthreads();
        if (kh == 0) {
#pragma unroll
            for (int j = 0; j < 4; ++j) { acc0[j] += part[j * 64 + lane]; acc1[j] += part[(4 + j) * 64 + lane]; }
            ss += part[8 * 64 + lane]; }
        __syncthreads();
        if (kh == 1) continue;
        ss += __shfl_xor(ss, 16); ss += __shfl_xor(ss, 32);
        const float rstd = 1.0f / sqrtf(ss * (1.0f / D) + EPS);
        if (fq == 0) rstd2[row0 + fr] = rstd;
        const float br0 = a.in[I_B_ROUTER][fr], br1 = a.in[I_B_ROUTER][16 + fr];
#pragma unroll
        for (int j = 0; j < 4; ++j) { const int row = 4 * fq + j; const float rs = __shfl(rstd, row);
            lg[row * 32 + fr] = acc0[j] * rs + br0; lg[row * 32 + 16 + fr] = acc1[j] * rs + br1; }
        asm volatile("s_waitcnt lgkmcnt(0)" ::: "memory");
        if (lane < 16) {
            float v[32];
#pragma unroll
            for (int q = 0; q < 8; ++q) { const f32x4 t = *(const LAS f32x4*)(lg + lane * 32 + 4 * q); v[4 * q] = t.x; v[4 * q + 1] = t.y; v[4 * q + 2] = t.z; v[4 * q + 3] = t.w; }
            float tv[4]; int te[4];
#pragma unroll
            for (int r = 0; r < 4; ++r) { float best = -3.0e38f; int bi = 0;
#pragma unroll
                for (int e = 0; e < 32; ++e) { const bool gtb = v[e] > best; best = gtb ? v[e] : best; bi = gtb ? e : bi; }
#pragma unroll
                for (int e = 0; e < 32; ++e) v[e] = (e == bi) ? -3.0e38f : v[e];
                tv[r] = best; te[r] = bi; }
            const float e1 = __expf(tv[1] - tv[0]), e2 = __expf(tv[2] - tv[0]), e3 = __expf(tv[3] - tv[0]);
            const float inv = 1.0f / (1.0f + e1 + e2 + e3);
            const int row = row0 + lane;
            *(int4*)(tope + row * 4) = make_int4(te[0], te[1], te[2], te[3]);
            *(f32x4*)(topw + row * 4) = (f32x4){inv, e1 * inv, e2 * inv, e3 * inv};
#pragma unroll
            for (int r = 0; r < 4; ++r) atomicAdd((int*)&hist[te[r]], 1);
        }
        asm volatile("s_waitcnt lgkmcnt(0)" ::: "memory");
    }
    __syncthreads();
    if (tid < 32 && hist[tid] != 0) atomicAdd(&counts[tid], (unsigned)hist[tid]);
}

__device__ __forceinline__ void build_tile_table(const Args& a, LAS int* tstart, int tid) {
    if (tid < 64) {
        const unsigned* counts = (const unsigned*)(a.ws + WS_CTL) + CW_COUNTS;
        const int nt = tid < NEXP ? (int)((__hip_atomic_load(counts + tid, __ATOMIC_RELAXED, __HIP_MEMORY_SCOPE_AGENT) + 255u) >> 8) : 0;
        int inc = nt;
#pragma unroll
        for (int o = 1; o < 32; o <<= 1) { const int v = __shfl_up(inc, o); if ((tid & 63) >= o) inc += v; }
        if (tid < NEXP) tstart[tid] = inc - nt;
        if (tid == NEXP - 1) tstart[NEXP] = inc;
    }
    __syncthreads();
    if (tid < 288) { int e = 0;
#pragma unroll 1
        for (int i = 1; i < NEXP; ++i) e += (tstart[i] <= tid) ? 1 : 0;
        ((LAS unsigned char*)(tstart + 64))[tid] = (unsigned char)e; }
    __syncthreads();
}
__device__ __forceinline__ int tile_expert(const LAS int* tstart, int tile) {
    int e = 0;
#pragma unroll 1
    for (int i = 1; i < NEXP; ++i) e += (tstart[i] <= tile) ? 1 : 0;
    return e;
}

__device__ __forceinline__ void phase_assign(const Args& a, LAS unsigned char* lds, int tid, int lane, int wave) {
    LAS int* tstart = (LAS int*)(lds + LDS_TAB);
    LAS int* hist = (LAS int*)lds; LAS int* base = hist + 32; LAS int* spos = base + 32;
    build_tile_table(a, tstart, tid);
    const int* tope = (const int*)(a.ws + WS_TOPE); const float* topw = (const float*)(a.ws + WS_TOPW); const float* rstd2 = (const float*)(a.ws + WS_RSTD2);
    int* rowpair = (int*)(a.ws + WS_ROWPAIR); float* roww = (float*)(a.ws + WS_ROWW);
    unsigned* cursor = (unsigned*)(a.ws + WS_CTL) + CW_CURSOR;
    const bf16* H1 = (const bf16*)(a.ws + WS_H1); unsigned char* XS = (unsigned char*)(a.ws + WS_XS);
    for (int blk = blockIdx.x; blk < MREAL / 64; blk += gridDim.x) {
        if (tid < 32) hist[tid] = 0;
        __syncthreads();
        int e = 0, rank = 0, pair = 0;
        if (tid < 256) { pair = blk * 256 + tid; e = tope[pair]; rank = atomicAdd((int*)&hist[e], 1); }
        __syncthreads();
        if (tid < 32) base[tid] = (int)atomicAdd(&cursor[tid], (unsigned)hist[tid]);
        __syncthreads();
        if (tid < 256) { const int pos = tstart[e] * 256 + base[e] + rank; spos[tid] = pos; rowpair[pos] = pair; roww[pos] = topw[pair]; ((int*)(a.ws + WS_PAIRPOS))[pair] = pos; }
        __syncthreads();
        for (int tt = wave * 8; tt < wave * 8 + 8; ++tt) {
            const int token = blk * 64 + tt; const float rstd = rstd2[token] * XS_SCALE;
            const u32x4* hr = (const u32x4*)(H1 + (size_t)token * D);
            u32x4* dst = (u32x4*)(XS + (size_t)token * D);
#pragma unroll
            for (int j = 0; j < 2; ++j) { const u32x4 ha = hr[2 * (lane + 64 * j)], hb = hr[2 * (lane + 64 * j) + 1];
                const f32x4* gp = (const f32x4*)a.in[I_NORM_FFN] + 4 * (lane + 64 * j); const f32x4 g0 = gp[0], g1 = gp[1], g2 = gp[2], g3 = gp[3];
                dst[lane + 64 * j] = (u32x4){pk4_fp8(bflo(ha[0]) * rstd * g0.x, bfhi(ha[0]) * rstd * g0.y, bflo(ha[1]) * rstd * g0.z, bfhi(ha[1]) * rstd * g0.w),
                                             pk4_fp8(bflo(ha[2]) * rstd * g1.x, bfhi(ha[2]) * rstd * g1.y, bflo(ha[3]) * rstd * g1.z, bfhi(ha[3]) * rstd * g1.w),
                                             pk4_fp8(bflo(hb[0]) * rstd * g2.x, bfhi(hb[0]) * rstd * g2.y, bflo(hb[1]) * rstd * g2.z, bfhi(hb[1]) * rstd * g2.w),
                                             pk4_fp8(bflo(hb[2]) * rstd * g3.x, bfhi(hb[2]) * rstd * g3.y, bflo(hb[3]) * rstd * g3.z, bfhi(hb[3]) * rstd * g3.w)}; }
        }
        __syncthreads();
    }
}

__device__ __forceinline__ void phase_final(const Args& a, int lane, int wave) {
    const int gw = blockIdx.x * 8 + wave, NGW = gridDim.x * 8;
    const bf16* H1 = (const bf16*)(a.ws + WS_H1); const unsigned char* YB = a.ws + WS_YB;
    const int* pairpos = (const int*)(a.ws + WS_PAIRPOS); const float* topw = (const float*)(a.ws + WS_TOPW);
    for (int row = gw; row < MREAL; row += NGW) {
        const int4 pp = *(const int4*)(pairpos + row * 4); const f32x4 pw = *(const f32x4*)(topw + row * 4) * (1.0f / YB_SCALE);
        const int pos[4] = {pp.x, pp.y, pp.z, pp.w}; const float w4[4] = {pw.x, pw.y, pw.z, pw.w};
        f32x4 v[8]; unsigned y[4][8]; float ss = 0.f;
#pragma unroll
        for (int k = 0; k < 4; ++k)
#pragma unroll
            for (int j = 0; j < 8; ++j) y[k][j] = ((const unsigned*)(YB + (size_t)pos[k] * D))[lane + 64 * j];
#pragma unroll
        for (int j = 0; j < 8; ++j) { { const u32x2 hh = ((const u32x2*)(H1 + (size_t)row * D))[lane + 64 * j]; v[j] = (f32x4){bflo(hh.x), bfhi(hh.x), bflo(hh.y), bfhi(hh.y)}; }
#pragma unroll
            for (int k = 0; k < 4; ++k) { const f32x2 lo = __builtin_amdgcn_cvt_pk_f32_fp8((int)y[k][j], false), hi = __builtin_amdgcn_cvt_pk_f32_fp8((int)y[k][j], true);
                v[j].x += w4[k] * lo.x; v[j].y += w4[k] * lo.y; v[j].z += w4[k] * hi.x; v[j].w += w4[k] * hi.y; }
            ss += (v[j].x * v[j].x + v[j].y * v[j].y) + (v[j].z * v[j].z + v[j].w * v[j].w); }
        ss = wave_sum(ss);
        const float rstd = 1.0f / sqrtf(ss * (1.0f / D) + EPS);
        f32x4* op = (f32x4*)(a.out + (size_t)row * D);
#pragma unroll
        for (int j = 0; j < 8; ++j) { const f32x4 g = ((const f32x4*)a.in[I_FINAL_NORM])[lane + 64 * j]; op[lane + 64 * j] = v[j] * rstd * g; }
    }
}

enum { PH_PROLOGUE = 0, PH_G1, PH_ATTN, PH_LRU_B, PH_G2, PH_ROUTER, PH_ASSIGN, PH_G3, PH_G4, PH_FINAL, PH_COUNT };

__global__ void __launch_bounds__(512, 2) fwd(Args a) {
    extern __shared__ __attribute__((aligned(16))) unsigned char lds_raw[];
    LAS unsigned char* lds = (LAS unsigned char*)lds_raw;
    const int tid = threadIdx.x, lane = tid & 63, wave = __builtin_amdgcn_readfirstlane(tid >> 6);
    const int gw = blockIdx.x * 8 + wave, NGW = gridDim.x * 8;
    unsigned char* ws = a.ws;
#define IN(k) (a.ph_lo <= (k) && (k) < a.ph_hi)
    pg8::BGNone nobg;
    pg8::BGConv bgup{(const char*)a.in[I_W_UP], ws + WS_WUT, (int)blockIdx.x * 128, (int)blockIdx.x * 128 + 80, ws + WS_DUMMY};
#define SEAM(k) do { if (IN(k) && IN((k) + 1)) xcd_barrier(bar); } while (0)
    if (tid < 4) ((LAS unsigned*)(lds + LDS_MISC))[tid] = 0u;
    __syncthreads();
    XcdBarrier bar; bar.bar = (unsigned*)(ws + WS_CTL) + CW_BAR; bar.x = 0; bar.st = nullptr;
    if (a.ph_hi - a.ph_lo > 1) bar = xcd_barrier_post((unsigned*)(ws + WS_CTL) + CW_BAR, (volatile LAS unsigned*)(lds + LDS_MISC));

    if (IN(PH_PROLOGUE)) { phase_prologue(a, lds, tid, lane, wave);
#if PROBE_REPEAT == 0
        __syncthreads(); phase_prologue(a, lds, tid, lane, wave);
#endif
    }
    SEAM(PH_PROLOGUE);

    if (IN(PH_G1)) {
        const int ncv = g1_conv_wg(), G1G = (int)gridDim.x - ncv;
        pg8::SchedDense S{(const char*)(ws + WS_N1), (const char*)(ws + WS_WINT), (const char*)(ws + WS_WINT), nullptr, MROWS / 256, DIN / 256, G1G, (int)blockIdx.x, G1_FP8 ? 2048 : 4096};
        pg8::EpiZ E{(bf16*)(ws + WS_Z), a.in[I_B_IN], (const float*)(ws + WS_RSTD1)};
        if ((int)blockIdx.x >= G1G) conv_tiles(a, lds, tid, conv_pro_tiles() + ((int)blockIdx.x - G1G), CONV_ALL_TILES, ncv);
        else
#if BG_WUP
        pg8::gemm_phase<G1_FP8 != 0>(lds, S, E, bgup);
#else
        pg8::gemm_phase<G1_FP8 != 0>(lds, S, E, nobg);
#endif
#if PROBE_REPEAT == 1
        __syncthreads(); pg8::gemm_phase<G1_FP8 != 0>(lds, S, E, nobg);
#endif
    }
    SEAM(PH_G1);
    if (IN(PH_ATTN)) {
        for (int it = blockIdx.x; it < NBATCH * 16 * 4; it += gridDim.x) attn_item(a, lds, it, tid, lane, wave);
        for (int j = blockIdx.x; j < NBATCH * 64 + 4; j += gridDim.x) {
            if (j < NBATCH * 64) lru_item<0>(a, lds, (j >> 6) * 65 + (j & 63), -1, tid, lane, wave); else lru_item<0>(a, lds, 64, j - NBATCH * 64, tid, lane, wave); }
#if PROBE_REPEAT == 2
        for (int it = blockIdx.x; it < NBATCH * 16 * 4; it += gridDim.x) attn_item(a, lds, it, tid, lane, wave);
#endif
#if PROBE_REPEAT == 3
        for (int j = blockIdx.x; j < NBATCH * 64 + 4; j += gridDim.x) {
            if (j < NBATCH * 64) lru_item<0>(a, lds, (j >> 6) * 65 + (j & 63), -1, tid, lane, wave); else lru_item<0>(a, lds, 64, j - NBATCH * 64, tid, lane, wave); }
#endif
    }
    SEAM(PH_ATTN);
    if (IN(PH_LRU_B)) {
        for (int it = blockIdx.x; it < NBATCH * 64; it += gridDim.x) lru_item_b(a, lds, (it & 256) ? (it ^ 63) : it, tid, lane, wave);
    }
    SEAM(PH_LRU_B);
    if (IN(PH_G2)) {
        pg8::SchedDense S{(const char*)(ws + WS_O), (const char*)(ws + WS_WOUTT), (const char*)(ws + WS_WOUTT), nullptr, MREAL / 256, D / 256, (int)gridDim.x, (int)blockIdx.x, G2_FP8 ? 2048 : 4096};
        pg8::EpiH1 E{(bf16*)(ws + WS_H1), (const bf16*)(ws + WS_N1), a.in[I_B_OUT], G2_FP8 ? 1.0f / (W_SCALE * XS_SCALE) : 1.0f};
#if BG_WUP
        pg8::gemm_phase<G2_FP8 != 0>(lds, S, E, bgup);
        for (int pair = bgup.next < bgup.end ? bgup.next : bgup.end; pair < bgup.end; ++pair) { const char* sp; unsigned char* dp; pg8::bg_pair_ptrs(bgup, pair, sp, dp);
            const int n = tid >> 4, c = tid & 15; const float* p = (const float*)sp + (size_t)(8 * c) * 2048 + n;
            *(u32x2*)(dp + (size_t)n * 2048 + 8 * c) = (u32x2){pk4_fp8(p[0] * W_SCALE, p[2048] * W_SCALE, p[4096] * W_SCALE, p[6144] * W_SCALE), pk4_fp8(p[8192] * W_SCALE, p[10240] * W_SCALE, p[12288] * W_SCALE, p[14336] * W_SCALE)}; }
#else
        pg8::gemm_phase<G2_FP8 != 0>(lds, S, E, nobg);
#endif
#if PROBE_REPEAT == 4
        __syncthreads(); pg8::gemm_phase<G2_FP8 != 0>(lds, S, E, nobg);
#endif
    }
    SEAM(PH_G2);
    if (IN(PH_ROUTER)) phase_router_mfma(a, lds, tid, lane, wave);
    if (IN(PH_ROUTER) && IN(PH_ASSIGN)) {
        asm volatile("s_waitcnt vmcnt(0)" ::: "memory"); __syncthreads();
        if (tid == 0) { unsigned* rs = (unsigned*)(ws + WS_CTL) + CW_RSYNC; unsigned* tmo = (unsigned*)(ws + WS_CTL) + CW_BAR + XB_TMO;
            __hip_atomic_fetch_add(rs, 1u, __ATOMIC_RELAXED, __HIP_MEMORY_SCOPE_AGENT);
            unsigned sp = 0; while (__hip_atomic_load(rs, __ATOMIC_RELAXED, __HIP_MEMORY_SCOPE_AGENT) < gridDim.x) { __builtin_amdgcn_s_sleep(1);
                if ((++sp & 255u) == 0u) { if (__hip_atomic_load(tmo, __ATOMIC_RELAXED, __HIP_MEMORY_SCOPE_AGENT)) break; if (sp > XB_SPIN_CAP) { atomicAdd(tmo, 1u); break; } } } }
        __syncthreads();
    } else SEAM(PH_ROUTER);
    if (IN(PH_ASSIGN)) phase_assign(a, lds, tid, lane, wave);
    SEAM(PH_ASSIGN);
    if (IN(PH_G3)) {
        LAS int* tstart = (LAS int*)(lds + LDS_TAB);
        if (!IN(PH_ASSIGN)) build_tile_table(a, tstart, tid);
        const int G3G = (int)gridDim.x - G3_TEST_IDLE;
        pg8::SchedMoE S{(const char*)(ws + WS_N2), (const char*)(ws + WS_WGT), (const char*)(ws + WS_WUT), (const int*)(ws + WS_ROWPAIR), tstart, tstart[NEXP], DFF / 128, G3G, (int)blockIdx.x, true};
        pg8::EpiAct E{(unsigned char*)(ws + WS_ACT), a.in[I_B_GATE], a.in[I_B_UP]};
#if BG_WDOWN
        int bg0, bg1;
        { const int U = tstart[NEXP] * (DFF / 128), ulo = U / G3G, nhi = U - ulo * G3G, c = (int)blockIdx.x;
          int plo = (32768 + nhi * 48 + G3G - 1) / G3G; if (nhi != 0 && plo > 8 * ulo) plo = 8 * ulo > 0 ? 8 * ulo : 1;
          int phi = nhi ? (32768 - (G3G - nhi) * plo + nhi - 1) / nhi : 0; if (phi < 0) phi = 0;
          bg0 = c < nhi ? c * phi : nhi * phi + (c - nhi) * plo; bg1 = bg0 + (c < nhi ? phi : plo);
          if (c >= G3G) { bg0 = bg1 = 32768; }
          if (c == G3G - 1) bg1 = 32768;
          bg0 = bg0 < 32768 ? bg0 : 32768; bg1 = bg1 < 32768 ? bg1 : 32768; }
        pg8::BGConv bg{(const char*)a.in[I_W_DOWN], ws + WS_WDT, bg0, bg1, ws + WS_DUMMY};
        if ((int)blockIdx.x < G3G) pg8::gemm_phase<true, pg8::EpiAct, pg8::SchedMoE, pg8::BGConv, true>(lds, S, E, bg);
        for (int pair = bg.next < bg.end ? bg.next : bg.end; pair < bg.end; ++pair) { const char* sp; unsigned char* dp; pg8::bg_pair_ptrs(bg, pair, sp, dp);
            const int n = tid >> 4, c = tid & 15;
            const float* p = (const float*)sp + (size_t)(8 * c) * 2048 + n;
            *(u32x2*)(dp + (size_t)n * 2048 + 8 * c) = (u32x2){pk4_fp8(p[0] * W_SCALE, p[2048] * W_SCALE, p[4096] * W_SCALE, p[6144] * W_SCALE), pk4_fp8(p[8192] * W_SCALE, p[10240] * W_SCALE, p[12288] * W_SCALE, p[14336] * W_SCALE)}; }
#else
        pg8::gemm_phase<true, pg8::EpiAct, pg8::SchedMoE, pg8::BGNone, true>(lds, S, E, nobg);
#endif
#if PROBE_REPEAT == 7
        __syncthreads(); pg8::gemm_phase<true, pg8::EpiAct, pg8::SchedMoE, pg8::BGNone, true>(lds, S, E, nobg);
#endif
    }
    SEAM(PH_G3);
    if (IN(PH_G4)) {
        LAS int* tstart = (LAS int*)(lds + LDS_TAB);
        if (!IN(PH_ASSIGN) && !IN(PH_G3)) build_tile_table(a, tstart, tid);
        pg8::SchedMoE S{(const char*)(ws + WS_ACT), (const char*)(ws + WS_WDT), (const char*)(ws + WS_WDT), nullptr, tstart, tstart[NEXP], D / 256, (int)gridDim.x, (int)blockIdx.x, false};
        pg8::EpiDown E{ws + WS_YB, a.in[I_B_DOWN]};
        pg8::gemm_phase<true>(lds, S, E, nobg);
#if PROBE_REPEAT == 8
        __syncthreads(); pg8::gemm_phase<true>(lds, S, E, nobg);
#endif
    }
    SEAM(PH_G4);
    if (IN(PH_FINAL)) { phase_final(a, lane, wave);
#if PROBE_REPEAT == 9
        phase_final(a, lane, wave);
#endif
    }
#undef IN
#undef SEAM
}

extern "C" void kernel_launch(void* const* d_in, const int* in_sizes, int n_in, void* d_out, int out_size, void* d_ws, size_t ws_size, hipStream_t stream) {
    static int grid = 0;
    if (grid == 0) {
        if (n_in != 27 || out_size != MREAL * D || ws_size < WS_END) { fprintf(stderr, "kernel_launch: unexpected problem (n_in %d, out %d, ws %zu)\n", n_in, out_size, ws_size); grid = -1; return; }
        int dev = 0, cus = 0;
        if (hipGetDevice(&dev) != hipSuccess || hipDeviceGetAttribute(&cus, hipDeviceAttributeMultiprocessorCount, dev) != hipSuccess) { grid = -1; return; }
        if (hipFuncSetAttribute((const void*)fwd, hipFuncAttributeMaxDynamicSharedMemorySize, LDS_BYTES) != hipSuccess) { fprintf(stderr, "kernel_launch: hipFuncSetAttribute failed\n"); grid = -1; return; }
        grid = cus;
    }
    if (grid < 0) return;
    (void)hipMemsetAsync((char*)d_ws + WS_CTL, 0, CTL_BYTES, stream);
    Args a{};
    for (int i = 0; i < 27; ++i) a.in[i] = (const float*)d_in[i];
    a.out = (float*)d_out; a.ws = (unsigned char*)d_ws;
#if MK_ONE_LAUNCH
    a.ph_lo = 0; a.ph_hi = PH_COUNT;
    hipLaunchKernelGGL(fwd, dim3(grid), dim3(512), LDS_BYTES, stream, a);
#else
    for (int ph = 0; ph < PH_COUNT; ++ph) {
        a.ph_lo = ph; a.ph_hi = ph + 1;
        hipLaunchKernelGGL(fwd, dim3(grid), dim3(512), LDS_BYTES, stream, a);
    }
#endif
}
```

```cpp
#include <hip/hip_runtime.h>
#include <cstdio>
#include <cstdint>

#define LAS __attribute__((address_space(3)))
#ifndef PROBE_REPEAT
#define PROBE_REPEAT -1
#endif
#ifndef G1_FP8
#define G1_FP8 0
#endif
#ifndef G2_FP8
#define G2_FP8 0
#endif
#ifndef BG_WDOWN
#define BG_WDOWN 1
#ifndef G3_TEST_IDLE
#define G3_TEST_IDLE 0
#endif
#endif
#ifndef BG_WUP
#define BG_WUP 0
#endif
#ifndef BG_EXP
#define BG_EXP 0
#endif
#ifndef MK_ONE_LAUNCH
#define MK_ONE_LAUNCH 1
#endif
typedef unsigned short bf16;
typedef float f32x4 __attribute__((ext_vector_type(4)));
typedef float f32x2 __attribute__((ext_vector_type(2)));
typedef short bf16x8 __attribute__((ext_vector_type(8)));
typedef unsigned u32x4 __attribute__((ext_vector_type(4)));
typedef unsigned u32x2 __attribute__((ext_vector_type(2)));

constexpr int D = 2048, SEQ = 2048, NMETA = 16, TT = 2064, NBATCH = 8;
constexpr int MREAL = 16384, METAROW0 = 16384, MVALID = 16400, MROWS = 16640;
constexpr int DIN = 3584, DLRU = 1024, HD = 64;
constexpr int ZQ = 0, ZK = 1024, ZV = 1280, ZX = 1536, ZG = 2560;
constexpr int NEXP = 32, DFF = 2048, PROWS = 73728;
constexpr float EPS = 1e-5f;

constexpr size_t MiB = 1u << 20;
constexpr size_t WS_CTL = 0, CTL_BYTES = 1 * MiB;
constexpr size_t WS_COS = 1 * MiB, WS_SIN = 1 * MiB + 320 * 1024;
constexpr size_t WS_TOPE = 2 * MiB, WS_TOPW = WS_TOPE + 256 * 1024, WS_RSTD2 = WS_TOPW + 256 * 1024, WS_ROWPAIR = WS_RSTD2 + 64 * 1024, WS_ROWW = WS_ROWPAIR + 320 * 1024;
constexpr size_t WS_PAIRPOS = 3 * MiB + 256 * 1024;
constexpr size_t WS_DUMMY = 3 * MiB + 512 * 1024;
constexpr size_t WS_LRUSUM = 4 * MiB;
constexpr size_t WS_RSTD1 = 8 * MiB + 256 * 1024;
constexpr size_t WS_SSQ = 8 * MiB + 512 * 1024;
constexpr size_t WS_WAT = 9 * MiB, WS_WIT = WS_WAT + 128 * 1024, WS_WRT = WS_WIT + 128 * 1024;
constexpr size_t WS_WINT = 10 * MiB, WS_WOUTT = 24 * MiB, WS_WGT = 32 * MiB, WS_WUT = 288 * MiB, WS_WDT = 544 * MiB;
constexpr size_t WS_N1 = 800 * MiB, WS_Z = 866 * MiB, WS_O = 980 * MiB, WS_H1 = 1044 * MiB, WS_XS = 1172 * MiB, WS_YB = WS_XS, WS_ACT = 1460 * MiB, WS_END = 1748 * MiB;
constexpr size_t WS_N2 = WS_XS;
constexpr size_t WS_AB = WS_XS;
constexpr size_t WS_ATT = WS_N1;
constexpr size_t WS_XC = WS_XS, WS_AA = WS_XS + 66 * MiB, WS_BB = WS_XS + 132 * MiB, WS_YL = WS_XS + 198 * MiB;
static_assert(WS_ROWW + PROWS * 4 <= WS_LRUSUM, "small map");
constexpr int CW_COUNTS = 1024, CW_CURSOR = 1088, CW_RSYNC = 1280, CW_BAR = 4096;

constexpr int LDS_TAB = 131072;
constexpr int LDS_META = LDS_TAB + 1024;
constexpr int LDS_RID = LDS_META + 3072;
constexpr int LDS_MISC = LDS_TAB + 8192;
constexpr int LDS_BG = LDS_MISC + 1024;
constexpr int LDS_T2 = LDS_BG + 16384;
constexpr int LDS_BYTES = LDS_T2 + 4352;
static_assert(LDS_BYTES <= 163840 && LDS_BG % 1024 == 0, "LDS map");

__device__ const float c_inv_freq[32] = {1.000000000e+00f, 7.498942018e-01f, 5.623413324e-01f, 4.216965139e-01f, 3.162277639e-01f, 2.371373922e-01f, 1.778279394e-01f, 1.333521456e-01f, 1.000000015e-01f, 7.498941571e-02f, 5.623412877e-02f, 4.216964915e-02f, 3.162277862e-02f, 2.371373586e-02f, 1.778279431e-02f, 1.333521493e-02f, 9.999999776e-03f, 7.498942316e-03f, 5.623413250e-03f, 4.216964822e-03f, 3.162277862e-03f, 2.371373819e-03f, 1.778279431e-03f, 1.333521446e-03f, 1.000000047e-03f, 7.498941850e-04f, 5.623413017e-04f, 4.216965463e-04f, 3.162277862e-04f, 2.371373848e-04f, 1.778279402e-04f, 1.333521504e-04f};

struct Args { const float* in[27]; float* out; unsigned char* ws; int ph_lo, ph_hi; };
enum { I_X = 0, I_META, I_NORM_MIX, I_W_IN, I_B_IN, I_SINKS, I_CONV_W, I_CONV_B, I_W_A, I_B_A, I_W_I, I_B_I, I_LAMBDA, I_G_ATTN, I_G_LRU, I_W_OUT, I_B_OUT, I_NORM_FFN,
       I_W_ROUTER, I_B_ROUTER, I_W_GATE, I_B_GATE, I_W_UP, I_B_UP, I_W_DOWN, I_B_DOWN, I_FINAL_NORM };


#define XB_TMO      128
#define XB_XCNT(j)  (256  + 64 * (j))
#define XB_XSUB(j)  (1280 + 64 * (j))
#define XB_XGEN(j)  (2304 + 64 * (j))
#define XB_TOP      3328
#define XB_TOPGEN   3392
#define XCD_BAR_WORDS 3456
#define XB_SPIN_CAP (1u << 18)

__device__ __forceinline__ unsigned xb_ld(unsigned* p)              { return __hip_atomic_load(p, __ATOMIC_RELAXED, __HIP_MEMORY_SCOPE_AGENT); }
__device__ __forceinline__ unsigned xb_add(unsigned* p, unsigned v) { return __hip_atomic_fetch_add(p, v, __ATOMIC_RELAXED, __HIP_MEMORY_SCOPE_AGENT); }
__device__ __forceinline__ unsigned xb_xcc_id() { return (unsigned)__builtin_amdgcn_s_getreg((3 << 11) | 20) & 0xFu; }
#define XB_SPIN(cond, bar) do { unsigned _sp = 0; while (cond) { __builtin_amdgcn_s_sleep(1); \
    if ((++_sp & 255u) == 0u) { if (xb_ld(&(bar)[XB_TMO])) break; if (_sp > XB_SPIN_CAP) { atomicAdd(&(bar)[XB_TMO], 1u); break; } } } } while (0)

struct XcdBarrier {
    unsigned* bar; unsigned x;
    volatile LAS unsigned* st;
};

__device__ __forceinline__ XcdBarrier xcd_barrier_post(unsigned* bar, volatile LAS unsigned* st) {
    XcdBarrier b; b.bar = bar; b.x = xb_xcc_id(); b.st = st;
    if (threadIdx.x == 0) (void)xb_add(&bar[XB_XCNT(b.x)], 1u);
    return b;
}
__device__ __forceinline__ void xcd_barrier_complete(unsigned* bar, unsigned x, unsigned& nloc, unsigned& nx) {
    const unsigned G = gridDim.x * gridDim.y * gridDim.z;
    unsigned sum, cnt, mine, sp = 0u;
    for (;;) {
        sum = 0u; cnt = 0u; mine = 0u;
#pragma unroll
        for (unsigned j = 0; j < 16; ++j) { const unsigned c = xb_ld(&bar[XB_XCNT(j)]); sum += c; cnt += (c > 0u) ? 1u : 0u; mine = (j == x) ? c : mine; }
        if (sum == G) break;
        __builtin_amdgcn_s_sleep(1);
        if ((++sp & 255u) == 0u) { if (xb_ld(&bar[XB_TMO])) break; if (sp > XB_SPIN_CAP) { atomicAdd(&bar[XB_TMO], 1u); break; } }
    }
    nloc = mine > 0u ? mine : 1u; nx = cnt > 0u ? cnt : 1u;
}

__device__ __forceinline__ void xcd_barrier(const XcdBarrier& b) {
    asm volatile("s_waitcnt vmcnt(0)" ::: "memory");
    __syncthreads();
    if (threadIdx.x == 0) {
        unsigned* bar = b.bar;
        __builtin_amdgcn_s_waitcnt(0);
        unsigned nloc = b.st[0], nx = b.st[1];
        if (nloc == 0u) { xcd_barrier_complete(bar, b.x, nloc, nx); b.st[0] = nloc; b.st[1] = nx; }
        const unsigned old = xb_add(&bar[XB_XSUB(b.x)], 1u);
        const unsigned gen = old / nloc;
        if (old + 1u == (gen + 1u) * nloc) {
            __builtin_amdgcn_fence(__ATOMIC_RELEASE, "agent");
            asm volatile("s_waitcnt vmcnt(0)" ::: "memory");
            const unsigned og = xb_add(&bar[XB_TOP], 1u);
            const unsigned tg = og / nx;
            if (og + 1u == (tg + 1u) * nx) xb_add(&bar[XB_TOPGEN], 1u);
            else XB_SPIN(xb_ld(&bar[XB_TOPGEN]) == tg, bar);
            __builtin_amdgcn_fence(__ATOMIC_ACQUIRE, "agent");
            xb_add(&bar[XB_XGEN(b.x)], 1u);
            asm volatile("s_waitcnt vmcnt(0)" ::: "memory");
        } else {
            XB_SPIN(xb_ld(&bar[XB_XGEN(b.x)]) == gen, bar);
            __builtin_amdgcn_fence(__ATOMIC_ACQUIRE, "agent");
            asm volatile("s_waitcnt vmcnt(0)" ::: "memory");
        }
    }
    __syncthreads();
}

__device__ __forceinline__ float bf2f(unsigned b) { return __uint_as_float((b & 0xffffu) << 16); }
__device__ __forceinline__ float bflo(unsigned w) { return __uint_as_float(w << 16); }
__device__ __forceinline__ float bfhi(unsigned w) { return __uint_as_float(w & 0xffff0000u); }
__device__ __forceinline__ unsigned f2bf(float f) { unsigned u = __float_as_uint(f); return (u + 0x7fffu + ((u >> 16) & 1u)) >> 16; }
typedef __bf16 bf16x2n __attribute__((ext_vector_type(2)));
typedef float f32x2n __attribute__((ext_vector_type(2)));
__device__ __forceinline__ unsigned pk2(float lo, float hi) { const f32x2n v = {lo, hi}; return __builtin_bit_cast(unsigned, __builtin_convertvector(v, bf16x2n)); }
constexpr float W_SCALE = 256.0f, XS_SCALE = 8.0f, ACT_SCALE = 4.0f, YB_SCALE = 16.0f;
__device__ __forceinline__ float clamp_fp8(float x) { return __builtin_amdgcn_fmed3f(x, -448.0f, 448.0f); }
__device__ __forceinline__ unsigned pk4_fp8(float a, float b, float c, float d) {
    int w = 0; w = __builtin_amdgcn_cvt_pk_fp8_f32(clamp_fp8(a), clamp_fp8(b), w, false); w = __builtin_amdgcn_cvt_pk_fp8_f32(clamp_fp8(c), clamp_fp8(d), w, true); return (unsigned)w; }
__device__ __forceinline__ unsigned pk4_fp8_nc(float a, float b, float c, float d) {
    int w = 0; w = __builtin_amdgcn_cvt_pk_fp8_f32(a, b, w, false); w = __builtin_amdgcn_cvt_pk_fp8_f32(c, d, w, true); return (unsigned)w; }
__device__ __forceinline__ float wave_sum(float v) {
#pragma unroll
    for (int o = 1; o < 64; o <<= 1) v += __shfl_xor(v, o);
    return v;
}
__device__ __forceinline__ float wave_max(float v) {
#pragma unroll
    for (int o = 1; o < 64; o <<= 1) v = fmaxf(v, __shfl_xor(v, o));
    return v;
}
__device__ __forceinline__ float sigmoidf_(float x) { return 1.0f / (1.0f + __expf(-x)); }
__device__ __forceinline__ float fast_sigmoid(float x) { return __builtin_amdgcn_rcpf(1.0f + __builtin_amdgcn_exp2f(-1.4426950408889634f * x)); }
__device__ __forceinline__ float fast_gelu_tanh(float x) { const float u2 = 1.5957691216057308f * (x + 0.044715f * x * x * x); return x * __builtin_amdgcn_rcpf(1.0f + __builtin_amdgcn_exp2f(-1.4426950408889634f * u2)); }
__device__ __forceinline__ float gelu_tanh(float x) { const float u = 0.7978845608028654f * (x + 0.044715f * x * x * x); return 0.5f * x * (1.0f + tanhf(u)); }
__device__ __forceinline__ int tok_row(int b, int t) { return t < NMETA ? METAROW0 + t : b * SEQ + (t - NMETA); }

__device__ __forceinline__ void transpose_item(const float* W, int K, int N, bf16* WT, LAS float* scr, int item, int lane, const float* kgain = nullptr, int kgain_n = 0) {
    const int nblk = N / 32, kb = item / nblk, nb = item % nblk, k0 = 64 * kb, n0 = 32 * nb;
    const int c = lane & 7;
    f32x4 g0 = (f32x4){1.f, 1.f, 1.f, 1.f}, g1 = g0;
    if (kgain != nullptr && k0 < kgain_n) { g0 = *(const f32x4*)(kgain + k0 + 8 * c); g1 = *(const f32x4*)(kgain + k0 + 8 * c + 4); }
#pragma unroll 8
    for (int i = 0; i < 32; ++i) { const int kk = 2 * i + (lane >> 5); scr[kk * 33 + (lane & 31)] = W[(size_t)(k0 + kk) * N + n0 + (lane & 31)]; }
    asm volatile("s_waitcnt lgkmcnt(0)" ::: "memory");
#pragma unroll
    for (int j = 0; j < 4; ++j) { const int n = (lane >> 3) + 8 * j; const LAS float* s = scr + (8 * c) * 33 + n;
        u32x4 o; o.x = pk2(s[0 * 33] * g0.x, s[1 * 33] * g0.y); o.y = pk2(s[2 * 33] * g0.z, s[3 * 33] * g0.w); o.z = pk2(s[4 * 33] * g1.x, s[5 * 33] * g1.y); o.w = pk2(s[6 * 33] * g1.z, s[7 * 33] * g1.w);
        *(u32x4*)(WT + (size_t)(n0 + n) * K + k0 + 8 * c) = o; }
    asm volatile("s_waitcnt lgkmcnt(0)" ::: "memory");
}

#define G1_CONV_WG 24
#define G1_CONV_PER_WG 43
constexpr int CONV_ALL_TILES = (2 + (BG_WDOWN ? 0 : 1)) * 32 * (D / 128) * (D / 256);
__device__ __forceinline__ int g1_conv_wg() { return gridDim.x == 256 ? G1_CONV_WG : 0; }
__device__ __forceinline__ int conv_pro_tiles() { return CONV_ALL_TILES - g1_conv_wg() * G1_CONV_PER_WG; }
__device__ __forceinline__ void conv_tiles(const Args& a, LAS unsigned char* lds, int tid, int first, int last, int stride) {
    unsigned char* ws = a.ws;
    __syncthreads();
    {
        LAS unsigned* T = (LAS unsigned*)lds;
        const int n4 = tid & 63, kq = tid >> 6;
        constexpr int T_IN = G1_FP8 ? (D / 128) * (DIN / 256) : 0, T_OUT = G2_FP8 ? (D / 128) * (D / 256) : 0, T_E = (D / 128) * (D / 256);
        constexpr int N_GATE = 32 * T_E, N_UP = (BG_WUP && !BG_EXP) ? 256 * 6 : 32 * T_E, N_DOWN = (BG_WDOWN && !BG_EXP) ? 0 : 32 * T_E;
        constexpr int NTILES = T_IN + T_OUT + N_GATE + N_UP + N_DOWN;
        static_assert(NTILES == CONV_ALL_TILES, "tile list size");
        auto tile_ptrs = [&](int tile, const float*& sp, unsigned char*& dp, int& ldn) {
            const float* sbase; unsigned char* dbase; int tl, nt;
            if (tile < T_IN) { sbase = a.in[I_W_IN]; dbase = ws + WS_WINT; tl = tile; nt = DIN / 256; ldn = DIN; }
            else if (tile < T_IN + T_OUT) { sbase = a.in[I_W_OUT]; dbase = ws + WS_WOUTT; tl = tile - T_IN; nt = D / 256; ldn = D; }
            else { int r = tile - T_IN - T_OUT, which, e; nt = D / 256; ldn = D;
                   if (r < N_GATE) { which = 0; e = r / T_E; tl = r % T_E; }
                   else if (r < N_GATE + N_UP) { r -= N_GATE; which = 1; int g = r; if (BG_WUP && !BG_EXP) g = 16 * (r / 6) + 10 + (r % 6);
                                                 e = g / T_E; tl = g % T_E; }
                   else { r -= N_GATE + N_UP; which = 2; e = r / T_E; tl = r % T_E; }
                   sbase = a.in[which == 0 ? I_W_GATE : (which == 1 ? I_W_UP : I_W_DOWN)] + (size_t)e * D * D; dbase = ws + (which == 0 ? WS_WGT : (which == 1 ? WS_WUT : WS_WDT)) + (size_t)e * D * D; }
            const int k0 = (tl / nt) * 128, n0 = (tl % nt) * 256;
            sp = sbase + (size_t)(k0 + 4 * kq) * ldn + n0 + 4 * n4; dp = dbase + (size_t)n0 * D + k0; };
#define CONV_LOAD(R, tile) do { const float* _p; unsigned char* _d; int _ld; tile_ptrs(tile, _p, _d, _ld); _Pragma("unroll") for (int i = 0; i < 4; ++i) _Pragma("unroll") for (int q = 0; q < 4; ++q) \
            R[i][q] = __builtin_nontemporal_load((const f32x4*)(_p + (size_t)(32 * i + q) * _ld)); } while (0)
#define CONV_STORE(R, tile) do { _Pragma("unroll") for (int i = 0; i < 4; ++i) { const int kd = kq + 8 * i; \
            T[(4 * n4 + 0) * 33 + kd] = pk4_fp8(R[i][0].x * W_SCALE, R[i][1].x * W_SCALE, R[i][2].x * W_SCALE, R[i][3].x * W_SCALE); \
            T[(4 * n4 + 1) * 33 + kd] = pk4_fp8(R[i][0].y * W_SCALE, R[i][1].y * W_SCALE, R[i][2].y * W_SCALE, R[i][3].y * W_SCALE); \
            T[(4 * n4 + 2) * 33 + kd] = pk4_fp8(R[i][0].z * W_SCALE, R[i][1].z * W_SCALE, R[i][2].z * W_SCALE, R[i][3].z * W_SCALE); \
            T[(4 * n4 + 3) * 33 + kd] = pk4_fp8(R[i][0].w * W_SCALE, R[i][1].w * W_SCALE, R[i][2].w * W_SCALE, R[i][3].w * W_SCALE); } \
            __syncthreads(); \
            { const float* _p; unsigned char* _d; int _ld; tile_ptrs(tile, _p, _d, _ld); _Pragma("unroll") for (int i = 0; i < 4; ++i) { const int n = (tid >> 3) + 64 * i, c = tid & 7; \
                const u32x4 o = (u32x4){T[n * 33 + 4 * c], T[n * 33 + 4 * c + 1], T[n * 33 + 4 * c + 2], T[n * 33 + 4 * c + 3]}; \
                *(u32x4*)(_d + (size_t)n * D + 16 * c) = o; } } \
            __syncthreads(); } while (0)
        f32x4 RA[4][4], RB[4][4];
        int tile = first;
        if (tile < last) CONV_LOAD(RA, tile);
        while (tile < last) {
            int nxt = tile + stride;
            if (nxt < last) CONV_LOAD(RB, nxt);
            CONV_STORE(RA, tile);
            tile = nxt; if (tile >= last) break;
            nxt = tile + stride;
            if (nxt < last) CONV_LOAD(RA, nxt);
            CONV_STORE(RB, tile);
            tile = nxt;
        }
#undef CONV_LOAD
#undef CONV_STORE
    }
}
__device__ __forceinline__ void phase_prologue(const Args& a, LAS unsigned char* lds, int tid, int lane, int wave) {
    const int gw = blockIdx.x * 8 + wave, NGW = gridDim.x * 8;
    const int gt = blockIdx.x * 512 + tid, NGT = gridDim.x * 512;
    unsigned char* ws = a.ws;
    LAS float* scr = (LAS float*)(lds + wave * 8704);
    {
        constexpr int IT_IN = G1_FP8 ? 0 : 32 * (DIN / 32), IT_OUT = G2_FP8 ? 0 : 32 * (D / 32);
        for (int it = gw; it < IT_IN + IT_OUT; it += NGW) {
            if (it < IT_IN) transpose_item(a.in[I_W_IN], D, DIN, (bf16*)(ws + WS_WINT), scr, it, lane, a.in[I_NORM_MIX], D);
            else transpose_item(a.in[I_W_OUT], D, D, (bf16*)(ws + WS_WOUTT), scr, it - IT_IN, lane, a.in[I_G_ATTN], 1024);
        }
        __syncthreads();
    }
    conv_tiles(a, lds, tid, blockIdx.x, conv_pro_tiles(), gridDim.x);
    static_assert(!G1_FP8, "xb is written as bf16");
    for (int r = gw; r < MROWS; r += NGW) {
        u32x4* orow = (u32x4*)((bf16*)(ws + WS_N1) + (size_t)r * D);
        if (r >= MVALID) {
#pragma unroll
            for (int j = 0; j < 4; ++j) orow[lane + 64 * j] = (u32x4){0u, 0u, 0u, 0u};
            if (lane == 0) ((float*)(ws + WS_RSTD1))[r] = 0.f;
            continue; }
        const f32x4* xr = (const f32x4*)(r < MREAL ? a.in[I_X] + (size_t)r * D : a.in[I_META] + (size_t)(r - MREAL) * D);
        f32x4 v[4][2]; float ss = 0.f;
#pragma unroll
        for (int j = 0; j < 4; ++j)
#pragma unroll
            for (int q = 0; q < 2; ++q) { v[j][q] = xr[2 * (lane + 64 * j) + q]; ss += (v[j][q].x * v[j][q].x + v[j][q].y * v[j][q].y) + (v[j][q].z * v[j][q].z + v[j][q].w * v[j][q].w); }
#pragma unroll
        for (int j = 0; j < 4; ++j) orow[lane + 64 * j] = (u32x4){pk2(v[j][0].x, v[j][0].y), pk2(v[j][0].z, v[j][0].w), pk2(v[j][1].x, v[j][1].y), pk2(v[j][1].z, v[j][1].w)};
        ss = wave_sum(ss);
        if (lane == 0) ((float*)(ws + WS_RSTD1))[r] = 1.0f / sqrtf(ss * (1.0f / D) + EPS);
    }
    float* cosT = (float*)(ws + WS_COS); float* sinT = (float*)(ws + WS_SIN);
    for (int i = gt; i < TT * 32; i += NGT) {
        const int pos = i >> 5, j = i & 31;
        const float ang = (float)pos * c_inv_freq[j];
        const double t = (double)ang * 0.15915494309189535; const float fr = (float)(t - floor(t));
        cosT[i] = __builtin_amdgcn_cosf(fr); sinT[i] = __builtin_amdgcn_sinf(fr);
    }
    { bf16* WaT = (bf16*)(ws + WS_WAT); bf16* WiT = (bf16*)(ws + WS_WIT);
      for (int i = gt; i < 16 * 64 * 64; i += NGT) { const int n = i >> 12, d = (i >> 6) & 63, cc = i & 63;
          WaT[i] = (bf16)f2bf(a.in[I_W_A][(n * 64 + cc) * 64 + d]); WiT[i] = (bf16)f2bf(a.in[I_W_I][(n * 64 + cc) * 64 + d]); } }
    { bf16* WRT = (bf16*)(ws + WS_WRT);
      for (int i = gt; i < NEXP * D; i += NGT) { const int e = i >> 11, k = i & 2047; WRT[i] = (bf16)f2bf(a.in[I_NORM_FFN][k] * a.in[I_W_ROUTER][k * NEXP + e]); } }
    int* rowpair = (int*)(ws + WS_ROWPAIR);
    for (int i = gt; i < PROWS; i += NGT) rowpair[i] = -1;
}

namespace pg8 {
constexpr int BM = 256, BK = 64, HALF = 128, HTB = HALF * BK * 2, STAGE_BYTES = 8 * HTB, NXCD = 8, WGM = 8, KD = 2048, NKT = KD / BK;
__host__ __device__ __forceinline__ int lds_byte(int r, int c) { const int st = (r >> 4) * 2 + (c >> 5), rr = r & 15, cc = c & 31, ob = rr * 64 + cc * 2; return st * 1024 + (ob ^ (((ob >> 9) & 1) << 5)); }
__host__ __device__ __forceinline__ void stage_rc(int b, int& R, int& C) { const int st = b / 1024, sb = b % 1024, swz = sb ^ (((sb >> 9) & 1) << 5); R = (st >> 1) * 16 + swz / 64; C = (st & 1) * 32 + (swz % 64) / 2; }
__host__ __device__ __forceinline__ int perm32(int rho) { const int n = rho >> 4, i = rho & 15; return 8 * (i >> 2) + 4 * n + (i & 3); }
struct Unit { unsigned a, b0, b1; int pm, pn, e; };
__device__ __forceinline__ bool static_tile(int i, int G, int c, int nM, int nN, int& pm, int& pn) {
    const int nwg = nM * nN; const long L = (long)i * G + c; if (L >= nwg) return false;
    int wgid = (int)L; { const int q = nwg >> 3, r = nwg & 7, xcd = wgid & 7, off = wgid >> 3; wgid = (xcd < r ? xcd * (q + 1) : r * (q + 1) + (xcd - r) * q) + off; }
    const int nig = WGM * nN; int gid, rem;
    if ((nN & (nN - 1)) == 0) { const int sh = 3 + (31 - __builtin_clz(nN)); gid = wgid >> sh; rem = wgid & (nig - 1); } else { gid = wgid / nig; rem = wgid - gid * nig; }
    const int fm = gid * WGM, gsz = (nM - fm) < WGM ? (nM - fm) : WGM;
    if (gsz == WGM) { pm = fm + (rem & 7); pn = rem >> 3; } else { pm = fm + rem % gsz; pn = rem / gsz; }
    return true;
}

typedef int i32x8 __attribute__((ext_vector_type(8)));
typedef int i32x4 __attribute__((ext_vector_type(4)));
__device__ __forceinline__ i32x8 cat8(bf16x8 lo, bf16x8 hi) { const i32x4 a = __builtin_bit_cast(i32x4, lo), b = __builtin_bit_cast(i32x4, hi); return __builtin_shufflevector(a, b, 0, 1, 2, 3, 4, 5, 6, 7); }
struct BGNone { static constexpr bool ON = false; };
struct BGConv { static constexpr bool ON = true; const char* src; unsigned char* dst; int next, end; unsigned char* dummy; };
__device__ __forceinline__ void bg_pair_ptrs(const BGConv& bg, int pair, const char*& sp, unsigned char*& dp) {
    const int e = pair >> 10, kbp = (pair >> 6) & 15, nb = pair & 63;
    sp = bg.src + ((size_t)(e * 2048 + 128 * kbp) * 2048 + 32 * nb) * 4; dp = bg.dst + (size_t)e * 2048 * 2048 + (size_t)(32 * nb) * 2048 + 128 * kbp; }
template <bool FP8, class Epi, class Sched, class BG, bool GATHER = false>
__device__ __forceinline__ void gemm_phase(LAS unsigned char* lds, const Sched& S, const Epi& E, BG& bg) {
    constexpr int ROWB = FP8 ? 2048 : 4096, NKTL = ROWB / 128;
    const int tid = threadIdx.x, wid = __builtin_amdgcn_readfirstlane(tid >> 6), lane = tid & 63, wr = wid >> 2, wc = wid & 3, fr = lane & 15, fq = lane >> 4;
    unsigned voffA[2], voffB[2];
#pragma unroll
    for (int i = 0; i < 2; ++i) { int R, C; stage_rc(tid * 16 + i * 8192, R, C); const int Rb = Epi::PERM ? ((R & ~31) + perm32(R & 31)) : R;
        voffA[i] = (unsigned)(R * ROWB + C * 2); voffB[i] = (unsigned)(Rb * ROWB + C * 2); }
    constexpr unsigned KS = BK * 2, HS = HALF * ROWB;
    const unsigned ldsw = (unsigned)wid * 1024u;
    const __amdgpu_buffer_rsrc_t rsA = __builtin_amdgcn_make_buffer_rsrc((void*)S.A, 0, 0x7ffffff0, 0x00020000), rsB0 = __builtin_amdgcn_make_buffer_rsrc((void*)S.B0, 0, 0x7ffffff0, 0x00020000), rsB1 = __builtin_amdgcn_make_buffer_rsrc((void*)S.B1, 0, 0x7ffffff0, 0x00020000);
    const int aoff = lds_byte(wr * 64 + fr, fq * 8), boff = lds_byte(wc * 32 + fr, fq * 8);
#define PG8_SA(b, h) (((b) * 2 + (h)) * HTB)
#define PG8_SB(b, h) ((4 + (b) * 2 + (h)) * HTB)
#define PG8_STAGE(bufoff, rs, soff, voff) do { _Pragma("unroll") for (int _i = 0; _i < 2; ++_i) \
        __builtin_amdgcn_raw_ptr_buffer_load_lds(rs, (LAS void*)(lds + (bufoff) + ldsw + _i * 8192), 16, (int)(voff)[_i], (int)(soff), 0, 0); } while (0)
    unsigned gA[2][2] = {{0u, 0u}, {0u, 0u}}, gN[2][2] = {{0u, 0u}, {0u, 0u}};
#define PG8_GOFF(dst, slot) do { int tz_ = threadIdx.x; asm volatile("" : "+v"(tz_)); _Pragma("unroll") for (int _i = 0; _i < 2; ++_i) { int R_, C_; stage_rc(tz_ * 16 + _i * 8192, R_, C_); \
        _Pragma("unroll") for (int _h = 0; _h < 2; ++_h) { const int id_ = *(const LAS int*)(lds + LDS_RID + (slot) * 1024 + (_h * 128 + R_) * 4); dst[_h][_i] = (unsigned)((id_ < 0 ? 0 : (id_ >> 2)) * ROWB + C_ * 2); } } } while (0)
#define PG8_STAGEA(bufoff, h, soff_dense, koff, nx) do { if constexpr (GATHER) { unsigned v_[2]; v_[0] = (nx) ? gN[h][0] : gA[h][0]; v_[1] = (nx) ? gN[h][1] : gA[h][1]; PG8_STAGE(bufoff, rsA, koff, v_); } \
        else PG8_STAGE(bufoff, rsA, (soff_dense) + (h) * HS, voffA); } while (0)
#define PG8_LDA(dst, b, h) do { _Pragma("unroll") for (int m = 0; m < 4; ++m) { \
        if constexpr (FP8) dst##8[m] = __builtin_shufflevector(*(const LAS i32x4*)(lds + PG8_SA(b, h) + aoff + m * 2048), *(const LAS i32x4*)(lds + PG8_SA(b, h) + aoff + m * 2048 + 1024), 0, 1, 2, 3, 4, 5, 6, 7); \
        else { _Pragma("unroll") for (int k = 0; k < 2; ++k) dst[m][k] = *(const LAS bf16x8*)(lds + PG8_SA(b, h) + aoff + m * 2048 + k * 1024); } } } while (0)
#define PG8_LDB(dst, b, h) do { _Pragma("unroll") for (int n = 0; n < 2; ++n) { \
        if constexpr (FP8) dst##8[n] = __builtin_shufflevector(*(const LAS i32x4*)(lds + PG8_SB(b, h) + boff + n * 2048), *(const LAS i32x4*)(lds + PG8_SB(b, h) + boff + n * 2048 + 1024), 0, 1, 2, 3, 4, 5, 6, 7); \
        else { _Pragma("unroll") for (int k = 0; k < 2; ++k) dst[n][k] = *(const LAS bf16x8*)(lds + PG8_SB(b, h) + boff + n * 2048 + k * 1024); } } } while (0)
#define PG8_MMA(ai, bj, At, Bt) do { _Pragma("unroll") for (int m = 0; m < 4; ++m) _Pragma("unroll") for (int n = 0; n < 2; ++n) { \
        if constexpr (FP8) asm volatile("v_mfma_f32_16x16x128_f8f6f4 %0, %1, %2, %0" : "+v"(acc[ai][bj][m][n]) : "v"(Bt##8[n]), "v"(At##8[m])); \
        else { _Pragma("unroll") for (int k = 0; k < 2; ++k) asm volatile("v_mfma_f32_16x16x32_bf16 %0, %1, %2, %0" : "+v"(acc[ai][bj][m][n]) : "v"(Bt[n][k]), "v"(At[m][k])); } } \
        } while (0)
#define PG8_WAIT_V(n) asm volatile("s_waitcnt vmcnt(" #n ")" ::: "memory")
#define PG8_WAIT_L(n) asm volatile("s_waitcnt lgkmcnt(" #n ")" ::: "memory")
#define PG8_BAR __builtin_amdgcn_s_barrier()
#define PG8_SCHED __builtin_amdgcn_sched_barrier(0)
    Unit cur, nxt; int ui = 0; bool bg_pending = false;
    if (!S.next(0, cur)) return;
    f32x4 acc[2][2][4][2];
#pragma unroll
    for (int a = 0; a < 2; ++a)
#pragma unroll
        for (int b = 0; b < 2; ++b)
#pragma unroll
            for (int m = 0; m < 4; ++m)
#pragma unroll
                for (int n = 0; n < 2; ++n) acc[a][b][m][n] = (f32x4){0.f, 0.f, 0.f, 0.f};
    bf16x8 At[4][2], B0[2][2], B1[2][2];
    i32x8 At8[4], B08[2], B18[2];
    if constexpr (GATHER) {
        if (tid < 256) *(LAS int*)(lds + LDS_RID + tid * 4) = S.rows[cur.pm * BM + tid];
        __syncthreads();
        PG8_GOFF(gA, 0);
    }
    PG8_STAGE(PG8_SB(0, 0), rsB0, cur.b0, voffB); PG8_STAGE(PG8_SB(0, 1), rsB1, cur.b1, voffB); PG8_STAGEA(PG8_SA(0, 0), 0, cur.a, 0u, false); PG8_STAGEA(PG8_SA(0, 1), 1, cur.a, 0u, false);
    if (wr == 1) PG8_BAR;
    PG8_WAIT_V(2); PG8_BAR;
    PG8_STAGE(PG8_SB(1, 0), rsB0, cur.b0 + KS, voffB); PG8_STAGEA(PG8_SA(1, 0), 0, cur.a + KS, KS, false); PG8_STAGE(PG8_SB(1, 1), rsB1, cur.b1 + KS, voffB);
    PG8_WAIT_V(6); PG8_BAR;
    for (;;) {
        const bool has_next = S.next(ui + 1, nxt);
        const unsigned nA = has_next ? nxt.a : cur.a, nB0 = has_next ? nxt.b0 : cur.b0, nB1 = has_next ? nxt.b1 : cur.b1;
        for (int t = 0; t < NKTL; t += 2) {
            const bool last = (t == NKTL - 2);
            if constexpr (Epi::MIDK_T >= 0) { if (t == Epi::MIDK_T) {
                PG8_SCHED; asm volatile("s_nop 15\n\ts_nop 15" ::: "memory"); PG8_SCHED; E.midk(acc, cur, wr, fr, lds); PG8_SCHED; asm volatile("s_nop 15" ::: "memory"); PG8_SCHED; } }
            const unsigned a1 = cur.a + (unsigned)(t + 1) * KS;
            const unsigned a2 = last ? nA : cur.a + (unsigned)(t + 2) * KS;
            const unsigned b20 = last ? nB0 : cur.b0 + (unsigned)(t + 2) * KS, b21 = last ? nB1 : cur.b1 + (unsigned)(t + 2) * KS;
            const unsigned a3 = a2 + KS, b30 = b20 + KS, b31 = b21 + KS;
            const unsigned k1 = (unsigned)(t + 1) * KS, k2 = last ? 0u : (unsigned)(t + 2) * KS;
            if constexpr (GATHER) { if (last) { if (has_next) PG8_GOFF(gN, (ui + 1) & 1); else { gN[0][0] = gA[0][0]; gN[0][1] = gA[0][1]; gN[1][0] = gA[1][0]; gN[1][1] = gA[1][1]; } } }
            PG8_LDB(B0, 0, 0); PG8_LDB(B1, 0, 1); PG8_SCHED; PG8_LDA(At, 0, 0); PG8_STAGEA(PG8_SA(1, 1), 1, a1, k1, false);
            if constexpr (GATHER) { if (t == 2 && has_next && wid == 3) __builtin_amdgcn_global_load_lds((const unsigned*)(S.rows + nxt.pm * BM + lane * 4), (LAS unsigned*)(lds + LDS_RID + ((ui + 1) & 1) * 1024), 16, 0, 0); }
            if (t == 2) E.prefetch(cur, lds, wid, lane);
            PG8_WAIT_V(8); PG8_WAIT_L(0); PG8_BAR; PG8_MMA(0, 0, At, B0);
            if constexpr (BG::ON) {
                PG8_SCHED;
                int tz = threadIdx.x; asm volatile("" : "+v"(tz));
#pragma unroll
                for (int j = 0; j < (BG_EXP == 1 ? 0 : 2); ++j) { const LAS float* p = (const LAS float*)(lds + LDS_BG + j * 8192 + (tz >> 5) * 512 + (tz & 31) * 4);
                    ((LAS unsigned*)(lds + LDS_T2))[(tz & 31) * 33 + 16 * j + (tz >> 5)] = pk4_fp8(p[0] * W_SCALE, p[32] * W_SCALE, p[64] * W_SCALE, p[96] * W_SCALE); }
                const char* bgs; { unsigned char* dp_; pg8::bg_pair_ptrs(bg, bg.next < bg.end ? bg.next : bg.end - 1, bgs, dp_); }
                PG8_SCHED;
                if (BG_EXP != 2) {
                const unsigned bgv = (unsigned)((8 * wid + ((tz & 63) >> 3)) * 8192 + (tz & 7) * 16);
                __builtin_amdgcn_global_load_lds((const unsigned*)(bgs + bgv), (LAS unsigned*)(lds + LDS_BG + ldsw), 16, 0, 0);
                __builtin_amdgcn_global_load_lds((const unsigned*)(bgs + 524288 + bgv), (LAS unsigned*)(lds + LDS_BG + 8192 + ldsw), 16, 0, 0); }
                PG8_SCHED; }
            PG8_MMA(0, 1, At, B1);
            if constexpr (BG::ON) { PG8_WAIT_L(0); }
            PG8_BAR; PG8_SCHED;
            PG8_LDA(At, 0, 1); PG8_STAGE(PG8_SB(0, 0), rsB0, b20, voffB); PG8_STAGE(PG8_SB(0, 1), rsB1, b21, voffB); PG8_STAGEA(PG8_SA(0, 0), 0, a2, k2, last);
            if constexpr (BG::ON) { if (BG_EXP == 2) PG8_WAIT_V(8); else PG8_WAIT_V(10); } else { PG8_WAIT_V(8); }
            PG8_WAIT_L(0); PG8_BAR; PG8_MMA(1, 0, At, B0);
            if constexpr (BG::ON) {
                PG8_SCHED;
                unsigned char* bgd; { const char* sp_; pg8::bg_pair_ptrs(bg, bg.next - 1 < bg.end ? bg.next - 1 : bg.end - 1, sp_, bgd); }
                int tz = threadIdx.x; asm volatile("" : "+v"(tz));
                const LAS unsigned* q = (const LAS unsigned*)(lds + LDS_T2) + (tz >> 4) * 33 + 2 * (tz & 15);
                const u32x2 w = (u32x2){q[0], q[1]};
                if (BG_EXP != 1) *(u32x2*)((bg_pending && !BG_EXP) ? bgd + (size_t)(tz >> 4) * 2048 + 8 * (tz & 15) : bg.dummy + 8 * tz) = w;
                ++bg.next; bg_pending = true;
                PG8_SCHED; }
            PG8_MMA(1, 1, At, B1); PG8_BAR; PG8_SCHED;
            PG8_LDB(B0, 1, 0); PG8_LDB(B1, 1, 1); PG8_SCHED; PG8_LDA(At, 1, 0); PG8_STAGEA(PG8_SA(0, 1), 1, a2, k2, last);
            if constexpr (BG::ON) { if (BG_EXP == 1) PG8_WAIT_V(10); else if (BG_EXP == 2) PG8_WAIT_V(9); else PG8_WAIT_V(11); } else { PG8_WAIT_V(8); }
            PG8_WAIT_L(0); PG8_BAR; PG8_MMA(0, 0, At, B0); PG8_MMA(0, 1, At, B1); PG8_BAR; PG8_SCHED;
            PG8_LDA(At, 1, 1); PG8_STAGE(PG8_SB(1, 0), rsB0, b30, voffB); PG8_STAGE(PG8_SB(1, 1), rsB1, b31, voffB); PG8_STAGEA(PG8_SA(1, 0), 0, a3, k2 + KS, last);
            if constexpr (BG::ON) { if (BG_EXP == 1) PG8_WAIT_V(8); else PG8_WAIT_V(9); } else { PG8_WAIT_V(8); }
            PG8_WAIT_L(0); PG8_BAR; PG8_MMA(1, 0, At, B0); PG8_MMA(1, 1, At, B1); PG8_BAR; PG8_SCHED;
        }
        if (wr == 0) PG8_BAR;
        asm volatile("s_nop 15\n\ts_nop 15" ::: "memory");
        E(acc, cur, wr, wc, fr, fq, lds);
        if (!has_next) break;
#pragma unroll
        for (int a = 0; a < 2; ++a)
#pragma unroll
            for (int b = 0; b < 2; ++b)
#pragma unroll
                for (int m = 0; m < 4; ++m)
#pragma unroll
                    for (int n = 0; n < 2; ++n) acc[a][b][m][n] = (f32x4){0.f, 0.f, 0.f, 0.f};
        cur = nxt; ++ui;
        if constexpr (GATHER) { gA[0][0] = gN[0][0]; gA[0][1] = gN[0][1]; gA[1][0] = gN[1][0]; gA[1][1] = gN[1][1]; }
        if (wr == 1) PG8_BAR;
    }
    PG8_WAIT_V(0);
    PG8_BAR;
    if constexpr (BG::ON) { if (bg_pending && !BG_EXP) {
        unsigned char* bgd; { const char* sp_; pg8::bg_pair_ptrs(bg, bg.next - 1 < bg.end ? bg.next - 1 : bg.end - 1, sp_, bgd); }
#pragma unroll
        for (int j = 0; j < 2; ++j) { const LAS float* p = (const LAS float*)(lds + LDS_BG + j * 8192 + (tid >> 5) * 512 + (tid & 31) * 4);
            ((LAS unsigned*)(lds + LDS_T2))[(tid & 31) * 33 + 16 * j + (tid >> 5)] = pk4_fp8(p[0] * W_SCALE, p[32] * W_SCALE, p[64] * W_SCALE, p[96] * W_SCALE); }
        __syncthreads();
        const LAS unsigned* q = (const LAS unsigned*)(lds + LDS_T2) + (tid >> 4) * 33 + 2 * (tid & 15);
        *(u32x2*)(bgd + (size_t)(tid >> 4) * 2048 + 8 * (tid & 15)) = (u32x2){q[0], q[1]}; } }
#undef PG8_SA
#undef PG8_SB
#undef PG8_STAGE
#undef PG8_STAGEA
#undef PG8_GOFF
#undef PG8_LDA
#undef PG8_LDB
#undef PG8_MMA
#undef PG8_WAIT_V
#undef PG8_WAIT_L
#undef PG8_BAR
#undef PG8_SCHED
}

struct SchedDense {
    const char* A; const char* B0; const char* B1; const int* rows; int nM, nN, G, c, rowb;
    __device__ __forceinline__ bool next(int i, Unit& u) const {
        int pm, pn; if (!static_tile(i, G, c, nM, nN, pm, pn)) return false;
        u.pm = pm; u.pn = pn; u.e = 0; u.a = (unsigned)pm * BM * rowb; u.b0 = (unsigned)pn * BM * rowb; u.b1 = u.b0 + (unsigned)HALF * rowb; return true;
    }
};
struct SchedMoE {
    const char* A; const char* B0; const char* B1; const int* rows; const LAS int* tstart; int nM, nN, G, c; bool split;
    __device__ __forceinline__ bool next(int i, Unit& u) const {
        int pm, pn; if (!static_tile(i, G, c, nM, nN, pm, pn)) return false;
        const int e = ((const LAS unsigned char*)(tstart + 64))[pm];
        u.pm = pm; u.pn = pn; u.e = e; u.a = (unsigned)pm * (BM * 2048);
        const unsigned eoff = (unsigned)e * (2048u * 2048u);
        if (split) { u.b0 = eoff + (unsigned)pn * (HALF * 2048); u.b1 = u.b0; }
        else { u.b0 = eoff + (unsigned)pn * (BM * 2048); u.b1 = u.b0 + (unsigned)HALF * 2048; }
        return true;
    }
};

__device__ __forceinline__ u32x4 widen16(u32x2 x, u32x2 y) {
    const auto r0 = __builtin_amdgcn_permlane16_swap(x.x, y.x, false, false), r1 = __builtin_amdgcn_permlane16_swap(x.y, y.y, false, false);
    return (u32x4){r0[0], r1[0], r0[1], r1[1]};
}
struct EpiZ {
    static constexpr bool PERM = true; static constexpr int MIDK_T = -1;
    bf16* Z; const float* bias; const float* rstd1;
    __device__ __forceinline__ void prefetch(const Unit& u, LAS unsigned char* lds, int wid, int lane) const {
        if (wid == 0) __builtin_amdgcn_global_load_lds((const unsigned*)(rstd1 + u.pm * BM + lane * 4), (LAS unsigned*)(lds + LDS_META), 16, 0, 0);
    }
    __device__ __forceinline__ void operator()(const f32x4 (&acc)[2][2][4][2], const Unit& u, int wr, int wc, int fr, int fq, const LAS unsigned char* lds) const {
        const int row0 = u.pm * BM + wr * 64 + fr, col0 = u.pn * BM + wc * 32 + 8 * fq;
        f32x4 bv[2][2];
#pragma unroll
        for (int bj = 0; bj < 2; ++bj)
#pragma unroll
            for (int n = 0; n < 2; ++n) bv[bj][n] = *(const f32x4*)(bias + col0 + bj * HALF + 4 * n);
#pragma unroll
        for (int ai = 0; ai < 2; ++ai)
#pragma unroll
            for (int m = 0; m < 4; ++m) { bf16* rowp = Z + (size_t)(row0 + ai * HALF + m * 16) * DIN + col0;
                const float sc = ((const LAS float*)(lds + LDS_META))[ai * HALF + wr * 64 + m * 16 + fr];
#pragma unroll
                for (int bj = 0; bj < 2; ++bj) { const f32x4 v0 = acc[ai][bj][m][0] * sc + bv[bj][0], v1 = acc[ai][bj][m][1] * sc + bv[bj][1];
                    u32x4 w; w.x = pk2(v0[0], v0[1]); w.y = pk2(v0[2], v0[3]); w.z = pk2(v1[0], v1[1]); w.w = pk2(v1[2], v1[3]);
                    *(u32x4*)(rowp + bj * HALF) = w; } }
    }
};
struct EpiH1 {
    static constexpr bool PERM = true;
    static constexpr int MIDK_T = 16;
    bf16* H1; const bf16* x; const float* bias; float sc; const float* ssq;
    __device__ __forceinline__ void prefetch(const Unit& u, LAS unsigned char* lds, int wid, int lane) const {
        if (wid < 4) __builtin_amdgcn_global_load_lds((const unsigned*)(ssq + (size_t)(u.pm * BM + wid * 64 + lane) * 4), (LAS unsigned*)(lds + LDS_META + wid * 1024), 16, 0, 0);
    }
    __device__ __forceinline__ void midk(f32x4 (&acc)[2][2][4][2], const Unit& u, int wr, int fr, const LAS unsigned char* lds) const {
        f32x4 s[2][4];
#pragma unroll
        for (int ai = 0; ai < 2; ++ai)
#pragma unroll
            for (int m = 0; m < 4; ++m) s[ai][m] = *(const LAS f32x4*)(lds + LDS_META + (ai * HALF + wr * 64 + m * 16 + fr) * 16);
#pragma unroll
        for (int ai = 0; ai < 2; ++ai)
#pragma unroll
            for (int m = 0; m < 4; ++m) { const float r = __builtin_amdgcn_rsqf(((s[ai][m].x + s[ai][m].y) + (s[ai][m].z + s[ai][m].w)) * (1.0f / 1024.0f) + EPS);
#pragma unroll
                for (int bj = 0; bj < 2; ++bj)
#pragma unroll
                    for (int n = 0; n < 2; ++n) acc[ai][bj][m][n] = acc[ai][bj][m][n] * r; }
    }
    __device__ __forceinline__ void operator()(const f32x4 (&acc)[2][2][4][2], const Unit& u, int wr, int wc, int fr, int fq, const LAS unsigned char*) const {
        const int row0 = u.pm * BM + wr * 64 + fr, col0 = u.pn * BM + wc * 32 + 8 * fq;
        f32x4 bv[2][2];
#pragma unroll
        for (int bj = 0; bj < 2; ++bj)
#pragma unroll
            for (int n = 0; n < 2; ++n) bv[bj][n] = *(const f32x4*)(bias + col0 + bj * HALF + 4 * n);
#pragma unroll
        for (int ai = 0; ai < 2; ++ai) {
            u32x4 xv[4][2];
#pragma unroll
            for (int m = 0; m < 4; ++m) { const size_t ro = (size_t)(row0 + ai * HALF + m * 16) * D + col0;
#pragma unroll
                for (int bj = 0; bj < 2; ++bj) xv[m][bj] = __builtin_nontemporal_load((const u32x4*)(x + ro + bj * HALF)); }
#pragma unroll
            for (int m = 0; m < 4; ++m) { const size_t ro = (size_t)(row0 + ai * HALF + m * 16) * D + col0;
#pragma unroll
                for (int bj = 0; bj < 2; ++bj) { const u32x4 xx = xv[m][bj];
                    const f32x4 v0 = (f32x4){bflo(xx[0]), bfhi(xx[0]), bflo(xx[1]), bfhi(xx[1])} + acc[ai][bj][m][0] * sc + bv[bj][0], v1 = (f32x4){bflo(xx[2]), bfhi(xx[2]), bflo(xx[3]), bfhi(xx[3])} + acc[ai][bj][m][1] * sc + bv[bj][1];
                    u32x4 w; w.x = pk2(v0[0], v0[1]); w.y = pk2(v0[2], v0[3]); w.z = pk2(v1[0], v1[1]); w.w = pk2(v1[2], v1[3]);
                    *(u32x4*)(H1 + ro + bj * HALF) = w; } }
        }
    }
};
struct EpiAct {
    static constexpr bool PERM = true; static constexpr int MIDK_T = -1;
    unsigned char* ACT; const float* bg; const float* bu;
    __device__ __forceinline__ void prefetch(const Unit& u, LAS unsigned char* lds, int wid, int lane) const {
        if (wid == 0) { const float* p = (lane < 32 ? bg : bu) + (size_t)u.e * DFF + u.pn * HALF + (lane & 31) * 4;
            __builtin_amdgcn_global_load_lds((const unsigned*)p, (LAS unsigned*)(lds + LDS_META), 16, 0, 0); }
    }
    __device__ __forceinline__ void operator()(const f32x4 (&acc)[2][2][4][2], const Unit& u, int wr, int wc, int fr, int fq, const LAS unsigned char* lds) const {
        const int row0 = u.pm * BM + wr * 64 + fr, cl = wc * 32 + 8 * fq, col0 = u.pn * HALF + cl;
        f32x4 gv[2], uv[2];
#pragma unroll
        for (int n = 0; n < 2; ++n) { gv[n] = *(const LAS f32x4*)(lds + LDS_META + (cl + 4 * n) * 4); uv[n] = *(const LAS f32x4*)(lds + LDS_META + 512 + (cl + 4 * n) * 4); }
#pragma unroll
        for (int ai = 0; ai < 2; ++ai)
#pragma unroll
            for (int mp = 0; mp < 2; ++mp) { u32x2 pc[2];
#pragma unroll
                for (int mi = 0; mi < 2; ++mi) { const int m = 2 * mp + mi; float r[8];
#pragma unroll
                    for (int n = 0; n < 2; ++n)
#pragma unroll
                        for (int j = 0; j < 4; ++j) { float g = acc[ai][0][m][n][j] * (1.0f / (W_SCALE * XS_SCALE)) + gv[n][j], up = acc[ai][1][m][n][j] * (1.0f / (W_SCALE * XS_SCALE)) + uv[n][j];
                            g = fminf(g, 7.0f); up = fminf(fmaxf(up, -7.0f), 7.0f);
                            r[n * 4 + j] = g * __builtin_amdgcn_rcpf(1.0f + __builtin_amdgcn_exp2f((-1.702f * 1.4426950408889634f) * g)) * fmaf(up, ACT_SCALE, ACT_SCALE); }
                    pc[mi] = (u32x2){pk4_fp8_nc(r[0], r[1], r[2], r[3]), pk4_fp8_nc(r[4], r[5], r[6], r[7])}; }
                const u32x4 w = widen16(pc[0], pc[1]);
                const int m = 2 * mp + (fq & 1);
                *(u32x4*)(ACT + (size_t)(row0 + ai * HALF + m * 16) * DFF + col0 - 8 * (fq & 1)) = w; }
    }
};
struct EpiDown {
    static constexpr bool PERM = true; static constexpr int MIDK_T = -1;
    unsigned char* YB; const float* bd;
    __device__ __forceinline__ void prefetch(const Unit& u, LAS unsigned char* lds, int wid, int lane) const {
        if (wid == 0) __builtin_amdgcn_global_load_lds((const unsigned*)(bd + (size_t)u.e * D + u.pn * BM + lane * 4), (LAS unsigned*)(lds + LDS_META), 16, 0, 0);
    }
    __device__ __forceinline__ void operator()(const f32x4 (&acc)[2][2][4][2], const Unit& u, int wr, int wc, int fr, int fq, const LAS unsigned char* lds) const {
        const int row0 = u.pm * BM + wr * 64 + fr, cl = wc * 32 + 8 * fq, col0 = u.pn * BM + cl;
        f32x4 bv[2][2];
#pragma unroll
        for (int bj = 0; bj < 2; ++bj)
#pragma unroll
            for (int n = 0; n < 2; ++n) bv[bj][n] = *(const LAS f32x4*)(lds + LDS_META + (cl + bj * HALF + 4 * n) * 4) * YB_SCALE;
#pragma unroll
        for (int ai = 0; ai < 2; ++ai)
#pragma unroll
            for (int m = 0; m < 4; ++m) { u32x2 pc[2];
#pragma unroll
                for (int bj = 0; bj < 2; ++bj) { const f32x4 v0 = acc[ai][bj][m][0] * (YB_SCALE / (W_SCALE * ACT_SCALE)) + bv[bj][0], v1 = acc[ai][bj][m][1] * (YB_SCALE / (W_SCALE * ACT_SCALE)) + bv[bj][1];
                    pc[bj] = (u32x2){pk4_fp8(v0[0], v0[1], v0[2], v0[3]), pk4_fp8(v1[0], v1[1], v1[2], v1[3])}; }
                const u32x4 w = widen16(pc[0], pc[1]);
                *(u32x4*)(YB + (size_t)(row0 + ai * HALF + m * 16) * D + col0 + (fq & 1) * (HALF - 8)) = w; }
    }
};
}


typedef float f32x16 __attribute__((ext_vector_type(16)));
constexpr int AT_KS = 144, AT_VS = 584, AT_KOFF = 0, AT_VOFF = 288 * AT_KS;

__device__ __forceinline__ void attn_tile(LAS unsigned char* lds, int slot_base, int kind, int j, int lane, int hq,
                                          const bf16x8 (&qf)[2][4], f32x16 (&oacc)[2][2], float (&mrow)[2], float (&lrow)[2]) {
    const int r31 = lane & 31, h = lane >> 5;
    bf16x8 kf[4], vf[2][2];
#pragma unroll
    for (int ks = 0; ks < 4; ++ks) kf[ks] = *(const LAS bf16x8*)(lds + AT_KOFF + (slot_base + r31) * AT_KS + (16 * ks + 8 * h) * 2);
#pragma unroll
    for (int dt = 0; dt < 2; ++dt)
#pragma unroll
        for (int sp = 0; sp < 2; ++sp) { const LAS unsigned char* p = lds + AT_VOFF + (32 * dt + r31) * AT_VS + (slot_base + 16 * sp + 4 * h) * 2;
            const u32x2 lo = *(const LAS u32x2*)p, hi = *(const LAS u32x2*)(p + 16);
            const u32x4 w = (u32x4){lo.x, lo.y, hi.x, hi.y}; vf[dt][sp] = __builtin_bit_cast(bf16x8, w); }
#pragma unroll
    for (int qt = 0; qt < 2; ++qt) {
        f32x16 s;
#pragma unroll
        for (int r = 0; r < 16; ++r) s[r] = 0.f;
#pragma unroll
        for (int ks = 0; ks < 4; ++ks) s = __builtin_amdgcn_mfma_f32_32x32x16_bf16(kf[ks], qf[qt][ks], s, 0, 0, 0);
        const int i = 64 * hq + 32 * qt + r31;
        float mx = -1.0e30f;
#pragma unroll
        for (int r = 0; r < 16; ++r) { const int key = (r & 3) + 8 * (r >> 2) + 4 * h;
            const bool ok = kind == 0 ? (key < 16) : (kind == 1 ? (32 * j + key >= i + 1) : (32 * j + key <= i));
            s[r] = ok ? s[r] : -1.0e30f; mx = fmaxf(mx, s[r]); }
        mx = fmaxf(mx, __shfl_xor(mx, 32));
        const float mn = fmaxf(mrow[qt], mx), al = __expf(mrow[qt] - mn); mrow[qt] = mn;
        float ps = 0.f;
#pragma unroll
        for (int r = 0; r < 16; ++r) { s[r] = __expf(s[r] - mn); ps += s[r]; }
        lrow[qt] = lrow[qt] * al + ps;
#pragma unroll
        for (int dt = 0; dt < 2; ++dt)
#pragma unroll
            for (int r = 0; r < 16; ++r) oacc[qt][dt][r] *= al;
        bf16x8 pf[2];
#pragma unroll
        for (int sp = 0; sp < 2; ++sp) { const u32x4 w = (u32x4){pk2(s[8 * sp + 0], s[8 * sp + 1]), pk2(s[8 * sp + 2], s[8 * sp + 3]), pk2(s[8 * sp + 4], s[8 * sp + 5]), pk2(s[8 * sp + 6], s[8 * sp + 7])};
            pf[sp] = __builtin_bit_cast(bf16x8, w); }
#pragma unroll
        for (int dt = 0; dt < 2; ++dt)
#pragma unroll
            for (int sp = 0; sp < 2; ++sp) oacc[qt][dt] = __builtin_amdgcn_mfma_f32_32x32x16_bf16(vf[dt][sp], pf[sp], oacc[qt][dt], 0, 0, 0);
    }
}

__device__ __forceinline__ void attn_item(const Args& a, LAS unsigned char* lds, int item, int tid, int lane, int wave) {
    const int kvh = item & 3, qblk = (item >> 2) & 15, b = item >> 6;
    const bf16* Z = (const bf16*)(a.ws + WS_Z); bf16* O = (bf16*)(a.ws + (G2_FP8 ? WS_ATT : WS_O)); constexpr int OLD = G2_FP8 ? 1024 : D;
    const float* cosT = (const float*)(a.ws + WS_COS); const float* sinT = (const float*)(a.ws + WS_SIN);
    __syncthreads();
    for (int task = tid; task < 288 * 4; task += 512) {
        const int slot = task >> 2, c = task & 3;
        int krow, kpos; bool valid;
        if (slot < 32) { valid = slot < NMETA; krow = METAROW0 + slot; kpos = slot; }
        else { const int sp = 128 * (qblk - 1) + (slot - 32); valid = sp >= 0; krow = b * SEQ + sp; kpos = NMETA + sp; }
        u32x4 lo = (u32x4){0u, 0u, 0u, 0u}, hi = lo;
        if (valid) {
            const bf16* kp = Z + (size_t)krow * DIN + ZK + kvh * 64 + c * 8;
            const u32x4 x1 = *(const u32x4*)kp, x2 = *(const u32x4*)(kp + 32);
            const f32x4 c0 = *(const f32x4*)(cosT + kpos * 32 + c * 8), c1 = *(const f32x4*)(cosT + kpos * 32 + c * 8 + 4);
            const f32x4 s0 = *(const f32x4*)(sinT + kpos * 32 + c * 8), s1 = *(const f32x4*)(sinT + kpos * 32 + c * 8 + 4);
#pragma unroll
            for (int q = 0; q < 4; ++q) { const float ca = q < 2 ? c0[2 * q] : c1[2 * q - 4], cb = q < 2 ? c0[2 * q + 1] : c1[2 * q - 3], sa = q < 2 ? s0[2 * q] : s1[2 * q - 4], sb = q < 2 ? s0[2 * q + 1] : s1[2 * q - 3];
                const float a0 = bflo(x1[q]), a1 = bfhi(x1[q]), b0 = bflo(x2[q]), b1 = bfhi(x2[q]);
                lo[q] = pk2(a0 * ca - b0 * sa, a1 * cb - b1 * sb); hi[q] = pk2(b0 * ca + a0 * sa, b1 * cb + a1 * sb); }
        }
        *(LAS u32x4*)(lds + AT_KOFF + slot * AT_KS + c * 16) = lo; *(LAS u32x4*)(lds + AT_KOFF + slot * AT_KS + 64 + c * 16) = hi;
    }
    for (int task = tid; task < 144 * 8; task += 512) {
        const int slot0 = (task >> 3) * 2, c = task & 7;
        int vrow; bool valid;
        if (slot0 < 32) { valid = slot0 < NMETA; vrow = METAROW0 + slot0; }
        else { const int sp = 128 * (qblk - 1) + (slot0 - 32); valid = sp >= 0; vrow = b * SEQ + sp; }
        u32x4 v0 = (u32x4){0u, 0u, 0u, 0u}, v1 = v0;
        if (valid) { const bf16* vp = Z + (size_t)vrow * DIN + ZV + kvh * 64 + c * 8; v0 = *(const u32x4*)vp; v1 = *(const u32x4*)(vp + DIN); }
#pragma unroll
        for (int q = 0; q < 4; ++q) {
            *(LAS unsigned*)(lds + AT_VOFF + (c * 8 + 2 * q) * AT_VS + slot0 * 2) = (v0[q] & 0xffffu) | (v1[q] << 16);
            *(LAS unsigned*)(lds + AT_VOFF + (c * 8 + 2 * q + 1) * AT_VS + slot0 * 2) = (v0[q] >> 16) | (v1[q] & 0xffff0000u); }
    }
    const int g = wave >> 1, hq = wave & 1, head = kvh * 4 + g, r31 = lane & 31, h = lane >> 5;
    bf16x8 qf[2][4];
#pragma unroll
    for (int qt = 0; qt < 2; ++qt) {
        const int s = 128 * qblk + 64 * hq + 32 * qt + r31, pos = NMETA + s;
        const bf16* qp = Z + (size_t)(b * SEQ + s) * DIN + ZQ + head * 64 + 8 * h;
        u32x4 x[4];
#pragma unroll
        for (int ks = 0; ks < 4; ++ks) x[ks] = *(const u32x4*)(qp + 16 * ks);
#pragma unroll
        for (int ks = 0; ks < 2; ++ks) {
            const float* cp = cosT + pos * 32 + 16 * ks + 8 * h; const float* sp = sinT + pos * 32 + 16 * ks + 8 * h;
            const f32x4 c0 = *(const f32x4*)cp, c1 = *(const f32x4*)(cp + 4), s0 = *(const f32x4*)sp, s1 = *(const f32x4*)(sp + 4);
            u32x4 lo, hi;
#pragma unroll
            for (int q = 0; q < 4; ++q) { const float ca = q < 2 ? c0[2 * q] : c1[2 * q - 4], cb = q < 2 ? c0[2 * q + 1] : c1[2 * q - 3], sa = q < 2 ? s0[2 * q] : s1[2 * q - 4], sb = q < 2 ? s0[2 * q + 1] : s1[2 * q - 3];
                const float a0 = bflo(x[ks][q]), a1 = bfhi(x[ks][q]), b0 = bflo(x[ks + 2][q]), b1 = bfhi(x[ks + 2][q]);
                lo[q] = pk2(0.125f * (a0 * ca - b0 * sa), 0.125f * (a1 * cb - b1 * sb)); hi[q] = pk2(0.125f * (b0 * ca + a0 * sa), 0.125f * (b1 * cb + a1 * sb)); }
            qf[qt][ks] = __builtin_bit_cast(bf16x8, lo); qf[qt][ks + 2] = __builtin_bit_cast(bf16x8, hi);
        }
    }
    f32x16 oacc[2][2]; float mrow[2], lrow[2];
#pragma unroll
    for (int qt = 0; qt < 2; ++qt) { mrow[qt] = a.in[I_SINKS][head]; lrow[qt] = h == 0 ? 1.0f : 0.0f;
#pragma unroll
        for (int dt = 0; dt < 2; ++dt)
#pragma unroll
            for (int r = 0; r < 16; ++r) oacc[qt][dt][r] = 0.f; }
    __syncthreads();
    attn_tile(lds, 0, 0, 0, lane, hq, qf, oacc, mrow, lrow);
    if (qblk > 0) {
#pragma unroll 1
        for (int j = hq ? 2 : 0; j < 4; ++j) attn_tile(lds, 32 + 32 * j, 1, j, lane, hq, qf, oacc, mrow, lrow);
    }
#pragma unroll 1
    for (int j = 0; j < (hq ? 4 : 2); ++j) attn_tile(lds, 160 + 32 * j, 2, j, lane, hq, qf, oacc, mrow, lrow);
    LAS float* ssL = (LAS float*)(lds + 90112);
#pragma unroll
    for (int qt = 0; qt < 2; ++qt) {
        const float lt = lrow[qt] + __shfl_xor(lrow[qt], 32), inv = 1.0f / lt;
        bf16* op = O + (size_t)(b * SEQ + 128 * qblk + 64 * hq + 32 * qt + r31) * OLD + head * 64 + 4 * h;
        float ss = 0.f;
#pragma unroll
        for (int dt = 0; dt < 2; ++dt)
#pragma unroll
            for (int rr = 0; rr < 4; ++rr) {
                const float o0 = oacc[qt][dt][4 * rr] * inv, o1 = oacc[qt][dt][4 * rr + 1] * inv, o2 = oacc[qt][dt][4 * rr + 2] * inv, o3 = oacc[qt][dt][4 * rr + 3] * inv;
                ss += (o0 * o0 + o1 * o1) + (o2 * o2 + o3 * o3);
                *(u32x2*)(op + 32 * dt + 8 * rr) = (u32x2){pk2(o0, o1), pk2(o2, o3)}; }
        ss += __shfl_xor(ss, 32);
        if (h == 0) ssL[g * 128 + 64 * hq + 32 * qt + r31] = ss;
    }
    __syncthreads();
    if (tid < 128) ((float*)(a.ws + WS_SSQ))[(size_t)(b * SEQ + 128 * qblk + tid) * 4 + kvh] = (ssL[tid] + ssL[128 + tid]) + (ssL[256 + tid] + ssL[384 + tid]);
}

constexpr int LR_XS = 2064;
__device__ __forceinline__ void lru_norm_rows(const Args& a, LAS unsigned char* lds, int b, int c, int lane, int wave) {
        bf16* O = (bf16*)(a.ws + WS_O); unsigned char* O8 = a.ws + WS_O;
        const bf16* ATT = (const bf16*)(a.ws + (G2_FP8 ? WS_ATT : WS_O)); constexpr int ALD = G2_FP8 ? 1024 : D;
        u32x4 aw[4][2];
#pragma unroll
        for (int q = 0; q < 4; ++q)
#pragma unroll
            for (int jj = 0; jj < 2; ++jj) aw[q][jj] = *(const u32x4*)(ATT + ((size_t)b * SEQ + 32 * c + 4 * wave + q) * ALD + (lane + 64 * jj) * 8);
        f32x4 ga[2][2], gl[2][2];
#pragma unroll
        for (int jj = 0; jj < 2; ++jj) { ga[jj][0] = *(const f32x4*)(a.in[I_G_ATTN] + (lane + 64 * jj) * 8); ga[jj][1] = *(const f32x4*)(a.in[I_G_ATTN] + (lane + 64 * jj) * 8 + 4);
            gl[jj][0] = *(const f32x4*)(a.in[I_G_LRU] + (lane + 64 * jj) * 8); gl[jj][1] = *(const f32x4*)(a.in[I_G_LRU] + (lane + 64 * jj) * 8 + 4); }
        __syncthreads();
#pragma unroll
        for (int q = 0; q < 4; ++q) {
            const int tl = 4 * wave + q; const size_t row = (size_t)b * SEQ + 32 * c + tl;
#pragma unroll
            for (int half = 0; half < 1; ++half) {
                u32x4 w[2]; float v[16]; float ss = 0.f;
#pragma unroll
                for (int jj = 0; jj < 2; ++jj) { w[jj] = half == 0 ? *(const LAS u32x4*)(lds + tl * LR_XS + (lane + 64 * jj) * 16) : aw[q][jj];
#pragma unroll
                    for (int k = 0; k < 4; ++k) { v[jj * 8 + 2 * k] = bflo(w[jj][k]); v[jj * 8 + 2 * k + 1] = bfhi(w[jj][k]); } }
#pragma unroll
                for (int k = 0; k < 16; ++k) ss += v[k] * v[k];
                ss = wave_sum(ss);
                const float rstd = (G2_FP8 ? XS_SCALE : 1.0f) * __builtin_amdgcn_rsqf(ss * (1.0f / 1024.0f) + EPS);
#pragma unroll
                for (int jj = 0; jj < 2; ++jj) { const f32x4 g0 = half == 0 ? gl[jj][0] : ga[jj][0], g1 = half == 0 ? gl[jj][1] : ga[jj][1];
                    const size_t col = (half == 0 ? 1024 : 0) + (lane + 64 * jj) * 8;
                    if (G2_FP8) *(u32x2*)(O8 + row * D + col) = (u32x2){pk4_fp8(v[jj * 8 + 0] * rstd * g0.x, v[jj * 8 + 1] * rstd * g0.y, v[jj * 8 + 2] * rstd * g0.z, v[jj * 8 + 3] * rstd * g0.w),
                                                                       pk4_fp8(v[jj * 8 + 4] * rstd * g1.x, v[jj * 8 + 5] * rstd * g1.y, v[jj * 8 + 6] * rstd * g1.z, v[jj * 8 + 7] * rstd * g1.w)};
                    else *(u32x4*)(O + row * D + col) = (u32x4){pk2(v[jj * 8 + 0] * rstd * g0.x, v[jj * 8 + 1] * rstd * g0.y), pk2(v[jj * 8 + 2] * rstd * g0.z, v[jj * 8 + 3] * rstd * g0.w),
                                                                pk2(v[jj * 8 + 4] * rstd * g1.x, v[jj * 8 + 5] * rstd * g1.y), pk2(v[jj * 8 + 6] * rstd * g1.z, v[jj * 8 + 7] * rstd * g1.w)}; }
            }
        }
}
template <int PASS>
__device__ __forceinline__ void lru_item(const Args& a, LAS unsigned char* lds, int item, int part, int tid, int lane, int wave) {
    const int b = item / 65, c = item % 65; const bool meta = (c == 64);
    const bf16* Z = (const bf16*)(a.ws + WS_Z);
    float* sumA = (float*)(a.ws + WS_LRUSUM); float* sumB = sumA + NBATCH * 64 * DLRU; float* metaB = sumB + NBATCH * 64 * DLRU;
    __syncthreads();
    {
        const int ch0 = (tid & 127) * 8, tq = tid >> 7;
        f32x4 cw[4][2], cb[2];
#pragma unroll
        for (int jj = 0; jj < 4; ++jj) { cw[jj][0] = *(const f32x4*)(a.in[I_CONV_W] + jj * DLRU + ch0); cw[jj][1] = *(const f32x4*)(a.in[I_CONV_W] + jj * DLRU + ch0 + 4); }
        cb[0] = *(const f32x4*)(a.in[I_CONV_B] + ch0); cb[1] = *(const f32x4*)(a.in[I_CONV_B] + ch0 + 4);
#pragma unroll 1
        for (int i0 = 0; i0 < 8; i0 += 4) {
            u32x4 x[4][4];
#pragma unroll
            for (int i = 0; i < 4; ++i) { const int tl = tq + 4 * (i0 + i); const int t = meta ? tl : NMETA + 32 * c + tl;
#pragma unroll
                for (int jj = 0; jj < 4; ++jj) { const int tt = t - 3 + jj; x[i][jj] = (u32x4){0u, 0u, 0u, 0u};
                    if (tt >= 0 && !(meta && tl >= NMETA)) x[i][jj] = *(const u32x4*)(Z + (size_t)tok_row(b, tt) * DIN + ZX + ch0); } }
#pragma unroll
            for (int i = 0; i < 4; ++i) { const int tl = tq + 4 * (i0 + i); const int t = meta ? tl : NMETA + 32 * c + tl;
                f32x4 a0 = cb[0], a1 = cb[1];
#pragma unroll
                for (int jj = 0; jj < 4; ++jj) { const u32x4 xx = x[i][jj];
                    if (t - 3 + jj >= 0) {
                        a0.x += cw[jj][0].x * bflo(xx[0]); a0.y += cw[jj][0].y * bfhi(xx[0]); a0.z += cw[jj][0].z * bflo(xx[1]); a0.w += cw[jj][0].w * bfhi(xx[1]);
                        a1.x += cw[jj][1].x * bflo(xx[2]); a1.y += cw[jj][1].y * bfhi(xx[2]); a1.z += cw[jj][1].z * bflo(xx[3]); a1.w += cw[jj][1].w * bfhi(xx[3]); } }
                u32x4 o = (u32x4){pk2(a0.x, a0.y), pk2(a0.z, a0.w), pk2(a1.x, a1.y), pk2(a1.z, a1.w)};
                if (meta && tl >= NMETA) o = (u32x4){0u, 0u, 0u, 0u};
                *(LAS u32x4*)(lds + tl * LR_XS + ch0 * 2) = o; }
        }
    }
    LAS float* hinL = (LAS float*)(lds + 32 * LR_XS);
    if (PASS == 1) {
        float h0 = metaB[tid], h1 = metaB[tid + 512];
        const float* pa = sumA + (size_t)b * 64 * DLRU + tid; const float* pb = sumB + (size_t)b * 64 * DLRU + tid;
#pragma unroll 8
        for (int jc = 0; jc < c; ++jc) { h0 = pa[jc * DLRU] * h0 + pb[jc * DLRU]; h1 = pa[jc * DLRU + 512] * h1 + pb[jc * DLRU + 512]; }
        hinL[tid] = h0; hinL[tid + 512] = h1;
    }
    __syncthreads();
    const bf16* WaT = (const bf16*)(a.ws + WS_WAT); const bf16* WiT = (const bf16*)(a.ws + WS_WIT);
    const int r31 = lane & 31, h = lane >> 5;
    const int tau = 16 * ((r31 >> 2) & 1) + 4 * (r31 >> 3) + (r31 & 3);
#pragma unroll 1
    for (int nb = 0; nb < 2; ++nb) {
        const int n = 2 * wave + nb;
        bf16x8 af[4];
#pragma unroll
        for (int ks = 0; ks < 4; ++ks) af[ks] = *(const LAS bf16x8*)(lds + tau * LR_XS + (64 * n + 16 * ks + 8 * h) * 2);
#pragma unroll 1
        for (int nt = 0; nt < 2; ++nt) {
            if (part >= 0 && 2 * nb + nt != part) continue;
            const int ch = 64 * n + 32 * nt + r31;
            f32x16 accR, accI;
#pragma unroll
            for (int r = 0; r < 16; ++r) { accR[r] = 0.f; accI[r] = 0.f; }
#pragma unroll
            for (int ks = 0; ks < 4; ++ks) {
                const bf16x8 wa = *(const bf16x8*)(WaT + ((size_t)(n * 64 + 32 * nt + r31) * 64 + 16 * ks + 8 * h));
                const bf16x8 wi = *(const bf16x8*)(WiT + ((size_t)(n * 64 + 32 * nt + r31) * 64 + 16 * ks + 8 * h));
                accR = __builtin_amdgcn_mfma_f32_32x32x16_bf16(af[ks], wa, accR, 0, 0, 0);
                accI = __builtin_amdgcn_mfma_f32_32x32x16_bf16(af[ks], wi, accI, 0, 0, 0);
            }
            const float ba = a.in[I_B_A][ch], bi = a.in[I_B_I][ch], sp8 = -8.0f * 1.4426950408889634f * log1pf(__expf(-a.in[I_LAMBDA][ch]));
            float av[16], bv[16];
            float Ap = 1.0f, Bp = 0.0f;
#pragma unroll
            for (int r = 0; r < 16; ++r) {
                const float xcv = bf2f(*(const LAS unsigned short*)(lds + (16 * h + r) * LR_XS + ch * 2));
                const float rg = fast_sigmoid(accR[r] + ba), ig = fast_sigmoid(accI[r] + bi);
                const float l2a = sp8 * rg;
                av[r] = __builtin_amdgcn_exp2f(l2a); bv[r] = __builtin_amdgcn_sqrtf(fmaxf(fmaf(-av[r], av[r], 1.0f), 0.0f)) * ig * xcv;
                Ap *= av[r]; Bp = av[r] * Bp + bv[r];
                if (PASS == 0 && !meta) ((unsigned*)(a.ws + WS_AB))[((size_t)b * SEQ + 32 * c + 16 * h + r) * DLRU + ch] = pk2(l2a, bv[r]);
            }
            const float Ao = __shfl_xor(Ap, 32), Bo = __shfl_xor(Bp, 32);
            if (PASS == 0) {
                if (h == 0) {
                    if (meta) metaB[ch] = Bp;
                    else { sumA[((size_t)b * 64 + c) * DLRU + ch] = Ap * Ao; sumB[((size_t)b * 64 + c) * DLRU + ch] = Ao * Bp + Bo; }
                }
            } else {
                const float hin = hinL[ch];
                float hs = h == 0 ? hin : (Ao * hin + Bo);
#pragma unroll
                for (int r = 0; r < 16; ++r) {
                    hs = av[r] * hs + bv[r];
                    const int tl = 16 * h + r;
                    const float gt = bf2f(Z[(size_t)(b * SEQ + 32 * c + tl) * DIN + ZG + ch]);
                    *(LAS unsigned short*)(lds + tl * LR_XS + ch * 2) = (unsigned short)f2bf(hs * fast_gelu_tanh(gt));
                }
            }
        }
    }
}

__device__ __forceinline__ void lru_item_b(const Args& a, LAS unsigned char* lds, int item, int tid, int lane, int wave) {
    const int b = item >> 6, c = item & 63;
    const bf16* Z = (const bf16*)(a.ws + WS_Z); const unsigned* AB = (const unsigned*)(a.ws + WS_AB);
    const float* sumA = (const float*)(a.ws + WS_LRUSUM); const float* sumB = sumA + NBATCH * 64 * DLRU; const float* metaB = sumB + NBATCH * 64 * DLRU;
    const size_t row0 = (size_t)b * SEQ + 32 * c;
    u32x2 ab[32]; unsigned gt[32];
#pragma unroll
    for (int tl = 0; tl < 32; ++tl) { ab[tl] = *(const u32x2*)(AB + (row0 + tl) * DLRU + 2 * tid); gt[tl] = *(const unsigned*)(Z + (row0 + tl) * DIN + ZG + 2 * tid); }
    float h0, h1; { const f32x2 m = *(const f32x2*)(metaB + 2 * tid); h0 = m.x; h1 = m.y; }
    { const float* pa = sumA + (size_t)b * 64 * DLRU + 2 * tid; const float* pb = sumB + (size_t)b * 64 * DLRU + 2 * tid;
#pragma unroll 16
      for (int jc = 0; jc < c; ++jc) { const f32x2 A2 = *(const f32x2*)(pa + jc * DLRU), B2 = *(const f32x2*)(pb + jc * DLRU); h0 = A2.x * h0 + B2.x; h1 = A2.y * h1 + B2.y; } }
    __syncthreads();
#pragma unroll
    for (int tl = 0; tl < 32; ++tl) {
        h0 = __builtin_amdgcn_exp2f(bflo(ab[tl].x)) * h0 + bfhi(ab[tl].x);
        h1 = __builtin_amdgcn_exp2f(bflo(ab[tl].y)) * h1 + bfhi(ab[tl].y);
        *(LAS unsigned*)(lds + tl * LR_XS + 4 * tid) = pk2(h0 * fast_gelu_tanh(bflo(gt[tl])), h1 * fast_gelu_tanh(bfhi(gt[tl])));
    }
    lru_norm_rows(a, lds, b, c, lane, wave);
}

__device__ __forceinline__ void phase_router_mfma(const Args& a, LAS unsigned char* lds, int tid, int lane, int wave) {
    const bf16* H1 = (const bf16*)(a.ws + WS_H1); const bf16* WRT = (const bf16*)(a.ws + WS_WRT);
    int* tope = (int*)(a.ws + WS_TOPE); float* topw = (float*)(a.ws + WS_TOPW); float* rstd2 = (float*)(a.ws + WS_RSTD2);
    unsigned* counts = (unsigned*)(a.ws + WS_CTL) + CW_COUNTS;
    LAS float* lg = (LAS float*)(lds + wave * 2048);
    LAS int* hist = (LAS int*)(lds + 32768);
    if (tid < 32) hist[tid] = 0;
    __syncthreads();
    const int fr = lane & 15, fq = lane >> 4;
    const int kh = wave >> 2;
    LAS float* part = (LAS float*)(lds + 40960 + (wave & 3) * 2560);
    for (int g0 = 4 * blockIdx.x; g0 < MREAL / 16; g0 += 4 * gridDim.x) {
        const int grp = g0 + (wave & 3);
        const int row0 = grp * 16;
        const bf16* hp = H1 + (size_t)(row0 + fr) * D + 8 * fq + 1024 * kh;
        const bf16* wp = WRT + (size_t)fr * D + 8 * fq + 1024 * kh;
        f32x4 acc0 = (f32x4){0.f, 0.f, 0.f, 0.f}, acc1 = acc0; float ss = 0.f;
#pragma unroll 8
        for (int kk = 0; kk < 32; ++kk) {
            const u32x4 w = *(const u32x4*)(hp + 32 * kk);
#pragma unroll
            for (int q = 0; q < 4; ++q) { const float lo = bflo(w[q]), hi = bfhi(w[q]); ss += lo * lo + hi * hi; }
            const bf16x8 af = __builtin_bit_cast(bf16x8, w);
            const bf16x8 b0 = *(const bf16x8*)(wp + 32 * kk), b1 = *(const bf16x8*)(wp + (size_t)16 * D + 32 * kk);
            acc0 = __builtin_amdgcn_mfma_f32_16x16x32_bf16(af, b0, acc0, 0, 0, 0);
            acc1 = __builtin_amdgcn_mfma_f32_16x16x32_bf16(af, b1, acc1, 0, 0, 0);
        }
        if (kh == 1) {
#pragma unroll
            for (int j = 0; j < 4; ++j) { part[j * 64 + lane] = acc0[j]; part[(4 + j) * 64 + lane] = acc1[j]; }
            part[8 * 64 + lane] = ss; }
        __syncthreads();
        if (kh == 0) {
#pragma unroll
            for (int j = 0; j < 4; ++j) { acc0[j] += part[j * 64 + lane]; acc1[j] += part[(4 + j) * 64 + lane]; }
            ss += part[8 * 64 + lane]; }
        __syncthreads();
        if (kh == 1) continue;
        ss += __shfl_xor(ss, 16); ss += __shfl_xor(ss, 32);
        const float rstd = 1.0f / sqrtf(ss * (1.0f / D) + EPS);
        if (fq == 0) rstd2[row0 + fr] = rstd;
        const float br0 = a.in[I_B_ROUTER][fr], br1 = a.in[I_B_ROUTER][16 + fr];
#pragma unroll
        for (int j = 0; j < 4; ++j) { const int row = 4 * fq + j; const float rs = __shfl(rstd, row);
            lg[row * 32 + fr] = acc0[j] * rs + br0; lg[row * 32 + 16 + fr] = acc1[j] * rs + br1; }
        asm volatile("s_waitcnt lgkmcnt(0)" ::: "memory");
        if (lane < 16) {
            float v[32];
#pragma unroll
            for (int q = 0; q < 8; ++q) { const f32x4 t = *(const LAS f32x4*)(lg + lane * 32 + 4 * q); v[4 * q] = t.x; v[4 * q + 1] = t.y; v[4 * q + 2] = t.z; v[4 * q + 3] = t.w; }
            float tv[4]; int te[4];
#pragma unroll
            for (int r = 0; r < 4; ++r) { float best = -3.0e38f; int bi = 0;
#pragma unroll
                for (int e = 0; e < 32; ++e) { const bool gtb = v[e] > best; best = gtb ? v[e] : best; bi = gtb ? e : bi; }
#pragma unroll
                for (int e = 0; e < 32; ++e) v[e] = (e == bi) ? -3.0e38f : v[e];
                tv[r] = best; te[r] = bi; }
            const float e1 = __expf(tv[1] - tv[0]), e2 = __expf(tv[2] - tv[0]), e3 = __expf(tv[3] - tv[0]);
            const float inv = 1.0f / (1.0f + e1 + e2 + e3);
            const int row = row0 + lane;
            *(int4*)(tope + row * 4) = make_int4(te[0], te[1], te[2], te[3]);
            *(f32x4*)(topw + row * 4) = (f32x4){inv, e1 * inv, e2 * inv, e3 * inv};
#pragma unroll
            for (int r = 0; r < 4; ++r) atomicAdd((int*)&hist[te[r]], 1);
        }
        asm volatile("s_waitcnt lgkmcnt(0)" ::: "memory");
    }
    __syncthreads();
    if (tid < 32 && hist[tid] != 0) atomicAdd(&counts[tid], (unsigned)hist[tid]);
}

__device__ __forceinline__ void build_tile_table(const Args& a, LAS int* tstart, int tid) {
    if (tid < 64) {
        const unsigned* counts = (const unsigned*)(a.ws + WS_CTL) + CW_COUNTS;
        const int nt = tid < NEXP ? (int)((__hip_atomic_load(counts + tid, __ATOMIC_RELAXED, __HIP_MEMORY_SCOPE_AGENT) + 255u) >> 8) : 0;
        int inc = nt;
#pragma unroll
        for (int o = 1; o < 32; o <<= 1) { const int v = __shfl_up(inc, o); if ((tid & 63) >= o) inc += v; }
        if (tid < NEXP) tstart[tid] = inc - nt;
        if (tid == NEXP - 1) tstart[NEXP] = inc;
    }
    __syncthreads();
    if (tid < 288) { int e = 0;
#pragma unroll 1
        for (int i = 1; i < NEXP; ++i) e += (tstart[i] <= tid) ? 1 : 0;
        ((LAS unsigned char*)(tstart + 64))[tid] = (unsigned char)e; }
    __syncthreads();
}
__device__ __forceinline__ int tile_expert(const LAS int* tstart, int tile) {
    int e = 0;
#pragma unroll 1
    for (int i = 1; i < NEXP; ++i) e += (tstart[i] <= tile) ? 1 : 0;
    return e;
}

__device__ __forceinline__ void phase_assign(const Args& a, LAS unsigned char* lds, int tid, int lane, int wave) {
    LAS int* tstart = (LAS int*)(lds + LDS_TAB);
    LAS int* hist = (LAS int*)lds; LAS int* base = hist + 32; LAS int* spos = base + 32;
    build_tile_table(a, tstart, tid);
    const int* tope = (const int*)(a.ws + WS_TOPE); const float* topw = (const float*)(a.ws + WS_TOPW); const float* rstd2 = (const float*)(a.ws + WS_RSTD2);
    int* rowpair = (int*)(a.ws + WS_ROWPAIR); float* roww = (float*)(a.ws + WS_ROWW);
    unsigned* cursor = (unsigned*)(a.ws + WS_CTL) + CW_CURSOR;
    const bf16* H1 = (const bf16*)(a.ws + WS_H1); unsigned char* XS = (unsigned char*)(a.ws + WS_XS);
    for (int blk = blockIdx.x; blk < MREAL / 64; blk += gridDim.x) {
        if (tid < 32) hist[tid] = 0;
        __syncthreads();
        int e = 0, rank = 0, pair = 0;
        if (tid < 256) { pair = blk * 256 + tid; e = tope[pair]; rank = atomicAdd((int*)&hist[e], 1); }
        __syncthreads();
        if (tid < 32) base[tid] = (int)atomicAdd(&cursor[tid], (unsigned)hist[tid]);
        __syncthreads();
        if (tid < 256) { const int pos = tstart[e] * 256 + base[e] + rank; spos[tid] = pos; rowpair[pos] = pair; roww[pos] = topw[pair]; ((int*)(a.ws + WS_PAIRPOS))[pair] = pos; }
        __syncthreads();
        for (int tt = wave * 8; tt < wave * 8 + 8; ++tt) {
            const int token = blk * 64 + tt; const float rstd = rstd2[token] * XS_SCALE;
            const u32x4* hr = (const u32x4*)(H1 + (size_t)token * D);
            u32x4* dst = (u32x4*)(XS + (size_t)token * D);
#pragma unroll
            for (int j = 0; j < 2; ++j) { const u32x4 ha = hr[2 * (lane + 64 * j)], hb = hr[2 * (lane + 64 * j) + 1];
                const f32x4* gp = (const f32x4*)a.in[I_NORM_FFN] + 4 * (lane + 64 * j); const f32x4 g0 = gp[0], g1 = gp[1], g2 = gp[2], g3 = gp[3];
                dst[lane + 64 * j] = (u32x4){pk4_fp8(bflo(ha[0]) * rstd * g0.x, bfhi(ha[0]) * rstd * g0.y, bflo(ha[1]) * rstd * g0.z, bfhi(ha[1]) * rstd * g0.w),
                                             pk4_fp8(bflo(ha[2]) * rstd * g1.x, bfhi(ha[2]) * rstd * g1.y, bflo(ha[3]) * rstd * g1.z, bfhi(ha[3]) * rstd * g1.w),
                                             pk4_fp8(bflo(hb[0]) * rstd * g2.x, bfhi(hb[0]) * rstd * g2.y, bflo(hb[1]) * rstd * g2.z, bfhi(hb[1]) * rstd * g2.w),
                                             pk4_fp8(bflo(hb[2]) * rstd * g3.x, bfhi(hb[2]) * rstd * g3.y, bflo(hb[3]) * rstd * g3.z, bfhi(hb[3]) * rstd * g3.w)}; }
        }
        __syncthreads();
    }
}

__device__ __forceinline__ void phase_final(const Args& a, int lane, int wave) {
    const int gw = blockIdx.x * 8 + wave, NGW = gridDim.x * 8;
    const bf16* H1 = (const bf16*)(a.ws + WS_H1); const unsigned char* YB = a.ws + WS_YB;
    const int* pairpos = (const int*)(a.ws + WS_PAIRPOS); const float* topw = (const float*)(a.ws + WS_TOPW);
    for (int row = gw; row < MREAL; row += NGW) {
        const int4 pp = *(const int4*)(pairpos + row * 4); const f32x4 pw = *(const f32x4*)(topw + row * 4) * (1.0f / YB_SCALE);
        const int pos[4] = {pp.x, pp.y, pp.z, pp.w}; const float w4[4] = {pw.x, pw.y, pw.z, pw.w};
        f32x4 v[8]; unsigned y[4][8]; float ss = 0.f;
#pragma unroll
        for (int k = 0; k < 4; ++k)
#pragma unroll
            for (int j = 0; j < 8; ++j) y[k][j] = ((const unsigned*)(YB + (size_t)pos[k] * D))[lane + 64 * j];
#pragma unroll
        for (int j = 0; j < 8; ++j) { { const u32x2 hh = ((const u32x2*)(H1 + (size_t)row * D))[lane + 64 * j]; v[j] = (f32x4){bflo(hh.x), bfhi(hh.x), bflo(hh.y), bfhi(hh.y)}; }
#pragma unroll
            for (int k = 0; k < 4; ++k) { const f32x2 lo = __builtin_amdgcn_cvt_pk_f32_fp8((int)y[k][j], false), hi = __builtin_amdgcn_cvt_pk_f32_fp8((int)y[k][j], true);
                v[j].x += w4[k] * lo.x; v[j].y += w4[k] * lo.y; v[j].z += w4[k] * hi.x; v[j].w += w4[k] * hi.y; }
            ss += (v[j].x * v[j].x + v[j].y * v[j].y) + (v[j].z * v[j].z + v[j].w * v[j].w); }
        ss = wave_sum(ss);
        const float rstd = 1.0f / sqrtf(ss * (1.0f / D) + EPS);
        f32x4* op = (f32x4*)(a.out + (size_t)row * D);
#pragma unroll
        for (int j = 0; j < 8; ++j) { const f32x4 g = ((const f32x4*)a.in[I_FINAL_NORM])[lane + 64 * j]; op[lane + 64 * j] = v[j] * rstd * g; }
    }
}

enum { PH_PROLOGUE = 0, PH_G1, PH_ATTN, PH_LRU_B, PH_G2, PH_ROUTER, PH_ASSIGN, PH_G3, PH_G4, PH_FINAL, PH_COUNT };

__global__ void __launch_bounds__(512, 2) fwd(Args a) {
    extern __shared__ __attribute__((aligned(16))) unsigned char lds_raw[];
    LAS unsigned char* lds = (LAS unsigned char*)lds_raw;
    const int tid = threadIdx.x, lane = tid & 63, wave = __builtin_amdgcn_readfirstlane(tid >> 6);
    const int gw = blockIdx.x * 8 + wave, NGW = gridDim.x * 8;
    unsigned char* ws = a.ws;
#define IN(k) (a.ph_lo <= (k) && (k) < a.ph_hi)
    pg8::BGNone nobg;
    pg8::BGConv bgup{(const char*)a.in[I_W_UP], ws + WS_WUT, (int)blockIdx.x * 128, (int)blockIdx.x * 128 + 80, ws + WS_DUMMY};
#define SEAM(k) do { if (IN(k) && IN((k) + 1)) xcd_barrier(bar); } while (0)
    if (tid < 4) ((LAS unsigned*)(lds + LDS_MISC))[tid] = 0u;
    __syncthreads();
    XcdBarrier bar; bar.bar = (unsigned*)(ws + WS_CTL) + CW_BAR; bar.x = 0; bar.st = nullptr;
    if (a.ph_hi - a.ph_lo > 1) bar = xcd_barrier_post((unsigned*)(ws + WS_CTL) + CW_BAR, (volatile LAS unsigned*)(lds + LDS_MISC));

    if (IN(PH_PROLOGUE)) { phase_prologue(a, lds, tid, lane, wave);
#if PROBE_REPEAT == 0
        __syncthreads(); phase_prologue(a, lds, tid, lane, wave);
#endif
    }
    SEAM(PH_PROLOGUE);

    if (IN(PH_G1)) {
        const int ncv = g1_conv_wg(), G1G = (int)gridDim.x - ncv;
        pg8::SchedDense S{(const char*)(ws + WS_N1), (const char*)(ws + WS_WINT), (const char*)(ws + WS_WINT), nullptr, MROWS / 256, DIN / 256, G1G, (int)blockIdx.x, G1_FP8 ? 2048 : 4096};
        pg8::EpiZ E{(bf16*)(ws + WS_Z), a.in[I_B_IN], (const float*)(ws + WS_RSTD1)};
        if ((int)blockIdx.x >= G1G) conv_tiles(a, lds, tid, conv_pro_tiles() + ((int)blockIdx.x - G1G), CONV_ALL_TILES, ncv);
        else
#if BG_WUP
        pg8::gemm_phase<G1_FP8 != 0>(lds, S, E, bgup);
#else
        pg8::gemm_phase<G1_FP8 != 0>(lds, S, E, nobg);
#endif
#if PROBE_REPEAT == 1
        __syncthreads(); pg8::gemm_phase<G1_FP8 != 0>(lds, S, E, nobg);
#endif
    }
    SEAM(PH_G1);
    if (IN(PH_ATTN)) {
        for (int it = blockIdx.x; it < NBATCH * 16 * 4; it += gridDim.x) attn_item(a, lds, it, tid, lane, wave);
        for (int j = blockIdx.x; j < NBATCH * 64 + 4; j += gridDim.x) {
            if (j < NBATCH * 64) lru_item<0>(a, lds, (j >> 6) * 65 + (j & 63), -1, tid, lane, wave); else lru_item<0>(a, lds, 64, j - NBATCH * 64, tid, lane, wave); }
#if PROBE_REPEAT == 2
        for (int it = blockIdx.x; it < NBATCH * 16 * 4; it += gridDim.x) attn_item(a, lds, it, tid, lane, wave);
#endif
#if PROBE_REPEAT == 3
        for (int j = blockIdx.x; j < NBATCH * 64 + 4; j += gridDim.x) {
            if (j < NBATCH * 64) lru_item<0>(a, lds, (j >> 6) * 65 + (j & 63), -1, tid, lane, wave); else lru_item<0>(a, lds, 64, j - NBATCH * 64, tid, lane, wave); }
#endif
    }
    SEAM(PH_ATTN);
    if (IN(PH_LRU_B)) {
        for (int it = blockIdx.x; it < NBATCH * 64; it += gridDim.x) lru_item_b(a, lds, (it & 256) ? (it ^ 63) : it, tid, lane, wave);
    }
    SEAM(PH_LRU_B);
    if (IN(PH_G2)) {
        pg8::SchedDense S{(const char*)(ws + WS_O), (const char*)(ws + WS_WOUTT), (const char*)(ws + WS_WOUTT), nullptr, MREAL / 256, D / 256, (int)gridDim.x, (int)blockIdx.x, G2_FP8 ? 2048 : 4096};
        pg8::EpiH1 E{(bf16*)(ws + WS_H1), (const bf16*)(ws + WS_N1), a.in[I_B_OUT], G2_FP8 ? 1.0f / (W_SCALE * XS_SCALE) : 1.0f, (const float*)(ws + WS_SSQ)};
#if BG_WUP
        pg8::gemm_phase<G2_FP8 != 0>(lds, S, E, bgup);
        for (int pair = bgup.next < bgup.end ? bgup.next : bgup.end; pair < bgup.end; ++pair) { const char* sp; unsigned char* dp; pg8::bg_pair_ptrs(bgup, pair, sp, dp);
            const int n = tid >> 4, c = tid & 15; const float* p = (const float*)sp + (size_t)(8 * c) * 2048 + n;
            *(u32x2*)(dp + (size_t)n * 2048 + 8 * c) = (u32x2){pk4_fp8(p[0] * W_SCALE, p[2048] * W_SCALE, p[4096] * W_SCALE, p[6144] * W_SCALE), pk4_fp8(p[8192] * W_SCALE, p[10240] * W_SCALE, p[12288] * W_SCALE, p[14336] * W_SCALE)}; }
#else
        pg8::gemm_phase<G2_FP8 != 0>(lds, S, E, nobg);
#endif
#if PROBE_REPEAT == 4
        __syncthreads(); pg8::gemm_phase<G2_FP8 != 0>(lds, S, E, nobg);
#endif
    }
    SEAM(PH_G2);
    if (IN(PH_ROUTER)) phase_router_mfma(a, lds, tid, lane, wave);
    if (IN(PH_ROUTER) && IN(PH_ASSIGN)) {
        asm volatile("s_waitcnt vmcnt(0)" ::: "memory"); __syncthreads();
        if (tid == 0) { unsigned* rs = (unsigned*)(ws + WS_CTL) + CW_RSYNC; unsigned* tmo = (unsigned*)(ws + WS_CTL) + CW_BAR + XB_TMO;
            __hip_atomic_fetch_add(rs, 1u, __ATOMIC_RELAXED, __HIP_MEMORY_SCOPE_AGENT);
            unsigned sp = 0; while (__hip_atomic_load(rs, __ATOMIC_RELAXED, __HIP_MEMORY_SCOPE_AGENT) < gridDim.x) { __builtin_amdgcn_s_sleep(1);
                if ((++sp & 255u) == 0u) { if (__hip_atomic_load(tmo, __ATOMIC_RELAXED, __HIP_MEMORY_SCOPE_AGENT)) break; if (sp > XB_SPIN_CAP) { atomicAdd(tmo, 1u); break; } } } }
        __syncthreads();
    } else SEAM(PH_ROUTER);
    if (IN(PH_ASSIGN)) phase_assign(a, lds, tid, lane, wave);
    SEAM(PH_ASSIGN);
    if (IN(PH_G3)) {
        LAS int* tstart = (LAS int*)(lds + LDS_TAB);
        if (!IN(PH_ASSIGN)) build_tile_table(a, tstart, tid);
        const int G3G = (int)gridDim.x - G3_TEST_IDLE;
        pg8::SchedMoE S{(const char*)(ws + WS_N2), (const char*)(ws + WS_WGT), (const char*)(ws + WS_WUT), (const int*)(ws + WS_ROWPAIR), tstart, tstart[NEXP], DFF / 128, G3G, (int)blockIdx.x, true};
        pg8::EpiAct E{(unsigned char*)(ws + WS_ACT), a.in[I_B_GATE], a.in[I_B_UP]};
#if BG_WDOWN
        int bg0, bg1;
        { const int U = tstart[NEXP] * (DFF / 128), ulo = U / G3G, nhi = U - ulo * G3G, c = (int)blockIdx.x;
          int plo = (32768 + nhi * 48 + G3G - 1) / G3G; if (nhi != 0 && plo > 8 * ulo) plo = 8 * ulo > 0 ? 8 * ulo : 1;
          int phi = nhi ? (32768 - (G3G - nhi) * plo + nhi - 1) / nhi : 0; if (phi < 0) phi = 0;
          bg0 = c < nhi ? c * phi : nhi * phi + (c - nhi) * plo; bg1 = bg0 + (c < nhi ? phi : plo);
          if (c >= G3G) { bg0 = bg1 = 32768; }
          if (c == G3G - 1) bg1 = 32768;
          bg0 = bg0 < 32768 ? bg0 : 32768; bg1 = bg1 < 32768 ? bg1 : 32768; }
        pg8::BGConv bg{(const char*)a.in[I_W_DOWN], ws + WS_WDT, bg0, bg1, ws + WS_DUMMY};
        if ((int)blockIdx.x < G3G) pg8::gemm_phase<true, pg8::EpiAct, pg8::SchedMoE, pg8::BGConv, true>(lds, S, E, bg);
        for (int pair = bg.next < bg.end ? bg.next : bg.end; pair < bg.end; ++pair) { const char* sp; unsigned char* dp; pg8::bg_pair_ptrs(bg, pair, sp, dp);
            const int n = tid >> 4, c = tid & 15;
            const float* p = (const float*)sp + (size_t)(8 * c) * 2048 + n;
            *(u32x2*)(dp + (size_t)n * 2048 + 8 * c) = (u32x2){pk4_fp8(p[0] * W_SCALE, p[2048] * W_SCALE, p[4096] * W_SCALE, p[6144] * W_SCALE), pk4_fp8(p[8192] * W_SCALE, p[10240] * W_SCALE, p[12288] * W_SCALE, p[14336] * W_SCALE)}; }
#else
        pg8::gemm_phase<true, pg8::EpiAct, pg8::SchedMoE, pg8::BGNone, true>(lds, S, E, nobg);
#endif
#if PROBE_REPEAT == 7
        __syncthreads(); pg8::gemm_phase<true, pg8::EpiAct, pg8::SchedMoE, pg8::BGNone, true>(lds, S, E, nobg);
#endif
    }
    SEAM(PH_G3);
    if (IN(PH_G4)) {
        LAS int* tstart = (LAS int*)(lds + LDS_TAB);
        if (!IN(PH_ASSIGN) && !IN(PH_G3)) build_tile_table(a, tstart, tid);
        pg8::SchedMoE S{(const char*)(ws + WS_ACT), (const char*)(ws + WS_WDT), (const char*)(ws + WS_WDT), nullptr, tstart, tstart[NEXP], D / 256, (int)gridDim.x, (int)blockIdx.x, false};
        pg8::EpiDown E{ws + WS_YB, a.in[I_B_DOWN]};
        pg8::gemm_phase<true>(lds, S, E, nobg);
#if PROBE_REPEAT == 8
        __syncthreads(); pg8::gemm_phase<true>(lds, S, E, nobg);
#endif
    }
    SEAM(PH_G4);
    if (IN(PH_FINAL)) { phase_final(a, lane, wave);
#if PROBE_REPEAT == 9
        phase_final(a, lane, wave);
#endif
    }
#undef IN
#undef SEAM
}

extern "C" void kernel_launch(void* const* d_in, const int* in_sizes, int n_in, void* d_out, int out_size, void* d_ws, size_t ws_size, hipStream_t stream) {
    static int grid = 0;
    if (grid == 0) {
        if (n_in != 27 || out_size != MREAL * D || ws_size < WS_END) { fprintf(stderr, "kernel_launch: unexpected problem (n_in %d, out %d, ws %zu)\n", n_in, out_size, ws_size); grid = -1; return; }
        int dev = 0, cus = 0;
        if (hipGetDevice(&dev) != hipSuccess || hipDeviceGetAttribute(&cus, hipDeviceAttributeMultiprocessorCount, dev) != hipSuccess) { grid = -1; return; }
        if (hipFuncSetAttribute((const void*)fwd, hipFuncAttributeMaxDynamicSharedMemorySize, LDS_BYTES) != hipSuccess) { fprintf(stderr, "kernel_launch: hipFuncSetAttribute failed\n"); grid = -1; return; }
        grid = cus;
    }
    if (grid < 0) return;
    (void)hipMemsetAsync((char*)d_ws + WS_CTL, 0, CTL_BYTES, stream);
    Args a{};
    for (int i = 0; i < 27; ++i) a.in[i] = (const float*)d_in[i];
    a.out = (float*)d_out; a.ws = (unsigned char*)d_ws;
#if MK_ONE_LAUNCH
    a.ph_lo = 0; a.ph_hi = PH_COUNT;
    hipLaunchKernelGGL(fwd, dim3(grid), dim3(512), LDS_BYTES, stream, a);
#else
    for (int ph = 0; ph < PH_COUNT; ++ph) {
        a.ph_lo = ph; a.ph_hi = ph + 1;
        hipLaunchKernelGGL(fwd, dim3(grid), dim3(512), LDS_BYTES, stream, a);
    }
#endif
}
```

```cpp
#include <hip/hip_runtime.h>
#include <cstdio>
#include <cstdint>

#define LAS __attribute__((address_space(3)))
#ifndef PROBE_REPEAT
#define PROBE_REPEAT -1
#endif
#ifndef G1_FP8
#define G1_FP8 0
#endif
#ifndef G2_FP8
#define G2_FP8 0
#endif
#ifndef BG_WDOWN
#define BG_WDOWN 1
#endif
#ifndef G3_TEST_IDLE
#define G3_TEST_IDLE 0
#endif
#ifndef BG_WUP
#define BG_WUP 0
#endif
#ifndef BG_EXP
#define BG_EXP 0
#endif
#ifndef MK_ONE_LAUNCH
#define MK_ONE_LAUNCH 1
#endif
typedef unsigned short bf16;
typedef float f32x4 __attribute__((ext_vector_type(4)));
typedef float f32x2 __attribute__((ext_vector_type(2)));
typedef short bf16x8 __attribute__((ext_vector_type(8)));
typedef unsigned u32x4 __attribute__((ext_vector_type(4)));
typedef unsigned u32x2 __attribute__((ext_vector_type(2)));

constexpr int D = 2048, SEQ = 2048, NMETA = 16, TT = 2064, NBATCH = 8;
constexpr int MREAL = 16384, METAROW0 = 16384, MVALID = 16400, MROWS = 16640;
constexpr int DIN = 3584, DLRU = 1024, HD = 64;
constexpr int ZQ = 0, ZK = 1024, ZV = 1280, ZX = 1536, ZG = 2560;
constexpr int NEXP = 32, DFF = 2048, PROWS = 73728;
constexpr float EPS = 1e-5f;

constexpr size_t MiB = 1u << 20;
constexpr size_t WS_CTL = 0, CTL_BYTES = 1 * MiB;
constexpr size_t WS_COS = 1 * MiB, WS_SIN = 1 * MiB + 320 * 1024;
constexpr size_t WS_TOPE = 2 * MiB, WS_TOPW = WS_TOPE + 256 * 1024, WS_RSTD2 = WS_TOPW + 256 * 1024, WS_ROWPAIR = WS_RSTD2 + 64 * 1024, WS_ROWW = WS_ROWPAIR + 320 * 1024;
constexpr size_t WS_PAIRPOS = 3 * MiB + 256 * 1024;
constexpr size_t WS_DUMMY = 3 * MiB + 512 * 1024;
constexpr size_t WS_LRUSUM = 4 * MiB;
constexpr size_t WS_RSTD1 = 8 * MiB + 256 * 1024;
constexpr size_t WS_SSQ = 8 * MiB + 512 * 1024;
constexpr size_t WS_WAT = 9 * MiB, WS_WIT = WS_WAT + 128 * 1024, WS_WRT = WS_WIT + 128 * 1024;
constexpr size_t WS_WINT = 10 * MiB, WS_WOUTT = 24 * MiB, WS_WGT = 32 * MiB, WS_WUT = 288 * MiB, WS_WDT = 544 * MiB;
constexpr size_t WS_N1 = 800 * MiB, WS_Z = 866 * MiB, WS_O = 980 * MiB, WS_H1 = 1044 * MiB, WS_XS = 1172 * MiB, WS_YB = WS_XS, WS_ACT = 1460 * MiB, WS_END = 1748 * MiB;
constexpr size_t WS_N2 = WS_XS;
constexpr size_t WS_AB = WS_XS;
constexpr size_t WS_ATT = WS_N1;
constexpr size_t WS_XC = WS_XS, WS_AA = WS_XS + 66 * MiB, WS_BB = WS_XS + 132 * MiB, WS_YL = WS_XS + 198 * MiB;
static_assert(WS_ROWW + PROWS * 4 <= WS_LRUSUM, "small map");
constexpr int CW_COUNTS = 1024, CW_CURSOR = 1088, CW_RSYNC = 1280, CW_BAR = 4096;

constexpr int LDS_TAB = 131072;
constexpr int LDS_META = LDS_TAB + 1024;
constexpr int LDS_RID = LDS_META + 3072;
constexpr int LDS_MISC = LDS_TAB + 8192;
constexpr int LDS_BG = LDS_MISC + 1024;
constexpr int LDS_T2 = LDS_BG + 16384;
constexpr int LDS_BYTES = LDS_T2 + 4352;
static_assert(LDS_BYTES <= 163840 && LDS_BG % 1024 == 0, "LDS map");

__device__ const float c_inv_freq[32] = {1.000000000e+00f, 7.498942018e-01f, 5.623413324e-01f, 4.216965139e-01f, 3.162277639e-01f, 2.371373922e-01f, 1.778279394e-01f, 1.333521456e-01f, 1.000000015e-01f, 7.498941571e-02f, 5.623412877e-02f, 4.216964915e-02f, 3.162277862e-02f, 2.371373586e-02f, 1.778279431e-02f, 1.333521493e-02f, 9.999999776e-03f, 7.498942316e-03f, 5.623413250e-03f, 4.216964822e-03f, 3.162277862e-03f, 2.371373819e-03f, 1.778279431e-03f, 1.333521446e-03f, 1.000000047e-03f, 7.498941850e-04f, 5.623413017e-04f, 4.216965463e-04f, 3.162277862e-04f, 2.371373848e-04f, 1.778279402e-04f, 1.333521504e-04f};

struct Args { const float* in[27]; float* out; unsigned char* ws; int ph_lo, ph_hi; };
enum { I_X = 0, I_META, I_NORM_MIX, I_W_IN, I_B_IN, I_SINKS, I_CONV_W, I_CONV_B, I_W_A, I_B_A, I_W_I, I_B_I, I_LAMBDA, I_G_ATTN, I_G_LRU, I_W_OUT, I_B_OUT, I_NORM_FFN,
       I_W_ROUTER, I_B_ROUTER, I_W_GATE, I_B_GATE, I_W_UP, I_B_UP, I_W_DOWN, I_B_DOWN, I_FINAL_NORM };


#define XB_TMO      128
#define XB_XCNT(j)  (256  + 64 * (j))
#define XB_XSUB(j)  (1280 + 64 * (j))
#define XB_XGEN(j)  (2304 + 64 * (j))
#define XB_TOP      3328
#define XB_TOPGEN   3392
#define XCD_BAR_WORDS 3456
#define XB_SPIN_CAP (1u << 18)

__device__ __forceinline__ unsigned xb_ld(unsigned* p)              { return __hip_atomic_load(p, __ATOMIC_RELAXED, __HIP_MEMORY_SCOPE_AGENT); }
__device__ __forceinline__ unsigned xb_add(unsigned* p, unsigned v) { return __hip_atomic_fetch_add(p, v, __ATOMIC_RELAXED, __HIP_MEMORY_SCOPE_AGENT); }
__device__ __forceinline__ unsigned xb_xcc_id() { return (unsigned)__builtin_amdgcn_s_getreg((3 << 11) | 20) & 0xFu; }
#define XB_SPIN(cond, bar) do { unsigned _sp = 0; while (cond) { __builtin_amdgcn_s_sleep(1); \
    if ((++_sp & 255u) == 0u) { if (xb_ld(&(bar)[XB_TMO])) break; if (_sp > XB_SPIN_CAP) { atomicAdd(&(bar)[XB_TMO], 1u); break; } } } } while (0)

struct XcdBarrier {
    unsigned* bar; unsigned x;
    volatile LAS unsigned* st;
};

__device__ __forceinline__ XcdBarrier xcd_barrier_post(unsigned* bar, volatile LAS unsigned* st) {
    XcdBarrier b; b.bar = bar; b.x = xb_xcc_id(); b.st = st;
    if (threadIdx.x == 0) (void)xb_add(&bar[XB_XCNT(b.x)], 1u);
    return b;
}
__device__ __forceinline__ void xcd_barrier_complete(unsigned* bar, unsigned x, unsigned& nloc, unsigned& nx) {
    const unsigned G = gridDim.x * gridDim.y * gridDim.z;
    unsigned sum, cnt, mine, sp = 0u;
    for (;;) {
        sum = 0u; cnt = 0u; mine = 0u;
#pragma unroll
        for (unsigned j = 0; j < 16; ++j) { const unsigned c = xb_ld(&bar[XB_XCNT(j)]); sum += c; cnt += (c > 0u) ? 1u : 0u; mine = (j == x) ? c : mine; }
        if (sum == G) break;
        __builtin_amdgcn_s_sleep(1);
        if ((++sp & 255u) == 0u) { if (xb_ld(&bar[XB_TMO])) break; if (sp > XB_SPIN_CAP) { atomicAdd(&bar[XB_TMO], 1u); break; } }
    }
    nloc = mine > 0u ? mine : 1u; nx = cnt > 0u ? cnt : 1u;
}

__device__ __forceinline__ void xcd_barrier(const XcdBarrier& b) {
    asm volatile("s_waitcnt vmcnt(0)" ::: "memory");
    __syncthreads();
    if (threadIdx.x == 0) {
        unsigned* bar = b.bar;
        __builtin_amdgcn_s_waitcnt(0);
        unsigned nloc = b.st[0], nx = b.st[1];
        if (nloc == 0u) { xcd_barrier_complete(bar, b.x, nloc, nx); b.st[0] = nloc; b.st[1] = nx; }
        const unsigned old = xb_add(&bar[XB_XSUB(b.x)], 1u);
        const unsigned gen = old / nloc;
        if (old + 1u == (gen + 1u) * nloc) {
            __builtin_amdgcn_fence(__ATOMIC_RELEASE, "agent");
            asm volatile("s_waitcnt vmcnt(0)" ::: "memory");
            const unsigned og = xb_add(&bar[XB_TOP], 1u);
            const unsigned tg = og / nx;
            if (og + 1u == (tg + 1u) * nx) xb_add(&bar[XB_TOPGEN], 1u);
            else XB_SPIN(xb_ld(&bar[XB_TOPGEN]) == tg, bar);
            __builtin_amdgcn_fence(__ATOMIC_ACQUIRE, "agent");
            xb_add(&bar[XB_XGEN(b.x)], 1u);
            asm volatile("s_waitcnt vmcnt(0)" ::: "memory");
        } else {
            XB_SPIN(xb_ld(&bar[XB_XGEN(b.x)]) == gen, bar);
            __builtin_amdgcn_fence(__ATOMIC_ACQUIRE, "agent");
            asm volatile("s_waitcnt vmcnt(0)" ::: "memory");
        }
    }
    __syncthreads();
}

__device__ __forceinline__ float bf2f(unsigned b) { return __uint_as_float((b & 0xffffu) << 16); }
__device__ __forceinline__ float bflo(unsigned w) { return __uint_as_float(w << 16); }
__device__ __forceinline__ float bfhi(unsigned w) { return __uint_as_float(w & 0xffff0000u); }
__device__ __forceinline__ unsigned f2bf(float f) { unsigned u = __float_as_uint(f); return (u + 0x7fffu + ((u >> 16) & 1u)) >> 16; }
typedef __bf16 bf16x2n __attribute__((ext_vector_type(2)));
typedef float f32x2n __attribute__((ext_vector_type(2)));
__device__ __forceinline__ unsigned pk2(float lo, float hi) { const f32x2n v = {lo, hi}; return __builtin_bit_cast(unsigned, __builtin_convertvector(v, bf16x2n)); }
constexpr float W_SCALE = 256.0f, XS_SCALE = 8.0f, ACT_SCALE = 4.0f, YB_SCALE = 16.0f;
__device__ __forceinline__ float clamp_fp8(float x) { return __builtin_amdgcn_fmed3f(x, -448.0f, 448.0f); }
__device__ __forceinline__ unsigned pk4_fp8(float a, float b, float c, float d) {
    int w = 0; w = __builtin_amdgcn_cvt_pk_fp8_f32(clamp_fp8(a), clamp_fp8(b), w, false); w = __builtin_amdgcn_cvt_pk_fp8_f32(clamp_fp8(c), clamp_fp8(d), w, true); return (unsigned)w; }
__device__ __forceinline__ unsigned pk4_fp8_nc(float a, float b, float c, float d) {
    int w = 0; w = __builtin_amdgcn_cvt_pk_fp8_f32(a, b, w, false); w = __builtin_amdgcn_cvt_pk_fp8_f32(c, d, w, true); return (unsigned)w; }
__device__ __forceinline__ float wave_sum(float v) {
#pragma unroll
    for (int o = 1; o < 64; o <<= 1) v += __shfl_xor(v, o);
    return v;
}
__device__ __forceinline__ float wave_max(float v) {
#pragma unroll
    for (int o = 1; o < 64; o <<= 1) v = fmaxf(v, __shfl_xor(v, o));
    return v;
}
__device__ __forceinline__ float sigmoidf_(float x) { return 1.0f / (1.0f + __expf(-x)); }
__device__ __forceinline__ float fast_sigmoid(float x) { return __builtin_amdgcn_rcpf(1.0f + __builtin_amdgcn_exp2f(-1.4426950408889634f * x)); }
__device__ __forceinline__ float fast_gelu_tanh(float x) { const float u2 = 1.5957691216057308f * (x + 0.044715f * x * x * x); return x * __builtin_amdgcn_rcpf(1.0f + __builtin_amdgcn_exp2f(-1.4426950408889634f * u2)); }
__device__ __forceinline__ float gelu_tanh(float x) { const float u = 0.7978845608028654f * (x + 0.044715f * x * x * x); return 0.5f * x * (1.0f + tanhf(u)); }
__device__ __forceinline__ int tok_row(int b, int t) { return t < NMETA ? METAROW0 + t : b * SEQ + (t - NMETA); }

__device__ __forceinline__ void transpose_item(const float* W, int K, int N, bf16* WT, LAS float* scr, int item, int lane, const float* kgain = nullptr, int kgain_n = 0) {
    const int nblk = N / 32, kb = item / nblk, nb = item % nblk, k0 = 64 * kb, n0 = 32 * nb;
    const int c = lane & 7;
    f32x4 g0 = (f32x4){1.f, 1.f, 1.f, 1.f}, g1 = g0;
    if (kgain != nullptr && k0 < kgain_n) { g0 = *(const f32x4*)(kgain + k0 + 8 * c); g1 = *(const f32x4*)(kgain + k0 + 8 * c + 4); }
#pragma unroll 8
    for (int i = 0; i < 32; ++i) { const int kk = 2 * i + (lane >> 5); scr[kk * 33 + (lane & 31)] = W[(size_t)(k0 + kk) * N + n0 + (lane & 31)]; }
    asm volatile("s_waitcnt lgkmcnt(0)" ::: "memory");
#pragma unroll
    for (int j = 0; j < 4; ++j) { const int n = (lane >> 3) + 8 * j; const LAS float* s = scr + (8 * c) * 33 + n;
        u32x4 o; o.x = pk2(s[0 * 33] * g0.x, s[1 * 33] * g0.y); o.y = pk2(s[2 * 33] * g0.z, s[3 * 33] * g0.w); o.z = pk2(s[4 * 33] * g1.x, s[5 * 33] * g1.y); o.w = pk2(s[6 * 33] * g1.z, s[7 * 33] * g1.w);
        *(u32x4*)(WT + (size_t)(n0 + n) * K + k0 + 8 * c) = o; }
    asm volatile("s_waitcnt lgkmcnt(0)" ::: "memory");
}

#define G1_CONV_WG 24
#define G1_CONV_PER_WG 43
constexpr int CONV_ALL_TILES = (2 + (BG_WDOWN ? 0 : 1)) * 32 * (D / 128) * (D / 256);
__device__ __forceinline__ int g1_conv_wg() { return gridDim.x == 256 ? G1_CONV_WG : 0; }
__device__ __forceinline__ int conv_pro_tiles() { return CONV_ALL_TILES - g1_conv_wg() * G1_CONV_PER_WG; }
__device__ __forceinline__ void conv_tiles(const Args& a, LAS unsigned char* lds, int tid, int first, int last, int stride) {
    unsigned char* ws = a.ws;
    __syncthreads();
    {
        LAS unsigned* T = (LAS unsigned*)lds;
        const int n4 = tid & 63, kq = tid >> 6;
        constexpr int T_IN = G1_FP8 ? (D / 128) * (DIN / 256) : 0, T_OUT = G2_FP8 ? (D / 128) * (D / 256) : 0, T_E = (D / 128) * (D / 256);
        constexpr int N_GATE = 32 * T_E, N_UP = (BG_WUP && !BG_EXP) ? 256 * 6 : 32 * T_E, N_DOWN = (BG_WDOWN && !BG_EXP) ? 0 : 32 * T_E;
        constexpr int NTILES = T_IN + T_OUT + N_GATE + N_UP + N_DOWN;
        static_assert(NTILES == CONV_ALL_TILES, "tile list size");
        auto tile_ptrs = [&](int tile, const float*& sp, unsigned char*& dp, int& ldn) {
            const float* sbase; unsigned char* dbase; int tl, nt;
            if (tile < T_IN) { sbase = a.in[I_W_IN]; dbase = ws + WS_WINT; tl = tile; nt = DIN / 256; ldn = DIN; }
            else if (tile < T_IN + T_OUT) { sbase = a.in[I_W_OUT]; dbase = ws + WS_WOUTT; tl = tile - T_IN; nt = D / 256; ldn = D; }
            else { int r = tile - T_IN - T_OUT, which, e; nt = D / 256; ldn = D;
                   if (r < N_GATE) { which = 0; e = r / T_E; tl = r % T_E; }
                   else if (r < N_GATE + N_UP) { r -= N_GATE; which = 1; int g = r; if (BG_WUP && !BG_EXP) g = 16 * (r / 6) + 10 + (r % 6);
                                                 e = g / T_E; tl = g % T_E; }
                   else { r -= N_GATE + N_UP; which = 2; e = r / T_E; tl = r % T_E; }
                   sbase = a.in[which == 0 ? I_W_GATE : (which == 1 ? I_W_UP : I_W_DOWN)] + (size_t)e * D * D; dbase = ws + (which == 0 ? WS_WGT : (which == 1 ? WS_WUT : WS_WDT)) + (size_t)e * D * D; }
            const int k0 = (tl / nt) * 128, n0 = (tl % nt) * 256;
            sp = sbase + (size_t)(k0 + 4 * kq) * ldn + n0 + 4 * n4; dp = dbase + (size_t)n0 * D + k0; };
#define CONV_LOAD(R, tile) do { const float* _p; unsigned char* _d; int _ld; tile_ptrs(tile, _p, _d, _ld); _Pragma("unroll") for (int i = 0; i < 4; ++i) _Pragma("unroll") for (int q = 0; q < 4; ++q) \
            R[i][q] = __builtin_nontemporal_load((const f32x4*)(_p + (size_t)(32 * i + q) * _ld)); } while (0)
#define CONV_STORE(R, tile) do { _Pragma("unroll") for (int i = 0; i < 4; ++i) { const int kd = kq + 8 * i; \
            T[(4 * n4 + 0) * 33 + kd] = pk4_fp8(R[i][0].x * W_SCALE, R[i][1].x * W_SCALE, R[i][2].x * W_SCALE, R[i][3].x * W_SCALE); \
            T[(4 * n4 + 1) * 33 + kd] = pk4_fp8(R[i][0].y * W_SCALE, R[i][1].y * W_SCALE, R[i][2].y * W_SCALE, R[i][3].y * W_SCALE); \
            T[(4 * n4 + 2) * 33 + kd] = pk4_fp8(R[i][0].z * W_SCALE, R[i][1].z * W_SCALE, R[i][2].z * W_SCALE, R[i][3].z * W_SCALE); \
            T[(4 * n4 + 3) * 33 + kd] = pk4_fp8(R[i][0].w * W_SCALE, R[i][1].w * W_SCALE, R[i][2].w * W_SCALE, R[i][3].w * W_SCALE); } \
            __syncthreads(); \
            { const float* _p; unsigned char* _d; int _ld; tile_ptrs(tile, _p, _d, _ld); _Pragma("unroll") for (int i = 0; i < 4; ++i) { const int n = (tid >> 3) + 64 * i, c = tid & 7; \
                const u32x4 o = (u32x4){T[n * 33 + 4 * c], T[n * 33 + 4 * c + 1], T[n * 33 + 4 * c + 2], T[n * 33 + 4 * c + 3]}; \
                *(u32x4*)(_d + (size_t)n * D + 16 * c) = o; } } \
            __syncthreads(); } while (0)
        f32x4 RA[4][4], RB[4][4];
        int tile = first;
        if (tile < last) CONV_LOAD(RA, tile);
        while (tile < last) {
            int nxt = tile + stride;
            if (nxt < last) CONV_LOAD(RB, nxt);
            CONV_STORE(RA, tile);
            tile = nxt; if (tile >= last) break;
            nxt = tile + stride;
            if (nxt < last) CONV_LOAD(RA, nxt);
            CONV_STORE(RB, tile);
            tile = nxt;
        }
#undef CONV_LOAD
#undef CONV_STORE
    }
}
__device__ __forceinline__ void phase_prologue(const Args& a, LAS unsigned char* lds, int tid, int lane, int wave) {
    const int gw = blockIdx.x * 8 + wave, NGW = gridDim.x * 8;
    const int gt = blockIdx.x * 512 + tid, NGT = gridDim.x * 512;
    unsigned char* ws = a.ws;
    LAS float* scr = (LAS float*)(lds + wave * 8704);
    {
        constexpr int IT_IN = G1_FP8 ? 0 : 32 * (DIN / 32), IT_OUT = G2_FP8 ? 0 : 32 * (D / 32);
        for (int it = gw; it < IT_IN + IT_OUT; it += NGW) {
            if (it < IT_IN) transpose_item(a.in[I_W_IN], D, DIN, (bf16*)(ws + WS_WINT), scr, it, lane, a.in[I_NORM_MIX], D);
            else transpose_item(a.in[I_W_OUT], D, D, (bf16*)(ws + WS_WOUTT), scr, it - IT_IN, lane, a.in[I_G_ATTN], 1024);
        }
        __syncthreads();
    }
    conv_tiles(a, lds, tid, blockIdx.x, conv_pro_tiles(), gridDim.x);
    static_assert(!G1_FP8, "xb is written as bf16");
    for (int r = gw; r < MROWS; r += NGW) {
        u32x4* orow = (u32x4*)((bf16*)(ws + WS_N1) + (size_t)r * D);
        if (r >= MVALID) {
#pragma unroll
            for (int j = 0; j < 4; ++j) orow[lane + 64 * j] = (u32x4){0u, 0u, 0u, 0u};
            if (lane == 0) ((float*)(ws + WS_RSTD1))[r] = 0.f;
            continue; }
        const f32x4* xr = (const f32x4*)(r < MREAL ? a.in[I_X] + (size_t)r * D : a.in[I_META] + (size_t)(r - MREAL) * D);
        f32x4 v[4][2]; float ss = 0.f;
#pragma unroll
        for (int j = 0; j < 4; ++j)
#pragma unroll
            for (int q = 0; q < 2; ++q) { v[j][q] = xr[2 * (lane + 64 * j) + q]; ss += (v[j][q].x * v[j][q].x + v[j][q].y * v[j][q].y) + (v[j][q].z * v[j][q].z + v[j][q].w * v[j][q].w); }
#pragma unroll
        for (int j = 0; j < 4; ++j) orow[lane + 64 * j] = (u32x4){pk2(v[j][0].x, v[j][0].y), pk2(v[j][0].z, v[j][0].w), pk2(v[j][1].x, v[j][1].y), pk2(v[j][1].z, v[j][1].w)};
        ss = wave_sum(ss);
        if (lane == 0) ((float*)(ws + WS_RSTD1))[r] = 1.0f / sqrtf(ss * (1.0f / D) + EPS);
    }
    float* cosT = (float*)(ws + WS_COS); float* sinT = (float*)(ws + WS_SIN);
    for (int i = gt; i < TT * 32; i += NGT) {
        const int pos = i >> 5, j = i & 31;
        const float ang = (float)pos * c_inv_freq[j];
        const double t = (double)ang * 0.15915494309189535; const float fr = (float)(t - floor(t));
        cosT[i] = __builtin_amdgcn_cosf(fr); sinT[i] = __builtin_amdgcn_sinf(fr);
    }
    { bf16* WaT = (bf16*)(ws + WS_WAT); bf16* WiT = (bf16*)(ws + WS_WIT);
      for (int i = gt; i < 16 * 64 * 64; i += NGT) { const int n = i >> 12, d = (i >> 6) & 63, cc = i & 63;
          WaT[i] = (bf16)f2bf(a.in[I_W_A][(n * 64 + cc) * 64 + d]); WiT[i] = (bf16)f2bf(a.in[I_W_I][(n * 64 + cc) * 64 + d]); } }
    { bf16* WRT = (bf16*)(ws + WS_WRT);
      for (int i = gt; i < NEXP * D; i += NGT) { const int e = i >> 11, k = i & 2047; WRT[i] = (bf16)f2bf(a.in[I_NORM_FFN][k] * a.in[I_W_ROUTER][k * NEXP + e]); } }
    int* rowpair = (int*)(ws + WS_ROWPAIR);
    for (int i = gt; i < PROWS; i += NGT) rowpair[i] = -1;
}

namespace pg8 {
constexpr int BM = 256, BK = 64, HALF = 128, HTB = HALF * BK * 2, STAGE_BYTES = 8 * HTB, NXCD = 8, WGM = 8, KD = 2048, NKT = KD / BK;
__host__ __device__ __forceinline__ int lds_byte(int r, int c) { const int st = (r >> 4) * 2 + (c >> 5), rr = r & 15, cc = c & 31, ob = rr * 64 + cc * 2; return st * 1024 + (ob ^ (((ob >> 9) & 1) << 5)); }
__host__ __device__ __forceinline__ void stage_rc(int b, int& R, int& C) { const int st = b / 1024, sb = b % 1024, swz = sb ^ (((sb >> 9) & 1) << 5); R = (st >> 1) * 16 + swz / 64; C = (st & 1) * 32 + (swz % 64) / 2; }
__host__ __device__ __forceinline__ int perm32(int rho) { const int n = rho >> 4, i = rho & 15; return 8 * (i >> 2) + 4 * n + (i & 3); }
struct Unit { unsigned a, b0, b1; int pm, pn, e; };
__device__ __forceinline__ bool static_tile(int i, int G, int c, int nM, int nN, int& pm, int& pn) {
    const int nwg = nM * nN; const long L = (long)i * G + c; if (L >= nwg) return false;
    int wgid = (int)L; { const int q = nwg >> 3, r = nwg & 7, xcd = wgid & 7, off = wgid >> 3; wgid = (xcd < r ? xcd * (q + 1) : r * (q + 1) + (xcd - r) * q) + off; }
    const int nig = WGM * nN; int gid, rem;
    if ((nN & (nN - 1)) == 0) { const int sh = 3 + (31 - __builtin_clz(nN)); gid = wgid >> sh; rem = wgid & (nig - 1); } else { gid = wgid / nig; rem = wgid - gid * nig; }
    const int fm = gid * WGM, gsz = (nM - fm) < WGM ? (nM - fm) : WGM;
    if (gsz == WGM) { pm = fm + (rem & 7); pn = rem >> 3; } else { pm = fm + rem % gsz; pn = rem / gsz; }
    return true;
}

typedef int i32x8 __attribute__((ext_vector_type(8)));
typedef int i32x4 __attribute__((ext_vector_type(4)));
__device__ __forceinline__ i32x8 cat8(bf16x8 lo, bf16x8 hi) { const i32x4 a = __builtin_bit_cast(i32x4, lo), b = __builtin_bit_cast(i32x4, hi); return __builtin_shufflevector(a, b, 0, 1, 2, 3, 4, 5, 6, 7); }
struct BGNone { static constexpr bool ON = false; };
struct BGConv { static constexpr bool ON = true; const char* src; unsigned char* dst; int next, end; unsigned char* dummy; };
__device__ __forceinline__ void bg_pair_ptrs(const BGConv& bg, int pair, const char*& sp, unsigned char*& dp) {
    const int e = pair >> 10, kbp = (pair >> 6) & 15, nb = pair & 63;
    sp = bg.src + ((size_t)(e * 2048 + 128 * kbp) * 2048 + 32 * nb) * 4; dp = bg.dst + (size_t)e * 2048 * 2048 + (size_t)(32 * nb) * 2048 + 128 * kbp; }
template <bool FP8, class Epi, class Sched, class BG, bool GATHER = false>
__device__ __forceinline__ void gemm_phase(LAS unsigned char* lds, const Sched& S, const Epi& E, BG& bg) {
    constexpr int ROWB = FP8 ? 2048 : 4096, NKTL = ROWB / 128;
    const int tid = threadIdx.x, wid = __builtin_amdgcn_readfirstlane(tid >> 6), lane = tid & 63, wr = wid >> 2, wc = wid & 3, fr = lane & 15, fq = lane >> 4;
    unsigned voffA[2], voffB[2];
#pragma unroll
    for (int i = 0; i < 2; ++i) { int R, C; stage_rc(tid * 16 + i * 8192, R, C); const int Rb = Epi::PERM ? ((R & ~31) + perm32(R & 31)) : R;
        voffA[i] = (unsigned)(R * ROWB + C * 2); voffB[i] = (unsigned)(Rb * ROWB + C * 2); }
    constexpr unsigned KS = BK * 2, HS = HALF * ROWB;
    const unsigned ldsw = (unsigned)wid * 1024u;
    const __amdgpu_buffer_rsrc_t rsA = __builtin_amdgcn_make_buffer_rsrc((void*)S.A, 0, 0x7ffffff0, 0x00020000), rsB0 = __builtin_amdgcn_make_buffer_rsrc((void*)S.B0, 0, 0x7ffffff0, 0x00020000), rsB1 = __builtin_amdgcn_make_buffer_rsrc((void*)S.B1, 0, 0x7ffffff0, 0x00020000);
    const int aoff = lds_byte(wr * 64 + fr, fq * 8), boff = lds_byte(wc * 32 + fr, fq * 8);
#define PG8_SA(b, h) (((b) * 2 + (h)) * HTB)
#define PG8_SB(b, h) ((4 + (b) * 2 + (h)) * HTB)
#define PG8_STAGE(bufoff, rs, soff, voff) do { _Pragma("unroll") for (int _i = 0; _i < 2; ++_i) \
        __builtin_amdgcn_raw_ptr_buffer_load_lds(rs, (LAS void*)(lds + (bufoff) + ldsw + _i * 8192), 16, (int)(voff)[_i], (int)(soff), 0, 0); } while (0)
    unsigned gA[2][2] = {{0u, 0u}, {0u, 0u}}, gN[2][2] = {{0u, 0u}, {0u, 0u}};
#define PG8_GOFF(dst, slot) do { int tz_ = threadIdx.x; asm volatile("" : "+v"(tz_)); _Pragma("unroll") for (int _i = 0; _i < 2; ++_i) { int R_, C_; stage_rc(tz_ * 16 + _i * 8192, R_, C_); \
        _Pragma("unroll") for (int _h = 0; _h < 2; ++_h) { const int id_ = *(const LAS int*)(lds + LDS_RID + (slot) * 1024 + (_h * 128 + R_) * 4); dst[_h][_i] = (unsigned)((id_ < 0 ? 0 : (id_ >> 2)) * ROWB + C_ * 2); } } } while (0)
#define PG8_STAGEA(bufoff, h, soff_dense, koff, nx) do { if constexpr (GATHER) { unsigned v_[2]; v_[0] = (nx) ? gN[h][0] : gA[h][0]; v_[1] = (nx) ? gN[h][1] : gA[h][1]; PG8_STAGE(bufoff, rsA, koff, v_); } \
        else PG8_STAGE(bufoff, rsA, (soff_dense) + (h) * HS, voffA); } while (0)
#define PG8_LDA(dst, b, h) do { _Pragma("unroll") for (int m = 0; m < 4; ++m) { \
        if constexpr (FP8) dst##8[m] = __builtin_shufflevector(*(const LAS i32x4*)(lds + PG8_SA(b, h) + aoff + m * 2048), *(const LAS i32x4*)(lds + PG8_SA(b, h) + aoff + m * 2048 + 1024), 0, 1, 2, 3, 4, 5, 6, 7); \
        else { _Pragma("unroll") for (int k = 0; k < 2; ++k) dst[m][k] = *(const LAS bf16x8*)(lds + PG8_SA(b, h) + aoff + m * 2048 + k * 1024); } } } while (0)
#define PG8_LDB(dst, b, h) do { _Pragma("unroll") for (int n = 0; n < 2; ++n) { \
        if constexpr (FP8) dst##8[n] = __builtin_shufflevector(*(const LAS i32x4*)(lds + PG8_SB(b, h) + boff + n * 2048), *(const LAS i32x4*)(lds + PG8_SB(b, h) + boff + n * 2048 + 1024), 0, 1, 2, 3, 4, 5, 6, 7); \
        else { _Pragma("unroll") for (int k = 0; k < 2; ++k) dst[n][k] = *(const LAS bf16x8*)(lds + PG8_SB(b, h) + boff + n * 2048 + k * 1024); } } } while (0)
#define PG8_MMA(ai, bj, At, Bt) do { _Pragma("unroll") for (int m = 0; m < 4; ++m) _Pragma("unroll") for (int n = 0; n < 2; ++n) { \
        if constexpr (FP8) asm volatile("v_mfma_f32_16x16x128_f8f6f4 %0, %1, %2, %0" : "+v"(acc[ai][bj][m][n]) : "v"(Bt##8[n]), "v"(At##8[m])); \
        else { _Pragma("unroll") for (int k = 0; k < 2; ++k) asm volatile("v_mfma_f32_16x16x32_bf16 %0, %1, %2, %0" : "+v"(acc[ai][bj][m][n]) : "v"(Bt[n][k]), "v"(At[m][k])); } } \
        } while (0)
#define PG8_WAIT_V(n) asm volatile("s_waitcnt vmcnt(" #n ")" ::: "memory")
#define PG8_WAIT_L(n) asm volatile("s_waitcnt lgkmcnt(" #n ")" ::: "memory")
#define PG8_BAR __builtin_amdgcn_s_barrier()
#define PG8_SCHED __builtin_amdgcn_sched_barrier(0)
    Unit cur, nxt; int ui = 0; bool bg_pending = false;
    if (!S.next(0, cur)) return;
    f32x4 acc[2][2][4][2];
#pragma unroll
    for (int a = 0; a < 2; ++a)
#pragma unroll
        for (int b = 0; b < 2; ++b)
#pragma unroll
            for (int m = 0; m < 4; ++m)
#pragma unroll
                for (int n = 0; n < 2; ++n) acc[a][b][m][n] = (f32x4){0.f, 0.f, 0.f, 0.f};
    bf16x8 At[4][2], B0[2][2], B1[2][2];
    i32x8 At8[4], B08[2], B18[2];
    if constexpr (GATHER) {
        if (tid < 256) *(LAS int*)(lds + LDS_RID + tid * 4) = S.rows[cur.pm * BM + tid];
        __syncthreads();
        PG8_GOFF(gA, 0);
    }
    PG8_STAGE(PG8_SB(0, 0), rsB0, cur.b0, voffB); PG8_STAGE(PG8_SB(0, 1), rsB1, cur.b1, voffB); PG8_STAGEA(PG8_SA(0, 0), 0, cur.a, 0u, false); PG8_STAGEA(PG8_SA(0, 1), 1, cur.a, 0u, false);
    if (wr == 1) PG8_BAR;
    PG8_WAIT_V(2); PG8_BAR;
    PG8_STAGE(PG8_SB(1, 0), rsB0, cur.b0 + KS, voffB); PG8_STAGEA(PG8_SA(1, 0), 0, cur.a + KS, KS, false); PG8_STAGE(PG8_SB(1, 1), rsB1, cur.b1 + KS, voffB);
    PG8_WAIT_V(6); PG8_BAR;
    for (;;) {
        const bool has_next = S.next(ui + 1, nxt);
        const unsigned nA = has_next ? nxt.a : cur.a, nB0 = has_next ? nxt.b0 : cur.b0, nB1 = has_next ? nxt.b1 : cur.b1;
        for (int t = 0; t < NKTL; t += 2) {
            const bool last = (t == NKTL - 2);
            if constexpr (Epi::MIDK_T >= 0) { if (t == Epi::MIDK_T) {
                PG8_SCHED; asm volatile("s_nop 15\n\ts_nop 15" ::: "memory"); PG8_SCHED; E.midk(acc, cur, wr, fr, lds); PG8_SCHED; asm volatile("s_nop 15" ::: "memory"); PG8_SCHED; } }
            const unsigned a1 = cur.a + (unsigned)(t + 1) * KS;
            const unsigned a2 = last ? nA : cur.a + (unsigned)(t + 2) * KS;
            const unsigned b20 = last ? nB0 : cur.b0 + (unsigned)(t + 2) * KS, b21 = last ? nB1 : cur.b1 + (unsigned)(t + 2) * KS;
            const unsigned a3 = a2 + KS, b30 = b20 + KS, b31 = b21 + KS;
            const unsigned k1 = (unsigned)(t + 1) * KS, k2 = last ? 0u : (unsigned)(t + 2) * KS;
            if constexpr (GATHER) { if (last) { if (has_next) PG8_GOFF(gN, (ui + 1) & 1); else { gN[0][0] = gA[0][0]; gN[0][1] = gA[0][1]; gN[1][0] = gA[1][0]; gN[1][1] = gA[1][1]; } } }
            PG8_LDB(B0, 0, 0); PG8_LDB(B1, 0, 1); PG8_SCHED; PG8_LDA(At, 0, 0); PG8_STAGEA(PG8_SA(1, 1), 1, a1, k1, false);
            if constexpr (GATHER) { if (t == 2 && has_next && wid == 3) __builtin_amdgcn_global_load_lds((const unsigned*)(S.rows + nxt.pm * BM + lane * 4), (LAS unsigned*)(lds + LDS_RID + ((ui + 1) & 1) * 1024), 16, 0, 0); }
            if (t == 2) E.prefetch(cur, lds, wid, lane);
            PG8_WAIT_V(8); PG8_WAIT_L(0); PG8_BAR; PG8_MMA(0, 0, At, B0);
            if constexpr (BG::ON) {
                PG8_SCHED;
                int tz = threadIdx.x; asm volatile("" : "+v"(tz));
#pragma unroll
                for (int j = 0; j < (BG_EXP == 1 ? 0 : 2); ++j) { const LAS float* p = (const LAS float*)(lds + LDS_BG + j * 8192 + (tz >> 5) * 512 + (tz & 31) * 4);
                    ((LAS unsigned*)(lds + LDS_T2))[(tz & 31) * 33 + 16 * j + (tz >> 5)] = pk4_fp8(p[0] * W_SCALE, p[32] * W_SCALE, p[64] * W_SCALE, p[96] * W_SCALE); }
                const char* bgs; { unsigned char* dp_; pg8::bg_pair_ptrs(bg, bg.next < bg.end ? bg.next : bg.end - 1, bgs, dp_); }
                PG8_SCHED;
                if (BG_EXP != 2) {
                const unsigned bgv = (unsigned)((8 * wid + ((tz & 63) >> 3)) * 8192 + (tz & 7) * 16);
                __builtin_amdgcn_global_load_lds((const unsigned*)(bgs + bgv), (LAS unsigned*)(lds + LDS_BG + ldsw), 16, 0, 0);
                __builtin_amdgcn_global_load_lds((const unsigned*)(bgs + 524288 + bgv), (LAS unsigned*)(lds + LDS_BG + 8192 + ldsw), 16, 0, 0); }
                PG8_SCHED; }
            PG8_MMA(0, 1, At, B1);
            if constexpr (BG::ON) { PG8_WAIT_L(0); }
            PG8_BAR; PG8_SCHED;
            PG8_LDA(At, 0, 1); PG8_STAGE(PG8_SB(0, 0), rsB0, b20, voffB); PG8_STAGE(PG8_SB(0, 1), rsB1, b21, voffB); PG8_STAGEA(PG8_SA(0, 0), 0, a2, k2, last);
            if constexpr (BG::ON) { if (BG_EXP == 2) PG8_WAIT_V(8); else PG8_WAIT_V(10); } else { PG8_WAIT_V(8); }
            PG8_WAIT_L(0); PG8_BAR; PG8_MMA(1, 0, At, B0);
            if constexpr (BG::ON) {
                PG8_SCHED;
                unsigned char* bgd; { const char* sp_; pg8::bg_pair_ptrs(bg, bg.next - 1 < bg.end ? bg.next - 1 : bg.end - 1, sp_, bgd); }
                int tz = threadIdx.x; asm volatile("" : "+v"(tz));
                const LAS unsigned* q = (const LAS unsigned*)(lds + LDS_T2) + (tz >> 4) * 33 + 2 * (tz & 15);
                const u32x2 w = (u32x2){q[0], q[1]};
                if (BG_EXP != 1) *(u32x2*)((bg_pending && !BG_EXP) ? bgd + (size_t)(tz >> 4) * 2048 + 8 * (tz & 15) : bg.dummy + 8 * tz) = w;
                ++bg.next; bg_pending = true;
                PG8_SCHED; }
            PG8_MMA(1, 1, At, B1); PG8_BAR; PG8_SCHED;
            PG8_LDB(B0, 1, 0); PG8_LDB(B1, 1, 1); PG8_SCHED; PG8_LDA(At, 1, 0); PG8_STAGEA(PG8_SA(0, 1), 1, a2, k2, last);
            if constexpr (BG::ON) { if (BG_EXP == 1) PG8_WAIT_V(10); else if (BG_EXP == 2) PG8_WAIT_V(9); else PG8_WAIT_V(11); } else { PG8_WAIT_V(8); }
            PG8_WAIT_L(0); PG8_BAR; PG8_MMA(0, 0, At, B0); PG8_MMA(0, 1, At, B1); PG8_BAR; PG8_SCHED;
            PG8_LDA(At, 1, 1); PG8_STAGE(PG8_SB(1, 0), rsB0, b30, voffB); PG8_STAGE(PG8_SB(1, 1), rsB1, b31, voffB); PG8_STAGEA(PG8_SA(1, 0), 0, a3, k2 + KS, last);
            if constexpr (BG::ON) { if (BG_EXP == 1) PG8_WAIT_V(8); else PG8_WAIT_V(9); } else { PG8_WAIT_V(8); }
            PG8_WAIT_L(0); PG8_BAR; PG8_MMA(1, 0, At, B0); PG8_MMA(1, 1, At, B1); PG8_BAR; PG8_SCHED;
        }
        if (wr == 0) PG8_BAR;
        asm volatile("s_nop 15\n\ts_nop 15" ::: "memory");
        E(acc, cur, wr, wc, fr, fq, lds);
        if (!has_next) break;
#pragma unroll
        for (int a = 0; a < 2; ++a)
#pragma unroll
            for (int b = 0; b < 2; ++b)
#pragma unroll
                for (int m = 0; m < 4; ++m)
#pragma unroll
                    for (int n = 0; n < 2; ++n) acc[a][b][m][n] = (f32x4){0.f, 0.f, 0.f, 0.f};
        cur = nxt; ++ui;
        if constexpr (GATHER) { gA[0][0] = gN[0][0]; gA[0][1] = gN[0][1]; gA[1][0] = gN[1][0]; gA[1][1] = gN[1][1]; }
        if (wr == 1) PG8_BAR;
    }
    PG8_WAIT_V(0);
    PG8_BAR;
    if constexpr (BG::ON) { if (bg_pending && !BG_EXP) {
        unsigned char* bgd; { const char* sp_; pg8::bg_pair_ptrs(bg, bg.next - 1 < bg.end ? bg.next - 1 : bg.end - 1, sp_, bgd); }
#pragma unroll
        for (int j = 0; j < 2; ++j) { const LAS float* p = (const LAS float*)(lds + LDS_BG + j * 8192 + (tid >> 5) * 512 + (tid & 31) * 4);
            ((LAS unsigned*)(lds + LDS_T2))[(tid & 31) * 33 + 16 * j + (tid >> 5)] = pk4_fp8(p[0] * W_SCALE, p[32] * W_SCALE, p[64] * W_SCALE, p[96] * W_SCALE); }
        __syncthreads();
        const LAS unsigned* q = (const LAS unsigned*)(lds + LDS_T2) + (tid >> 4) * 33 + 2 * (tid & 15);
        *(u32x2*)(bgd + (size_t)(tid >> 4) * 2048 + 8 * (tid & 15)) = (u32x2){q[0], q[1]}; } }
#undef PG8_SA
#undef PG8_SB
#undef PG8_STAGE
#undef PG8_STAGEA
#undef PG8_GOFF
#undef PG8_LDA
#undef PG8_LDB
#undef PG8_MMA
#undef PG8_WAIT_V
#undef PG8_WAIT_L
#undef PG8_BAR
#undef PG8_SCHED
}

struct SchedDense {
    const char* A; const char* B0; const char* B1; const int* rows; int nM, nN, G, c, rowb;
    __device__ __forceinline__ bool next(int i, Unit& u) const {
        int pm, pn; if (!static_tile(i, G, c, nM, nN, pm, pn)) return false;
        u.pm = pm; u.pn = pn; u.e = 0; u.a = (unsigned)pm * BM * rowb; u.b0 = (unsigned)pn * BM * rowb; u.b1 = u.b0 + (unsigned)HALF * rowb; return true;
    }
};
struct SchedMoE {
    const char* A; const char* B0; const char* B1; const int* rows; const LAS int* tstart; int nM, nN, G, c; bool split;
    __device__ __forceinline__ bool next(int i, Unit& u) const {
        int pm, pn; if (!static_tile(i, G, c, nM, nN, pm, pn)) return false;
        const int e = ((const LAS unsigned char*)(tstart + 64))[pm];
        u.pm = pm; u.pn = pn; u.e = e; u.a = (unsigned)pm * (BM * 2048);
        const unsigned eoff = (unsigned)e * (2048u * 2048u);
        if (split) { u.b0 = eoff + (unsigned)pn * (HALF * 2048); u.b1 = u.b0; }
        else { u.b0 = eoff + (unsigned)pn * (BM * 2048); u.b1 = u.b0 + (unsigned)HALF * 2048; }
        return true;
    }
};

__device__ __forceinline__ u32x4 widen16(u32x2 x, u32x2 y) {
    const auto r0 = __builtin_amdgcn_permlane16_swap(x.x, y.x, false, false), r1 = __builtin_amdgcn_permlane16_swap(x.y, y.y, false, false);
    return (u32x4){r0[0], r1[0], r0[1], r1[1]};
}
struct EpiZ {
    static constexpr bool PERM = true; static constexpr int MIDK_T = -1;
    bf16* Z; const float* bias; const float* rstd1;
    __device__ __forceinline__ void prefetch(const Unit& u, LAS unsigned char* lds, int wid, int lane) const {
        if (wid == 0) __builtin_amdgcn_global_load_lds((const unsigned*)(rstd1 + u.pm * BM + lane * 4), (LAS unsigned*)(lds + LDS_META), 16, 0, 0);
    }
    __device__ __forceinline__ void operator()(const f32x4 (&acc)[2][2][4][2], const Unit& u, int wr, int wc, int fr, int fq, const LAS unsigned char* lds) const {
        const int row0 = u.pm * BM + wr * 64 + fr, col0 = u.pn * BM + wc * 32 + 8 * fq;
        f32x4 bv[2][2];
#pragma unroll
        for (int bj = 0; bj < 2; ++bj)
#pragma unroll
            for (int n = 0; n < 2; ++n) bv[bj][n] = *(const f32x4*)(bias + col0 + bj * HALF + 4 * n);
#pragma unroll
        for (int ai = 0; ai < 2; ++ai)
#pragma unroll
            for (int m = 0; m < 4; ++m) { bf16* rowp = Z + (size_t)(row0 + ai * HALF + m * 16) * DIN + col0;
                const float sc = ((const LAS float*)(lds + LDS_META))[ai * HALF + wr * 64 + m * 16 + fr];
#pragma unroll
                for (int bj = 0; bj < 2; ++bj) { const f32x4 v0 = acc[ai][bj][m][0] * sc + bv[bj][0], v1 = acc[ai][bj][m][1] * sc + bv[bj][1];
                    u32x4 w; w.x = pk2(v0[0], v0[1]); w.y = pk2(v0[2], v0[3]); w.z = pk2(v1[0], v1[1]); w.w = pk2(v1[2], v1[3]);
                    *(u32x4*)(rowp + bj * HALF) = w; } }
    }
};
struct EpiH1 {
    static constexpr bool PERM = true;
    static constexpr int MIDK_T = 16;
    bf16* H1; const bf16* x; const float* bias; float sc; const float* ssq;
    __device__ __forceinline__ void prefetch(const Unit& u, LAS unsigned char* lds, int wid, int lane) const {
        if (wid < 4) __builtin_amdgcn_global_load_lds((const unsigned*)(ssq + (size_t)(u.pm * BM + wid * 64 + lane) * 4), (LAS unsigned*)(lds + LDS_META + wid * 1024), 16, 0, 0);
    }
    __device__ __forceinline__ void midk(f32x4 (&acc)[2][2][4][2], const Unit& u, int wr, int fr, const LAS unsigned char* lds) const {
        f32x4 s[2][4];
#pragma unroll
        for (int ai = 0; ai < 2; ++ai)
#pragma unroll
            for (int m = 0; m < 4; ++m) s[ai][m] = *(const LAS f32x4*)(lds + LDS_META + (ai * HALF + wr * 64 + m * 16 + fr) * 16);
#pragma unroll
        for (int ai = 0; ai < 2; ++ai)
#pragma unroll
            for (int m = 0; m < 4; ++m) { const float r = __builtin_amdgcn_rsqf(((s[ai][m].x + s[ai][m].y) + (s[ai][m].z + s[ai][m].w)) * (1.0f / 1024.0f) + EPS);
#pragma unroll
                for (int bj = 0; bj < 2; ++bj)
#pragma unroll
                    for (int n = 0; n < 2; ++n) acc[ai][bj][m][n] = acc[ai][bj][m][n] * r; }
    }
    __device__ __forceinline__ void operator()(const f32x4 (&acc)[2][2][4][2], const Unit& u, int wr, int wc, int fr, int fq, const LAS unsigned char*) const {
        const int row0 = u.pm * BM + wr * 64 + fr, col0 = u.pn * BM + wc * 32 + 8 * fq;
        f32x4 bv[2][2];
#pragma unroll
        for (int bj = 0; bj < 2; ++bj)
#pragma unroll
            for (int n = 0; n < 2; ++n) bv[bj][n] = *(const f32x4*)(bias + col0 + bj * HALF + 4 * n);
#pragma unroll
        for (int ai = 0; ai < 2; ++ai) {
            u32x4 xv[4][2];
#pragma unroll
            for (int m = 0; m < 4; ++m) { const size_t ro = (size_t)(row0 + ai * HALF + m * 16) * D + col0;
#pragma unroll
                for (int bj = 0; bj < 2; ++bj) xv[m][bj] = __builtin_nontemporal_load((const u32x4*)(x + ro + bj * HALF)); }
#pragma unroll
            for (int m = 0; m < 4; ++m) { const size_t ro = (size_t)(row0 + ai * HALF + m * 16) * D + col0;
#pragma unroll
                for (int bj = 0; bj < 2; ++bj) { const u32x4 xx = xv[m][bj];
                    const f32x4 v0 = (f32x4){bflo(xx[0]), bfhi(xx[0]), bflo(xx[1]), bfhi(xx[1])} + acc[ai][bj][m][0] * sc + bv[bj][0], v1 = (f32x4){bflo(xx[2]), bfhi(xx[2]), bflo(xx[3]), bfhi(xx[3])} + acc[ai][bj][m][1] * sc + bv[bj][1];
                    u32x4 w; w.x = pk2(v0[0], v0[1]); w.y = pk2(v0[2], v0[3]); w.z = pk2(v1[0], v1[1]); w.w = pk2(v1[2], v1[3]);
                    *(u32x4*)(H1 + ro + bj * HALF) = w; } }
        }
    }
};
struct EpiAct {
    static constexpr bool PERM = true; static constexpr int MIDK_T = -1;
    unsigned char* ACT; const float* bg; const float* bu;
    __device__ __forceinline__ void prefetch(const Unit& u, LAS unsigned char* lds, int wid, int lane) const {
        if (wid == 0) { const float* p = (lane < 32 ? bg : bu) + (size_t)u.e * DFF + u.pn * HALF + (lane & 31) * 4;
            __builtin_amdgcn_global_load_lds((const unsigned*)p, (LAS unsigned*)(lds + LDS_META), 16, 0, 0); }
    }
    __device__ __forceinline__ void operator()(const f32x4 (&acc)[2][2][4][2], const Unit& u, int wr, int wc, int fr, int fq, const LAS unsigned char* lds) const {
        const int row0 = u.pm * BM + wr * 64 + fr, cl = wc * 32 + 8 * fq, col0 = u.pn * HALF + cl;
        f32x4 gv[2], uv[2];
#pragma unroll
        for (int n = 0; n < 2; ++n) { gv[n] = *(const LAS f32x4*)(lds + LDS_META + (cl + 4 * n) * 4); uv[n] = *(const LAS f32x4*)(lds + LDS_META + 512 + (cl + 4 * n) * 4); }
#pragma unroll
        for (int ai = 0; ai < 2; ++ai)
#pragma unroll
            for (int mp = 0; mp < 2; ++mp) { u32x2 pc[2];
#pragma unroll
                for (int mi = 0; mi < 2; ++mi) { const int m = 2 * mp + mi; float r[8];
#pragma unroll
                    for (int n = 0; n < 2; ++n)
#pragma unroll
                        for (int j = 0; j < 4; ++j) { float g = acc[ai][0][m][n][j] * (1.0f / (W_SCALE * XS_SCALE)) + gv[n][j], up = acc[ai][1][m][n][j] * (1.0f / (W_SCALE * XS_SCALE)) + uv[n][j];
                            g = fminf(g, 7.0f); up = fminf(fmaxf(up, -7.0f), 7.0f);
                            r[n * 4 + j] = g * __builtin_amdgcn_rcpf(1.0f + __builtin_amdgcn_exp2f((-1.702f * 1.4426950408889634f) * g)) * fmaf(up, ACT_SCALE, ACT_SCALE); }
                    pc[mi] = (u32x2){pk4_fp8_nc(r[0], r[1], r[2], r[3]), pk4_fp8_nc(r[4], r[5], r[6], r[7])}; }
                const u32x4 w = widen16(pc[0], pc[1]);
                const int m = 2 * mp + (fq & 1);
                *(u32x4*)(ACT + (size_t)(row0 + ai * HALF + m * 16) * DFF + col0 - 8 * (fq & 1)) = w; }
    }
};
struct EpiDown {
    static constexpr bool PERM = true; static constexpr int MIDK_T = -1;
    unsigned char* YB; const float* bd;
    __device__ __forceinline__ void prefetch(const Unit& u, LAS unsigned char* lds, int wid, int lane) const {
        if (wid == 0) __builtin_amdgcn_global_load_lds((const unsigned*)(bd + (size_t)u.e * D + u.pn * BM + lane * 4), (LAS unsigned*)(lds + LDS_META), 16, 0, 0);
    }
    __device__ __forceinline__ void operator()(const f32x4 (&acc)[2][2][4][2], const Unit& u, int wr, int wc, int fr, int fq, const LAS unsigned char* lds) const {
        const int row0 = u.pm * BM + wr * 64 + fr, cl = wc * 32 + 8 * fq, col0 = u.pn * BM + cl;
        f32x4 bv[2][2];
#pragma unroll
        for (int bj = 0; bj < 2; ++bj)
#pragma unroll
            for (int n = 0; n < 2; ++n) bv[bj][n] = *(const LAS f32x4*)(lds + LDS_META + (cl + bj * HALF + 4 * n) * 4) * YB_SCALE;
#pragma unroll
        for (int ai = 0; ai < 2; ++ai)
#pragma unroll
            for (int m = 0; m < 4; ++m) { u32x2 pc[2];
#pragma unroll
                for (int bj = 0; bj < 2; ++bj) { const f32x4 v0 = acc[ai][bj][m][0] * (YB_SCALE / (W_SCALE * ACT_SCALE)) + bv[bj][0], v1 = acc[ai][bj][m][1] * (YB_SCALE / (W_SCALE * ACT_SCALE)) + bv[bj][1];
                    pc[bj] = (u32x2){pk4_fp8(v0[0], v0[1], v0[2], v0[3]), pk4_fp8(v1[0], v1[1], v1[2], v1[3])}; }
                const u32x4 w = widen16(pc[0], pc[1]);
                *(u32x4*)(YB + (size_t)(row0 + ai * HALF + m * 16) * D + col0 + (fq & 1) * (HALF - 8)) = w; }
    }
};
}


typedef float f32x16 __attribute__((ext_vector_type(16)));
constexpr int AT_KS = 144, AT_VS = 584, AT_KOFF = 0, AT_VOFF = 288 * AT_KS;

__device__ __forceinline__ void attn_tile(LAS unsigned char* lds, int slot_base, int kind, int j, int lane, int hq,
                                          const bf16x8 (&qf)[2][4], f32x16 (&oacc)[2][2], float (&mrow)[2], float (&lrow)[2]) {
    const int r31 = lane & 31, h = lane >> 5;
    bf16x8 kf[4], vf[2][2];
#pragma unroll
    for (int ks = 0; ks < 4; ++ks) kf[ks] = *(const LAS bf16x8*)(lds + AT_KOFF + (slot_base + r31) * AT_KS + (16 * ks + 8 * h) * 2);
#pragma unroll
    for (int dt = 0; dt < 2; ++dt)
#pragma unroll
        for (int sp = 0; sp < 2; ++sp) { const LAS unsigned char* p = lds + AT_VOFF + (32 * dt + r31) * AT_VS + (slot_base + 16 * sp + 4 * h) * 2;
            const u32x2 lo = *(const LAS u32x2*)p, hi = *(const LAS u32x2*)(p + 16);
            const u32x4 w = (u32x4){lo.x, lo.y, hi.x, hi.y}; vf[dt][sp] = __builtin_bit_cast(bf16x8, w); }
#pragma unroll
    for (int qt = 0; qt < 2; ++qt) {
        const int dg = 2 * hq + qt;
        if ((kind == 2 && j > dg) || (kind == 1 && j < dg)) continue;
        f32x16 s;
#pragma unroll
        for (int r = 0; r < 16; ++r) s[r] = 0.f;
#pragma unroll
        for (int ks = 0; ks < 4; ++ks) s = __builtin_amdgcn_mfma_f32_32x32x16_bf16(kf[ks], qf[qt][ks], s, 0, 0, 0);
        if (kind == 0) {
#pragma unroll
            for (int r = 0; r < 16; ++r) { const int key = (r & 3) + 8 * (r >> 2) + 4 * h; s[r] = key < 16 ? s[r] : -1.0e30f; }
        } else if (j == dg) {
            const int i = 32 * qt + r31 - 32 * (j - 2 * hq);
#pragma unroll
            for (int r = 0; r < 16; ++r) { const int key = (r & 3) + 8 * (r >> 2) + 4 * h;
                const bool ok = kind == 1 ? (key >= i + 1) : (key <= i);
                s[r] = ok ? s[r] : -1.0e30f; }
        }
        float mx = s[0];
#pragma unroll
        for (int r = 1; r < 16; ++r) mx = fmaxf(mx, s[r]);
        mx = fmaxf(mx, __shfl_xor(mx, 32));
        if (__builtin_amdgcn_ballot_w64(mx > mrow[qt] + 8.0f) != 0ull) {
            const float mn = fmaxf(mrow[qt], mx), al = __builtin_amdgcn_exp2f(mrow[qt] - mn); mrow[qt] = mn;
            lrow[qt] *= al;
#pragma unroll
            for (int dt = 0; dt < 2; ++dt)
#pragma unroll
                for (int r = 0; r < 16; ++r) oacc[qt][dt][r] *= al;
        }
        const float mn = mrow[qt];
        float ps = 0.f;
#pragma unroll
        for (int r = 0; r < 16; ++r) { s[r] = __builtin_amdgcn_exp2f(s[r] - mn); ps += s[r]; }
        lrow[qt] += ps;
        bf16x8 pf[2];
#pragma unroll
        for (int sp = 0; sp < 2; ++sp) { const u32x4 w = (u32x4){pk2(s[8 * sp + 0], s[8 * sp + 1]), pk2(s[8 * sp + 2], s[8 * sp + 3]), pk2(s[8 * sp + 4], s[8 * sp + 5]), pk2(s[8 * sp + 6], s[8 * sp + 7])};
            pf[sp] = __builtin_bit_cast(bf16x8, w); }
#pragma unroll
        for (int dt = 0; dt < 2; ++dt)
#pragma unroll
            for (int sp = 0; sp < 2; ++sp) oacc[qt][dt] = __builtin_amdgcn_mfma_f32_32x32x16_bf16(vf[dt][sp], pf[sp], oacc[qt][dt], 0, 0, 0);
    }
}

__device__ __forceinline__ void attn_item(const Args& a, LAS unsigned char* lds, int item, int tid, int lane, int wave) {
    const int kvh = item & 3, qblk = (item >> 2) & 15, b = item >> 6;
    const bf16* Z = (const bf16*)(a.ws + WS_Z); bf16* O = (bf16*)(a.ws + (G2_FP8 ? WS_ATT : WS_O)); constexpr int OLD = G2_FP8 ? 1024 : D;
    const float* cosT = (const float*)(a.ws + WS_COS); const float* sinT = (const float*)(a.ws + WS_SIN);
    __syncthreads();
    for (int task = tid; task < 288 * 4; task += 512) {
        const int slot = task >> 2, c = task & 3;
        int krow, kpos; bool valid;
        if (slot < 32) { valid = slot < NMETA; krow = METAROW0 + slot; kpos = slot; }
        else { const int sp = 128 * (qblk - 1) + (slot - 32); valid = sp >= 0; krow = b * SEQ + sp; kpos = NMETA + sp; }
        u32x4 lo = (u32x4){0u, 0u, 0u, 0u}, hi = lo;
        if (valid) {
            const bf16* kp = Z + (size_t)krow * DIN + ZK + kvh * 64 + c * 8;
            const u32x4 x1 = *(const u32x4*)kp, x2 = *(const u32x4*)(kp + 32);
            const f32x4 c0 = *(const f32x4*)(cosT + kpos * 32 + c * 8), c1 = *(const f32x4*)(cosT + kpos * 32 + c * 8 + 4);
            const f32x4 s0 = *(const f32x4*)(sinT + kpos * 32 + c * 8), s1 = *(const f32x4*)(sinT + kpos * 32 + c * 8 + 4);
#pragma unroll
            for (int q = 0; q < 4; ++q) { const float ca = q < 2 ? c0[2 * q] : c1[2 * q - 4], cb = q < 2 ? c0[2 * q + 1] : c1[2 * q - 3], sa = q < 2 ? s0[2 * q] : s1[2 * q - 4], sb = q < 2 ? s0[2 * q + 1] : s1[2 * q - 3];
                const float a0 = bflo(x1[q]), a1 = bfhi(x1[q]), b0 = bflo(x2[q]), b1 = bfhi(x2[q]);
                lo[q] = pk2(a0 * ca - b0 * sa, a1 * cb - b1 * sb); hi[q] = pk2(b0 * ca + a0 * sa, b1 * cb + a1 * sb); }
        }
        *(LAS u32x4*)(lds + AT_KOFF + slot * AT_KS + c * 16) = lo; *(LAS u32x4*)(lds + AT_KOFF + slot * AT_KS + 64 + c * 16) = hi;
    }
    for (int task = tid; task < 144 * 8; task += 512) {
        const int slot0 = (task >> 3) * 2, c = task & 7;
        int vrow; bool valid;
        if (slot0 < 32) { valid = slot0 < NMETA; vrow = METAROW0 + slot0; }
        else { const int sp = 128 * (qblk - 1) + (slot0 - 32); valid = sp >= 0; vrow = b * SEQ + sp; }
        u32x4 v0 = (u32x4){0u, 0u, 0u, 0u}, v1 = v0;
        if (valid) { const bf16* vp = Z + (size_t)vrow * DIN + ZV + kvh * 64 + c * 8; v0 = *(const u32x4*)vp; v1 = *(const u32x4*)(vp + DIN); }
#pragma unroll
        for (int q = 0; q < 4; ++q) {
            *(LAS unsigned*)(lds + AT_VOFF + (c * 8 + 2 * q) * AT_VS + slot0 * 2) = (v0[q] & 0xffffu) | (v1[q] << 16);
            *(LAS unsigned*)(lds + AT_VOFF + (c * 8 + 2 * q + 1) * AT_VS + slot0 * 2) = (v0[q] >> 16) | (v1[q] & 0xffff0000u); }
    }
    constexpr float QSC = 0.125f * 1.4426950408889634f;
    const int g = wave >> 1, hq = wave & 1, head = kvh * 4 + g, r31 = lane & 31, h = lane >> 5;
    bf16x8 qf[2][4];
#pragma unroll
    for (int qt = 0; qt < 2; ++qt) {
        const int s = 128 * qblk + 64 * hq + 32 * qt + r31, pos = NMETA + s;
        const bf16* qp = Z + (size_t)(b * SEQ + s) * DIN + ZQ + head * 64 + 8 * h;
        u32x4 x[4];
#pragma unroll
        for (int ks = 0; ks < 4; ++ks) x[ks] = *(const u32x4*)(qp + 16 * ks);
#pragma unroll
        for (int ks = 0; ks < 2; ++ks) {
            const float* cp = cosT + pos * 32 + 16 * ks + 8 * h; const float* sp = sinT + pos * 32 + 16 * ks + 8 * h;
            const f32x4 c0 = *(const f32x4*)cp, c1 = *(const f32x4*)(cp + 4), s0 = *(const f32x4*)sp, s1 = *(const f32x4*)(sp + 4);
            u32x4 lo, hi;
#pragma unroll
            for (int q = 0; q < 4; ++q) { const float ca = q < 2 ? c0[2 * q] : c1[2 * q - 4], cb = q < 2 ? c0[2 * q + 1] : c1[2 * q - 3], sa = q < 2 ? s0[2 * q] : s1[2 * q - 4], sb = q < 2 ? s0[2 * q + 1] : s1[2 * q - 3];
                const float a0 = bflo(x[ks][q]), a1 = bfhi(x[ks][q]), b0 = bflo(x[ks + 2][q]), b1 = bfhi(x[ks + 2][q]);
                lo[q] = pk2(QSC * (a0 * ca - b0 * sa), QSC * (a1 * cb - b1 * sb)); hi[q] = pk2(QSC * (b0 * ca + a0 * sa), QSC * (b1 * cb + a1 * sb)); }
            qf[qt][ks] = __builtin_bit_cast(bf16x8, lo); qf[qt][ks + 2] = __builtin_bit_cast(bf16x8, hi);
        }
    }
    f32x16 oacc[2][2]; float mrow[2], lrow[2];
#pragma unroll
    for (int qt = 0; qt < 2; ++qt) { mrow[qt] = a.in[I_SINKS][head] * 1.4426950408889634f; lrow[qt] = h == 0 ? 1.0f : 0.0f;
#pragma unroll
        for (int dt = 0; dt < 2; ++dt)
#pragma unroll
            for (int r = 0; r < 16; ++r) oacc[qt][dt][r] = 0.f; }
    __syncthreads();
    attn_tile(lds, 0, 0, 0, lane, hq, qf, oacc, mrow, lrow);
    if (qblk > 0) {
#pragma unroll 1
        for (int j = hq ? 2 : 0; j < 4; ++j) attn_tile(lds, 32 + 32 * j, 1, j, lane, hq, qf, oacc, mrow, lrow);
    }
#pragma unroll 1
    for (int j = 0; j < (hq ? 4 : 2); ++j) attn_tile(lds, 160 + 32 * j, 2, j, lane, hq, qf, oacc, mrow, lrow);
    LAS float* ssL = (LAS float*)(lds + 90112);
#pragma unroll
    for (int qt = 0; qt < 2; ++qt) {
        const float lt = lrow[qt] + __shfl_xor(lrow[qt], 32), inv = 1.0f / lt;
        bf16* op = O + (size_t)(b * SEQ + 128 * qblk + 64 * hq + 32 * qt + r31) * OLD + head * 64 + 4 * h;
        float ss = 0.f;
#pragma unroll
        for (int dt = 0; dt < 2; ++dt)
#pragma unroll
            for (int rr = 0; rr < 4; ++rr) {
                const float o0 = oacc[qt][dt][4 * rr] * inv, o1 = oacc[qt][dt][4 * rr + 1] * inv, o2 = oacc[qt][dt][4 * rr + 2] * inv, o3 = oacc[qt][dt][4 * rr + 3] * inv;
                ss += (o0 * o0 + o1 * o1) + (o2 * o2 + o3 * o3);
                *(u32x2*)(op + 32 * dt + 8 * rr) = (u32x2){pk2(o0, o1), pk2(o2, o3)}; }
        ss += __shfl_xor(ss, 32);
        if (h == 0) ssL[g * 128 + 64 * hq + 32 * qt + r31] = ss;
    }
    __syncthreads();
    if (tid < 128) ((float*)(a.ws + WS_SSQ))[(size_t)(b * SEQ + 128 * qblk + tid) * 4 + kvh] = (ssL[tid] + ssL[128 + tid]) + (ssL[256 + tid] + ssL[384 + tid]);
}

constexpr int LR_XS = 2064;
__device__ __forceinline__ void lru_norm_rows(const Args& a, LAS unsigned char* lds, int b, int c, int lane, int wave) {
        bf16* O = (bf16*)(a.ws + WS_O); unsigned char* O8 = a.ws + WS_O;
        const bf16* ATT = (const bf16*)(a.ws + (G2_FP8 ? WS_ATT : WS_O)); constexpr int ALD = G2_FP8 ? 1024 : D;
        u32x4 aw[4][2];
#pragma unroll
        for (int q = 0; q < 4; ++q)
#pragma unroll
            for (int jj = 0; jj < 2; ++jj) aw[q][jj] = *(const u32x4*)(ATT + ((size_t)b * SEQ + 32 * c + 4 * wave + q) * ALD + (lane + 64 * jj) * 8);
        f32x4 ga[2][2], gl[2][2];
#pragma unroll
        for (int jj = 0; jj < 2; ++jj) { ga[jj][0] = *(const f32x4*)(a.in[I_G_ATTN] + (lane + 64 * jj) * 8); ga[jj][1] = *(const f32x4*)(a.in[I_G_ATTN] + (lane + 64 * jj) * 8 + 4);
            gl[jj][0] = *(const f32x4*)(a.in[I_G_LRU] + (lane + 64 * jj) * 8); gl[jj][1] = *(const f32x4*)(a.in[I_G_LRU] + (lane + 64 * jj) * 8 + 4); }
        __syncthreads();
#pragma unroll
        for (int q = 0; q < 4; ++q) {
            const int tl = 4 * wave + q; const size_t row = (size_t)b * SEQ + 32 * c + tl;
#pragma unroll
            for (int half = 0; half < 1; ++half) {
                u32x4 w[2]; float v[16]; float ss = 0.f;
#pragma unroll
                for (int jj = 0; jj < 2; ++jj) { w[jj] = half == 0 ? *(const LAS u32x4*)(lds + tl * LR_XS + (lane + 64 * jj) * 16) : aw[q][jj];
#pragma unroll
                    for (int k = 0; k < 4; ++k) { v[jj * 8 + 2 * k] = bflo(w[jj][k]); v[jj * 8 + 2 * k + 1] = bfhi(w[jj][k]); } }
#pragma unroll
                for (int k = 0; k < 16; ++k) ss += v[k] * v[k];
                ss = wave_sum(ss);
                const float rstd = (G2_FP8 ? XS_SCALE : 1.0f) * __builtin_amdgcn_rsqf(ss * (1.0f / 1024.0f) + EPS);
#pragma unroll
                for (int jj = 0; jj < 2; ++jj) { const f32x4 g0 = half == 0 ? gl[jj][0] : ga[jj][0], g1 = half == 0 ? gl[jj][1] : ga[jj][1];
                    const size_t col = (half == 0 ? 1024 : 0) + (lane + 64 * jj) * 8;
                    if (G2_FP8) *(u32x2*)(O8 + row * D + col) = (u32x2){pk4_fp8(v[jj * 8 + 0] * rstd * g0.x, v[jj * 8 + 1] * rstd * g0.y, v[jj * 8 + 2] * rstd * g0.z, v[jj * 8 + 3] * rstd * g0.w),
                                                                       pk4_fp8(v[jj * 8 + 4] * rstd * g1.x, v[jj * 8 + 5] * rstd * g1.y, v[jj * 8 + 6] * rstd * g1.z, v[jj * 8 + 7] * rstd * g1.w)};
                    else *(u32x4*)(O + row * D + col) = (u32x4){pk2(v[jj * 8 + 0] * rstd * g0.x, v[jj * 8 + 1] * rstd * g0.y), pk2(v[jj * 8 + 2] * rstd * g0.z, v[jj * 8 + 3] * rstd * g0.w),
                                                                pk2(v[jj * 8 + 4] * rstd * g1.x, v[jj * 8 + 5] * rstd * g1.y), pk2(v[jj * 8 + 6] * rstd * g1.z, v[jj * 8 + 7] * rstd * g1.w)}; }
            }
        }
}
template <int PASS>
__device__ __forceinline__ void lru_item(const Args& a, LAS unsigned char* lds, int item, int part, int tid, int lane, int wave) {
    const int b = item / 65, c = item % 65; const bool meta = (c == 64);
    const bf16* Z = (const bf16*)(a.ws + WS_Z);
    float* sumA = (float*)(a.ws + WS_LRUSUM); float* sumB = sumA + NBATCH * 64 * DLRU; float* metaB = sumB + NBATCH * 64 * DLRU;
    __syncthreads();
    {
        const int ch0 = (tid & 127) * 8, tq = tid >> 7;
        f32x4 cw[4][2], cb[2];
#pragma unroll
        for (int jj = 0; jj < 4; ++jj) { cw[jj][0] = *(const f32x4*)(a.in[I_CONV_W] + jj * DLRU + ch0); cw[jj][1] = *(const f32x4*)(a.in[I_CONV_W] + jj * DLRU + ch0 + 4); }
        cb[0] = *(const f32x4*)(a.in[I_CONV_B] + ch0); cb[1] = *(const f32x4*)(a.in[I_CONV_B] + ch0 + 4);
#pragma unroll 1
        for (int i0 = 0; i0 < 8; i0 += 4) {
            u32x4 x[4][4];
#pragma unroll
            for (int i = 0; i < 4; ++i) { const int tl = tq + 4 * (i0 + i); const int t = meta ? tl : NMETA + 32 * c + tl;
#pragma unroll
                for (int jj = 0; jj < 4; ++jj) { const int tt = t - 3 + jj; x[i][jj] = (u32x4){0u, 0u, 0u, 0u};
                    if (tt >= 0 && !(meta && tl >= NMETA)) x[i][jj] = *(const u32x4*)(Z + (size_t)tok_row(b, tt) * DIN + ZX + ch0); } }
#pragma unroll
            for (int i = 0; i < 4; ++i) { const int tl = tq + 4 * (i0 + i); const int t = meta ? tl : NMETA + 32 * c + tl;
                f32x4 a0 = cb[0], a1 = cb[1];
#pragma unroll
                for (int jj = 0; jj < 4; ++jj) { const u32x4 xx = x[i][jj];
                    if (t - 3 + jj >= 0) {
                        a0.x += cw[jj][0].x * bflo(xx[0]); a0.y += cw[jj][0].y * bfhi(xx[0]); a0.z += cw[jj][0].z * bflo(xx[1]); a0.w += cw[jj][0].w * bfhi(xx[1]);
                        a1.x += cw[jj][1].x * bflo(xx[2]); a1.y += cw[jj][1].y * bfhi(xx[2]); a1.z += cw[jj][1].z * bflo(xx[3]); a1.w += cw[jj][1].w * bfhi(xx[3]); } }
                u32x4 o = (u32x4){pk2(a0.x, a0.y), pk2(a0.z, a0.w), pk2(a1.x, a1.y), pk2(a1.z, a1.w)};
                if (meta && tl >= NMETA) o = (u32x4){0u, 0u, 0u, 0u};
                *(LAS u32x4*)(lds + tl * LR_XS + ch0 * 2) = o; }
        }
    }
    LAS float* hinL = (LAS float*)(lds + 32 * LR_XS);
    if (PASS == 1) {
        float h0 = metaB[tid], h1 = metaB[tid + 512];
        const float* pa = sumA + (size_t)b * 64 * DLRU + tid; const float* pb = sumB + (size_t)b * 64 * DLRU + tid;
#pragma unroll 8
        for (int jc = 0; jc < c; ++jc) { h0 = pa[jc * DLRU] * h0 + pb[jc * DLRU]; h1 = pa[jc * DLRU + 512] * h1 + pb[jc * DLRU + 512]; }
        hinL[tid] = h0; hinL[tid + 512] = h1;
    }
    __syncthreads();
    const bf16* WaT = (const bf16*)(a.ws + WS_WAT); const bf16* WiT = (const bf16*)(a.ws + WS_WIT);
    const int r31 = lane & 31, h = lane >> 5;
    const int tau = 16 * ((r31 >> 2) & 1) + 4 * (r31 >> 3) + (r31 & 3);
#pragma unroll 1
    for (int nb = 0; nb < 2; ++nb) {
        const int n = 2 * wave + nb;
        bf16x8 af[4];
#pragma unroll
        for (int ks = 0; ks < 4; ++ks) af[ks] = *(const LAS bf16x8*)(lds + tau * LR_XS + (64 * n + 16 * ks + 8 * h) * 2);
#pragma unroll 1
        for (int nt = 0; nt < 2; ++nt) {
            if (part >= 0 && 2 * nb + nt != part) continue;
            const int ch = 64 * n + 32 * nt + r31;
            f32x16 accR, accI;
#pragma unroll
            for (int r = 0; r < 16; ++r) { accR[r] = 0.f; accI[r] = 0.f; }
#pragma unroll
            for (int ks = 0; ks < 4; ++ks) {
                const bf16x8 wa = *(const bf16x8*)(WaT + ((size_t)(n * 64 + 32 * nt + r31) * 64 + 16 * ks + 8 * h));
                const bf16x8 wi = *(const bf16x8*)(WiT + ((size_t)(n * 64 + 32 * nt + r31) * 64 + 16 * ks + 8 * h));
                accR = __builtin_amdgcn_mfma_f32_32x32x16_bf16(af[ks], wa, accR, 0, 0, 0);
                accI = __builtin_amdgcn_mfma_f32_32x32x16_bf16(af[ks], wi, accI, 0, 0, 0);
            }
            const float ba = a.in[I_B_A][ch], bi = a.in[I_B_I][ch], sp8 = -8.0f * 1.4426950408889634f * log1pf(__expf(-a.in[I_LAMBDA][ch]));
            float av[16], bv[16];
            float Ap = 1.0f, Bp = 0.0f;
#pragma unroll
            for (int r = 0; r < 16; ++r) {
                const float xcv = bf2f(*(const LAS unsigned short*)(lds + (16 * h + r) * LR_XS + ch * 2));
                const float rg = fast_sigmoid(accR[r] + ba), ig = fast_sigmoid(accI[r] + bi);
                const float l2a = sp8 * rg;
                av[r] = __builtin_amdgcn_exp2f(l2a); bv[r] = __builtin_amdgcn_sqrtf(fmaxf(fmaf(-av[r], av[r], 1.0f), 0.0f)) * ig * xcv;
                Ap *= av[r]; Bp = av[r] * Bp + bv[r];
                if (PASS == 0 && !meta) ((unsigned*)(a.ws + WS_AB))[((size_t)b * SEQ + 32 * c + 16 * h + r) * DLRU + ch] = pk2(l2a, bv[r]);
            }
            const float Ao = __shfl_xor(Ap, 32), Bo = __shfl_xor(Bp, 32);
            if (PASS == 0) {
                if (h == 0) {
                    if (meta) metaB[ch] = Bp;
                    else { sumA[((size_t)b * 64 + c) * DLRU + ch] = Ap * Ao; sumB[((size_t)b * 64 + c) * DLRU + ch] = Ao * Bp + Bo; }
                }
            } else {
                const float hin = hinL[ch];
                float hs = h == 0 ? hin : (Ao * hin + Bo);
#pragma unroll
                for (int r = 0; r < 16; ++r) {
                    hs = av[r] * hs + bv[r];
                    const int tl = 16 * h + r;
                    const float gt = bf2f(Z[(size_t)(b * SEQ + 32 * c + tl) * DIN + ZG + ch]);
                    *(LAS unsigned short*)(lds + tl * LR_XS + ch * 2) = (unsigned short)f2bf(hs * fast_gelu_tanh(gt));
                }
            }
        }
    }
}

__device__ __forceinline__ void lru_item_b(const Args& a, LAS unsigned char* lds, int item, int tid, int lane, int wave) {
    const int b = item >> 6, c = item & 63;
    const bf16* Z = (const bf16*)(a.ws + WS_Z); const unsigned* AB = (const unsigned*)(a.ws + WS_AB);
    const float* sumA = (const float*)(a.ws + WS_LRUSUM); const float* sumB = sumA + NBATCH * 64 * DLRU; const float* metaB = sumB + NBATCH * 64 * DLRU;
    const size_t row0 = (size_t)b * SEQ + 32 * c;
    u32x2 ab[32]; unsigned gt[32];
#pragma unroll
    for (int tl = 0; tl < 32; ++tl) { ab[tl] = *(const u32x2*)(AB + (row0 + tl) * DLRU + 2 * tid); gt[tl] = *(const unsigned*)(Z + (row0 + tl) * DIN + ZG + 2 * tid); }
    float h0, h1; { const f32x2 m = *(const f32x2*)(metaB + 2 * tid); h0 = m.x; h1 = m.y; }
    { const float* pa = sumA + (size_t)b * 64 * DLRU + 2 * tid; const float* pb = sumB + (size_t)b * 64 * DLRU + 2 * tid;
#pragma unroll 16
      for (int jc = 0; jc < c; ++jc) { const f32x2 A2 = *(const f32x2*)(pa + jc * DLRU), B2 = *(const f32x2*)(pb + jc * DLRU); h0 = A2.x * h0 + B2.x; h1 = A2.y * h1 + B2.y; } }
    __syncthreads();
#pragma unroll
    for (int tl = 0; tl < 32; ++tl) {
        h0 = __builtin_amdgcn_exp2f(bflo(ab[tl].x)) * h0 + bfhi(ab[tl].x);
        h1 = __builtin_amdgcn_exp2f(bflo(ab[tl].y)) * h1 + bfhi(ab[tl].y);
        *(LAS unsigned*)(lds + tl * LR_XS + 4 * tid) = pk2(h0 * fast_gelu_tanh(bflo(gt[tl])), h1 * fast_gelu_tanh(bfhi(gt[tl])));
    }
    lru_norm_rows(a, lds, b, c, lane, wave);
}

__device__ __forceinline__ void phase_router_mfma(const Args& a, LAS unsigned char* lds, int tid, int lane, int wave) {
    const bf16* H1 = (const bf16*)(a.ws + WS_H1); const bf16* WRT = (const bf16*)(a.ws + WS_WRT);
    int* tope = (int*)(a.ws + WS_TOPE); float* topw = (float*)(a.ws + WS_TOPW); float* rstd2 = (float*)(a.ws + WS_RSTD2);
    unsigned* counts = (unsigned*)(a.ws + WS_CTL) + CW_COUNTS;
    LAS float* lg = (LAS float*)(lds + wave * 2048);
    LAS int* hist = (LAS int*)(lds + 32768);
    if (tid < 32) hist[tid] = 0;
    __syncthreads();
    const int fr = lane & 15, fq = lane >> 4;
    const int kh = wave >> 2;
    LAS float* part = (LAS float*)(lds + 40960 + (wave & 3) * 2560);
    for (int g0 = 4 * blockIdx.x; g0 < MREAL / 16; g0 += 4 * gridDim.x) {
        const int grp = g0 + (wave & 3);
        const int row0 = grp * 16;
        const bf16* hp = H1 + (size_t)(row0 + fr) * D + 8 * fq + 1024 * kh;
        const bf16* wp = WRT + (size_t)fr * D + 8 * fq + 1024 * kh;
        f32x4 acc0 = (f32x4){0.f, 0.f, 0.f, 0.f}, acc1 = acc0; float ss = 0.f;
#pragma unroll 8
        for (int kk = 0; kk < 32; ++kk) {
            const u32x4 w = *(const u32x4*)(hp + 32 * kk);
#pragma unroll
            for (int q = 0; q < 4; ++q) { const float lo = bflo(w[q]), hi = bfhi(w[q]); ss += lo * lo + hi * hi; }
            const bf16x8 af = __builtin_bit_cast(bf16x8, w);
            const bf16x8 b0 = *(const bf16x8*)(wp + 32 * kk), b1 = *(const bf16x8*)(wp + (size_t)16 * D + 32 * kk);
            acc0 = __builtin_amdgcn_mfma_f32_16x16x32_bf16(af, b0, acc0, 0, 0, 0);
            acc1 = __builtin_amdgcn_mfma_f32_16x16x32_bf16(af, b1, acc1, 0, 0, 0);
        }
        if (kh == 1) {
#pragma unroll
            for (int j = 0; j < 4; ++j) { part[j * 64 + lane] = acc0[j]; part[(4 + j) * 64 + lane] = acc1[j]; }
            part[8 * 64 + lane] = ss; }
        __syncthreads();
        if (kh == 0) {
#pragma unroll
            for (int j = 0; j < 4; ++j) { acc0[j] += part[j * 64 + lane]; acc1[j] += part[(4 + j) * 64 + lane]; }
            ss += part[8 * 64 + lane]; }
        __syncthreads();
        if (kh == 1) continue;
        ss += __shfl_xor(ss, 16); ss += __shfl_xor(ss, 32);
        const float rstd = 1.0f / sqrtf(ss * (1.0f / D) + EPS);
        if (fq == 0) rstd2[row0 + fr] = rstd;
        const float br0 = a.in[I_B_ROUTER][fr], br1 = a.in[I_B_ROUTER][16 + fr];
#pragma unroll
        for (int j = 0; j < 4; ++j) { const int row = 4 * fq + j; const float rs = __shfl(rstd, row);
            lg[row * 32 + fr] = acc0[j] * rs + br0; lg[row * 32 + 16 + fr] = acc1[j] * rs + br1; }
        asm volatile("s_waitcnt lgkmcnt(0)" ::: "memory");
        if (lane < 16) {
            float v[32];
#pragma unroll
            for (int q = 0; q < 8; ++q) { const f32x4 t = *(const LAS f32x4*)(lg + lane * 32 + 4 * q); v[4 * q] = t.x; v[4 * q + 1] = t.y; v[4 * q + 2] = t.z; v[4 * q + 3] = t.w; }
            float tv[4]; int te[4];
#pragma unroll
            for (int r = 0; r < 4; ++r) { float best = -3.0e38f; int bi = 0;
#pragma unroll
                for (int e = 0; e < 32; ++e) { const bool gtb = v[e] > best; best = gtb ? v[e] : best; bi = gtb ? e : bi; }
#pragma unroll
                for (int e = 0; e < 32; ++e) v[e] = (e == bi) ? -3.0e38f : v[e];
                tv[r] = best; te[r] = bi; }
            const float e1 = __expf(tv[1] - tv[0]), e2 = __expf(tv[2] - tv[0]), e3 = __expf(tv[3] - tv[0]);
            const float inv = 1.0f / (1.0f + e1 + e2 + e3);
            const int row = row0 + lane;
            *(int4*)(tope + row * 4) = make_int4(te[0], te[1], te[2], te[3]);
            *(f32x4*)(topw + row * 4) = (f32x4){inv, e1 * inv, e2 * inv, e3 * inv};
#pragma unroll
            for (int r = 0; r < 4; ++r) atomicAdd((int*)&hist[te[r]], 1);
        }
        asm volatile("s_waitcnt lgkmcnt(0)" ::: "memory");
    }
    __syncthreads();
    if (tid < 32 && hist[tid] != 0) atomicAdd(&counts[tid], (unsigned)hist[tid]);
}

__device__ __forceinline__ void build_tile_table(const Args& a, LAS int* tstart, int tid) {
    if (tid < 64) {
        const unsigned* counts = (const unsigned*)(a.ws + WS_CTL) + CW_COUNTS;
        const int nt = tid < NEXP ? (int)((__hip_atomic_load(counts + tid, __ATOMIC_RELAXED, __HIP_MEMORY_SCOPE_AGENT) + 255u) >> 8) : 0;
        int inc = nt;
#pragma unroll
        for (int o = 1; o < 32; o <<= 1) { const int v = __shfl_up(inc, o); if ((tid & 63) >= o) inc += v; }
        if (tid < NEXP) tstart[tid] = inc - nt;
        if (tid == NEXP - 1) tstart[NEXP] = inc;
    }
    __syncthreads();
    if (tid < 288) { int e = 0;
#pragma unroll 1
        for (int i = 1; i < NEXP; ++i) e += (tstart[i] <= tid) ? 1 : 0;
        ((LAS unsigned char*)(tstart + 64))[tid] = (unsigned char)e; }
    __syncthreads();
}
__device__ __forceinline__ int tile_expert(const LAS int* tstart, int tile) {
    int e = 0;
#pragma unroll 1
    for (int i = 1; i < NEXP; ++i) e += (tstart[i] <= tile) ? 1 : 0;
    return e;
}

__device__ __forceinline__ void phase_assign(const Args& a, LAS unsigned char* lds, int tid, int lane, int wave) {
    LAS int* tstart = (LAS int*)(lds + LDS_TAB);
    LAS int* hist = (LAS int*)lds; LAS int* base = hist + 32; LAS int* spos = base + 32;
    build_tile_table(a, tstart, tid);
    const int* tope = (const int*)(a.ws + WS_TOPE); const float* topw = (const float*)(a.ws + WS_TOPW); const float* rstd2 = (const float*)(a.ws + WS_RSTD2);
    int* rowpair = (int*)(a.ws + WS_ROWPAIR); float* roww = (float*)(a.ws + WS_ROWW);
    unsigned* cursor = (unsigned*)(a.ws + WS_CTL) + CW_CURSOR;
    const bf16* H1 = (const bf16*)(a.ws + WS_H1); unsigned char* XS = (unsigned char*)(a.ws + WS_XS);
    for (int blk = blockIdx.x; blk < MREAL / 64; blk += gridDim.x) {
        if (tid < 32) hist[tid] = 0;
        __syncthreads();
        int e = 0, rank = 0, pair = 0;
        if (tid < 256) { pair = blk * 256 + tid; e = tope[pair]; rank = atomicAdd((int*)&hist[e], 1); }
        __syncthreads();
        if (tid < 32) base[tid] = (int)atomicAdd(&cursor[tid], (unsigned)hist[tid]);
        __syncthreads();
        if (tid < 256) { const int pos = tstart[e] * 256 + base[e] + rank; spos[tid] = pos; rowpair[pos] = pair; roww[pos] = topw[pair]; ((int*)(a.ws + WS_PAIRPOS))[pair] = pos; }
        __syncthreads();
        for (int tt = wave * 8; tt < wave * 8 + 8; ++tt) {
            const int token = blk * 64 + tt; const float rstd = rstd2[token] * XS_SCALE;
            const u32x4* hr = (const u32x4*)(H1 + (size_t)token * D);
            u32x4* dst = (u32x4*)(XS + (size_t)token * D);
#pragma unroll
            for (int j = 0; j < 2; ++j) { const u32x4 ha = hr[2 * (lane + 64 * j)], hb = hr[2 * (lane + 64 * j) + 1];
                const f32x4* gp = (const f32x4*)a.in[I_NORM_FFN] + 4 * (lane + 64 * j); const f32x4 g0 = gp[0], g1 = gp[1], g2 = gp[2], g3 = gp[3];
                dst[lane + 64 * j] = (u32x4){pk4_fp8(bflo(ha[0]) * rstd * g0.x, bfhi(ha[0]) * rstd * g0.y, bflo(ha[1]) * rstd * g0.z, bfhi(ha[1]) * rstd * g0.w),
                                             pk4_fp8(bflo(ha[2]) * rstd * g1.x, bfhi(ha[2]) * rstd * g1.y, bflo(ha[3]) * rstd * g1.z, bfhi(ha[3]) * rstd * g1.w),
                                             pk4_fp8(bflo(hb[0]) * rstd * g2.x, bfhi(hb[0]) * rstd * g2.y, bflo(hb[1]) * rstd * g2.z, bfhi(hb[1]) * rstd * g2.w),
                                             pk4_fp8(bflo(hb[2]) * rstd * g3.x, bfhi(hb[2]) * rstd * g3.y, bflo(hb[3]) * rstd * g3.z, bfhi(hb[3]) * rstd * g3.w)}; }
        }
        __syncthreads();
    }
}

__device__ __forceinline__ void phase_final(const Args& a, int lane, int wave) {
    const int gw = blockIdx.x * 8 + wave, NGW = gridDim.x * 8;
    const bf16* H1 = (const bf16*)(a.ws + WS_H1); const unsigned char* YB = a.ws + WS_YB;
    const int* pairpos = (const int*)(a.ws + WS_PAIRPOS); const float* topw = (const float*)(a.ws + WS_TOPW);
    for (int row = gw; row < MREAL; row += NGW) {
        const int4 pp = *(const int4*)(pairpos + row * 4); const f32x4 pw = *(const f32x4*)(topw + row * 4) * (1.0f / YB_SCALE);
        const int pos[4] = {pp.x, pp.y, pp.z, pp.w}; const float w4[4] = {pw.x, pw.y, pw.z, pw.w};
        f32x4 v[8]; unsigned y[4][8]; float ss = 0.f;
#pragma unroll
        for (int k = 0; k < 4; ++k)
#pragma unroll
            for (int j = 0; j < 8; ++j) y[k][j] = ((const unsigned*)(YB + (size_t)pos[k] * D))[lane + 64 * j];
#pragma unroll
        for (int j = 0; j < 8; ++j) { { const u32x2 hh = ((const u32x2*)(H1 + (size_t)row * D))[lane + 64 * j]; v[j] = (f32x4){bflo(hh.x), bfhi(hh.x), bflo(hh.y), bfhi(hh.y)}; }
#pragma unroll
            for (int k = 0; k < 4; ++k) { const f32x2 lo = __builtin_amdgcn_cvt_pk_f32_fp8((int)y[k][j], false), hi = __builtin_amdgcn_cvt_pk_f32_fp8((int)y[k][j], true);
                v[j].x += w4[k] * lo.x; v[j].y += w4[k] * lo.y; v[j].z += w4[k] * hi.x; v[j].w += w4[k] * hi.y; }
            ss += (v[j].x * v[j].x + v[j].y * v[j].y) + (v[j].z * v[j].z + v[j].w * v[j].w); }
        ss = wave_sum(ss);
        const float rstd = 1.0f / sqrtf(ss * (1.0f / D) + EPS);
        f32x4* op = (f32x4*)(a.out + (size_t)row * D);
#pragma unroll
        for (int j = 0; j < 8; ++j) { const f32x4 g = ((const f32x4*)a.in[I_FINAL_NORM])[lane + 64 * j]; op[lane + 64 * j] = v[j] * rstd * g; }
    }
}

enum { PH_PROLOGUE = 0, PH_G1, PH_ATTN, PH_LRU_B, PH_G2, PH_ROUTER, PH_ASSIGN, PH_G3, PH_G4, PH_FINAL, PH_COUNT };

__global__ void __launch_bounds__(512, 2) fwd(Args a) {
    extern __shared__ __attribute__((aligned(16))) unsigned char lds_raw[];
    LAS unsigned char* lds = (LAS unsigned char*)lds_raw;
    const int tid = threadIdx.x, lane = tid & 63, wave = __builtin_amdgcn_readfirstlane(tid >> 6);
    const int gw = blockIdx.x * 8 + wave, NGW = gridDim.x * 8;
    unsigned char* ws = a.ws;
#define IN(k) (a.ph_lo <= (k) && (k) < a.ph_hi)
    pg8::BGNone nobg;
    pg8::BGConv bgup{(const char*)a.in[I_W_UP], ws + WS_WUT, (int)blockIdx.x * 128, (int)blockIdx.x * 128 + 80, ws + WS_DUMMY};
#define SEAM(k) do { if (IN(k) && IN((k) + 1)) xcd_barrier(bar); } while (0)
    if (tid < 4) ((LAS unsigned*)(lds + LDS_MISC))[tid] = 0u;
    __syncthreads();
    XcdBarrier bar; bar.bar = (unsigned*)(ws + WS_CTL) + CW_BAR; bar.x = 0; bar.st = nullptr;
    if (a.ph_hi - a.ph_lo > 1) bar = xcd_barrier_post((unsigned*)(ws + WS_CTL) + CW_BAR, (volatile LAS unsigned*)(lds + LDS_MISC));

    if (IN(PH_PROLOGUE)) { phase_prologue(a, lds, tid, lane, wave);
#if PROBE_REPEAT == 0
        __syncthreads(); phase_prologue(a, lds, tid, lane, wave);
#endif
    }
    SEAM(PH_PROLOGUE);

    if (IN(PH_G1)) {
        const int ncv = g1_conv_wg(), G1G = (int)gridDim.x - ncv;
        pg8::SchedDense S{(const char*)(ws + WS_N1), (const char*)(ws + WS_WINT), (const char*)(ws + WS_WINT), nullptr, MROWS / 256, DIN / 256, G1G, (int)blockIdx.x, G1_FP8 ? 2048 : 4096};
        pg8::EpiZ E{(bf16*)(ws + WS_Z), a.in[I_B_IN], (const float*)(ws + WS_RSTD1)};
        if ((int)blockIdx.x >= G1G) conv_tiles(a, lds, tid, conv_pro_tiles() + ((int)blockIdx.x - G1G), CONV_ALL_TILES, ncv);
        else
#if BG_WUP
        pg8::gemm_phase<G1_FP8 != 0>(lds, S, E, bgup);
#else
        pg8::gemm_phase<G1_FP8 != 0>(lds, S, E, nobg);
#endif
#if PROBE_REPEAT == 1
        __syncthreads(); pg8::gemm_phase<G1_FP8 != 0>(lds, S, E, nobg);
#endif
    }
    SEAM(PH_G1);
    if (IN(PH_ATTN)) {
        for (int it = blockIdx.x; it < NBATCH * 16 * 4; it += gridDim.x) attn_item(a, lds, it, tid, lane, wave);
        for (int j = blockIdx.x; j < NBATCH * 64 + 4; j += gridDim.x) {
            if (j < NBATCH * 64) lru_item<0>(a, lds, (j >> 6) * 65 + (j & 63), -1, tid, lane, wave); else lru_item<0>(a, lds, 64, j - NBATCH * 64, tid, lane, wave); }
#if PROBE_REPEAT == 2
        for (int it = blockIdx.x; it < NBATCH * 16 * 4; it += gridDim.x) attn_item(a, lds, it, tid, lane, wave);
#endif
#if PROBE_REPEAT == 3
        for (int j = blockIdx.x; j < NBATCH * 64 + 4; j += gridDim.x) {
            if (j < NBATCH * 64) lru_item<0>(a, lds, (j >> 6) * 65 + (j & 63), -1, tid, lane, wave); else lru_item<0>(a, lds, 64, j - NBATCH * 64, tid, lane, wave); }
#endif
    }
    SEAM(PH_ATTN);
    if (IN(PH_LRU_B)) {
        for (int it = blockIdx.x; it < NBATCH * 64; it += gridDim.x) lru_item_b(a, lds, (it & 256) ? (it ^ 63) : it, tid, lane, wave);
    }
    SEAM(PH_LRU_B);
    if (IN(PH_G2)) {
        pg8::SchedDense S{(const char*)(ws + WS_O), (const char*)(ws + WS_WOUTT), (const char*)(ws + WS_WOUTT), nullptr, MREAL / 256, D / 256, (int)gridDim.x, (int)blockIdx.x, G2_FP8 ? 2048 : 4096};
        pg8::EpiH1 E{(bf16*)(ws + WS_H1), (const bf16*)(ws + WS_N1), a.in[I_B_OUT], G2_FP8 ? 1.0f / (W_SCALE * XS_SCALE) : 1.0f, (const float*)(ws + WS_SSQ)};
#if BG_WUP
        pg8::gemm_phase<G2_FP8 != 0>(lds, S, E, bgup);
        for (int pair = bgup.next < bgup.end ? bgup.next : bgup.end; pair < bgup.end; ++pair) { const char* sp; unsigned char* dp; pg8::bg_pair_ptrs(bgup, pair, sp, dp);
            const int n = tid >> 4, c = tid & 15; const float* p = (const float*)sp + (size_t)(8 * c) * 2048 + n;
            *(u32x2*)(dp + (size_t)n * 2048 + 8 * c) = (u32x2){pk4_fp8(p[0] * W_SCALE, p[2048] * W_SCALE, p[4096] * W_SCALE, p[6144] * W_SCALE), pk4_fp8(p[8192] * W_SCALE, p[10240] * W_SCALE, p[12288] * W_SCALE, p[14336] * W_SCALE)}; }
#else
        pg8::gemm_phase<G2_FP8 != 0>(lds, S, E, nobg);
#endif
#if PROBE_REPEAT == 4
        __syncthreads(); pg8::gemm_phase<G2_FP8 != 0>(lds, S, E, nobg);
#endif
    }
    SEAM(PH_G2);
    if (IN(PH_ROUTER)) phase_router_mfma(a, lds, tid, lane, wave);
    if (IN(PH_ROUTER) && IN(PH_ASSIGN)) {
        asm volatile("s_waitcnt vmcnt(0)" ::: "memory"); __syncthreads();
        if (tid == 0) { unsigned* rs = (unsigned*)(ws + WS_CTL) + CW_RSYNC; unsigned* tmo = (unsigned*)(ws + WS_CTL) + CW_BAR + XB_TMO;
            __hip_atomic_fetch_add(rs, 1u, __ATOMIC_RELAXED, __HIP_MEMORY_SCOPE_AGENT);
            unsigned sp = 0; while (__hip_atomic_load(rs, __ATOMIC_RELAXED, __HIP_MEMORY_SCOPE_AGENT) < gridDim.x) { __builtin_amdgcn_s_sleep(1);
                if ((++sp & 255u) == 0u) { if (__hip_atomic_load(tmo, __ATOMIC_RELAXED, __HIP_MEMORY_SCOPE_AGENT)) break; if (sp > XB_SPIN_CAP) { atomicAdd(tmo, 1u); break; } } } }
        __syncthreads();
    } else SEAM(PH_ROUTER);
    if (IN(PH_ASSIGN)) phase_assign(a, lds, tid, lane, wave);
    SEAM(PH_ASSIGN);
    if (IN(PH_G3)) {
        LAS int* tstart = (LAS int*)(lds + LDS_TAB);
        if (!IN(PH_ASSIGN)) build_tile_table(a, tstart, tid);
        const int G3G = (int)gridDim.x - G3_TEST_IDLE;
        pg8::SchedMoE S{(const char*)(ws + WS_N2), (const char*)(ws + WS_WGT), (const char*)(ws + WS_WUT), (const int*)(ws + WS_ROWPAIR), tstart, tstart[NEXP], DFF / 128, G3G, (int)blockIdx.x, true};
        pg8::EpiAct E{(unsigned char*)(ws + WS_ACT), a.in[I_B_GATE], a.in[I_B_UP]};
#if BG_WDOWN
        int bg0, bg1;
        { const int U = tstart[NEXP] * (DFF / 128), ulo = U / G3G, nhi = U - ulo * G3G, c = (int)blockIdx.x;
          int plo = (32768 + nhi * 48 + G3G - 1) / G3G; if (nhi != 0 && plo > 8 * ulo) plo = 8 * ulo > 0 ? 8 * ulo : 1;
          int phi = nhi ? (32768 - (G3G - nhi) * plo + nhi - 1) / nhi : 0; if (phi < 0) phi = 0;
          bg0 = c < nhi ? c * phi : nhi * phi + (c - nhi) * plo; bg1 = bg0 + (c < nhi ? phi : plo);
          if (c >= G3G) { bg0 = bg1 = 32768; }
          if (c == G3G - 1) bg1 = 32768;
          bg0 = bg0 < 32768 ? bg0 : 32768; bg1 = bg1 < 32768 ? bg1 : 32768; }
        pg8::BGConv bg{(const char*)a.in[I_W_DOWN], ws + WS_WDT, bg0, bg1, ws + WS_DUMMY};
        if ((int)blockIdx.x < G3G) pg8::gemm_phase<true, pg8::EpiAct, pg8::SchedMoE, pg8::BGConv, true>(lds, S, E, bg);
        for (int pair = bg.next < bg.end ? bg.next : bg.end; pair < bg.end; ++pair) { const char* sp; unsigned char* dp; pg8::bg_pair_ptrs(bg, pair, sp, dp);
            const int n = tid >> 4, c = tid & 15;
            const float* p = (const float*)sp + (size_t)(8 * c) * 2048 + n;
            *(u32x2*)(dp + (size_t)n * 2048 + 8 * c) = (u32x2){pk4_fp8(p[0] * W_SCALE, p[2048] * W_SCALE, p[4096] * W_SCALE, p[6144] * W_SCALE), pk4_fp8(p[8192] * W_SCALE, p[10240] * W_SCALE, p[12288] * W_SCALE, p[14336] * W_SCALE)}; }
#else
        pg8::gemm_phase<true, pg8::EpiAct, pg8::SchedMoE, pg8::BGNone, true>(lds, S, E, nobg);
#endif
#if PROBE_REPEAT == 7
        __syncthreads(); pg8::gemm_phase<true, pg8::EpiAct, pg8::SchedMoE, pg8::BGNone, true>(lds, S, E, nobg);
#endif
    }
    SEAM(PH_G3);
    if (IN(PH_G4)) {
        LAS int* tstart = (LAS int*)(lds + LDS_TAB);
        if (!IN(PH_ASSIGN) && !IN(PH_G3)) build_tile_table(a, tstart, tid);
        pg8::SchedMoE S{(const char*)(ws + WS_ACT), (const char*)(ws + WS_WDT), (const char*)(ws + WS_WDT), nullptr, tstart, tstart[NEXP], D / 256, (int)gridDim.x, (int)blockIdx.x, false};
        pg8::EpiDown E{ws + WS_YB, a.in[I_B_DOWN]};
        pg8::gemm_phase<true>(lds, S, E, nobg);
#if PROBE_REPEAT == 8
        __syncthreads(); pg8::gemm_phase<true>(lds, S, E, nobg);
#endif
    }
    SEAM(PH_G4);
    if (IN(PH_FINAL)) { phase_final(a, lane, wave);
#if PROBE_REPEAT == 9
        phase_final(a, lane, wave);
#endif
    }
#undef IN
#undef SEAM
}

extern "C" void kernel_launch(void* const* d_in, const int* in_sizes, int n_in, void* d_out, int out_size, void* d_ws, size_t ws_size, hipStream_t stream) {
    static int grid = 0;
    if (grid == 0) {
        if (n_in != 27 || out_size != MREAL * D || ws_size < WS_END) { fprintf(stderr, "kernel_launch: unexpected problem (n_in %d, out %d, ws %zu)\n", n_in, out_size, ws_size); grid = -1; return; }
        int dev = 0, cus = 0;
        if (hipGetDevice(&dev) != hipSuccess || hipDeviceGetAttribute(&cus, hipDeviceAttributeMultiprocessorCount, dev) != hipSuccess) { grid = -1; return; }
        if (hipFuncSetAttribute((const void*)fwd, hipFuncAttributeMaxDynamicSharedMemorySize, LDS_BYTES) != hipSuccess) { fprintf(stderr, "kernel_launch: hipFuncSetAttribute failed\n"); grid = -1; return; }
        grid = cus;
    }
    if (grid < 0) return;
    (void)hipMemsetAsync((char*)d_ws + WS_CTL, 0, CTL_BYTES, stream);
    Args a{};
    for (int i = 0; i < 27; ++i) a.in[i] = (const float*)d_in[i];
    a.out = (float*)d_out; a.ws = (unsigned char*)d_ws;
#if MK_ONE_LAUNCH
    a.ph_lo = 0; a.ph_hi = PH_COUNT;
    hipLaunchKernelGGL(fwd, dim3(grid), dim3(512), LDS_BYTES, stream, a);
#else
    for (int ph = 0; ph < PH_COUNT; ++ph) {
        a.ph_lo = ph; a.ph_hi = ph + 1;
        hipLaunchKernelGGL(fwd, dim3(grid), dim3(512), LDS_BYTES, stream, a);
    }
#endif
}
```

```cpp
#include <hip/hip_runtime.h>
#include <cstdio>
#include <cstdint>

#define LAS __attribute__((address_space(3)))
#ifndef PROBE_REPEAT
#define PROBE_REPEAT -1
#endif
#ifndef G1_FP8
#define G1_FP8 0
#endif
#ifndef G2_FP8
#define G2_FP8 0
#endif
#ifndef BG_WDOWN
#define BG_WDOWN 1
#endif
#ifndef G3_TEST_IDLE
#define G3_TEST_IDLE 0
#endif
#ifndef BG_WUP
#define BG_WUP 0
#endif
#ifndef BG_EXP
#define BG_EXP 0
#endif
#ifndef MK_ONE_LAUNCH
#define MK_ONE_LAUNCH 1
#endif
typedef unsigned short bf16;
typedef float f32x4 __attribute__((ext_vector_type(4)));
typedef float f32x2 __attribute__((ext_vector_type(2)));
typedef short bf16x8 __attribute__((ext_vector_type(8)));
typedef unsigned u32x4 __attribute__((ext_vector_type(4)));
typedef unsigned u32x2 __attribute__((ext_vector_type(2)));

constexpr int D = 2048, SEQ = 2048, NMETA = 16, TT = 2064, NBATCH = 8;
constexpr int MREAL = 16384, METAROW0 = 16384, MVALID = 16400, MROWS = 16640;
constexpr int DIN = 3584, DLRU = 1024, HD = 64;
constexpr int ZQ = 0, ZK = 1024, ZV = 1280, ZX = 1536, ZG = 2560;
constexpr int NEXP = 32, DFF = 2048, PROWS = 73728;
constexpr float EPS = 1e-5f;

constexpr size_t MiB = 1u << 20;
constexpr size_t WS_CTL = 0, CTL_BYTES = 1 * MiB, CTL_ZERO_BYTES = 32 * 1024;
constexpr size_t WS_COS = 1 * MiB, WS_SIN = 1 * MiB + 320 * 1024;
constexpr size_t WS_TOPE = 2 * MiB, WS_TOPW = WS_TOPE + 256 * 1024, WS_RSTD2 = WS_TOPW + 256 * 1024, WS_ROWPAIR = WS_RSTD2 + 64 * 1024, WS_ROWW = WS_ROWPAIR + 320 * 1024;
constexpr size_t WS_PAIRPOS = 3 * MiB + 256 * 1024;
constexpr size_t WS_DUMMY = 3 * MiB + 512 * 1024;
constexpr size_t WS_LRUSUM = 4 * MiB;
constexpr size_t WS_RSTD1 = 8 * MiB + 256 * 1024;
constexpr size_t WS_SSQ = 8 * MiB + 512 * 1024;
constexpr size_t WS_WAT = 9 * MiB, WS_WIT = WS_WAT + 128 * 1024, WS_WRT = WS_WIT + 128 * 1024;
constexpr size_t WS_WINT = 10 * MiB, WS_WOUTT = 24 * MiB, WS_WGT = 32 * MiB, WS_WUT = 288 * MiB, WS_WDT = 544 * MiB;
constexpr size_t WS_N1 = 800 * MiB, WS_Z = 866 * MiB, WS_O = 980 * MiB, WS_H1 = 1044 * MiB, WS_XS = 1172 * MiB, WS_YB = WS_XS, WS_ACT = 1460 * MiB, WS_END = 1748 * MiB;
constexpr size_t WS_N2 = WS_XS;
constexpr size_t WS_AB = WS_XS;
constexpr size_t WS_ATT = WS_N1;
constexpr size_t WS_XC = WS_XS, WS_AA = WS_XS + 66 * MiB, WS_BB = WS_XS + 132 * MiB, WS_YL = WS_XS + 198 * MiB;
static_assert(WS_ROWW + PROWS * 4 <= WS_LRUSUM, "small map");
constexpr int CW_COUNTS = 1024, CW_CURSOR = 1088, CW_RSYNC = 1280, CW_BAR = 4096;

constexpr int LDS_TAB = 131072;
constexpr int LDS_META = LDS_TAB + 1024;
constexpr int LDS_RID = LDS_META + 3072;
constexpr int LDS_MISC = LDS_TAB + 8192;
constexpr int LDS_BG = LDS_MISC + 1024;
constexpr int LDS_T2 = LDS_BG + 16384;
constexpr int LDS_BYTES = LDS_T2 + 4352;
static_assert(LDS_BYTES <= 163840 && LDS_BG % 1024 == 0, "LDS map");

__device__ const float c_inv_freq[32] = {1.000000000e+00f, 7.498942018e-01f, 5.623413324e-01f, 4.216965139e-01f, 3.162277639e-01f, 2.371373922e-01f, 1.778279394e-01f, 1.333521456e-01f, 1.000000015e-01f, 7.498941571e-02f, 5.623412877e-02f, 4.216964915e-02f, 3.162277862e-02f, 2.371373586e-02f, 1.778279431e-02f, 1.333521493e-02f, 9.999999776e-03f, 7.498942316e-03f, 5.623413250e-03f, 4.216964822e-03f, 3.162277862e-03f, 2.371373819e-03f, 1.778279431e-03f, 1.333521446e-03f, 1.000000047e-03f, 7.498941850e-04f, 5.623413017e-04f, 4.216965463e-04f, 3.162277862e-04f, 2.371373848e-04f, 1.778279402e-04f, 1.333521504e-04f};

struct Args { const float* in[27]; float* out; unsigned char* ws; int ph_lo, ph_hi; };
enum { I_X = 0, I_META, I_NORM_MIX, I_W_IN, I_B_IN, I_SINKS, I_CONV_W, I_CONV_B, I_W_A, I_B_A, I_W_I, I_B_I, I_LAMBDA, I_G_ATTN, I_G_LRU, I_W_OUT, I_B_OUT, I_NORM_FFN,
       I_W_ROUTER, I_B_ROUTER, I_W_GATE, I_B_GATE, I_W_UP, I_B_UP, I_W_DOWN, I_B_DOWN, I_FINAL_NORM };


#define XB_TMO      128
#define XB_XCNT(j)  (256  + 64 * (j))
#define XB_XSUB(j)  (1280 + 64 * (j))
#define XB_XGEN(j)  (2304 + 64 * (j))
#define XB_TOP      3328
#define XB_TOPGEN   3392
#define XCD_BAR_WORDS 3456
#define XB_SPIN_CAP (1u << 18)

__device__ __forceinline__ unsigned xb_ld(unsigned* p)              { return __hip_atomic_load(p, __ATOMIC_RELAXED, __HIP_MEMORY_SCOPE_AGENT); }
__device__ __forceinline__ unsigned xb_add(unsigned* p, unsigned v) { return __hip_atomic_fetch_add(p, v, __ATOMIC_RELAXED, __HIP_MEMORY_SCOPE_AGENT); }
__device__ __forceinline__ unsigned xb_xcc_id() { return (unsigned)__builtin_amdgcn_s_getreg((3 << 11) | 20) & 0xFu; }
#define XB_SPIN(cond, bar) do { unsigned _sp = 0; while (cond) { __builtin_amdgcn_s_sleep(1); \
    if ((++_sp & 255u) == 0u) { if (xb_ld(&(bar)[XB_TMO])) break; if (_sp > XB_SPIN_CAP) { atomicAdd(&(bar)[XB_TMO], 1u); break; } } } } while (0)

struct XcdBarrier {
    unsigned* bar; unsigned x;
    volatile LAS unsigned* st;
};

__device__ __forceinline__ XcdBarrier xcd_barrier_post(unsigned* bar, volatile LAS unsigned* st) {
    XcdBarrier b; b.bar = bar; b.x = xb_xcc_id(); b.st = st;
    if (threadIdx.x == 0) (void)xb_add(&bar[XB_XCNT(b.x)], 1u);
    return b;
}
__device__ __forceinline__ void xcd_barrier_complete(unsigned* bar, unsigned x, unsigned& nloc, unsigned& nx) {
    const unsigned G = gridDim.x * gridDim.y * gridDim.z;
    unsigned sum, cnt, mine, sp = 0u;
    for (;;) {
        sum = 0u; cnt = 0u; mine = 0u;
#pragma unroll
        for (unsigned j = 0; j < 16; ++j) { const unsigned c = xb_ld(&bar[XB_XCNT(j)]); sum += c; cnt += (c > 0u) ? 1u : 0u; mine = (j == x) ? c : mine; }
        if (sum == G) break;
        __builtin_amdgcn_s_sleep(1);
        if ((++sp & 255u) == 0u) { if (xb_ld(&bar[XB_TMO])) break; if (sp > XB_SPIN_CAP) { atomicAdd(&bar[XB_TMO], 1u); break; } }
    }
    nloc = mine > 0u ? mine : 1u; nx = cnt > 0u ? cnt : 1u;
}

__device__ __forceinline__ void xcd_barrier(const XcdBarrier& b) {
    asm volatile("s_waitcnt vmcnt(0)" ::: "memory");
    __syncthreads();
    if (threadIdx.x == 0) {
        unsigned* bar = b.bar;
        __builtin_amdgcn_s_waitcnt(0);
        unsigned nloc = b.st[0], nx = b.st[1];
        if (nloc == 0u) { xcd_barrier_complete(bar, b.x, nloc, nx); b.st[0] = nloc; b.st[1] = nx; }
        const unsigned old = xb_add(&bar[XB_XSUB(b.x)], 1u);
        const unsigned gen = old / nloc;
        if (old + 1u == (gen + 1u) * nloc) {
            __builtin_amdgcn_fence(__ATOMIC_RELEASE, "agent");
            asm volatile("s_waitcnt vmcnt(0)" ::: "memory");
            const unsigned og = xb_add(&bar[XB_TOP], 1u);
            const unsigned tg = og / nx;
            if (og + 1u == (tg + 1u) * nx) xb_add(&bar[XB_TOPGEN], 1u);
            else XB_SPIN(xb_ld(&bar[XB_TOPGEN]) == tg, bar);
            __builtin_amdgcn_fence(__ATOMIC_ACQUIRE, "agent");
            xb_add(&bar[XB_XGEN(b.x)], 1u);
            asm volatile("s_waitcnt vmcnt(0)" ::: "memory");
        } else {
            XB_SPIN(xb_ld(&bar[XB_XGEN(b.x)]) == gen, bar);
            __builtin_amdgcn_fence(__ATOMIC_ACQUIRE, "agent");
            asm volatile("s_waitcnt vmcnt(0)" ::: "memory");
        }
    }
    __syncthreads();
}

__device__ __forceinline__ float bf2f(unsigned b) { return __uint_as_float((b & 0xffffu) << 16); }
__device__ __forceinline__ float bflo(unsigned w) { return __uint_as_float(w << 16); }
__device__ __forceinline__ float bfhi(unsigned w) { return __uint_as_float(w & 0xffff0000u); }
__device__ __forceinline__ unsigned f2bf(float f) { unsigned u = __float_as_uint(f); return (u + 0x7fffu + ((u >> 16) & 1u)) >> 16; }
typedef __bf16 bf16x2n __attribute__((ext_vector_type(2)));
typedef float f32x2n __attribute__((ext_vector_type(2)));
__device__ __forceinline__ unsigned pk2(float lo, float hi) { const f32x2n v = {lo, hi}; return __builtin_bit_cast(unsigned, __builtin_convertvector(v, bf16x2n)); }
constexpr float W_SCALE = 256.0f, XS_SCALE = 8.0f, ACT_SCALE = 4.0f, YB_SCALE = 16.0f;
__device__ __forceinline__ float clamp_fp8(float x) { return __builtin_amdgcn_fmed3f(x, -448.0f, 448.0f); }
__device__ __forceinline__ unsigned pk4_fp8(float a, float b, float c, float d) {
    int w = 0; w = __builtin_amdgcn_cvt_pk_fp8_f32(clamp_fp8(a), clamp_fp8(b), w, false); w = __builtin_amdgcn_cvt_pk_fp8_f32(clamp_fp8(c), clamp_fp8(d), w, true); return (unsigned)w; }
__device__ __forceinline__ unsigned pk4_fp8_nc(float a, float b, float c, float d) {
    int w = 0; w = __builtin_amdgcn_cvt_pk_fp8_f32(a, b, w, false); w = __builtin_amdgcn_cvt_pk_fp8_f32(c, d, w, true); return (unsigned)w; }
__device__ __forceinline__ float wave_sum(float v) {
#pragma unroll
    for (int o = 1; o < 64; o <<= 1) v += __shfl_xor(v, o);
    return v;
}
__device__ __forceinline__ float wave_max(float v) {
#pragma unroll
    for (int o = 1; o < 64; o <<= 1) v = fmaxf(v, __shfl_xor(v, o));
    return v;
}
__device__ __forceinline__ float sigmoidf_(float x) { return 1.0f / (1.0f + __expf(-x)); }
__device__ __forceinline__ float fast_sigmoid(float x) { return __builtin_amdgcn_rcpf(1.0f + __builtin_amdgcn_exp2f(-1.4426950408889634f * x)); }
__device__ __forceinline__ float fast_gelu_tanh(float x) { const float u2 = 1.5957691216057308f * (x + 0.044715f * x * x * x); return x * __builtin_amdgcn_rcpf(1.0f + __builtin_amdgcn_exp2f(-1.4426950408889634f * u2)); }
__device__ __forceinline__ float gelu_tanh(float x) { const float u = 0.7978845608028654f * (x + 0.044715f * x * x * x); return 0.5f * x * (1.0f + tanhf(u)); }
__device__ __forceinline__ int tok_row(int b, int t) { return t < NMETA ? METAROW0 + t : b * SEQ + (t - NMETA); }

__device__ __forceinline__ void transpose_item(const float* W, int K, int N, bf16* WT, LAS float* scr, int item, int lane, const float* kgain = nullptr, int kgain_n = 0) {
    const int nblk = N / 32, kb = item / nblk, nb = item % nblk, k0 = 64 * kb, n0 = 32 * nb;
    const int c = lane & 7;
    f32x4 g0 = (f32x4){1.f, 1.f, 1.f, 1.f}, g1 = g0;
    if (kgain != nullptr && k0 < kgain_n) { g0 = *(const f32x4*)(kgain + k0 + 8 * c); g1 = *(const f32x4*)(kgain + k0 + 8 * c + 4); }
#pragma unroll 8
    for (int i = 0; i < 32; ++i) { const int kk = 2 * i + (lane >> 5); scr[kk * 33 + (lane & 31)] = W[(size_t)(k0 + kk) * N + n0 + (lane & 31)]; }
    asm volatile("s_waitcnt lgkmcnt(0)" ::: "memory");
#pragma unroll
    for (int j = 0; j < 4; ++j) { const int n = (lane >> 3) + 8 * j; const LAS float* s = scr + (8 * c) * 33 + n;
        u32x4 o; o.x = pk2(s[0 * 33] * g0.x, s[1 * 33] * g0.y); o.y = pk2(s[2 * 33] * g0.z, s[3 * 33] * g0.w); o.z = pk2(s[4 * 33] * g1.x, s[5 * 33] * g1.y); o.w = pk2(s[6 * 33] * g1.z, s[7 * 33] * g1.w);
        *(u32x4*)(WT + (size_t)(n0 + n) * K + k0 + 8 * c) = o; }
    asm volatile("s_waitcnt lgkmcnt(0)" ::: "memory");
}

#define G1_CONV_WG 104
#define G1_CONV_PER_WG 69
#ifndef BG_G2_TILES
#define BG_G2_TILES 1024
#endif
constexpr int CONV_ALL_TILES = (2 + (BG_WDOWN ? 0 : 1)) * 32 * (D / 128) * (D / 256);
__device__ __forceinline__ int g1_conv_wg() { return gridDim.x == 256 ? G1_CONV_WG : 0; }
__device__ __forceinline__ int conv_pro_tiles() { const int t = CONV_ALL_TILES - BG_G2_TILES - g1_conv_wg() * G1_CONV_PER_WG; return t > 0 ? t : 0; }
static_assert(BG_G2_TILES <= 4096, "tile list split");
__device__ __forceinline__ void conv_tiles(const Args& a, LAS unsigned char* lds, int tid, int first, int last, int stride) {
    unsigned char* ws = a.ws;
    __syncthreads();
    {
        LAS unsigned* T = (LAS unsigned*)lds;
        const int n4 = tid & 63, kq = tid >> 6;
        constexpr int T_IN = G1_FP8 ? (D / 128) * (DIN / 256) : 0, T_OUT = G2_FP8 ? (D / 128) * (D / 256) : 0, T_E = (D / 128) * (D / 256);
        constexpr int N_GATE = 32 * T_E, N_UP = (BG_WUP && !BG_EXP) ? 256 * 6 : 32 * T_E, N_DOWN = (BG_WDOWN && !BG_EXP) ? 0 : 32 * T_E;
        constexpr int NTILES = T_IN + T_OUT + N_GATE + N_UP + N_DOWN;
        static_assert(NTILES == CONV_ALL_TILES, "tile list size");
        auto tile_ptrs = [&](int tile, const float*& sp, unsigned char*& dp, int& ldn) {
            const float* sbase; unsigned char* dbase; int tl, nt;
            if (tile < T_IN) { sbase = a.in[I_W_IN]; dbase = ws + WS_WINT; tl = tile; nt = DIN / 256; ldn = DIN; }
            else if (tile < T_IN + T_OUT) { sbase = a.in[I_W_OUT]; dbase = ws + WS_WOUTT; tl = tile - T_IN; nt = D / 256; ldn = D; }
            else { int r = tile - T_IN - T_OUT, which, e; nt = D / 256; ldn = D;
                   if (r < N_GATE) { which = 0; e = r / T_E; tl = r % T_E; }
                   else if (r < N_GATE + N_UP) { r -= N_GATE; which = 1; int g = r; if (BG_WUP && !BG_EXP) g = 16 * (r / 6) + 10 + (r % 6);
                                                 e = g / T_E; tl = g % T_E; }
                   else { r -= N_GATE + N_UP; which = 2; e = r / T_E; tl = r % T_E; }
                   sbase = a.in[which == 0 ? I_W_GATE : (which == 1 ? I_W_UP : I_W_DOWN)] + (size_t)e * D * D; dbase = ws + (which == 0 ? WS_WGT : (which == 1 ? WS_WUT : WS_WDT)) + (size_t)e * D * D; }
            const int k0 = (tl / nt) * 128, n0 = (tl % nt) * 256;
            sp = sbase + (size_t)(k0 + 4 * kq) * ldn + n0 + 4 * n4; dp = dbase + (size_t)n0 * D + k0; };
#define CONV_LOAD(R, tile) do { const float* _p; unsigned char* _d; int _ld; tile_ptrs(tile, _p, _d, _ld); _Pragma("unroll") for (int i = 0; i < 4; ++i) _Pragma("unroll") for (int q = 0; q < 4; ++q) \
            R[i][q] = __builtin_nontemporal_load((const f32x4*)(_p + (size_t)(32 * i + q) * _ld)); } while (0)
#define CONV_STORE(R, tile) do { _Pragma("unroll") for (int i = 0; i < 4; ++i) { const int kd = kq + 8 * i; \
            T[(4 * n4 + 0) * 33 + kd] = pk4_fp8(R[i][0].x * W_SCALE, R[i][1].x * W_SCALE, R[i][2].x * W_SCALE, R[i][3].x * W_SCALE); \
            T[(4 * n4 + 1) * 33 + kd] = pk4_fp8(R[i][0].y * W_SCALE, R[i][1].y * W_SCALE, R[i][2].y * W_SCALE, R[i][3].y * W_SCALE); \
            T[(4 * n4 + 2) * 33 + kd] = pk4_fp8(R[i][0].z * W_SCALE, R[i][1].z * W_SCALE, R[i][2].z * W_SCALE, R[i][3].z * W_SCALE); \
            T[(4 * n4 + 3) * 33 + kd] = pk4_fp8(R[i][0].w * W_SCALE, R[i][1].w * W_SCALE, R[i][2].w * W_SCALE, R[i][3].w * W_SCALE); } \
            __syncthreads(); \
            { const float* _p; unsigned char* _d; int _ld; tile_ptrs(tile, _p, _d, _ld); _Pragma("unroll") for (int i = 0; i < 4; ++i) { const int n = (tid >> 3) + 64 * i, c = tid & 7; \
                const u32x4 o = (u32x4){T[n * 33 + 4 * c], T[n * 33 + 4 * c + 1], T[n * 33 + 4 * c + 2], T[n * 33 + 4 * c + 3]}; \
                *(u32x4*)(_d + (size_t)n * D + 16 * c) = o; } } \
            __syncthreads(); } while (0)
        f32x4 RA[4][4], RB[4][4];
        int tile = first;
        if (tile < last) CONV_LOAD(RA, tile);
        while (tile < last) {
            int nxt = tile + stride;
            if (nxt < last) CONV_LOAD(RB, nxt);
            CONV_STORE(RA, tile);
            tile = nxt; if (tile >= last) break;
            nxt = tile + stride;
            if (nxt < last) CONV_LOAD(RA, nxt);
            CONV_STORE(RB, tile);
            tile = nxt;
        }
#undef CONV_LOAD
#undef CONV_STORE
    }
}
__device__ __forceinline__ void phase_prologue(const Args& a, LAS unsigned char* lds, int tid, int lane, int wave) {
    const int gw = blockIdx.x * 8 + wave, NGW = gridDim.x * 8;
    const int gt = blockIdx.x * 512 + tid, NGT = gridDim.x * 512;
    unsigned char* ws = a.ws;
    LAS float* scr = (LAS float*)(lds + wave * 8704);
    {
        constexpr int IT_IN = G1_FP8 ? 0 : 32 * (DIN / 32), IT_OUT = G2_FP8 ? 0 : 32 * (D / 32);
        for (int it = gw; it < IT_IN + IT_OUT; it += NGW) {
            if (it < IT_IN) transpose_item(a.in[I_W_IN], D, DIN, (bf16*)(ws + WS_WINT), scr, it, lane, a.in[I_NORM_MIX], D);
            else transpose_item(a.in[I_W_OUT], D, D, (bf16*)(ws + WS_WOUTT), scr, it - IT_IN, lane, a.in[I_G_ATTN], 1024);
        }
        __syncthreads();
    }
    conv_tiles(a, lds, tid, blockIdx.x, conv_pro_tiles(), gridDim.x);
    static_assert(!G1_FP8, "xb is written as bf16");
    for (int r = gw; r < MROWS; r += NGW) {
        u32x4* orow = (u32x4*)((bf16*)(ws + WS_N1) + (size_t)r * D);
        if (r >= MVALID) {
#pragma unroll
            for (int j = 0; j < 4; ++j) orow[lane + 64 * j] = (u32x4){0u, 0u, 0u, 0u};
            if (lane == 0) ((float*)(ws + WS_RSTD1))[r] = 0.f;
            continue; }
        const f32x4* xr = (const f32x4*)(r < MREAL ? a.in[I_X] + (size_t)r * D : a.in[I_META] + (size_t)(r - MREAL) * D);
        f32x4 v[4][2]; float ss = 0.f;
#pragma unroll
        for (int j = 0; j < 4; ++j)
#pragma unroll
            for (int q = 0; q < 2; ++q) { v[j][q] = xr[2 * (lane + 64 * j) + q]; ss += (v[j][q].x * v[j][q].x + v[j][q].y * v[j][q].y) + (v[j][q].z * v[j][q].z + v[j][q].w * v[j][q].w); }
#pragma unroll
        for (int j = 0; j < 4; ++j) orow[lane + 64 * j] = (u32x4){pk2(v[j][0].x, v[j][0].y), pk2(v[j][0].z, v[j][0].w), pk2(v[j][1].x, v[j][1].y), pk2(v[j][1].z, v[j][1].w)};
        ss = wave_sum(ss);
        if (lane == 0) ((float*)(ws + WS_RSTD1))[r] = 1.0f / sqrtf(ss * (1.0f / D) + EPS);
    }
    float* cosT = (float*)(ws + WS_COS); float* sinT = (float*)(ws + WS_SIN);
    for (int i = gt; i < TT * 32; i += NGT) {
        const int pos = i >> 5, j = i & 31;
        const float ang = (float)pos * c_inv_freq[j];
        const double t = (double)ang * 0.15915494309189535; const float fr = (float)(t - floor(t));
        cosT[i] = __builtin_amdgcn_cosf(fr); sinT[i] = __builtin_amdgcn_sinf(fr);
    }
    { bf16* WaT = (bf16*)(ws + WS_WAT); bf16* WiT = (bf16*)(ws + WS_WIT);
      for (int i = gt; i < 16 * 64 * 64; i += NGT) { const int n = i >> 12, d = (i >> 6) & 63, cc = i & 63;
          WaT[i] = (bf16)f2bf(a.in[I_W_A][(n * 64 + cc) * 64 + d]); WiT[i] = (bf16)f2bf(a.in[I_W_I][(n * 64 + cc) * 64 + d]); } }
    { bf16* WRT = (bf16*)(ws + WS_WRT);
      for (int i = gt; i < NEXP * D; i += NGT) { const int e = i >> 11, k = i & 2047; WRT[i] = (bf16)f2bf(a.in[I_NORM_FFN][k] * a.in[I_W_ROUTER][k * NEXP + e]); } }
    int* rowpair = (int*)(ws + WS_ROWPAIR);
    for (int i = gt; i < PROWS; i += NGT) rowpair[i] = -1;
}

namespace pg8 {
constexpr int BM = 256, BK = 64, HALF = 128, HTB = HALF * BK * 2, STAGE_BYTES = 8 * HTB, NXCD = 8, KD = 2048, NKT = KD / BK;
__host__ __device__ __forceinline__ int lds_byte(int r, int c) { const int st = (r >> 4) * 2 + (c >> 5), rr = r & 15, cc = c & 31, ob = rr * 64 + cc * 2; return st * 1024 + (ob ^ (((ob >> 9) & 1) << 5)); }
__host__ __device__ __forceinline__ void stage_rc(int b, int& R, int& C) { const int st = b / 1024, sb = b % 1024, swz = sb ^ (((sb >> 9) & 1) << 5); R = (st >> 1) * 16 + swz / 64; C = (st & 1) * 32 + (swz % 64) / 2; }
__host__ __device__ __forceinline__ int perm32(int rho) { const int n = rho >> 4, i = rho & 15; return 8 * (i >> 2) + 4 * n + (i & 3); }
struct Unit { unsigned a, b0, b1; int pm, pn, e; };
template <int WGM_LOG>
__device__ __forceinline__ bool static_tile(int i, int G, int c, int nM, int nN, int& pm, int& pn) {
    constexpr int WGM = 1 << WGM_LOG;
    const int nwg = nM * nN; const long L = (long)i * G + c; if (L >= nwg) return false;
    int wgid = (int)L; { const int q = nwg >> 3, r = nwg & 7, xcd = wgid & 7, off = wgid >> 3; wgid = (xcd < r ? xcd * (q + 1) : r * (q + 1) + (xcd - r) * q) + off; }
    const int nig = WGM * nN; int gid, rem;
    if ((nN & (nN - 1)) == 0) { const int sh = WGM_LOG + (31 - __builtin_clz(nN)); gid = wgid >> sh; rem = wgid & (nig - 1); } else { gid = wgid / nig; rem = wgid - gid * nig; }
    const int fm = gid * WGM, gsz = (nM - fm) < WGM ? (nM - fm) : WGM;
    if (gsz == WGM) { pm = fm + (rem & (WGM - 1)); pn = rem >> WGM_LOG; } else { pm = fm + rem % gsz; pn = rem / gsz; }
    return true;
}

typedef int i32x8 __attribute__((ext_vector_type(8)));
typedef int i32x4 __attribute__((ext_vector_type(4)));
__device__ __forceinline__ i32x8 cat8(bf16x8 lo, bf16x8 hi) { const i32x4 a = __builtin_bit_cast(i32x4, lo), b = __builtin_bit_cast(i32x4, hi); return __builtin_shufflevector(a, b, 0, 1, 2, 3, 4, 5, 6, 7); }
struct BGNone { static constexpr bool ON = false; };
struct BGConv { static constexpr bool ON = true; const char* src; unsigned char* dst; int next, end; unsigned char* dummy; };
__device__ __forceinline__ void bg_pair_ptrs(const BGConv& bg, int pair, const char*& sp, unsigned char*& dp) {
    const int e = pair >> 10, kbp = (pair >> 6) & 15, nb = pair & 63;
    sp = bg.src + ((size_t)(e * 2048 + 128 * kbp) * 2048 + 32 * nb) * 4; dp = bg.dst + (size_t)e * 2048 * 2048 + (size_t)(32 * nb) * 2048 + 128 * kbp; }
template <bool FP8, class Epi, class Sched, class BG, bool GATHER = false>
__device__ __forceinline__ void gemm_phase(LAS unsigned char* lds, const Sched& S, const Epi& E, BG& bg) {
    constexpr int ROWB = FP8 ? 2048 : 4096, NKTL = ROWB / 128;
    const int tid = threadIdx.x, wid = __builtin_amdgcn_readfirstlane(tid >> 6), lane = tid & 63, wr = wid >> 2, wc = wid & 3, fr = lane & 15, fq = lane >> 4;
    unsigned voffA[2], voffB[2];
#pragma unroll
    for (int i = 0; i < 2; ++i) { int R, C; stage_rc(tid * 16 + i * 8192, R, C); const int Rb = Epi::PERM ? ((R & ~31) + perm32(R & 31)) : R;
        voffA[i] = (unsigned)(R * ROWB + C * 2); voffB[i] = (unsigned)(Rb * ROWB + C * 2); }
    constexpr unsigned KS = BK * 2, HS = HALF * ROWB;
    const unsigned ldsw = (unsigned)wid * 1024u;
    const __amdgpu_buffer_rsrc_t rsA = __builtin_amdgcn_make_buffer_rsrc((void*)S.A, 0, 0x7ffffff0, 0x00020000), rsB0 = __builtin_amdgcn_make_buffer_rsrc((void*)S.B0, 0, 0x7ffffff0, 0x00020000), rsB1 = __builtin_amdgcn_make_buffer_rsrc((void*)S.B1, 0, 0x7ffffff0, 0x00020000);
    const int aoff = lds_byte(wr * 64 + fr, fq * 8), boff = lds_byte(wc * 32 + fr, fq * 8);
#define PG8_SA(b, h) (((b) * 2 + (h)) * HTB)
#define PG8_SB(b, h) ((4 + (b) * 2 + (h)) * HTB)
#define PG8_STAGE(bufoff, rs, soff, voff) do { _Pragma("unroll") for (int _i = 0; _i < 2; ++_i) \
        __builtin_amdgcn_raw_ptr_buffer_load_lds(rs, (LAS void*)(lds + (bufoff) + ldsw + _i * 8192), 16, (int)(voff)[_i], (int)(soff), 0, 0); } while (0)
    unsigned gA[2][2] = {{0u, 0u}, {0u, 0u}}, gN[2][2] = {{0u, 0u}, {0u, 0u}};
#define PG8_GOFF(dst, slot) do { int tz_ = threadIdx.x; asm volatile("" : "+v"(tz_)); _Pragma("unroll") for (int _i = 0; _i < 2; ++_i) { int R_, C_; stage_rc(tz_ * 16 + _i * 8192, R_, C_); \
        _Pragma("unroll") for (int _h = 0; _h < 2; ++_h) { const int id_ = *(const LAS int*)(lds + LDS_RID + (slot) * 1024 + (_h * 128 + R_) * 4); dst[_h][_i] = (unsigned)((id_ < 0 ? 0 : (id_ >> 2)) * ROWB + C_ * 2); } } } while (0)
#define PG8_STAGEA(bufoff, h, soff_dense, koff, nx) do { if constexpr (GATHER) { unsigned v_[2]; v_[0] = (nx) ? gN[h][0] : gA[h][0]; v_[1] = (nx) ? gN[h][1] : gA[h][1]; PG8_STAGE(bufoff, rsA, koff, v_); } \
        else PG8_STAGE(bufoff, rsA, (soff_dense) + (h) * HS, voffA); } while (0)
#define PG8_LDA(dst, b, h) do { _Pragma("unroll") for (int m = 0; m < 4; ++m) { \
        if constexpr (FP8) dst##8[m] = __builtin_shufflevector(*(const LAS i32x4*)(lds + PG8_SA(b, h) + aoff + m * 2048), *(const LAS i32x4*)(lds + PG8_SA(b, h) + aoff + m * 2048 + 1024), 0, 1, 2, 3, 4, 5, 6, 7); \
        else { _Pragma("unroll") for (int k = 0; k < 2; ++k) dst[m][k] = *(const LAS bf16x8*)(lds + PG8_SA(b, h) + aoff + m * 2048 + k * 1024); } } } while (0)
#define PG8_LDB(dst, b, h) do { _Pragma("unroll") for (int n = 0; n < 2; ++n) { \
        if constexpr (FP8) dst##8[n] = __builtin_shufflevector(*(const LAS i32x4*)(lds + PG8_SB(b, h) + boff + n * 2048), *(const LAS i32x4*)(lds + PG8_SB(b, h) + boff + n * 2048 + 1024), 0, 1, 2, 3, 4, 5, 6, 7); \
        else { _Pragma("unroll") for (int k = 0; k < 2; ++k) dst[n][k] = *(const LAS bf16x8*)(lds + PG8_SB(b, h) + boff + n * 2048 + k * 1024); } } } while (0)
#define PG8_MMA(ai, bj, At, Bt) do { _Pragma("unroll") for (int m = 0; m < 4; ++m) _Pragma("unroll") for (int n = 0; n < 2; ++n) { \
        if constexpr (FP8) asm volatile("v_mfma_f32_16x16x128_f8f6f4 %0, %1, %2, %0" : "+v"(acc[ai][bj][m][n]) : "v"(Bt##8[n]), "v"(At##8[m])); \
        else { _Pragma("unroll") for (int k = 0; k < 2; ++k) asm volatile("v_mfma_f32_16x16x32_bf16 %0, %1, %2, %0" : "+v"(acc[ai][bj][m][n]) : "v"(Bt[n][k]), "v"(At[m][k])); } } \
        } while (0)
#define PG8_WAIT_V(n) asm volatile("s_waitcnt vmcnt(" #n ")" ::: "memory")
#define PG8_WAIT_L(n) asm volatile("s_waitcnt lgkmcnt(" #n ")" ::: "memory")
#define PG8_BAR __builtin_amdgcn_s_barrier()
#define PG8_SCHED __builtin_amdgcn_sched_barrier(0)
    Unit cur, nxt; int ui = 0; bool bg_pending = false;
    if (!S.next(0, cur)) return;
    f32x4 acc[2][2][4][2];
#pragma unroll
    for (int a = 0; a < 2; ++a)
#pragma unroll
        for (int b = 0; b < 2; ++b)
#pragma unroll
            for (int m = 0; m < 4; ++m)
#pragma unroll
                for (int n = 0; n < 2; ++n) acc[a][b][m][n] = (f32x4){0.f, 0.f, 0.f, 0.f};
    bf16x8 At[4][2], B0[2][2], B1[2][2];
    i32x8 At8[4], B08[2], B18[2];
    if constexpr (GATHER) {
        if (tid < 256) *(LAS int*)(lds + LDS_RID + tid * 4) = S.rows[cur.pm * BM + tid];
        __syncthreads();
        PG8_GOFF(gA, 0);
    }
    PG8_STAGE(PG8_SB(0, 0), rsB0, cur.b0, voffB); PG8_STAGE(PG8_SB(0, 1), rsB1, cur.b1, voffB); PG8_STAGEA(PG8_SA(0, 0), 0, cur.a, 0u, false); PG8_STAGEA(PG8_SA(0, 1), 1, cur.a, 0u, false);
    if (wr == 1) PG8_BAR;
    PG8_WAIT_V(2); PG8_BAR;
    PG8_STAGE(PG8_SB(1, 0), rsB0, cur.b0 + KS, voffB); PG8_STAGEA(PG8_SA(1, 0), 0, cur.a + KS, KS, false); PG8_STAGE(PG8_SB(1, 1), rsB1, cur.b1 + KS, voffB);
    PG8_WAIT_V(6); PG8_BAR;
    for (;;) {
        const bool has_next = S.next(ui + 1, nxt);
        const unsigned nA = has_next ? nxt.a : cur.a, nB0 = has_next ? nxt.b0 : cur.b0, nB1 = has_next ? nxt.b1 : cur.b1;
        for (int t = 0; t < NKTL; t += 2) {
            const bool last = (t == NKTL - 2);
            if constexpr (Epi::MIDK_T >= 0) { if (t == Epi::MIDK_T) {
                PG8_SCHED; asm volatile("s_nop 15\n\ts_nop 15" ::: "memory"); PG8_SCHED; E.midk(acc, cur, wr, fr, lds); PG8_SCHED; asm volatile("s_nop 15" ::: "memory"); PG8_SCHED; } }
            const unsigned a1 = cur.a + (unsigned)(t + 1) * KS;
            const unsigned a2 = last ? nA : cur.a + (unsigned)(t + 2) * KS;
            const unsigned b20 = last ? nB0 : cur.b0 + (unsigned)(t + 2) * KS, b21 = last ? nB1 : cur.b1 + (unsigned)(t + 2) * KS;
            const unsigned a3 = a2 + KS, b30 = b20 + KS, b31 = b21 + KS;
            const unsigned k1 = (unsigned)(t + 1) * KS, k2 = last ? 0u : (unsigned)(t + 2) * KS;
            if constexpr (GATHER) { if (last) { if (has_next) PG8_GOFF(gN, (ui + 1) & 1); else { gN[0][0] = gA[0][0]; gN[0][1] = gA[0][1]; gN[1][0] = gA[1][0]; gN[1][1] = gA[1][1]; } } }
            PG8_LDB(B0, 0, 0); PG8_LDB(B1, 0, 1); PG8_SCHED; PG8_LDA(At, 0, 0); PG8_STAGEA(PG8_SA(1, 1), 1, a1, k1, false);
            if constexpr (GATHER) { if (t == 2 && has_next && wid == 3) __builtin_amdgcn_global_load_lds((const unsigned*)(S.rows + nxt.pm * BM + lane * 4), (LAS unsigned*)(lds + LDS_RID + ((ui + 1) & 1) * 1024), 16, 0, 0); }
            if (t == 2) E.prefetch(cur, lds, wid, lane);
            PG8_WAIT_V(8); PG8_WAIT_L(0); PG8_BAR; PG8_MMA(0, 0, At, B0);
            if constexpr (BG::ON) {
                PG8_SCHED;
                int tz = threadIdx.x; asm volatile("" : "+v"(tz));
#pragma unroll
                for (int j = 0; j < (BG_EXP == 1 ? 0 : 2); ++j) { const LAS float* p = (const LAS float*)(lds + LDS_BG + j * 8192 + (tz >> 5) * 512 + (tz & 31) * 4);
                    ((LAS unsigned*)(lds + LDS_T2))[(tz & 31) * 33 + 16 * j + (tz >> 5)] = pk4_fp8(p[0] * W_SCALE, p[32] * W_SCALE, p[64] * W_SCALE, p[96] * W_SCALE); }
                const char* bgs; { unsigned char* dp_; pg8::bg_pair_ptrs(bg, bg.next < bg.end ? bg.next : bg.end - 1, bgs, dp_); }
                PG8_SCHED;
                if (BG_EXP != 2) {
                const unsigned bgv = (unsigned)((8 * wid + ((tz & 63) >> 3)) * 8192 + (tz & 7) * 16);
                __builtin_amdgcn_global_load_lds((const unsigned*)(bgs + bgv), (LAS unsigned*)(lds + LDS_BG + ldsw), 16, 0, 0);
                __builtin_amdgcn_global_load_lds((const unsigned*)(bgs + 524288 + bgv), (LAS unsigned*)(lds + LDS_BG + 8192 + ldsw), 16, 0, 0); }
                PG8_SCHED; }
            PG8_MMA(0, 1, At, B1);
            if constexpr (BG::ON) { PG8_WAIT_L(0); }
            PG8_BAR; PG8_SCHED;
            PG8_LDA(At, 0, 1); PG8_STAGE(PG8_SB(0, 0), rsB0, b20, voffB); PG8_STAGE(PG8_SB(0, 1), rsB1, b21, voffB); PG8_STAGEA(PG8_SA(0, 0), 0, a2, k2, last);
            if constexpr (BG::ON) { if (BG_EXP == 2) PG8_WAIT_V(8); else PG8_WAIT_V(10); } else { PG8_WAIT_V(8); }
            PG8_WAIT_L(0); PG8_BAR; PG8_MMA(1, 0, At, B0);
            if constexpr (BG::ON) {
                PG8_SCHED;
                unsigned char* bgd; { const char* sp_; pg8::bg_pair_ptrs(bg, bg.next - 1 < bg.end ? bg.next - 1 : bg.end - 1, sp_, bgd); }
                int tz = threadIdx.x; asm volatile("" : "+v"(tz));
                const LAS unsigned* q = (const LAS unsigned*)(lds + LDS_T2) + (tz >> 4) * 33 + 2 * (tz & 15);
                const u32x2 w = (u32x2){q[0], q[1]};
                if (BG_EXP != 1) *(u32x2*)((bg_pending && !BG_EXP) ? bgd + (size_t)(tz >> 4) * 2048 + 8 * (tz & 15) : bg.dummy + 8 * tz) = w;
                ++bg.next; bg_pending = true;
                PG8_SCHED; }
            PG8_MMA(1, 1, At, B1); PG8_BAR; PG8_SCHED;
            PG8_LDB(B0, 1, 0); PG8_LDB(B1, 1, 1); PG8_SCHED; PG8_LDA(At, 1, 0); PG8_STAGEA(PG8_SA(0, 1), 1, a2, k2, last);
            if constexpr (BG::ON) { if (BG_EXP == 1) PG8_WAIT_V(10); else if (BG_EXP == 2) PG8_WAIT_V(9); else PG8_WAIT_V(11); } else { PG8_WAIT_V(8); }
            PG8_WAIT_L(0); PG8_BAR; PG8_MMA(0, 0, At, B0); PG8_MMA(0, 1, At, B1); PG8_BAR; PG8_SCHED;
            PG8_LDA(At, 1, 1); PG8_STAGE(PG8_SB(1, 0), rsB0, b30, voffB); PG8_STAGE(PG8_SB(1, 1), rsB1, b31, voffB); PG8_STAGEA(PG8_SA(1, 0), 0, a3, k2 + KS, last);
            if constexpr (BG::ON) { if (BG_EXP == 1) PG8_WAIT_V(8); else PG8_WAIT_V(9); } else { PG8_WAIT_V(8); }
            PG8_WAIT_L(0); PG8_BAR; PG8_MMA(1, 0, At, B0); PG8_MMA(1, 1, At, B1); PG8_BAR; PG8_SCHED;
        }
        if (wr == 0) PG8_BAR;
        asm volatile("s_nop 15\n\ts_nop 15" ::: "memory");
        E(acc, cur, wr, wc, fr, fq, lds);
        if (!has_next) break;
#pragma unroll
        for (int a = 0; a < 2; ++a)
#pragma unroll
            for (int b = 0; b < 2; ++b)
#pragma unroll
                for (int m = 0; m < 4; ++m)
#pragma unroll
                    for (int n = 0; n < 2; ++n) acc[a][b][m][n] = (f32x4){0.f, 0.f, 0.f, 0.f};
        cur = nxt; ++ui;
        if constexpr (GATHER) { gA[0][0] = gN[0][0]; gA[0][1] = gN[0][1]; gA[1][0] = gN[1][0]; gA[1][1] = gN[1][1]; }
        if (wr == 1) PG8_BAR;
    }
    PG8_WAIT_V(0);
    PG8_BAR;
    if constexpr (BG::ON) { if (bg_pending && !BG_EXP) {
        unsigned char* bgd; { const char* sp_; pg8::bg_pair_ptrs(bg, bg.next - 1 < bg.end ? bg.next - 1 : bg.end - 1, sp_, bgd); }
#pragma unroll
        for (int j = 0; j < 2; ++j) { const LAS float* p = (const LAS float*)(lds + LDS_BG + j * 8192 + (tid >> 5) * 512 + (tid & 31) * 4);
            ((LAS unsigned*)(lds + LDS_T2))[(tid & 31) * 33 + 16 * j + (tid >> 5)] = pk4_fp8(p[0] * W_SCALE, p[32] * W_SCALE, p[64] * W_SCALE, p[96] * W_SCALE); }
        __syncthreads();
        const LAS unsigned* q = (const LAS unsigned*)(lds + LDS_T2) + (tid >> 4) * 33 + 2 * (tid & 15);
        *(u32x2*)(bgd + (size_t)(tid >> 4) * 2048 + 8 * (tid & 15)) = (u32x2){q[0], q[1]}; } }
#undef PG8_SA
#undef PG8_SB
#undef PG8_STAGE
#undef PG8_STAGEA
#undef PG8_GOFF
#undef PG8_LDA
#undef PG8_LDB
#undef PG8_MMA
#undef PG8_WAIT_V
#undef PG8_WAIT_L
#undef PG8_BAR
#undef PG8_SCHED
}

struct SchedDense {
    const char* A; const char* B0; const char* B1; const int* rows; int nM, nN, G, c, rowb;
    __device__ __forceinline__ bool next(int i, Unit& u) const {
        int pm, pn; if (!static_tile<1>(i, G, c, nM, nN, pm, pn)) return false;
        u.pm = pm; u.pn = pn; u.e = 0; u.a = (unsigned)pm * BM * rowb; u.b0 = (unsigned)pn * BM * rowb; u.b1 = u.b0 + (unsigned)HALF * rowb; return true;
    }
};
struct SchedMoE {
    const char* A; const char* B0; const char* B1; const int* rows; const LAS int* tstart; int nM, nN, G, c; bool split;
    __device__ __forceinline__ bool next(int i, Unit& u) const {
        int pm, pn; if (!static_tile<2>(i, G, c, nM, nN, pm, pn)) return false;
        const int e = ((const LAS unsigned char*)(tstart + 64))[pm];
        u.pm = pm; u.pn = pn; u.e = e; u.a = (unsigned)pm * (BM * 2048);
        const unsigned eoff = (unsigned)e * (2048u * 2048u);
        if (split) { u.b0 = eoff + (unsigned)pn * (HALF * 2048); u.b1 = u.b0; }
        else { u.b0 = eoff + (unsigned)pn * (BM * 2048); u.b1 = u.b0 + (unsigned)HALF * 2048; }
        return true;
    }
};

__device__ __forceinline__ u32x4 widen16(u32x2 x, u32x2 y) {
    const auto r0 = __builtin_amdgcn_permlane16_swap(x.x, y.x, false, false), r1 = __builtin_amdgcn_permlane16_swap(x.y, y.y, false, false);
    return (u32x4){r0[0], r1[0], r0[1], r1[1]};
}
struct EpiZ {
    static constexpr bool PERM = true; static constexpr int MIDK_T = -1;
    bf16* Z; const float* bias; const float* rstd1;
    __device__ __forceinline__ void prefetch(const Unit& u, LAS unsigned char* lds, int wid, int lane) const {
        if (wid == 0) __builtin_amdgcn_global_load_lds((const unsigned*)(rstd1 + u.pm * BM + lane * 4), (LAS unsigned*)(lds + LDS_META), 16, 0, 0);
    }
    __device__ __forceinline__ void operator()(const f32x4 (&acc)[2][2][4][2], const Unit& u, int wr, int wc, int fr, int fq, const LAS unsigned char* lds) const {
        const int row0 = u.pm * BM + wr * 64 + fr, col0 = u.pn * BM + wc * 32 + 8 * fq;
        f32x4 bv[2][2];
#pragma unroll
        for (int bj = 0; bj < 2; ++bj)
#pragma unroll
            for (int n = 0; n < 2; ++n) bv[bj][n] = *(const f32x4*)(bias + col0 + bj * HALF + 4 * n);
#pragma unroll
        for (int ai = 0; ai < 2; ++ai)
#pragma unroll
            for (int m = 0; m < 4; ++m) { bf16* rowp = Z + (size_t)(row0 + ai * HALF + m * 16) * DIN + col0;
                const float sc = ((const LAS float*)(lds + LDS_META))[ai * HALF + wr * 64 + m * 16 + fr];
#pragma unroll
                for (int bj = 0; bj < 2; ++bj) { const f32x4 v0 = acc[ai][bj][m][0] * sc + bv[bj][0], v1 = acc[ai][bj][m][1] * sc + bv[bj][1];
                    u32x4 w; w.x = pk2(v0[0], v0[1]); w.y = pk2(v0[2], v0[3]); w.z = pk2(v1[0], v1[1]); w.w = pk2(v1[2], v1[3]);
                    *(u32x4*)(rowp + bj * HALF) = w; } }
    }
};
struct EpiH1 {
    static constexpr bool PERM = true;
    static constexpr int MIDK_T = 16;
    bf16* H1; const bf16* x; const float* bias; float sc; const float* ssq;
    __device__ __forceinline__ void prefetch(const Unit& u, LAS unsigned char* lds, int wid, int lane) const {
        if (wid < 4) __builtin_amdgcn_global_load_lds((const unsigned*)(ssq + (size_t)(u.pm * BM + wid * 64 + lane) * 4), (LAS unsigned*)(lds + LDS_META + wid * 1024), 16, 0, 0);
    }
    __device__ __forceinline__ void midk(f32x4 (&acc)[2][2][4][2], const Unit& u, int wr, int fr, const LAS unsigned char* lds) const {
        f32x4 s[2][4];
#pragma unroll
        for (int ai = 0; ai < 2; ++ai)
#pragma unroll
            for (int m = 0; m < 4; ++m) s[ai][m] = *(const LAS f32x4*)(lds + LDS_META + (ai * HALF + wr * 64 + m * 16 + fr) * 16);
#pragma unroll
        for (int ai = 0; ai < 2; ++ai)
#pragma unroll
            for (int m = 0; m < 4; ++m) { const float r = __builtin_amdgcn_rsqf(((s[ai][m].x + s[ai][m].y) + (s[ai][m].z + s[ai][m].w)) * (1.0f / 1024.0f) + EPS);
#pragma unroll
                for (int bj = 0; bj < 2; ++bj)
#pragma unroll
                    for (int n = 0; n < 2; ++n) acc[ai][bj][m][n] = acc[ai][bj][m][n] * r; }
    }
    __device__ __forceinline__ void operator()(const f32x4 (&acc)[2][2][4][2], const Unit& u, int wr, int wc, int fr, int fq, const LAS unsigned char*) const {
        const int row0 = u.pm * BM + wr * 64 + fr, col0 = u.pn * BM + wc * 32 + 8 * fq;
        f32x4 bv[2][2];
#pragma unroll
        for (int bj = 0; bj < 2; ++bj)
#pragma unroll
            for (int n = 0; n < 2; ++n) bv[bj][n] = *(const f32x4*)(bias + col0 + bj * HALF + 4 * n);
#pragma unroll
        for (int ai = 0; ai < 2; ++ai) {
            u32x4 xv[4][2];
#pragma unroll
            for (int m = 0; m < 4; ++m) { const size_t ro = (size_t)(row0 + ai * HALF + m * 16) * D + col0;
#pragma unroll
                for (int bj = 0; bj < 2; ++bj) xv[m][bj] = __builtin_nontemporal_load((const u32x4*)(x + ro + bj * HALF)); }
#pragma unroll
            for (int m = 0; m < 4; ++m) { const size_t ro = (size_t)(row0 + ai * HALF + m * 16) * D + col0;
#pragma unroll
                for (int bj = 0; bj < 2; ++bj) { const u32x4 xx = xv[m][bj];
                    const f32x4 v0 = (f32x4){bflo(xx[0]), bfhi(xx[0]), bflo(xx[1]), bfhi(xx[1])} + acc[ai][bj][m][0] * sc + bv[bj][0], v1 = (f32x4){bflo(xx[2]), bfhi(xx[2]), bflo(xx[3]), bfhi(xx[3])} + acc[ai][bj][m][1] * sc + bv[bj][1];
                    u32x4 w; w.x = pk2(v0[0], v0[1]); w.y = pk2(v0[2], v0[3]); w.z = pk2(v1[0], v1[1]); w.w = pk2(v1[2], v1[3]);
                    *(u32x4*)(H1 + ro + bj * HALF) = w; } }
        }
    }
};
struct EpiAct {
    static constexpr bool PERM = true; static constexpr int MIDK_T = -1;
    unsigned char* ACT; const float* bg; const float* bu;
    __device__ __forceinline__ void prefetch(const Unit& u, LAS unsigned char* lds, int wid, int lane) const {
        if (wid == 0) { const float* p = (lane < 32 ? bg : bu) + (size_t)u.e * DFF + u.pn * HALF + (lane & 31) * 4;
            __builtin_amdgcn_global_load_lds((const unsigned*)p, (LAS unsigned*)(lds + LDS_META), 16, 0, 0); }
    }
    __device__ __forceinline__ void operator()(const f32x4 (&acc)[2][2][4][2], const Unit& u, int wr, int wc, int fr, int fq, const LAS unsigned char* lds) const {
        const int row0 = u.pm * BM + wr * 64 + fr, cl = wc * 32 + 8 * fq, col0 = u.pn * HALF + cl;
        f32x4 gv[2], uv[2];
#pragma unroll
        for (int n = 0; n < 2; ++n) { gv[n] = *(const LAS f32x4*)(lds + LDS_META + (cl + 4 * n) * 4); uv[n] = *(const LAS f32x4*)(lds + LDS_META + 512 + (cl + 4 * n) * 4); }
#pragma unroll
        for (int ai = 0; ai < 2; ++ai)
#pragma unroll
            for (int mp = 0; mp < 2; ++mp) { u32x2 pc[2];
#pragma unroll
                for (int mi = 0; mi < 2; ++mi) { const int m = 2 * mp + mi; float r[8];
#pragma unroll
                    for (int n = 0; n < 2; ++n)
#pragma unroll
                        for (int j = 0; j < 4; ++j) { float g = acc[ai][0][m][n][j] * (1.0f / (W_SCALE * XS_SCALE)) + gv[n][j], up = acc[ai][1][m][n][j] * (1.0f / (W_SCALE * XS_SCALE)) + uv[n][j];
                            g = fminf(g, 7.0f); up = fminf(fmaxf(up, -7.0f), 7.0f);
                            r[n * 4 + j] = g * __builtin_amdgcn_rcpf(1.0f + __builtin_amdgcn_exp2f((-1.702f * 1.4426950408889634f) * g)) * fmaf(up, ACT_SCALE, ACT_SCALE); }
                    pc[mi] = (u32x2){pk4_fp8_nc(r[0], r[1], r[2], r[3]), pk4_fp8_nc(r[4], r[5], r[6], r[7])}; }
                const u32x4 w = widen16(pc[0], pc[1]);
                const int m = 2 * mp + (fq & 1);
                *(u32x4*)(ACT + (size_t)(row0 + ai * HALF + m * 16) * DFF + col0 - 8 * (fq & 1)) = w; }
    }
};
struct EpiDown {
    static constexpr bool PERM = true; static constexpr int MIDK_T = -1;
    unsigned char* YB; const float* bd;
    __device__ __forceinline__ void prefetch(const Unit& u, LAS unsigned char* lds, int wid, int lane) const {
        if (wid == 0) __builtin_amdgcn_global_load_lds((const unsigned*)(bd + (size_t)u.e * D + u.pn * BM + lane * 4), (LAS unsigned*)(lds + LDS_META), 16, 0, 0);
    }
    __device__ __forceinline__ void operator()(const f32x4 (&acc)[2][2][4][2], const Unit& u, int wr, int wc, int fr, int fq, const LAS unsigned char* lds) const {
        const int row0 = u.pm * BM + wr * 64 + fr, cl = wc * 32 + 8 * fq, col0 = u.pn * BM + cl;
        f32x4 bv[2][2];
#pragma unroll
        for (int bj = 0; bj < 2; ++bj)
#pragma unroll
            for (int n = 0; n < 2; ++n) bv[bj][n] = *(const LAS f32x4*)(lds + LDS_META + (cl + bj * HALF + 4 * n) * 4) * YB_SCALE;
#pragma unroll
        for (int ai = 0; ai < 2; ++ai)
#pragma unroll
            for (int m = 0; m < 4; ++m) { u32x2 pc[2];
#pragma unroll
                for (int bj = 0; bj < 2; ++bj) { const f32x4 v0 = acc[ai][bj][m][0] * (YB_SCALE / (W_SCALE * ACT_SCALE)) + bv[bj][0], v1 = acc[ai][bj][m][1] * (YB_SCALE / (W_SCALE * ACT_SCALE)) + bv[bj][1];
                    pc[bj] = (u32x2){pk4_fp8(v0[0], v0[1], v0[2], v0[3]), pk4_fp8(v1[0], v1[1], v1[2], v1[3])}; }
                const u32x4 w = widen16(pc[0], pc[1]);
                *(u32x4*)(YB + (size_t)(row0 + ai * HALF + m * 16) * D + col0 + (fq & 1) * (HALF - 8)) = w; }
    }
};
}


typedef float f32x16 __attribute__((ext_vector_type(16)));
constexpr int AT_KS = 144, AT_VS = 584, AT_KOFF = 0, AT_VOFF = 288 * AT_KS;

__device__ __forceinline__ void attn_tile(LAS unsigned char* lds, int slot_base, int kind, int j, int lane, int hq,
                                          const bf16x8 (&qf)[2][4], f32x16 (&oacc)[2][2], float (&mrow)[2], float (&lrow)[2]) {
    const int r31 = lane & 31, h = lane >> 5;
    bf16x8 kf[4], vf[2][2];
#pragma unroll
    for (int ks = 0; ks < 4; ++ks) kf[ks] = *(const LAS bf16x8*)(lds + AT_KOFF + (slot_base + r31) * AT_KS + (16 * ks + 8 * h) * 2);
#pragma unroll
    for (int dt = 0; dt < 2; ++dt)
#pragma unroll
        for (int sp = 0; sp < 2; ++sp) { const LAS unsigned char* p = lds + AT_VOFF + (32 * dt + r31) * AT_VS + (slot_base + 16 * sp + 4 * h) * 2;
            const u32x2 lo = *(const LAS u32x2*)p, hi = *(const LAS u32x2*)(p + 16);
            const u32x4 w = (u32x4){lo.x, lo.y, hi.x, hi.y}; vf[dt][sp] = __builtin_bit_cast(bf16x8, w); }
#pragma unroll
    for (int qt = 0; qt < 2; ++qt) {
        const int dg = 2 * hq + qt;
        if ((kind == 2 && j > dg) || (kind == 1 && j < dg)) continue;
        f32x16 s;
#pragma unroll
        for (int r = 0; r < 16; ++r) s[r] = 0.f;
#pragma unroll
        for (int ks = 0; ks < 4; ++ks) s = __builtin_amdgcn_mfma_f32_32x32x16_bf16(kf[ks], qf[qt][ks], s, 0, 0, 0);
        if (kind == 0) {
#pragma unroll
            for (int r = 0; r < 16; ++r) { const int key = (r & 3) + 8 * (r >> 2) + 4 * h; s[r] = key < 16 ? s[r] : -1.0e30f; }
        } else if (j == dg) {
            const int i = 32 * qt + r31 - 32 * (j - 2 * hq);
#pragma unroll
            for (int r = 0; r < 16; ++r) { const int key = (r & 3) + 8 * (r >> 2) + 4 * h;
                const bool ok = kind == 1 ? (key >= i + 1) : (key <= i);
                s[r] = ok ? s[r] : -1.0e30f; }
        }
        float mx = s[0];
#pragma unroll
        for (int r = 1; r < 16; ++r) mx = fmaxf(mx, s[r]);
        mx = fmaxf(mx, __shfl_xor(mx, 32));
        if (__builtin_amdgcn_ballot_w64(mx > mrow[qt] + 8.0f) != 0ull) {
            const float mn = fmaxf(mrow[qt], mx), al = __builtin_amdgcn_exp2f(mrow[qt] - mn); mrow[qt] = mn;
            lrow[qt] *= al;
#pragma unroll
            for (int dt = 0; dt < 2; ++dt)
#pragma unroll
                for (int r = 0; r < 16; ++r) oacc[qt][dt][r] *= al;
        }
        const float mn = mrow[qt];
        float ps = 0.f;
#pragma unroll
        for (int r = 0; r < 16; ++r) { s[r] = __builtin_amdgcn_exp2f(s[r] - mn); ps += s[r]; }
        lrow[qt] += ps;
        bf16x8 pf[2];
#pragma unroll
        for (int sp = 0; sp < 2; ++sp) { const u32x4 w = (u32x4){pk2(s[8 * sp + 0], s[8 * sp + 1]), pk2(s[8 * sp + 2], s[8 * sp + 3]), pk2(s[8 * sp + 4], s[8 * sp + 5]), pk2(s[8 * sp + 6], s[8 * sp + 7])};
            pf[sp] = __builtin_bit_cast(bf16x8, w); }
#pragma unroll
        for (int dt = 0; dt < 2; ++dt)
#pragma unroll
            for (int sp = 0; sp < 2; ++sp) oacc[qt][dt] = __builtin_amdgcn_mfma_f32_32x32x16_bf16(vf[dt][sp], pf[sp], oacc[qt][dt], 0, 0, 0);
    }
}

__device__ __forceinline__ void attn_item(const Args& a, LAS unsigned char* lds, int item, int tid, int lane, int wave) {
    const int kvh = item & 3, qblk = (item >> 2) & 15, b = item >> 6;
    const bf16* Z = (const bf16*)(a.ws + WS_Z); bf16* O = (bf16*)(a.ws + (G2_FP8 ? WS_ATT : WS_O)); constexpr int OLD = G2_FP8 ? 1024 : D;
    const float* cosT = (const float*)(a.ws + WS_COS); const float* sinT = (const float*)(a.ws + WS_SIN);
    __syncthreads();
    for (int task = tid; task < 288 * 4; task += 512) {
        const int slot = task >> 2, c = task & 3;
        int krow, kpos; bool valid;
        if (slot < 32) { valid = slot < NMETA; krow = METAROW0 + slot; kpos = slot; }
        else { const int sp = 128 * (qblk - 1) + (slot - 32); valid = sp >= 0; krow = b * SEQ + sp; kpos = NMETA + sp; }
        u32x4 lo = (u32x4){0u, 0u, 0u, 0u}, hi = lo;
        if (valid) {
            const bf16* kp = Z + (size_t)krow * DIN + ZK + kvh * 64 + c * 8;
            const u32x4 x1 = *(const u32x4*)kp, x2 = *(const u32x4*)(kp + 32);
            const f32x4 c0 = *(const f32x4*)(cosT + kpos * 32 + c * 8), c1 = *(const f32x4*)(cosT + kpos * 32 + c * 8 + 4);
            const f32x4 s0 = *(const f32x4*)(sinT + kpos * 32 + c * 8), s1 = *(const f32x4*)(sinT + kpos * 32 + c * 8 + 4);
#pragma unroll
            for (int q = 0; q < 4; ++q) { const float ca = q < 2 ? c0[2 * q] : c1[2 * q - 4], cb = q < 2 ? c0[2 * q + 1] : c1[2 * q - 3], sa = q < 2 ? s0[2 * q] : s1[2 * q - 4], sb = q < 2 ? s0[2 * q + 1] : s1[2 * q - 3];
                const float a0 = bflo(x1[q]), a1 = bfhi(x1[q]), b0 = bflo(x2[q]), b1 = bfhi(x2[q]);
                lo[q] = pk2(a0 * ca - b0 * sa, a1 * cb - b1 * sb); hi[q] = pk2(b0 * ca + a0 * sa, b1 * cb + a1 * sb); }
        }
        *(LAS u32x4*)(lds + AT_KOFF + slot * AT_KS + c * 16) = lo; *(LAS u32x4*)(lds + AT_KOFF + slot * AT_KS + 64 + c * 16) = hi;
    }
    for (int task = tid; task < 144 * 8; task += 512) {
        const int slot0 = (task >> 3) * 2, c = task & 7;
        int vrow; bool valid;
        if (slot0 < 32) { valid = slot0 < NMETA; vrow = METAROW0 + slot0; }
        else { const int sp = 128 * (qblk - 1) + (slot0 - 32); valid = sp >= 0; vrow = b * SEQ + sp; }
        u32x4 v0 = (u32x4){0u, 0u, 0u, 0u}, v1 = v0;
        if (valid) { const bf16* vp = Z + (size_t)vrow * DIN + ZV + kvh * 64 + c * 8; v0 = *(const u32x4*)vp; v1 = *(const u32x4*)(vp + DIN); }
#pragma unroll
        for (int q = 0; q < 4; ++q) {
            *(LAS unsigned*)(lds + AT_VOFF + (c * 8 + 2 * q) * AT_VS + slot0 * 2) = (v0[q] & 0xffffu) | (v1[q] << 16);
            *(LAS unsigned*)(lds + AT_VOFF + (c * 8 + 2 * q + 1) * AT_VS + slot0 * 2) = (v0[q] >> 16) | (v1[q] & 0xffff0000u); }
    }
    constexpr float QSC = 0.125f * 1.4426950408889634f;
    const int g = wave >> 1, hq = wave & 1, head = kvh * 4 + g, r31 = lane & 31, h = lane >> 5;
    bf16x8 qf[2][4];
#pragma unroll
    for (int qt = 0; qt < 2; ++qt) {
        const int s = 128 * qblk + 64 * hq + 32 * qt + r31, pos = NMETA + s;
        const bf16* qp = Z + (size_t)(b * SEQ + s) * DIN + ZQ + head * 64 + 8 * h;
        u32x4 x[4];
#pragma unroll
        for (int ks = 0; ks < 4; ++ks) x[ks] = *(const u32x4*)(qp + 16 * ks);
#pragma unroll
        for (int ks = 0; ks < 2; ++ks) {
            const float* cp = cosT + pos * 32 + 16 * ks + 8 * h; const float* sp = sinT + pos * 32 + 16 * ks + 8 * h;
            const f32x4 c0 = *(const f32x4*)cp, c1 = *(const f32x4*)(cp + 4), s0 = *(const f32x4*)sp, s1 = *(const f32x4*)(sp + 4);
            u32x4 lo, hi;
#pragma unroll
            for (int q = 0; q < 4; ++q) { const float ca = q < 2 ? c0[2 * q] : c1[2 * q - 4], cb = q < 2 ? c0[2 * q + 1] : c1[2 * q - 3], sa = q < 2 ? s0[2 * q] : s1[2 * q - 4], sb = q < 2 ? s0[2 * q + 1] : s1[2 * q - 3];
                const float a0 = bflo(x[ks][q]), a1 = bfhi(x[ks][q]), b0 = bflo(x[ks + 2][q]), b1 = bfhi(x[ks + 2][q]);
                lo[q] = pk2(QSC * (a0 * ca - b0 * sa), QSC * (a1 * cb - b1 * sb)); hi[q] = pk2(QSC * (b0 * ca + a0 * sa), QSC * (b1 * cb + a1 * sb)); }
            qf[qt][ks] = __builtin_bit_cast(bf16x8, lo); qf[qt][ks + 2] = __builtin_bit_cast(bf16x8, hi);
        }
    }
    f32x16 oacc[2][2]; float mrow[2], lrow[2];
#pragma unroll
    for (int qt = 0; qt < 2; ++qt) { mrow[qt] = a.in[I_SINKS][head] * 1.4426950408889634f; lrow[qt] = h == 0 ? 1.0f : 0.0f;
#pragma unroll
        for (int dt = 0; dt < 2; ++dt)
#pragma unroll
            for (int r = 0; r < 16; ++r) oacc[qt][dt][r] = 0.f; }
    __syncthreads();
    attn_tile(lds, 0, 0, 0, lane, hq, qf, oacc, mrow, lrow);
    if (qblk > 0) {
#pragma unroll 1
        for (int j = hq ? 2 : 0; j < 4; ++j) attn_tile(lds, 32 + 32 * j, 1, j, lane, hq, qf, oacc, mrow, lrow);
    }
#pragma unroll 1
    for (int j = 0; j < (hq ? 4 : 2); ++j) attn_tile(lds, 160 + 32 * j, 2, j, lane, hq, qf, oacc, mrow, lrow);
    LAS float* ssL = (LAS float*)(lds + 90112);
#pragma unroll
    for (int qt = 0; qt < 2; ++qt) {
        const float lt = lrow[qt] + __shfl_xor(lrow[qt], 32), inv = 1.0f / lt;
        bf16* op = O + (size_t)(b * SEQ + 128 * qblk + 64 * hq + 32 * qt + r31) * OLD + head * 64 + 8 * h;
        float ss = 0.f;
#pragma unroll
        for (int dt = 0; dt < 2; ++dt)
#pragma unroll
            for (int rp = 0; rp < 2; ++rp) { unsigned pa[2], pb[2];
#pragma unroll
                for (int e = 0; e < 2; ++e) { const int rr = 2 * rp + e;
                    const float o0 = oacc[qt][dt][4 * rr] * inv, o1 = oacc[qt][dt][4 * rr + 1] * inv, o2 = oacc[qt][dt][4 * rr + 2] * inv, o3 = oacc[qt][dt][4 * rr + 3] * inv;
                    ss += (o0 * o0 + o1 * o1) + (o2 * o2 + o3 * o3);
                    if (e == 0) { pa[0] = pk2(o0, o1); pa[1] = pk2(o2, o3); } else { pb[0] = pk2(o0, o1); pb[1] = pk2(o2, o3); } }
                const auto s0 = __builtin_amdgcn_permlane32_swap(pa[0], pb[0], false, false), s1 = __builtin_amdgcn_permlane32_swap(pa[1], pb[1], false, false);
                *(u32x4*)(op + 32 * dt + 16 * rp) = (u32x4){s0[0], s1[0], s0[1], s1[1]}; }
        ss += __shfl_xor(ss, 32);
        if (h == 0) ssL[g * 128 + 64 * hq + 32 * qt + r31] = ss;
    }
    __syncthreads();
    if (tid < 128) ((float*)(a.ws + WS_SSQ))[(size_t)(b * SEQ + 128 * qblk + tid) * 4 + kvh] = (ssL[tid] + ssL[128 + tid]) + (ssL[256 + tid] + ssL[384 + tid]);
}

constexpr int LR_XS = 2064;
__device__ __forceinline__ void lru_norm_rows(const Args& a, LAS unsigned char* lds, int b, int c, int lane, int wave) {
        bf16* O = (bf16*)(a.ws + WS_O); unsigned char* O8 = a.ws + WS_O;
        const bf16* ATT = (const bf16*)(a.ws + (G2_FP8 ? WS_ATT : WS_O)); constexpr int ALD = G2_FP8 ? 1024 : D;
        u32x4 aw[4][2];
#pragma unroll
        for (int q = 0; q < 4; ++q)
#pragma unroll
            for (int jj = 0; jj < 2; ++jj) aw[q][jj] = *(const u32x4*)(ATT + ((size_t)b * SEQ + 32 * c + 4 * wave + q) * ALD + (lane + 64 * jj) * 8);
        f32x4 ga[2][2], gl[2][2];
#pragma unroll
        for (int jj = 0; jj < 2; ++jj) { ga[jj][0] = *(const f32x4*)(a.in[I_G_ATTN] + (lane + 64 * jj) * 8); ga[jj][1] = *(const f32x4*)(a.in[I_G_ATTN] + (lane + 64 * jj) * 8 + 4);
            gl[jj][0] = *(const f32x4*)(a.in[I_G_LRU] + (lane + 64 * jj) * 8); gl[jj][1] = *(const f32x4*)(a.in[I_G_LRU] + (lane + 64 * jj) * 8 + 4); }
        __syncthreads();
#pragma unroll
        for (int q = 0; q < 4; ++q) {
            const int tl = 4 * wave + q; const size_t row = (size_t)b * SEQ + 32 * c + tl;
#pragma unroll
            for (int half = 0; half < 1; ++half) {
                u32x4 w[2]; float v[16]; float ss = 0.f;
#pragma unroll
                for (int jj = 0; jj < 2; ++jj) { w[jj] = half == 0 ? *(const LAS u32x4*)(lds + tl * LR_XS + (lane + 64 * jj) * 16) : aw[q][jj];
#pragma unroll
                    for (int k = 0; k < 4; ++k) { v[jj * 8 + 2 * k] = bflo(w[jj][k]); v[jj * 8 + 2 * k + 1] = bfhi(w[jj][k]); } }
#pragma unroll
                for (int k = 0; k < 16; ++k) ss += v[k] * v[k];
                ss = wave_sum(ss);
                const float rstd = (G2_FP8 ? XS_SCALE : 1.0f) * __builtin_amdgcn_rsqf(ss * (1.0f / 1024.0f) + EPS);
#pragma unroll
                for (int jj = 0; jj < 2; ++jj) { const f32x4 g0 = half == 0 ? gl[jj][0] : ga[jj][0], g1 = half == 0 ? gl[jj][1] : ga[jj][1];
                    const size_t col = (half == 0 ? 1024 : 0) + (lane + 64 * jj) * 8;
                    if (G2_FP8) *(u32x2*)(O8 + row * D + col) = (u32x2){pk4_fp8(v[jj * 8 + 0] * rstd * g0.x, v[jj * 8 + 1] * rstd * g0.y, v[jj * 8 + 2] * rstd * g0.z, v[jj * 8 + 3] * rstd * g0.w),
                                                                       pk4_fp8(v[jj * 8 + 4] * rstd * g1.x, v[jj * 8 + 5] * rstd * g1.y, v[jj * 8 + 6] * rstd * g1.z, v[jj * 8 + 7] * rstd * g1.w)};
                    else *(u32x4*)(O + row * D + col) = (u32x4){pk2(v[jj * 8 + 0] * rstd * g0.x, v[jj * 8 + 1] * rstd * g0.y), pk2(v[jj * 8 + 2] * rstd * g0.z, v[jj * 8 + 3] * rstd * g0.w),
                                                                pk2(v[jj * 8 + 4] * rstd * g1.x, v[jj * 8 + 5] * rstd * g1.y), pk2(v[jj * 8 + 6] * rstd * g1.z, v[jj * 8 + 7] * rstd * g1.w)}; }
            }
        }
}
template <int PASS>
__device__ __forceinline__ void lru_item(const Args& a, LAS unsigned char* lds, int item, int part, int tid, int lane, int wave) {
    const int b = item / 65, c = item % 65; const bool meta = (c == 64);
    const bf16* Z = (const bf16*)(a.ws + WS_Z);
    float* sumA = (float*)(a.ws + WS_LRUSUM); float* sumB = sumA + NBATCH * 64 * DLRU; float* metaB = sumB + NBATCH * 64 * DLRU;
    __syncthreads();
    {
        const int ch0 = (tid & 127) * 8, tq = tid >> 7;
        f32x4 cw[4][2], cb[2];
#pragma unroll
        for (int jj = 0; jj < 4; ++jj) { cw[jj][0] = *(const f32x4*)(a.in[I_CONV_W] + jj * DLRU + ch0); cw[jj][1] = *(const f32x4*)(a.in[I_CONV_W] + jj * DLRU + ch0 + 4); }
        cb[0] = *(const f32x4*)(a.in[I_CONV_B] + ch0); cb[1] = *(const f32x4*)(a.in[I_CONV_B] + ch0 + 4);
#pragma unroll 1
        for (int i0 = 0; i0 < 8; i0 += 4) {
            u32x4 x[4][4];
#pragma unroll
            for (int i = 0; i < 4; ++i) { const int tl = tq + 4 * (i0 + i); const int t = meta ? tl : NMETA + 32 * c + tl;
#pragma unroll
                for (int jj = 0; jj < 4; ++jj) { const int tt = t - 3 + jj; x[i][jj] = (u32x4){0u, 0u, 0u, 0u};
                    if (tt >= 0 && !(meta && tl >= NMETA)) x[i][jj] = *(const u32x4*)(Z + (size_t)tok_row(b, tt) * DIN + ZX + ch0); } }
#pragma unroll
            for (int i = 0; i < 4; ++i) { const int tl = tq + 4 * (i0 + i); const int t = meta ? tl : NMETA + 32 * c + tl;
                f32x4 a0 = cb[0], a1 = cb[1];
#pragma unroll
                for (int jj = 0; jj < 4; ++jj) { const u32x4 xx = x[i][jj];
                    if (t - 3 + jj >= 0) {
                        a0.x += cw[jj][0].x * bflo(xx[0]); a0.y += cw[jj][0].y * bfhi(xx[0]); a0.z += cw[jj][0].z * bflo(xx[1]); a0.w += cw[jj][0].w * bfhi(xx[1]);
                        a1.x += cw[jj][1].x * bflo(xx[2]); a1.y += cw[jj][1].y * bfhi(xx[2]); a1.z += cw[jj][1].z * bflo(xx[3]); a1.w += cw[jj][1].w * bfhi(xx[3]); } }
                u32x4 o = (u32x4){pk2(a0.x, a0.y), pk2(a0.z, a0.w), pk2(a1.x, a1.y), pk2(a1.z, a1.w)};
                if (meta && tl >= NMETA) o = (u32x4){0u, 0u, 0u, 0u};
                *(LAS u32x4*)(lds + tl * LR_XS + ch0 * 2) = o; }
        }
    }
    LAS float* hinL = (LAS float*)(lds + 32 * LR_XS);
    if (PASS == 1) {
        float h0 = metaB[tid], h1 = metaB[tid + 512];
        const float* pa = sumA + (size_t)b * 64 * DLRU + tid; const float* pb = sumB + (size_t)b * 64 * DLRU + tid;
#pragma unroll 8
        for (int jc = 0; jc < c; ++jc) { h0 = pa[jc * DLRU] * h0 + pb[jc * DLRU]; h1 = pa[jc * DLRU + 512] * h1 + pb[jc * DLRU + 512]; }
        hinL[tid] = h0; hinL[tid + 512] = h1;
    }
    __syncthreads();
    const bf16* WaT = (const bf16*)(a.ws + WS_WAT); const bf16* WiT = (const bf16*)(a.ws + WS_WIT);
    const int r31 = lane & 31, h = lane >> 5;
    const int tau = 16 * ((r31 >> 2) & 1) + 4 * (r31 >> 3) + (r31 & 3);
#pragma unroll 1
    for (int nb = 0; nb < 2; ++nb) {
        const int n = 2 * wave + nb;
        bf16x8 af[4];
#pragma unroll
        for (int ks = 0; ks < 4; ++ks) af[ks] = *(const LAS bf16x8*)(lds + tau * LR_XS + (64 * n + 16 * ks + 8 * h) * 2);
#pragma unroll 1
        for (int nt = 0; nt < 2; ++nt) {
            if (part >= 0 && 2 * nb + nt != part) continue;
            const int ch = 64 * n + 32 * nt + r31;
            f32x16 accR, accI;
#pragma unroll
            for (int r = 0; r < 16; ++r) { accR[r] = 0.f; accI[r] = 0.f; }
#pragma unroll
            for (int ks = 0; ks < 4; ++ks) {
                const bf16x8 wa = *(const bf16x8*)(WaT + ((size_t)(n * 64 + 32 * nt + r31) * 64 + 16 * ks + 8 * h));
                const bf16x8 wi = *(const bf16x8*)(WiT + ((size_t)(n * 64 + 32 * nt + r31) * 64 + 16 * ks + 8 * h));
                accR = __builtin_amdgcn_mfma_f32_32x32x16_bf16(af[ks], wa, accR, 0, 0, 0);
                accI = __builtin_amdgcn_mfma_f32_32x32x16_bf16(af[ks], wi, accI, 0, 0, 0);
            }
            const float ba = a.in[I_B_A][ch], bi = a.in[I_B_I][ch], sp8 = -8.0f * 1.4426950408889634f * log1pf(__expf(-a.in[I_LAMBDA][ch]));
            float av[16], bv[16];
            float Ap = 1.0f, Bp = 0.0f;
#pragma unroll
            for (int r = 0; r < 16; ++r) {
                const float xcv = bf2f(*(const LAS unsigned short*)(lds + (16 * h + r) * LR_XS + ch * 2));
                const float rg = fast_sigmoid(accR[r] + ba), ig = fast_sigmoid(accI[r] + bi);
                const float l2a = sp8 * rg;
                av[r] = __builtin_amdgcn_exp2f(l2a); bv[r] = __builtin_amdgcn_sqrtf(fmaxf(fmaf(-av[r], av[r], 1.0f), 0.0f)) * ig * xcv;
                Ap *= av[r]; Bp = av[r] * Bp + bv[r];
                if (PASS == 0 && !meta) ((unsigned*)(a.ws + WS_AB))[((size_t)b * SEQ + 32 * c + 16 * h + r) * DLRU + ch] = pk2(l2a, bv[r]);
            }
            const float Ao = __shfl_xor(Ap, 32), Bo = __shfl_xor(Bp, 32);
            if (PASS == 0) {
                if (h == 0) {
                    if (meta) metaB[ch] = Bp;
                    else { sumA[((size_t)b * 64 + c) * DLRU + ch] = Ap * Ao; sumB[((size_t)b * 64 + c) * DLRU + ch] = Ao * Bp + Bo; }
                }
            } else {
                const float hin = hinL[ch];
                float hs = h == 0 ? hin : (Ao * hin + Bo);
#pragma unroll
                for (int r = 0; r < 16; ++r) {
                    hs = av[r] * hs + bv[r];
                    const int tl = 16 * h + r;
                    const float gt = bf2f(Z[(size_t)(b * SEQ + 32 * c + tl) * DIN + ZG + ch]);
                    *(LAS unsigned short*)(lds + tl * LR_XS + ch * 2) = (unsigned short)f2bf(hs * fast_gelu_tanh(gt));
                }
            }
        }
    }
}

__device__ __forceinline__ void lru_item_b(const Args& a, LAS unsigned char* lds, int item, int tid, int lane, int wave) {
    const int b = item >> 6, c = item & 63;
    const bf16* Z = (const bf16*)(a.ws + WS_Z); const unsigned* AB = (const unsigned*)(a.ws + WS_AB);
    const float* sumA = (const float*)(a.ws + WS_LRUSUM); const float* sumB = sumA + NBATCH * 64 * DLRU; const float* metaB = sumB + NBATCH * 64 * DLRU;
    const size_t row0 = (size_t)b * SEQ + 32 * c;
    u32x2 ab[32]; unsigned gt[32];
#pragma unroll
    for (int tl = 0; tl < 32; ++tl) { ab[tl] = *(const u32x2*)(AB + (row0 + tl) * DLRU + 2 * tid); gt[tl] = *(const unsigned*)(Z + (row0 + tl) * DIN + ZG + 2 * tid); }
    float h0, h1; { const f32x2 m = *(const f32x2*)(metaB + 2 * tid); h0 = m.x; h1 = m.y; }
    { const float* pa = sumA + (size_t)b * 64 * DLRU + 2 * tid; const float* pb = sumB + (size_t)b * 64 * DLRU + 2 * tid;
#pragma unroll 16
      for (int jc = 0; jc < c; ++jc) { const f32x2 A2 = *(const f32x2*)(pa + jc * DLRU), B2 = *(const f32x2*)(pb + jc * DLRU); h0 = A2.x * h0 + B2.x; h1 = A2.y * h1 + B2.y; } }
    __syncthreads();
#pragma unroll
    for (int tl = 0; tl < 32; ++tl) {
        h0 = __builtin_amdgcn_exp2f(bflo(ab[tl].x)) * h0 + bfhi(ab[tl].x);
        h1 = __builtin_amdgcn_exp2f(bflo(ab[tl].y)) * h1 + bfhi(ab[tl].y);
        *(LAS unsigned*)(lds + tl * LR_XS + 4 * tid) = pk2(h0 * fast_gelu_tanh(bflo(gt[tl])), h1 * fast_gelu_tanh(bfhi(gt[tl])));
    }
    lru_norm_rows(a, lds, b, c, lane, wave);
}

__device__ __forceinline__ void phase_router_mfma(const Args& a, LAS unsigned char* lds, int tid, int lane, int wave) {
    const bf16* H1 = (const bf16*)(a.ws + WS_H1); const bf16* WRT = (const bf16*)(a.ws + WS_WRT);
    int* tope = (int*)(a.ws + WS_TOPE); float* topw = (float*)(a.ws + WS_TOPW); float* rstd2 = (float*)(a.ws + WS_RSTD2);
    unsigned* counts = (unsigned*)(a.ws + WS_CTL) + CW_COUNTS;
    LAS float* lg = (LAS float*)(lds + wave * 2048);
    LAS int* hist = (LAS int*)(lds + 32768);
    if (tid < 32) hist[tid] = 0;
    __syncthreads();
    const int fr = lane & 15, fq = lane >> 4;
    const int kh = wave >> 2;
    LAS float* part = (LAS float*)(lds + 40960 + (wave & 3) * 2560);
    for (int g0 = 4 * blockIdx.x; g0 < MREAL / 16; g0 += 4 * gridDim.x) {
        const int grp = g0 + (wave & 3);
        const int row0 = grp * 16;
        const bf16* hp = H1 + (size_t)(row0 + fr) * D + 8 * fq + 1024 * kh;
        const bf16* wp = WRT + (size_t)fr * D + 8 * fq + 1024 * kh;
        f32x4 acc0 = (f32x4){0.f, 0.f, 0.f, 0.f}, acc1 = acc0; float ss = 0.f;
#pragma unroll 8
        for (int kk = 0; kk < 32; ++kk) {
            const u32x4 w = *(const u32x4*)(hp + 32 * kk);
#pragma unroll
            for (int q = 0; q < 4; ++q) { const float lo = bflo(w[q]), hi = bfhi(w[q]); ss += lo * lo + hi * hi; }
            const bf16x8 af = __builtin_bit_cast(bf16x8, w);
            const bf16x8 b0 = *(const bf16x8*)(wp + 32 * kk), b1 = *(const bf16x8*)(wp + (size_t)16 * D + 32 * kk);
            acc0 = __builtin_amdgcn_mfma_f32_16x16x32_bf16(af, b0, acc0, 0, 0, 0);
            acc1 = __builtin_amdgcn_mfma_f32_16x16x32_bf16(af, b1, acc1, 0, 0, 0);
        }
        if (kh == 1) {
#pragma unroll
            for (int j = 0; j < 4; ++j) { part[j * 64 + lane] = acc0[j]; part[(4 + j) * 64 + lane] = acc1[j]; }
            part[8 * 64 + lane] = ss; }
        __syncthreads();
        if (kh == 0) {
#pragma unroll
            for (int j = 0; j < 4; ++j) { acc0[j] += part[j * 64 + lane]; acc1[j] += part[(4 + j) * 64 + lane]; }
            ss += part[8 * 64 + lane]; }
        __syncthreads();
        if (kh == 1) continue;
        ss += __shfl_xor(ss, 16); ss += __shfl_xor(ss, 32);
        const float rstd = 1.0f / sqrtf(ss * (1.0f / D) + EPS);
        if (fq == 0) rstd2[row0 + fr] = rstd;
        const float br0 = a.in[I_B_ROUTER][fr], br1 = a.in[I_B_ROUTER][16 + fr];
#pragma unroll
        for (int j = 0; j < 4; ++j) { const int row = 4 * fq + j; const float rs = __shfl(rstd, row);
            lg[row * 32 + fr] = acc0[j] * rs + br0; lg[row * 32 + 16 + fr] = acc1[j] * rs + br1; }
        asm volatile("s_waitcnt lgkmcnt(0)" ::: "memory");
        if (lane < 16) {
            float v[32];
#pragma unroll
            for (int q = 0; q < 8; ++q) { const f32x4 t = *(const LAS f32x4*)(lg + lane * 32 + 4 * q); v[4 * q] = t.x; v[4 * q + 1] = t.y; v[4 * q + 2] = t.z; v[4 * q + 3] = t.w; }
            float tv[4]; int te[4];
#pragma unroll
            for (int r = 0; r < 4; ++r) { float best = -3.0e38f; int bi = 0;
#pragma unroll
                for (int e = 0; e < 32; ++e) { const bool gtb = v[e] > best; best = gtb ? v[e] : best; bi = gtb ? e : bi; }
#pragma unroll
                for (int e = 0; e < 32; ++e) v[e] = (e == bi) ? -3.0e38f : v[e];
                tv[r] = best; te[r] = bi; }
            const float e1 = __expf(tv[1] - tv[0]), e2 = __expf(tv[2] - tv[0]), e3 = __expf(tv[3] - tv[0]);
            const float inv = 1.0f / (1.0f + e1 + e2 + e3);
            const int row = row0 + lane;
            *(int4*)(tope + row * 4) = make_int4(te[0], te[1], te[2], te[3]);
            *(f32x4*)(topw + row * 4) = (f32x4){inv, e1 * inv, e2 * inv, e3 * inv};
#pragma unroll
            for (int r = 0; r < 4; ++r) atomicAdd((int*)&hist[te[r]], 1);
        }
        asm volatile("s_waitcnt lgkmcnt(0)" ::: "memory");
    }
    __syncthreads();
    if (tid < 32 && hist[tid] != 0) atomicAdd(&counts[tid], (unsigned)hist[tid]);
}

__device__ __forceinline__ void build_tile_table(const Args& a, LAS int* tstart, int tid) {
    if (tid < 64) {
        const unsigned* counts = (const unsigned*)(a.ws + WS_CTL) + CW_COUNTS;
        const int nt = tid < NEXP ? (int)((__hip_atomic_load(counts + tid, __ATOMIC_RELAXED, __HIP_MEMORY_SCOPE_AGENT) + 255u) >> 8) : 0;
        int inc = nt;
#pragma unroll
        for (int o = 1; o < 32; o <<= 1) { const int v = __shfl_up(inc, o); if ((tid & 63) >= o) inc += v; }
        if (tid < NEXP) tstart[tid] = inc - nt;
        if (tid == NEXP - 1) tstart[NEXP] = inc;
    }
    __syncthreads();
    if (tid < 288) { int e = 0;
#pragma unroll 1
        for (int i = 1; i < NEXP; ++i) e += (tstart[i] <= tid) ? 1 : 0;
        ((LAS unsigned char*)(tstart + 64))[tid] = (unsigned char)e; }
    __syncthreads();
}
__device__ __forceinline__ int tile_expert(const LAS int* tstart, int tile) {
    int e = 0;
#pragma unroll 1
    for (int i = 1; i < NEXP; ++i) e += (tstart[i] <= tile) ? 1 : 0;
    return e;
}

__device__ __forceinline__ void assign_n2rows(const Args& a, int blk, int lane, int wave) {
    const float* rstd2 = (const float*)(a.ws + WS_RSTD2); const bf16* H1 = (const bf16*)(a.ws + WS_H1); unsigned char* XS = (unsigned char*)(a.ws + WS_XS);
    for (int tt = wave * 8; tt < wave * 8 + 8; ++tt) {
        const int token = blk * 64 + tt; const float rstd = rstd2[token] * XS_SCALE;
        const u32x4* hr = (const u32x4*)(H1 + (size_t)token * D);
        u32x4* dst = (u32x4*)(XS + (size_t)token * D);
#pragma unroll
        for (int j = 0; j < 2; ++j) { const u32x4 ha = hr[2 * (lane + 64 * j)], hb = hr[2 * (lane + 64 * j) + 1];
            const f32x4* gp = (const f32x4*)a.in[I_NORM_FFN] + 4 * (lane + 64 * j); const f32x4 g0 = gp[0], g1 = gp[1], g2 = gp[2], g3 = gp[3];
            dst[lane + 64 * j] = (u32x4){pk4_fp8(bflo(ha[0]) * rstd * g0.x, bfhi(ha[0]) * rstd * g0.y, bflo(ha[1]) * rstd * g0.z, bfhi(ha[1]) * rstd * g0.w),
                                         pk4_fp8(bflo(ha[2]) * rstd * g1.x, bfhi(ha[2]) * rstd * g1.y, bflo(ha[3]) * rstd * g1.z, bfhi(ha[3]) * rstd * g1.w),
                                         pk4_fp8(bflo(hb[0]) * rstd * g2.x, bfhi(hb[0]) * rstd * g2.y, bflo(hb[1]) * rstd * g2.z, bfhi(hb[1]) * rstd * g2.w),
                                         pk4_fp8(bflo(hb[2]) * rstd * g3.x, bfhi(hb[2]) * rstd * g3.y, bflo(hb[3]) * rstd * g3.z, bfhi(hb[3]) * rstd * g3.w)}; }
    }
}
__device__ __forceinline__ void phase_assign(const Args& a, LAS unsigned char* lds, int tid, int lane, int wave, bool do_rows) {
    LAS int* tstart = (LAS int*)(lds + LDS_TAB);
    LAS int* hist = (LAS int*)lds; LAS int* base = hist + 32; LAS int* spos = base + 32;
    build_tile_table(a, tstart, tid);
    const int* tope = (const int*)(a.ws + WS_TOPE); const float* topw = (const float*)(a.ws + WS_TOPW); const float* rstd2 = (const float*)(a.ws + WS_RSTD2);
    int* rowpair = (int*)(a.ws + WS_ROWPAIR); float* roww = (float*)(a.ws + WS_ROWW);
    unsigned* cursor = (unsigned*)(a.ws + WS_CTL) + CW_CURSOR;
    const bf16* H1 = (const bf16*)(a.ws + WS_H1); unsigned char* XS = (unsigned char*)(a.ws + WS_XS);
    for (int blk = blockIdx.x; blk < MREAL / 64; blk += gridDim.x) {
        if (tid < 32) hist[tid] = 0;
        __syncthreads();
        int e = 0, rank = 0, pair = 0;
        if (tid < 256) { pair = blk * 256 + tid; e = tope[pair]; rank = atomicAdd((int*)&hist[e], 1); }
        __syncthreads();
        if (tid < 32) base[tid] = (int)atomicAdd(&cursor[tid], (unsigned)hist[tid]);
        __syncthreads();
        if (tid < 256) { const int pos = tstart[e] * 256 + base[e] + rank; spos[tid] = pos; rowpair[pos] = pair; roww[pos] = topw[pair]; ((int*)(a.ws + WS_PAIRPOS))[pair] = pos; }
        __syncthreads();
        if (do_rows) assign_n2rows(a, blk, lane, wave);
        __syncthreads();
    }
}

__device__ __forceinline__ void phase_final(const Args& a, int lane, int wave) {
    const int gw = blockIdx.x * 8 + wave, NGW = gridDim.x * 8;
    const bf16* H1 = (const bf16*)(a.ws + WS_H1); const unsigned char* YB = a.ws + WS_YB;
    const int* pairpos = (const int*)(a.ws + WS_PAIRPOS); const float* topw = (const float*)(a.ws + WS_TOPW);
    for (int row = gw; row < MREAL; row += NGW) {
        const int4 pp = *(const int4*)(pairpos + row * 4); const f32x4 pw = *(const f32x4*)(topw + row * 4) * (1.0f / YB_SCALE);
        const int pos[4] = {pp.x, pp.y, pp.z, pp.w}; const float w4[4] = {pw.x, pw.y, pw.z, pw.w};
        f32x4 v[8]; unsigned y[4][8]; float ss = 0.f;
#pragma unroll
        for (int k = 0; k < 4; ++k)
#pragma unroll
            for (int j = 0; j < 8; ++j) y[k][j] = ((const unsigned*)(YB + (size_t)pos[k] * D))[lane + 64 * j];
#pragma unroll
        for (int j = 0; j < 8; ++j) { { const u32x2 hh = ((const u32x2*)(H1 + (size_t)row * D))[lane + 64 * j]; v[j] = (f32x4){bflo(hh.x), bfhi(hh.x), bflo(hh.y), bfhi(hh.y)}; }
#pragma unroll
            for (int k = 0; k < 4; ++k) { const f32x2 lo = __builtin_amdgcn_cvt_pk_f32_fp8((int)y[k][j], false), hi = __builtin_amdgcn_cvt_pk_f32_fp8((int)y[k][j], true);
                v[j].x += w4[k] * lo.x; v[j].y += w4[k] * lo.y; v[j].z += w4[k] * hi.x; v[j].w += w4[k] * hi.y; }
            ss += (v[j].x * v[j].x + v[j].y * v[j].y) + (v[j].z * v[j].z + v[j].w * v[j].w); }
        ss = wave_sum(ss);
        const float rstd = 1.0f / sqrtf(ss * (1.0f / D) + EPS);
        f32x4* op = (f32x4*)(a.out + (size_t)row * D);
#pragma unroll
        for (int j = 0; j < 8; ++j) { const f32x4 g = ((const f32x4*)a.in[I_FINAL_NORM])[lane + 64 * j]; op[lane + 64 * j] = v[j] * rstd * g; }
    }
}

enum { PH_PROLOGUE = 0, PH_G1, PH_ATTN, PH_LRU_B, PH_G2, PH_ROUTER, PH_ASSIGN, PH_G3, PH_G4, PH_FINAL, PH_COUNT };

__global__ void __launch_bounds__(512, 2) fwd(Args a) {
    extern __shared__ __attribute__((aligned(16))) unsigned char lds_raw[];
    LAS unsigned char* lds = (LAS unsigned char*)lds_raw;
    const int tid = threadIdx.x, lane = tid & 63, wave = __builtin_amdgcn_readfirstlane(tid >> 6);
    const int gw = blockIdx.x * 8 + wave, NGW = gridDim.x * 8;
    unsigned char* ws = a.ws;
#define IN(k) (a.ph_lo <= (k) && (k) < a.ph_hi)
    pg8::BGNone nobg;
    pg8::BGConv bgup{(const char*)a.in[I_W_UP], ws + WS_WUT, (int)blockIdx.x * 128, (int)blockIdx.x * 128 + 80, ws + WS_DUMMY};
#define SEAM(k) do { if (IN(k) && IN((k) + 1)) xcd_barrier(bar); } while (0)
    if (tid < 4) ((LAS unsigned*)(lds + LDS_MISC))[tid] = 0u;
    __syncthreads();
    XcdBarrier bar; bar.bar = (unsigned*)(ws + WS_CTL) + CW_BAR; bar.x = 0; bar.st = nullptr;
    if (a.ph_hi - a.ph_lo > 1) bar = xcd_barrier_post((unsigned*)(ws + WS_CTL) + CW_BAR, (volatile LAS unsigned*)(lds + LDS_MISC));

    if (IN(PH_PROLOGUE)) { phase_prologue(a, lds, tid, lane, wave);
#if PROBE_REPEAT == 0
        __syncthreads(); phase_prologue(a, lds, tid, lane, wave);
#endif
    }
    SEAM(PH_PROLOGUE);

    if (IN(PH_G1)) {
        const int ncv = g1_conv_wg(), G1G = (int)gridDim.x - ncv;
        pg8::SchedDense S{(const char*)(ws + WS_N1), (const char*)(ws + WS_WINT), (const char*)(ws + WS_WINT), nullptr, MROWS / 256, DIN / 256, G1G, (int)blockIdx.x, G1_FP8 ? 2048 : 4096};
        pg8::EpiZ E{(bf16*)(ws + WS_Z), a.in[I_B_IN], (const float*)(ws + WS_RSTD1)};
        if ((int)blockIdx.x >= G1G) conv_tiles(a, lds, tid, conv_pro_tiles() + ((int)blockIdx.x - G1G), CONV_ALL_TILES - BG_G2_TILES, ncv);
        else
#if BG_WUP
        pg8::gemm_phase<G1_FP8 != 0>(lds, S, E, bgup);
#else
        pg8::gemm_phase<G1_FP8 != 0>(lds, S, E, nobg);
#endif
#if PROBE_REPEAT == 1
        __syncthreads(); pg8::gemm_phase<G1_FP8 != 0>(lds, S, E, nobg);
#endif
    }
    SEAM(PH_G1);
    if (IN(PH_ATTN)) {
        for (int it = blockIdx.x; it < NBATCH * 16 * 4; it += gridDim.x) attn_item(a, lds, it, tid, lane, wave);
        for (int j = blockIdx.x; j < NBATCH * 64 + 4; j += gridDim.x) {
            if (j < NBATCH * 64) lru_item<0>(a, lds, (j >> 6) * 65 + (j & 63), -1, tid, lane, wave); else lru_item<0>(a, lds, 64, j - NBATCH * 64, tid, lane, wave); }
#if PROBE_REPEAT == 2
        for (int it = blockIdx.x; it < NBATCH * 16 * 4; it += gridDim.x) attn_item(a, lds, it, tid, lane, wave);
#endif
#if PROBE_REPEAT == 3
        for (int j = blockIdx.x; j < NBATCH * 64 + 4; j += gridDim.x) {
            if (j < NBATCH * 64) lru_item<0>(a, lds, (j >> 6) * 65 + (j & 63), -1, tid, lane, wave); else lru_item<0>(a, lds, 64, j - NBATCH * 64, tid, lane, wave); }
#endif
    }
    SEAM(PH_ATTN);
    if (IN(PH_LRU_B)) {
        for (int it = blockIdx.x; it < NBATCH * 64; it += gridDim.x) lru_item_b(a, lds, (it & 256) ? (it ^ 63) : it, tid, lane, wave);
    }
    SEAM(PH_LRU_B);
    if (IN(PH_G2)) {
        pg8::SchedDense S{(const char*)(ws + WS_O), (const char*)(ws + WS_WOUTT), (const char*)(ws + WS_WOUTT), nullptr, MREAL / 256, D / 256, (int)gridDim.x, (int)blockIdx.x, G2_FP8 ? 2048 : 4096};
        pg8::EpiH1 E{(bf16*)(ws + WS_H1), (const bf16*)(ws + WS_N1), a.in[I_B_OUT], G2_FP8 ? 1.0f / (W_SCALE * XS_SCALE) : 1.0f, (const float*)(ws + WS_SSQ)};
#if BG_WUP
        pg8::gemm_phase<G2_FP8 != 0>(lds, S, E, bgup);
        for (int pair = bgup.next < bgup.end ? bgup.next : bgup.end; pair < bgup.end; ++pair) { const char* sp; unsigned char* dp; pg8::bg_pair_ptrs(bgup, pair, sp, dp);
            const int n = tid >> 4, c = tid & 15; const float* p = (const float*)sp + (size_t)(8 * c) * 2048 + n;
            *(u32x2*)(dp + (size_t)n * 2048 + 8 * c) = (u32x2){pk4_fp8(p[0] * W_SCALE, p[2048] * W_SCALE, p[4096] * W_SCALE, p[6144] * W_SCALE), pk4_fp8(p[8192] * W_SCALE, p[10240] * W_SCALE, p[12288] * W_SCALE, p[14336] * W_SCALE)}; }
#elif BG_G2_TILES > 0
        { const int pfirst = (4096 - BG_G2_TILES) * 8, pcount = BG_G2_TILES * 8;
          pg8::BGConv bg2{(const char*)a.in[I_W_UP], ws + WS_WUT, pfirst + (int)((long)blockIdx.x * pcount / gridDim.x), pfirst + (int)((long)(blockIdx.x + 1) * pcount / gridDim.x), ws + WS_DUMMY};
          pg8::gemm_phase<false, pg8::EpiH1, pg8::SchedDense, pg8::BGConv>(lds, S, E, bg2);
          for (int pair = bg2.next < bg2.end ? bg2.next : bg2.end; pair < bg2.end; ++pair) { const char* sp; unsigned char* dp; pg8::bg_pair_ptrs(bg2, pair, sp, dp);
              const int n = tid >> 4, c = tid & 15; const float* p = (const float*)sp + (size_t)(8 * c) * 2048 + n;
              *(u32x2*)(dp + (size_t)n * 2048 + 8 * c) = (u32x2){pk4_fp8(p[0] * W_SCALE, p[2048] * W_SCALE, p[4096] * W_SCALE, p[6144] * W_SCALE), pk4_fp8(p[8192] * W_SCALE, p[10240] * W_SCALE, p[12288] * W_SCALE, p[14336] * W_SCALE)}; } }
#else
        pg8::gemm_phase<G2_FP8 != 0>(lds, S, E, nobg);
#endif
#if PROBE_REPEAT == 4
        __syncthreads(); pg8::gemm_phase<G2_FP8 != 0>(lds, S, E, nobg);
#endif
    }
    SEAM(PH_G2);
    if (IN(PH_ROUTER)) phase_router_mfma(a, lds, tid, lane, wave);
    if (IN(PH_ROUTER) && IN(PH_ASSIGN)) {
        asm volatile("s_waitcnt vmcnt(0)" ::: "memory"); __syncthreads();
        if (tid == 0) __hip_atomic_fetch_add((unsigned*)(ws + WS_CTL) + CW_RSYNC, 1u, __ATOMIC_RELAXED, __HIP_MEMORY_SCOPE_AGENT);
        for (int blk = blockIdx.x; blk < MREAL / 64; blk += gridDim.x) assign_n2rows(a, blk, lane, wave);
        if (tid == 0) { unsigned* rs = (unsigned*)(ws + WS_CTL) + CW_RSYNC; unsigned* tmo = (unsigned*)(ws + WS_CTL) + CW_BAR + XB_TMO;
            unsigned sp = 0; while (__hip_atomic_load(rs, __ATOMIC_RELAXED, __HIP_MEMORY_SCOPE_AGENT) < gridDim.x) { __builtin_amdgcn_s_sleep(1);
                if ((++sp & 255u) == 0u) { if (__hip_atomic_load(tmo, __ATOMIC_RELAXED, __HIP_MEMORY_SCOPE_AGENT)) break; if (sp > XB_SPIN_CAP) { atomicAdd(tmo, 1u); break; } } } }
        __syncthreads();
    } else SEAM(PH_ROUTER);
    if (IN(PH_ASSIGN)) phase_assign(a, lds, tid, lane, wave, !(IN(PH_ROUTER)));
    SEAM(PH_ASSIGN);
    if (IN(PH_G3)) {
        LAS int* tstart = (LAS int*)(lds + LDS_TAB);
        if (!IN(PH_ASSIGN)) build_tile_table(a, tstart, tid);
        const int G3G = (int)gridDim.x - G3_TEST_IDLE;
        pg8::SchedMoE S{(const char*)(ws + WS_N2), (const char*)(ws + WS_WGT), (const char*)(ws + WS_WUT), (const int*)(ws + WS_ROWPAIR), tstart, tstart[NEXP], DFF / 128, G3G, (int)blockIdx.x, true};
        pg8::EpiAct E{(unsigned char*)(ws + WS_ACT), a.in[I_B_GATE], a.in[I_B_UP]};
#if BG_WDOWN
        int bg0, bg1;
        { const int U = tstart[NEXP] * (DFF / 128), ulo = U / G3G, nhi = U - ulo * G3G, c = (int)blockIdx.x;
          int plo = (32768 + nhi * 48 + G3G - 1) / G3G; if (nhi != 0 && plo > 8 * ulo) plo = 8 * ulo > 0 ? 8 * ulo : 1;
          int phi = nhi ? (32768 - (G3G - nhi) * plo + nhi - 1) / nhi : 0; if (phi < 0) phi = 0;
          bg0 = c < nhi ? c * phi : nhi * phi + (c - nhi) * plo; bg1 = bg0 + (c < nhi ? phi : plo);
          if (c >= G3G) { bg0 = bg1 = 32768; }
          if (c == G3G - 1) bg1 = 32768;
          bg0 = bg0 < 32768 ? bg0 : 32768; bg1 = bg1 < 32768 ? bg1 : 32768; }
        pg8::BGConv bg{(const char*)a.in[I_W_DOWN], ws + WS_WDT, bg0, bg1, ws + WS_DUMMY};
        if ((int)blockIdx.x < G3G) pg8::gemm_phase<true, pg8::EpiAct, pg8::SchedMoE, pg8::BGConv, true>(lds, S, E, bg);
        for (int pair = bg.next < bg.end ? bg.next : bg.end; pair < bg.end; ++pair) { const char* sp; unsigned char* dp; pg8::bg_pair_ptrs(bg, pair, sp, dp);
            const int n = tid >> 4, c = tid & 15;
            const float* p = (const float*)sp + (size_t)(8 * c) * 2048 + n;
            *(u32x2*)(dp + (size_t)n * 2048 + 8 * c) = (u32x2){pk4_fp8(p[0] * W_SCALE, p[2048] * W_SCALE, p[4096] * W_SCALE, p[6144] * W_SCALE), pk4_fp8(p[8192] * W_SCALE, p[10240] * W_SCALE, p[12288] * W_SCALE, p[14336] * W_SCALE)}; }
#else
        pg8::gemm_phase<true, pg8::EpiAct, pg8::SchedMoE, pg8::BGNone, true>(lds, S, E, nobg);
#endif
#if PROBE_REPEAT == 7
        __syncthreads(); pg8::gemm_phase<true, pg8::EpiAct, pg8::SchedMoE, pg8::BGNone, true>(lds, S, E, nobg);
#endif
    }
    SEAM(PH_G3);
    if (IN(PH_G4)) {
        LAS int* tstart = (LAS int*)(lds + LDS_TAB);
        if (!IN(PH_ASSIGN) && !IN(PH_G3)) build_tile_table(a, tstart, tid);
        pg8::SchedMoE S{(const char*)(ws + WS_ACT), (const char*)(ws + WS_WDT), (const char*)(ws + WS_WDT), nullptr, tstart, tstart[NEXP], D / 256, (int)gridDim.x, (int)blockIdx.x, false};
        pg8::EpiDown E{ws + WS_YB, a.in[I_B_DOWN]};
        pg8::gemm_phase<true>(lds, S, E, nobg);
#if PROBE_REPEAT == 8
        __syncthreads(); pg8::gemm_phase<true>(lds, S, E, nobg);
#endif
    }
    SEAM(PH_G4);
    if (IN(PH_FINAL)) { phase_final(a, lane, wave);
#if PROBE_REPEAT == 9
        phase_final(a, lane, wave);
#endif
    }
#undef IN
#undef SEAM
}

extern "C" void kernel_launch(void* const* d_in, const int* in_sizes, int n_in, void* d_out, int out_size, void* d_ws, size_t ws_size, hipStream_t stream) {
    static int grid = 0;
    if (grid == 0) {
        if (n_in != 27 || out_size != MREAL * D || ws_size < WS_END) { fprintf(stderr, "kernel_launch: unexpected problem (n_in %d, out %d, ws %zu)\n", n_in, out_size, ws_size); grid = -1; return; }
        int dev = 0, cus = 0;
        if (hipGetDevice(&dev) != hipSuccess || hipDeviceGetAttribute(&cus, hipDeviceAttributeMultiprocessorCount, dev) != hipSuccess) { grid = -1; return; }
        if (hipFuncSetAttribute((const void*)fwd, hipFuncAttributeMaxDynamicSharedMemorySize, LDS_BYTES) != hipSuccess) { fprintf(stderr, "kernel_launch: hipFuncSetAttribute failed\n"); grid = -1; return; }
        int nb = 0;
        if (hipOccupancyMaxActiveBlocksPerMultiprocessor(&nb, (const void*)fwd, 512, LDS_BYTES) != hipSuccess || nb < 1) { fprintf(stderr, "kernel_launch: the kernel does not fit a CU\n"); grid = -1; return; }
        grid = cus;
    }
    if (grid < 0) return;
    (void)hipMemsetAsync((char*)d_ws + WS_CTL, 0, CTL_ZERO_BYTES, stream);
    Args a{};
    for (int i = 0; i < 27; ++i) a.in[i] = (const float*)d_in[i];
    a.out = (float*)d_out; a.ws = (unsigned char*)d_ws;
#if MK_ONE_LAUNCH
    a.ph_lo = 0; a.ph_hi = PH_COUNT;
    hipLaunchKernelGGL(fwd, dim3(grid), dim3(512), LDS_BYTES, stream, a);
#else
    for (int ph = 0; ph < PH_COUNT; ++ph) {
        a.ph_lo = ph; a.ph_hi = ph + 1;
        hipLaunchKernelGGL(fwd, dim3(grid), dim3(512), LDS_BYTES, stream, a);
    }
#endif
}
```
